# Optimizing an MI355X kernel written in HIP

```python
import math
import jax, jax.numpy as jnp
from jax import lax
import numpy as np

D_MODEL = 1024
BATCH = 32
SEQ = 256
DEPTH = 1
DEC_BATCH = 2
DEC_SEQ = 2048
PAST_LEN = 256

GRID_W = 64
M_INNER = 2 * D_MODEL
M_HEADDIM = 64
M_HEADS = M_INNER // M_HEADDIM
M_GROUPS = 4
M_HPG = M_HEADS // M_GROUPS
M_STATE = 128
M_CONV = 5
M_CHUNK = 128
M_XBC = M_INNER + 2 * M_GROUPS * M_STATE
R_WIDTH = D_MODEL
R_HEADSIZE = 64
R_HEADS = R_WIDTH // R_HEADSIZE
R_DECAY_RANK = 64
R_ICLR_RANK = 64
R_GATE_RANK = 128
R_COLS = 3 * R_WIDTH + 2 * R_DECAY_RANK + 2 * R_ICLR_RANK + R_GATE_RANK
IN_COLS = M_INNER + M_XBC + 2 * M_HEADS + R_COLS + 2 * D_MODEL
D_FF = -(-8 * D_MODEL // (3 * 256)) * 256

kernel_name = 'hybrid_ssd_rwkv7_diffusion_step'


def rmsnorm(x, w, eps=1e-6):
    xf = x.astype(jnp.float32)
    y = xf * lax.rsqrt(jnp.mean(xf * xf, axis=-1, keepdims=True) + eps)
    return (y * w).astype(x.dtype)


def centred_dwconv(x, w, b):
    pad = M_CONV // 2
    l = x.shape[1]
    xp = jnp.pad(x, ((0, 0), (pad, pad), (0, 0)))
    return b + sum(xp[:, i:i + l] * w[i] for i in range(M_CONV))


def qshift_seq(x):
    q = x.shape[-1] // 4
    prev = jnp.pad(x[:, :-1], ((0, 0), (1, 0), (0, 0)))
    nxt = jnp.pad(x[:, 1:], ((0, 0), (0, 1), (0, 0)))
    return jnp.concatenate([prev[..., :q], nxt[..., q:2 * q], prev[..., 2 * q:3 * q], nxt[..., 3 * q:]], axis=-1)


def qshift_grid(x):
    b, l, ch = x.shape
    rows = l // GRID_W
    g = x.reshape(b, rows, GRID_W, ch)
    q = ch // 4
    left = jnp.pad(g[:, :, :-1, :q], ((0, 0), (0, 0), (1, 0), (0, 0)))
    right = jnp.pad(g[:, :, 1:, q:2 * q], ((0, 0), (0, 0), (0, 1), (0, 0)))
    up = jnp.pad(g[:, :-1, :, 2 * q:3 * q], ((0, 0), (1, 0), (0, 0), (0, 0)))
    down = jnp.pad(g[:, 1:, :, 3 * q:], ((0, 0), (0, 1), (0, 0), (0, 0)))
    return jnp.concatenate([left, right, up, down], axis=-1).reshape(b, l, ch)


def segsum_exp(a):
    t = a.shape[-1]
    cs = jnp.cumsum(a, axis=-1)
    mask = jnp.tril(jnp.ones((t, t), dtype=bool))
    return jnp.exp(jnp.where(mask, cs[..., :, None] - cs[..., None, :], -jnp.inf))


def ssd_scan(x, dt, a, bm, cm, h0):
    b, l, _, p = x.shape
    nc = l // M_CHUNK
    xs = (x * dt[..., None]).reshape(b, nc, M_CHUNK, M_GROUPS, M_HPG, p)
    da = jnp.moveaxis((dt * a).reshape(b, nc, M_CHUNK, M_GROUPS, M_HPG), 2, -1)
    bc = bm.reshape(b, nc, M_CHUNK, M_GROUPS, M_STATE)
    cc = cm.reshape(b, nc, M_CHUNK, M_GROUPS, M_STATE)
    da_cs = jnp.cumsum(da, axis=-1)
    lmat = segsum_exp(da)
    cb = jnp.einsum('bclgn,bcsgn->bcgls', cc, bc)
    y_diag = jnp.einsum('bcgls,bcgels,bcsgep->bclgep', cb, lmat, xs)
    decay_states = jnp.exp(da_cs[..., -1:] - da_cs)
    states = jnp.einsum('bclgn,bcgel,bclgep->bcgepn', bc, decay_states, xs)
    h0g = h0.astype(jnp.float32).reshape(b, M_GROUPS, M_HPG, p, M_STATE)
    states = jnp.concatenate([h0g[:, None], states], axis=1)
    chunk_a = jnp.moveaxis(jnp.pad(da_cs[..., -1], ((0, 0), (1, 0), (0, 0), (0, 0))), 1, -1)
    decay_chunk = segsum_exp(chunk_a)
    new_states = jnp.einsum('bgezc,bcgepn->bzgepn', decay_chunk, states)
    prev_states, final = new_states[:, :-1], new_states[:, -1]
    y_off = jnp.einsum('bclgn,bcgepn,bcgel->bclgep', cc, prev_states, jnp.exp(da_cs))
    y = (y_diag + y_off).reshape(b, l, M_HEADS, p)
    return y, final.reshape(b, M_HEADS, p, M_STATE)


def mamba_branch(z, xbc, dt_raw, h0_f, h0_b, p):
    f32 = jnp.float32
    b, l, _ = z.shape
    xbc = jax.nn.silu(centred_dwconv(xbc, p['conv_w'], p['conv_b'])).astype(f32)
    xm, bm, cm = jnp.split(xbc, [M_INNER, M_INNER + M_GROUPS * M_STATE], axis=-1)
    xm = xm.reshape(b, l, M_HEADS, M_HEADDIM)
    bm = bm.reshape(b, l, M_GROUPS, M_STATE)
    cm = cm.reshape(b, l, M_GROUPS, M_STATE)
    dt = jax.nn.softplus(dt_raw.reshape(b, l, 2, M_HEADS).astype(f32) + p['dt_bias'].astype(f32))
    a = -jnp.exp(p['a_log'].astype(f32))
    y_f, hf = ssd_scan(xm, dt[:, :, 0], a[0], bm, cm, h0_f)
    y_b, hb = ssd_scan(xm[:, ::-1], dt[:, ::-1, 1], a[1], bm[:, ::-1], cm[:, ::-1], h0_b)
    y = y_f + y_b[:, ::-1] + p['d_skip'].astype(f32)[:, None] * xm
    y = y.reshape(b, l, M_INNER) * jax.nn.silu(z.astype(f32))
    yg = y.reshape(b, l, M_GROUPS, M_INNER // M_GROUPS)
    yg = yg * lax.rsqrt(jnp.mean(yg * yg, axis=-1, keepdims=True) + 1e-5)
    y = yg.reshape(b, l, M_INNER) * p['m_norm_w']
    return y.astype(z.dtype), hf, hb


def to_heads(t):
    return t.reshape(*t.shape[:-1], R_HEADS, R_HEADSIZE)


def wkv7_scan(r, w, k, v, kk, a, s0):
    def step(s, inp):
        rt, wt, kt, vt, kkt, at = inp
        sa = jnp.einsum('dbhij,dbhj->dbhi', s, -kkt)
        s = s * wt[..., None, :] + sa[..., None] * (kkt * at)[..., None, :] + vt[..., None] * kt[..., None, :]
        return s, jnp.einsum('dbhij,dbhj->dbhi', s, rt)
    xs = tuple(jnp.moveaxis(t, 2, 0) for t in (r, w, k, v, kk, a))
    s, y = lax.scan(step, s0, xs)
    return jnp.moveaxis(y, 0, 2), s


def rwkv_branch(rw, shifted, s0_f, s0_b, p):
    f32 = jnp.float32
    b, l, _ = rw.shape
    xx = (rw + p['mu_shift'] * (shifted - rw)).astype(f32)
    widths = [R_WIDTH, R_DECAY_RANK, R_DECAY_RANK, R_WIDTH, R_WIDTH, R_ICLR_RANK, R_ICLR_RANK, R_GATE_RANK]
    r, wlf, wlb, k, v, alf, alb, glo = jnp.split(xx, np.cumsum(widths)[:-1].tolist(), axis=-1)
    w_logit = p['w0'][:, None, None, :] + jnp.einsum('dblr,drc->dblc', jnp.tanh(jnp.stack([wlf, wlb])), p['w2'])
    decay = jnp.exp(-jnp.exp(-jax.nn.softplus(-w_logit.astype(f32)) - 0.5))
    a = jax.nn.sigmoid(p['a0'][:, None, None, :] + jnp.einsum('dblr,drc->dblc', jnp.stack([alf, alb]), p['a2'])).astype(f32)
    g = jax.nn.sigmoid(glo) @ p['g2']
    kk = to_heads(k * p['k_k'])
    kk = kk * lax.rsqrt(jnp.sum(kk * kk, axis=-1, keepdims=True) + 1e-12)
    k_dir = k[None] * (1 + (a - 1) * p['k_a'])
    rh, vh = to_heads(r), to_heads(v)
    both = lambda t: jnp.stack([t, t[:, ::-1]])
    per_dir = lambda t: jnp.stack([t[0], t[1][:, ::-1]])
    y, s = wkv7_scan(both(rh), to_heads(per_dir(decay)), to_heads(per_dir(k_dir)), both(vh), both(kk),
                     to_heads(per_dir(a)), jnp.stack([s0_f, s0_b]).astype(f32))
    y = y[0] + y[1][:, ::-1]
    mean = jnp.mean(y, axis=-1, keepdims=True)
    var = jnp.mean(jnp.square(y - mean), axis=-1, keepdims=True)
    yn = ((y - mean) * lax.rsqrt(var + 64e-5)).reshape(b, l, R_WIDTH) * p['lnx_w'] + p['lnx_b']
    k_mean = to_heads(0.5 * (k_dir[0] + k_dir[1]))
    bonus = jnp.sum(rh * k_mean * p['r_k'], axis=-1, keepdims=True) * vh
    out = (yn + bonus.reshape(b, l, R_WIDTH)) * g
    return out.astype(rw.dtype), s[0], s[1]


def trunk_layer(x, mod, on_grid, ssm_f, ssm_b, wkv_f, wkv_b, p):
    sh1, sc1, gt1, sh2, sc2, gt2 = jnp.split(mod, 6, axis=-1)
    h = rmsnorm(x, p['norm1_w']) * (1 + sc1) + sh1
    proj = h @ p['w_in']
    o1 = M_INNER
    o2 = o1 + M_XBC
    o3 = o2 + 2 * M_HEADS
    o4 = o3 + R_COLS
    z, xbc, dt_raw, rw, gates = jnp.split(proj, [o1, o2, o3, o4], axis=-1)
    y_m, ssm_f, ssm_b = mamba_branch(z, xbc, dt_raw, ssm_f, ssm_b, p)
    shifted = qshift_grid(rw) if on_grid else qshift_seq(rw)
    y_r, wkv_f, wkv_b = rwkv_branch(rw, shifted, wkv_f, wkv_b, p)
    g_m, g_r = jnp.split(jax.nn.sigmoid(gates), 2, axis=-1)
    mix = (g_m * (y_m @ p['w_m_out']) + g_r * (y_r @ p['w_r_out'])) @ p['w_o']
    x = x + gt1 * mix
    h = rmsnorm(x, p['norm2_w']) * (1 + sc2) + sh2
    gg, uu = jnp.split(h @ p['w_gu'], 2, axis=-1)
    x = x + gt2 * ((jax.nn.silu(gg) * uu) @ p['w_down'])
    return x, ssm_f, ssm_b, wkv_f, wkv_b


def setup_inputs(seed: int = 0) -> dict:
    key = jax.random.key(seed)
    ks = iter(jax.random.split(key, 48))
    D = D_MODEL

    def nrm(shape, scale):
        return scale * jax.random.normal(next(ks), shape, jnp.float32)

    def unif(shape, lo, hi):
        return jax.random.uniform(next(ks), shape, jnp.float32, lo, hi)

    dt0 = jnp.exp(unif((DEPTH, 2, M_HEADS), math.log(1e-3), math.log(1e-1)))
    dt_bias = dt0 + jnp.log(-jnp.expm1(-dt0))
    a_log = jnp.log(unif((DEPTH, 2, M_HEADS), 1.0, 16.0))
    return {
        'x_prompt': nrm((BATCH, SEQ, D), 1.0),
        'x_sample': nrm((DEC_BATCH, DEC_SEQ, D), 1.0),
        'state_ssm_fwd': nrm((DEC_BATCH, DEPTH, M_HEADS, M_HEADDIM, M_STATE), 0.1),
        'state_ssm_bwd': nrm((DEC_BATCH, DEPTH, M_HEADS, M_HEADDIM, M_STATE), 0.1),
        'state_wkv_fwd': nrm((DEC_BATCH, DEPTH, R_HEADS, R_HEADSIZE, R_HEADSIZE), 0.5),
        'state_wkv_bwd': nrm((DEC_BATCH, DEPTH, R_HEADS, R_HEADSIZE, R_HEADSIZE), 0.5),
        'c': nrm((DEC_BATCH, D), 1.0),
        'c_ctx': nrm((D,), 1.0),
        'norm1_w': 1.0 + nrm((DEPTH, D), 0.02),
        'norm2_w': 1.0 + nrm((DEPTH, D), 0.02),
        'w_ada': nrm((DEPTH, D, 6 * D), D ** -0.5),
        'b_ada': nrm((DEPTH, 6 * D), 0.02),
        'w_in': nrm((DEPTH, D, IN_COLS), D ** -0.5),
        'conv_w': nrm((DEPTH, M_CONV, M_XBC), M_CONV ** -0.5),
        'conv_b': nrm((DEPTH, M_XBC), 0.02),
        'dt_bias': dt_bias,
        'a_log': a_log,
        'd_skip': 1.0 + nrm((DEPTH, M_HEADS), 0.1),
        'm_norm_w': 1.0 + nrm((DEPTH, M_INNER), 0.02),
        'mu_shift': unif((DEPTH, R_COLS), 0.0, 1.0),
        'w0': -0.5 + nrm((DEPTH, 2, R_WIDTH), 0.5),
        'w2': nrm((DEPTH, 2, R_DECAY_RANK, R_WIDTH), R_DECAY_RANK ** -0.5),
        'a0': nrm((DEPTH, 2, R_WIDTH), 0.1),
        'a2': nrm((DEPTH, 2, R_ICLR_RANK, R_WIDTH), R_ICLR_RANK ** -0.5),
        'g2': nrm((DEPTH, R_GATE_RANK, R_WIDTH), R_GATE_RANK ** -0.5),
        'k_k': 0.85 + nrm((DEPTH, R_WIDTH), 0.05),
        'k_a': 1.0 + nrm((DEPTH, R_WIDTH), 0.05),
        'r_k': nrm((DEPTH, R_HEADS, R_HEADSIZE), 0.1),
        'lnx_w': 1.0 + nrm((DEPTH, R_WIDTH), 0.02),
        'lnx_b': nrm((DEPTH, R_WIDTH), 0.02),
        'w_m_out': nrm((DEPTH, M_INNER, D), M_INNER ** -0.5),
        'w_r_out': nrm((DEPTH, R_WIDTH, D), R_WIDTH ** -0.5),
        'w_o': nrm((DEPTH, D, D), D ** -0.5),
        'w_gu': nrm((DEPTH, D, 2 * D_FF), D ** -0.5),
        'w_down': nrm((DEPTH, D_FF, D), D_FF ** -0.5),
        'final_norm_w': 1.0 + nrm((D,), 0.02),
    }


def reference(x_prompt, x_sample, state_ssm_fwd, state_ssm_bwd, state_wkv_fwd, state_wkv_bwd,
              c, c_ctx, norm1_w, norm2_w, w_ada, b_ada, w_in, conv_w, conv_b, dt_bias, a_log,
              d_skip, m_norm_w, mu_shift, w0, w2, a0, a2, g2, k_k, k_a, r_k, lnx_w, lnx_b,
              w_m_out, w_r_out, w_o, w_gu, w_down, final_norm_w):
    f32 = jnp.float32
    bp = x_prompt.shape[0]
    ctx, lat = x_prompt, x_sample
    new_sf, new_sb, new_wf, new_wb = [], [], [], []
    for l in range(DEPTH):
        p = dict(norm1_w=norm1_w[l], norm2_w=norm2_w[l], w_in=w_in[l], conv_w=conv_w[l], conv_b=conv_b[l],
                 dt_bias=dt_bias[l], a_log=a_log[l], d_skip=d_skip[l], m_norm_w=m_norm_w[l],
                 mu_shift=mu_shift[l], w0=w0[l], w2=w2[l], a0=a0[l], a2=a2[l], g2=g2[l], k_k=k_k[l],
                 k_a=k_a[l], r_k=r_k[l], lnx_w=lnx_w[l], lnx_b=lnx_b[l], w_m_out=w_m_out[l],
                 w_r_out=w_r_out[l], w_o=w_o[l], w_gu=w_gu[l], w_down=w_down[l])
        mod_ctx = (jax.nn.silu(c_ctx) @ w_ada[l] + b_ada[l])[None, None, :]
        mod_lat = (jax.nn.silu(c) @ w_ada[l] + b_ada[l])[:, None, :]
        z_ssm = jnp.zeros((bp, M_HEADS, M_HEADDIM, M_STATE), f32)
        z_wkv = jnp.zeros((bp, R_HEADS, R_HEADSIZE, R_HEADSIZE), f32)
        ctx, sf, sb, wf, wb = trunk_layer(ctx, mod_ctx, False, z_ssm, z_ssm, z_wkv, z_wkv, p)
        new_sf.append(sf)
        new_sb.append(sb)
        new_wf.append(wf)
        new_wb.append(wb)
        lat, _, _, _, _ = trunk_layer(lat, mod_lat, True, state_ssm_fwd[:, l], state_ssm_bwd[:, l],
                                      state_wkv_fwd[:, l], state_wkv_bwd[:, l], p)
    y_prompt = rmsnorm(ctx, final_norm_w)
    y_sample = rmsnorm(lat, final_norm_w)
    new_ssm_fwd = jnp.stack(new_sf, axis=1).astype(x_prompt.dtype)
    new_ssm_bwd = jnp.stack(new_sb, axis=1).astype(x_prompt.dtype)
    new_wkv_fwd = jnp.stack(new_wf, axis=1).astype(x_prompt.dtype)
    new_wkv_bwd = jnp.stack(new_wb, axis=1).astype(x_prompt.dtype)
    return (y_prompt, y_sample, new_ssm_fwd, new_ssm_bwd, new_wkv_fwd, new_wkv_bwd)
```

```cpp
#include <hip/hip_runtime.h>
#include <hip/hip_cooperative_groups.h>
#include <hip/hip_fp16.h>
#include <cstdio>
#include <cstdint>
namespace cg = cooperative_groups;

#ifndef MULTI_LAUNCH
#define MULTI_LAUNCH 0
#endif

#define DI __device__ __forceinline__
typedef __attribute__((ext_vector_type(8))) short bf16x8;
typedef __attribute__((ext_vector_type(4))) float f32x4;
typedef unsigned short u16;

#ifndef STEP_MASK
#define STEP_MASK 0xffffff
#endif
constexpr int SM = STEP_MASK;
constexpr int TG = 4096;
constexpr int NTOK = 12288;
constexpr int NPAD = 10752;
constexpr int NTHR = 512;
constexpr int SMEM_BYTES = 133120;

constexpr size_t OFF_WIN = 0;
constexpr size_t OFF_WGU = OFF_WIN + (size_t)NPAD * 1024 * 2;
constexpr size_t OFF_WDOWN = OFF_WGU + (size_t)5632 * 1024 * 2;
constexpr size_t OFF_WMOUT = OFF_WDOWN + (size_t)1024 * 2816 * 2;
constexpr size_t OFF_WROUT = OFF_WMOUT + (size_t)1024 * 2048 * 2;
constexpr size_t OFF_WO = OFF_WROUT + (size_t)1024 * 1024 * 2;
constexpr size_t OFF_W2T = OFF_WO + (size_t)1024 * 1024 * 2;
constexpr size_t OFF_A2T = OFF_W2T + 262144;
constexpr size_t OFF_G2T = OFF_A2T + 262144;
constexpr size_t OFF_MOD = OFF_G2T + 262144;
constexpr size_t OFF_GRP = OFF_MOD + 73728;
constexpr size_t OFF_Z = OFF_GRP;
constexpr size_t OFF_GATE = OFF_Z + (size_t)TG * 2048 * 2;
constexpr size_t OFF_XBC = OFF_GATE + (size_t)TG * 2048 * 2;
constexpr size_t OFF_WK = OFF_XBC + (size_t)TG * 3072 * 2;
constexpr size_t OFF_GR = OFF_WK + (size_t)TG * 16 * 1024;
constexpr size_t OFF_DT = OFF_GR + (size_t)TG * 1024 * 2;
constexpr size_t OFF_TL = OFF_DT + (size_t)TG * 64 * 4;
constexpr size_t OFF_SG = OFF_TL + (size_t)TG * 256 * 2;
constexpr size_t OFF_R = OFF_SG + (size_t)TG * 128 * 2;
constexpr size_t OFF_H1 = OFF_R;
constexpr size_t OFF_XBCRAW = OFF_H1 + (size_t)TG * 1024 * 2;
constexpr size_t OFF_RW = OFF_XBCRAW + (size_t)TG * 3072 * 2;
constexpr size_t OFF_SYF = OFF_R;
constexpr size_t OFF_SYB = OFF_SYF + (size_t)TG * 2048 * 2;
constexpr size_t OFF_WYF = OFF_SYB + (size_t)TG * 2048 * 2;
constexpr size_t OFF_WYB = OFF_WYF + (size_t)TG * 1024 * 2;
constexpr size_t OFF_YM = OFF_WYB + (size_t)TG * 1024 * 2;
constexpr size_t OFF_YR = OFF_YM + (size_t)TG * 2048 * 2;
constexpr size_t OFF_END = OFF_YR + (size_t)TG * 1024 * 2;
constexpr size_t OFF_U = OFF_XBC;
constexpr size_t OFF_H2 = OFF_GRP;
constexpr size_t OFF_ACT = OFF_H2 + (size_t)NTOK * 1024 * 2;

constexpr size_t OUT_SSMF = 12582912;
constexpr size_t OUT_SSMB = OUT_SSMF + 8388608;
constexpr size_t OUT_WKVF = OUT_SSMB + 8388608;
constexpr size_t OUT_WKVB = OUT_WKVF + 2097152;

struct Params {
  const float *x_prompt, *x_sample, *ssm_f, *ssm_b, *wkv_f, *wkv_b, *c, *c_ctx, *norm1_w, *norm2_w,
      *w_ada, *b_ada, *w_in, *conv_w, *conv_b, *dt_bias, *a_log, *d_skip, *m_norm_w, *mu_shift, *w0,
      *w2, *a0, *a2, *g2, *k_k, *k_a, *r_k, *lnx_w, *lnx_b, *w_m_out, *w_r_out, *w_o, *w_gu, *w_down,
      *final_norm_w;
  float* out;
  char* ws;
  int step_lo, step_hi;
};

DI int get_tid() {
  int t = threadIdx.x;
  asm volatile("" : "+v"(t));
  return t;
}
DI u16 f2bf(float f) {
  unsigned u = __float_as_uint(f);
  u += 0x7fffu + ((u >> 16) & 1u);
  return (u16)(u >> 16);
}
DI float bf2f(u16 h) { return __uint_as_float(((unsigned)h) << 16); }
DI float siluf(float x) { return x / (1.f + __expf(-x)); }
DI float sigm(float x) { return 1.f / (1.f + __expf(-x)); }
DI float wave_sum(float v) {
#pragma unroll
  for (int o = 32; o > 0; o >>= 1) v += __shfl_xor(v, o);
  return v;
}
DI unsigned pack2(float a, float b) { return (unsigned)f2bf(a) | ((unsigned)f2bf(b) << 16); }
DI int mrow_of(int tok) { return tok < 8192 ? 0 : 1 + ((tok - 8192) >> 11); }

DI void gemm_load(const int tid, const u16* A, int lda, const u16* B, int ldb, int k0, uint4 (&ra)[4], uint4 (&rb)[2]) {
#pragma unroll
  for (int i = 0; i < 4; ++i) {
    int idx = tid + i * 512;
    int row = idx >> 3, ch = idx & 7;
    ra[i] = *(const uint4*)(A + (size_t)row * lda + k0 + ch * 8);
  }
#pragma unroll
  for (int i = 0; i < 2; ++i) {
    int idx = tid + i * 512;
    int row = idx >> 3, ch = idx & 7;
    rb[i] = *(const uint4*)(B + (size_t)row * ldb + k0 + ch * 8);
  }
}
DI void gemm_store_lds(const int tid, char* sA, char* sB, const uint4 (&ra)[4], const uint4 (&rb)[2]) {
#pragma unroll
  for (int i = 0; i < 4; ++i) {
    int idx = tid + i * 512;
    int row = idx >> 3, ch = idx & 7;
    *(uint4*)(sA + row * 128 + ((ch ^ ((row >> 1) & 7)) << 4)) = ra[i];
  }
#pragma unroll
  for (int i = 0; i < 2; ++i) {
    int idx = tid + i * 512;
    int row = idx >> 3, ch = idx & 7;
    *(uint4*)(sB + row * 128 + ((ch ^ ((row >> 1) & 7)) << 4)) = rb[i];
  }
}
DI void gemm_compute(const char* sA, const char* sB, f32x4 (&acc)[4][4], int wm, int wn, int lane) {
#pragma unroll
  for (int kk = 0; kk < 2; ++kk) {
    bf16x8 a[4], b[4];
    const int ch = kk * 4 + (lane >> 4);
#pragma unroll
    for (int mf = 0; mf < 4; ++mf) {
      int row = wm * 64 + mf * 16 + (lane & 15);
      a[mf] = *(const bf16x8*)(sA + row * 128 + ((ch ^ ((row >> 1) & 7)) << 4));
    }
#pragma unroll
    for (int nf = 0; nf < 4; ++nf) {
      int row = wn * 64 + nf * 16 + (lane & 15);
      b[nf] = *(const bf16x8*)(sB + row * 128 + ((ch ^ ((row >> 1) & 7)) << 4));
    }
#pragma unroll
    for (int mf = 0; mf < 4; ++mf)
#pragma unroll
      for (int nf = 0; nf < 4; ++nf)
        acc[mf][nf] = __builtin_amdgcn_mfma_f32_16x16x32_bf16(a[mf], b[nf], acc[mf][nf], 0, 0, 0);
  }
}
DI void gemm_acc(const u16* A, int lda, const u16* B, int ldb, int K, f32x4 (&acc)[4][4], char* smem) {
  const int tid = get_tid(), lane = tid & 63, wave = tid >> 6;
  const int wm = wave >> 1, wn = wave & 1;
  char* sA0 = smem;
  char* sB0 = smem + 32768;
  char* sA1 = smem + 49152;
  char* sB1 = smem + 81920;
  uint4 ra[4], rb[2];
  const int nk = K >> 6;
  gemm_load(tid, A, lda, B, ldb, 0, ra, rb);
  gemm_store_lds(tid, sA0, sB0, ra, rb);
  __syncthreads();
  for (int kt = 0; kt < nk; ++kt) {
    const bool more = (kt + 1 < nk);
    if (more) gemm_load(tid, A, lda, B, ldb, (kt + 1) * 64, ra, rb);
    if (kt & 1) gemm_compute(sA1, sB1, acc, wm, wn, lane);
    else gemm_compute(sA0, sB0, acc, wm, wn, lane);
    if (more) {
      if (kt & 1) gemm_store_lds(tid, sA0, sB0, ra, rb);
      else gemm_store_lds(tid, sA1, sB1, ra, rb);
    }
    __syncthreads();
  }
}
DI void zero_acc(f32x4 (&acc)[4][4]) {
#pragma unroll
  for (int i = 0; i < 4; ++i)
#pragma unroll
    for (int j = 0; j < 4; ++j) acc[i][j] = f32x4{0.f, 0.f, 0.f, 0.f};
}

template <int MODE>
__device__ __forceinline__ void convT(const float* __restrict__ src, int K, int N, u16* __restrict__ dst, char* smem) {
  float* tile = (float*)smem;
  const int tid = get_tid();
  const int KT = K >> 6, NT = N >> 6;
  for (int t = blockIdx.x; t < KT * NT; t += gridDim.x) {
    int kt = t % KT, nt = t / KT;
#pragma unroll
    for (int i = 0; i < 8; ++i) {
      int idx = tid + i * 512;
      int r = idx >> 6, cc = idx & 63;
      tile[r * 65 + cc] = src[(size_t)(kt * 64 + r) * N + nt * 64 + cc];
    }
    __syncthreads();
    int n = tid >> 3, kc = tid & 7;
    unsigned w[4];
#pragma unroll
    for (int j = 0; j < 4; ++j)
      w[j] = pack2(tile[(kc * 8 + 2 * j) * 65 + n], tile[(kc * 8 + 2 * j + 1) * 65 + n]);
    int ng = nt * 64 + n;
    int row = ng;
    if (MODE == 1) {
      int isu = ng >= 2816;
      int nn = ng - isu * 2816;
      int j = nn >> 6, c2 = nn & 63;
      row = j * 128 + (c2 >> 5) * 64 + isu * 32 + (c2 & 31);
    }
    *(uint4*)(dst + (size_t)row * K + kt * 64 + kc * 8) = uint4{w[0], w[1], w[2], w[3]};
    __syncthreads();
  }
}

__device__ __forceinline__ void step_prep(const Params& p, char* smem) {
  const int tid = get_tid();
  char* ws = p.ws;
  {
    float* red = (float*)smem;
    float* mod = (float*)(ws + OFF_MOD);
    for (int item = blockIdx.x; item < 192; item += gridDim.x) {
      int c4 = tid & 7, kl = tid >> 3;
      float acc[12];
#pragma unroll
      for (int i = 0; i < 12; ++i) acc[i] = 0.f;
      for (int k = kl; k < 1024; k += 64) {
        float4 w = *(const float4*)(p.w_ada + (size_t)k * 6144 + item * 32 + c4 * 4);
        float s0 = siluf(p.c_ctx[k]), s1 = siluf(p.c[k]), s2 = siluf(p.c[1024 + k]);
        acc[0] += s0 * w.x; acc[1] += s0 * w.y; acc[2] += s0 * w.z; acc[3] += s0 * w.w;
        acc[4] += s1 * w.x; acc[5] += s1 * w.y; acc[6] += s1 * w.z; acc[7] += s1 * w.w;
        acc[8] += s2 * w.x; acc[9] += s2 * w.y; acc[10] += s2 * w.z; acc[11] += s2 * w.w;
      }
#pragma unroll
      for (int i = 0; i < 12; ++i) red[(kl * 8 + c4) * 12 + i] = acc[i];
      __syncthreads();
      if (tid < 96) {
        int cond = tid >> 5, col = tid & 31;
        int cc4 = col >> 2, e = col & 3;
        float s = 0.f;
        for (int k = 0; k < 64; ++k) s += red[(k * 8 + cc4) * 12 + cond * 4 + e];
        int n = item * 32 + col;
        mod[cond * 6144 + n] = s + p.b_ada[n];
      }
      __syncthreads();
    }
  }
  convT<0>(p.w_in, 1024, 10688, (u16*)(ws + OFF_WIN), smem);
  convT<1>(p.w_gu, 1024, 5632, (u16*)(ws + OFF_WGU), smem);
  convT<0>(p.w_down, 2816, 1024, (u16*)(ws + OFF_WDOWN), smem);
  convT<0>(p.w_m_out, 2048, 1024, (u16*)(ws + OFF_WMOUT), smem);
  convT<0>(p.w_r_out, 1024, 1024, (u16*)(ws + OFF_WROUT), smem);
  convT<0>(p.w_o, 1024, 1024, (u16*)(ws + OFF_WO), smem);
  convT<0>(p.w2, 64, 1024, (u16*)(ws + OFF_W2T), smem);
  convT<0>(p.w2 + 65536, 64, 1024, (u16*)(ws + OFF_W2T) + 65536, smem);
  convT<0>(p.a2, 64, 1024, (u16*)(ws + OFF_A2T), smem);
  convT<0>(p.a2 + 65536, 64, 1024, (u16*)(ws + OFF_A2T) + 65536, smem);
  convT<0>(p.g2, 128, 1024, (u16*)(ws + OFF_G2T), smem);
  {
    uint4* z = (uint4*)(ws + OFF_WIN + (size_t)10688 * 1024 * 2);
    for (int i = blockIdx.x * NTHR + tid; i < 8192; i += gridDim.x * NTHR) z[i] = uint4{0, 0, 0, 0};
  }
}

template <int WHICH>
__device__ __forceinline__ void step_norm(const Params& p, int g) {
  const int tid = get_tid(), lane = tid & 63, wave = tid >> 6;
  const float* mod = (const float*)(p.ws + OFF_MOD);
  const int nrows = WHICH == 0 ? TG : NTOK;
  u16* dst = (u16*)(p.ws + (WHICH == 0 ? OFF_H1 : OFF_H2));
  const float* nw = WHICH == 0 ? p.norm1_w : p.norm2_w;
  for (int r = blockIdx.x * 8 + wave; r < nrows; r += gridDim.x * 8) {
    int tok = WHICH == 0 ? g * TG + r : r;
    const float* xr;
    if (WHICH == 0) xr = tok < 8192 ? p.x_prompt + (size_t)tok * 1024 : p.x_sample + (size_t)(tok - 8192) * 1024;
    else xr = p.out + (size_t)tok * 1024;
    const float* mr = mod + mrow_of(tok) * 6144 + (WHICH == 0 ? 0 : 3072);
    float4 v[4];
    float ss = 0.f;
#pragma unroll
    for (int i = 0; i < 4; ++i) {
      v[i] = ((const float4*)xr)[i * 64 + lane];
      ss += v[i].x * v[i].x + v[i].y * v[i].y + v[i].z * v[i].z + v[i].w * v[i].w;
    }
    ss = wave_sum(ss);
    float rinv = rsqrtf(ss * (1.f / 1024.f) + 1e-6f);
#pragma unroll
    for (int i = 0; i < 4; ++i) {
      int col = (i * 64 + lane) * 4;
      float4 w4 = *(const float4*)(nw + col);
      float4 sh = *(const float4*)(mr + col);
      float4 sc = *(const float4*)(mr + 1024 + col);
      float h0 = v[i].x * rinv * w4.x * (1.f + sc.x) + sh.x;
      float h1 = v[i].y * rinv * w4.y * (1.f + sc.y) + sh.y;
      float h2 = v[i].z * rinv * w4.z * (1.f + sc.z) + sh.z;
      float h3 = v[i].w * rinv * w4.w * (1.f + sc.w) + sh.w;
      *(uint2*)(dst + (size_t)r * 1024 + col) = uint2{pack2(h0, h1), pack2(h2, h3)};
    }
  }
}

__device__ __forceinline__ void step_gemm1(const Params& p, char* smem) {
  char* ws = p.ws;
  const int tid = get_tid(), lane = tid & 63, wave = tid >> 6;
  const int wm = wave >> 1, wn = wave & 1;
  const u16* A = (const u16*)(ws + OFF_H1);
  const u16* Bt = (const u16*)(ws + OFF_WIN);
  u16* zb = (u16*)(ws + OFF_Z);
  u16* xr = (u16*)(ws + OFF_XBCRAW);
  float* dtb = (float*)(ws + OFF_DT);
  u16* rwb = (u16*)(ws + OFF_RW);
  u16* gb = (u16*)(ws + OFF_GATE);
  for (int t = blockIdx.x; t < 16 * 84; t += gridDim.x) {
    int mt = t & 15, nt = t >> 4;
    f32x4 acc[4][4];
    zero_acc(acc);
    gemm_acc(A + (size_t)mt * 256 * 1024, 1024, Bt + (size_t)nt * 128 * 1024, 1024, 1024, acc, smem);
    int nw0 = nt * 128 + wn * 64;
    if (nw0 >= 10688) continue;
#pragma unroll
    for (int mf = 0; mf < 4; ++mf)
#pragma unroll
      for (int nf = 0; nf < 4; ++nf)
#pragma unroll
        for (int j = 0; j < 4; ++j) {
          if (nf == 0 && j == 0) asm volatile("" ::: "memory");
          int m = mt * 256 + wm * 64 + mf * 16 + (lane >> 4) * 4 + j;
          int n = nw0 + nf * 16 + (lane & 15);
          float v = acc[mf][nf][j];
          if (nw0 < 2048) zb[(size_t)m * 2048 + n] = f2bf(v);
          else if (nw0 < 5120) xr[(size_t)m * 3072 + (n - 2048)] = f2bf(v);
          else if (nw0 < 5184) dtb[(size_t)m * 64 + (n - 5120)] = v;
          else if (nw0 < 8640) rwb[(size_t)m * 3456 + (n - 5184)] = f2bf(v);
          else gb[(size_t)m * 2048 + (n - 8640)] = f2bf(v);
        }
  }
}

__device__ __forceinline__ void step_cr1(const Params& p, int g) {
  char* ws = p.ws;
  const int tid = get_tid(), lane = tid & 63, wave = tid >> 6;
  const int Ls = g < 2 ? 256 : 2048;
  {
    const u16* xr = (const u16*)(ws + OFF_XBCRAW);
    u16* xo = (u16*)(ws + OFF_XBC);
    for (int idx = blockIdx.x * NTHR + tid; idx < TG * 384; idx += gridDim.x * NTHR) {
      int r = idx / 384, cc = idx - r * 384;
      int pos = r & (Ls - 1);
      float s[8];
      {
        float4 b0 = *(const float4*)(p.conv_b + cc * 8), b1 = *(const float4*)(p.conv_b + cc * 8 + 4);
        s[0] = b0.x; s[1] = b0.y; s[2] = b0.z; s[3] = b0.w; s[4] = b1.x; s[5] = b1.y; s[6] = b1.z; s[7] = b1.w;
      }
#pragma unroll
      for (int i = 0; i < 5; ++i) {
        int pp = pos + i - 2;
        if (pp >= 0 && pp < Ls) {
          uint4 u = *(const uint4*)(xr + (size_t)(r + i - 2) * 3072 + cc * 8);
          float4 w0 = *(const float4*)(p.conv_w + i * 3072 + cc * 8), w1 = *(const float4*)(p.conv_w + i * 3072 + cc * 8 + 4);
          s[0] += bf2f(u.x & 0xffff) * w0.x; s[1] += bf2f(u.x >> 16) * w0.y;
          s[2] += bf2f(u.y & 0xffff) * w0.z; s[3] += bf2f(u.y >> 16) * w0.w;
          s[4] += bf2f(u.z & 0xffff) * w1.x; s[5] += bf2f(u.z >> 16) * w1.y;
          s[6] += bf2f(u.w & 0xffff) * w1.z; s[7] += bf2f(u.w >> 16) * w1.w;
        }
      }
#pragma unroll
      for (int e = 0; e < 8; ++e) s[e] = siluf(s[e]);
      *(uint4*)(xo + (size_t)r * 3072 + cc * 8) = uint4{pack2(s[0], s[1]), pack2(s[2], s[3]), pack2(s[4], s[5]), pack2(s[6], s[7])};
    }
  }
  {
    const u16* rw = (const u16*)(ws + OFF_RW);
    __half* wk = (__half*)(ws + OFF_WK);
    u16* tl = (u16*)(ws + OFF_TL);
    u16* sg = (u16*)(ws + OFF_SG);
    const bool grid = (g == 2);
    for (int r = blockIdx.x * 8 + wave; r < TG; r += gridDim.x * 8) {
      int pos = r & (Ls - 1);
      for (int it = 0; it < 54; ++it) {
        int c = it * 64 + lane;
        float cur = bf2f(rw[(size_t)r * 3456 + c]);
        int q = c / 864;
        int dr;
        bool ok;
        if (!grid) {
          if (q & 1) { dr = 1; ok = pos < Ls - 1; } else { dr = -1; ok = pos > 0; }
        } else {
          if (q == 0) { dr = -1; ok = (pos & 63) != 0; }
          else if (q == 1) { dr = 1; ok = (pos & 63) != 63; }
          else if (q == 2) { dr = -64; ok = pos >= 64; }
          else { dr = 64; ok = pos < Ls - 64; }
        }
        float sh = ok ? bf2f(rw[(size_t)(r + dr) * 3456 + c]) : 0.f;
        float xx = cur + p.mu_shift[c] * (sh - cur);
        if (it < 16) {
          wk[((size_t)(r * 16 + it) * 8 + 0) * 64 + lane] = __float2half(xx);
        } else if (it == 16) {
          tl[(size_t)r * 256 + lane] = f2bf(tanhf(xx));
        } else if (it == 17) {
          tl[(size_t)r * 256 + 64 + lane] = f2bf(tanhf(xx));
        } else if (it < 34) {
          int h = it - 18;
          float kk = xx * p.k_k[h * 64 + lane];
          float ss = wave_sum(kk * kk);
          float nkk = -kk * rsqrtf(ss + 1e-12f);
          wk[((size_t)(r * 16 + h) * 8 + 2) * 64 + lane] = __float2half(xx);
          wk[((size_t)(r * 16 + h) * 8 + 3) * 64 + lane] = __float2half(nkk);
        } else if (it < 50) {
          int h = it - 34;
          wk[((size_t)(r * 16 + h) * 8 + 1) * 64 + lane] = __float2half(xx);
        } else if (it == 50) {
          tl[(size_t)r * 256 + 128 + lane] = f2bf(xx);
        } else if (it == 51) {
          tl[(size_t)r * 256 + 192 + lane] = f2bf(xx);
        } else {
          sg[(size_t)r * 128 + (it - 52) * 64 + lane] = f2bf(sigm(xx));
        }
      }
    }
  }
}

__device__ __forceinline__ void step_r2(const Params& p, char* smem) {
  char* ws = p.ws;
  const int tid = get_tid(), lane = tid & 63, wave = tid >> 6;
  const int wm = wave >> 1, wn = wave & 1;
  const u16* tl = (const u16*)(ws + OFF_TL);
  const u16* sg = (const u16*)(ws + OFF_SG);
  __half* wk = (__half*)(ws + OFF_WK);
  u16* gr = (u16*)(ws + OFF_GR);
  for (int t = blockIdx.x; t < 5 * 128; t += gridDim.x) {
    int sub = t >> 7, rem = t & 127;
    int mt = rem & 15, nt = rem >> 4;
    f32x4 acc[4][4];
    zero_acc(acc);
    if (sub < 2) {
      gemm_acc(tl + (size_t)mt * 256 * 256 + sub * 64, 256, (const u16*)(ws + OFF_W2T) + sub * 65536 + (size_t)nt * 128 * 64, 64, 64, acc, smem);
    } else if (sub < 4) {
      gemm_acc(tl + (size_t)mt * 256 * 256 + 128 + (sub - 2) * 64, 256, (const u16*)(ws + OFF_A2T) + (sub - 2) * 65536 + (size_t)nt * 128 * 64, 64, 64, acc, smem);
    } else {
      gemm_acc(sg + (size_t)mt * 256 * 128, 128, (const u16*)(ws + OFF_G2T) + (size_t)nt * 128 * 128, 128, 128, acc, smem);
    }
#pragma unroll
    for (int mf = 0; mf < 4; ++mf)
#pragma unroll
      for (int nf = 0; nf < 4; ++nf)
#pragma unroll
        for (int j = 0; j < 4; ++j) {
          if (nf == 0 && j == 0) asm volatile("" ::: "memory");
          int m = mt * 256 + wm * 64 + mf * 16 + (lane >> 4) * 4 + j;
          int n = nt * 128 + wn * 64 + nf * 16 + (lane & 15);
          float v = acc[mf][nf][j];
          if (sub < 2) {
            float wl = v + p.w0[sub * 1024 + n];
            float dec = __expf(-0.6065306597f * sigm(wl));
            wk[((size_t)(m * 16 + (n >> 6)) * 8 + 4 + 2 * sub) * 64 + (n & 63)] = __float2half(dec);
          } else if (sub < 4) {
            int d = sub - 2;
            float a = sigm(v + p.a0[d * 1024 + n]);
            wk[((size_t)(m * 16 + (n >> 6)) * 8 + 5 + 2 * d) * 64 + (n & 63)] = __float2half(a);
          } else {
            gr[(size_t)m * 1024 + n] = f2bf(v);
          }
        }
  }
}

DI int sw256(int row, int e) { return row * 256 + ((((e >> 3) ^ (row & 15))) << 4) + (e & 7) * 2; }
DI const bf16x8 ldfrag256(const char* base, int row, int ch) {
  return *(const bf16x8*)(base + row * 256 + ((ch ^ (row & 15)) << 4));
}

__device__ __forceinline__ void ssd_chain(const Params& p, char* smem, int g, int chain) {
  char* ws = p.ws;
  const int tid = get_tid(), lane = tid & 63, wave = tid >> 6;
  const int Ls = g < 2 ? 256 : 2048;
  const int nch = Ls >> 7;
  const int d = chain & 1, h = (chain >> 1) & 31, b = chain >> 6;
  const int grp = h >> 3;
  const u16* xbc = (const u16*)(ws + OFF_XBC);
  const float* dtb = (const float*)(ws + OFF_DT);
  u16* yout = (u16*)(ws + (d ? OFF_SYB : OFF_SYF));
  char* Cs = smem;
  char* Bs = smem + 32768;
  char* BdT = smem + 65536;
  char* XT = smem + 98304;
  char* Ss = smem + 114688;
  float* csum = (float*)(smem + 131072);
  float* dts = (float*)(smem + 131584);
  const float a_h = -__expf(p.a_log[d * 32 + h]);
  const float dtbias = p.dt_bias[d * 32 + h];
  const int wp = wave >> 2, wn4 = wave & 3;
  f32x4 sacc[2][2];
#pragma unroll
  for (int pf = 0; pf < 2; ++pf)
#pragma unroll
    for (int nf = 0; nf < 2; ++nf) {
      if (g == 2) {
        const float* h0 = (d ? p.ssm_b : p.ssm_f) + (size_t)(b * 32 + h) * 8192;
#pragma unroll
        for (int j = 0; j < 4; ++j) {
          int pp = wp * 32 + pf * 16 + (lane >> 4) * 4 + j;
          int n = wn4 * 32 + nf * 16 + (lane & 15);
          sacc[pf][nf][j] = h0[pp * 128 + n];
        }
      } else {
        sacc[pf][nf] = f32x4{0.f, 0.f, 0.f, 0.f};
      }
    }
  const int tid_outer = tid;
  for (int ci = 0; ci < nch; ++ci) {
    int tidv = tid_outer;
    asm volatile("" : "+v"(tidv));
    const int tid = tidv, lane = tidv & 63, wave = tidv >> 6;
    const int wp = wave >> 2, wn4 = wave & 3;
    const int c = d ? nch - 1 - ci : ci;
    const int tok0 = b * Ls + c * 128;
#pragma unroll
    for (int i = 0; i < 4; ++i) {
      int idx = tid + i * 512;
      int row = idx >> 4, ch = idx & 15;
      const u16* src = xbc + (size_t)(tok0 + row) * 3072 + grp * 128 + ch * 8;
      uint4 cv = *(const uint4*)(src + 2560);
      uint4 bv = *(const uint4*)(src + 2048);
      *(uint4*)(Cs + row * 256 + ((ch ^ (row & 15)) << 4)) = cv;
      *(uint4*)(Bs + row * 256 + ((ch ^ (row & 15)) << 4)) = bv;
    }
#pragma unroll
    for (int i = 0; i < 2; ++i) {
      int idx = tid + i * 512;
      int l = idx >> 3, ch = idx & 7;
      uint4 xv = *(const uint4*)(xbc + (size_t)(tok0 + l) * 3072 + h * 64 + ch * 8);
      unsigned w[4] = {xv.x, xv.y, xv.z, xv.w};
#pragma unroll
      for (int e = 0; e < 8; ++e) {
        int pp = ch * 8 + e;
        u16 val = (u16)((w[e >> 1] >> ((e & 1) * 16)) & 0xffff);
        *(u16*)(XT + sw256(pp, l)) = val;
      }
    }
    if (wave == 0) {
      int e0 = 2 * lane, e1 = 2 * lane + 1;
      int l0 = d ? 127 - e0 : e0, l1 = d ? 127 - e1 : e1;
      float x0 = dtb[(size_t)(tok0 + l0) * 64 + d * 32 + h] + dtbias;
      float x1 = dtb[(size_t)(tok0 + l1) * 64 + d * 32 + h] + dtbias;
      float dt0 = x0 > 20.f ? x0 : log1pf(__expf(x0));
      float dt1 = x1 > 20.f ? x1 : log1pf(__expf(x1));
      float a0 = dt0 * a_h, a1 = dt1 * a_h;
      float s = a0 + a1;
#pragma unroll
      for (int o = 1; o < 64; o <<= 1) {
        float t = __shfl_up(s, o);
        if (lane >= o) s += t;
      }
      csum[l1] = s;
      csum[l0] = s - a1;
      dts[l0] = dt0;
      dts[l1] = dt1;
    }
#pragma unroll
    for (int pf = 0; pf < 2; ++pf)
#pragma unroll
      for (int nf = 0; nf < 2; ++nf)
#pragma unroll
        for (int j = 0; j < 4; ++j) {
          int pp = wp * 32 + pf * 16 + (lane >> 4) * 4 + j;
          int n = wn4 * 32 + nf * 16 + (lane & 15);
          *(u16*)(Ss + sw256(pp, n)) = f2bf(sacc[pf][nf][j]);
        }
    __syncthreads();
    const float cstot = csum[d ? 0 : 127];
#pragma unroll
    for (int i = 0; i < 4; ++i) {
      int idx = tid + i * 512;
      int l = idx >> 4, ch = idx & 15;
      uint4 bv = *(const uint4*)(Bs + l * 256 + ((ch ^ (l & 15)) << 4));
      float f = dts[l] * __expf(cstot - csum[l]);
      unsigned w[4] = {bv.x, bv.y, bv.z, bv.w};
#pragma unroll
      for (int e = 0; e < 8; ++e) {
        int n = ch * 8 + e;
        float val = bf2f((u16)((w[e >> 1] >> ((e & 1) * 16)) & 0xffff)) * f;
        *(u16*)(BdT + sw256(n, l)) = f2bf(val);
      }
    }
    const int wm = wave >> 1, wn2 = wave & 1;
    f32x4 gacc[2][4];
#pragma unroll
    for (int i = 0; i < 2; ++i)
#pragma unroll
      for (int j = 0; j < 4; ++j) gacc[i][j] = f32x4{0.f, 0.f, 0.f, 0.f};
#pragma unroll
    for (int ks = 0; ks < 4; ++ks) {
      int ch = ks * 4 + (lane >> 4);
      bf16x8 a[2], bb[4];
#pragma unroll
      for (int mf = 0; mf < 2; ++mf) a[mf] = ldfrag256(Cs, wm * 32 + mf * 16 + (lane & 15), ch);
#pragma unroll
      for (int nf = 0; nf < 4; ++nf) bb[nf] = ldfrag256(Bs, wn2 * 64 + nf * 16 + (lane & 15), ch);
#pragma unroll
      for (int mf = 0; mf < 2; ++mf)
#pragma unroll
        for (int nf = 0; nf < 4; ++nf)
          gacc[mf][nf] = __builtin_amdgcn_mfma_f32_16x16x32_bf16(a[mf], bb[nf], gacc[mf][nf], 0, 0, 0);
    }
    {
      float csl[2][4];
#pragma unroll
      for (int mf = 0; mf < 2; ++mf)
#pragma unroll
        for (int j = 0; j < 4; ++j) csl[mf][j] = csum[wm * 32 + mf * 16 + (lane >> 4) * 4 + j];
#pragma unroll
      for (int nf = 0; nf < 4; ++nf) {
        int s = wn2 * 64 + nf * 16 + (lane & 15);
        float css = csum[s], dss = dts[s];
#pragma unroll
        for (int mf = 0; mf < 2; ++mf)
#pragma unroll
          for (int j = 0; j < 4; ++j) {
            int l = wm * 32 + mf * 16 + (lane >> 4) * 4 + j;
            bool valid = d ? (s >= l) : (s <= l);
            float e = valid ? __expf(csl[mf][j] - css) * dss : 0.f;
            gacc[mf][nf][j] *= e;
          }
      }
    }
    __syncthreads();
#pragma unroll
    for (int mf = 0; mf < 2; ++mf)
#pragma unroll
      for (int nf = 0; nf < 4; ++nf)
#pragma unroll
        for (int j = 0; j < 4; ++j) {
          int l = wm * 32 + mf * 16 + (lane >> 4) * 4 + j;
          int s = wn2 * 64 + nf * 16 + (lane & 15);
          *(u16*)(Bs + sw256(l, s)) = f2bf(gacc[mf][nf][j]);
        }
    __syncthreads();
    {
      f32x4 yacc[2][2];
#pragma unroll
      for (int i = 0; i < 2; ++i)
#pragma unroll
        for (int j = 0; j < 2; ++j) yacc[i][j] = f32x4{0.f, 0.f, 0.f, 0.f};
#pragma unroll
      for (int ks = 0; ks < 4; ++ks) {
        int ch = ks * 4 + (lane >> 4);
        bf16x8 a[2], bb[2];
#pragma unroll
        for (int mf = 0; mf < 2; ++mf) a[mf] = ldfrag256(Cs, wm * 32 + mf * 16 + (lane & 15), ch);
#pragma unroll
        for (int nf = 0; nf < 2; ++nf) bb[nf] = ldfrag256(Ss, wn2 * 32 + nf * 16 + (lane & 15), ch);
#pragma unroll
        for (int mf = 0; mf < 2; ++mf)
#pragma unroll
          for (int nf = 0; nf < 2; ++nf)
            yacc[mf][nf] = __builtin_amdgcn_mfma_f32_16x16x32_bf16(a[mf], bb[nf], yacc[mf][nf], 0, 0, 0);
      }
#pragma unroll
      for (int mf = 0; mf < 2; ++mf)
#pragma unroll
        for (int j = 0; j < 4; ++j) {
          float e = __expf(csum[wm * 32 + mf * 16 + (lane >> 4) * 4 + j]);
#pragma unroll
          for (int nf = 0; nf < 2; ++nf) yacc[mf][nf][j] *= e;
        }
#pragma unroll
      for (int ks = 0; ks < 4; ++ks) {
        int ch = ks * 4 + (lane >> 4);
        bf16x8 a[2], bb[2];
#pragma unroll
        for (int mf = 0; mf < 2; ++mf) a[mf] = ldfrag256(Bs, wm * 32 + mf * 16 + (lane & 15), ch);
#pragma unroll
        for (int nf = 0; nf < 2; ++nf) bb[nf] = ldfrag256(XT, wn2 * 32 + nf * 16 + (lane & 15), ch);
#pragma unroll
        for (int mf = 0; mf < 2; ++mf)
#pragma unroll
          for (int nf = 0; nf < 2; ++nf)
            yacc[mf][nf] = __builtin_amdgcn_mfma_f32_16x16x32_bf16(a[mf], bb[nf], yacc[mf][nf], 0, 0, 0);
      }
#pragma unroll
      for (int mf = 0; mf < 2; ++mf)
#pragma unroll
        for (int nf = 0; nf < 2; ++nf)
#pragma unroll
          for (int j = 0; j < 4; ++j) {
            int l = wm * 32 + mf * 16 + (lane >> 4) * 4 + j;
            int pp = wn2 * 32 + nf * 16 + (lane & 15);
            yout[(size_t)(tok0 + l) * 2048 + h * 64 + pp] = f2bf(yacc[mf][nf][j]);
          }
    }
    {
      float e = __expf(cstot);
#pragma unroll
      for (int pf = 0; pf < 2; ++pf)
#pragma unroll
        for (int nf = 0; nf < 2; ++nf) sacc[pf][nf] *= e;
#pragma unroll
      for (int ks = 0; ks < 4; ++ks) {
        int ch = ks * 4 + (lane >> 4);
        bf16x8 a[2], bb[2];
#pragma unroll
        for (int pf = 0; pf < 2; ++pf) a[pf] = ldfrag256(XT, wp * 32 + pf * 16 + (lane & 15), ch);
#pragma unroll
        for (int nf = 0; nf < 2; ++nf) bb[nf] = ldfrag256(BdT, wn4 * 32 + nf * 16 + (lane & 15), ch);
#pragma unroll
        for (int pf = 0; pf < 2; ++pf)
#pragma unroll
          for (int nf = 0; nf < 2; ++nf)
            sacc[pf][nf] = __builtin_amdgcn_mfma_f32_16x16x32_bf16(a[pf], bb[nf], sacc[pf][nf], 0, 0, 0);
      }
    }
    __syncthreads();
  }
  if (g < 2) {
    float* so = p.out + (d ? OUT_SSMB : OUT_SSMF) + (size_t)((g * 16 + b) * 32 + h) * 8192;
#pragma unroll
    for (int pf = 0; pf < 2; ++pf)
#pragma unroll
      for (int nf = 0; nf < 2; ++nf)
#pragma unroll
        for (int j = 0; j < 4; ++j) {
          int pp = wp * 32 + pf * 16 + (lane >> 4) * 4 + j;
          int n = wn4 * 32 + nf * 16 + (lane & 15);
          so[pp * 128 + n] = sacc[pf][nf][j];
        }
  }
}

DI float dpp_xor1(float v) { return __shfl_xor(v, 1); }
DI float dpp_xor2(float v) { return __shfl_xor(v, 2); }

__device__ __forceinline__ void wkv_pair(const Params& p, char* smem, int g, int chain0, int nact) {
  char* ws = p.ws;
  const int tid = get_tid(), lane = tid & 63, wave = tid >> 6;
  const int Ls = g < 2 ? 256 : 2048;
  const int ntb = Ls >> 4;
  const __half* wk = (const __half*)(ws + OFF_WK);
  float* stage = (float*)smem;
  float* ylds = (float*)(smem + 98304);
  const int slot = wave >> 2, wq = wave & 3;
  const int ig = lane >> 2, jg = lane & 3;
  const int row = wq * 16 + ig;
  const bool act = slot < nact;
  const int chain = chain0 + (act ? slot : 0);
  const int d = chain & 1, h = (chain >> 1) & 15, b = chain >> 5;
  float S[16];
  if (g == 2) {
    const float* s0 = (d ? p.wkv_b : p.wkv_f) + ((size_t)(b * 16 + h) * 64 + row) * 64 + jg * 16;
#pragma unroll
    for (int c = 0; c < 16; ++c) S[c] = s0[c];
  } else {
#pragma unroll
    for (int c = 0; c < 16; ++c) S[c] = 0.f;
  }
  const int pair = tid >> 4, lslot = pair >> 4, lstep = pair & 15, sub = tid & 15;
  const bool lact = lslot < nact;
  const int lchain = chain0 + (lact ? lslot : 0);
  const int ld = lchain & 1, lh = (lchain >> 1) & 15, lb = lchain >> 5;
  float ka[4];
#pragma unroll
  for (int e = 0; e < 4; ++e) ka[e] = p.k_a[lh * 64 + sub * 4 + e];
  u16* yout = (u16*)(ws + (ld ? OFF_WYB : OFF_WYF));
  uint2 rg[6];
  auto prefetch = [&](int tb) {
    int s = tb * 16 + lstep;
    int pos = ld ? Ls - 1 - s : s;
    int r = lb * Ls + pos;
    const __half* rec = wk + ((size_t)(r * 16 + lh) * 8) * 64 + sub * 4;
    rg[0] = *(const uint2*)(rec + 0 * 64);
    rg[1] = *(const uint2*)(rec + 1 * 64);
    rg[2] = *(const uint2*)(rec + 2 * 64);
    rg[3] = *(const uint2*)(rec + 3 * 64);
    rg[4] = *(const uint2*)(rec + (4 + 2 * ld) * 64);
    rg[5] = *(const uint2*)(rec + (5 + 2 * ld) * 64);
  };
  auto unpack4 = [&](uint2 u, float (&o)[4]) {
    __half2 h0 = *reinterpret_cast<__half2*>(&u.x);
    __half2 h1 = *reinterpret_cast<__half2*>(&u.y);
    float2 f0 = __half22float2(h0), f1 = __half22float2(h1);
    o[0] = f0.x; o[1] = f0.y; o[2] = f1.x; o[3] = f1.y;
  };
  auto stage_store = [&](int buf) {
    float r_[4], v_[4], k_[4], nkk_[4], w_[4], a_[4];
    unpack4(rg[0], r_); unpack4(rg[1], v_); unpack4(rg[2], k_); unpack4(rg[3], nkk_); unpack4(rg[4], w_); unpack4(rg[5], a_);
    float b_[4], kd_[4];
#pragma unroll
    for (int e = 0; e < 4; ++e) {
      b_[e] = -nkk_[e] * a_[e];
      kd_[e] = k_[e] * (1.f + (a_[e] - 1.f) * ka[e]);
    }
    float* dst = stage + ((size_t)((buf * 2 + lslot) * 16 + lstep) * 6) * 64 + sub * 4;
    *(float4*)(dst + 0 * 64) = float4{nkk_[0], nkk_[1], nkk_[2], nkk_[3]};
    *(float4*)(dst + 1 * 64) = float4{w_[0], w_[1], w_[2], w_[3]};
    *(float4*)(dst + 2 * 64) = float4{b_[0], b_[1], b_[2], b_[3]};
    *(float4*)(dst + 3 * 64) = float4{kd_[0], kd_[1], kd_[2], kd_[3]};
    *(float4*)(dst + 4 * 64) = float4{r_[0], r_[1], r_[2], r_[3]};
    *(float4*)(dst + 5 * 64) = float4{v_[0], v_[1], v_[2], v_[3]};
  };
  prefetch(0);
  stage_store(0);
  __syncthreads();
  for (int tb = 0; tb < ntb; ++tb) {
    const bool more = tb + 1 < ntb;
    if (more) prefetch(tb + 1);
    if (act) {
      const float* sb = stage + ((size_t)(((tb & 1) * 2 + slot) * 16) * 6) * 64;
      for (int st = 0; st < 16; ++st) {
        const float* v6 = sb + st * 384 + jg * 16;
        float nkk[16], w[16], bb[16], kd[16], rr[16];
#pragma unroll
        for (int q = 0; q < 4; ++q) {
          float4 t0 = *(const float4*)(v6 + 0 * 64 + q * 4);
          nkk[q * 4] = t0.x; nkk[q * 4 + 1] = t0.y; nkk[q * 4 + 2] = t0.z; nkk[q * 4 + 3] = t0.w;
          float4 t1 = *(const float4*)(v6 + 1 * 64 + q * 4);
          w[q * 4] = t1.x; w[q * 4 + 1] = t1.y; w[q * 4 + 2] = t1.z; w[q * 4 + 3] = t1.w;
          float4 t2 = *(const float4*)(v6 + 2 * 64 + q * 4);
          bb[q * 4] = t2.x; bb[q * 4 + 1] = t2.y; bb[q * 4 + 2] = t2.z; bb[q * 4 + 3] = t2.w;
          float4 t3 = *(const float4*)(v6 + 3 * 64 + q * 4);
          kd[q * 4] = t3.x; kd[q * 4 + 1] = t3.y; kd[q * 4 + 2] = t3.z; kd[q * 4 + 3] = t3.w;
          float4 t4 = *(const float4*)(v6 + 4 * 64 + q * 4);
          rr[q * 4] = t4.x; rr[q * 4 + 1] = t4.y; rr[q * 4 + 2] = t4.z; rr[q * 4 + 3] = t4.w;
        }
        float vi = sb[st * 384 + 5 * 64 + row];
        float sa = 0.f;
#pragma unroll
        for (int c = 0; c < 16; ++c) sa += S[c] * nkk[c];
        sa += dpp_xor1(sa);
        sa += dpp_xor2(sa);
        float y = 0.f;
#pragma unroll
        for (int c = 0; c < 16; ++c) {
          S[c] = S[c] * w[c] + (sa * bb[c] + vi * kd[c]);
          y += S[c] * rr[c];
        }
        y += dpp_xor1(y);
        y += dpp_xor2(y);
        if (jg == 0) ylds[(slot * 16 + st) * 64 + row] = y;
      }
    }
    __syncthreads();
    if (more) stage_store((tb + 1) & 1);
    if (lact) {
      int s = tb * 16 + lstep;
      int pos = ld ? Ls - 1 - s : s;
      int r = lb * Ls + pos;
      float4 yv = *(const float4*)(ylds + (lslot * 16 + lstep) * 64 + sub * 4);
      *(uint2*)(yout + (size_t)r * 1024 + lh * 64 + sub * 4) = uint2{pack2(yv.x, yv.y), pack2(yv.z, yv.w)};
    }
    __syncthreads();
  }
  if (g < 2 && act) {
    float* so = p.out + (d ? OUT_WKVB : OUT_WKVF) + ((size_t)((g * 16 + b) * 16 + h) * 64 + row) * 64 + jg * 16;
#pragma unroll
    for (int c = 0; c < 16; ++c) so[c] = S[c];
  }
}

__device__ __forceinline__ void step_scan(const Params& p, char* smem, int g) {
  const int G = gridDim.x;
  if (g < 2) {
    if (SM & 8192) for (int ch = blockIdx.x; ch < 1024; ch += G) ssd_chain(p, smem, g, ch);
    if (SM & 16384) for (int it = blockIdx.x; it < 256; it += G) wkv_pair(p, smem, g, it * 2, 2);
  } else {
    if (SM & 8192) for (int ch = blockIdx.x; ch < 128; ch += G) ssd_chain(p, smem, g, ch);
    if (SM & 16384) for (int it = (G - 1 - blockIdx.x); it < 64; it += G) wkv_pair(p, smem, g, it, 1);
  }
}

__device__ __forceinline__ void step_fin(const Params& p, int g) {
  char* ws = p.ws;
  const int tid = get_tid(), lane = tid & 63, wave = tid >> 6;
  const int gw = blockIdx.x * 8 + wave, nw = gridDim.x * 8;
  {
    const u16* yf = (const u16*)(ws + OFF_SYF);
    const u16* yb = (const u16*)(ws + OFF_SYB);
    const u16* xbc = (const u16*)(ws + OFF_XBC);
    const u16* zb = (const u16*)(ws + OFF_Z);
    u16* ym = (u16*)(ws + OFF_YM);
    for (int it = gw; it < TG * 4; it += nw) {
      int r = it >> 2, gq = it & 3;
      int ch = gq * 512 + lane * 8;
      uint4 a = *(const uint4*)(yf + (size_t)r * 2048 + ch);
      uint4 b = *(const uint4*)(yb + (size_t)r * 2048 + ch);
      uint4 x = *(const uint4*)(xbc + (size_t)r * 3072 + ch);
      uint4 z = *(const uint4*)(zb + (size_t)r * 2048 + ch);
      float dsk = p.d_skip[ch >> 6];
      unsigned aw[4] = {a.x, a.y, a.z, a.w}, bw[4] = {b.x, b.y, b.z, b.w}, xw[4] = {x.x, x.y, x.z, x.w}, zw[4] = {z.x, z.y, z.z, z.w};
      float y[8];
      float ss = 0.f;
#pragma unroll
      for (int e = 0; e < 8; ++e) {
        int sh = (e & 1) * 16;
        float yy = bf2f((u16)(aw[e >> 1] >> sh)) + bf2f((u16)(bw[e >> 1] >> sh)) + dsk * bf2f((u16)(xw[e >> 1] >> sh));
        yy *= siluf(bf2f((u16)(zw[e >> 1] >> sh)));
        y[e] = yy;
        ss += yy * yy;
      }
      ss = wave_sum(ss);
      float rinv = rsqrtf(ss * (1.f / 512.f) + 1e-5f);
      float4 w0 = *(const float4*)(p.m_norm_w + ch), w1 = *(const float4*)(p.m_norm_w + ch + 4);
      *(uint4*)(ym + (size_t)r * 2048 + ch) =
          uint4{pack2(y[0] * rinv * w0.x, y[1] * rinv * w0.y), pack2(y[2] * rinv * w0.z, y[3] * rinv * w0.w),
                pack2(y[4] * rinv * w1.x, y[5] * rinv * w1.y), pack2(y[6] * rinv * w1.z, y[7] * rinv * w1.w)};
    }
  }
  {
    const u16* yf = (const u16*)(ws + OFF_WYF);
    const u16* yb = (const u16*)(ws + OFF_WYB);
    const __half* wk = (const __half*)(ws + OFF_WK);
    const u16* gr = (const u16*)(ws + OFF_GR);
    u16* yr = (u16*)(ws + OFF_YR);
    for (int it = gw; it < TG * 16; it += nw) {
      int r = it >> 4, h = it & 15;
      int c = h * 64 + lane;
      float y = bf2f(yf[(size_t)r * 1024 + c]) + bf2f(yb[(size_t)r * 1024 + c]);
      float mean = wave_sum(y) * (1.f / 64.f);
      float dy = y - mean;
      float var = wave_sum(dy * dy) * (1.f / 64.f);
      float yn = dy * rsqrtf(var + 64e-5f) * p.lnx_w[c] + p.lnx_b[c];
      const __half* rec = wk + ((size_t)(r * 16 + h) * 8) * 64 + lane;
      float rr = __half2float(rec[0]), vv = __half2float(rec[64]), kk = __half2float(rec[128]);
      float af = __half2float(rec[5 * 64]), ab = __half2float(rec[7 * 64]);
      float kmean = kk * (1.f + (0.5f * (af + ab) - 1.f) * p.k_a[c]);
      float bs = wave_sum(rr * kmean * p.r_k[c]);
      float o = (yn + bs * vv) * bf2f(gr[(size_t)r * 1024 + c]);
      yr[(size_t)r * 1024 + c] = f2bf(o);
    }
  }
}

__device__ __forceinline__ void step_outproj(const Params& p, char* smem) {
  char* ws = p.ws;
  const int tid = get_tid(), lane = tid & 63, wave = tid >> 6;
  const int wm = wave >> 1, wn = wave & 1;
  const u16* ym = (const u16*)(ws + OFF_YM);
  const u16* yr = (const u16*)(ws + OFF_YR);
  const u16* gb = (const u16*)(ws + OFF_GATE);
  u16* U = (u16*)(ws + OFF_U);
  for (int t = blockIdx.x; t < 128; t += gridDim.x) {
    int mt = t & 15, nt = t >> 4;
    f32x4 acc[4][4];
    zero_acc(acc);
    gemm_acc(ym + (size_t)mt * 256 * 2048, 2048, (const u16*)(ws + OFF_WMOUT) + (size_t)nt * 128 * 2048, 2048, 2048, acc, smem);
#pragma unroll
    for (int mf = 0; mf < 4; ++mf)
#pragma unroll
      for (int nf = 0; nf < 4; ++nf)
#pragma unroll
        for (int j = 0; j < 4; ++j) {
          if (nf == 0 && j == 0) asm volatile("" ::: "memory");
          int m = mt * 256 + wm * 64 + mf * 16 + (lane >> 4) * 4 + j;
          int n = nt * 128 + wn * 64 + nf * 16 + (lane & 15);
          U[(size_t)m * 1024 + n] = f2bf(sigm(bf2f(gb[(size_t)m * 2048 + n])) * acc[mf][nf][j]);
        }
  }
  for (int t = blockIdx.x; t < 128; t += gridDim.x) {
    int mt = t & 15, nt = t >> 4;
    f32x4 acc[4][4];
    zero_acc(acc);
    gemm_acc(yr + (size_t)mt * 256 * 1024, 1024, (const u16*)(ws + OFF_WROUT) + (size_t)nt * 128 * 1024, 1024, 1024, acc, smem);
#pragma unroll
    for (int mf = 0; mf < 4; ++mf)
#pragma unroll
      for (int nf = 0; nf < 4; ++nf)
#pragma unroll
        for (int j = 0; j < 4; ++j) {
          if (nf == 0 && j == 0) asm volatile("" ::: "memory");
          int m = mt * 256 + wm * 64 + mf * 16 + (lane >> 4) * 4 + j;
          int n = nt * 128 + wn * 64 + nf * 16 + (lane & 15);
          float v = bf2f(U[(size_t)m * 1024 + n]) + sigm(bf2f(gb[(size_t)m * 2048 + 1024 + n])) * acc[mf][nf][j];
          U[(size_t)m * 1024 + n] = f2bf(v);
        }
  }
}

__device__ __forceinline__ void step_wo(const Params& p, char* smem, int g) {
  char* ws = p.ws;
  const int tid = get_tid(), lane = tid & 63, wave = tid >> 6;
  const int wm = wave >> 1, wn = wave & 1;
  const u16* U = (const u16*)(ws + OFF_U);
  const float* mod = (const float*)(ws + OFF_MOD);
  for (int t = blockIdx.x; t < 128; t += gridDim.x) {
    int mt = t & 15, nt = t >> 4;
    f32x4 acc[4][4];
    zero_acc(acc);
    gemm_acc(U + (size_t)mt * 256 * 1024, 1024, (const u16*)(ws + OFF_WO) + (size_t)nt * 128 * 1024, 1024, 1024, acc, smem);
#pragma unroll
    for (int mf = 0; mf < 4; ++mf)
#pragma unroll
      for (int nf = 0; nf < 4; ++nf)
#pragma unroll
        for (int j = 0; j < 4; ++j) {
          if (nf == 0 && j == 0) asm volatile("" ::: "memory");
          int m = mt * 256 + wm * 64 + mf * 16 + (lane >> 4) * 4 + j;
          int n = nt * 128 + wn * 64 + nf * 16 + (lane & 15);
          int tok = g * TG + m;
          const float* xr = tok < 8192 ? p.x_prompt + (size_t)tok * 1024 : p.x_sample + (size_t)(tok - 8192) * 1024;
          float gt1 = mod[mrow_of(tok) * 6144 + 2048 + n];
          p.out[(size_t)tok * 1024 + n] = xr[n] + gt1 * acc[mf][nf][j];
        }
  }
}

__device__ __forceinline__ void step_gu(const Params& p, char* smem) {
  char* ws = p.ws;
  const int tid = get_tid(), lane = tid & 63, wave = tid >> 6;
  const int wm = wave >> 1, wn = wave & 1;
  const u16* H2 = (const u16*)(ws + OFF_H2);
  u16* act = (u16*)(ws + OFF_ACT);
  for (int t = blockIdx.x; t < 48 * 44; t += gridDim.x) {
    int mt = t % 48, nt = t / 48;
    f32x4 acc[4][4];
    zero_acc(acc);
    gemm_acc(H2 + (size_t)mt * 256 * 1024, 1024, (const u16*)(ws + OFF_WGU) + (size_t)nt * 128 * 1024, 1024, 1024, acc, smem);
#pragma unroll
    for (int mf = 0; mf < 4; ++mf)
#pragma unroll
      for (int nf = 0; nf < 2; ++nf)
#pragma unroll
        for (int j = 0; j < 4; ++j) {
          if (nf == 0 && j == 0) asm volatile("" ::: "memory");
          int m = mt * 256 + wm * 64 + mf * 16 + (lane >> 4) * 4 + j;
          int n = nt * 64 + wn * 32 + nf * 16 + (lane & 15);
          float gg = acc[mf][nf][j], uu = acc[mf][nf + 2][j];
          act[(size_t)m * 2816 + n] = f2bf(siluf(gg) * uu);
        }
  }
}

__device__ __forceinline__ void step_down(const Params& p, char* smem) {
  char* ws = p.ws;
  const int tid = get_tid(), lane = tid & 63, wave = tid >> 6;
  const int wm = wave >> 1, wn = wave & 1;
  const u16* act = (const u16*)(ws + OFF_ACT);
  const float* mod = (const float*)(ws + OFF_MOD);
  for (int t = blockIdx.x; t < 48 * 8; t += gridDim.x) {
    int mt = t % 48, nt = t / 48;
    f32x4 acc[4][4];
    zero_acc(acc);
    gemm_acc(act + (size_t)mt * 256 * 2816, 2816, (const u16*)(ws + OFF_WDOWN) + (size_t)nt * 128 * 2816, 2816, 2816, acc, smem);
#pragma unroll
    for (int mf = 0; mf < 4; ++mf)
#pragma unroll
      for (int nf = 0; nf < 4; ++nf)
#pragma unroll
        for (int j = 0; j < 4; ++j) {
          if (nf == 0 && j == 0) asm volatile("" ::: "memory");
          int m = mt * 256 + wm * 64 + mf * 16 + (lane >> 4) * 4 + j;
          int n = nt * 128 + wn * 64 + nf * 16 + (lane & 15);
          float gt2 = mod[mrow_of(m) * 6144 + 5120 + n];
          p.out[(size_t)m * 1024 + n] += gt2 * acc[mf][nf][j];
        }
  }
}

__device__ __forceinline__ void step_final(const Params& p) {
  const int tid = get_tid(), lane = tid & 63, wave = tid >> 6;
  for (int r = blockIdx.x * 8 + wave; r < NTOK; r += gridDim.x * 8) {
    float* xr = p.out + (size_t)r * 1024;
    float4 v[4];
    float ss = 0.f;
#pragma unroll
    for (int i = 0; i < 4; ++i) {
      v[i] = ((const float4*)xr)[i * 64 + lane];
      ss += v[i].x * v[i].x + v[i].y * v[i].y + v[i].z * v[i].z + v[i].w * v[i].w;
    }
    ss = wave_sum(ss);
    float rinv = rsqrtf(ss * (1.f / 1024.f) + 1e-6f);
#pragma unroll
    for (int i = 0; i < 4; ++i) {
      float4 w4 = ((const float4*)p.final_norm_w)[i * 64 + lane];
      ((float4*)xr)[i * 64 + lane] = float4{v[i].x * rinv * w4.x, v[i].y * rinv * w4.y, v[i].z * rinv * w4.z, v[i].w * rinv * w4.w};
    }
  }
}

constexpr int NSTEPS = 29;

__global__ void __launch_bounds__(NTHR) mega(Params p) {
  __shared__ __attribute__((aligned(16))) char smem[SMEM_BYTES];
  for (int step = p.step_lo; step <= p.step_hi; ++step) {
    if (step == 0) { if (SM & 1) step_prep(p, smem); }
    else if (step <= 24) {
      int g = (step - 1) >> 3, s = (step - 1) & 7;
      switch (s) {
        case 0: if (SM & 2) step_norm<0>(p, g); break;
        case 1: if (SM & 4) step_gemm1(p, smem); break;
        case 2: if (SM & 8) step_cr1(p, g); break;
        case 3: if (SM & 16) step_r2(p, smem); break;
        case 4: if (SM & 32) step_scan(p, smem, g); break;
        case 5: if (SM & 64) step_fin(p, g); break;
        case 6: if (SM & 128) step_outproj(p, smem); break;
        default: if (SM & 256) step_wo(p, smem, g); break;
      }
    } else if (step == 25) { if (SM & 512) step_norm<1>(p, 0); }
    else if (step == 26) { if (SM & 1024) step_gu(p, smem); }
    else if (step == 27) { if (SM & 2048) step_down(p, smem); }
    else { if (SM & 4096) step_final(p); }
    if (step < p.step_hi) {
#if !MULTI_LAUNCH
      cg::this_grid().sync();
#endif
    }
  }
}

extern "C" void kernel_launch(void* const* d_in, const int* in_sizes, int n_in, void* d_out, int out_size,
                              void* d_ws, size_t ws_size, hipStream_t stream) {
  Params p{};
  const float** pp = (const float**)&p;
  for (int i = 0; i < 36; ++i) pp[i] = (const float*)d_in[i];
  p.out = (float*)d_out;
  p.ws = (char*)d_ws;
  if (ws_size < OFF_END) fprintf(stderr, "workspace too small: %zu < %zu\n", ws_size, (size_t)OFF_END);
#if MULTI_LAUNCH
  for (int s = 0; s < NSTEPS; ++s) {
    p.step_lo = s;
    p.step_hi = s;
    hipLaunchKernelGGL(mega, dim3(256), dim3(NTHR), 0, stream, p);
  }
#else
  static int grid_blocks = 0;
  if (!grid_blocks) {
    int dev = 0, cus = 0, per_cu = 0;
    hipGetDevice(&dev);
    hipDeviceGetAttribute(&cus, hipDeviceAttributeMultiprocessorCount, dev);
    hipOccupancyMaxActiveBlocksPerMultiprocessor(&per_cu, mega, NTHR, 0);
    if (per_cu < 1) per_cu = 1;
    if (per_cu > 1) per_cu = 1;
    grid_blocks = cus * per_cu;
  }
  p.step_lo = 0;
  p.step_hi = NSTEPS - 1;
  void* args[] = {&p};
  hipError_t e = hipLaunchCooperativeKernel((void*)mega, dim3(grid_blocks), dim3(NTHR), args, 0, stream);
  if (e != hipSuccess) fprintf(stderr, "cooperative launch failed: %s (grid %d)\n", hipGetErrorString(e), grid_blocks);
#endif
}
```

```cpp
#include <hip/hip_runtime.h>
#include <hip/hip_cooperative_groups.h>
#include <hip/hip_fp16.h>
#include <cstdio>
#include <cstdint>
namespace cg = cooperative_groups;

#ifndef MULTI_LAUNCH
#define MULTI_LAUNCH 0
#endif

#define DI __device__ __forceinline__
typedef __attribute__((ext_vector_type(8))) short bf16x8;
typedef __attribute__((ext_vector_type(4))) float f32x4;
typedef unsigned short u16;

#ifndef STEP_MASK
#define STEP_MASK 0xffffff
#endif
constexpr int SM = STEP_MASK;
#ifndef REPEAT_MASK
#define REPEAT_MASK 0
#endif
#ifndef XSYNC
#define XSYNC 0
#endif
constexpr int RM = REPEAT_MASK;
constexpr int TG = 4096;
constexpr int NTOK = 12288;
constexpr int NPAD = 10752;
constexpr int NTHR = 512;
constexpr int SMEM_BYTES = 133120;
constexpr int XCD_BAR_WORDS_C = 3456;

constexpr size_t OFF_WIN = 0;
constexpr size_t OFF_WGU = OFF_WIN + (size_t)NPAD * 1024 * 2;
constexpr size_t OFF_WDOWN = OFF_WGU + (size_t)5632 * 1024 * 2;
constexpr size_t OFF_WMOUT = OFF_WDOWN + (size_t)1024 * 2816 * 2;
constexpr size_t OFF_WROUT = OFF_WMOUT + (size_t)1024 * 2048 * 2;
constexpr size_t OFF_WO = OFF_WROUT + (size_t)1024 * 1024 * 2;
constexpr size_t OFF_W2T = OFF_WO + (size_t)1024 * 1024 * 2;
constexpr size_t OFF_A2T = OFF_W2T + 262144;
constexpr size_t OFF_G2T = OFF_A2T + 262144;
constexpr size_t OFF_MOD = OFF_G2T + 262144;
constexpr size_t OFF_GRP = OFF_MOD + 73728;
constexpr size_t OFF_Z = OFF_GRP;
constexpr size_t OFF_GATE = OFF_Z + (size_t)TG * 2048 * 2;
constexpr size_t OFF_XBC = OFF_GATE + (size_t)TG * 2048 * 2;
constexpr size_t OFF_WK = OFF_XBC + (size_t)TG * 3072 * 2;
constexpr size_t OFF_GR = OFF_WK + (size_t)TG * 16 * 1024;
constexpr size_t OFF_DT = OFF_GR + (size_t)TG * 1024 * 2;
constexpr size_t OFF_TL = OFF_DT + (size_t)TG * 64 * 4;
constexpr size_t OFF_SG = OFF_TL + (size_t)TG * 256 * 2;
constexpr size_t OFF_R = OFF_SG + (size_t)TG * 128 * 2;
constexpr size_t OFF_H1 = OFF_R;
constexpr size_t OFF_XBCRAW = OFF_H1 + (size_t)TG * 1024 * 2;
constexpr size_t OFF_RW = OFF_XBCRAW + (size_t)TG * 3072 * 2;
constexpr size_t OFF_SYF = OFF_R;
constexpr size_t OFF_SYB = OFF_SYF + (size_t)TG * 2048 * 2;
constexpr size_t OFF_WYF = OFF_SYB + (size_t)TG * 2048 * 2;
constexpr size_t OFF_WYB = OFF_WYF + (size_t)TG * 1024 * 2;
constexpr size_t OFF_YM = OFF_WYB + (size_t)TG * 1024 * 2;
constexpr size_t OFF_YR = OFF_YM + (size_t)TG * 2048 * 2;
constexpr size_t OFF_END = OFF_YR + (size_t)TG * 1024 * 2;
constexpr size_t OFF_BAR = OFF_END;
constexpr size_t WS_NEED = OFF_BAR + XCD_BAR_WORDS_C * 4;
constexpr size_t OFF_U = OFF_XBC;
constexpr size_t OFF_H2 = OFF_GRP;
constexpr size_t OFF_ACT = OFF_H2 + (size_t)NTOK * 1024 * 2;

constexpr size_t OUT_SSMF = 12582912;
constexpr size_t OUT_SSMB = OUT_SSMF + 8388608;
constexpr size_t OUT_WKVF = OUT_SSMB + 8388608;
constexpr size_t OUT_WKVB = OUT_WKVF + 2097152;

struct Params {
  const float *x_prompt, *x_sample, *ssm_f, *ssm_b, *wkv_f, *wkv_b, *c, *c_ctx, *norm1_w, *norm2_w,
      *w_ada, *b_ada, *w_in, *conv_w, *conv_b, *dt_bias, *a_log, *d_skip, *m_norm_w, *mu_shift, *w0,
      *w2, *a0, *a2, *g2, *k_k, *k_a, *r_k, *lnx_w, *lnx_b, *w_m_out, *w_r_out, *w_o, *w_gu, *w_down,
      *final_norm_w;
  float* out;
  char* ws;
  int step_lo, step_hi;
};

DI int get_tid() {
  int t = threadIdx.x;
  asm volatile("" : "+v"(t));
  return t;
}
DI u16 f2bf(float f) {
  unsigned u = __float_as_uint(f);
  u += 0x7fffu + ((u >> 16) & 1u);
  return (u16)(u >> 16);
}
DI float bf2f(u16 h) { return __uint_as_float(((unsigned)h) << 16); }
DI float siluf(float x) { return x / (1.f + __expf(-x)); }
DI float sigm(float x) { return 1.f / (1.f + __expf(-x)); }
DI float wave_sum(float v) {
#pragma unroll
  for (int o = 32; o > 0; o >>= 1) v += __shfl_xor(v, o);
  return v;
}
DI unsigned pack2(float a, float b) { return (unsigned)f2bf(a) | ((unsigned)f2bf(b) << 16); }
DI int mrow_of(int tok) { return tok < 8192 ? 0 : 1 + ((tok - 8192) >> 11); }


#define XB_TMO      128
#define XB_XCNT(j)  (256  + 64 * (j))
#define XB_XSUB(j)  (1280 + 64 * (j))
#define XB_XGEN(j)  (2304 + 64 * (j))
#define XB_TOP      3328
#define XB_TOPGEN   3392
#define XCD_BAR_WORDS 3456
#define XB_SPIN_CAP (1u << 22)
#define LAS __attribute__((address_space(3)))
DI unsigned xb_ld(unsigned* p) { return __hip_atomic_load(p, __ATOMIC_RELAXED, __HIP_MEMORY_SCOPE_AGENT); }
DI unsigned xb_add(unsigned* p, unsigned v) { return __hip_atomic_fetch_add(p, v, __ATOMIC_RELAXED, __HIP_MEMORY_SCOPE_AGENT); }
DI unsigned xb_xcc_id() { return (unsigned)__builtin_amdgcn_s_getreg((3 << 11) | 20) & 0xFu; }
#define XB_SPIN(cond, bar) do { unsigned _sp = 0; while (cond) { __builtin_amdgcn_s_sleep(1); \
    if ((++_sp & 255u) == 0u) { if (xb_ld(&(bar)[XB_TMO])) break; if (_sp > XB_SPIN_CAP) { atomicAdd(&(bar)[XB_TMO], 1u); break; } } } } while (0)
struct XcdBarrier { unsigned* bar; unsigned x; volatile LAS unsigned* st; };
DI XcdBarrier xcd_barrier_post(unsigned* bar, volatile LAS unsigned* st) {
  XcdBarrier b; b.bar = bar; b.x = xb_xcc_id(); b.st = st;
  if (threadIdx.x == 0) (void)xb_add(&bar[XB_XCNT(b.x)], 1u);
  return b;
}
DI void xcd_barrier_complete(unsigned* bar, unsigned x, unsigned& nloc, unsigned& nx) {
  const unsigned G = gridDim.x * gridDim.y * gridDim.z;
  unsigned sum, cnt, mine, sp = 0u;
  for (;;) {
    sum = 0u; cnt = 0u; mine = 0u;
#pragma unroll
    for (unsigned j = 0; j < 16; ++j) { const unsigned c = xb_ld(&bar[XB_XCNT(j)]); sum += c; cnt += (c > 0u) ? 1u : 0u; mine = (j == x) ? c : mine; }
    if (sum == G) break;
    __builtin_amdgcn_s_sleep(1);
    if ((++sp & 255u) == 0u) { if (xb_ld(&bar[XB_TMO])) break; if (sp > XB_SPIN_CAP) { atomicAdd(&bar[XB_TMO], 1u); break; } }
  }
  nloc = mine > 0u ? mine : 1u; nx = cnt > 0u ? cnt : 1u;
}
DI void xcd_barrier(const XcdBarrier& b) {
  asm volatile("s_waitcnt vmcnt(0)" ::: "memory");
  __syncthreads();
  if (threadIdx.x == 0) {
    unsigned* bar = b.bar;
    __builtin_amdgcn_s_waitcnt(0);
    unsigned nloc = b.st[0], nx = b.st[1];
    if (nloc == 0u) { xcd_barrier_complete(bar, b.x, nloc, nx); b.st[0] = nloc; b.st[1] = nx; }
    const unsigned old = xb_add(&bar[XB_XSUB(b.x)], 1u);
    const unsigned gen = old / nloc;
    if (old + 1u == (gen + 1u) * nloc) {
      __builtin_amdgcn_fence(__ATOMIC_RELEASE, "agent");
      asm volatile("s_waitcnt vmcnt(0)" ::: "memory");
      const unsigned og = xb_add(&bar[XB_TOP], 1u);
      const unsigned tg = og / nx;
      if (og + 1u == (tg + 1u) * nx) xb_add(&bar[XB_TOPGEN], 1u);
      else XB_SPIN(xb_ld(&bar[XB_TOPGEN]) == tg, bar);
      __builtin_amdgcn_fence(__ATOMIC_ACQUIRE, "agent");
      xb_add(&bar[XB_XGEN(b.x)], 1u);
      asm volatile("s_waitcnt vmcnt(0)" ::: "memory");
    } else {
      XB_SPIN(xb_ld(&bar[XB_XGEN(b.x)]) == gen, bar);
      __builtin_amdgcn_fence(__ATOMIC_ACQUIRE, "agent");
      asm volatile("s_waitcnt vmcnt(0)" ::: "memory");
    }
  }
  __syncthreads();
}

DI void gemm_load(const int tid, const u16* A, int lda, const u16* B, int ldb, int k0, uint4 (&ra)[4], uint4 (&rb)[2]) {
#pragma unroll
  for (int i = 0; i < 4; ++i) {
    int idx = tid + i * 512;
    int row = idx >> 3, ch = idx & 7;
    ra[i] = *(const uint4*)(A + (size_t)row * lda + k0 + ch * 8);
  }
#pragma unroll
  for (int i = 0; i < 2; ++i) {
    int idx = tid + i * 512;
    int row = idx >> 3, ch = idx & 7;
    rb[i] = *(const uint4*)(B + (size_t)row * ldb + k0 + ch * 8);
  }
}
DI void gemm_store_lds(const int tid, char* sA, char* sB, const uint4 (&ra)[4], const uint4 (&rb)[2]) {
#pragma unroll
  for (int i = 0; i < 4; ++i) {
    int idx = tid + i * 512;
    int row = idx >> 3, ch = idx & 7;
    *(uint4*)(sA + row * 128 + ((ch ^ ((row >> 1) & 7)) << 4)) = ra[i];
  }
#pragma unroll
  for (int i = 0; i < 2; ++i) {
    int idx = tid + i * 512;
    int row = idx >> 3, ch = idx & 7;
    *(uint4*)(sB + row * 128 + ((ch ^ ((row >> 1) & 7)) << 4)) = rb[i];
  }
}
DI void gemm_compute(const char* sA, const char* sB, f32x4 (&acc)[4][4], int wm, int wn, int lane) {
#pragma unroll
  for (int kk = 0; kk < 2; ++kk) {
    bf16x8 a[4], b[4];
    const int ch = kk * 4 + (lane >> 4);
#pragma unroll
    for (int mf = 0; mf < 4; ++mf) {
      int row = wm * 64 + mf * 16 + (lane & 15);
      a[mf] = *(const bf16x8*)(sA + row * 128 + ((ch ^ ((row >> 1) & 7)) << 4));
    }
#pragma unroll
    for (int nf = 0; nf < 4; ++nf) {
      int row = wn * 64 + nf * 16 + (lane & 15);
      b[nf] = *(const bf16x8*)(sB + row * 128 + ((ch ^ ((row >> 1) & 7)) << 4));
    }
#pragma unroll
    for (int mf = 0; mf < 4; ++mf)
#pragma unroll
      for (int nf = 0; nf < 4; ++nf)
        acc[mf][nf] = __builtin_amdgcn_mfma_f32_16x16x32_bf16(a[mf], b[nf], acc[mf][nf], 0, 0, 0);
  }
}
DI void gemm_acc(const u16* A, int lda, const u16* B, int ldb, int K, f32x4 (&acc)[4][4], char* smem) {
  const int tid = get_tid(), lane = tid & 63, wave = tid >> 6;
  const int wm = wave >> 1, wn = wave & 1;
  char* sA0 = smem;
  char* sB0 = smem + 32768;
  char* sA1 = smem + 49152;
  char* sB1 = smem + 81920;
  uint4 ra[4], rb[2];
  const int nk = K >> 6;
  gemm_load(tid, A, lda, B, ldb, 0, ra, rb);
  gemm_store_lds(tid, sA0, sB0, ra, rb);
  __syncthreads();
  for (int kt = 0; kt < nk; ++kt) {
    const bool more = (kt + 1 < nk);
    if (more) gemm_load(tid, A, lda, B, ldb, (kt + 1) * 64, ra, rb);
    if (kt & 1) gemm_compute(sA1, sB1, acc, wm, wn, lane);
    else gemm_compute(sA0, sB0, acc, wm, wn, lane);
    if (more) {
      if (kt & 1) gemm_store_lds(tid, sA0, sB0, ra, rb);
      else gemm_store_lds(tid, sA1, sB1, ra, rb);
    }
    __syncthreads();
  }
}
DI void zero_acc(f32x4 (&acc)[4][4]) {
#pragma unroll
  for (int i = 0; i < 4; ++i)
#pragma unroll
    for (int j = 0; j < 4; ++j) acc[i][j] = f32x4{0.f, 0.f, 0.f, 0.f};
}

template <int MODE>
__device__ __forceinline__ void convT(const float* __restrict__ src, int K, int N, u16* __restrict__ dst, char* smem) {
  float* tile = (float*)smem;
  const int tid = get_tid();
  const int KT = K >> 6, NT = N >> 6;
  for (int t = blockIdx.x; t < KT * NT; t += gridDim.x) {
    int kt = t % KT, nt = t / KT;
#pragma unroll
    for (int i = 0; i < 8; ++i) {
      int idx = tid + i * 512;
      int r = idx >> 6, cc = idx & 63;
      tile[r * 65 + cc] = src[(size_t)(kt * 64 + r) * N + nt * 64 + cc];
    }
    __syncthreads();
    int n = tid >> 3, kc = tid & 7;
    unsigned w[4];
#pragma unroll
    for (int j = 0; j < 4; ++j)
      w[j] = pack2(tile[(kc * 8 + 2 * j) * 65 + n], tile[(kc * 8 + 2 * j + 1) * 65 + n]);
    int ng = nt * 64 + n;
    int row = ng;
    if (MODE == 1) {
      int isu = ng >= 2816;
      int nn = ng - isu * 2816;
      int j = nn >> 6, c2 = nn & 63;
      row = j * 128 + (c2 >> 5) * 64 + isu * 32 + (c2 & 31);
    }
    *(uint4*)(dst + (size_t)row * K + kt * 64 + kc * 8) = uint4{w[0], w[1], w[2], w[3]};
    __syncthreads();
  }
}

__device__ __forceinline__ void step_prep(const Params& p, char* smem) {
  const int tid = get_tid();
  char* ws = p.ws;
  {
    float* red = (float*)smem;
    float* mod = (float*)(ws + OFF_MOD);
    for (int item = blockIdx.x; item < 192; item += gridDim.x) {
      int c4 = tid & 7, kl = tid >> 3;
      float acc[12];
#pragma unroll
      for (int i = 0; i < 12; ++i) acc[i] = 0.f;
      for (int k = kl; k < 1024; k += 64) {
        float4 w = *(const float4*)(p.w_ada + (size_t)k * 6144 + item * 32 + c4 * 4);
        float s0 = siluf(p.c_ctx[k]), s1 = siluf(p.c[k]), s2 = siluf(p.c[1024 + k]);
        acc[0] += s0 * w.x; acc[1] += s0 * w.y; acc[2] += s0 * w.z; acc[3] += s0 * w.w;
        acc[4] += s1 * w.x; acc[5] += s1 * w.y; acc[6] += s1 * w.z; acc[7] += s1 * w.w;
        acc[8] += s2 * w.x; acc[9] += s2 * w.y; acc[10] += s2 * w.z; acc[11] += s2 * w.w;
      }
#pragma unroll
      for (int i = 0; i < 12; ++i) red[(kl * 8 + c4) * 12 + i] = acc[i];
      __syncthreads();
      if (tid < 96) {
        int cond = tid >> 5, col = tid & 31;
        int cc4 = col >> 2, e = col & 3;
        float s = 0.f;
        for (int k = 0; k < 64; ++k) s += red[(k * 8 + cc4) * 12 + cond * 4 + e];
        int n = item * 32 + col;
        mod[cond * 6144 + n] = s + p.b_ada[n];
      }
      __syncthreads();
    }
  }
  convT<0>(p.w_in, 1024, 10688, (u16*)(ws + OFF_WIN), smem);
  convT<1>(p.w_gu, 1024, 5632, (u16*)(ws + OFF_WGU), smem);
  convT<0>(p.w_down, 2816, 1024, (u16*)(ws + OFF_WDOWN), smem);
  convT<0>(p.w_m_out, 2048, 1024, (u16*)(ws + OFF_WMOUT), smem);
  convT<0>(p.w_r_out, 1024, 1024, (u16*)(ws + OFF_WROUT), smem);
  convT<0>(p.w_o, 1024, 1024, (u16*)(ws + OFF_WO), smem);
  convT<0>(p.w2, 64, 1024, (u16*)(ws + OFF_W2T), smem);
  convT<0>(p.w2 + 65536, 64, 1024, (u16*)(ws + OFF_W2T) + 65536, smem);
  convT<0>(p.a2, 64, 1024, (u16*)(ws + OFF_A2T), smem);
  convT<0>(p.a2 + 65536, 64, 1024, (u16*)(ws + OFF_A2T) + 65536, smem);
  convT<0>(p.g2, 128, 1024, (u16*)(ws + OFF_G2T), smem);
  {
    uint4* z = (uint4*)(ws + OFF_WIN + (size_t)10688 * 1024 * 2);
    for (int i = blockIdx.x * NTHR + tid; i < 8192; i += gridDim.x * NTHR) z[i] = uint4{0, 0, 0, 0};
  }
}

template <int WHICH>
__device__ __forceinline__ void step_norm(const Params& p, int g) {
  const int tid = get_tid(), lane = tid & 63, wave = tid >> 6;
  const float* mod = (const float*)(p.ws + OFF_MOD);
  const int nrows = WHICH == 0 ? TG : NTOK;
  u16* dst = (u16*)(p.ws + (WHICH == 0 ? OFF_H1 : OFF_H2));
  const float* nw = WHICH == 0 ? p.norm1_w : p.norm2_w;
  for (int r = blockIdx.x * 8 + wave; r < nrows; r += gridDim.x * 8) {
    int tok = WHICH == 0 ? g * TG + r : r;
    const float* xr;
    if (WHICH == 0) xr = tok < 8192 ? p.x_prompt + (size_t)tok * 1024 : p.x_sample + (size_t)(tok - 8192) * 1024;
    else xr = p.out + (size_t)tok * 1024;
    const float* mr = mod + mrow_of(tok) * 6144 + (WHICH == 0 ? 0 : 3072);
    float4 v[4];
    float ss = 0.f;
#pragma unroll
    for (int i = 0; i < 4; ++i) {
      v[i] = ((const float4*)xr)[i * 64 + lane];
      ss += v[i].x * v[i].x + v[i].y * v[i].y + v[i].z * v[i].z + v[i].w * v[i].w;
    }
    ss = wave_sum(ss);
    float rinv = rsqrtf(ss * (1.f / 1024.f) + 1e-6f);
#pragma unroll
    for (int i = 0; i < 4; ++i) {
      int col = (i * 64 + lane) * 4;
      float4 w4 = *(const float4*)(nw + col);
      float4 sh = *(const float4*)(mr + col);
      float4 sc = *(const float4*)(mr + 1024 + col);
      float h0 = v[i].x * rinv * w4.x * (1.f + sc.x) + sh.x;
      float h1 = v[i].y * rinv * w4.y * (1.f + sc.y) + sh.y;
      float h2 = v[i].z * rinv * w4.z * (1.f + sc.z) + sh.z;
      float h3 = v[i].w * rinv * w4.w * (1.f + sc.w) + sh.w;
      *(uint2*)(dst + (size_t)r * 1024 + col) = uint2{pack2(h0, h1), pack2(h2, h3)};
    }
  }
}

__device__ __forceinline__ void step_gemm1(const Params& p, char* smem) {
  char* ws = p.ws;
  const int tid = get_tid(), lane = tid & 63, wave = tid >> 6;
  const int wm = wave >> 1, wn = wave & 1;
  const u16* A = (const u16*)(ws + OFF_H1);
  const u16* Bt = (const u16*)(ws + OFF_WIN);
  u16* zb = (u16*)(ws + OFF_Z);
  u16* xr = (u16*)(ws + OFF_XBCRAW);
  float* dtb = (float*)(ws + OFF_DT);
  u16* rwb = (u16*)(ws + OFF_RW);
  u16* gb = (u16*)(ws + OFF_GATE);
  for (int t = blockIdx.x; t < 16 * 84; t += gridDim.x) {
    int mt = t & 15, nt = t >> 4;
    f32x4 acc[4][4];
    zero_acc(acc);
    gemm_acc(A + (size_t)mt * 256 * 1024, 1024, Bt + (size_t)nt * 128 * 1024, 1024, 1024, acc, smem);
    int nw0 = nt * 128 + wn * 64;
    if (nw0 >= 10688) continue;
#pragma unroll
    for (int mf = 0; mf < 4; ++mf)
#pragma unroll
      for (int nf = 0; nf < 4; ++nf)
#pragma unroll
        for (int j = 0; j < 4; ++j) {
          if (nf == 0 && j == 0) asm volatile("" ::: "memory");
          int m = mt * 256 + wm * 64 + mf * 16 + (lane >> 4) * 4 + j;
          int n = nw0 + nf * 16 + (lane & 15);
          float v = acc[mf][nf][j];
          if (nw0 < 2048) zb[(size_t)m * 2048 + n] = f2bf(v);
          else if (nw0 < 5120) xr[(size_t)m * 3072 + (n - 2048)] = f2bf(v);
          else if (nw0 < 5184) dtb[(size_t)m * 64 + (n - 5120)] = v;
          else if (nw0 < 8640) rwb[(size_t)m * 3456 + (n - 5184)] = f2bf(v);
          else gb[(size_t)m * 2048 + (n - 8640)] = f2bf(v);
        }
  }
}

__device__ __forceinline__ void step_cr1(const Params& p, int g) {
  char* ws = p.ws;
  const int tid = get_tid(), lane = tid & 63, wave = tid >> 6;
  const int Ls = g < 2 ? 256 : 2048;
  {
    const u16* xr = (const u16*)(ws + OFF_XBCRAW);
    u16* xo = (u16*)(ws + OFF_XBC);
    for (int idx = blockIdx.x * NTHR + tid; idx < TG * 384; idx += gridDim.x * NTHR) {
      int r = idx / 384, cc = idx - r * 384;
      int pos = r & (Ls - 1);
      float s[8];
      {
        float4 b0 = *(const float4*)(p.conv_b + cc * 8), b1 = *(const float4*)(p.conv_b + cc * 8 + 4);
        s[0] = b0.x; s[1] = b0.y; s[2] = b0.z; s[3] = b0.w; s[4] = b1.x; s[5] = b1.y; s[6] = b1.z; s[7] = b1.w;
      }
#pragma unroll
      for (int i = 0; i < 5; ++i) {
        int pp = pos + i - 2;
        if (pp >= 0 && pp < Ls) {
          uint4 u = *(const uint4*)(xr + (size_t)(r + i - 2) * 3072 + cc * 8);
          float4 w0 = *(const float4*)(p.conv_w + i * 3072 + cc * 8), w1 = *(const float4*)(p.conv_w + i * 3072 + cc * 8 + 4);
          s[0] += bf2f(u.x & 0xffff) * w0.x; s[1] += bf2f(u.x >> 16) * w0.y;
          s[2] += bf2f(u.y & 0xffff) * w0.z; s[3] += bf2f(u.y >> 16) * w0.w;
          s[4] += bf2f(u.z & 0xffff) * w1.x; s[5] += bf2f(u.z >> 16) * w1.y;
          s[6] += bf2f(u.w & 0xffff) * w1.z; s[7] += bf2f(u.w >> 16) * w1.w;
        }
      }
#pragma unroll
      for (int e = 0; e < 8; ++e) s[e] = siluf(s[e]);
      *(uint4*)(xo + (size_t)r * 3072 + cc * 8) = uint4{pack2(s[0], s[1]), pack2(s[2], s[3]), pack2(s[4], s[5]), pack2(s[6], s[7])};
    }
  }
  {
    const u16* rw = (const u16*)(ws + OFF_RW);
    __half* wk = (__half*)(ws + OFF_WK);
    u16* tl = (u16*)(ws + OFF_TL);
    u16* sg = (u16*)(ws + OFF_SG);
    const bool grid = (g == 2);
    for (int r = blockIdx.x * 8 + wave; r < TG; r += gridDim.x * 8) {
      int pos = r & (Ls - 1);
      for (int it = 0; it < 54; ++it) {
        int c = it * 64 + lane;
        float cur = bf2f(rw[(size_t)r * 3456 + c]);
        int q = c / 864;
        int dr;
        bool ok;
        if (!grid) {
          if (q & 1) { dr = 1; ok = pos < Ls - 1; } else { dr = -1; ok = pos > 0; }
        } else {
          if (q == 0) { dr = -1; ok = (pos & 63) != 0; }
          else if (q == 1) { dr = 1; ok = (pos & 63) != 63; }
          else if (q == 2) { dr = -64; ok = pos >= 64; }
          else { dr = 64; ok = pos < Ls - 64; }
        }
        float sh = ok ? bf2f(rw[(size_t)(r + dr) * 3456 + c]) : 0.f;
        float xx = cur + p.mu_shift[c] * (sh - cur);
        if (it < 16) {
          wk[((size_t)(r * 16 + it) * 8 + 0) * 64 + lane] = __float2half(xx);
        } else if (it == 16) {
          tl[(size_t)r * 256 + lane] = f2bf(tanhf(xx));
        } else if (it == 17) {
          tl[(size_t)r * 256 + 64 + lane] = f2bf(tanhf(xx));
        } else if (it < 34) {
          int h = it - 18;
          float kk = xx * p.k_k[h * 64 + lane];
          float ss = wave_sum(kk * kk);
          float nkk = -kk * rsqrtf(ss + 1e-12f);
          wk[((size_t)(r * 16 + h) * 8 + 2) * 64 + lane] = __float2half(xx);
          wk[((size_t)(r * 16 + h) * 8 + 3) * 64 + lane] = __float2half(nkk);
        } else if (it < 50) {
          int h = it - 34;
          wk[((size_t)(r * 16 + h) * 8 + 1) * 64 + lane] = __float2half(xx);
        } else if (it == 50) {
          tl[(size_t)r * 256 + 128 + lane] = f2bf(xx);
        } else if (it == 51) {
          tl[(size_t)r * 256 + 192 + lane] = f2bf(xx);
        } else {
          sg[(size_t)r * 128 + (it - 52) * 64 + lane] = f2bf(sigm(xx));
        }
      }
    }
  }
}

__device__ __forceinline__ void step_r2(const Params& p, char* smem) {
  char* ws = p.ws;
  const int tid = get_tid(), lane = tid & 63, wave = tid >> 6;
  const int wm = wave >> 1, wn = wave & 1;
  const u16* tl = (const u16*)(ws + OFF_TL);
  const u16* sg = (const u16*)(ws + OFF_SG);
  __half* wk = (__half*)(ws + OFF_WK);
  u16* gr = (u16*)(ws + OFF_GR);
  for (int t = blockIdx.x; t < 5 * 128; t += gridDim.x) {
    int sub = t >> 7, rem = t & 127;
    int mt = rem & 15, nt = rem >> 4;
    f32x4 acc[4][4];
    zero_acc(acc);
    if (sub < 2) {
      gemm_acc(tl + (size_t)mt * 256 * 256 + sub * 64, 256, (const u16*)(ws + OFF_W2T) + sub * 65536 + (size_t)nt * 128 * 64, 64, 64, acc, smem);
    } else if (sub < 4) {
      gemm_acc(tl + (size_t)mt * 256 * 256 + 128 + (sub - 2) * 64, 256, (const u16*)(ws + OFF_A2T) + (sub - 2) * 65536 + (size_t)nt * 128 * 64, 64, 64, acc, smem);
    } else {
      gemm_acc(sg + (size_t)mt * 256 * 128, 128, (const u16*)(ws + OFF_G2T) + (size_t)nt * 128 * 128, 128, 128, acc, smem);
    }
#pragma unroll
    for (int mf = 0; mf < 4; ++mf)
#pragma unroll
      for (int nf = 0; nf < 4; ++nf)
#pragma unroll
        for (int j = 0; j < 4; ++j) {
          if (nf == 0 && j == 0) asm volatile("" ::: "memory");
          int m = mt * 256 + wm * 64 + mf * 16 + (lane >> 4) * 4 + j;
          int n = nt * 128 + wn * 64 + nf * 16 + (lane & 15);
          float v = acc[mf][nf][j];
          if (sub < 2) {
            float wl = v + p.w0[sub * 1024 + n];
            float dec = __expf(-0.6065306597f * sigm(wl));
            wk[((size_t)(m * 16 + (n >> 6)) * 8 + 4 + 2 * sub) * 64 + (n & 63)] = __float2half(dec);
          } else if (sub < 4) {
            int d = sub - 2;
            float a = sigm(v + p.a0[d * 1024 + n]);
            wk[((size_t)(m * 16 + (n >> 6)) * 8 + 5 + 2 * d) * 64 + (n & 63)] = __float2half(a);
          } else {
            gr[(size_t)m * 1024 + n] = f2bf(v);
          }
        }
  }
}

DI int sw256(int row, int e) { return row * 256 + ((((e >> 3) ^ (row & 15))) << 4) + (e & 7) * 2; }
DI const bf16x8 ldfrag256(const char* base, int row, int ch) {
  return *(const bf16x8*)(base + row * 256 + ((ch ^ (row & 15)) << 4));
}

__device__ __forceinline__ void ssd_chain(const Params& p, char* smem, int g, int chain) {
  char* ws = p.ws;
  const int tid = get_tid(), lane = tid & 63, wave = tid >> 6;
  const int Ls = g < 2 ? 256 : 2048;
  const int nch = Ls >> 7;
  const int d = chain & 1, h = (chain >> 1) & 31, b = chain >> 6;
  const int grp = h >> 3;
  const u16* xbc = (const u16*)(ws + OFF_XBC);
  const float* dtb = (const float*)(ws + OFF_DT);
  u16* yout = (u16*)(ws + (d ? OFF_SYB : OFF_SYF));
  char* Cs = smem;
  char* Bs = smem + 32768;
  char* BdT = smem + 65536;
  char* XT = smem + 98304;
  char* Ss = smem + 114688;
  float* csum = (float*)(smem + 131072);
  float* dts = (float*)(smem + 131584);
  const float a_h = -__expf(p.a_log[d * 32 + h]);
  const float dtbias = p.dt_bias[d * 32 + h];
  const int wp = wave >> 2, wn4 = wave & 3;
  f32x4 sacc[2][2];
#pragma unroll
  for (int pf = 0; pf < 2; ++pf)
#pragma unroll
    for (int nf = 0; nf < 2; ++nf) {
      if (g == 2) {
        const float* h0 = (d ? p.ssm_b : p.ssm_f) + (size_t)(b * 32 + h) * 8192;
#pragma unroll
        for (int j = 0; j < 4; ++j) {
          int pp = wp * 32 + pf * 16 + (lane >> 4) * 4 + j;
          int n = wn4 * 32 + nf * 16 + (lane & 15);
          sacc[pf][nf][j] = h0[pp * 128 + n];
        }
      } else {
        sacc[pf][nf] = f32x4{0.f, 0.f, 0.f, 0.f};
      }
    }
  const int tid_outer = tid;
  for (int ci = 0; ci < nch; ++ci) {
    int tidv = tid_outer;
    asm volatile("" : "+v"(tidv));
    const int tid = tidv, lane = tidv & 63, wave = tidv >> 6;
    const int wp = wave >> 2, wn4 = wave & 3;
    const int c = d ? nch - 1 - ci : ci;
    const int tok0 = b * Ls + c * 128;
#pragma unroll
    for (int i = 0; i < 4; ++i) {
      int idx = tid + i * 512;
      int row = idx >> 4, ch = idx & 15;
      const u16* src = xbc + (size_t)(tok0 + row) * 3072 + grp * 128 + ch * 8;
      uint4 cv = *(const uint4*)(src + 2560);
      uint4 bv = *(const uint4*)(src + 2048);
      *(uint4*)(Cs + row * 256 + ((ch ^ (row & 15)) << 4)) = cv;
      *(uint4*)(Bs + row * 256 + ((ch ^ (row & 15)) << 4)) = bv;
    }
#pragma unroll
    for (int i = 0; i < 2; ++i) {
      int idx = tid + i * 512;
      int l = idx >> 3, ch = idx & 7;
      uint4 xv = *(const uint4*)(xbc + (size_t)(tok0 + l) * 3072 + h * 64 + ch * 8);
      unsigned w[4] = {xv.x, xv.y, xv.z, xv.w};
#pragma unroll
      for (int e = 0; e < 8; ++e) {
        int pp = ch * 8 + e;
        u16 val = (u16)((w[e >> 1] >> ((e & 1) * 16)) & 0xffff);
        *(u16*)(XT + sw256(pp, l)) = val;
      }
    }
    if (wave == 0) {
      int e0 = 2 * lane, e1 = 2 * lane + 1;
      int l0 = d ? 127 - e0 : e0, l1 = d ? 127 - e1 : e1;
      float x0 = dtb[(size_t)(tok0 + l0) * 64 + d * 32 + h] + dtbias;
      float x1 = dtb[(size_t)(tok0 + l1) * 64 + d * 32 + h] + dtbias;
      float dt0 = x0 > 20.f ? x0 : log1pf(__expf(x0));
      float dt1 = x1 > 20.f ? x1 : log1pf(__expf(x1));
      float a0 = dt0 * a_h, a1 = dt1 * a_h;
      float s = a0 + a1;
#pragma unroll
      for (int o = 1; o < 64; o <<= 1) {
        float t = __shfl_up(s, o);
        if (lane >= o) s += t;
      }
      csum[l1] = s;
      csum[l0] = s - a1;
      dts[l0] = dt0;
      dts[l1] = dt1;
    }
#pragma unroll
    for (int pf = 0; pf < 2; ++pf)
#pragma unroll
      for (int nf = 0; nf < 2; ++nf)
#pragma unroll
        for (int j = 0; j < 4; ++j) {
          int pp = wp * 32 + pf * 16 + (lane >> 4) * 4 + j;
          int n = wn4 * 32 + nf * 16 + (lane & 15);
          *(u16*)(Ss + sw256(pp, n)) = f2bf(sacc[pf][nf][j]);
        }
    __syncthreads();
    const float cstot = csum[d ? 0 : 127];
#pragma unroll
    for (int i = 0; i < 4; ++i) {
      int idx = tid + i * 512;
      int l = idx >> 4, ch = idx & 15;
      uint4 bv = *(const uint4*)(Bs + l * 256 + ((ch ^ (l & 15)) << 4));
      float f = dts[l] * __expf(cstot - csum[l]);
      unsigned w[4] = {bv.x, bv.y, bv.z, bv.w};
#pragma unroll
      for (int e = 0; e < 8; ++e) {
        int n = ch * 8 + e;
        float val = bf2f((u16)((w[e >> 1] >> ((e & 1) * 16)) & 0xffff)) * f;
        *(u16*)(BdT + sw256(n, l)) = f2bf(val);
      }
    }
    const int wm = wave >> 1, wn2 = wave & 1;
    f32x4 gacc[2][4];
#pragma unroll
    for (int i = 0; i < 2; ++i)
#pragma unroll
      for (int j = 0; j < 4; ++j) gacc[i][j] = f32x4{0.f, 0.f, 0.f, 0.f};
#pragma unroll
    for (int ks = 0; ks < 4; ++ks) {
      int ch = ks * 4 + (lane >> 4);
      bf16x8 a[2], bb[4];
#pragma unroll
      for (int mf = 0; mf < 2; ++mf) a[mf] = ldfrag256(Cs, wm * 32 + mf * 16 + (lane & 15), ch);
#pragma unroll
      for (int nf = 0; nf < 4; ++nf) bb[nf] = ldfrag256(Bs, wn2 * 64 + nf * 16 + (lane & 15), ch);
#pragma unroll
      for (int mf = 0; mf < 2; ++mf)
#pragma unroll
        for (int nf = 0; nf < 4; ++nf)
          gacc[mf][nf] = __builtin_amdgcn_mfma_f32_16x16x32_bf16(a[mf], bb[nf], gacc[mf][nf], 0, 0, 0);
    }
    {
      float csl[2][4];
#pragma unroll
      for (int mf = 0; mf < 2; ++mf)
#pragma unroll
        for (int j = 0; j < 4; ++j) csl[mf][j] = csum[wm * 32 + mf * 16 + (lane >> 4) * 4 + j];
#pragma unroll
      for (int nf = 0; nf < 4; ++nf) {
        int s = wn2 * 64 + nf * 16 + (lane & 15);
        float css = csum[s], dss = dts[s];
#pragma unroll
        for (int mf = 0; mf < 2; ++mf)
#pragma unroll
          for (int j = 0; j < 4; ++j) {
            int l = wm * 32 + mf * 16 + (lane >> 4) * 4 + j;
            bool valid = d ? (s >= l) : (s <= l);
            float e = valid ? __expf(csl[mf][j] - css) * dss : 0.f;
            gacc[mf][nf][j] *= e;
          }
      }
    }
    __syncthreads();
#pragma unroll
    for (int mf = 0; mf < 2; ++mf)
#pragma unroll
      for (int nf = 0; nf < 4; ++nf)
#pragma unroll
        for (int j = 0; j < 4; ++j) {
          int l = wm * 32 + mf * 16 + (lane >> 4) * 4 + j;
          int s = wn2 * 64 + nf * 16 + (lane & 15);
          *(u16*)(Bs + sw256(l, s)) = f2bf(gacc[mf][nf][j]);
        }
    __syncthreads();
    {
      f32x4 yacc[2][2];
#pragma unroll
      for (int i = 0; i < 2; ++i)
#pragma unroll
        for (int j = 0; j < 2; ++j) yacc[i][j] = f32x4{0.f, 0.f, 0.f, 0.f};
#pragma unroll
      for (int ks = 0; ks < 4; ++ks) {
        int ch = ks * 4 + (lane >> 4);
        bf16x8 a[2], bb[2];
#pragma unroll
        for (int mf = 0; mf < 2; ++mf) a[mf] = ldfrag256(Cs, wm * 32 + mf * 16 + (lane & 15), ch);
#pragma unroll
        for (int nf = 0; nf < 2; ++nf) bb[nf] = ldfrag256(Ss, wn2 * 32 + nf * 16 + (lane & 15), ch);
#pragma unroll
        for (int mf = 0; mf < 2; ++mf)
#pragma unroll
          for (int nf = 0; nf < 2; ++nf)
            yacc[mf][nf] = __builtin_amdgcn_mfma_f32_16x16x32_bf16(a[mf], bb[nf], yacc[mf][nf], 0, 0, 0);
      }
#pragma unroll
      for (int mf = 0; mf < 2; ++mf)
#pragma unroll
        for (int j = 0; j < 4; ++j) {
          float e = __expf(csum[wm * 32 + mf * 16 + (lane >> 4) * 4 + j]);
#pragma unroll
          for (int nf = 0; nf < 2; ++nf) yacc[mf][nf][j] *= e;
        }
#pragma unroll
      for (int ks = 0; ks < 4; ++ks) {
        int ch = ks * 4 + (lane >> 4);
        bf16x8 a[2], bb[2];
#pragma unroll
        for (int mf = 0; mf < 2; ++mf) a[mf] = ldfrag256(Bs, wm * 32 + mf * 16 + (lane & 15), ch);
#pragma unroll
        for (int nf = 0; nf < 2; ++nf) bb[nf] = ldfrag256(XT, wn2 * 32 + nf * 16 + (lane & 15), ch);
#pragma unroll
        for (int mf = 0; mf < 2; ++mf)
#pragma unroll
          for (int nf = 0; nf < 2; ++nf)
            yacc[mf][nf] = __builtin_amdgcn_mfma_f32_16x16x32_bf16(a[mf], bb[nf], yacc[mf][nf], 0, 0, 0);
      }
#pragma unroll
      for (int mf = 0; mf < 2; ++mf)
#pragma unroll
        for (int nf = 0; nf < 2; ++nf)
#pragma unroll
          for (int j = 0; j < 4; ++j) {
            int l = wm * 32 + mf * 16 + (lane >> 4) * 4 + j;
            int pp = wn2 * 32 + nf * 16 + (lane & 15);
            yout[(size_t)(tok0 + l) * 2048 + h * 64 + pp] = f2bf(yacc[mf][nf][j]);
          }
    }
    {
      float e = __expf(cstot);
#pragma unroll
      for (int pf = 0; pf < 2; ++pf)
#pragma unroll
        for (int nf = 0; nf < 2; ++nf) sacc[pf][nf] *= e;
#pragma unroll
      for (int ks = 0; ks < 4; ++ks) {
        int ch = ks * 4 + (lane >> 4);
        bf16x8 a[2], bb[2];
#pragma unroll
        for (int pf = 0; pf < 2; ++pf) a[pf] = ldfrag256(XT, wp * 32 + pf * 16 + (lane & 15), ch);
#pragma unroll
        for (int nf = 0; nf < 2; ++nf) bb[nf] = ldfrag256(BdT, wn4 * 32 + nf * 16 + (lane & 15), ch);
#pragma unroll
        for (int pf = 0; pf < 2; ++pf)
#pragma unroll
          for (int nf = 0; nf < 2; ++nf)
            sacc[pf][nf] = __builtin_amdgcn_mfma_f32_16x16x32_bf16(a[pf], bb[nf], sacc[pf][nf], 0, 0, 0);
      }
    }
    __syncthreads();
  }
  if (g < 2) {
    float* so = p.out + (d ? OUT_SSMB : OUT_SSMF) + (size_t)((g * 16 + b) * 32 + h) * 8192;
#pragma unroll
    for (int pf = 0; pf < 2; ++pf)
#pragma unroll
      for (int nf = 0; nf < 2; ++nf)
#pragma unroll
        for (int j = 0; j < 4; ++j) {
          int pp = wp * 32 + pf * 16 + (lane >> 4) * 4 + j;
          int n = wn4 * 32 + nf * 16 + (lane & 15);
          so[pp * 128 + n] = sacc[pf][nf][j];
        }
  }
}

DI float dpp_xor1(float v) { return __shfl_xor(v, 1); }
DI float dpp_xor2(float v) { return __shfl_xor(v, 2); }

__device__ __forceinline__ void wkv_pair(const Params& p, char* smem, int g, int chain0, int nact) {
  char* ws = p.ws;
  const int tid = get_tid(), lane = tid & 63, wave = tid >> 6;
  const int Ls = g < 2 ? 256 : 2048;
  const int ntb = Ls >> 4;
  const __half* wk = (const __half*)(ws + OFF_WK);
  float* stage = (float*)smem;
  float* ylds = (float*)(smem + 98304);
  const int slot = wave >> 2, wq = wave & 3;
  const int ig = lane >> 2, jg = lane & 3;
  const int row = wq * 16 + ig;
  const bool act = slot < nact;
  const int chain = chain0 + (act ? slot : 0);
  const int d = chain & 1, h = (chain >> 1) & 15, b = chain >> 5;
  float S[16];
  if (g == 2) {
    const float* s0 = (d ? p.wkv_b : p.wkv_f) + ((size_t)(b * 16 + h) * 64 + row) * 64 + jg * 16;
#pragma unroll
    for (int c = 0; c < 16; ++c) S[c] = s0[c];
  } else {
#pragma unroll
    for (int c = 0; c < 16; ++c) S[c] = 0.f;
  }
  const int pair = tid >> 4, lslot = pair >> 4, lstep = pair & 15, sub = tid & 15;
  const bool lact = lslot < nact;
  const int lchain = chain0 + (lact ? lslot : 0);
  const int ld = lchain & 1, lh = (lchain >> 1) & 15, lb = lchain >> 5;
  float ka[4];
#pragma unroll
  for (int e = 0; e < 4; ++e) ka[e] = p.k_a[lh * 64 + sub * 4 + e];
  u16* yout = (u16*)(ws + (ld ? OFF_WYB : OFF_WYF));
  uint2 rg[6];
  auto prefetch = [&](int tb) {
    int s = tb * 16 + lstep;
    int pos = ld ? Ls - 1 - s : s;
    int r = lb * Ls + pos;
    const __half* rec = wk + ((size_t)(r * 16 + lh) * 8) * 64 + sub * 4;
    rg[0] = *(const uint2*)(rec + 0 * 64);
    rg[1] = *(const uint2*)(rec + 1 * 64);
    rg[2] = *(const uint2*)(rec + 2 * 64);
    rg[3] = *(const uint2*)(rec + 3 * 64);
    rg[4] = *(const uint2*)(rec + (4 + 2 * ld) * 64);
    rg[5] = *(const uint2*)(rec + (5 + 2 * ld) * 64);
  };
  auto unpack4 = [&](uint2 u, float (&o)[4]) {
    __half2 h0 = *reinterpret_cast<__half2*>(&u.x);
    __half2 h1 = *reinterpret_cast<__half2*>(&u.y);
    float2 f0 = __half22float2(h0), f1 = __half22float2(h1);
    o[0] = f0.x; o[1] = f0.y; o[2] = f1.x; o[3] = f1.y;
  };
  auto stage_store = [&](int buf) {
    float r_[4], v_[4], k_[4], nkk_[4], w_[4], a_[4];
    unpack4(rg[0], r_); unpack4(rg[1], v_); unpack4(rg[2], k_); unpack4(rg[3], nkk_); unpack4(rg[4], w_); unpack4(rg[5], a_);
    float b_[4], kd_[4];
#pragma unroll
    for (int e = 0; e < 4; ++e) {
      b_[e] = -nkk_[e] * a_[e];
      kd_[e] = k_[e] * (1.f + (a_[e] - 1.f) * ka[e]);
    }
    float* dst = stage + ((size_t)((buf * 2 + lslot) * 16 + lstep) * 6) * 64 + sub * 4;
    *(float4*)(dst + 0 * 64) = float4{nkk_[0], nkk_[1], nkk_[2], nkk_[3]};
    *(float4*)(dst + 1 * 64) = float4{w_[0], w_[1], w_[2], w_[3]};
    *(float4*)(dst + 2 * 64) = float4{b_[0], b_[1], b_[2], b_[3]};
    *(float4*)(dst + 3 * 64) = float4{kd_[0], kd_[1], kd_[2], kd_[3]};
    *(float4*)(dst + 4 * 64) = float4{r_[0], r_[1], r_[2], r_[3]};
    *(float4*)(dst + 5 * 64) = float4{v_[0], v_[1], v_[2], v_[3]};
  };
  prefetch(0);
  stage_store(0);
  __syncthreads();
  for (int tb = 0; tb < ntb; ++tb) {
    const bool more = tb + 1 < ntb;
    if (more) prefetch(tb + 1);
    if (act) {
      const float* sb = stage + ((size_t)(((tb & 1) * 2 + slot) * 16) * 6) * 64;
      for (int st = 0; st < 16; ++st) {
        const float* v6 = sb + st * 384 + jg * 16;
        float nkk[16], w[16], bb[16], kd[16], rr[16];
#pragma unroll
        for (int q = 0; q < 4; ++q) {
          float4 t0 = *(const float4*)(v6 + 0 * 64 + q * 4);
          nkk[q * 4] = t0.x; nkk[q * 4 + 1] = t0.y; nkk[q * 4 + 2] = t0.z; nkk[q * 4 + 3] = t0.w;
          float4 t1 = *(const float4*)(v6 + 1 * 64 + q * 4);
          w[q * 4] = t1.x; w[q * 4 + 1] = t1.y; w[q * 4 + 2] = t1.z; w[q * 4 + 3] = t1.w;
          float4 t2 = *(const float4*)(v6 + 2 * 64 + q * 4);
          bb[q * 4] = t2.x; bb[q * 4 + 1] = t2.y; bb[q * 4 + 2] = t2.z; bb[q * 4 + 3] = t2.w;
          float4 t3 = *(const float4*)(v6 + 3 * 64 + q * 4);
          kd[q * 4] = t3.x; kd[q * 4 + 1] = t3.y; kd[q * 4 + 2] = t3.z; kd[q * 4 + 3] = t3.w;
          float4 t4 = *(const float4*)(v6 + 4 * 64 + q * 4);
          rr[q * 4] = t4.x; rr[q * 4 + 1] = t4.y; rr[q * 4 + 2] = t4.z; rr[q * 4 + 3] = t4.w;
        }
        float vi = sb[st * 384 + 5 * 64 + row];
        float sa = 0.f;
#pragma unroll
        for (int c = 0; c < 16; ++c) sa += S[c] * nkk[c];
        sa += dpp_xor1(sa);
        sa += dpp_xor2(sa);
        float y = 0.f;
#pragma unroll
        for (int c = 0; c < 16; ++c) {
          S[c] = S[c] * w[c] + (sa * bb[c] + vi * kd[c]);
          y += S[c] * rr[c];
        }
        y += dpp_xor1(y);
        y += dpp_xor2(y);
        if (jg == 0) ylds[(slot * 16 + st) * 64 + row] = y;
      }
    }
    __syncthreads();
    if (more) stage_store((tb + 1) & 1);
    if (lact) {
      int s = tb * 16 + lstep;
      int pos = ld ? Ls - 1 - s : s;
      int r = lb * Ls + pos;
      float4 yv = *(const float4*)(ylds + (lslot * 16 + lstep) * 64 + sub * 4);
      *(uint2*)(yout + (size_t)r * 1024 + lh * 64 + sub * 4) = uint2{pack2(yv.x, yv.y), pack2(yv.z, yv.w)};
    }
    __syncthreads();
  }
  if (g < 2 && act) {
    float* so = p.out + (d ? OUT_WKVB : OUT_WKVF) + ((size_t)((g * 16 + b) * 16 + h) * 64 + row) * 64 + jg * 16;
#pragma unroll
    for (int c = 0; c < 16; ++c) so[c] = S[c];
  }
}

__device__ __forceinline__ void step_scan(const Params& p, char* smem, int g) {
  const int G = gridDim.x;
  if (g < 2) {
    if (SM & 8192) for (int ch = blockIdx.x; ch < 1024; ch += G) ssd_chain(p, smem, g, ch);
    if (SM & 16384) for (int it = blockIdx.x; it < 256; it += G) wkv_pair(p, smem, g, it * 2, 2);
  } else {
    if (SM & 8192) for (int ch = blockIdx.x; ch < 128; ch += G) ssd_chain(p, smem, g, ch);
    if (SM & 16384) for (int it = (G - 1 - blockIdx.x); it < 64; it += G) wkv_pair(p, smem, g, it, 1);
  }
}

__device__ __forceinline__ void step_fin(const Params& p, int g) {
  char* ws = p.ws;
  const int tid = get_tid(), lane = tid & 63, wave = tid >> 6;
  const int gw = blockIdx.x * 8 + wave, nw = gridDim.x * 8;
  {
    const u16* yf = (const u16*)(ws + OFF_SYF);
    const u16* yb = (const u16*)(ws + OFF_SYB);
    const u16* xbc = (const u16*)(ws + OFF_XBC);
    const u16* zb = (const u16*)(ws + OFF_Z);
    u16* ym = (u16*)(ws + OFF_YM);
    for (int it = gw; it < TG * 4; it += nw) {
      int r = it >> 2, gq = it & 3;
      int ch = gq * 512 + lane * 8;
      uint4 a = *(const uint4*)(yf + (size_t)r * 2048 + ch);
      uint4 b = *(const uint4*)(yb + (size_t)r * 2048 + ch);
      uint4 x = *(const uint4*)(xbc + (size_t)r * 3072 + ch);
      uint4 z = *(const uint4*)(zb + (size_t)r * 2048 + ch);
      float dsk = p.d_skip[ch >> 6];
      unsigned aw[4] = {a.x, a.y, a.z, a.w}, bw[4] = {b.x, b.y, b.z, b.w}, xw[4] = {x.x, x.y, x.z, x.w}, zw[4] = {z.x, z.y, z.z, z.w};
      float y[8];
      float ss = 0.f;
#pragma unroll
      for (int e = 0; e < 8; ++e) {
        int sh = (e & 1) * 16;
        float yy = bf2f((u16)(aw[e >> 1] >> sh)) + bf2f((u16)(bw[e >> 1] >> sh)) + dsk * bf2f((u16)(xw[e >> 1] >> sh));
        yy *= siluf(bf2f((u16)(zw[e >> 1] >> sh)));
        y[e] = yy;
        ss += yy * yy;
      }
      ss = wave_sum(ss);
      float rinv = rsqrtf(ss * (1.f / 512.f) + 1e-5f);
      float4 w0 = *(const float4*)(p.m_norm_w + ch), w1 = *(const float4*)(p.m_norm_w + ch + 4);
      *(uint4*)(ym + (size_t)r * 2048 + ch) =
          uint4{pack2(y[0] * rinv * w0.x, y[1] * rinv * w0.y), pack2(y[2] * rinv * w0.z, y[3] * rinv * w0.w),
                pack2(y[4] * rinv * w1.x, y[5] * rinv * w1.y), pack2(y[6] * rinv * w1.z, y[7] * rinv * w1.w)};
    }
  }
  {
    const u16* yf = (const u16*)(ws + OFF_WYF);
    const u16* yb = (const u16*)(ws + OFF_WYB);
    const __half* wk = (const __half*)(ws + OFF_WK);
    const u16* gr = (const u16*)(ws + OFF_GR);
    u16* yr = (u16*)(ws + OFF_YR);
    for (int it = gw; it < TG * 16; it += nw) {
      int r = it >> 4, h = it & 15;
      int c = h * 64 + lane;
      float y = bf2f(yf[(size_t)r * 1024 + c]) + bf2f(yb[(size_t)r * 1024 + c]);
      float mean = wave_sum(y) * (1.f / 64.f);
      float dy = y - mean;
      float var = wave_sum(dy * dy) * (1.f / 64.f);
      float yn = dy * rsqrtf(var + 64e-5f) * p.lnx_w[c] + p.lnx_b[c];
      const __half* rec = wk + ((size_t)(r * 16 + h) * 8) * 64 + lane;
      float rr = __half2float(rec[0]), vv = __half2float(rec[64]), kk = __half2float(rec[128]);
      float af = __half2float(rec[5 * 64]), ab = __half2float(rec[7 * 64]);
      float kmean = kk * (1.f + (0.5f * (af + ab) - 1.f) * p.k_a[c]);
      float bs = wave_sum(rr * kmean * p.r_k[c]);
      float o = (yn + bs * vv) * bf2f(gr[(size_t)r * 1024 + c]);
      yr[(size_t)r * 1024 + c] = f2bf(o);
    }
  }
}

__device__ __forceinline__ void step_outproj(const Params& p, char* smem) {
  char* ws = p.ws;
  const int tid = get_tid(), lane = tid & 63, wave = tid >> 6;
  const int wm = wave >> 1, wn = wave & 1;
  const u16* ym = (const u16*)(ws + OFF_YM);
  const u16* yr = (const u16*)(ws + OFF_YR);
  const u16* gb = (const u16*)(ws + OFF_GATE);
  u16* U = (u16*)(ws + OFF_U);
  for (int t = blockIdx.x; t < 128; t += gridDim.x) {
    int mt = t & 15, nt = t >> 4;
    f32x4 acc[4][4];
    zero_acc(acc);
    gemm_acc(ym + (size_t)mt * 256 * 2048, 2048, (const u16*)(ws + OFF_WMOUT) + (size_t)nt * 128 * 2048, 2048, 2048, acc, smem);
#pragma unroll
    for (int mf = 0; mf < 4; ++mf)
#pragma unroll
      for (int nf = 0; nf < 4; ++nf)
#pragma unroll
        for (int j = 0; j < 4; ++j) {
          if (nf == 0 && j == 0) asm volatile("" ::: "memory");
          int m = mt * 256 + wm * 64 + mf * 16 + (lane >> 4) * 4 + j;
          int n = nt * 128 + wn * 64 + nf * 16 + (lane & 15);
          U[(size_t)m * 1024 + n] = f2bf(sigm(bf2f(gb[(size_t)m * 2048 + n])) * acc[mf][nf][j]);
        }
  }
  for (int t = blockIdx.x; t < 128; t += gridDim.x) {
    int mt = t & 15, nt = t >> 4;
    f32x4 acc[4][4];
    zero_acc(acc);
    gemm_acc(yr + (size_t)mt * 256 * 1024, 1024, (const u16*)(ws + OFF_WROUT) + (size_t)nt * 128 * 1024, 1024, 1024, acc, smem);
#pragma unroll
    for (int mf = 0; mf < 4; ++mf)
#pragma unroll
      for (int nf = 0; nf < 4; ++nf)
#pragma unroll
        for (int j = 0; j < 4; ++j) {
          if (nf == 0 && j == 0) asm volatile("" ::: "memory");
          int m = mt * 256 + wm * 64 + mf * 16 + (lane >> 4) * 4 + j;
          int n = nt * 128 + wn * 64 + nf * 16 + (lane & 15);
          float v = bf2f(U[(size_t)m * 1024 + n]) + sigm(bf2f(gb[(size_t)m * 2048 + 1024 + n])) * acc[mf][nf][j];
          U[(size_t)m * 1024 + n] = f2bf(v);
        }
  }
}

__device__ __forceinline__ void step_wo(const Params& p, char* smem, int g) {
  char* ws = p.ws;
  const int tid = get_tid(), lane = tid & 63, wave = tid >> 6;
  const int wm = wave >> 1, wn = wave & 1;
  const u16* U = (const u16*)(ws + OFF_U);
  const float* mod = (const float*)(ws + OFF_MOD);
  for (int t = blockIdx.x; t < 128; t += gridDim.x) {
    int mt = t & 15, nt = t >> 4;
    f32x4 acc[4][4];
    zero_acc(acc);
    gemm_acc(U + (size_t)mt * 256 * 1024, 1024, (const u16*)(ws + OFF_WO) + (size_t)nt * 128 * 1024, 1024, 1024, acc, smem);
#pragma unroll
    for (int mf = 0; mf < 4; ++mf)
#pragma unroll
      for (int nf = 0; nf < 4; ++nf)
#pragma unroll
        for (int j = 0; j < 4; ++j) {
          if (nf == 0 && j == 0) asm volatile("" ::: "memory");
          int m = mt * 256 + wm * 64 + mf * 16 + (lane >> 4) * 4 + j;
          int n = nt * 128 + wn * 64 + nf * 16 + (lane & 15);
          int tok = g * TG + m;
          const float* xr = tok < 8192 ? p.x_prompt + (size_t)tok * 1024 : p.x_sample + (size_t)(tok - 8192) * 1024;
          float gt1 = mod[mrow_of(tok) * 6144 + 2048 + n];
          p.out[(size_t)tok * 1024 + n] = xr[n] + gt1 * acc[mf][nf][j];
        }
  }
}

__device__ __forceinline__ void step_gu(const Params& p, char* smem) {
  char* ws = p.ws;
  const int tid = get_tid(), lane = tid & 63, wave = tid >> 6;
  const int wm = wave >> 1, wn = wave & 1;
  const u16* H2 = (const u16*)(ws + OFF_H2);
  u16* act = (u16*)(ws + OFF_ACT);
  for (int t = blockIdx.x; t < 48 * 44; t += gridDim.x) {
    int mt = t % 48, nt = t / 48;
    f32x4 acc[4][4];
    zero_acc(acc);
    gemm_acc(H2 + (size_t)mt * 256 * 1024, 1024, (const u16*)(ws + OFF_WGU) + (size_t)nt * 128 * 1024, 1024, 1024, acc, smem);
#pragma unroll
    for (int mf = 0; mf < 4; ++mf)
#pragma unroll
      for (int nf = 0; nf < 2; ++nf)
#pragma unroll
        for (int j = 0; j < 4; ++j) {
          if (nf == 0 && j == 0) asm volatile("" ::: "memory");
          int m = mt * 256 + wm * 64 + mf * 16 + (lane >> 4) * 4 + j;
          int n = nt * 64 + wn * 32 + nf * 16 + (lane & 15);
          float gg = acc[mf][nf][j], uu = acc[mf][nf + 2][j];
          act[(size_t)m * 2816 + n] = f2bf(siluf(gg) * uu);
        }
  }
}

__device__ __forceinline__ void step_down(const Params& p, char* smem) {
  char* ws = p.ws;
  const int tid = get_tid(), lane = tid & 63, wave = tid >> 6;
  const int wm = wave >> 1, wn = wave & 1;
  const u16* act = (const u16*)(ws + OFF_ACT);
  const float* mod = (const float*)(ws + OFF_MOD);
  for (int t = blockIdx.x; t < 48 * 8; t += gridDim.x) {
    int mt = t % 48, nt = t / 48;
    f32x4 acc[4][4];
    zero_acc(acc);
    gemm_acc(act + (size_t)mt * 256 * 2816, 2816, (const u16*)(ws + OFF_WDOWN) + (size_t)nt * 128 * 2816, 2816, 2816, acc, smem);
#pragma unroll
    for (int mf = 0; mf < 4; ++mf)
#pragma unroll
      for (int nf = 0; nf < 4; ++nf)
#pragma unroll
        for (int j = 0; j < 4; ++j) {
          if (nf == 0 && j == 0) asm volatile("" ::: "memory");
          int m = mt * 256 + wm * 64 + mf * 16 + (lane >> 4) * 4 + j;
          int n = nt * 128 + wn * 64 + nf * 16 + (lane & 15);
          float gt2 = mod[mrow_of(m) * 6144 + 5120 + n];
          p.out[(size_t)m * 1024 + n] += gt2 * acc[mf][nf][j];
        }
  }
}

__device__ __forceinline__ void step_final(const Params& p) {
  const int tid = get_tid(), lane = tid & 63, wave = tid >> 6;
  for (int r = blockIdx.x * 8 + wave; r < NTOK; r += gridDim.x * 8) {
    float* xr = p.out + (size_t)r * 1024;
    float4 v[4];
    float ss = 0.f;
#pragma unroll
    for (int i = 0; i < 4; ++i) {
      v[i] = ((const float4*)xr)[i * 64 + lane];
      ss += v[i].x * v[i].x + v[i].y * v[i].y + v[i].z * v[i].z + v[i].w * v[i].w;
    }
    ss = wave_sum(ss);
    float rinv = rsqrtf(ss * (1.f / 1024.f) + 1e-6f);
#pragma unroll
    for (int i = 0; i < 4; ++i) {
      float4 w4 = ((const float4*)p.final_norm_w)[i * 64 + lane];
      ((float4*)xr)[i * 64 + lane] = float4{v[i].x * rinv * w4.x, v[i].y * rinv * w4.y, v[i].z * rinv * w4.z, v[i].w * rinv * w4.w};
    }
  }
}

constexpr int NSTEPS = 29;

__global__ void __launch_bounds__(NTHR) mega(Params p) {
  __shared__ __attribute__((aligned(16))) char smem[SMEM_BYTES];
#if !MULTI_LAUNCH
  if (threadIdx.x == 0) *(uint4*)(smem + SMEM_BYTES - 16) = uint4{0u, 0u, 0u, 0u};
  __syncthreads();
  XcdBarrier xb = xcd_barrier_post((unsigned*)(p.ws + OFF_BAR), (volatile LAS unsigned*)(smem + SMEM_BYTES - 16));
#endif
  for (int step = p.step_lo; step <= p.step_hi; ++step) {
    const int scode = step == 0 ? 0 : (step <= 24 ? 1 + ((step - 1) & 7) : step - 16);
    const int reps = ((RM >> scode) & 1) ? 2 : 1;
    for (int rep = 0; rep < reps; ++rep)
    if (step == 0) { if (SM & 1) step_prep(p, smem); }
    else if (step <= 24) {
      int g = (step - 1) >> 3, s = (step - 1) & 7;
      switch (s) {
        case 0: if (SM & 2) step_norm<0>(p, g); break;
        case 1: if (SM & 4) step_gemm1(p, smem); break;
        case 2: if (SM & 8) step_cr1(p, g); break;
        case 3: if (SM & 16) step_r2(p, smem); break;
        case 4: if (SM & 32) step_scan(p, smem, g); break;
        case 5: if (SM & 64) step_fin(p, g); break;
        case 6: if (SM & 128) step_outproj(p, smem); break;
        default: if (SM & 256) step_wo(p, smem, g); break;
      }
    } else if (step == 25) { if (SM & 512) step_norm<1>(p, 0); }
    else if (step == 26) { if (SM & 1024) step_gu(p, smem); }
    else if (step == 27) { if (SM & 2048) step_down(p, smem); }
    else { if (SM & 4096) step_final(p); }
    if (step < p.step_hi) {
#if !MULTI_LAUNCH
      if (step == p.step_lo) cg::this_grid().sync();
      else for (int xs = 0; xs < 1 + XSYNC; ++xs) xcd_barrier(xb);
#endif
    }
  }
}

extern "C" void kernel_launch(void* const* d_in, const int* in_sizes, int n_in, void* d_out, int out_size,
                              void* d_ws, size_t ws_size, hipStream_t stream) {
  Params p{};
  const float** pp = (const float**)&p;
  for (int i = 0; i < 36; ++i) pp[i] = (const float*)d_in[i];
  p.out = (float*)d_out;
  p.ws = (char*)d_ws;
  if (ws_size < WS_NEED) fprintf(stderr, "workspace too small: %zu < %zu\n", ws_size, (size_t)WS_NEED);
#if MULTI_LAUNCH
  for (int s = 0; s < NSTEPS; ++s) {
    p.step_lo = s;
    p.step_hi = s;
    hipLaunchKernelGGL(mega, dim3(256), dim3(NTHR), 0, stream, p);
  }
#else
  static int grid_blocks = 0;
  if (!grid_blocks) {
    int dev = 0, cus = 0, per_cu = 0;
    hipGetDevice(&dev);
    hipDeviceGetAttribute(&cus, hipDeviceAttributeMultiprocessorCount, dev);
    hipOccupancyMaxActiveBlocksPerMultiprocessor(&per_cu, mega, NTHR, 0);
    if (per_cu < 1) per_cu = 1;
    if (per_cu > 1) per_cu = 1;
    grid_blocks = cus * per_cu;
  }
  p.step_lo = 0;
  p.step_hi = NSTEPS - 1;
  void* args[] = {&p};
  hipMemsetAsync((char*)d_ws + OFF_BAR, 0, XCD_BAR_WORDS_C * 4, stream);
  hipError_t e = hipLaunchCooperativeKernel((void*)mega, dim3(grid_blocks), dim3(NTHR), args, 0, stream);
  if (e != hipSuccess) fprintf(stderr, "cooperative launch failed: %s (grid %d)\n", hipGetErrorString(e), grid_blocks);
#endif
}
```

```cpp
#include <hip/hip_runtime.h>
#include <hip/hip_cooperative_groups.h>
#include <hip/hip_fp16.h>
#include <cstdio>
#include <cstdint>
namespace cg = cooperative_groups;

#ifndef MULTI_LAUNCH
#define MULTI_LAUNCH 0
#endif

#define DI __device__ __forceinline__
typedef __attribute__((ext_vector_type(8))) short bf16x8;
typedef __attribute__((ext_vector_type(4))) float f32x4;
typedef unsigned short u16;

#ifndef STEP_MASK
#define STEP_MASK 0xffffff
#endif
constexpr int SM = STEP_MASK;
#ifndef REPEAT_MASK
#define REPEAT_MASK 0
#endif
#ifndef XSYNC
#define XSYNC 0
#endif
constexpr int RM = REPEAT_MASK;
constexpr int TG = 4096;
constexpr int NTOK = 12288;
constexpr int NPAD = 10752;
constexpr int NTHR = 512;
constexpr int SMEM_BYTES = 133120;
constexpr int XCD_BAR_WORDS_C = 3456;

constexpr size_t OFF_WIN = 0;
constexpr size_t OFF_WGU = OFF_WIN + (size_t)NPAD * 1024 * 2;
constexpr size_t OFF_WDOWN = OFF_WGU + (size_t)5632 * 1024 * 2;
constexpr size_t OFF_WMOUT = OFF_WDOWN + (size_t)1024 * 2816 * 2;
constexpr size_t OFF_WROUT = OFF_WMOUT + (size_t)1024 * 2048 * 2;
constexpr size_t OFF_WO = OFF_WROUT + (size_t)1024 * 1024 * 2;
constexpr size_t OFF_W2T = OFF_WO + (size_t)1024 * 1024 * 2;
constexpr size_t OFF_A2T = OFF_W2T + 262144;
constexpr size_t OFF_G2T = OFF_A2T + 262144;
constexpr size_t OFF_MOD = OFF_G2T + 262144;
constexpr size_t OFF_GRP = OFF_MOD + 73728;
constexpr size_t OFF_Z = OFF_GRP;
constexpr size_t OFF_GATE = OFF_Z + (size_t)TG * 2048 * 2;
constexpr size_t OFF_XBC = OFF_GATE + (size_t)TG * 2048 * 2;
constexpr size_t OFF_WK = OFF_XBC + (size_t)TG * 3072 * 2;
constexpr size_t OFF_GR = OFF_WK + (size_t)TG * 16 * 1024;
constexpr size_t OFF_DT = OFF_GR + (size_t)TG * 1024 * 2;
constexpr size_t OFF_TL = OFF_DT + (size_t)TG * 64 * 4;
constexpr size_t OFF_SG = OFF_TL + (size_t)TG * 256 * 2;
constexpr size_t OFF_R = OFF_SG + (size_t)TG * 128 * 2;
constexpr size_t OFF_H1 = OFF_R;
constexpr size_t OFF_XBCRAW = OFF_H1 + (size_t)TG * 1024 * 2;
constexpr size_t OFF_RW = OFF_XBCRAW + (size_t)TG * 3072 * 2;
constexpr size_t OFF_SYF = OFF_R;
constexpr size_t OFF_SYB = OFF_SYF + (size_t)TG * 2048 * 2;
constexpr size_t OFF_WYF = OFF_SYB + (size_t)TG * 2048 * 2;
constexpr size_t OFF_WYB = OFF_WYF + (size_t)TG * 1024 * 2;
constexpr size_t OFF_YM = OFF_WYB + (size_t)TG * 1024 * 2;
constexpr size_t OFF_YR = OFF_YM + (size_t)TG * 2048 * 2;
constexpr size_t OFF_END = OFF_YR + (size_t)TG * 1024 * 2;
constexpr size_t OFF_BAR = OFF_END;
constexpr size_t WS_NEED = OFF_BAR + XCD_BAR_WORDS_C * 4;
constexpr size_t OFF_U = OFF_XBC;
constexpr size_t OFF_H2 = OFF_GRP;
constexpr size_t OFF_ACT = OFF_H2 + (size_t)NTOK * 1024 * 2;

constexpr size_t OUT_SSMF = 12582912;
constexpr size_t OUT_SSMB = OUT_SSMF + 8388608;
constexpr size_t OUT_WKVF = OUT_SSMB + 8388608;
constexpr size_t OUT_WKVB = OUT_WKVF + 2097152;

struct Params {
  const float *x_prompt, *x_sample, *ssm_f, *ssm_b, *wkv_f, *wkv_b, *c, *c_ctx, *norm1_w, *norm2_w,
      *w_ada, *b_ada, *w_in, *conv_w, *conv_b, *dt_bias, *a_log, *d_skip, *m_norm_w, *mu_shift, *w0,
      *w2, *a0, *a2, *g2, *k_k, *k_a, *r_k, *lnx_w, *lnx_b, *w_m_out, *w_r_out, *w_o, *w_gu, *w_down,
      *final_norm_w;
  float* out;
  char* ws;
  int step_lo, step_hi;
};

DI int get_tid() {
  int t = threadIdx.x;
  asm volatile("" : "+v"(t));
  return t;
}
DI u16 f2bf(float f) {
  unsigned u = __float_as_uint(f);
  u += 0x7fffu + ((u >> 16) & 1u);
  return (u16)(u >> 16);
}
DI float bf2f(u16 h) { return __uint_as_float(((unsigned)h) << 16); }
DI float siluf(float x) { return x / (1.f + __expf(-x)); }
DI float sigm(float x) { return 1.f / (1.f + __expf(-x)); }
DI float wave_sum(float v) {
#pragma unroll
  for (int o = 32; o > 0; o >>= 1) v += __shfl_xor(v, o);
  return v;
}
DI unsigned pack2(float a, float b) { return (unsigned)f2bf(a) | ((unsigned)f2bf(b) << 16); }
DI int mrow_of(int tok) { return tok < 8192 ? 0 : 1 + ((tok - 8192) >> 11); }


#define XB_TMO      128
#define XB_XCNT(j)  (256  + 64 * (j))
#define XB_XSUB(j)  (1280 + 64 * (j))
#define XB_XGEN(j)  (2304 + 64 * (j))
#define XB_TOP      3328
#define XB_TOPGEN   3392
#define XCD_BAR_WORDS 3456
#define XB_SPIN_CAP (1u << 22)
#define LAS __attribute__((address_space(3)))
DI unsigned xb_ld(unsigned* p) { return __hip_atomic_load(p, __ATOMIC_RELAXED, __HIP_MEMORY_SCOPE_AGENT); }
DI unsigned xb_add(unsigned* p, unsigned v) { return __hip_atomic_fetch_add(p, v, __ATOMIC_RELAXED, __HIP_MEMORY_SCOPE_AGENT); }
DI unsigned xb_xcc_id() { return (unsigned)__builtin_amdgcn_s_getreg((3 << 11) | 20) & 0xFu; }
#define XB_SPIN(cond, bar) do { unsigned _sp = 0; while (cond) { __builtin_amdgcn_s_sleep(1); \
    if ((++_sp & 255u) == 0u) { if (xb_ld(&(bar)[XB_TMO])) break; if (_sp > XB_SPIN_CAP) { atomicAdd(&(bar)[XB_TMO], 1u); break; } } } } while (0)
struct XcdBarrier { unsigned* bar; unsigned x; volatile LAS unsigned* st; };
DI XcdBarrier xcd_barrier_post(unsigned* bar, volatile LAS unsigned* st) {
  XcdBarrier b; b.bar = bar; b.x = xb_xcc_id(); b.st = st;
  if (threadIdx.x == 0) (void)xb_add(&bar[XB_XCNT(b.x)], 1u);
  return b;
}
DI void xcd_barrier_complete(unsigned* bar, unsigned x, unsigned& nloc, unsigned& nx) {
  const unsigned G = gridDim.x * gridDim.y * gridDim.z;
  unsigned sum, cnt, mine, sp = 0u;
  for (;;) {
    sum = 0u; cnt = 0u; mine = 0u;
#pragma unroll
    for (unsigned j = 0; j < 16; ++j) { const unsigned c = xb_ld(&bar[XB_XCNT(j)]); sum += c; cnt += (c > 0u) ? 1u : 0u; mine = (j == x) ? c : mine; }
    if (sum == G) break;
    __builtin_amdgcn_s_sleep(1);
    if ((++sp & 255u) == 0u) { if (xb_ld(&bar[XB_TMO])) break; if (sp > XB_SPIN_CAP) { atomicAdd(&bar[XB_TMO], 1u); break; } }
  }
  nloc = mine > 0u ? mine : 1u; nx = cnt > 0u ? cnt : 1u;
}
DI void xcd_barrier(const XcdBarrier& b) {
  asm volatile("s_waitcnt vmcnt(0)" ::: "memory");
  __syncthreads();
  if (threadIdx.x == 0) {
    unsigned* bar = b.bar;
    asm volatile("" : "+s"(bar));
    __builtin_amdgcn_s_waitcnt(0);
    unsigned nloc = b.st[0], nx = b.st[1];
    if (nloc == 0u) { xcd_barrier_complete(bar, b.x, nloc, nx); b.st[0] = nloc; b.st[1] = nx; }
    const unsigned old = xb_add(&bar[XB_XSUB(b.x)], 1u);
    const unsigned gen = old / nloc;
    if (old + 1u == (gen + 1u) * nloc) {
      __builtin_amdgcn_fence(__ATOMIC_RELEASE, "agent");
      asm volatile("s_waitcnt vmcnt(0)" ::: "memory");
      const unsigned og = xb_add(&bar[XB_TOP], 1u);
      const unsigned tg = og / nx;
      if (og + 1u == (tg + 1u) * nx) xb_add(&bar[XB_TOPGEN], 1u);
      else XB_SPIN(xb_ld(&bar[XB_TOPGEN]) == tg, bar);
      __builtin_amdgcn_fence(__ATOMIC_ACQUIRE, "agent");
      xb_add(&bar[XB_XGEN(b.x)], 1u);
      asm volatile("s_waitcnt vmcnt(0)" ::: "memory");
    } else {
      XB_SPIN(xb_ld(&bar[XB_XGEN(b.x)]) == gen, bar);
      __builtin_amdgcn_fence(__ATOMIC_ACQUIRE, "agent");
      asm volatile("s_waitcnt vmcnt(0)" ::: "memory");
    }
  }
  __syncthreads();
}

DI void gemm_load(const int tid, const u16* A, int lda, const u16* B, int ldb, int k0, uint4 (&ra)[4], uint4 (&rb)[2]) {
#pragma unroll
  for (int i = 0; i < 4; ++i) {
    int idx = tid + i * 512;
    int row = idx >> 3, ch = idx & 7;
    ra[i] = *(const uint4*)(A + (size_t)row * lda + k0 + ch * 8);
  }
#pragma unroll
  for (int i = 0; i < 2; ++i) {
    int idx = tid + i * 512;
    int row = idx >> 3, ch = idx & 7;
    rb[i] = *(const uint4*)(B + (size_t)row * ldb + k0 + ch * 8);
  }
}
DI void gemm_store_lds(const int tid, char* sA, char* sB, const uint4 (&ra)[4], const uint4 (&rb)[2]) {
#pragma unroll
  for (int i = 0; i < 4; ++i) {
    int idx = tid + i * 512;
    int row = idx >> 3, ch = idx & 7;
    *(uint4*)(sA + row * 128 + ((ch ^ ((row >> 1) & 7)) << 4)) = ra[i];
  }
#pragma unroll
  for (int i = 0; i < 2; ++i) {
    int idx = tid + i * 512;
    int row = idx >> 3, ch = idx & 7;
    *(uint4*)(sB + row * 128 + ((ch ^ ((row >> 1) & 7)) << 4)) = rb[i];
  }
}
DI void gemm_compute(const char* sA, const char* sB, f32x4 (&acc)[4][4], int wm, int wn, int lane) {
#pragma unroll
  for (int kk = 0; kk < 2; ++kk) {
    bf16x8 a[4], b[4];
    const int ch = kk * 4 + (lane >> 4);
#pragma unroll
    for (int mf = 0; mf < 4; ++mf) {
      int row = wm * 64 + mf * 16 + (lane & 15);
      a[mf] = *(const bf16x8*)(sA + row * 128 + ((ch ^ ((row >> 1) & 7)) << 4));
    }
#pragma unroll
    for (int nf = 0; nf < 4; ++nf) {
      int row = wn * 64 + nf * 16 + (lane & 15);
      b[nf] = *(const bf16x8*)(sB + row * 128 + ((ch ^ ((row >> 1) & 7)) << 4));
    }
#pragma unroll
    for (int mf = 0; mf < 4; ++mf)
#pragma unroll
      for (int nf = 0; nf < 4; ++nf)
        acc[mf][nf] = __builtin_amdgcn_mfma_f32_16x16x32_bf16(a[mf], b[nf], acc[mf][nf], 0, 0, 0);
  }
}
DI void gemm_acc(const u16* A, int lda, const u16* B, int ldb, int K, f32x4 (&acc)[4][4], char* smem) {
  const int tid = get_tid(), lane = tid & 63, wave = tid >> 6;
  const int wm = wave >> 1, wn = wave & 1;
  char* sA0 = smem;
  char* sB0 = smem + 32768;
  char* sA1 = smem + 49152;
  char* sB1 = smem + 81920;
  uint4 ra[4], rb[2];
  const int nk = K >> 6;
  gemm_load(tid, A, lda, B, ldb, 0, ra, rb);
  gemm_store_lds(tid, sA0, sB0, ra, rb);
  __syncthreads();
  for (int kt = 0; kt < nk; ++kt) {
    const bool more = (kt + 1 < nk);
    if (more) gemm_load(tid, A, lda, B, ldb, (kt + 1) * 64, ra, rb);
    if (kt & 1) gemm_compute(sA1, sB1, acc, wm, wn, lane);
    else gemm_compute(sA0, sB0, acc, wm, wn, lane);
    if (more) {
      if (kt & 1) gemm_store_lds(tid, sA0, sB0, ra, rb);
      else gemm_store_lds(tid, sA1, sB1, ra, rb);
    }
    __syncthreads();
  }
}
DI void zero_acc(f32x4 (&acc)[4][4]) {
#pragma unroll
  for (int i = 0; i < 4; ++i)
#pragma unroll
    for (int j = 0; j < 4; ++j) acc[i][j] = f32x4{0.f, 0.f, 0.f, 0.f};
}

#define PG8_LAS __attribute__((address_space(3)))
namespace pg8 {
typedef unsigned short bf16_t;
typedef short bf16x8 __attribute__((ext_vector_type(8)));
typedef float f32x4 __attribute__((ext_vector_type(4)));
typedef unsigned u32x4 __attribute__((ext_vector_type(4)));
constexpr int BM = 256, BK = 64, HALF = 128, HTB = HALF * BK * 2  , STAGE_BYTES = 8 * HTB, NXCD = 8, WGM = 8;

__host__ __device__ __forceinline__ int lds_byte(int r, int c) { const int st = (r >> 4) * 2 + (c >> 5), rr = r & 15, cc = c & 31, ob = rr * 64 + cc * 2; return st * 1024 + (ob ^ (((ob >> 9) & 1) << 5)); }
__host__ __device__ __forceinline__ void stage_rc(int b, int& R, int& C) { const int st = b / 1024, sb = b % 1024, swz = sb ^ (((sb >> 9) & 1) << 5); R = (st >> 1) * 16 + swz / 64; C = (st & 1) * 32 + (swz % 64) / 2; }
__host__ __device__ __forceinline__ int perm32(int rho) { const int n = rho >> 4, i = rho & 15; return 8 * (i >> 2) + 4 * n + (i & 3); }

struct Unit { int pm, pn; };
struct Gemm { const bf16_t* A; const bf16_t* Bt; int M, N, K; };

struct StaticOrder {
    int nM, nN, nwg, G, c;
    __host__ __device__ void init(int M, int N, int G_, int c_) { nM = M / BM; nN = N / BM; nwg = nM * nN; G = G_; c = c_; }
    __host__ __device__ bool next(int i, Unit& u) const {
        const long L = (long)i * G + c; if (L >= nwg) return false;
        int wgid = (int)L; { const int q = nwg / NXCD, r = nwg % NXCD, xcd = wgid % NXCD, off = wgid / NXCD; wgid = (xcd < r ? xcd * (q + 1) : r * (q + 1) + (xcd - r) * q) + off; }
        const int nig = WGM * nN, gid = wgid / nig, fm = gid * WGM, gsz = (nM - fm) < WGM ? (nM - fm) : WGM;
        u.pm = fm + ((wgid % nig) % gsz); u.pn = (wgid % nig) / gsz; return true;
    }
    __device__ __forceinline__ void a_ready(const Unit&) const {}
    __device__ __forceinline__ void done(const Unit&) const {}
};
__device__ __forceinline__ unsigned cvt_pk_bf16(float lo, float hi) { unsigned r; asm volatile("v_cvt_pk_bf16_f32 %0, %1, %2" : "=v"(r) : "v"(lo), "v"(hi)); return r; }
template <class Epi, class Sched, bool STAMP = false>
__device__ __forceinline__ void gemm_phase(PG8_LAS unsigned char* lds, const Gemm g, const Sched& S, const Epi& E, unsigned long long* stamps) {
    const int tid = get_tid(), wid = __builtin_amdgcn_readfirstlane(tid >> 6), lane = tid & 63, wr = wid >> 2, wc = wid & 3, fr = lane & 15, fq = lane >> 4;
    const int K = g.K, nt = K / BK;
    int ts_lo = 0, ts_hi = 0, nts = 0; const unsigned long long rt_entry = STAMP ? (unsigned long long)wall_clock64() : 0ull;
#define PG8_STAMP() do { if (STAMP && wid == 0 && nts < 64) { const unsigned long long _c = (unsigned long long)clock64(); \
        ts_lo = (lane == nts) ? (int)(unsigned)_c : ts_lo; ts_hi = (lane == nts) ? (int)(unsigned)(_c >> 32) : ts_hi; ++nts; } } while (0)
    PG8_STAMP();
    unsigned voffA[2], voffB[2];
#pragma unroll
    for (int i = 0; i < 2; ++i) { int R, C; stage_rc(tid * 16 + i * 8192, R, C); const int Rb = Epi::PERM ? ((R & ~31) + perm32(R & 31)) : R;
        voffA[i] = (unsigned)(R * K + C) * 2u; voffB[i] = (unsigned)(Rb * K + C) * 2u; }
    const size_t kstep = (size_t)(BK * 2);
    const size_t hstep = (size_t)HALF * K * 2;
    const size_t tstep = 2 * hstep;
    const unsigned ldsw = (unsigned)wid * 1024u;
    const int aoff = lds_byte(wr * 64 + fr, fq * 8), boff = lds_byte(wc * 32 + fr, fq * 8);
#define PG8_SA(b, h) (((b) * 2 + (h)) * HTB)
#define PG8_SB(b, h) ((4 + (b) * 2 + (h)) * HTB)
#define PG8_STAGE(bufoff, gbase, voff) do { _Pragma("unroll") for (int _i = 0; _i < 2; ++_i) \
        __builtin_amdgcn_global_load_lds((const unsigned*)((const char*)(gbase) + (voff)[_i]), (PG8_LAS unsigned*)(lds + (bufoff) + ldsw + _i * 8192), 16, 0, 0); } while (0)
#define PG8_LDA(dst, b, h) do { _Pragma("unroll") for (int m = 0; m < 4; ++m) _Pragma("unroll") for (int k = 0; k < 2; ++k) dst[m][k] = *(const PG8_LAS bf16x8*)(lds + PG8_SA(b, h) + aoff + m * 2048 + k * 1024); } while (0)
#define PG8_LDB(dst, b, h) do { _Pragma("unroll") for (int n = 0; n < 2; ++n) _Pragma("unroll") for (int k = 0; k < 2; ++k) dst[n][k] = *(const PG8_LAS bf16x8*)(lds + PG8_SB(b, h) + boff + n * 2048 + k * 1024); } while (0)
#define PG8_MMA(ai, bj, At, Bt) do { __builtin_amdgcn_s_setprio(1); _Pragma("unroll") for (int m = 0; m < 4; ++m) _Pragma("unroll") for (int n = 0; n < 2; ++n) _Pragma("unroll") for (int k = 0; k < 2; ++k) \
        acc[ai][bj][m][n] = __builtin_amdgcn_mfma_f32_16x16x32_bf16(Bt[n][k], At[m][k], acc[ai][bj][m][n], 0, 0, 0); __builtin_amdgcn_s_setprio(0); } while (0)
#define PG8_WAIT_V(n) asm volatile("s_waitcnt vmcnt(" #n ")" ::: "memory")
#define PG8_WAIT_L(n) asm volatile("s_waitcnt lgkmcnt(" #n ")" ::: "memory")
#define PG8_BAR __builtin_amdgcn_s_barrier()
#define PG8_SCHED __builtin_amdgcn_sched_barrier(0)
    Unit cur, nxt; int ui = 0;
    if (!S.next(0, cur)) return;
    f32x4 acc[2][2][4][2];
#pragma unroll
    for (int a = 0; a < 2; ++a)
#pragma unroll
        for (int b = 0; b < 2; ++b)
#pragma unroll
            for (int m = 0; m < 4; ++m)
#pragma unroll
                for (int n = 0; n < 2; ++n) acc[a][b][m][n] = (f32x4){0.f, 0.f, 0.f, 0.f};
    bf16x8 At[4][2], B0[2][2], B1[2][2];
    const char* cA = (const char*)g.A + (size_t)cur.pm * tstep; const char* cB = (const char*)g.Bt + (size_t)cur.pn * tstep;
    S.a_ready(cur);
    PG8_STAGE(PG8_SB(0, 0), cB, voffB); PG8_STAGE(PG8_SA(0, 0), cA, voffA); PG8_STAGE(PG8_SB(0, 1), cB + hstep, voffB); PG8_STAGE(PG8_SA(0, 1), cA + hstep, voffA);
    if (wr == 1) PG8_BAR;
    PG8_WAIT_V(4); PG8_BAR;
    PG8_STAGE(PG8_SB(1, 0), cB + kstep, voffB); PG8_STAGE(PG8_SA(1, 0), cA + kstep, voffA); PG8_STAGE(PG8_SB(1, 1), cB + hstep + kstep, voffB);
    PG8_WAIT_V(6); PG8_BAR;
    PG8_STAMP();
    for (;;) {
        const bool has_next = S.next(ui + 1, nxt);
        const char* nA = has_next ? (const char*)g.A + (size_t)nxt.pm * tstep : cA; const char* nB = has_next ? (const char*)g.Bt + (size_t)nxt.pn * tstep : cB;
        for (int t = 0; t < nt; t += 2) {
            const bool last = (t == nt - 2);
            const char* a1 = cA + (size_t)(t + 1) * kstep;
            const char* a2 = last ? nA : cA + (size_t)(t + 2) * kstep; const char* b2 = last ? nB : cB + (size_t)(t + 2) * kstep;
            const char* a3 = a2 + kstep; const char* b3 = b2 + kstep;
            if (last && has_next) S.a_ready(nxt);
            PG8_LDB(B0, 0, 0); PG8_SCHED; PG8_LDA(At, 0, 0); PG8_STAGE(PG8_SA(1, 1), a1 + hstep, voffA);
            PG8_WAIT_L(8); PG8_BAR; PG8_WAIT_L(0); PG8_MMA(0, 0, At, B0); PG8_BAR; PG8_SCHED;
            PG8_LDB(B1, 0, 1); PG8_STAGE(PG8_SB(0, 0), b2, voffB);
            PG8_BAR; PG8_WAIT_L(0); PG8_MMA(0, 1, At, B1); PG8_BAR;
            PG8_LDA(At, 0, 1); PG8_STAGE(PG8_SA(0, 0), a2, voffA);
            PG8_BAR; PG8_WAIT_L(0); PG8_MMA(1, 0, At, B0); PG8_BAR; PG8_SCHED;
            PG8_STAGE(PG8_SB(0, 1), b2 + hstep, voffB);
            PG8_WAIT_V(6); PG8_BAR; PG8_MMA(1, 1, At, B1); PG8_BAR;
            PG8_LDB(B0, 1, 0); PG8_SCHED; PG8_LDA(At, 1, 0); PG8_STAGE(PG8_SA(0, 1), a2 + hstep, voffA);
            PG8_WAIT_L(8); PG8_BAR; PG8_WAIT_L(0); PG8_MMA(0, 0, At, B0); PG8_BAR; PG8_SCHED;
            PG8_LDB(B1, 1, 1); PG8_STAGE(PG8_SB(1, 0), b3, voffB);
            PG8_BAR; PG8_WAIT_L(0); PG8_MMA(0, 1, At, B1); PG8_BAR;
            PG8_LDA(At, 1, 1); PG8_STAGE(PG8_SA(1, 0), a3, voffA);
            PG8_BAR; PG8_WAIT_L(0); PG8_MMA(1, 0, At, B0); PG8_BAR; PG8_SCHED;
            PG8_STAGE(PG8_SB(1, 1), b3 + hstep, voffB);
            PG8_WAIT_V(6); PG8_BAR; PG8_MMA(1, 1, At, B1); PG8_BAR;
        }
        PG8_STAMP();
        if constexpr (!Epi::AFTER_DRAIN) { E(acc, cur, wr, wc, fr, fq); S.done(cur); }
        PG8_STAMP();
        if (!has_next) break;
#pragma unroll
        for (int a = 0; a < 2; ++a)
#pragma unroll
            for (int b = 0; b < 2; ++b)
#pragma unroll
                for (int m = 0; m < 4; ++m)
#pragma unroll
                    for (int n = 0; n < 2; ++n) acc[a][b][m][n] = (f32x4){0.f, 0.f, 0.f, 0.f};
        cur = nxt; cA = nA; cB = nB; ++ui;
    }
    PG8_WAIT_V(0);
    if (wr == 0) PG8_BAR;
    PG8_BAR;
    if constexpr (Epi::AFTER_DRAIN) { E.fused(acc, cur, wr, wc, fr, fq, lds, wid, lane); S.done(cur); }
    PG8_STAMP();
    if (STAMP && wid == 0) { stamps[lane] = lane < nts ? (((unsigned long long)(unsigned)ts_hi << 32) | (unsigned)ts_lo) : 0ull;
        if (lane == 62) stamps[62] = rt_entry; if (lane == 63) stamps[63] = (unsigned long long)wall_clock64(); }
#undef PG8_STAMP
#undef PG8_SA
#undef PG8_SB
#undef PG8_STAGE
#undef PG8_LDA
#undef PG8_LDB
#undef PG8_MMA
#undef PG8_WAIT_V
#undef PG8_WAIT_L
#undef PG8_BAR
#undef PG8_SCHED
}
}

using pg8::cvt_pk_bf16;
DI uint4 pack8(const pg8::f32x4& a, const pg8::f32x4& b) {
  return uint4{cvt_pk_bf16(a[0], a[1]), cvt_pk_bf16(a[2], a[3]), cvt_pk_bf16(b[0], b[1]), cvt_pk_bf16(b[2], b[3])};
}
DI void unpack8(const uint4& u, float (&o)[8]) {
  o[0] = bf2f((u16)(u.x & 0xffff)); o[1] = bf2f((u16)(u.x >> 16));
  o[2] = bf2f((u16)(u.y & 0xffff)); o[3] = bf2f((u16)(u.y >> 16));
  o[4] = bf2f((u16)(u.z & 0xffff)); o[5] = bf2f((u16)(u.z >> 16));
  o[6] = bf2f((u16)(u.w & 0xffff)); o[7] = bf2f((u16)(u.w >> 16));
}
struct EpiP {
  static constexpr bool PERM = true, AFTER_DRAIN = false;
  u16 *zb, *xr, *rwb, *gb; float* dtb;
  DI void operator()(const pg8::f32x4 (&acc)[2][2][4][2], const pg8::Unit& u, int wr, int wc, int fr, int fq) const {
    const int row0 = u.pm * 256 + wr * 64 + fr;
#pragma unroll
    for (int bj = 0; bj < 2; ++bj) {
      const int cg = u.pn * 256 + bj * 128 + wc * 32;
      const int col0 = cg + 8 * fq;
      if (cg >= 10688) continue;
#pragma unroll
      for (int ai = 0; ai < 2; ++ai)
#pragma unroll
        for (int m = 0; m < 4; ++m) {
          const size_t row = row0 + ai * 128 + m * 16;
          const pg8::f32x4 v0 = acc[ai][bj][m][0], v1 = acc[ai][bj][m][1];
          if (cg >= 5120 && cg < 5184) {
            float* d = dtb + row * 64 + (col0 - 5120);
            *(pg8::f32x4*)d = v0; *(pg8::f32x4*)(d + 4) = v1;
          } else {
            u16* dst = (cg < 2048) ? zb + row * 2048 + col0
                     : (cg < 5120) ? xr + row * 3072 + (col0 - 2048)
                     : (cg < 8640) ? rwb + row * 3456 + (col0 - 5184)
                                   : gb + row * 2048 + (col0 - 8640);
            *(uint4*)dst = pack8(v0, v1);
          }
        }
    }
  }
};
template <int PASS>
struct EpiOut {
  static constexpr bool PERM = true, AFTER_DRAIN = false;
  const u16* gb; u16* U;
  DI void operator()(const pg8::f32x4 (&acc)[2][2][4][2], const pg8::Unit& u, int wr, int wc, int fr, int fq) const {
    const int row0 = u.pm * 256 + wr * 64 + fr;
#pragma unroll
    for (int bj = 0; bj < 2; ++bj) {
      const int col0 = u.pn * 256 + bj * 128 + wc * 32 + 8 * fq;
#pragma unroll
      for (int ai = 0; ai < 2; ++ai)
#pragma unroll
        for (int m = 0; m < 4; ++m) {
          const size_t row = row0 + ai * 128 + m * 16;
          float gt[8];
          unpack8(*(const uint4*)(gb + row * 2048 + PASS * 1024 + col0), gt);
          pg8::f32x4 v0 = acc[ai][bj][m][0], v1 = acc[ai][bj][m][1];
#pragma unroll
          for (int e = 0; e < 4; ++e) { v0[e] *= sigm(gt[e]); v1[e] *= sigm(gt[4 + e]); }
          if (PASS == 1) {
            float pu[8];
            unpack8(*(const uint4*)(U + row * 1024 + col0), pu);
#pragma unroll
            for (int e = 0; e < 4; ++e) { v0[e] += pu[e]; v1[e] += pu[4 + e]; }
          }
          *(uint4*)(U + row * 1024 + col0) = pack8(v0, v1);
        }
    }
  }
};
struct EpiWo {
  static constexpr bool PERM = true, AFTER_DRAIN = false;
  const float *xp, *xs, *mod; float* out; int tok0;
  DI void operator()(const pg8::f32x4 (&acc)[2][2][4][2], const pg8::Unit& u, int wr, int wc, int fr, int fq) const {
    const int row0 = u.pm * 256 + wr * 64 + fr;
#pragma unroll
    for (int bj = 0; bj < 2; ++bj) {
      const int col0 = u.pn * 256 + bj * 128 + wc * 32 + 8 * fq;
#pragma unroll
      for (int ai = 0; ai < 2; ++ai)
#pragma unroll
        for (int m = 0; m < 4; ++m) {
          const int tok = tok0 + row0 + ai * 128 + m * 16;
          const float* xr = tok < 8192 ? xp + (size_t)tok * 1024 : xs + (size_t)(tok - 8192) * 1024;
          const float* gt = mod + mrow_of(tok) * 6144 + 2048 + col0;
          const pg8::f32x4 x0 = *(const pg8::f32x4*)(xr + col0), x1 = *(const pg8::f32x4*)(xr + col0 + 4);
          const pg8::f32x4 g0 = *(const pg8::f32x4*)gt, g1 = *(const pg8::f32x4*)(gt + 4);
          float* o = out + (size_t)tok * 1024 + col0;
          *(pg8::f32x4*)o = x0 + g0 * acc[ai][bj][m][0];
          *(pg8::f32x4*)(o + 4) = x1 + g1 * acc[ai][bj][m][1];
        }
    }
  }
};
struct EpiGU {
  static constexpr bool PERM = true, AFTER_DRAIN = false;
  u16* act;
  DI void operator()(const pg8::f32x4 (&acc)[2][2][4][2], const pg8::Unit& u, int wr, int wc, int fr, int fq) const {
    const int row0 = u.pm * 256 + wr * 64 + fr;
    const int col0 = u.pn * 128 + wc * 32 + 8 * fq;
#pragma unroll
    for (int ai = 0; ai < 2; ++ai)
#pragma unroll
      for (int m = 0; m < 4; ++m) {
        const size_t row = row0 + ai * 128 + m * 16;
        pg8::f32x4 v0, v1;
#pragma unroll
        for (int e = 0; e < 4; ++e) {
          v0[e] = siluf(acc[ai][0][m][0][e]) * acc[ai][1][m][0][e];
          v1[e] = siluf(acc[ai][0][m][1][e]) * acc[ai][1][m][1][e];
        }
        *(uint4*)(act + row * 2816 + col0) = pack8(v0, v1);
      }
  }
};
struct EpiDown {
  static constexpr bool PERM = true, AFTER_DRAIN = false;
  const float* mod; float* out;
  DI void operator()(const pg8::f32x4 (&acc)[2][2][4][2], const pg8::Unit& u, int wr, int wc, int fr, int fq) const {
    const int row0 = u.pm * 256 + wr * 64 + fr;
#pragma unroll
    for (int bj = 0; bj < 2; ++bj) {
      const int col0 = u.pn * 256 + bj * 128 + wc * 32 + 8 * fq;
#pragma unroll
      for (int ai = 0; ai < 2; ++ai)
#pragma unroll
        for (int m = 0; m < 4; ++m) {
          const int tok = row0 + ai * 128 + m * 16;
          const float* gt = mod + mrow_of(tok) * 6144 + 5120 + col0;
          const pg8::f32x4 g0 = *(const pg8::f32x4*)gt, g1 = *(const pg8::f32x4*)(gt + 4);
          float* o = out + (size_t)tok * 1024 + col0;
          const pg8::f32x4 x0 = *(const pg8::f32x4*)o, x1 = *(const pg8::f32x4*)(o + 4);
          *(pg8::f32x4*)o = x0 + g0 * acc[ai][bj][m][0];
          *(pg8::f32x4*)(o + 4) = x1 + g1 * acc[ai][bj][m][1];
        }
    }
  }
};
template <class Epi>
DI void run_gemm8(char* smem, const u16* A, const u16* Bt, int M, int N, int K, const Epi& E) {
  asm volatile("" : "+s"(M), "+s"(N), "+s"(K));
  pg8::Gemm gm{A, Bt, M, N, K};
  pg8::StaticOrder S;
  S.init(M, N, gridDim.x, blockIdx.x);
  pg8::gemm_phase<Epi, pg8::StaticOrder, false>((PG8_LAS unsigned char*)smem, gm, S, E, nullptr);
  __syncthreads();
}

template <int MODE>
__device__ __forceinline__ void convT(const float* __restrict__ src, int K, int N, u16* __restrict__ dst, char* smem) {
  float* tile = (float*)smem;
  const int tid = get_tid();
  const int KT = K >> 6, NT = N >> 6;
  for (int t = blockIdx.x; t < KT * NT; t += gridDim.x) {
    int kt = t % KT, nt = t / KT;
#pragma unroll
    for (int i = 0; i < 8; ++i) {
      int idx = tid + i * 512;
      int r = idx >> 6, cc = idx & 63;
      tile[r * 65 + cc] = src[(size_t)(kt * 64 + r) * N + nt * 64 + cc];
    }
    __syncthreads();
    int n = tid >> 3, kc = tid & 7;
    unsigned w[4];
#pragma unroll
    for (int j = 0; j < 4; ++j)
      w[j] = pack2(tile[(kc * 8 + 2 * j) * 65 + n], tile[(kc * 8 + 2 * j + 1) * 65 + n]);
    int ng = nt * 64 + n;
    int row = ng;
    if (MODE == 1) {
      int isu = ng >= 2816;
      int nn = ng - isu * 2816;
      row = (nn >> 7) * 256 + isu * 128 + (nn & 127);
    }
    *(uint4*)(dst + (size_t)row * K + kt * 64 + kc * 8) = uint4{w[0], w[1], w[2], w[3]};
    __syncthreads();
  }
}

__device__ __forceinline__ void step_prep(const Params& p, char* smem) {
  const int tid = get_tid();
  char* ws = p.ws;
  {
    float* red = (float*)smem;
    float* mod = (float*)(ws + OFF_MOD);
    for (int item = blockIdx.x; item < 192; item += gridDim.x) {
      int c4 = tid & 7, kl = tid >> 3;
      float acc[12];
#pragma unroll
      for (int i = 0; i < 12; ++i) acc[i] = 0.f;
      for (int k = kl; k < 1024; k += 64) {
        float4 w = *(const float4*)(p.w_ada + (size_t)k * 6144 + item * 32 + c4 * 4);
        float s0 = siluf(p.c_ctx[k]), s1 = siluf(p.c[k]), s2 = siluf(p.c[1024 + k]);
        acc[0] += s0 * w.x; acc[1] += s0 * w.y; acc[2] += s0 * w.z; acc[3] += s0 * w.w;
        acc[4] += s1 * w.x; acc[5] += s1 * w.y; acc[6] += s1 * w.z; acc[7] += s1 * w.w;
        acc[8] += s2 * w.x; acc[9] += s2 * w.y; acc[10] += s2 * w.z; acc[11] += s2 * w.w;
      }
#pragma unroll
      for (int i = 0; i < 12; ++i) red[(kl * 8 + c4) * 12 + i] = acc[i];
      __syncthreads();
      if (tid < 96) {
        int cond = tid >> 5, col = tid & 31;
        int cc4 = col >> 2, e = col & 3;
        float s = 0.f;
        for (int k = 0; k < 64; ++k) s += red[(k * 8 + cc4) * 12 + cond * 4 + e];
        int n = item * 32 + col;
        mod[cond * 6144 + n] = s + p.b_ada[n];
      }
      __syncthreads();
    }
  }
  convT<0>(p.w_in, 1024, 10688, (u16*)(ws + OFF_WIN), smem);
  convT<1>(p.w_gu, 1024, 5632, (u16*)(ws + OFF_WGU), smem);
  convT<0>(p.w_down, 2816, 1024, (u16*)(ws + OFF_WDOWN), smem);
  convT<0>(p.w_m_out, 2048, 1024, (u16*)(ws + OFF_WMOUT), smem);
  convT<0>(p.w_r_out, 1024, 1024, (u16*)(ws + OFF_WROUT), smem);
  convT<0>(p.w_o, 1024, 1024, (u16*)(ws + OFF_WO), smem);
  convT<0>(p.w2, 64, 1024, (u16*)(ws + OFF_W2T), smem);
  convT<0>(p.w2 + 65536, 64, 1024, (u16*)(ws + OFF_W2T) + 65536, smem);
  convT<0>(p.a2, 64, 1024, (u16*)(ws + OFF_A2T), smem);
  convT<0>(p.a2 + 65536, 64, 1024, (u16*)(ws + OFF_A2T) + 65536, smem);
  convT<0>(p.g2, 128, 1024, (u16*)(ws + OFF_G2T), smem);
  {
    uint4* z = (uint4*)(ws + OFF_WIN + (size_t)10688 * 1024 * 2);
    for (int i = blockIdx.x * NTHR + tid; i < 8192; i += gridDim.x * NTHR) z[i] = uint4{0, 0, 0, 0};
  }
}

template <int WHICH>
__device__ __forceinline__ void step_norm(const Params& p, int g) {
  const int tid = get_tid(), lane = tid & 63, wave = tid >> 6;
  const float* mod = (const float*)(p.ws + OFF_MOD);
  const int nrows = WHICH == 0 ? TG : NTOK;
  u16* dst = (u16*)(p.ws + (WHICH == 0 ? OFF_H1 : OFF_H2));
  const float* nw = WHICH == 0 ? p.norm1_w : p.norm2_w;
  for (int r = blockIdx.x * 8 + wave; r < nrows; r += gridDim.x * 8) {
    int tok = WHICH == 0 ? g * TG + r : r;
    const float* xr;
    if (WHICH == 0) xr = tok < 8192 ? p.x_prompt + (size_t)tok * 1024 : p.x_sample + (size_t)(tok - 8192) * 1024;
    else xr = p.out + (size_t)tok * 1024;
    const float* mr = mod + mrow_of(tok) * 6144 + (WHICH == 0 ? 0 : 3072);
    float4 v[4];
    float ss = 0.f;
#pragma unroll
    for (int i = 0; i < 4; ++i) {
      v[i] = ((const float4*)xr)[i * 64 + lane];
      ss += v[i].x * v[i].x + v[i].y * v[i].y + v[i].z * v[i].z + v[i].w * v[i].w;
    }
    ss = wave_sum(ss);
    float rinv = rsqrtf(ss * (1.f / 1024.f) + 1e-6f);
#pragma unroll
    for (int i = 0; i < 4; ++i) {
      int col = (i * 64 + lane) * 4;
      float4 w4 = *(const float4*)(nw + col);
      float4 sh = *(const float4*)(mr + col);
      float4 sc = *(const float4*)(mr + 1024 + col);
      float h0 = v[i].x * rinv * w4.x * (1.f + sc.x) + sh.x;
      float h1 = v[i].y * rinv * w4.y * (1.f + sc.y) + sh.y;
      float h2 = v[i].z * rinv * w4.z * (1.f + sc.z) + sh.z;
      float h3 = v[i].w * rinv * w4.w * (1.f + sc.w) + sh.w;
      *(uint2*)(dst + (size_t)r * 1024 + col) = uint2{pack2(h0, h1), pack2(h2, h3)};
    }
  }
}

__device__ __forceinline__ void step_gemm1(const Params& p, char* smem) {
  char* ws = p.ws;
  EpiP E{(u16*)(ws + OFF_Z), (u16*)(ws + OFF_XBCRAW), (u16*)(ws + OFF_RW), (u16*)(ws + OFF_GATE), (float*)(ws + OFF_DT)};
  run_gemm8(smem, (const u16*)(ws + OFF_H1), (const u16*)(ws + OFF_WIN), TG, NPAD, 1024, E);
}

__device__ __forceinline__ void step_cr1(const Params& p, int g) {
  char* ws = p.ws;
  const int tid = get_tid(), lane = tid & 63, wave = tid >> 6;
  const int Ls = g < 2 ? 256 : 2048;
  {
    const u16* xr = (const u16*)(ws + OFF_XBCRAW);
    u16* xo = (u16*)(ws + OFF_XBC);
    for (int idx = blockIdx.x * NTHR + tid; idx < TG * 384; idx += gridDim.x * NTHR) {
      int r = idx / 384, cc = idx - r * 384;
      int pos = r & (Ls - 1);
      float s[8];
      {
        float4 b0 = *(const float4*)(p.conv_b + cc * 8), b1 = *(const float4*)(p.conv_b + cc * 8 + 4);
        s[0] = b0.x; s[1] = b0.y; s[2] = b0.z; s[3] = b0.w; s[4] = b1.x; s[5] = b1.y; s[6] = b1.z; s[7] = b1.w;
      }
#pragma unroll
      for (int i = 0; i < 5; ++i) {
        int pp = pos + i - 2;
        if (pp >= 0 && pp < Ls) {
          uint4 u = *(const uint4*)(xr + (size_t)(r + i - 2) * 3072 + cc * 8);
          float4 w0 = *(const float4*)(p.conv_w + i * 3072 + cc * 8), w1 = *(const float4*)(p.conv_w + i * 3072 + cc * 8 + 4);
          s[0] += bf2f(u.x & 0xffff) * w0.x; s[1] += bf2f(u.x >> 16) * w0.y;
          s[2] += bf2f(u.y & 0xffff) * w0.z; s[3] += bf2f(u.y >> 16) * w0.w;
          s[4] += bf2f(u.z & 0xffff) * w1.x; s[5] += bf2f(u.z >> 16) * w1.y;
          s[6] += bf2f(u.w & 0xffff) * w1.z; s[7] += bf2f(u.w >> 16) * w1.w;
        }
      }
#pragma unroll
      for (int e = 0; e < 8; ++e) s[e] = siluf(s[e]);
      *(uint4*)(xo + (size_t)r * 3072 + cc * 8) = uint4{pack2(s[0], s[1]), pack2(s[2], s[3]), pack2(s[4], s[5]), pack2(s[6], s[7])};
    }
  }
  {
    const u16* rw = (const u16*)(ws + OFF_RW);
    __half* wk = (__half*)(ws + OFF_WK);
    u16* tl = (u16*)(ws + OFF_TL);
    u16* sg = (u16*)(ws + OFF_SG);
    const bool grid = (g == 2);
    for (int r = blockIdx.x * 8 + wave; r < TG; r += gridDim.x * 8) {
      int pos = r & (Ls - 1);
      for (int it = 0; it < 54; ++it) {
        int c = it * 64 + lane;
        float cur = bf2f(rw[(size_t)r * 3456 + c]);
        int q = c / 864;
        int dr;
        bool ok;
        if (!grid) {
          if (q & 1) { dr = 1; ok = pos < Ls - 1; } else { dr = -1; ok = pos > 0; }
        } else {
          if (q == 0) { dr = -1; ok = (pos & 63) != 0; }
          else if (q == 1) { dr = 1; ok = (pos & 63) != 63; }
          else if (q == 2) { dr = -64; ok = pos >= 64; }
          else { dr = 64; ok = pos < Ls - 64; }
        }
        float sh = ok ? bf2f(rw[(size_t)(r + dr) * 3456 + c]) : 0.f;
        float xx = cur + p.mu_shift[c] * (sh - cur);
        if (it < 16) {
          wk[((size_t)(r * 16 + it) * 8 + 0) * 64 + lane] = __float2half(xx);
        } else if (it == 16) {
          tl[(size_t)r * 256 + lane] = f2bf(tanhf(xx));
        } else if (it == 17) {
          tl[(size_t)r * 256 + 64 + lane] = f2bf(tanhf(xx));
        } else if (it < 34) {
          int h = it - 18;
          float kk = xx * p.k_k[h * 64 + lane];
          float ss = wave_sum(kk * kk);
          float nkk = -kk * rsqrtf(ss + 1e-12f);
          wk[((size_t)(r * 16 + h) * 8 + 2) * 64 + lane] = __float2half(xx);
          wk[((size_t)(r * 16 + h) * 8 + 3) * 64 + lane] = __float2half(nkk);
        } else if (it < 50) {
          int h = it - 34;
          wk[((size_t)(r * 16 + h) * 8 + 1) * 64 + lane] = __float2half(xx);
        } else if (it == 50) {
          tl[(size_t)r * 256 + 128 + lane] = f2bf(xx);
        } else if (it == 51) {
          tl[(size_t)r * 256 + 192 + lane] = f2bf(xx);
        } else {
          sg[(size_t)r * 128 + (it - 52) * 64 + lane] = f2bf(sigm(xx));
        }
      }
    }
  }
}

__device__ __forceinline__ void step_r2(const Params& p, char* smem) {
  char* ws = p.ws;
  const int tid = get_tid(), lane = tid & 63, wave = tid >> 6;
  const int wm = wave >> 1, wn = wave & 1;
  const u16* tl = (const u16*)(ws + OFF_TL);
  const u16* sg = (const u16*)(ws + OFF_SG);
  __half* wk = (__half*)(ws + OFF_WK);
  u16* gr = (u16*)(ws + OFF_GR);
  for (int t = blockIdx.x; t < 5 * 128; t += gridDim.x) {
    int sub = t >> 7, rem = t & 127;
    int mt = rem & 15, nt = rem >> 4;
    f32x4 acc[4][4];
    zero_acc(acc);
    if (sub < 2) {
      gemm_acc(tl + (size_t)mt * 256 * 256 + sub * 64, 256, (const u16*)(ws + OFF_W2T) + sub * 65536 + (size_t)nt * 128 * 64, 64, 64, acc, smem);
    } else if (sub < 4) {
      gemm_acc(tl + (size_t)mt * 256 * 256 + 128 + (sub - 2) * 64, 256, (const u16*)(ws + OFF_A2T) + (sub - 2) * 65536 + (size_t)nt * 128 * 64, 64, 64, acc, smem);
    } else {
      gemm_acc(sg + (size_t)mt * 256 * 128, 128, (const u16*)(ws + OFF_G2T) + (size_t)nt * 128 * 128, 128, 128, acc, smem);
    }
#pragma unroll
    for (int mf = 0; mf < 4; ++mf)
#pragma unroll
      for (int nf = 0; nf < 4; ++nf)
#pragma unroll
        for (int j = 0; j < 4; ++j) {
          if (nf == 0 && j == 0) asm volatile("" ::: "memory");
          int m = mt * 256 + wm * 64 + mf * 16 + (lane >> 4) * 4 + j;
          int n = nt * 128 + wn * 64 + nf * 16 + (lane & 15);
          float v = acc[mf][nf][j];
          if (sub < 2) {
            float wl = v + p.w0[sub * 1024 + n];
            float dec = __expf(-0.6065306597f * sigm(wl));
            wk[((size_t)(m * 16 + (n >> 6)) * 8 + 4 + 2 * sub) * 64 + (n & 63)] = __float2half(dec);
          } else if (sub < 4) {
            int d = sub - 2;
            float a = sigm(v + p.a0[d * 1024 + n]);
            wk[((size_t)(m * 16 + (n >> 6)) * 8 + 5 + 2 * d) * 64 + (n & 63)] = __float2half(a);
          } else {
            gr[(size_t)m * 1024 + n] = f2bf(v);
          }
        }
  }
}

DI int sw256(int row, int e) { return row * 256 + ((((e >> 3) ^ (row & 15))) << 4) + (e & 7) * 2; }
DI const bf16x8 ldfrag256(const char* base, int row, int ch) {
  return *(const bf16x8*)(base + row * 256 + ((ch ^ (row & 15)) << 4));
}

__device__ __forceinline__ void ssd_chain(const Params& p, char* smem, int g, int chain) {
  char* ws = p.ws;
  const int tid = get_tid(), lane = tid & 63, wave = tid >> 6;
  const int Ls = g < 2 ? 256 : 2048;
  const int nch = Ls >> 7;
  const int d = chain & 1, h = (chain >> 1) & 31, b = chain >> 6;
  const int grp = h >> 3;
  const u16* xbc = (const u16*)(ws + OFF_XBC);
  const float* dtb = (const float*)(ws + OFF_DT);
  u16* yout = (u16*)(ws + (d ? OFF_SYB : OFF_SYF));
  char* Cs = smem;
  char* Bs = smem + 32768;
  char* BdT = smem + 65536;
  char* XT = smem + 98304;
  char* Ss = smem + 114688;
  float* csum = (float*)(smem + 131072);
  float* dts = (float*)(smem + 131584);
  const float a_h = -__expf(p.a_log[d * 32 + h]);
  const float dtbias = p.dt_bias[d * 32 + h];
  const int wp = wave >> 2, wn4 = wave & 3;
  f32x4 sacc[2][2];
#pragma unroll
  for (int pf = 0; pf < 2; ++pf)
#pragma unroll
    for (int nf = 0; nf < 2; ++nf) {
      if (g == 2) {
        const float* h0 = (d ? p.ssm_b : p.ssm_f) + (size_t)(b * 32 + h) * 8192;
#pragma unroll
        for (int j = 0; j < 4; ++j) {
          int pp = wp * 32 + pf * 16 + (lane >> 4) * 4 + j;
          int n = wn4 * 32 + nf * 16 + (lane & 15);
          sacc[pf][nf][j] = h0[pp * 128 + n];
        }
      } else {
        sacc[pf][nf] = f32x4{0.f, 0.f, 0.f, 0.f};
      }
    }
  const int tid_outer = tid;
  for (int ci = 0; ci < nch; ++ci) {
    int tidv = tid_outer;
    asm volatile("" : "+v"(tidv));
    const int tid = tidv, lane = tidv & 63, wave = tidv >> 6;
    const int wp = wave >> 2, wn4 = wave & 3;
    const int c = d ? nch - 1 - ci : ci;
    const int tok0 = b * Ls + c * 128;
#pragma unroll
    for (int i = 0; i < 4; ++i) {
      int idx = tid + i * 512;
      int row = idx >> 4, ch = idx & 15;
      const u16* src = xbc + (size_t)(tok0 + row) * 3072 + grp * 128 + ch * 8;
      uint4 cv = *(const uint4*)(src + 2560);
      uint4 bv = *(const uint4*)(src + 2048);
      *(uint4*)(Cs + row * 256 + ((ch ^ (row & 15)) << 4)) = cv;
      *(uint4*)(Bs + row * 256 + ((ch ^ (row & 15)) << 4)) = bv;
    }
#pragma unroll
    for (int i = 0; i < 2; ++i) {
      int idx = tid + i * 512;
      int l = idx >> 3, ch = idx & 7;
      uint4 xv = *(const uint4*)(xbc + (size_t)(tok0 + l) * 3072 + h * 64 + ch * 8);
      unsigned w[4] = {xv.x, xv.y, xv.z, xv.w};
#pragma unroll
      for (int e = 0; e < 8; ++e) {
        int pp = ch * 8 + e;
        u16 val = (u16)((w[e >> 1] >> ((e & 1) * 16)) & 0xffff);
        *(u16*)(XT + sw256(pp, l)) = val;
      }
    }
    if (wave == 0) {
      int e0 = 2 * lane, e1 = 2 * lane + 1;
      int l0 = d ? 127 - e0 : e0, l1 = d ? 127 - e1 : e1;
      float x0 = dtb[(size_t)(tok0 + l0) * 64 + d * 32 + h] + dtbias;
      float x1 = dtb[(size_t)(tok0 + l1) * 64 + d * 32 + h] + dtbias;
      float dt0 = x0 > 20.f ? x0 : log1pf(__expf(x0));
      float dt1 = x1 > 20.f ? x1 : log1pf(__expf(x1));
      float a0 = dt0 * a_h, a1 = dt1 * a_h;
      float s = a0 + a1;
#pragma unroll
      for (int o = 1; o < 64; o <<= 1) {
        float t = __shfl_up(s, o);
        if (lane >= o) s += t;
      }
      csum[l1] = s;
      csum[l0] = s - a1;
      dts[l0] = dt0;
      dts[l1] = dt1;
    }
#pragma unroll
    for (int pf = 0; pf < 2; ++pf)
#pragma unroll
      for (int nf = 0; nf < 2; ++nf)
#pragma unroll
        for (int j = 0; j < 4; ++j) {
          int pp = wp * 32 + pf * 16 + (lane >> 4) * 4 + j;
          int n = wn4 * 32 + nf * 16 + (lane & 15);
          *(u16*)(Ss + sw256(pp, n)) = f2bf(sacc[pf][nf][j]);
        }
    __syncthreads();
    const float cstot = csum[d ? 0 : 127];
#pragma unroll
    for (int i = 0; i < 4; ++i) {
      int idx = tid + i * 512;
      int l = idx >> 4, ch = idx & 15;
      uint4 bv = *(const uint4*)(Bs + l * 256 + ((ch ^ (l & 15)) << 4));
      float f = dts[l] * __expf(cstot - csum[l]);
      unsigned w[4] = {bv.x, bv.y, bv.z, bv.w};
#pragma unroll
      for (int e = 0; e < 8; ++e) {
        int n = ch * 8 + e;
        float val = bf2f((u16)((w[e >> 1] >> ((e & 1) * 16)) & 0xffff)) * f;
        *(u16*)(BdT + sw256(n, l)) = f2bf(val);
      }
    }
    const int wm = wave >> 1, wn2 = wave & 1;
    f32x4 gacc[2][4];
#pragma unroll
    for (int i = 0; i < 2; ++i)
#pragma unroll
      for (int j = 0; j < 4; ++j) gacc[i][j] = f32x4{0.f, 0.f, 0.f, 0.f};
#pragma unroll
    for (int ks = 0; ks < 4; ++ks) {
      int ch = ks * 4 + (lane >> 4);
      bf16x8 a[2], bb[4];
#pragma unroll
      for (int mf = 0; mf < 2; ++mf) a[mf] = ldfrag256(Cs, wm * 32 + mf * 16 + (lane & 15), ch);
#pragma unroll
      for (int nf = 0; nf < 4; ++nf) bb[nf] = ldfrag256(Bs, wn2 * 64 + nf * 16 + (lane & 15), ch);
#pragma unroll
      for (int mf = 0; mf < 2; ++mf)
#pragma unroll
        for (int nf = 0; nf < 4; ++nf)
          gacc[mf][nf] = __builtin_amdgcn_mfma_f32_16x16x32_bf16(a[mf], bb[nf], gacc[mf][nf], 0, 0, 0);
    }
    {
      float csl[2][4];
#pragma unroll
      for (int mf = 0; mf < 2; ++mf)
#pragma unroll
        for (int j = 0; j < 4; ++j) csl[mf][j] = csum[wm * 32 + mf * 16 + (lane >> 4) * 4 + j];
#pragma unroll
      for (int nf = 0; nf < 4; ++nf) {
        int s = wn2 * 64 + nf * 16 + (lane & 15);
        float css = csum[s], dss = dts[s];
#pragma unroll
        for (int mf = 0; mf < 2; ++mf)
#pragma unroll
          for (int j = 0; j < 4; ++j) {
            int l = wm * 32 + mf * 16 + (lane >> 4) * 4 + j;
            bool valid = d ? (s >= l) : (s <= l);
            float e = valid ? __expf(csl[mf][j] - css) * dss : 0.f;
            gacc[mf][nf][j] *= e;
          }
      }
    }
    __syncthreads();
#pragma unroll
    for (int mf = 0; mf < 2; ++mf)
#pragma unroll
      for (int nf = 0; nf < 4; ++nf)
#pragma unroll
        for (int j = 0; j < 4; ++j) {
          int l = wm * 32 + mf * 16 + (lane >> 4) * 4 + j;
          int s = wn2 * 64 + nf * 16 + (lane & 15);
          *(u16*)(Bs + sw256(l, s)) = f2bf(gacc[mf][nf][j]);
        }
    __syncthreads();
    {
      f32x4 yacc[2][2];
#pragma unroll
      for (int i = 0; i < 2; ++i)
#pragma unroll
        for (int j = 0; j < 2; ++j) yacc[i][j] = f32x4{0.f, 0.f, 0.f, 0.f};
#pragma unroll
      for (int ks = 0; ks < 4; ++ks) {
        int ch = ks * 4 + (lane >> 4);
        bf16x8 a[2], bb[2];
#pragma unroll
        for (int mf = 0; mf < 2; ++mf) a[mf] = ldfrag256(Cs, wm * 32 + mf * 16 + (lane & 15), ch);
#pragma unroll
        for (int nf = 0; nf < 2; ++nf) bb[nf] = ldfrag256(Ss, wn2 * 32 + nf * 16 + (lane & 15), ch);
#pragma unroll
        for (int mf = 0; mf < 2; ++mf)
#pragma unroll
          for (int nf = 0; nf < 2; ++nf)
            yacc[mf][nf] = __builtin_amdgcn_mfma_f32_16x16x32_bf16(a[mf], bb[nf], yacc[mf][nf], 0, 0, 0);
      }
#pragma unroll
      for (int mf = 0; mf < 2; ++mf)
#pragma unroll
        for (int j = 0; j < 4; ++j) {
          float e = __expf(csum[wm * 32 + mf * 16 + (lane >> 4) * 4 + j]);
#pragma unroll
          for (int nf = 0; nf < 2; ++nf) yacc[mf][nf][j] *= e;
        }
#pragma unroll
      for (int ks = 0; ks < 4; ++ks) {
        int ch = ks * 4 + (lane >> 4);
        bf16x8 a[2], bb[2];
#pragma unroll
        for (int mf = 0; mf < 2; ++mf) a[mf] = ldfrag256(Bs, wm * 32 + mf * 16 + (lane & 15), ch);
#pragma unroll
        for (int nf = 0; nf < 2; ++nf) bb[nf] = ldfrag256(XT, wn2 * 32 + nf * 16 + (lane & 15), ch);
#pragma unroll
        for (int mf = 0; mf < 2; ++mf)
#pragma unroll
          for (int nf = 0; nf < 2; ++nf)
            yacc[mf][nf] = __builtin_amdgcn_mfma_f32_16x16x32_bf16(a[mf], bb[nf], yacc[mf][nf], 0, 0, 0);
      }
#pragma unroll
      for (int mf = 0; mf < 2; ++mf)
#pragma unroll
        for (int nf = 0; nf < 2; ++nf)
#pragma unroll
          for (int j = 0; j < 4; ++j) {
            int l = wm * 32 + mf * 16 + (lane >> 4) * 4 + j;
            int pp = wn2 * 32 + nf * 16 + (lane & 15);
            yout[(size_t)(tok0 + l) * 2048 + h * 64 + pp] = f2bf(yacc[mf][nf][j]);
          }
    }
    {
      float e = __expf(cstot);
#pragma unroll
      for (int pf = 0; pf < 2; ++pf)
#pragma unroll
        for (int nf = 0; nf < 2; ++nf) sacc[pf][nf] *= e;
#pragma unroll
      for (int ks = 0; ks < 4; ++ks) {
        int ch = ks * 4 + (lane >> 4);
        bf16x8 a[2], bb[2];
#pragma unroll
        for (int pf = 0; pf < 2; ++pf) a[pf] = ldfrag256(XT, wp * 32 + pf * 16 + (lane & 15), ch);
#pragma unroll
        for (int nf = 0; nf < 2; ++nf) bb[nf] = ldfrag256(BdT, wn4 * 32 + nf * 16 + (lane & 15), ch);
#pragma unroll
        for (int pf = 0; pf < 2; ++pf)
#pragma unroll
          for (int nf = 0; nf < 2; ++nf)
            sacc[pf][nf] = __builtin_amdgcn_mfma_f32_16x16x32_bf16(a[pf], bb[nf], sacc[pf][nf], 0, 0, 0);
      }
    }
    __syncthreads();
  }
  if (g < 2) {
    float* so = p.out + (d ? OUT_SSMB : OUT_SSMF) + (size_t)((g * 16 + b) * 32 + h) * 8192;
#pragma unroll
    for (int pf = 0; pf < 2; ++pf)
#pragma unroll
      for (int nf = 0; nf < 2; ++nf)
#pragma unroll
        for (int j = 0; j < 4; ++j) {
          int pp = wp * 32 + pf * 16 + (lane >> 4) * 4 + j;
          int n = wn4 * 32 + nf * 16 + (lane & 15);
          so[pp * 128 + n] = sacc[pf][nf][j];
        }
  }
}

DI float dpp_xor1(float v) { return __shfl_xor(v, 1); }
DI float dpp_xor2(float v) { return __shfl_xor(v, 2); }

__device__ __forceinline__ void wkv_pair(const Params& p, char* smem, int g, int chain0, int nact) {
  char* ws = p.ws;
  const int tid = get_tid(), lane = tid & 63, wave = tid >> 6;
  const int Ls = g < 2 ? 256 : 2048;
  const int ntb = Ls >> 4;
  const __half* wk = (const __half*)(ws + OFF_WK);
  float* stage = (float*)smem;
  float* ylds = (float*)(smem + 98304);
  const int slot = wave >> 2, wq = wave & 3;
  const int ig = lane >> 2, jg = lane & 3;
  const int row = wq * 16 + ig;
  const bool act = slot < nact;
  const int chain = chain0 + (act ? slot : 0);
  const int d = chain & 1, h = (chain >> 1) & 15, b = chain >> 5;
  float S[16];
  if (g == 2) {
    const float* s0 = (d ? p.wkv_b : p.wkv_f) + ((size_t)(b * 16 + h) * 64 + row) * 64 + jg * 16;
#pragma unroll
    for (int c = 0; c < 16; ++c) S[c] = s0[c];
  } else {
#pragma unroll
    for (int c = 0; c < 16; ++c) S[c] = 0.f;
  }
  const int pair = tid >> 4, lslot = pair >> 4, lstep = pair & 15, sub = tid & 15;
  const bool lact = lslot < nact;
  const int lchain = chain0 + (lact ? lslot : 0);
  const int ld = lchain & 1, lh = (lchain >> 1) & 15, lb = lchain >> 5;
  float ka[4];
#pragma unroll
  for (int e = 0; e < 4; ++e) ka[e] = p.k_a[lh * 64 + sub * 4 + e];
  u16* yout = (u16*)(ws + (ld ? OFF_WYB : OFF_WYF));
  uint2 rg[6];
  auto prefetch = [&](int tb) {
    int s = tb * 16 + lstep;
    int pos = ld ? Ls - 1 - s : s;
    int r = lb * Ls + pos;
    const __half* rec = wk + ((size_t)(r * 16 + lh) * 8) * 64 + sub * 4;
    rg[0] = *(const uint2*)(rec + 0 * 64);
    rg[1] = *(const uint2*)(rec + 1 * 64);
    rg[2] = *(const uint2*)(rec + 2 * 64);
    rg[3] = *(const uint2*)(rec + 3 * 64);
    rg[4] = *(const uint2*)(rec + (4 + 2 * ld) * 64);
    rg[5] = *(const uint2*)(rec + (5 + 2 * ld) * 64);
  };
  auto unpack4 = [&](uint2 u, float (&o)[4]) {
    __half2 h0 = *reinterpret_cast<__half2*>(&u.x);
    __half2 h1 = *reinterpret_cast<__half2*>(&u.y);
    float2 f0 = __half22float2(h0), f1 = __half22float2(h1);
    o[0] = f0.x; o[1] = f0.y; o[2] = f1.x; o[3] = f1.y;
  };
  auto stage_store = [&](int buf) {
    float r_[4], v_[4], k_[4], nkk_[4], w_[4], a_[4];
    unpack4(rg[0], r_); unpack4(rg[1], v_); unpack4(rg[2], k_); unpack4(rg[3], nkk_); unpack4(rg[4], w_); unpack4(rg[5], a_);
    float b_[4], kd_[4];
#pragma unroll
    for (int e = 0; e < 4; ++e) {
      b_[e] = -nkk_[e] * a_[e];
      kd_[e] = k_[e] * (1.f + (a_[e] - 1.f) * ka[e]);
    }
    float* dst = stage + ((size_t)((buf * 2 + lslot) * 16 + lstep) * 6) * 64 + sub * 4;
    *(float4*)(dst + 0 * 64) = float4{nkk_[0], nkk_[1], nkk_[2], nkk_[3]};
    *(float4*)(dst + 1 * 64) = float4{w_[0], w_[1], w_[2], w_[3]};
    *(float4*)(dst + 2 * 64) = float4{b_[0], b_[1], b_[2], b_[3]};
    *(float4*)(dst + 3 * 64) = float4{kd_[0], kd_[1], kd_[2], kd_[3]};
    *(float4*)(dst + 4 * 64) = float4{r_[0], r_[1], r_[2], r_[3]};
    *(float4*)(dst + 5 * 64) = float4{v_[0], v_[1], v_[2], v_[3]};
  };
  prefetch(0);
  stage_store(0);
  __syncthreads();
  for (int tb = 0; tb < ntb; ++tb) {
    const bool more = tb + 1 < ntb;
    if (more) prefetch(tb + 1);
    if (act) {
      const float* sb = stage + ((size_t)(((tb & 1) * 2 + slot) * 16) * 6) * 64;
      for (int st = 0; st < 16; ++st) {
        const float* v6 = sb + st * 384 + jg * 16;
        float nkk[16], w[16], bb[16], kd[16], rr[16];
#pragma unroll
        for (int q = 0; q < 4; ++q) {
          float4 t0 = *(const float4*)(v6 + 0 * 64 + q * 4);
          nkk[q * 4] = t0.x; nkk[q * 4 + 1] = t0.y; nkk[q * 4 + 2] = t0.z; nkk[q * 4 + 3] = t0.w;
          float4 t1 = *(const float4*)(v6 + 1 * 64 + q * 4);
          w[q * 4] = t1.x; w[q * 4 + 1] = t1.y; w[q * 4 + 2] = t1.z; w[q * 4 + 3] = t1.w;
          float4 t2 = *(const float4*)(v6 + 2 * 64 + q * 4);
          bb[q * 4] = t2.x; bb[q * 4 + 1] = t2.y; bb[q * 4 + 2] = t2.z; bb[q * 4 + 3] = t2.w;
          float4 t3 = *(const float4*)(v6 + 3 * 64 + q * 4);
          kd[q * 4] = t3.x; kd[q * 4 + 1] = t3.y; kd[q * 4 + 2] = t3.z; kd[q * 4 + 3] = t3.w;
          float4 t4 = *(const float4*)(v6 + 4 * 64 + q * 4);
          rr[q * 4] = t4.x; rr[q * 4 + 1] = t4.y; rr[q * 4 + 2] = t4.z; rr[q * 4 + 3] = t4.w;
        }
        float vi = sb[st * 384 + 5 * 64 + row];
        float sa = 0.f;
#pragma unroll
        for (int c = 0; c < 16; ++c) sa += S[c] * nkk[c];
        sa += dpp_xor1(sa);
        sa += dpp_xor2(sa);
        float y = 0.f;
#pragma unroll
        for (int c = 0; c < 16; ++c) {
          S[c] = S[c] * w[c] + (sa * bb[c] + vi * kd[c]);
          y += S[c] * rr[c];
        }
        y += dpp_xor1(y);
        y += dpp_xor2(y);
        if (jg == 0) ylds[(slot * 16 + st) * 64 + row] = y;
      }
    }
    __syncthreads();
    if (more) stage_store((tb + 1) & 1);
    if (lact) {
      int s = tb * 16 + lstep;
      int pos = ld ? Ls - 1 - s : s;
      int r = lb * Ls + pos;
      float4 yv = *(const float4*)(ylds + (lslot * 16 + lstep) * 64 + sub * 4);
      *(uint2*)(yout + (size_t)r * 1024 + lh * 64 + sub * 4) = uint2{pack2(yv.x, yv.y), pack2(yv.z, yv.w)};
    }
    __syncthreads();
  }
  if (g < 2 && act) {
    float* so = p.out + (d ? OUT_WKVB : OUT_WKVF) + ((size_t)((g * 16 + b) * 16 + h) * 64 + row) * 64 + jg * 16;
#pragma unroll
    for (int c = 0; c < 16; ++c) so[c] = S[c];
  }
}

__device__ __forceinline__ void step_scan(const Params& p, char* smem, int g) {
  const int G = gridDim.x;
  if (g < 2) {
    if (SM & 8192) for (int ch = blockIdx.x; ch < 1024; ch += G) ssd_chain(p, smem, g, ch);
    if (SM & 16384) for (int it = blockIdx.x; it < 256; it += G) wkv_pair(p, smem, g, it * 2, 2);
  } else {
    if (SM & 8192) for (int ch = blockIdx.x; ch < 128; ch += G) ssd_chain(p, smem, g, ch);
    if (SM & 16384) for (int it = (G - 1 - blockIdx.x); it < 64; it += G) wkv_pair(p, smem, g, it, 1);
  }
}

__device__ __forceinline__ void step_fin(const Params& p, int g) {
  char* ws = p.ws;
  const int tid = get_tid(), lane = tid & 63, wave = tid >> 6;
  const int gw = blockIdx.x * 8 + wave, nw = gridDim.x * 8;
  {
    const u16* yf = (const u16*)(ws + OFF_SYF);
    const u16* yb = (const u16*)(ws + OFF_SYB);
    const u16* xbc = (const u16*)(ws + OFF_XBC);
    const u16* zb = (const u16*)(ws + OFF_Z);
    u16* ym = (u16*)(ws + OFF_YM);
    for (int it = gw; it < TG * 4; it += nw) {
      int r = it >> 2, gq = it & 3;
      int ch = gq * 512 + lane * 8;
      uint4 a = *(const uint4*)(yf + (size_t)r * 2048 + ch);
      uint4 b = *(const uint4*)(yb + (size_t)r * 2048 + ch);
      uint4 x = *(const uint4*)(xbc + (size_t)r * 3072 + ch);
      uint4 z = *(const uint4*)(zb + (size_t)r * 2048 + ch);
      float dsk = p.d_skip[ch >> 6];
      unsigned aw[4] = {a.x, a.y, a.z, a.w}, bw[4] = {b.x, b.y, b.z, b.w}, xw[4] = {x.x, x.y, x.z, x.w}, zw[4] = {z.x, z.y, z.z, z.w};
      float y[8];
      float ss = 0.f;
#pragma unroll
      for (int e = 0; e < 8; ++e) {
        int sh = (e & 1) * 16;
        float yy = bf2f((u16)(aw[e >> 1] >> sh)) + bf2f((u16)(bw[e >> 1] >> sh)) + dsk * bf2f((u16)(xw[e >> 1] >> sh));
        yy *= siluf(bf2f((u16)(zw[e >> 1] >> sh)));
        y[e] = yy;
        ss += yy * yy;
      }
      ss = wave_sum(ss);
      float rinv = rsqrtf(ss * (1.f / 512.f) + 1e-5f);
      float4 w0 = *(const float4*)(p.m_norm_w + ch), w1 = *(const float4*)(p.m_norm_w + ch + 4);
      *(uint4*)(ym + (size_t)r * 2048 + ch) =
          uint4{pack2(y[0] * rinv * w0.x, y[1] * rinv * w0.y), pack2(y[2] * rinv * w0.z, y[3] * rinv * w0.w),
                pack2(y[4] * rinv * w1.x, y[5] * rinv * w1.y), pack2(y[6] * rinv * w1.z, y[7] * rinv * w1.w)};
    }
  }
  {
    const u16* yf = (const u16*)(ws + OFF_WYF);
    const u16* yb = (const u16*)(ws + OFF_WYB);
    const __half* wk = (const __half*)(ws + OFF_WK);
    const u16* gr = (const u16*)(ws + OFF_GR);
    u16* yr = (u16*)(ws + OFF_YR);
    for (int it = gw; it < TG * 16; it += nw) {
      int r = it >> 4, h = it & 15;
      int c = h * 64 + lane;
      float y = bf2f(yf[(size_t)r * 1024 + c]) + bf2f(yb[(size_t)r * 1024 + c]);
      float mean = wave_sum(y) * (1.f / 64.f);
      float dy = y - mean;
      float var = wave_sum(dy * dy) * (1.f / 64.f);
      float yn = dy * rsqrtf(var + 64e-5f) * p.lnx_w[c] + p.lnx_b[c];
      const __half* rec = wk + ((size_t)(r * 16 + h) * 8) * 64 + lane;
      float rr = __half2float(rec[0]), vv = __half2float(rec[64]), kk = __half2float(rec[128]);
      float af = __half2float(rec[5 * 64]), ab = __half2float(rec[7 * 64]);
      float kmean = kk * (1.f + (0.5f * (af + ab) - 1.f) * p.k_a[c]);
      float bs = wave_sum(rr * kmean * p.r_k[c]);
      float o = (yn + bs * vv) * bf2f(gr[(size_t)r * 1024 + c]);
      yr[(size_t)r * 1024 + c] = f2bf(o);
    }
  }
}

__device__ __forceinline__ void step_outproj(const Params& p, char* smem) {
  char* ws = p.ws;
  EpiOut<0> E0{(const u16*)(ws + OFF_GATE), (u16*)(ws + OFF_U)};
  run_gemm8(smem, (const u16*)(ws + OFF_YM), (const u16*)(ws + OFF_WMOUT), TG, 1024, 2048, E0);
  EpiOut<1> E1{(const u16*)(ws + OFF_GATE), (u16*)(ws + OFF_U)};
  run_gemm8(smem, (const u16*)(ws + OFF_YR), (const u16*)(ws + OFF_WROUT), TG, 1024, 1024, E1);
}

__device__ __forceinline__ void step_wo(const Params& p, char* smem, int g) {
  char* ws = p.ws;
  EpiWo E{p.x_prompt, p.x_sample, (const float*)(ws + OFF_MOD), p.out, g * TG};
  run_gemm8(smem, (const u16*)(ws + OFF_U), (const u16*)(ws + OFF_WO), TG, 1024, 1024, E);
}

__device__ __forceinline__ void step_gu(const Params& p, char* smem) {
  char* ws = p.ws;
  EpiGU E{(u16*)(ws + OFF_ACT)};
  run_gemm8(smem, (const u16*)(ws + OFF_H2), (const u16*)(ws + OFF_WGU), NTOK, 5632, 1024, E);
}

__device__ __forceinline__ void step_down(const Params& p, char* smem) {
  char* ws = p.ws;
  EpiDown E{(const float*)(ws + OFF_MOD), p.out};
  run_gemm8(smem, (const u16*)(ws + OFF_ACT), (const u16*)(ws + OFF_WDOWN), NTOK, 1024, 2816, E);
}

__device__ __forceinline__ void step_final(const Params& p) {
  const int tid = get_tid(), lane = tid & 63, wave = tid >> 6;
  for (int r = blockIdx.x * 8 + wave; r < NTOK; r += gridDim.x * 8) {
    float* xr = p.out + (size_t)r * 1024;
    float4 v[4];
    float ss = 0.f;
#pragma unroll
    for (int i = 0; i < 4; ++i) {
      v[i] = ((const float4*)xr)[i * 64 + lane];
      ss += v[i].x * v[i].x + v[i].y * v[i].y + v[i].z * v[i].z + v[i].w * v[i].w;
    }
    ss = wave_sum(ss);
    float rinv = rsqrtf(ss * (1.f / 1024.f) + 1e-6f);
#pragma unroll
    for (int i = 0; i < 4; ++i) {
      float4 w4 = ((const float4*)p.final_norm_w)[i * 64 + lane];
      ((float4*)xr)[i * 64 + lane] = float4{v[i].x * rinv * w4.x, v[i].y * rinv * w4.y, v[i].z * rinv * w4.z, v[i].w * rinv * w4.w};
    }
  }
}

constexpr int NSTEPS = 29;

__global__ void __launch_bounds__(NTHR) mega(Params p_arg) {
  const int step_lo = p_arg.step_lo, step_hi = p_arg.step_hi;
  __shared__ __attribute__((aligned(16))) char smem[SMEM_BYTES];
#if !MULTI_LAUNCH
  if (threadIdx.x == 0) *(uint4*)(smem + SMEM_BYTES - 16) = uint4{0u, 0u, 0u, 0u};
  __syncthreads();
  XcdBarrier xb = xcd_barrier_post((unsigned*)(p_arg.ws + OFF_BAR), (volatile LAS unsigned*)(smem + SMEM_BYTES - 16));
#endif
  for (int step = step_lo; step <= step_hi; ++step) {
#if defined(__HIP_DEVICE_COMPILE__)
    const __attribute__((address_space(4))) Params* pp = (const __attribute__((address_space(4))) Params*)__builtin_amdgcn_kernarg_segment_ptr();
    asm volatile("" : "+s"(pp));
    const Params p = *pp;
#else
    const Params p = p_arg;
#endif
    const int scode = step == 0 ? 0 : (step <= 24 ? 1 + ((step - 1) & 7) : step - 16);
    const int reps = ((RM >> scode) & 1) ? 2 : 1;
    for (int rep = 0; rep < reps; ++rep)
    if (step == 0) { if (SM & 1) step_prep(p, smem); }
    else if (step <= 24) {
      int g = (step - 1) >> 3, s = (step - 1) & 7;
      switch (s) {
        case 0: if (SM & 2) step_norm<0>(p, g); break;
        case 1: if (SM & 4) step_gemm1(p, smem); break;
        case 2: if (SM & 8) step_cr1(p, g); break;
        case 3: if (SM & 16) step_r2(p, smem); break;
        case 4: if (SM & 32) step_scan(p, smem, g); break;
        case 5: if (SM & 64) step_fin(p, g); break;
        case 6: if (SM & 128) step_outproj(p, smem); break;
        default: if (SM & 256) step_wo(p, smem, g); break;
      }
    } else if (step == 25) { if (SM & 512) step_norm<1>(p, 0); }
    else if (step == 26) { if (SM & 1024) step_gu(p, smem); }
    else if (step == 27) { if (SM & 2048) step_down(p, smem); }
    else { if (SM & 4096) step_final(p); }
    if (step < step_hi) {
#if !MULTI_LAUNCH
      if (step == step_lo) cg::this_grid().sync();
      else for (int xs = 0; xs < 1 + XSYNC; ++xs) xcd_barrier(xb);
#endif
    }
  }
}

extern "C" void kernel_launch(void* const* d_in, const int* in_sizes, int n_in, void* d_out, int out_size,
                              void* d_ws, size_t ws_size, hipStream_t stream) {
  Params p{};
  const float** pp = (const float**)&p;
  for (int i = 0; i < 36; ++i) pp[i] = (const float*)d_in[i];
  p.out = (float*)d_out;
  p.ws = (char*)d_ws;
  if (ws_size < WS_NEED) fprintf(stderr, "workspace too small: %zu < %zu\n", ws_size, (size_t)WS_NEED);
#if MULTI_LAUNCH
  for (int s = 0; s < NSTEPS; ++s) {
    p.step_lo = s;
    p.step_hi = s;
    hipLaunchKernelGGL(mega, dim3(256), dim3(NTHR), 0, stream, p);
  }
#else
  static int grid_blocks = 0;
  if (!grid_blocks) {
    int dev = 0, cus = 0, per_cu = 0;
    hipGetDevice(&dev);
    hipDeviceGetAttribute(&cus, hipDeviceAttributeMultiprocessorCount, dev);
    hipOccupancyMaxActiveBlocksPerMultiprocessor(&per_cu, mega, NTHR, 0);
    if (per_cu < 1) per_cu = 1;
    if (per_cu > 1) per_cu = 1;
    grid_blocks = cus * per_cu;
  }
  p.step_lo = 0;
  p.step_hi = NSTEPS - 1;
  void* args[] = {&p};
  hipMemsetAsync((char*)d_ws + OFF_BAR, 0, XCD_BAR_WORDS_C * 4, stream);
  hipError_t e = hipLaunchCooperativeKernel((void*)mega, dim3(grid_blocks), dim3(NTHR), args, 0, stream);
  if (e != hipSuccess) fprintf(stderr, "cooperative launch failed: %s (grid %d)\n", hipGetErrorString(e), grid_blocks);
#endif
}
```

```cpp
#include <hip/hip_runtime.h>
#include <hip/hip_cooperative_groups.h>
#include <hip/hip_fp16.h>
#include <cstdio>
#include <cstdint>
namespace cg = cooperative_groups;

#ifndef MULTI_LAUNCH
#define MULTI_LAUNCH 0
#endif

#define DI __device__ __forceinline__
typedef __attribute__((ext_vector_type(8))) short bf16x8;
typedef __attribute__((ext_vector_type(4))) float f32x4;
typedef unsigned short u16;

#ifndef STEP_MASK
#define STEP_MASK 0xffffff
#endif
constexpr int SM = STEP_MASK;
#ifndef REPEAT_MASK
#define REPEAT_MASK 0
#endif
#ifndef XSYNC
#define XSYNC 0
#endif
constexpr int RM = REPEAT_MASK;
constexpr int TG = 4096;
constexpr int NTOK = 12288;
constexpr int NPAD = 10752;
constexpr int NTHR = 512;
constexpr int SMEM_BYTES = 133120;
constexpr int XCD_BAR_WORDS_C = 3456;

constexpr size_t OFF_WIN = 0;
constexpr size_t OFF_WGU = OFF_WIN + (size_t)NPAD * 1024 * 2;
constexpr size_t OFF_WDOWN = OFF_WGU + (size_t)5632 * 1024 * 2;
constexpr size_t OFF_WMOUT = OFF_WDOWN + (size_t)1024 * 2816 * 2;
constexpr size_t OFF_WROUT = OFF_WMOUT + (size_t)1024 * 2048 * 2;
constexpr size_t OFF_WO = OFF_WROUT + (size_t)1024 * 1024 * 2;
constexpr size_t OFF_W2T = OFF_WO + (size_t)1024 * 1024 * 2;
constexpr size_t OFF_A2T = OFF_W2T + 262144;
constexpr size_t OFF_G2T = OFF_A2T + 262144;
constexpr size_t OFF_MOD = OFF_G2T + 262144;
constexpr size_t OFF_GRP = OFF_MOD + 73728;
constexpr size_t OFF_Z = OFF_GRP;
constexpr size_t OFF_GATE = OFF_Z + (size_t)TG * 2048 * 2;
constexpr size_t OFF_XBC = OFF_GATE + (size_t)TG * 2048 * 2;
constexpr size_t OFF_WK = OFF_XBC + (size_t)TG * 3072 * 2;
constexpr size_t OFF_GR = OFF_WK + (size_t)TG * 16 * 1024;
constexpr size_t OFF_DT = OFF_GR + (size_t)TG * 1024 * 2;
constexpr size_t OFF_TL = OFF_DT + (size_t)TG * 64 * 4;
constexpr size_t OFF_SG = OFF_TL + (size_t)TG * 256 * 2;
constexpr size_t OFF_R = OFF_SG + (size_t)TG * 128 * 2;
constexpr size_t OFF_H1 = OFF_R;
constexpr size_t OFF_XBCRAW = OFF_H1 + (size_t)TG * 1024 * 2;
constexpr size_t OFF_RW = OFF_XBCRAW + (size_t)TG * 3072 * 2;
constexpr size_t OFF_SYF = OFF_R;
constexpr size_t OFF_SYB = OFF_SYF + (size_t)TG * 2048 * 2;
constexpr size_t OFF_WYF = OFF_SYB + (size_t)TG * 2048 * 2;
constexpr size_t OFF_WYB = OFF_WYF + (size_t)TG * 1024 * 2;
constexpr size_t OFF_YM = OFF_WYB + (size_t)TG * 1024 * 2;
constexpr size_t OFF_YR = OFF_YM + (size_t)TG * 2048 * 2;
constexpr size_t OFF_END = OFF_YR + (size_t)TG * 1024 * 2;
constexpr size_t OFF_BAR = OFF_END;
constexpr size_t WS_NEED = OFF_BAR + XCD_BAR_WORDS_C * 4;
constexpr size_t OFF_U = OFF_XBC;
constexpr size_t OFF_H2 = OFF_GRP;
constexpr size_t OFF_ACT = OFF_H2 + (size_t)NTOK * 1024 * 2;

constexpr size_t OUT_SSMF = 12582912;
constexpr size_t OUT_SSMB = OUT_SSMF + 8388608;
constexpr size_t OUT_WKVF = OUT_SSMB + 8388608;
constexpr size_t OUT_WKVB = OUT_WKVF + 2097152;

struct Params {
  const float *x_prompt, *x_sample, *ssm_f, *ssm_b, *wkv_f, *wkv_b, *c, *c_ctx, *norm1_w, *norm2_w,
      *w_ada, *b_ada, *w_in, *conv_w, *conv_b, *dt_bias, *a_log, *d_skip, *m_norm_w, *mu_shift, *w0,
      *w2, *a0, *a2, *g2, *k_k, *k_a, *r_k, *lnx_w, *lnx_b, *w_m_out, *w_r_out, *w_o, *w_gu, *w_down,
      *final_norm_w;
  float* out;
  char* ws;
  int step_lo, step_hi;
};

DI int get_tid() {
  int t = threadIdx.x;
  asm volatile("" : "+v"(t));
  return t;
}
DI u16 f2bf(float f) {
  unsigned u = __float_as_uint(f);
  u += 0x7fffu + ((u >> 16) & 1u);
  return (u16)(u >> 16);
}
DI float bf2f(u16 h) { return __uint_as_float(((unsigned)h) << 16); }
DI float siluf(float x) { return x / (1.f + __expf(-x)); }
DI float sigm(float x) { return 1.f / (1.f + __expf(-x)); }
DI float wave_sum(float v) {
#pragma unroll
  for (int o = 32; o > 0; o >>= 1) v += __shfl_xor(v, o);
  return v;
}
DI unsigned pack2(float a, float b) { return (unsigned)f2bf(a) | ((unsigned)f2bf(b) << 16); }
DI int mrow_of(int tok) { return tok < 8192 ? 0 : 1 + ((tok - 8192) >> 11); }


#define XB_TMO      128
#define XB_XCNT(j)  (256  + 64 * (j))
#define XB_XSUB(j)  (1280 + 64 * (j))
#define XB_XGEN(j)  (2304 + 64 * (j))
#define XB_TOP      3328
#define XB_TOPGEN   3392
#define XCD_BAR_WORDS 3456
#define XB_SPIN_CAP (1u << 22)
#define LAS __attribute__((address_space(3)))
DI unsigned xb_ld(unsigned* p) { return __hip_atomic_load(p, __ATOMIC_RELAXED, __HIP_MEMORY_SCOPE_AGENT); }
DI unsigned xb_add(unsigned* p, unsigned v) { return __hip_atomic_fetch_add(p, v, __ATOMIC_RELAXED, __HIP_MEMORY_SCOPE_AGENT); }
DI unsigned xb_xcc_id() { return (unsigned)__builtin_amdgcn_s_getreg((3 << 11) | 20) & 0xFu; }
#define XB_SPIN(cond, bar) do { unsigned _sp = 0; while (cond) { __builtin_amdgcn_s_sleep(1); \
    if ((++_sp & 255u) == 0u) { if (xb_ld(&(bar)[XB_TMO])) break; if (_sp > XB_SPIN_CAP) { atomicAdd(&(bar)[XB_TMO], 1u); break; } } } } while (0)
struct XcdBarrier { unsigned* bar; unsigned x; volatile LAS unsigned* st; };
DI XcdBarrier xcd_barrier_post(unsigned* bar, volatile LAS unsigned* st) {
  XcdBarrier b; b.bar = bar; b.x = xb_xcc_id(); b.st = st;
  if (threadIdx.x == 0) (void)xb_add(&bar[XB_XCNT(b.x)], 1u);
  return b;
}
DI void xcd_barrier_complete(unsigned* bar, unsigned x, unsigned& nloc, unsigned& nx) {
  const unsigned G = gridDim.x * gridDim.y * gridDim.z;
  unsigned sum, cnt, mine, sp = 0u;
  for (;;) {
    sum = 0u; cnt = 0u; mine = 0u;
#pragma unroll
    for (unsigned j = 0; j < 16; ++j) { const unsigned c = xb_ld(&bar[XB_XCNT(j)]); sum += c; cnt += (c > 0u) ? 1u : 0u; mine = (j == x) ? c : mine; }
    if (sum == G) break;
    __builtin_amdgcn_s_sleep(1);
    if ((++sp & 255u) == 0u) { if (xb_ld(&bar[XB_TMO])) break; if (sp > XB_SPIN_CAP) { atomicAdd(&bar[XB_TMO], 1u); break; } }
  }
  nloc = mine > 0u ? mine : 1u; nx = cnt > 0u ? cnt : 1u;
}
DI void xcd_barrier(const XcdBarrier& b) {
  asm volatile("s_waitcnt vmcnt(0)" ::: "memory");
  __syncthreads();
  if (threadIdx.x == 0) {
    unsigned* bar = b.bar;
    asm volatile("" : "+s"(bar));
    __builtin_amdgcn_s_waitcnt(0);
    unsigned nloc = b.st[0], nx = b.st[1];
    if (nloc == 0u) { xcd_barrier_complete(bar, b.x, nloc, nx); b.st[0] = nloc; b.st[1] = nx; }
    const unsigned old = xb_add(&bar[XB_XSUB(b.x)], 1u);
    const unsigned gen = old / nloc;
    if (old + 1u == (gen + 1u) * nloc) {
      __builtin_amdgcn_fence(__ATOMIC_RELEASE, "agent");
      asm volatile("s_waitcnt vmcnt(0)" ::: "memory");
      const unsigned og = xb_add(&bar[XB_TOP], 1u);
      const unsigned tg = og / nx;
      if (og + 1u == (tg + 1u) * nx) xb_add(&bar[XB_TOPGEN], 1u);
      else XB_SPIN(xb_ld(&bar[XB_TOPGEN]) == tg, bar);
      __builtin_amdgcn_fence(__ATOMIC_ACQUIRE, "agent");
      xb_add(&bar[XB_XGEN(b.x)], 1u);
      asm volatile("s_waitcnt vmcnt(0)" ::: "memory");
    } else {
      XB_SPIN(xb_ld(&bar[XB_XGEN(b.x)]) == gen, bar);
      __builtin_amdgcn_fence(__ATOMIC_ACQUIRE, "agent");
      asm volatile("s_waitcnt vmcnt(0)" ::: "memory");
    }
  }
  __syncthreads();
}

DI void gemm_load(const int tid, const u16* A, int lda, const u16* B, int ldb, int k0, uint4 (&ra)[4], uint4 (&rb)[2]) {
#pragma unroll
  for (int i = 0; i < 4; ++i) {
    int idx = tid + i * 512;
    int row = idx >> 3, ch = idx & 7;
    ra[i] = *(const uint4*)(A + (size_t)row * lda + k0 + ch * 8);
  }
#pragma unroll
  for (int i = 0; i < 2; ++i) {
    int idx = tid + i * 512;
    int row = idx >> 3, ch = idx & 7;
    rb[i] = *(const uint4*)(B + (size_t)row * ldb + k0 + ch * 8);
  }
}
DI void gemm_store_lds(const int tid, char* sA, char* sB, const uint4 (&ra)[4], const uint4 (&rb)[2]) {
#pragma unroll
  for (int i = 0; i < 4; ++i) {
    int idx = tid + i * 512;
    int row = idx >> 3, ch = idx & 7;
    *(uint4*)(sA + row * 128 + ((ch ^ ((row >> 1) & 7)) << 4)) = ra[i];
  }
#pragma unroll
  for (int i = 0; i < 2; ++i) {
    int idx = tid + i * 512;
    int row = idx >> 3, ch = idx & 7;
    *(uint4*)(sB + row * 128 + ((ch ^ ((row >> 1) & 7)) << 4)) = rb[i];
  }
}
DI void gemm_compute(const char* sA, const char* sB, f32x4 (&acc)[4][4], int wm, int wn, int lane) {
#pragma unroll
  for (int kk = 0; kk < 2; ++kk) {
    bf16x8 a[4], b[4];
    const int ch = kk * 4 + (lane >> 4);
#pragma unroll
    for (int mf = 0; mf < 4; ++mf) {
      int row = wm * 64 + mf * 16 + (lane & 15);
      a[mf] = *(const bf16x8*)(sA + row * 128 + ((ch ^ ((row >> 1) & 7)) << 4));
    }
#pragma unroll
    for (int nf = 0; nf < 4; ++nf) {
      int row = wn * 64 + nf * 16 + (lane & 15);
      b[nf] = *(const bf16x8*)(sB + row * 128 + ((ch ^ ((row >> 1) & 7)) << 4));
    }
#pragma unroll
    for (int mf = 0; mf < 4; ++mf)
#pragma unroll
      for (int nf = 0; nf < 4; ++nf)
        acc[mf][nf] = __builtin_amdgcn_mfma_f32_16x16x32_bf16(a[mf], b[nf], acc[mf][nf], 0, 0, 0);
  }
}
DI void gemm_acc(const u16* A, int lda, const u16* B, int ldb, int K, f32x4 (&acc)[4][4], char* smem) {
  const int tid = get_tid(), lane = tid & 63, wave = tid >> 6;
  const int wm = wave >> 1, wn = wave & 1;
  char* sA0 = smem;
  char* sB0 = smem + 32768;
  char* sA1 = smem + 49152;
  char* sB1 = smem + 81920;
  uint4 ra[4], rb[2];
  const int nk = K >> 6;
  gemm_load(tid, A, lda, B, ldb, 0, ra, rb);
  gemm_store_lds(tid, sA0, sB0, ra, rb);
  __syncthreads();
  for (int kt = 0; kt < nk; ++kt) {
    const bool more = (kt + 1 < nk);
    if (more) gemm_load(tid, A, lda, B, ldb, (kt + 1) * 64, ra, rb);
    if (kt & 1) gemm_compute(sA1, sB1, acc, wm, wn, lane);
    else gemm_compute(sA0, sB0, acc, wm, wn, lane);
    if (more) {
      if (kt & 1) gemm_store_lds(tid, sA0, sB0, ra, rb);
      else gemm_store_lds(tid, sA1, sB1, ra, rb);
    }
    __syncthreads();
  }
}
DI void zero_acc(f32x4 (&acc)[4][4]) {
#pragma unroll
  for (int i = 0; i < 4; ++i)
#pragma unroll
    for (int j = 0; j < 4; ++j) { float z0; asm volatile("v_mov_b32 %0, 0" : "=v"(z0)); acc[i][j] = f32x4{z0, z0, z0, z0}; }
}

#define PG8_LAS __attribute__((address_space(3)))
namespace pg8 {
typedef unsigned short bf16_t;
typedef short bf16x8 __attribute__((ext_vector_type(8)));
typedef float f32x4 __attribute__((ext_vector_type(4)));
typedef unsigned u32x4 __attribute__((ext_vector_type(4)));
constexpr int BM = 256, BK = 64, HALF = 128, HTB = HALF * BK * 2  , STAGE_BYTES = 8 * HTB, NXCD = 8, WGM = 8;

__host__ __device__ __forceinline__ int lds_byte(int r, int c) { const int st = (r >> 4) * 2 + (c >> 5), rr = r & 15, cc = c & 31, ob = rr * 64 + cc * 2; return st * 1024 + (ob ^ (((ob >> 9) & 1) << 5)); }
__host__ __device__ __forceinline__ void stage_rc(int b, int& R, int& C) { const int st = b / 1024, sb = b % 1024, swz = sb ^ (((sb >> 9) & 1) << 5); R = (st >> 1) * 16 + swz / 64; C = (st & 1) * 32 + (swz % 64) / 2; }
__host__ __device__ __forceinline__ int perm32(int rho) { const int n = rho >> 4, i = rho & 15; return 8 * (i >> 2) + 4 * n + (i & 3); }

struct Unit { int pm, pn; };
struct Gemm { const bf16_t* A; const bf16_t* Bt; int M, N, K; };

struct StaticOrder {
    int nM, nN, nwg, G, c;
    __host__ __device__ void init(int M, int N, int G_, int c_) { nM = M / BM; nN = N / BM; nwg = nM * nN; G = G_; c = c_; }
    __host__ __device__ bool next(int i, Unit& u) const {
        const long L = (long)i * G + c; if (L >= nwg) return false;
        int wgid = (int)L; { const int q = nwg / NXCD, r = nwg % NXCD, xcd = wgid % NXCD, off = wgid / NXCD; wgid = (xcd < r ? xcd * (q + 1) : r * (q + 1) + (xcd - r) * q) + off; }
        const int nig = WGM * nN, gid = wgid / nig, fm = gid * WGM, gsz = (nM - fm) < WGM ? (nM - fm) : WGM;
        u.pm = fm + ((wgid % nig) % gsz); u.pn = (wgid % nig) / gsz; return true;
    }
    __device__ __forceinline__ void a_ready(const Unit&) const {}
    __device__ __forceinline__ void done(const Unit&) const {}
};
__device__ __forceinline__ unsigned cvt_pk_bf16(float lo, float hi) { unsigned r; asm volatile("v_cvt_pk_bf16_f32 %0, %1, %2" : "=v"(r) : "v"(lo), "v"(hi)); return r; }
template <class Epi, class Sched, bool STAMP = false>
__device__ __forceinline__ void gemm_phase(PG8_LAS unsigned char* lds, const Gemm g, const Sched& S, const Epi& E, unsigned long long* stamps) {
    const int tid = get_tid(), wid = __builtin_amdgcn_readfirstlane(tid >> 6), lane = tid & 63, wr = wid >> 2, wc = wid & 3, fr = lane & 15, fq = lane >> 4;
    const int K = g.K, nt = K / BK;
    int ts_lo = 0, ts_hi = 0, nts = 0; const unsigned long long rt_entry = STAMP ? (unsigned long long)wall_clock64() : 0ull;
#define PG8_STAMP() do { if (STAMP && wid == 0 && nts < 64) { const unsigned long long _c = (unsigned long long)clock64(); \
        ts_lo = (lane == nts) ? (int)(unsigned)_c : ts_lo; ts_hi = (lane == nts) ? (int)(unsigned)(_c >> 32) : ts_hi; ++nts; } } while (0)
    PG8_STAMP();
    unsigned voffA[2], voffB[2];
#pragma unroll
    for (int i = 0; i < 2; ++i) { int R, C; stage_rc(tid * 16 + i * 8192, R, C); const int Rb = Epi::PERM ? ((R & ~31) + perm32(R & 31)) : R;
        voffA[i] = (unsigned)(R * K + C) * 2u; voffB[i] = (unsigned)(Rb * K + C) * 2u; }
    const size_t kstep = (size_t)(BK * 2);
    const size_t hstep = (size_t)HALF * K * 2;
    const size_t tstep = 2 * hstep;
    const unsigned ldsw = (unsigned)wid * 1024u;
    const int aoff = lds_byte(wr * 64 + fr, fq * 8), boff = lds_byte(wc * 32 + fr, fq * 8);
#define PG8_SA(b, h) (((b) * 2 + (h)) * HTB)
#define PG8_SB(b, h) ((4 + (b) * 2 + (h)) * HTB)
#define PG8_STAGE(bufoff, gbase, voff) do { _Pragma("unroll") for (int _i = 0; _i < 2; ++_i) \
        __builtin_amdgcn_global_load_lds((const unsigned*)((const char*)(gbase) + (voff)[_i]), (PG8_LAS unsigned*)(lds + (bufoff) + ldsw + _i * 8192), 16, 0, 0); } while (0)
#define PG8_LDA(dst, b, h) do { _Pragma("unroll") for (int m = 0; m < 4; ++m) _Pragma("unroll") for (int k = 0; k < 2; ++k) dst[m][k] = *(const PG8_LAS bf16x8*)(lds + PG8_SA(b, h) + aoff + m * 2048 + k * 1024); } while (0)
#define PG8_LDB(dst, b, h) do { _Pragma("unroll") for (int n = 0; n < 2; ++n) _Pragma("unroll") for (int k = 0; k < 2; ++k) dst[n][k] = *(const PG8_LAS bf16x8*)(lds + PG8_SB(b, h) + boff + n * 2048 + k * 1024); } while (0)
#define PG8_MMA(ai, bj, At, Bt) do { __builtin_amdgcn_s_setprio(1); _Pragma("unroll") for (int m = 0; m < 4; ++m) _Pragma("unroll") for (int n = 0; n < 2; ++n) _Pragma("unroll") for (int k = 0; k < 2; ++k) \
        acc[ai][bj][m][n] = __builtin_amdgcn_mfma_f32_16x16x32_bf16(Bt[n][k], At[m][k], acc[ai][bj][m][n], 0, 0, 0); __builtin_amdgcn_s_setprio(0); } while (0)
#define PG8_WAIT_V(n) asm volatile("s_waitcnt vmcnt(" #n ")" ::: "memory")
#define PG8_WAIT_L(n) asm volatile("s_waitcnt lgkmcnt(" #n ")" ::: "memory")
#define PG8_BAR __builtin_amdgcn_s_barrier()
#define PG8_SCHED __builtin_amdgcn_sched_barrier(0)
    Unit cur, nxt; int ui = 0;
    if (!S.next(0, cur)) return;
    f32x4 acc[2][2][4][2];
#pragma unroll
    for (int a = 0; a < 2; ++a)
#pragma unroll
        for (int b = 0; b < 2; ++b)
#pragma unroll
            for (int m = 0; m < 4; ++m)
#pragma unroll
                for (int n = 0; n < 2; ++n) { float z0; asm volatile("v_mov_b32 %0, 0" : "=v"(z0)); acc[a][b][m][n] = (f32x4){z0, z0, z0, z0}; }
    bf16x8 At[4][2], B0[2][2], B1[2][2];
    const char* cA = (const char*)g.A + (size_t)cur.pm * tstep; const char* cB = (const char*)g.Bt + (size_t)cur.pn * tstep;
    S.a_ready(cur);
    PG8_STAGE(PG8_SB(0, 0), cB, voffB); PG8_STAGE(PG8_SA(0, 0), cA, voffA); PG8_STAGE(PG8_SB(0, 1), cB + hstep, voffB); PG8_STAGE(PG8_SA(0, 1), cA + hstep, voffA);
    if (wr == 1) PG8_BAR;
    PG8_WAIT_V(4); PG8_BAR;
    PG8_STAGE(PG8_SB(1, 0), cB + kstep, voffB); PG8_STAGE(PG8_SA(1, 0), cA + kstep, voffA); PG8_STAGE(PG8_SB(1, 1), cB + hstep + kstep, voffB);
    PG8_WAIT_V(6); PG8_BAR;
    PG8_STAMP();
    for (;;) {
        const bool has_next = S.next(ui + 1, nxt);
        const char* nA = has_next ? (const char*)g.A + (size_t)nxt.pm * tstep : cA; const char* nB = has_next ? (const char*)g.Bt + (size_t)nxt.pn * tstep : cB;
        for (int t = 0; t < nt; t += 2) {
            const bool last = (t == nt - 2);
            const char* a1 = cA + (size_t)(t + 1) * kstep;
            const char* a2 = last ? nA : cA + (size_t)(t + 2) * kstep; const char* b2 = last ? nB : cB + (size_t)(t + 2) * kstep;
            const char* a3 = a2 + kstep; const char* b3 = b2 + kstep;
            if (last && has_next) S.a_ready(nxt);
            PG8_LDB(B0, 0, 0); PG8_SCHED; PG8_LDA(At, 0, 0); PG8_STAGE(PG8_SA(1, 1), a1 + hstep, voffA);
            PG8_WAIT_L(8); PG8_BAR; PG8_WAIT_L(0); PG8_MMA(0, 0, At, B0); PG8_BAR; PG8_SCHED;
            PG8_LDB(B1, 0, 1); PG8_STAGE(PG8_SB(0, 0), b2, voffB);
            PG8_BAR; PG8_WAIT_L(0); PG8_MMA(0, 1, At, B1); PG8_BAR;
            PG8_LDA(At, 0, 1); PG8_STAGE(PG8_SA(0, 0), a2, voffA);
            PG8_BAR; PG8_WAIT_L(0); PG8_MMA(1, 0, At, B0); PG8_BAR; PG8_SCHED;
            PG8_STAGE(PG8_SB(0, 1), b2 + hstep, voffB);
            PG8_WAIT_V(6); PG8_BAR; PG8_MMA(1, 1, At, B1); PG8_BAR;
            PG8_LDB(B0, 1, 0); PG8_SCHED; PG8_LDA(At, 1, 0); PG8_STAGE(PG8_SA(0, 1), a2 + hstep, voffA);
            PG8_WAIT_L(8); PG8_BAR; PG8_WAIT_L(0); PG8_MMA(0, 0, At, B0); PG8_BAR; PG8_SCHED;
            PG8_LDB(B1, 1, 1); PG8_STAGE(PG8_SB(1, 0), b3, voffB);
            PG8_BAR; PG8_WAIT_L(0); PG8_MMA(0, 1, At, B1); PG8_BAR;
            PG8_LDA(At, 1, 1); PG8_STAGE(PG8_SA(1, 0), a3, voffA);
            PG8_BAR; PG8_WAIT_L(0); PG8_MMA(1, 0, At, B0); PG8_BAR; PG8_SCHED;
            PG8_STAGE(PG8_SB(1, 1), b3 + hstep, voffB);
            PG8_WAIT_V(6); PG8_BAR; PG8_MMA(1, 1, At, B1); PG8_BAR;
        }
        PG8_STAMP();
        if constexpr (!Epi::AFTER_DRAIN) { E(acc, cur, wr, wc, fr, fq); S.done(cur); }
        PG8_STAMP();
        if (!has_next) break;
#pragma unroll
        for (int a = 0; a < 2; ++a)
#pragma unroll
            for (int b = 0; b < 2; ++b)
#pragma unroll
                for (int m = 0; m < 4; ++m)
#pragma unroll
                    for (int n = 0; n < 2; ++n) { float z0; asm volatile("v_mov_b32 %0, 0" : "=v"(z0)); acc[a][b][m][n] = (f32x4){z0, z0, z0, z0}; }
        cur = nxt; cA = nA; cB = nB; ++ui;
    }
    PG8_WAIT_V(0);
    if (wr == 0) PG8_BAR;
    PG8_BAR;
    if constexpr (Epi::AFTER_DRAIN) { E.fused(acc, cur, wr, wc, fr, fq, lds, wid, lane); S.done(cur); }
    PG8_STAMP();
    if (STAMP && wid == 0) { stamps[lane] = lane < nts ? (((unsigned long long)(unsigned)ts_hi << 32) | (unsigned)ts_lo) : 0ull;
        if (lane == 62) stamps[62] = rt_entry; if (lane == 63) stamps[63] = (unsigned long long)wall_clock64(); }
#undef PG8_STAMP
#undef PG8_SA
#undef PG8_SB
#undef PG8_STAGE
#undef PG8_LDA
#undef PG8_LDB
#undef PG8_MMA
#undef PG8_WAIT_V
#undef PG8_WAIT_L
#undef PG8_BAR
#undef PG8_SCHED
}
}

using pg8::cvt_pk_bf16;
DI uint4 pack8(const pg8::f32x4& a, const pg8::f32x4& b) {
  return uint4{cvt_pk_bf16(a[0], a[1]), cvt_pk_bf16(a[2], a[3]), cvt_pk_bf16(b[0], b[1]), cvt_pk_bf16(b[2], b[3])};
}
DI void unpack8(const uint4& u, float (&o)[8]) {
  o[0] = bf2f((u16)(u.x & 0xffff)); o[1] = bf2f((u16)(u.x >> 16));
  o[2] = bf2f((u16)(u.y & 0xffff)); o[3] = bf2f((u16)(u.y >> 16));
  o[4] = bf2f((u16)(u.z & 0xffff)); o[5] = bf2f((u16)(u.z >> 16));
  o[6] = bf2f((u16)(u.w & 0xffff)); o[7] = bf2f((u16)(u.w >> 16));
}
struct EpiP {
  static constexpr bool PERM = true, AFTER_DRAIN = false;
  u16 *zb, *xr, *rwb, *gb; float* dtb;
  DI void operator()(const pg8::f32x4 (&acc)[2][2][4][2], const pg8::Unit& u, int wr, int wc, int fr, int fq) const {
    const int row0 = u.pm * 256 + wr * 64 + fr;
#pragma unroll
    for (int bj = 0; bj < 2; ++bj) {
      const int cg = u.pn * 256 + bj * 128 + wc * 32;
      const int col0 = cg + 8 * fq;
      if (cg >= 10688) continue;
#pragma unroll
      for (int ai = 0; ai < 2; ++ai)
#pragma unroll
        for (int m = 0; m < 4; ++m) {
          const size_t row = row0 + ai * 128 + m * 16;
          const pg8::f32x4 v0 = acc[ai][bj][m][0], v1 = acc[ai][bj][m][1];
          if (cg >= 5120 && cg < 5184) {
            float* d = dtb + row * 64 + (col0 - 5120);
            *(pg8::f32x4*)d = v0; *(pg8::f32x4*)(d + 4) = v1;
          } else {
            u16* dst = (cg < 2048) ? zb + row * 2048 + col0
                     : (cg < 5120) ? xr + row * 3072 + (col0 - 2048)
                     : (cg < 8640) ? rwb + row * 3456 + (col0 - 5184)
                                   : gb + row * 2048 + (col0 - 8640);
            *(uint4*)dst = pack8(v0, v1);
          }
        }
    }
  }
};
template <int PASS>
struct EpiOut {
  static constexpr bool PERM = true, AFTER_DRAIN = false;
  const u16* gb; u16* U;
  DI void operator()(const pg8::f32x4 (&acc)[2][2][4][2], const pg8::Unit& u, int wr, int wc, int fr, int fq) const {
    const int row0 = u.pm * 256 + wr * 64 + fr;
#pragma unroll
    for (int bj = 0; bj < 2; ++bj) {
      const int col0 = u.pn * 256 + bj * 128 + wc * 32 + 8 * fq;
#pragma unroll
      for (int ai = 0; ai < 2; ++ai)
#pragma unroll
        for (int m = 0; m < 4; ++m) {
          const size_t row = row0 + ai * 128 + m * 16;
          float gt[8];
          unpack8(*(const uint4*)(gb + row * 2048 + PASS * 1024 + col0), gt);
          pg8::f32x4 v0 = acc[ai][bj][m][0], v1 = acc[ai][bj][m][1];
#pragma unroll
          for (int e = 0; e < 4; ++e) { v0[e] *= sigm(gt[e]); v1[e] *= sigm(gt[4 + e]); }
          if (PASS == 1) {
            float pu[8];
            unpack8(*(const uint4*)(U + row * 1024 + col0), pu);
#pragma unroll
            for (int e = 0; e < 4; ++e) { v0[e] += pu[e]; v1[e] += pu[4 + e]; }
          }
          *(uint4*)(U + row * 1024 + col0) = pack8(v0, v1);
        }
    }
  }
};
struct EpiWo {
  static constexpr bool PERM = true, AFTER_DRAIN = false;
  const float *xp, *xs, *mod; float* out; int tok0;
  DI void operator()(const pg8::f32x4 (&acc)[2][2][4][2], const pg8::Unit& u, int wr, int wc, int fr, int fq) const {
    const int row0 = u.pm * 256 + wr * 64 + fr;
#pragma unroll
    for (int bj = 0; bj < 2; ++bj) {
      const int col0 = u.pn * 256 + bj * 128 + wc * 32 + 8 * fq;
#pragma unroll
      for (int ai = 0; ai < 2; ++ai)
#pragma unroll
        for (int m = 0; m < 4; ++m) {
          const int tok = tok0 + row0 + ai * 128 + m * 16;
          const float* xr = tok < 8192 ? xp + (size_t)tok * 1024 : xs + (size_t)(tok - 8192) * 1024;
          const float* gt = mod + mrow_of(tok) * 6144 + 2048 + col0;
          const pg8::f32x4 x0 = *(const pg8::f32x4*)(xr + col0), x1 = *(const pg8::f32x4*)(xr + col0 + 4);
          const pg8::f32x4 g0 = *(const pg8::f32x4*)gt, g1 = *(const pg8::f32x4*)(gt + 4);
          float* o = out + (size_t)tok * 1024 + col0;
          *(pg8::f32x4*)o = x0 + g0 * acc[ai][bj][m][0];
          *(pg8::f32x4*)(o + 4) = x1 + g1 * acc[ai][bj][m][1];
        }
    }
  }
};
struct EpiGU {
  static constexpr bool PERM = true, AFTER_DRAIN = false;
  u16* act;
  DI void operator()(const pg8::f32x4 (&acc)[2][2][4][2], const pg8::Unit& u, int wr, int wc, int fr, int fq) const {
    const int row0 = u.pm * 256 + wr * 64 + fr;
    const int col0 = u.pn * 128 + wc * 32 + 8 * fq;
#pragma unroll
    for (int ai = 0; ai < 2; ++ai)
#pragma unroll
      for (int m = 0; m < 4; ++m) {
        const size_t row = row0 + ai * 128 + m * 16;
        pg8::f32x4 v0, v1;
#pragma unroll
        for (int e = 0; e < 4; ++e) {
          v0[e] = siluf(acc[ai][0][m][0][e]) * acc[ai][1][m][0][e];
          v1[e] = siluf(acc[ai][0][m][1][e]) * acc[ai][1][m][1][e];
        }
        *(uint4*)(act + row * 2816 + col0) = pack8(v0, v1);
      }
  }
};
struct EpiDown {
  static constexpr bool PERM = true, AFTER_DRAIN = false;
  const float* mod; float* out;
  DI void operator()(const pg8::f32x4 (&acc)[2][2][4][2], const pg8::Unit& u, int wr, int wc, int fr, int fq) const {
    const int row0 = u.pm * 256 + wr * 64 + fr;
#pragma unroll
    for (int bj = 0; bj < 2; ++bj) {
      const int col0 = u.pn * 256 + bj * 128 + wc * 32 + 8 * fq;
#pragma unroll
      for (int ai = 0; ai < 2; ++ai)
#pragma unroll
        for (int m = 0; m < 4; ++m) {
          const int tok = row0 + ai * 128 + m * 16;
          const float* gt = mod + mrow_of(tok) * 6144 + 5120 + col0;
          const pg8::f32x4 g0 = *(const pg8::f32x4*)gt, g1 = *(const pg8::f32x4*)(gt + 4);
          float* o = out + (size_t)tok * 1024 + col0;
          const pg8::f32x4 x0 = *(const pg8::f32x4*)o, x1 = *(const pg8::f32x4*)(o + 4);
          *(pg8::f32x4*)o = x0 + g0 * acc[ai][bj][m][0];
          *(pg8::f32x4*)(o + 4) = x1 + g1 * acc[ai][bj][m][1];
        }
    }
  }
};
template <class Epi>
DI void run_gemm8(char* smem, const u16* A, const u16* Bt, int M, int N, int K, const Epi& E) {
  asm volatile("" : "+s"(M), "+s"(N), "+s"(K));
  pg8::Gemm gm{A, Bt, M, N, K};
  pg8::StaticOrder S;
  S.init(M, N, gridDim.x, blockIdx.x);
  pg8::gemm_phase<Epi, pg8::StaticOrder, false>((PG8_LAS unsigned char*)smem, gm, S, E, nullptr);
  __syncthreads();
}

template <int MODE>
__device__ __forceinline__ void convT(const float* __restrict__ src, int K, int N, u16* __restrict__ dst, char* smem) {
  float* tile = (float*)smem;
  const int tid = get_tid();
  const int KT = K >> 6, NT = N >> 6;
  for (int t = blockIdx.x; t < KT * NT; t += gridDim.x) {
    int kt = t % KT, nt = t / KT;
#pragma unroll
    for (int i = 0; i < 8; ++i) {
      int idx = tid + i * 512;
      int r = idx >> 6, cc = idx & 63;
      tile[r * 65 + cc] = src[(size_t)(kt * 64 + r) * N + nt * 64 + cc];
    }
    __syncthreads();
    int n = tid >> 3, kc = tid & 7;
    unsigned w[4];
#pragma unroll
    for (int j = 0; j < 4; ++j)
      w[j] = pack2(tile[(kc * 8 + 2 * j) * 65 + n], tile[(kc * 8 + 2 * j + 1) * 65 + n]);
    int ng = nt * 64 + n;
    int row = ng;
    if (MODE == 1) {
      int isu = ng >= 2816;
      int nn = ng - isu * 2816;
      row = (nn >> 7) * 256 + isu * 128 + (nn & 127);
    }
    *(uint4*)(dst + (size_t)row * K + kt * 64 + kc * 8) = uint4{w[0], w[1], w[2], w[3]};
    __syncthreads();
  }
}

__device__ __forceinline__ void step_prep(const Params& p, char* smem) {
  const int tid = get_tid();
  char* ws = p.ws;
  {
    float* red = (float*)smem;
    float* mod = (float*)(ws + OFF_MOD);
    for (int item = blockIdx.x; item < 192; item += gridDim.x) {
      int c4 = tid & 7, kl = tid >> 3;
      float acc[12];
#pragma unroll
      for (int i = 0; i < 12; ++i) acc[i] = 0.f;
      for (int k = kl; k < 1024; k += 64) {
        float4 w = *(const float4*)(p.w_ada + (size_t)k * 6144 + item * 32 + c4 * 4);
        float s0 = siluf(p.c_ctx[k]), s1 = siluf(p.c[k]), s2 = siluf(p.c[1024 + k]);
        acc[0] += s0 * w.x; acc[1] += s0 * w.y; acc[2] += s0 * w.z; acc[3] += s0 * w.w;
        acc[4] += s1 * w.x; acc[5] += s1 * w.y; acc[6] += s1 * w.z; acc[7] += s1 * w.w;
        acc[8] += s2 * w.x; acc[9] += s2 * w.y; acc[10] += s2 * w.z; acc[11] += s2 * w.w;
      }
#pragma unroll
      for (int i = 0; i < 12; ++i) red[(kl * 8 + c4) * 12 + i] = acc[i];
      __syncthreads();
      if (tid < 96) {
        int cond = tid >> 5, col = tid & 31;
        int cc4 = col >> 2, e = col & 3;
        float s = 0.f;
        for (int k = 0; k < 64; ++k) s += red[(k * 8 + cc4) * 12 + cond * 4 + e];
        int n = item * 32 + col;
        mod[cond * 6144 + n] = s + p.b_ada[n];
      }
      __syncthreads();
    }
  }
  convT<0>(p.w_in, 1024, 10688, (u16*)(ws + OFF_WIN), smem);
  convT<1>(p.w_gu, 1024, 5632, (u16*)(ws + OFF_WGU), smem);
  convT<0>(p.w_down, 2816, 1024, (u16*)(ws + OFF_WDOWN), smem);
  convT<0>(p.w_m_out, 2048, 1024, (u16*)(ws + OFF_WMOUT), smem);
  convT<0>(p.w_r_out, 1024, 1024, (u16*)(ws + OFF_WROUT), smem);
  convT<0>(p.w_o, 1024, 1024, (u16*)(ws + OFF_WO), smem);
  convT<0>(p.w2, 64, 1024, (u16*)(ws + OFF_W2T), smem);
  convT<0>(p.w2 + 65536, 64, 1024, (u16*)(ws + OFF_W2T) + 65536, smem);
  convT<0>(p.a2, 64, 1024, (u16*)(ws + OFF_A2T), smem);
  convT<0>(p.a2 + 65536, 64, 1024, (u16*)(ws + OFF_A2T) + 65536, smem);
  convT<0>(p.g2, 128, 1024, (u16*)(ws + OFF_G2T), smem);
  {
    uint4* z = (uint4*)(ws + OFF_WIN + (size_t)10688 * 1024 * 2);
    for (int i = blockIdx.x * NTHR + tid; i < 8192; i += gridDim.x * NTHR) z[i] = uint4{0, 0, 0, 0};
  }
}

template <int WHICH>
__device__ __forceinline__ void step_norm(const Params& p, int g) {
  const int tid = get_tid(), lane = tid & 63, wave = tid >> 6;
  const float* mod = (const float*)(p.ws + OFF_MOD);
  const int nrows = WHICH == 0 ? TG : NTOK;
  u16* dst = (u16*)(p.ws + (WHICH == 0 ? OFF_H1 : OFF_H2));
  const float* nw = WHICH == 0 ? p.norm1_w : p.norm2_w;
  for (int r = blockIdx.x * 8 + wave; r < nrows; r += gridDim.x * 8) {
    int tok = WHICH == 0 ? g * TG + r : r;
    const float* xr;
    if (WHICH == 0) xr = tok < 8192 ? p.x_prompt + (size_t)tok * 1024 : p.x_sample + (size_t)(tok - 8192) * 1024;
    else xr = p.out + (size_t)tok * 1024;
    const float* mr = mod + mrow_of(tok) * 6144 + (WHICH == 0 ? 0 : 3072);
    float4 v[4];
    float ss = 0.f;
#pragma unroll
    for (int i = 0; i < 4; ++i) {
      v[i] = ((const float4*)xr)[i * 64 + lane];
      ss += v[i].x * v[i].x + v[i].y * v[i].y + v[i].z * v[i].z + v[i].w * v[i].w;
    }
    ss = wave_sum(ss);
    float rinv = rsqrtf(ss * (1.f / 1024.f) + 1e-6f);
#pragma unroll
    for (int i = 0; i < 4; ++i) {
      int col = (i * 64 + lane) * 4;
      float4 w4 = *(const float4*)(nw + col);
      float4 sh = *(const float4*)(mr + col);
      float4 sc = *(const float4*)(mr + 1024 + col);
      float h0 = v[i].x * rinv * w4.x * (1.f + sc.x) + sh.x;
      float h1 = v[i].y * rinv * w4.y * (1.f + sc.y) + sh.y;
      float h2 = v[i].z * rinv * w4.z * (1.f + sc.z) + sh.z;
      float h3 = v[i].w * rinv * w4.w * (1.f + sc.w) + sh.w;
      *(uint2*)(dst + (size_t)r * 1024 + col) = uint2{pack2(h0, h1), pack2(h2, h3)};
    }
  }
}

__device__ __forceinline__ void step_gemm1(const Params& p, char* smem) {
  char* ws = p.ws;
  EpiP E{(u16*)(ws + OFF_Z), (u16*)(ws + OFF_XBCRAW), (u16*)(ws + OFF_RW), (u16*)(ws + OFF_GATE), (float*)(ws + OFF_DT)};
  run_gemm8(smem, (const u16*)(ws + OFF_H1), (const u16*)(ws + OFF_WIN), TG, NPAD, 1024, E);
}

__device__ __forceinline__ void step_cr1(const Params& p, int g) {
  char* ws = p.ws;
  const int tid = get_tid(), lane = tid & 63, wave = tid >> 6;
  const int Ls = g < 2 ? 256 : 2048;
  {
    const u16* xr = (const u16*)(ws + OFF_XBCRAW);
    u16* xo = (u16*)(ws + OFF_XBC);
    for (int idx = blockIdx.x * NTHR + tid; idx < TG * 384; idx += gridDim.x * NTHR) {
      int r = idx / 384, cc = idx - r * 384;
      int pos = r & (Ls - 1);
      float s[8];
      {
        float4 b0 = *(const float4*)(p.conv_b + cc * 8), b1 = *(const float4*)(p.conv_b + cc * 8 + 4);
        s[0] = b0.x; s[1] = b0.y; s[2] = b0.z; s[3] = b0.w; s[4] = b1.x; s[5] = b1.y; s[6] = b1.z; s[7] = b1.w;
      }
#pragma unroll
      for (int i = 0; i < 5; ++i) {
        int pp = pos + i - 2;
        if (pp >= 0 && pp < Ls) {
          uint4 u = *(const uint4*)(xr + (size_t)(r + i - 2) * 3072 + cc * 8);
          float4 w0 = *(const float4*)(p.conv_w + i * 3072 + cc * 8), w1 = *(const float4*)(p.conv_w + i * 3072 + cc * 8 + 4);
          s[0] += bf2f(u.x & 0xffff) * w0.x; s[1] += bf2f(u.x >> 16) * w0.y;
          s[2] += bf2f(u.y & 0xffff) * w0.z; s[3] += bf2f(u.y >> 16) * w0.w;
          s[4] += bf2f(u.z & 0xffff) * w1.x; s[5] += bf2f(u.z >> 16) * w1.y;
          s[6] += bf2f(u.w & 0xffff) * w1.z; s[7] += bf2f(u.w >> 16) * w1.w;
        }
      }
#pragma unroll
      for (int e = 0; e < 8; ++e) s[e] = siluf(s[e]);
      *(uint4*)(xo + (size_t)r * 3072 + cc * 8) = uint4{pack2(s[0], s[1]), pack2(s[2], s[3]), pack2(s[4], s[5]), pack2(s[6], s[7])};
    }
  }
  {
    const u16* rw = (const u16*)(ws + OFF_RW);
    __half* wk = (__half*)(ws + OFF_WK);
    u16* tl = (u16*)(ws + OFF_TL);
    u16* sg = (u16*)(ws + OFF_SG);
    const bool grid = (g == 2);
    for (int r = blockIdx.x * 8 + wave; r < TG; r += gridDim.x * 8) {
      int pos = r & (Ls - 1);
      for (int ib = 0; ib < 54; ib += 6) {
        float xxs[6];
        {
          float cur[6], shv[6], muv[6];
#pragma unroll
          for (int u = 0; u < 6; ++u) {
            int c = (ib + u) * 64 + lane;
            cur[u] = bf2f(rw[(size_t)r * 3456 + c]);
            int q = c / 864;
            int dr;
            bool ok;
            if (!grid) {
              if (q & 1) { dr = 1; ok = pos < Ls - 1; } else { dr = -1; ok = pos > 0; }
            } else {
              if (q == 0) { dr = -1; ok = (pos & 63) != 0; }
              else if (q == 1) { dr = 1; ok = (pos & 63) != 63; }
              else if (q == 2) { dr = -64; ok = pos >= 64; }
              else { dr = 64; ok = pos < Ls - 64; }
            }
            shv[u] = ok ? bf2f(rw[(size_t)(r + dr) * 3456 + c]) : 0.f;
            muv[u] = p.mu_shift[c];
          }
#pragma unroll
          for (int u = 0; u < 6; ++u) xxs[u] = cur[u] + muv[u] * (shv[u] - cur[u]);
        }
#pragma unroll
        for (int u = 0; u < 6; ++u) {
          const int it = ib + u;
          const float xx = xxs[u];
          if (it < 16) {
            wk[((size_t)(r * 16 + it) * 8 + 0) * 64 + lane] = __float2half(xx);
          } else if (it == 16) {
            tl[(size_t)r * 256 + lane] = f2bf(tanhf(xx));
          } else if (it == 17) {
            tl[(size_t)r * 256 + 64 + lane] = f2bf(tanhf(xx));
          } else if (it < 34) {
            int h = it - 18;
            float kk = xx * p.k_k[h * 64 + lane];
            float ss = wave_sum(kk * kk);
            float nkk = -kk * rsqrtf(ss + 1e-12f);
            wk[((size_t)(r * 16 + h) * 8 + 2) * 64 + lane] = __float2half(xx);
            wk[((size_t)(r * 16 + h) * 8 + 3) * 64 + lane] = __float2half(nkk);
          } else if (it < 50) {
            int h = it - 34;
            wk[((size_t)(r * 16 + h) * 8 + 1) * 64 + lane] = __float2half(xx);
          } else if (it == 50) {
            tl[(size_t)r * 256 + 128 + lane] = f2bf(xx);
          } else if (it == 51) {
            tl[(size_t)r * 256 + 192 + lane] = f2bf(xx);
          } else {
            sg[(size_t)r * 128 + (it - 52) * 64 + lane] = f2bf(sigm(xx));
          }
        }
      }
    }
  }
}

__device__ __forceinline__ void step_r2(const Params& p, char* smem) {
  char* ws = p.ws;
  const int tid = get_tid(), lane = tid & 63, wave = tid >> 6;
  const int wm = wave >> 1, wn = wave & 1;
  const u16* tl = (const u16*)(ws + OFF_TL);
  const u16* sg = (const u16*)(ws + OFF_SG);
  __half* wk = (__half*)(ws + OFF_WK);
  u16* gr = (u16*)(ws + OFF_GR);
  for (int t = blockIdx.x; t < 5 * 128; t += gridDim.x) {
    int sub = t >> 7, rem = t & 127;
    int mt = rem & 15, nt = rem >> 4;
    f32x4 acc[4][4];
    zero_acc(acc);
    if (sub < 2) {
      gemm_acc(tl + (size_t)mt * 256 * 256 + sub * 64, 256, (const u16*)(ws + OFF_W2T) + sub * 65536 + (size_t)nt * 128 * 64, 64, 64, acc, smem);
    } else if (sub < 4) {
      gemm_acc(tl + (size_t)mt * 256 * 256 + 128 + (sub - 2) * 64, 256, (const u16*)(ws + OFF_A2T) + (sub - 2) * 65536 + (size_t)nt * 128 * 64, 64, 64, acc, smem);
    } else {
      gemm_acc(sg + (size_t)mt * 256 * 128, 128, (const u16*)(ws + OFF_G2T) + (size_t)nt * 128 * 128, 128, 128, acc, smem);
    }
#pragma unroll
    for (int mf = 0; mf < 4; ++mf)
#pragma unroll
      for (int nf = 0; nf < 4; ++nf)
#pragma unroll
        for (int j = 0; j < 4; ++j) {
          if (nf == 0 && j == 0) asm volatile("" ::: "memory");
          int m = mt * 256 + wm * 64 + mf * 16 + (lane >> 4) * 4 + j;
          int n = nt * 128 + wn * 64 + nf * 16 + (lane & 15);
          float v = acc[mf][nf][j];
          if (sub < 2) {
            float wl = v + p.w0[sub * 1024 + n];
            float dec = __expf(-0.6065306597f * sigm(wl));
            wk[((size_t)(m * 16 + (n >> 6)) * 8 + 4 + 2 * sub) * 64 + (n & 63)] = __float2half(dec);
          } else if (sub < 4) {
            int d = sub - 2;
            float a = sigm(v + p.a0[d * 1024 + n]);
            wk[((size_t)(m * 16 + (n >> 6)) * 8 + 5 + 2 * d) * 64 + (n & 63)] = __float2half(a);
          } else {
            gr[(size_t)m * 1024 + n] = f2bf(v);
          }
        }
  }
}

DI int sw256(int row, int e) { return row * 256 + ((((e >> 3) ^ (row & 15))) << 4) + (e & 7) * 2; }
DI const bf16x8 ldfrag256(const char* base, int row, int ch) {
  return *(const bf16x8*)(base + row * 256 + ((ch ^ (row & 15)) << 4));
}

__device__ __forceinline__ void ssd_chain(const Params& p, char* smem, int g, int chain) {
  char* ws = p.ws;
  const int tid = get_tid(), lane = tid & 63, wave = tid >> 6;
  const int Ls = g < 2 ? 256 : 2048;
  const int nch = Ls >> 7;
  const int d = chain & 1, h = (chain >> 1) & 31, b = chain >> 6;
  const int grp = h >> 3;
  const u16* xbc = (const u16*)(ws + OFF_XBC);
  const float* dtb = (const float*)(ws + OFF_DT);
  u16* yout = (u16*)(ws + (d ? OFF_SYB : OFF_SYF));
  char* Cs = smem;
  char* Bs = smem + 32768;
  char* BdT = smem + 65536;
  char* XT = smem + 98304;
  char* Ss = smem + 114688;
  float* csum = (float*)(smem + 131072);
  float* dts = (float*)(smem + 131584);
  const float a_h = -__expf(p.a_log[d * 32 + h]);
  const float dtbias = p.dt_bias[d * 32 + h];
  const int wp = wave >> 2, wn4 = wave & 3;
  f32x4 sacc[2][2];
#pragma unroll
  for (int pf = 0; pf < 2; ++pf)
#pragma unroll
    for (int nf = 0; nf < 2; ++nf) {
      if (g == 2) {
        const float* h0 = (d ? p.ssm_b : p.ssm_f) + (size_t)(b * 32 + h) * 8192;
#pragma unroll
        for (int j = 0; j < 4; ++j) {
          int pp = wp * 32 + pf * 16 + (lane >> 4) * 4 + j;
          int n = wn4 * 32 + nf * 16 + (lane & 15);
          sacc[pf][nf][j] = h0[pp * 128 + n];
        }
      } else {
        sacc[pf][nf] = f32x4{0.f, 0.f, 0.f, 0.f};
      }
    }
  const int tid_outer = tid;
  for (int ci = 0; ci < nch; ++ci) {
    int tidv = tid_outer;
    asm volatile("" : "+v"(tidv));
    const int tid = tidv, lane = tidv & 63, wave = tidv >> 6;
    const int wp = wave >> 2, wn4 = wave & 3;
    const int c = d ? nch - 1 - ci : ci;
    const int tok0 = b * Ls + c * 128;
#pragma unroll
    for (int i = 0; i < 4; ++i) {
      int idx = tid + i * 512;
      int row = idx >> 4, ch = idx & 15;
      const u16* src = xbc + (size_t)(tok0 + row) * 3072 + grp * 128 + ch * 8;
      uint4 cv = *(const uint4*)(src + 2560);
      uint4 bv = *(const uint4*)(src + 2048);
      *(uint4*)(Cs + row * 256 + ((ch ^ (row & 15)) << 4)) = cv;
      *(uint4*)(Bs + row * 256 + ((ch ^ (row & 15)) << 4)) = bv;
    }
#pragma unroll
    for (int i = 0; i < 2; ++i) {
      int idx = tid + i * 512;
      int l = idx >> 3, ch = idx & 7;
      uint4 xv = *(const uint4*)(xbc + (size_t)(tok0 + l) * 3072 + h * 64 + ch * 8);
      unsigned w[4] = {xv.x, xv.y, xv.z, xv.w};
#pragma unroll
      for (int e = 0; e < 8; ++e) {
        int pp = ch * 8 + e;
        u16 val = (u16)((w[e >> 1] >> ((e & 1) * 16)) & 0xffff);
        *(u16*)(XT + sw256(pp, l)) = val;
      }
    }
    if (wave == 0) {
      int e0 = 2 * lane, e1 = 2 * lane + 1;
      int l0 = d ? 127 - e0 : e0, l1 = d ? 127 - e1 : e1;
      float x0 = dtb[(size_t)(tok0 + l0) * 64 + d * 32 + h] + dtbias;
      float x1 = dtb[(size_t)(tok0 + l1) * 64 + d * 32 + h] + dtbias;
      float dt0 = x0 > 20.f ? x0 : log1pf(__expf(x0));
      float dt1 = x1 > 20.f ? x1 : log1pf(__expf(x1));
      float a0 = dt0 * a_h, a1 = dt1 * a_h;
      float s = a0 + a1;
#pragma unroll
      for (int o = 1; o < 64; o <<= 1) {
        float t = __shfl_up(s, o);
        if (lane >= o) s += t;
      }
      csum[l1] = s;
      csum[l0] = s - a1;
      dts[l0] = dt0;
      dts[l1] = dt1;
    }
#pragma unroll
    for (int pf = 0; pf < 2; ++pf)
#pragma unroll
      for (int nf = 0; nf < 2; ++nf)
#pragma unroll
        for (int j = 0; j < 4; ++j) {
          int pp = wp * 32 + pf * 16 + (lane >> 4) * 4 + j;
          int n = wn4 * 32 + nf * 16 + (lane & 15);
          *(u16*)(Ss + sw256(pp, n)) = f2bf(sacc[pf][nf][j]);
        }
    __syncthreads();
    const float cstot = csum[d ? 0 : 127];
#pragma unroll
    for (int i = 0; i < 4; ++i) {
      int idx = tid + i * 512;
      int l = idx >> 4, ch = idx & 15;
      uint4 bv = *(const uint4*)(Bs + l * 256 + ((ch ^ (l & 15)) << 4));
      float f = dts[l] * __expf(cstot - csum[l]);
      unsigned w[4] = {bv.x, bv.y, bv.z, bv.w};
#pragma unroll
      for (int e = 0; e < 8; ++e) {
        int n = ch * 8 + e;
        float val = bf2f((u16)((w[e >> 1] >> ((e & 1) * 16)) & 0xffff)) * f;
        *(u16*)(BdT + sw256(n, l)) = f2bf(val);
      }
    }
    const int wm = wave >> 1, wn2 = wave & 1;
    f32x4 gacc[2][4];
#pragma unroll
    for (int i = 0; i < 2; ++i)
#pragma unroll
      for (int j = 0; j < 4; ++j) gacc[i][j] = f32x4{0.f, 0.f, 0.f, 0.f};
#pragma unroll
    for (int ks = 0; ks < 4; ++ks) {
      int ch = ks * 4 + (lane >> 4);
      bf16x8 a[2], bb[4];
#pragma unroll
      for (int mf = 0; mf < 2; ++mf) a[mf] = ldfrag256(Cs, wm * 32 + mf * 16 + (lane & 15), ch);
#pragma unroll
      for (int nf = 0; nf < 4; ++nf) bb[nf] = ldfrag256(Bs, wn2 * 64 + nf * 16 + (lane & 15), ch);
#pragma unroll
      for (int mf = 0; mf < 2; ++mf)
#pragma unroll
        for (int nf = 0; nf < 4; ++nf)
          gacc[mf][nf] = __builtin_amdgcn_mfma_f32_16x16x32_bf16(a[mf], bb[nf], gacc[mf][nf], 0, 0, 0);
    }
    {
      float csl[2][4];
#pragma unroll
      for (int mf = 0; mf < 2; ++mf)
#pragma unroll
        for (int j = 0; j < 4; ++j) csl[mf][j] = csum[wm * 32 + mf * 16 + (lane >> 4) * 4 + j];
#pragma unroll
      for (int nf = 0; nf < 4; ++nf) {
        int s = wn2 * 64 + nf * 16 + (lane & 15);
        float css = csum[s], dss = dts[s];
#pragma unroll
        for (int mf = 0; mf < 2; ++mf)
#pragma unroll
          for (int j = 0; j < 4; ++j) {
            int l = wm * 32 + mf * 16 + (lane >> 4) * 4 + j;
            bool valid = d ? (s >= l) : (s <= l);
            float e = valid ? __expf(csl[mf][j] - css) * dss : 0.f;
            gacc[mf][nf][j] *= e;
          }
      }
    }
    __syncthreads();
#pragma unroll
    for (int mf = 0; mf < 2; ++mf)
#pragma unroll
      for (int nf = 0; nf < 4; ++nf)
#pragma unroll
        for (int j = 0; j < 4; ++j) {
          int l = wm * 32 + mf * 16 + (lane >> 4) * 4 + j;
          int s = wn2 * 64 + nf * 16 + (lane & 15);
          *(u16*)(Bs + sw256(l, s)) = f2bf(gacc[mf][nf][j]);
        }
    __syncthreads();
    {
      f32x4 yacc[2][2];
#pragma unroll
      for (int i = 0; i < 2; ++i)
#pragma unroll
        for (int j = 0; j < 2; ++j) yacc[i][j] = f32x4{0.f, 0.f, 0.f, 0.f};
#pragma unroll
      for (int ks = 0; ks < 4; ++ks) {
        int ch = ks * 4 + (lane >> 4);
        bf16x8 a[2], bb[2];
#pragma unroll
        for (int mf = 0; mf < 2; ++mf) a[mf] = ldfrag256(Cs, wm * 32 + mf * 16 + (lane & 15), ch);
#pragma unroll
        for (int nf = 0; nf < 2; ++nf) bb[nf] = ldfrag256(Ss, wn2 * 32 + nf * 16 + (lane & 15), ch);
#pragma unroll
        for (int mf = 0; mf < 2; ++mf)
#pragma unroll
          for (int nf = 0; nf < 2; ++nf)
            yacc[mf][nf] = __builtin_amdgcn_mfma_f32_16x16x32_bf16(a[mf], bb[nf], yacc[mf][nf], 0, 0, 0);
      }
#pragma unroll
      for (int mf = 0; mf < 2; ++mf)
#pragma unroll
        for (int j = 0; j < 4; ++j) {
          float e = __expf(csum[wm * 32 + mf * 16 + (lane >> 4) * 4 + j]);
#pragma unroll
          for (int nf = 0; nf < 2; ++nf) yacc[mf][nf][j] *= e;
        }
#pragma unroll
      for (int ks = 0; ks < 4; ++ks) {
        int ch = ks * 4 + (lane >> 4);
        bf16x8 a[2], bb[2];
#pragma unroll
        for (int mf = 0; mf < 2; ++mf) a[mf] = ldfrag256(Bs, wm * 32 + mf * 16 + (lane & 15), ch);
#pragma unroll
        for (int nf = 0; nf < 2; ++nf) bb[nf] = ldfrag256(XT, wn2 * 32 + nf * 16 + (lane & 15), ch);
#pragma unroll
        for (int mf = 0; mf < 2; ++mf)
#pragma unroll
          for (int nf = 0; nf < 2; ++nf)
            yacc[mf][nf] = __builtin_amdgcn_mfma_f32_16x16x32_bf16(a[mf], bb[nf], yacc[mf][nf], 0, 0, 0);
      }
#pragma unroll
      for (int mf = 0; mf < 2; ++mf)
#pragma unroll
        for (int nf = 0; nf < 2; ++nf)
#pragma unroll
          for (int j = 0; j < 4; ++j) {
            int l = wm * 32 + mf * 16 + (lane >> 4) * 4 + j;
            int pp = wn2 * 32 + nf * 16 + (lane & 15);
            yout[(size_t)(tok0 + l) * 2048 + h * 64 + pp] = f2bf(yacc[mf][nf][j]);
          }
    }
    {
      float e = __expf(cstot);
#pragma unroll
      for (int pf = 0; pf < 2; ++pf)
#pragma unroll
        for (int nf = 0; nf < 2; ++nf) sacc[pf][nf] *= e;
#pragma unroll
      for (int ks = 0; ks < 4; ++ks) {
        int ch = ks * 4 + (lane >> 4);
        bf16x8 a[2], bb[2];
#pragma unroll
        for (int pf = 0; pf < 2; ++pf) a[pf] = ldfrag256(XT, wp * 32 + pf * 16 + (lane & 15), ch);
#pragma unroll
        for (int nf = 0; nf < 2; ++nf) bb[nf] = ldfrag256(BdT, wn4 * 32 + nf * 16 + (lane & 15), ch);
#pragma unroll
        for (int pf = 0; pf < 2; ++pf)
#pragma unroll
          for (int nf = 0; nf < 2; ++nf)
            sacc[pf][nf] = __builtin_amdgcn_mfma_f32_16x16x32_bf16(a[pf], bb[nf], sacc[pf][nf], 0, 0, 0);
      }
    }
    __syncthreads();
  }
  if (g < 2) {
    float* so = p.out + (d ? OUT_SSMB : OUT_SSMF) + (size_t)((g * 16 + b) * 32 + h) * 8192;
#pragma unroll
    for (int pf = 0; pf < 2; ++pf)
#pragma unroll
      for (int nf = 0; nf < 2; ++nf)
#pragma unroll
        for (int j = 0; j < 4; ++j) {
          int pp = wp * 32 + pf * 16 + (lane >> 4) * 4 + j;
          int n = wn4 * 32 + nf * 16 + (lane & 15);
          so[pp * 128 + n] = sacc[pf][nf][j];
        }
  }
}

DI float dpp_xor1(float v) { return __int_as_float(__builtin_amdgcn_update_dpp(0, __float_as_int(v), 0xB1, 0xF, 0xF, true)); }
DI float dpp_hmirror(float v) { return __int_as_float(__builtin_amdgcn_update_dpp(0, __float_as_int(v), 0x141, 0xF, 0xF, true)); }
DI float dpp_xor2(float v) { return __int_as_float(__builtin_amdgcn_update_dpp(0, __float_as_int(v), 0x4E, 0xF, 0xF, true)); }

template <bool SEG>
__device__ __forceinline__ void wkv_pair(const Params& p, char* smem, int g, int item) {
  char* ws = p.ws;
  const int tid = get_tid(), lane = tid & 63, wave = tid >> 6;
  const int Ls = SEG ? 2048 : 256;
  const __half* wk = (const __half*)(ws + OFF_WK);
  float* stage = (float*)smem;
  float* ylds = (float*)(smem + 98304);
  const bool cw = true;
  const int slot = wave >> 2, wq = wave & 3;
  const int ig = lane >> 3, jg = lane & 7;
  const int row0 = wq * 16 + ig * 2;
  const int chain = SEG ? (item >> 3) : item * 2 + slot;
  const int seg = SEG ? (item & 7) : 0;
  const bool act = cw && (SEG ? !(slot == 1 && seg == 0) : true);
  const int d = chain & 1, h = (chain >> 1) & 15, b = chain >> 5;
  typedef float f2 __attribute__((ext_vector_type(2)));
  f2 S[2][4];
#pragma unroll
  for (int rr = 0; rr < 2; ++rr) {
    if (SEG) {
      if (slot == 0) {
        if (seg == 0) {
          const float* s0 = (d ? p.wkv_b : p.wkv_f) + ((size_t)(b * 16 + h) * 64 + row0 + rr) * 64 + jg * 8;
#pragma unroll
          for (int c = 0; c < 4; ++c) S[rr][c] = f2{s0[2 * c], s0[2 * c + 1]};
        } else {
#pragma unroll
          for (int c = 0; c < 4; ++c) S[rr][c] = f2{0.f, 0.f};
        }
      } else {
#pragma unroll
        for (int c = 0; c < 4; ++c) S[rr][c] = f2{(row0 + rr == jg * 8 + 2 * c) ? 1.f : 0.f, (row0 + rr == jg * 8 + 2 * c + 1) ? 1.f : 0.f};
      }
    } else {
#pragma unroll
      for (int c = 0; c < 4; ++c) S[rr][c] = f2{0.f, 0.f};
    }
  }
  const int pair = tid >> 4, lslot = pair >> 4, lstep = pair & 15, sub = tid & 15;
  const int lch = SEG ? (item >> 3) : item * 2 + lslot;
  const int ld = lch & 1, lh = (lch >> 1) & 15, lb = lch >> 5;
  const bool ldo = SEG ? (lslot == 0) : true;
  const int sbase = seg * 256;
  const int cslot = SEG ? 0 : slot;
  float ka[4];
#pragma unroll
  for (int e = 0; e < 4; ++e) ka[e] = p.k_a[lh * 64 + sub * 4 + e];
  u16* yout;
  if (SEG) yout = lslot == 0 ? (u16*)(ws + (ld ? OFF_WYB : OFF_WYF)) : (u16*)(ws + OFF_YM) + (ld ? (size_t)TG * 1024 : 0);
  else yout = (u16*)(ws + (ld ? OFF_WYB : OFF_WYF));
  const bool ywr = SEG ? (lslot == 0 || seg > 0) : true;
  uint2 rg[6];
  auto prefetch = [&](int tb) {
    int s = sbase + tb * 16 + lstep;
    int pos = ld ? Ls - 1 - s : s;
    int r = lb * Ls + pos;
    const __half* rec = wk + ((size_t)(r * 16 + lh) * 8) * 64 + sub * 4;
    rg[0] = *(const uint2*)(rec + 0 * 64);
    rg[1] = *(const uint2*)(rec + 1 * 64);
    rg[2] = *(const uint2*)(rec + 2 * 64);
    rg[3] = *(const uint2*)(rec + 3 * 64);
    rg[4] = *(const uint2*)(rec + (4 + 2 * ld) * 64);
    rg[5] = *(const uint2*)(rec + (5 + 2 * ld) * 64);
  };
  auto unpack4 = [&](uint2 u, float (&o)[4]) {
    __half2 h0 = *reinterpret_cast<__half2*>(&u.x);
    __half2 h1 = *reinterpret_cast<__half2*>(&u.y);
    float2 f0 = __half22float2(h0), f1 = __half22float2(h1);
    o[0] = f0.x; o[1] = f0.y; o[2] = f1.x; o[3] = f1.y;
  };
  auto stage_store = [&](int buf) {
    float r_[4], v_[4], k_[4], nkk_[4], w_[4], a_[4];
    unpack4(rg[0], r_); unpack4(rg[1], v_); unpack4(rg[2], k_); unpack4(rg[3], nkk_); unpack4(rg[4], w_); unpack4(rg[5], a_);
    float b_[4], kd_[4];
#pragma unroll
    for (int e = 0; e < 4; ++e) {
      b_[e] = -nkk_[e] * a_[e];
      kd_[e] = k_[e] * (1.f + (a_[e] - 1.f) * ka[e]);
    }
    float* dst = stage + ((size_t)((buf * 2 + lslot) * 16 + lstep) * 6) * 64 + sub * 4;
    *(float4*)(dst + 0 * 64) = float4{nkk_[0], nkk_[1], nkk_[2], nkk_[3]};
    *(float4*)(dst + 1 * 64) = float4{w_[0], w_[1], w_[2], w_[3]};
    *(float4*)(dst + 2 * 64) = float4{b_[0], b_[1], b_[2], b_[3]};
    *(float4*)(dst + 3 * 64) = float4{kd_[0], kd_[1], kd_[2], kd_[3]};
    *(float4*)(dst + 4 * 64) = float4{r_[0], r_[1], r_[2], r_[3]};
    *(float4*)(dst + 5 * 64) = float4{v_[0], v_[1], v_[2], v_[3]};
  };
  if (ldo) { prefetch(0); stage_store(0); }
  __syncthreads();
  for (int tb = 0; tb < 16; ++tb) {
    const bool more = tb + 1 < 16;
    if (more && ldo) prefetch(tb + 1);
    if (act) {
      const float* sb = stage + ((size_t)(((tb & 1) * 2 + cslot) * 16) * 6) * 64;
      for (int sg = 0; sg < 8; ++sg) {
        float ysv[2][2];
#pragma unroll
        for (int s4 = 0; s4 < 2; ++s4) {
          const int st = sg * 2 + s4;
          const float* v6 = sb + st * 384 + jg * 8;
          f2 nkk[4], w[4], bb[4], kd[4], rr[4];
#pragma unroll
          for (int q = 0; q < 2; ++q) {
            float4 t0 = *(const float4*)(v6 + 0 * 64 + q * 4);
            nkk[q * 2] = f2{t0.x, t0.y}; nkk[q * 2 + 1] = f2{t0.z, t0.w};
            float4 t1 = *(const float4*)(v6 + 1 * 64 + q * 4);
            w[q * 2] = f2{t1.x, t1.y}; w[q * 2 + 1] = f2{t1.z, t1.w};
            float4 t2 = *(const float4*)(v6 + 2 * 64 + q * 4);
            bb[q * 2] = f2{t2.x, t2.y}; bb[q * 2 + 1] = f2{t2.z, t2.w};
            float4 t3 = *(const float4*)(v6 + 3 * 64 + q * 4);
            kd[q * 2] = f2{t3.x, t3.y}; kd[q * 2 + 1] = f2{t3.z, t3.w};
            float4 t4 = *(const float4*)(v6 + 4 * 64 + q * 4);
            rr[q * 2] = f2{t4.x, t4.y}; rr[q * 2 + 1] = f2{t4.z, t4.w};
          }
          float2 vv2 = *(const float2*)(sb + st * 384 + 5 * 64 + row0);
          float vi[2] = {vv2.x, vv2.y};
          if (SEG && slot == 1) { vi[0] = 0.f; vi[1] = 0.f; }
#pragma unroll
          for (int r2 = 0; r2 < 2; ++r2) {
            f2 sa2a = S[r2][0] * nkk[0], sa2b = S[r2][1] * nkk[1];
            sa2a += S[r2][2] * nkk[2]; sa2b += S[r2][3] * nkk[3];
            f2 sat = sa2a + sa2b;
            float sa = sat.x + sat.y;
            sa += dpp_xor1(sa);
            sa += dpp_xor2(sa);
            sa += dpp_hmirror(sa);
            f2 y2a, y2b;
            {
              f2 t0 = S[r2][0] * w[0] + vi[r2] * kd[0]; S[r2][0] = t0 + sa * bb[0]; y2a = S[r2][0] * rr[0];
              f2 t1 = S[r2][1] * w[1] + vi[r2] * kd[1]; S[r2][1] = t1 + sa * bb[1]; y2b = S[r2][1] * rr[1];
              f2 t2 = S[r2][2] * w[2] + vi[r2] * kd[2]; S[r2][2] = t2 + sa * bb[2]; y2a += S[r2][2] * rr[2];
              f2 t3 = S[r2][3] * w[3] + vi[r2] * kd[3]; S[r2][3] = t3 + sa * bb[3]; y2b += S[r2][3] * rr[3];
            }
            f2 yt = y2a + y2b;
            float y = yt.x + yt.y;
            y += dpp_xor1(y);
            y += dpp_xor2(y);
            y += dpp_hmirror(y);
            ysv[s4][r2] = y;
          }
        }
        if (jg == 0) {
#pragma unroll
          for (int s4 = 0; s4 < 2; ++s4)
            *(float2*)(ylds + (slot * 16 + sg * 2 + s4) * 64 + row0) = float2{ysv[s4][0], ysv[s4][1]};
        }
      }
    }
    __syncthreads();
    if (more && ldo) stage_store((tb + 1) & 1);
    if (ywr) {
      int s = sbase + tb * 16 + lstep;
      int pos = ld ? Ls - 1 - s : s;
      int r = lb * Ls + pos;
      float4 yv = *(const float4*)(ylds + (lslot * 16 + lstep) * 64 + sub * 4);
      *(uint2*)(yout + (size_t)r * 1024 + lh * 64 + sub * 4) = uint2{pack2(yv.x, yv.y), pack2(yv.z, yv.w)};
    }
    __syncthreads();
  }
  if (act) {
#pragma unroll
    for (int r2 = 0; r2 < 2; ++r2) {
      float* so;
      if (SEG) so = p.out + 8388608 + ((size_t)((chain * 8 + seg) * 2 + slot)) * 4096 + (row0 + r2) * 64 + jg * 8;
      else so = p.out + (d ? OUT_WKVB : OUT_WKVF) + ((size_t)((g * 16 + b) * 16 + h) * 64 + row0 + r2) * 64 + jg * 8;
#pragma unroll
      for (int c = 0; c < 4; ++c) { so[2 * c] = S[r2][c].x; so[2 * c + 1] = S[r2][c].y; }
    }
  }
}

__device__ __forceinline__ void wkv_fix(const Params& p, char* smem, int chain) {
  char* ws = p.ws;
  const int tid = get_tid(), lane = tid & 63, wave = tid >> 6;
  const int d = chain & 1, h = (chain >> 1) & 15, b = chain >> 5;
  const float* SE = p.out + 8388608;
  u16* yout = (u16*)(ws + (d ? OFF_WYB : OFF_WYF));
  const u16* Q = (const u16*)(ws + OFF_YM) + (d ? (size_t)TG * 1024 : 0);
  float* Pl = (float*)smem;
  float* Sl = (float*)(smem + 16384);
  u16* Ql = (u16*)(smem + 36864);
  const int i = lane;
  float S0[64];
  {
    const float* src = SE + ((size_t)(chain * 8) * 2) * 4096 + i * 64;
#pragma unroll
    for (int j = 0; j < 16; ++j) {
      float4 t = *(const float4*)(src + j * 4);
      S0[j * 4] = t.x; S0[j * 4 + 1] = t.y; S0[j * 4 + 2] = t.z; S0[j * 4 + 3] = t.w;
    }
  }
  for (int k = 1; k < 8; ++k) {
#pragma unroll
    for (int e = 0; e < 4; ++e) {
      int idx = tid + e * 512;
      int tt = idx >> 3, ch = idx & 7;
      int s = k * 256 + tt;
      int pos = d ? 2047 - s : s;
      int r = b * 2048 + pos;
      *(uint4*)(Ql + tt * 64 + ch * 8) = *(const uint4*)(Q + (size_t)r * 1024 + h * 64 + ch * 8);
    }
    if (k < 7) {
      const float* src = SE + ((size_t)((chain * 8 + k) * 2 + 1)) * 4096;
#pragma unroll
      for (int e = 0; e < 2; ++e) ((float4*)Pl)[tid + e * 512] = ((const float4*)src)[tid + e * 512];
    }
    __syncthreads();
    for (int n = 0; n < 32; ++n) {
      int tt = wave + n * 8;
      float a0 = 0.f, a1 = 0.f;
#pragma unroll
      for (int jc = 0; jc < 8; ++jc) {
        float q[8];
        unpack8(*(const uint4*)(Ql + tt * 64 + jc * 8), q);
#pragma unroll
        for (int e = 0; e < 8; e += 2) { a0 += S0[jc * 8 + e] * q[e]; a1 += S0[jc * 8 + e + 1] * q[e + 1]; }
      }
      int s = k * 256 + tt;
      int pos = d ? 2047 - s : s;
      size_t off = (size_t)(b * 2048 + pos) * 1024 + h * 64 + i;
      yout[off] = f2bf(bf2f(yout[off]) + (a0 + a1));
    }
    if (k < 7) {
      float nv[8];
      const float* sl = SE + ((size_t)((chain * 8 + k) * 2)) * 4096 + i * 64 + wave * 8;
      {
        float4 t0 = *(const float4*)sl, t1 = *(const float4*)(sl + 4);
        nv[0] = t0.x; nv[1] = t0.y; nv[2] = t0.z; nv[3] = t0.w; nv[4] = t1.x; nv[5] = t1.y; nv[6] = t1.z; nv[7] = t1.w;
      }
#pragma unroll
      for (int m = 0; m < 64; ++m) {
        float4 p0 = *(const float4*)(Pl + m * 64 + wave * 8), p1 = *(const float4*)(Pl + m * 64 + wave * 8 + 4);
        nv[0] += S0[m] * p0.x; nv[1] += S0[m] * p0.y; nv[2] += S0[m] * p0.z; nv[3] += S0[m] * p0.w;
        nv[4] += S0[m] * p1.x; nv[5] += S0[m] * p1.y; nv[6] += S0[m] * p1.z; nv[7] += S0[m] * p1.w;
      }
      *(float4*)(Sl + i * 68 + wave * 8) = float4{nv[0], nv[1], nv[2], nv[3]};
      *(float4*)(Sl + i * 68 + wave * 8 + 4) = float4{nv[4], nv[5], nv[6], nv[7]};
      __syncthreads();
#pragma unroll
      for (int j = 0; j < 16; ++j) {
        float4 t = *(const float4*)(Sl + i * 68 + j * 4);
        S0[j * 4] = t.x; S0[j * 4 + 1] = t.y; S0[j * 4 + 2] = t.z; S0[j * 4 + 3] = t.w;
      }
    }
    __syncthreads();
  }
}

__device__ __forceinline__ void step_scan(const Params& p, char* smem, int g) {
  const int G = gridDim.x;
  const int r1 = (RM & (1 << 20)) ? 2 : 1, r2 = (RM & (1 << 21)) ? 2 : 1;
  if (g < 2) {
    for (int rr = 0; rr < r1; ++rr) for (int ch = blockIdx.x; ch < 1024; ch += G) ssd_chain(p, smem, g, ch);
    for (int rr = 0; rr < r2; ++rr) for (int it = blockIdx.x; it < 256; it += G) wkv_pair<false>(p, smem, g, it);
  } else {
    for (int rr = 0; rr < r1; ++rr) for (int ch = blockIdx.x; ch < 128; ch += G) ssd_chain(p, smem, g, ch);
    for (int rr = 0; rr < r2; ++rr) for (int it = (G - 1 - blockIdx.x); it < 512; it += G) wkv_pair<true>(p, smem, g, it);
  }
}
__device__ __forceinline__ void step_fix(const Params& p, char* smem) {
  for (int ch = blockIdx.x; ch < 64; ch += gridDim.x) wkv_fix(p, smem, ch);
}

__device__ __forceinline__ void step_fin(const Params& p, int g) {
  char* ws = p.ws;
  const int tid = get_tid(), lane = tid & 63, wave = tid >> 6;
  const int gw = blockIdx.x * 8 + wave, nw = gridDim.x * 8;
  {
    const u16* yf = (const u16*)(ws + OFF_SYF);
    const u16* yb = (const u16*)(ws + OFF_SYB);
    const u16* xbc = (const u16*)(ws + OFF_XBC);
    const u16* zb = (const u16*)(ws + OFF_Z);
    u16* ym = (u16*)(ws + OFF_YM);
    for (int it = gw; it < TG * 4; it += nw) {
      int r = it >> 2, gq = it & 3;
      int ch = gq * 512 + lane * 8;
      uint4 a = *(const uint4*)(yf + (size_t)r * 2048 + ch);
      uint4 b = *(const uint4*)(yb + (size_t)r * 2048 + ch);
      uint4 x = *(const uint4*)(xbc + (size_t)r * 3072 + ch);
      uint4 z = *(const uint4*)(zb + (size_t)r * 2048 + ch);
      float dsk = p.d_skip[ch >> 6];
      unsigned aw[4] = {a.x, a.y, a.z, a.w}, bw[4] = {b.x, b.y, b.z, b.w}, xw[4] = {x.x, x.y, x.z, x.w}, zw[4] = {z.x, z.y, z.z, z.w};
      float y[8];
      float ss = 0.f;
#pragma unroll
      for (int e = 0; e < 8; ++e) {
        int sh = (e & 1) * 16;
        float yy = bf2f((u16)(aw[e >> 1] >> sh)) + bf2f((u16)(bw[e >> 1] >> sh)) + dsk * bf2f((u16)(xw[e >> 1] >> sh));
        yy *= siluf(bf2f((u16)(zw[e >> 1] >> sh)));
        y[e] = yy;
        ss += yy * yy;
      }
      ss = wave_sum(ss);
      float rinv = rsqrtf(ss * (1.f / 512.f) + 1e-5f);
      float4 w0 = *(const float4*)(p.m_norm_w + ch), w1 = *(const float4*)(p.m_norm_w + ch + 4);
      *(uint4*)(ym + (size_t)r * 2048 + ch) =
          uint4{pack2(y[0] * rinv * w0.x, y[1] * rinv * w0.y), pack2(y[2] * rinv * w0.z, y[3] * rinv * w0.w),
                pack2(y[4] * rinv * w1.x, y[5] * rinv * w1.y), pack2(y[6] * rinv * w1.z, y[7] * rinv * w1.w)};
    }
  }
  {
    const u16* yf = (const u16*)(ws + OFF_WYF);
    const u16* yb = (const u16*)(ws + OFF_WYB);
    const __half* wk = (const __half*)(ws + OFF_WK);
    const u16* gr = (const u16*)(ws + OFF_GR);
    u16* yr = (u16*)(ws + OFF_YR);
    for (int it = gw; it < TG * 4; it += nw) {
      const int r = it >> 2, h0 = (it & 3) * 4;
      float yv[4], rr[4], vv[4], kk[4], af[4], ab[4], gg[4];
#pragma unroll
      for (int u = 0; u < 4; ++u) {
        int c = (h0 + u) * 64 + lane;
        yv[u] = bf2f(yf[(size_t)r * 1024 + c]) + bf2f(yb[(size_t)r * 1024 + c]);
        const __half* rec = wk + ((size_t)(r * 16 + h0 + u) * 8) * 64 + lane;
        rr[u] = __half2float(rec[0]); vv[u] = __half2float(rec[64]); kk[u] = __half2float(rec[128]);
        af[u] = __half2float(rec[5 * 64]); ab[u] = __half2float(rec[7 * 64]);
        gg[u] = bf2f(gr[(size_t)r * 1024 + c]);
      }
#pragma unroll
      for (int u = 0; u < 4; ++u) {
        int c = (h0 + u) * 64 + lane;
        float y = yv[u];
        float mean = wave_sum(y) * (1.f / 64.f);
        float dy = y - mean;
        float var = wave_sum(dy * dy) * (1.f / 64.f);
        float yn = dy * rsqrtf(var + 64e-5f) * p.lnx_w[c] + p.lnx_b[c];
        float kmean = kk[u] * (1.f + (0.5f * (af[u] + ab[u]) - 1.f) * p.k_a[c]);
        float bs = wave_sum(rr[u] * kmean * p.r_k[c]);
        float o = (yn + bs * vv[u]) * gg[u];
        yr[(size_t)r * 1024 + c] = f2bf(o);
      }
    }
  }
}

__device__ __forceinline__ void step_outproj(const Params& p, char* smem) {
  char* ws = p.ws;
  EpiOut<0> E0{(const u16*)(ws + OFF_GATE), (u16*)(ws + OFF_U)};
  run_gemm8(smem, (const u16*)(ws + OFF_YM), (const u16*)(ws + OFF_WMOUT), TG, 1024, 2048, E0);
  EpiOut<1> E1{(const u16*)(ws + OFF_GATE), (u16*)(ws + OFF_U)};
  run_gemm8(smem, (const u16*)(ws + OFF_YR), (const u16*)(ws + OFF_WROUT), TG, 1024, 1024, E1);
}

__device__ __forceinline__ void step_wo(const Params& p, char* smem, int g) {
  char* ws = p.ws;
  EpiWo E{p.x_prompt, p.x_sample, (const float*)(ws + OFF_MOD), p.out, g * TG};
  run_gemm8(smem, (const u16*)(ws + OFF_U), (const u16*)(ws + OFF_WO), TG, 1024, 1024, E);
}

__device__ __forceinline__ void step_gu(const Params& p, char* smem) {
  char* ws = p.ws;
  EpiGU E{(u16*)(ws + OFF_ACT)};
  run_gemm8(smem, (const u16*)(ws + OFF_H2), (const u16*)(ws + OFF_WGU), NTOK, 5632, 1024, E);
}

__device__ __forceinline__ void step_down(const Params& p, char* smem) {
  char* ws = p.ws;
  EpiDown E{(const float*)(ws + OFF_MOD), p.out};
  run_gemm8(smem, (const u16*)(ws + OFF_ACT), (const u16*)(ws + OFF_WDOWN), NTOK, 1024, 2816, E);
}

__device__ __forceinline__ void step_final(const Params& p) {
  const int tid = get_tid(), lane = tid & 63, wave = tid >> 6;
  for (int r = blockIdx.x * 8 + wave; r < NTOK; r += gridDim.x * 8) {
    float* xr = p.out + (size_t)r * 1024;
    float4 v[4];
    float ss = 0.f;
#pragma unroll
    for (int i = 0; i < 4; ++i) {
      v[i] = ((const float4*)xr)[i * 64 + lane];
      ss += v[i].x * v[i].x + v[i].y * v[i].y + v[i].z * v[i].z + v[i].w * v[i].w;
    }
    ss = wave_sum(ss);
    float rinv = rsqrtf(ss * (1.f / 1024.f) + 1e-6f);
#pragma unroll
    for (int i = 0; i < 4; ++i) {
      float4 w4 = ((const float4*)p.final_norm_w)[i * 64 + lane];
      ((float4*)xr)[i * 64 + lane] = float4{v[i].x * rinv * w4.x, v[i].y * rinv * w4.y, v[i].z * rinv * w4.z, v[i].w * rinv * w4.w};
    }
  }
}

constexpr int NSTEPS = 32;

__global__ void __launch_bounds__(NTHR) mega(Params p_arg) {
  const int step_lo = p_arg.step_lo, step_hi = p_arg.step_hi;
  __shared__ __attribute__((aligned(16))) char smem[SMEM_BYTES];
#if !MULTI_LAUNCH
  if (threadIdx.x == 0) *(uint4*)(smem + SMEM_BYTES - 16) = uint4{0u, 0u, 0u, 0u};
  __syncthreads();
  XcdBarrier xb = xcd_barrier_post((unsigned*)(p_arg.ws + OFF_BAR), (volatile LAS unsigned*)(smem + SMEM_BYTES - 16));
#endif
  for (int step = step_lo; step <= step_hi; ++step) {
#if defined(__HIP_DEVICE_COMPILE__)
    const __attribute__((address_space(4))) Params* pp = (const __attribute__((address_space(4))) Params*)__builtin_amdgcn_kernarg_segment_ptr();
    asm volatile("" : "+s"(pp));
    const Params p = *pp;
#else
    const Params p = p_arg;
#endif
    const int g = (step - 1) / 9, s = (step - 1) - g * 9;
    const int scode = step == 0 ? 0 : (step <= 27 ? 1 + s : step - 18);
    if (scode == 6 && g < 2) continue;
    const int reps = ((RM >> scode) & 1) ? 2 : 1;
    for (int rep = 0; rep < reps; ++rep) {
      if (!((SM >> scode) & 1)) continue;
      switch (scode) {
        case 0: step_prep(p, smem); break;
        case 1: step_norm<0>(p, g); break;
        case 2: step_gemm1(p, smem); break;
        case 3: step_cr1(p, g); break;
        case 4: step_r2(p, smem); break;
        case 5: step_scan(p, smem, g); break;
        case 6: step_fix(p, smem); break;
        case 7: step_fin(p, g); break;
        case 8: step_outproj(p, smem); break;
        case 9: step_wo(p, smem, g); break;
        case 10: step_norm<1>(p, 0); break;
        case 11: step_gu(p, smem); break;
        case 12: step_down(p, smem); break;
        default: step_final(p); break;
      }
    }
    if (step < step_hi) {
#if !MULTI_LAUNCH
      if (step == step_lo) cg::this_grid().sync();
      else for (int xs = 0; xs < 1 + XSYNC; ++xs) xcd_barrier(xb);
#endif
    }
  }
}

extern "C" void kernel_launch(void* const* d_in, const int* in_sizes, int n_in, void* d_out, int out_size,
                              void* d_ws, size_t ws_size, hipStream_t stream) {
  Params p{};
  const float** pp = (const float**)&p;
  for (int i = 0; i < 36; ++i) pp[i] = (const float*)d_in[i];
  p.out = (float*)d_out;
  p.ws = (char*)d_ws;
  if (ws_size < WS_NEED) fprintf(stderr, "workspace too small: %zu < %zu\n", ws_size, (size_t)WS_NEED);
#if MULTI_LAUNCH
  for (int s = 0; s < NSTEPS; ++s) {
    p.step_lo = s;
    p.step_hi = s;
    hipLaunchKernelGGL(mega, dim3(256), dim3(NTHR), 0, stream, p);
  }
#else
  static int grid_blocks = 0;
  if (!grid_blocks) {
    int dev = 0, cus = 0, per_cu = 0;
    hipGetDevice(&dev);
    hipDeviceGetAttribute(&cus, hipDeviceAttributeMultiprocessorCount, dev);
    hipOccupancyMaxActiveBlocksPerMultiprocessor(&per_cu, mega, NTHR, 0);
    if (per_cu < 1) per_cu = 1;
    if (per_cu > 1) per_cu = 1;
    grid_blocks = cus * per_cu;
  }
  p.step_lo = 0;
  p.step_hi = NSTEPS - 1;
  void* args[] = {&p};
  hipMemsetAsync((char*)d_ws + OFF_BAR, 0, XCD_BAR_WORDS_C * 4, stream);
  hipError_t e = hipLaunchCooperativeKernel((void*)mega, dim3(grid_blocks), dim3(NTHR), args, 0, stream);
  if (e != hipSuccess) fprintf(stderr, "cooperative launch failed: %s (grid %d)\n", hipGetErrorString(e), grid_blocks);
#endif
}
```

```cpp
#include <hip/hip_runtime.h>
#include <hip/hip_cooperative_groups.h>
#include <hip/hip_fp16.h>
#include <cstdio>
#include <cstdint>
namespace cg = cooperative_groups;

#ifndef MULTI_LAUNCH
#define MULTI_LAUNCH 0
#endif

#define DI __device__ __forceinline__
typedef __attribute__((ext_vector_type(8))) short bf16x8;
typedef __attribute__((ext_vector_type(4))) float f32x4;
typedef unsigned short u16;

#ifndef STEP_MASK
#define STEP_MASK 0xffffff
#endif
constexpr int SM = STEP_MASK;
#ifndef REPEAT_MASK
#define REPEAT_MASK 0
#endif
#ifndef XSYNC
#define XSYNC 0
#endif
constexpr int RM = REPEAT_MASK;
constexpr int TG = 4096;
constexpr int NTOK = 12288;
constexpr int NPAD = 10752;
constexpr int NTHR = 512;
constexpr int SMEM_BYTES = 133120;
constexpr int XCD_BAR_WORDS_C = 3456;

constexpr size_t OFF_WIN = 0;
constexpr size_t OFF_WGU = OFF_WIN + (size_t)NPAD * 1024 * 2;
constexpr size_t OFF_WDOWN = OFF_WGU + (size_t)5632 * 1024 * 2;
constexpr size_t OFF_WMOUT = OFF_WDOWN + (size_t)1024 * 2816 * 2;
constexpr size_t OFF_WROUT = OFF_WMOUT + (size_t)1024 * 2048 * 2;
constexpr size_t OFF_WO = OFF_WROUT + (size_t)1024 * 1024 * 2;
constexpr size_t OFF_W2T = OFF_WO + (size_t)1024 * 1024 * 2;
constexpr size_t OFF_A2T = OFF_W2T + 262144;
constexpr size_t OFF_G2T = OFF_A2T + 262144;
constexpr size_t OFF_MOD = OFF_G2T + 262144;
constexpr size_t OFF_GRP = OFF_MOD + 73728;
constexpr size_t OFF_Z = OFF_GRP;
constexpr size_t OFF_GATE = OFF_Z + (size_t)TG * 2048 * 2;
constexpr size_t OFF_XBC = OFF_GATE + (size_t)TG * 2048 * 2;
constexpr size_t OFF_WK = OFF_XBC + (size_t)TG * 3072 * 2;
constexpr size_t OFF_GR = OFF_WK + (size_t)TG * 16 * 1024;
constexpr size_t OFF_DT = OFF_GR + (size_t)TG * 1024 * 2;
constexpr size_t OFF_TL = OFF_DT + (size_t)TG * 64 * 4;
constexpr size_t OFF_SG = OFF_TL + (size_t)TG * 256 * 2;
constexpr size_t OFF_R = OFF_SG + (size_t)TG * 128 * 2;
constexpr size_t OFF_H1 = OFF_R;
constexpr size_t OFF_XBCRAW = OFF_H1 + (size_t)TG * 1024 * 2;
constexpr size_t OFF_RW = OFF_XBCRAW + (size_t)TG * 3072 * 2;
constexpr size_t OFF_SYF = OFF_R;
constexpr size_t OFF_SYB = OFF_SYF + (size_t)TG * 2048 * 2;
constexpr size_t OFF_WYF = OFF_SYB + (size_t)TG * 2048 * 2;
constexpr size_t OFF_WYB = OFF_WYF + (size_t)TG * 1024 * 2;
constexpr size_t OFF_YM = OFF_WYB + (size_t)TG * 1024 * 2;
constexpr size_t OFF_YR = OFF_YM + (size_t)TG * 2048 * 2;
constexpr size_t OFF_END = OFF_YR + (size_t)TG * 1024 * 2;
constexpr size_t OFF_BAR = OFF_END;
constexpr size_t WS_NEED = OFF_BAR + XCD_BAR_WORDS_C * 4;
constexpr size_t OFF_U = OFF_XBC;
constexpr size_t OFF_H2 = OFF_GRP;
constexpr size_t OFF_ACT = OFF_H2 + (size_t)NTOK * 1024 * 2;
constexpr size_t OFF_X1 = OFF_ACT + (size_t)NTOK * 2816 * 2;

constexpr size_t OUT_SSMF = 12582912;
constexpr size_t OUT_SSMB = OUT_SSMF + 8388608;
constexpr size_t OUT_WKVF = OUT_SSMB + 8388608;
constexpr size_t OUT_WKVB = OUT_WKVF + 2097152;

struct Params {
  const float *x_prompt, *x_sample, *ssm_f, *ssm_b, *wkv_f, *wkv_b, *c, *c_ctx, *norm1_w, *norm2_w,
      *w_ada, *b_ada, *w_in, *conv_w, *conv_b, *dt_bias, *a_log, *d_skip, *m_norm_w, *mu_shift, *w0,
      *w2, *a0, *a2, *g2, *k_k, *k_a, *r_k, *lnx_w, *lnx_b, *w_m_out, *w_r_out, *w_o, *w_gu, *w_down,
      *final_norm_w;
  float* out;
  char* ws;
  int step_lo, step_hi;
};

DI int get_tid() {
  int t = threadIdx.x;
  asm volatile("" : "+v"(t));
  return t;
}
DI u16 f2bf(float f) {
  unsigned u = __float_as_uint(f);
  u += 0x7fffu + ((u >> 16) & 1u);
  return (u16)(u >> 16);
}
DI float bf2f(u16 h) { return __uint_as_float(((unsigned)h) << 16); }
DI float siluf(float x) { return x / (1.f + __expf(-x)); }
DI float sigm(float x) { return 1.f / (1.f + __expf(-x)); }
DI float wave_sum(float v) {
  v += __int_as_float(__builtin_amdgcn_update_dpp(0, __float_as_int(v), 0xB1, 0xF, 0xF, true));
  v += __int_as_float(__builtin_amdgcn_update_dpp(0, __float_as_int(v), 0x4E, 0xF, 0xF, true));
  v += __int_as_float(__builtin_amdgcn_update_dpp(0, __float_as_int(v), 0x141, 0xF, 0xF, true));
  v += __int_as_float(__builtin_amdgcn_update_dpp(0, __float_as_int(v), 0x140, 0xF, 0xF, true));
  const int vi = __float_as_int(v);
  float a = __int_as_float(__builtin_amdgcn_readlane(vi, 0)), b = __int_as_float(__builtin_amdgcn_readlane(vi, 16));
  float c = __int_as_float(__builtin_amdgcn_readlane(vi, 32)), d = __int_as_float(__builtin_amdgcn_readlane(vi, 48));
  return (a + b) + (c + d);
}
DI unsigned pack2(float a, float b) { return (unsigned)f2bf(a) | ((unsigned)f2bf(b) << 16); }
DI int mrow_of(int tok) { return tok < 8192 ? 0 : 1 + ((tok - 8192) >> 11); }


#define XB_TMO      128
#define XB_XCNT(j)  (256  + 64 * (j))
#define XB_XSUB(j)  (1280 + 64 * (j))
#define XB_XGEN(j)  (2304 + 64 * (j))
#define XB_TOP      3328
#define XB_TOPGEN   3392
#define XCD_BAR_WORDS 3456
#define XB_SPIN_CAP (1u << 22)
#define LAS __attribute__((address_space(3)))
DI unsigned xb_ld(unsigned* p) { return __hip_atomic_load(p, __ATOMIC_RELAXED, __HIP_MEMORY_SCOPE_AGENT); }
DI unsigned xb_add(unsigned* p, unsigned v) { return __hip_atomic_fetch_add(p, v, __ATOMIC_RELAXED, __HIP_MEMORY_SCOPE_AGENT); }
DI unsigned xb_xcc_id() { return (unsigned)__builtin_amdgcn_s_getreg((3 << 11) | 20) & 0xFu; }
#define XB_SPIN(cond, bar) do { unsigned _sp = 0; while (cond) { __builtin_amdgcn_s_sleep(1); \
    if ((++_sp & 255u) == 0u) { if (xb_ld(&(bar)[XB_TMO])) break; if (_sp > XB_SPIN_CAP) { atomicAdd(&(bar)[XB_TMO], 1u); break; } } } } while (0)
struct XcdBarrier { unsigned* bar; unsigned x; volatile LAS unsigned* st; };
DI XcdBarrier xcd_barrier_post(unsigned* bar, volatile LAS unsigned* st) {
  XcdBarrier b; b.bar = bar; b.x = xb_xcc_id(); b.st = st;
  if (threadIdx.x == 0) (void)xb_add(&bar[XB_XCNT(b.x)], 1u);
  return b;
}
DI void xcd_barrier_complete(unsigned* bar, unsigned x, unsigned& nloc, unsigned& nx) {
  const unsigned G = gridDim.x * gridDim.y * gridDim.z;
  unsigned sum, cnt, mine, sp = 0u;
  for (;;) {
    sum = 0u; cnt = 0u; mine = 0u;
#pragma unroll
    for (unsigned j = 0; j < 16; ++j) { const unsigned c = xb_ld(&bar[XB_XCNT(j)]); sum += c; cnt += (c > 0u) ? 1u : 0u; mine = (j == x) ? c : mine; }
    if (sum == G) break;
    __builtin_amdgcn_s_sleep(1);
    if ((++sp & 255u) == 0u) { if (xb_ld(&bar[XB_TMO])) break; if (sp > XB_SPIN_CAP) { atomicAdd(&bar[XB_TMO], 1u); break; } }
  }
  nloc = mine > 0u ? mine : 1u; nx = cnt > 0u ? cnt : 1u;
}
DI void xcd_barrier(const XcdBarrier& b) {
  asm volatile("s_waitcnt vmcnt(0)" ::: "memory");
  __syncthreads();
  if (threadIdx.x == 0) {
    unsigned* bar = b.bar;
    asm volatile("" : "+s"(bar));
    __builtin_amdgcn_s_waitcnt(0);
    unsigned nloc = b.st[0], nx = b.st[1];
    if (nloc == 0u) { xcd_barrier_complete(bar, b.x, nloc, nx); b.st[0] = nloc; b.st[1] = nx; }
    const unsigned old = xb_add(&bar[XB_XSUB(b.x)], 1u);
    const unsigned gen = old / nloc;
    if (old + 1u == (gen + 1u) * nloc) {
      __builtin_amdgcn_fence(__ATOMIC_RELEASE, "agent");
      asm volatile("s_waitcnt vmcnt(0)" ::: "memory");
      const unsigned og = xb_add(&bar[XB_TOP], 1u);
      const unsigned tg = og / nx;
      if (og + 1u == (tg + 1u) * nx) xb_add(&bar[XB_TOPGEN], 1u);
      else XB_SPIN(xb_ld(&bar[XB_TOPGEN]) == tg, bar);
      __builtin_amdgcn_fence(__ATOMIC_ACQUIRE, "agent");
      xb_add(&bar[XB_XGEN(b.x)], 1u);
      asm volatile("s_waitcnt vmcnt(0)" ::: "memory");
    } else {
      XB_SPIN(xb_ld(&bar[XB_XGEN(b.x)]) == gen, bar);
      __builtin_amdgcn_fence(__ATOMIC_ACQUIRE, "agent");
      asm volatile("s_waitcnt vmcnt(0)" ::: "memory");
    }
  }
  __syncthreads();
}

DI void gemm_load(const int tid, const u16* A, int lda, const u16* B, int ldb, int k0, uint4 (&ra)[4], uint4 (&rb)[2]) {
#pragma unroll
  for (int i = 0; i < 4; ++i) {
    int idx = tid + i * 512;
    int row = idx >> 3, ch = idx & 7;
    ra[i] = *(const uint4*)(A + (size_t)row * lda + k0 + ch * 8);
  }
#pragma unroll
  for (int i = 0; i < 2; ++i) {
    int idx = tid + i * 512;
    int row = idx >> 3, ch = idx & 7;
    rb[i] = *(const uint4*)(B + (size_t)row * ldb + k0 + ch * 8);
  }
}
DI void gemm_store_lds(const int tid, char* sA, char* sB, const uint4 (&ra)[4], const uint4 (&rb)[2]) {
#pragma unroll
  for (int i = 0; i < 4; ++i) {
    int idx = tid + i * 512;
    int row = idx >> 3, ch = idx & 7;
    *(uint4*)(sA + row * 128 + ((ch ^ ((row >> 1) & 7)) << 4)) = ra[i];
  }
#pragma unroll
  for (int i = 0; i < 2; ++i) {
    int idx = tid + i * 512;
    int row = idx >> 3, ch = idx & 7;
    *(uint4*)(sB + row * 128 + ((ch ^ ((row >> 1) & 7)) << 4)) = rb[i];
  }
}
DI void gemm_compute(const char* sA, const char* sB, f32x4 (&acc)[4][4], int wm, int wn, int lane) {
#pragma unroll
  for (int kk = 0; kk < 2; ++kk) {
    bf16x8 a[4], b[4];
    const int ch = kk * 4 + (lane >> 4);
#pragma unroll
    for (int mf = 0; mf < 4; ++mf) {
      int row = wm * 64 + mf * 16 + (lane & 15);
      a[mf] = *(const bf16x8*)(sA + row * 128 + ((ch ^ ((row >> 1) & 7)) << 4));
    }
#pragma unroll
    for (int nf = 0; nf < 4; ++nf) {
      int row = wn * 64 + nf * 16 + (lane & 15);
      b[nf] = *(const bf16x8*)(sB + row * 128 + ((ch ^ ((row >> 1) & 7)) << 4));
    }
#pragma unroll
    for (int mf = 0; mf < 4; ++mf)
#pragma unroll
      for (int nf = 0; nf < 4; ++nf)
        acc[mf][nf] = __builtin_amdgcn_mfma_f32_16x16x32_bf16(a[mf], b[nf], acc[mf][nf], 0, 0, 0);
  }
}
DI void gemm_acc(const u16* A, int lda, const u16* B, int ldb, int K, f32x4 (&acc)[4][4], char* smem) {
  const int tid = get_tid(), lane = tid & 63, wave = tid >> 6;
  const int wm = wave >> 1, wn = wave & 1;
  char* sA0 = smem;
  char* sB0 = smem + 32768;
  char* sA1 = smem + 49152;
  char* sB1 = smem + 81920;
  uint4 ra[4], rb[2];
  const int nk = K >> 6;
  gemm_load(tid, A, lda, B, ldb, 0, ra, rb);
  gemm_store_lds(tid, sA0, sB0, ra, rb);
  __syncthreads();
  for (int kt = 0; kt < nk; ++kt) {
    const bool more = (kt + 1 < nk);
    if (more) gemm_load(tid, A, lda, B, ldb, (kt + 1) * 64, ra, rb);
    if (kt & 1) gemm_compute(sA1, sB1, acc, wm, wn, lane);
    else gemm_compute(sA0, sB0, acc, wm, wn, lane);
    if (more) {
      if (kt & 1) gemm_store_lds(tid, sA0, sB0, ra, rb);
      else gemm_store_lds(tid, sA1, sB1, ra, rb);
    }
    __syncthreads();
  }
}
DI void zero_acc(f32x4 (&acc)[4][4]) {
#pragma unroll
  for (int i = 0; i < 4; ++i)
#pragma unroll
    for (int j = 0; j < 4; ++j) { float z0; asm volatile("v_mov_b32 %0, 0" : "=v"(z0)); acc[i][j] = f32x4{z0, z0, z0, z0}; }
}

#define PG8_LAS __attribute__((address_space(3)))
namespace pg8 {
typedef unsigned short bf16_t;
typedef short bf16x8 __attribute__((ext_vector_type(8)));
typedef float f32x4 __attribute__((ext_vector_type(4)));
typedef unsigned u32x4 __attribute__((ext_vector_type(4)));
constexpr int BM = 256, BK = 64, HALF = 128, HTB = HALF * BK * 2  , STAGE_BYTES = 8 * HTB, NXCD = 8, WGM = 8;

__host__ __device__ __forceinline__ int lds_byte(int r, int c) { const int st = (r >> 4) * 2 + (c >> 5), rr = r & 15, cc = c & 31, ob = rr * 64 + cc * 2; return st * 1024 + (ob ^ (((ob >> 9) & 1) << 5)); }
__host__ __device__ __forceinline__ void stage_rc(int b, int& R, int& C) { const int st = b / 1024, sb = b % 1024, swz = sb ^ (((sb >> 9) & 1) << 5); R = (st >> 1) * 16 + swz / 64; C = (st & 1) * 32 + (swz % 64) / 2; }
__host__ __device__ __forceinline__ int perm32(int rho) { const int n = rho >> 4, i = rho & 15; return 8 * (i >> 2) + 4 * n + (i & 3); }

struct Unit { int pm, pn; };
struct Gemm { const bf16_t* A; const bf16_t* Bt; int M, N, K; };

struct StaticOrder {
    int nM, nN, nwg, G, c;
    __host__ __device__ void init(int M, int N, int G_, int c_) { nM = M / BM; nN = N / BM; nwg = nM * nN; G = G_; c = c_; }
    __host__ __device__ bool next(int i, Unit& u) const {
        const long L = (long)i * G + c; if (L >= nwg) return false;
        int wgid = (int)L; { const int q = nwg / NXCD, r = nwg % NXCD, xcd = wgid % NXCD, off = wgid / NXCD; wgid = (xcd < r ? xcd * (q + 1) : r * (q + 1) + (xcd - r) * q) + off; }
        const int nig = WGM * nN, gid = wgid / nig, fm = gid * WGM, gsz = (nM - fm) < WGM ? (nM - fm) : WGM;
        u.pm = fm + ((wgid % nig) % gsz); u.pn = (wgid % nig) / gsz; return true;
    }
    __device__ __forceinline__ void a_ready(const Unit&) const {}
    __device__ __forceinline__ void done(const Unit&) const {}
};
__device__ __forceinline__ unsigned cvt_pk_bf16(float lo, float hi) { unsigned r; asm volatile("v_cvt_pk_bf16_f32 %0, %1, %2" : "=v"(r) : "v"(lo), "v"(hi)); return r; }
template <class Epi, class Sched, bool STAMP = false>
__device__ __forceinline__ void gemm_phase(PG8_LAS unsigned char* lds, const Gemm g, const Sched& S, const Epi& E, unsigned long long* stamps) {
    const int tid = get_tid(), wid = __builtin_amdgcn_readfirstlane(tid >> 6), lane = tid & 63, wr = wid >> 2, wc = wid & 3, fr = lane & 15, fq = lane >> 4;
    const int K = g.K, nt = K / BK;
    int ts_lo = 0, ts_hi = 0, nts = 0; const unsigned long long rt_entry = STAMP ? (unsigned long long)wall_clock64() : 0ull;
#define PG8_STAMP() do { if (STAMP && wid == 0 && nts < 64) { const unsigned long long _c = (unsigned long long)clock64(); \
        ts_lo = (lane == nts) ? (int)(unsigned)_c : ts_lo; ts_hi = (lane == nts) ? (int)(unsigned)(_c >> 32) : ts_hi; ++nts; } } while (0)
    PG8_STAMP();
    unsigned voffA[2], voffB[2];
#pragma unroll
    for (int i = 0; i < 2; ++i) { int R, C; stage_rc(tid * 16 + i * 8192, R, C); const int Rb = Epi::PERM ? ((R & ~31) + perm32(R & 31)) : R;
        voffA[i] = (unsigned)(R * K + C) * 2u; voffB[i] = (unsigned)(Rb * K + C) * 2u; }
    const size_t kstep = (size_t)(BK * 2);
    const size_t hstep = (size_t)HALF * K * 2;
    const size_t tstep = 2 * hstep;
    const unsigned ldsw = (unsigned)wid * 1024u;
    const int aoff = lds_byte(wr * 64 + fr, fq * 8), boff = lds_byte(wc * 32 + fr, fq * 8);
#define PG8_SA(b, h) (((b) * 2 + (h)) * HTB)
#define PG8_SB(b, h) ((4 + (b) * 2 + (h)) * HTB)
#define PG8_STAGE(bufoff, gbase, voff) do { _Pragma("unroll") for (int _i = 0; _i < 2; ++_i) \
        __builtin_amdgcn_global_load_lds((const unsigned*)((const char*)(gbase) + (voff)[_i]), (PG8_LAS unsigned*)(lds + (bufoff) + ldsw + _i * 8192), 16, 0, 0); } while (0)
#define PG8_LDA(dst, b, h) do { _Pragma("unroll") for (int m = 0; m < 4; ++m) _Pragma("unroll") for (int k = 0; k < 2; ++k) dst[m][k] = *(const PG8_LAS bf16x8*)(lds + PG8_SA(b, h) + aoff + m * 2048 + k * 1024); } while (0)
#define PG8_LDB(dst, b, h) do { _Pragma("unroll") for (int n = 0; n < 2; ++n) _Pragma("unroll") for (int k = 0; k < 2; ++k) dst[n][k] = *(const PG8_LAS bf16x8*)(lds + PG8_SB(b, h) + boff + n * 2048 + k * 1024); } while (0)
#define PG8_MMA(ai, bj, At, Bt) do { __builtin_amdgcn_s_setprio(1); _Pragma("unroll") for (int m = 0; m < 4; ++m) _Pragma("unroll") for (int n = 0; n < 2; ++n) _Pragma("unroll") for (int k = 0; k < 2; ++k) \
        acc[ai][bj][m][n] = __builtin_amdgcn_mfma_f32_16x16x32_bf16(Bt[n][k], At[m][k], acc[ai][bj][m][n], 0, 0, 0); __builtin_amdgcn_s_setprio(0); } while (0)
#define PG8_WAIT_V(n) asm volatile("s_waitcnt vmcnt(" #n ")" ::: "memory")
#define PG8_WAIT_L(n) asm volatile("s_waitcnt lgkmcnt(" #n ")" ::: "memory")
#define PG8_BAR __builtin_amdgcn_s_barrier()
#define PG8_SCHED __builtin_amdgcn_sched_barrier(0)
    Unit cur, nxt; int ui = 0;
    if (!S.next(0, cur)) return;
    f32x4 acc[2][2][4][2];
#pragma unroll
    for (int a = 0; a < 2; ++a)
#pragma unroll
        for (int b = 0; b < 2; ++b)
#pragma unroll
            for (int m = 0; m < 4; ++m)
#pragma unroll
                for (int n = 0; n < 2; ++n) { float z0; asm volatile("v_mov_b32 %0, 0" : "=v"(z0)); acc[a][b][m][n] = (f32x4){z0, z0, z0, z0}; }
    bf16x8 At[4][2], B0[2][2], B1[2][2];
    const char* cA = (const char*)g.A + (size_t)cur.pm * tstep; const char* cB = (const char*)g.Bt + (size_t)cur.pn * tstep;
    S.a_ready(cur);
    PG8_STAGE(PG8_SB(0, 0), cB, voffB); PG8_STAGE(PG8_SA(0, 0), cA, voffA); PG8_STAGE(PG8_SB(0, 1), cB + hstep, voffB); PG8_STAGE(PG8_SA(0, 1), cA + hstep, voffA);
    if (wr == 1) PG8_BAR;
    PG8_WAIT_V(4); PG8_BAR;
    PG8_STAGE(PG8_SB(1, 0), cB + kstep, voffB); PG8_STAGE(PG8_SA(1, 0), cA + kstep, voffA); PG8_STAGE(PG8_SB(1, 1), cB + hstep + kstep, voffB);
    PG8_WAIT_V(6); PG8_BAR;
    PG8_STAMP();
    for (;;) {
        const bool has_next = S.next(ui + 1, nxt);
        const char* nA = has_next ? (const char*)g.A + (size_t)nxt.pm * tstep : cA; const char* nB = has_next ? (const char*)g.Bt + (size_t)nxt.pn * tstep : cB;
        for (int t = 0; t < nt; t += 2) {
            const bool last = (t == nt - 2);
            const char* a1 = cA + (size_t)(t + 1) * kstep;
            const char* a2 = last ? nA : cA + (size_t)(t + 2) * kstep; const char* b2 = last ? nB : cB + (size_t)(t + 2) * kstep;
            const char* a3 = a2 + kstep; const char* b3 = b2 + kstep;
            if (last && has_next) S.a_ready(nxt);
            PG8_LDB(B0, 0, 0); PG8_SCHED; PG8_LDA(At, 0, 0); PG8_STAGE(PG8_SA(1, 1), a1 + hstep, voffA);
            PG8_WAIT_L(8); PG8_BAR; PG8_WAIT_L(0); PG8_MMA(0, 0, At, B0); PG8_BAR; PG8_SCHED;
            PG8_LDB(B1, 0, 1); PG8_STAGE(PG8_SB(0, 0), b2, voffB);
            PG8_BAR; PG8_WAIT_L(0); PG8_MMA(0, 1, At, B1); PG8_BAR;
            PG8_LDA(At, 0, 1); PG8_STAGE(PG8_SA(0, 0), a2, voffA);
            PG8_BAR; PG8_WAIT_L(0); PG8_MMA(1, 0, At, B0); PG8_BAR; PG8_SCHED;
            PG8_STAGE(PG8_SB(0, 1), b2 + hstep, voffB);
            PG8_WAIT_V(6); PG8_BAR; PG8_MMA(1, 1, At, B1); PG8_BAR;
            PG8_LDB(B0, 1, 0); PG8_SCHED; PG8_LDA(At, 1, 0); PG8_STAGE(PG8_SA(0, 1), a2 + hstep, voffA);
            PG8_WAIT_L(8); PG8_BAR; PG8_WAIT_L(0); PG8_MMA(0, 0, At, B0); PG8_BAR; PG8_SCHED;
            PG8_LDB(B1, 1, 1); PG8_STAGE(PG8_SB(1, 0), b3, voffB);
            PG8_BAR; PG8_WAIT_L(0); PG8_MMA(0, 1, At, B1); PG8_BAR;
            PG8_LDA(At, 1, 1); PG8_STAGE(PG8_SA(1, 0), a3, voffA);
            PG8_BAR; PG8_WAIT_L(0); PG8_MMA(1, 0, At, B0); PG8_BAR; PG8_SCHED;
            PG8_STAGE(PG8_SB(1, 1), b3 + hstep, voffB);
            PG8_WAIT_V(6); PG8_BAR; PG8_MMA(1, 1, At, B1); PG8_BAR;
        }
        PG8_STAMP();
        if constexpr (!Epi::AFTER_DRAIN) { E(acc, cur, wr, wc, fr, fq); S.done(cur); }
        PG8_STAMP();
        if (!has_next) break;
#pragma unroll
        for (int a = 0; a < 2; ++a)
#pragma unroll
            for (int b = 0; b < 2; ++b)
#pragma unroll
                for (int m = 0; m < 4; ++m)
#pragma unroll
                    for (int n = 0; n < 2; ++n) { float z0; asm volatile("v_mov_b32 %0, 0" : "=v"(z0)); acc[a][b][m][n] = (f32x4){z0, z0, z0, z0}; }
        cur = nxt; cA = nA; cB = nB; ++ui;
    }
    PG8_WAIT_V(0);
    if (wr == 0) PG8_BAR;
    PG8_BAR;
    if constexpr (Epi::AFTER_DRAIN) { E.fused(acc, cur, wr, wc, fr, fq, lds, wid, lane); S.done(cur); }
    PG8_STAMP();
    if (STAMP && wid == 0) { stamps[lane] = lane < nts ? (((unsigned long long)(unsigned)ts_hi << 32) | (unsigned)ts_lo) : 0ull;
        if (lane == 62) stamps[62] = rt_entry; if (lane == 63) stamps[63] = (unsigned long long)wall_clock64(); }
#undef PG8_STAMP
#undef PG8_SA
#undef PG8_SB
#undef PG8_STAGE
#undef PG8_LDA
#undef PG8_LDB
#undef PG8_MMA
#undef PG8_WAIT_V
#undef PG8_WAIT_L
#undef PG8_BAR
#undef PG8_SCHED
}
}

using pg8::cvt_pk_bf16;
DI uint4 pack8(const pg8::f32x4& a, const pg8::f32x4& b) {
  return uint4{cvt_pk_bf16(a[0], a[1]), cvt_pk_bf16(a[2], a[3]), cvt_pk_bf16(b[0], b[1]), cvt_pk_bf16(b[2], b[3])};
}
DI void unpack8(const uint4& u, float (&o)[8]) {
  o[0] = bf2f((u16)(u.x & 0xffff)); o[1] = bf2f((u16)(u.x >> 16));
  o[2] = bf2f((u16)(u.y & 0xffff)); o[3] = bf2f((u16)(u.y >> 16));
  o[4] = bf2f((u16)(u.z & 0xffff)); o[5] = bf2f((u16)(u.z >> 16));
  o[6] = bf2f((u16)(u.w & 0xffff)); o[7] = bf2f((u16)(u.w >> 16));
}
struct EpiP {
  static constexpr bool PERM = true, AFTER_DRAIN = false;
  u16 *zb, *xr, *rwb, *gb; float* dtb;
  DI void operator()(const pg8::f32x4 (&acc)[2][2][4][2], const pg8::Unit& u, int wr, int wc, int fr, int fq) const {
    const int row0 = u.pm * 256 + wr * 64 + fr;
#pragma unroll
    for (int bj = 0; bj < 2; ++bj) {
      const int cg = u.pn * 256 + bj * 128 + wc * 32;
      const int col0 = cg + 8 * fq;
      if (cg >= 10688) continue;
#pragma unroll
      for (int ai = 0; ai < 2; ++ai)
#pragma unroll
        for (int m = 0; m < 4; ++m) {
          const size_t row = row0 + ai * 128 + m * 16;
          const pg8::f32x4 v0 = acc[ai][bj][m][0], v1 = acc[ai][bj][m][1];
          if (cg >= 5120 && cg < 5184) {
            float* d = dtb + row * 64 + (col0 - 5120);
            *(pg8::f32x4*)d = v0; *(pg8::f32x4*)(d + 4) = v1;
          } else {
            u16* dst = (cg < 2048) ? zb + row * 2048 + col0
                     : (cg < 5120) ? xr + row * 3072 + (col0 - 2048)
                     : (cg < 8640) ? rwb + row * 3456 + (col0 - 5184)
                                   : gb + row * 2048 + (col0 - 8640);
            *(uint4*)dst = pack8(v0, v1);
          }
        }
    }
  }
};
template <int PASS>
struct EpiOut {
  static constexpr bool PERM = true, AFTER_DRAIN = false;
  const u16* gb; u16* U;
  DI void operator()(const pg8::f32x4 (&acc)[2][2][4][2], const pg8::Unit& u, int wr, int wc, int fr, int fq) const {
    const int row0 = u.pm * 256 + wr * 64 + fr;
#pragma unroll
    for (int bj = 0; bj < 2; ++bj) {
      const int col0 = u.pn * 256 + bj * 128 + wc * 32 + 8 * fq;
#pragma unroll
      for (int ai = 0; ai < 2; ++ai)
#pragma unroll
        for (int m = 0; m < 4; ++m) {
          const size_t row = row0 + ai * 128 + m * 16;
          float gt[8];
          unpack8(*(const uint4*)(gb + row * 2048 + PASS * 1024 + col0), gt);
          pg8::f32x4 v0 = acc[ai][bj][m][0], v1 = acc[ai][bj][m][1];
#pragma unroll
          for (int e = 0; e < 4; ++e) { v0[e] *= sigm(gt[e]); v1[e] *= sigm(gt[4 + e]); }
          if (PASS == 1) {
            float pu[8];
            unpack8(*(const uint4*)(U + row * 1024 + col0), pu);
#pragma unroll
            for (int e = 0; e < 4; ++e) { v0[e] += pu[e]; v1[e] += pu[4 + e]; }
          }
          *(uint4*)(U + row * 1024 + col0) = pack8(v0, v1);
        }
    }
  }
};
struct EpiWo {
  static constexpr bool PERM = true, AFTER_DRAIN = false;
  const float *xp, *xs, *mod; float* out; int tok0;
  DI void operator()(const pg8::f32x4 (&acc)[2][2][4][2], const pg8::Unit& u, int wr, int wc, int fr, int fq) const {
    const int row0 = u.pm * 256 + wr * 64 + fr;
#pragma unroll
    for (int bj = 0; bj < 2; ++bj) {
      const int col0 = u.pn * 256 + bj * 128 + wc * 32 + 8 * fq;
#pragma unroll
      for (int ai = 0; ai < 2; ++ai)
#pragma unroll
        for (int m = 0; m < 4; ++m) {
          const int tok = tok0 + row0 + ai * 128 + m * 16;
          const float* xr = tok < 8192 ? xp + (size_t)tok * 1024 : xs + (size_t)(tok - 8192) * 1024;
          const float* gt = mod + mrow_of(tok) * 6144 + 2048 + col0;
          const pg8::f32x4 x0 = *(const pg8::f32x4*)(xr + col0), x1 = *(const pg8::f32x4*)(xr + col0 + 4);
          const pg8::f32x4 g0 = *(const pg8::f32x4*)gt, g1 = *(const pg8::f32x4*)(gt + 4);
          float* o = out + (size_t)tok * 1024 + col0;
          *(pg8::f32x4*)o = x0 + g0 * acc[ai][bj][m][0];
          *(pg8::f32x4*)(o + 4) = x1 + g1 * acc[ai][bj][m][1];
        }
    }
  }
};
struct EpiGU {
  static constexpr bool PERM = true, AFTER_DRAIN = false;
  u16* act;
  DI void operator()(const pg8::f32x4 (&acc)[2][2][4][2], const pg8::Unit& u, int wr, int wc, int fr, int fq) const {
    const int row0 = u.pm * 256 + wr * 64 + fr;
    const int col0 = u.pn * 128 + wc * 32 + 8 * fq;
#pragma unroll
    for (int ai = 0; ai < 2; ++ai)
#pragma unroll
      for (int m = 0; m < 4; ++m) {
        const size_t row = row0 + ai * 128 + m * 16;
        pg8::f32x4 v0, v1;
#pragma unroll
        for (int e = 0; e < 4; ++e) {
          v0[e] = siluf(acc[ai][0][m][0][e]) * acc[ai][1][m][0][e];
          v1[e] = siluf(acc[ai][0][m][1][e]) * acc[ai][1][m][1][e];
        }
        *(uint4*)(act + row * 2816 + col0) = pack8(v0, v1);
      }
  }
};
struct EpiDown {
  static constexpr bool PERM = true, AFTER_DRAIN = false;
  const float* mod; float* out;
  DI void operator()(const pg8::f32x4 (&acc)[2][2][4][2], const pg8::Unit& u, int wr, int wc, int fr, int fq) const {
    const int row0 = u.pm * 256 + wr * 64 + fr;
#pragma unroll
    for (int bj = 0; bj < 2; ++bj) {
      const int col0 = u.pn * 256 + bj * 128 + wc * 32 + 8 * fq;
#pragma unroll
      for (int ai = 0; ai < 2; ++ai)
#pragma unroll
        for (int m = 0; m < 4; ++m) {
          const int tok = row0 + ai * 128 + m * 16;
          const float* gt = mod + mrow_of(tok) * 6144 + 5120 + col0;
          const pg8::f32x4 g0 = *(const pg8::f32x4*)gt, g1 = *(const pg8::f32x4*)(gt + 4);
          float* o = out + (size_t)tok * 1024 + col0;
          const pg8::f32x4 x0 = *(const pg8::f32x4*)o, x1 = *(const pg8::f32x4*)(o + 4);
          *(pg8::f32x4*)o = x0 + g0 * acc[ai][bj][m][0];
          *(pg8::f32x4*)(o + 4) = x1 + g1 * acc[ai][bj][m][1];
        }
    }
  }
};
template <class Epi>
DI void run_gemm8(char* smem, const u16* A, const u16* Bt, int M, int N, int K, const Epi& E) {
  asm volatile("" : "+s"(M), "+s"(N), "+s"(K));
  pg8::Gemm gm{A, Bt, M, N, K};
  pg8::StaticOrder S;
  S.init(M, N, gridDim.x, blockIdx.x);
  pg8::gemm_phase<Epi, pg8::StaticOrder, false>((PG8_LAS unsigned char*)smem, gm, S, E, nullptr);
  __syncthreads();
}

template <int MODE>
__device__ __forceinline__ void convT(const float* __restrict__ src, int K, int N, u16* __restrict__ dst, char* smem) {
  float* tile = (float*)smem;
  const int tid = get_tid();
  const int KT = K >> 6, NT = N >> 6;
  for (int t = blockIdx.x; t < KT * NT; t += gridDim.x) {
    int kt = t % KT, nt = t / KT;
#pragma unroll
    for (int i = 0; i < 8; ++i) {
      int idx = tid + i * 512;
      int r = idx >> 6, cc = idx & 63;
      tile[r * 65 + cc] = src[(size_t)(kt * 64 + r) * N + nt * 64 + cc];
    }
    __syncthreads();
    int n = tid >> 3, kc = tid & 7;
    unsigned w[4];
#pragma unroll
    for (int j = 0; j < 4; ++j)
      w[j] = pack2(tile[(kc * 8 + 2 * j) * 65 + n], tile[(kc * 8 + 2 * j + 1) * 65 + n]);
    int ng = nt * 64 + n;
    int row = ng;
    if (MODE == 1) {
      int isu = ng >= 2816;
      int nn = ng - isu * 2816;
      row = (nn >> 7) * 256 + isu * 128 + (nn & 127);
    }
    *(uint4*)(dst + (size_t)row * K + kt * 64 + kc * 8) = uint4{w[0], w[1], w[2], w[3]};
    __syncthreads();
  }
}

__device__ __forceinline__ void step_prep(const Params& p, char* smem) {
  const int tid = get_tid();
  char* ws = p.ws;
  {
    float* red = (float*)smem;
    float* mod = (float*)(ws + OFF_MOD);
    for (int item = blockIdx.x; item < 192; item += gridDim.x) {
      int c4 = tid & 7, kl = tid >> 3;
      float acc[12];
#pragma unroll
      for (int i = 0; i < 12; ++i) acc[i] = 0.f;
      for (int k = kl; k < 1024; k += 64) {
        float4 w = *(const float4*)(p.w_ada + (size_t)k * 6144 + item * 32 + c4 * 4);
        float s0 = siluf(p.c_ctx[k]), s1 = siluf(p.c[k]), s2 = siluf(p.c[1024 + k]);
        acc[0] += s0 * w.x; acc[1] += s0 * w.y; acc[2] += s0 * w.z; acc[3] += s0 * w.w;
        acc[4] += s1 * w.x; acc[5] += s1 * w.y; acc[6] += s1 * w.z; acc[7] += s1 * w.w;
        acc[8] += s2 * w.x; acc[9] += s2 * w.y; acc[10] += s2 * w.z; acc[11] += s2 * w.w;
      }
#pragma unroll
      for (int i = 0; i < 12; ++i) red[(kl * 8 + c4) * 12 + i] = acc[i];
      __syncthreads();
      if (tid < 96) {
        int cond = tid >> 5, col = tid & 31;
        int cc4 = col >> 2, e = col & 3;
        float s = 0.f;
        for (int k = 0; k < 64; ++k) s += red[(k * 8 + cc4) * 12 + cond * 4 + e];
        int n = item * 32 + col;
        mod[cond * 6144 + n] = s + p.b_ada[n];
      }
      __syncthreads();
    }
  }
  convT<0>(p.w_in, 1024, 10688, (u16*)(ws + OFF_WIN), smem);
  convT<1>(p.w_gu, 1024, 5632, (u16*)(ws + OFF_WGU), smem);
  convT<0>(p.w_down, 2816, 1024, (u16*)(ws + OFF_WDOWN), smem);
  convT<0>(p.w_m_out, 2048, 1024, (u16*)(ws + OFF_WMOUT), smem);
  convT<0>(p.w_r_out, 1024, 1024, (u16*)(ws + OFF_WROUT), smem);
  convT<0>(p.w_o, 1024, 1024, (u16*)(ws + OFF_WO), smem);
  convT<0>(p.w2, 64, 1024, (u16*)(ws + OFF_W2T), smem);
  convT<0>(p.w2 + 65536, 64, 1024, (u16*)(ws + OFF_W2T) + 65536, smem);
  convT<0>(p.a2, 64, 1024, (u16*)(ws + OFF_A2T), smem);
  convT<0>(p.a2 + 65536, 64, 1024, (u16*)(ws + OFF_A2T) + 65536, smem);
  convT<0>(p.g2, 128, 1024, (u16*)(ws + OFF_G2T), smem);
  {
    uint4* z = (uint4*)(ws + OFF_WIN + (size_t)10688 * 1024 * 2);
    for (int i = blockIdx.x * NTHR + tid; i < 8192; i += gridDim.x * NTHR) z[i] = uint4{0, 0, 0, 0};
  }
}

template <int WHICH>
__device__ __forceinline__ void step_norm(const Params& p, int g) {
  const int tid = get_tid(), lane = tid & 63, wave = tid >> 6;
  const float* mod = (const float*)(p.ws + OFF_MOD);
  const int nrows = WHICH == 0 ? TG : NTOK;
  u16* dst = (u16*)(p.ws + (WHICH == 0 ? OFF_H1 : OFF_H2));
  const float* nw = WHICH == 0 ? p.norm1_w : p.norm2_w;
  for (int r = blockIdx.x * 8 + wave; r < nrows; r += gridDim.x * 8) {
    int tok = WHICH == 0 ? g * TG + r : r;
    const float* xr;
    if (WHICH == 0) xr = tok < 8192 ? p.x_prompt + (size_t)tok * 1024 : p.x_sample + (size_t)(tok - 8192) * 1024;
    else xr = (const float*)(p.ws + OFF_X1) + (size_t)tok * 1024;
    const float* mr = mod + mrow_of(tok) * 6144 + (WHICH == 0 ? 0 : 3072);
    float4 v[4];
    float ss = 0.f;
#pragma unroll
    for (int i = 0; i < 4; ++i) {
      v[i] = ((const float4*)xr)[i * 64 + lane];
      ss += v[i].x * v[i].x + v[i].y * v[i].y + v[i].z * v[i].z + v[i].w * v[i].w;
    }
    ss = wave_sum(ss);
    float rinv = rsqrtf(ss * (1.f / 1024.f) + 1e-6f);
#pragma unroll
    for (int i = 0; i < 4; ++i) {
      int col = (i * 64 + lane) * 4;
      float4 w4 = *(const float4*)(nw + col);
      float4 sh = *(const float4*)(mr + col);
      float4 sc = *(const float4*)(mr + 1024 + col);
      float h0 = v[i].x * rinv * w4.x * (1.f + sc.x) + sh.x;
      float h1 = v[i].y * rinv * w4.y * (1.f + sc.y) + sh.y;
      float h2 = v[i].z * rinv * w4.z * (1.f + sc.z) + sh.z;
      float h3 = v[i].w * rinv * w4.w * (1.f + sc.w) + sh.w;
      *(uint2*)(dst + (size_t)r * 1024 + col) = uint2{pack2(h0, h1), pack2(h2, h3)};
    }
  }
}

__device__ __forceinline__ void step_gemm1(const Params& p, char* smem) {
  char* ws = p.ws;
  EpiP E{(u16*)(ws + OFF_Z), (u16*)(ws + OFF_XBCRAW), (u16*)(ws + OFF_RW), (u16*)(ws + OFF_GATE), (float*)(ws + OFF_DT)};
  run_gemm8(smem, (const u16*)(ws + OFF_H1), (const u16*)(ws + OFF_WIN), TG, NPAD, 1024, E);
}

__device__ __forceinline__ void step_cr1(const Params& p, int g) {
  char* ws = p.ws;
  const int tid = get_tid(), lane = tid & 63, wave = tid >> 6;
  const int Ls = g < 2 ? 256 : 2048;
  {
    const u16* xr = (const u16*)(ws + OFF_XBCRAW);
    u16* xo = (u16*)(ws + OFF_XBC);
    for (int idx = blockIdx.x * NTHR + tid; idx < TG * 384; idx += gridDim.x * NTHR) {
      int r = idx / 384, cc = idx - r * 384;
      int pos = r & (Ls - 1);
      float s[8];
      {
        float4 b0 = *(const float4*)(p.conv_b + cc * 8), b1 = *(const float4*)(p.conv_b + cc * 8 + 4);
        s[0] = b0.x; s[1] = b0.y; s[2] = b0.z; s[3] = b0.w; s[4] = b1.x; s[5] = b1.y; s[6] = b1.z; s[7] = b1.w;
      }
#pragma unroll
      for (int i = 0; i < 5; ++i) {
        int pp = pos + i - 2;
        if (pp >= 0 && pp < Ls) {
          uint4 u = *(const uint4*)(xr + (size_t)(r + i - 2) * 3072 + cc * 8);
          float4 w0 = *(const float4*)(p.conv_w + i * 3072 + cc * 8), w1 = *(const float4*)(p.conv_w + i * 3072 + cc * 8 + 4);
          s[0] += bf2f(u.x & 0xffff) * w0.x; s[1] += bf2f(u.x >> 16) * w0.y;
          s[2] += bf2f(u.y & 0xffff) * w0.z; s[3] += bf2f(u.y >> 16) * w0.w;
          s[4] += bf2f(u.z & 0xffff) * w1.x; s[5] += bf2f(u.z >> 16) * w1.y;
          s[6] += bf2f(u.w & 0xffff) * w1.z; s[7] += bf2f(u.w >> 16) * w1.w;
        }
      }
#pragma unroll
      for (int e = 0; e < 8; ++e) s[e] = siluf(s[e]);
      *(uint4*)(xo + (size_t)r * 3072 + cc * 8) = uint4{pack2(s[0], s[1]), pack2(s[2], s[3]), pack2(s[4], s[5]), pack2(s[6], s[7])};
    }
  }
  {
    const u16* rw = (const u16*)(ws + OFF_RW);
    __half* wk = (__half*)(ws + OFF_WK);
    u16* tl = (u16*)(ws + OFF_TL);
    u16* sg = (u16*)(ws + OFF_SG);
    const bool grid = (g == 2);
    for (int r = blockIdx.x * 8 + wave; r < TG; r += gridDim.x * 8) {
      int pos = r & (Ls - 1);
      for (int ib = 0; ib < 54; ib += 6) {
        float xxs[6];
        {
          float cur[6], shv[6], muv[6];
#pragma unroll
          for (int u = 0; u < 6; ++u) {
            int c = (ib + u) * 64 + lane;
            cur[u] = bf2f(rw[(size_t)r * 3456 + c]);
            int q = c / 864;
            int dr;
            bool ok;
            if (!grid) {
              if (q & 1) { dr = 1; ok = pos < Ls - 1; } else { dr = -1; ok = pos > 0; }
            } else {
              if (q == 0) { dr = -1; ok = (pos & 63) != 0; }
              else if (q == 1) { dr = 1; ok = (pos & 63) != 63; }
              else if (q == 2) { dr = -64; ok = pos >= 64; }
              else { dr = 64; ok = pos < Ls - 64; }
            }
            shv[u] = ok ? bf2f(rw[(size_t)(r + dr) * 3456 + c]) : 0.f;
            muv[u] = p.mu_shift[c];
          }
#pragma unroll
          for (int u = 0; u < 6; ++u) xxs[u] = cur[u] + muv[u] * (shv[u] - cur[u]);
        }
#pragma unroll
        for (int u = 0; u < 6; ++u) {
          const int it = ib + u;
          const float xx = xxs[u];
          if (it < 16) {
            wk[((size_t)(r * 16 + it) * 8 + 0) * 64 + lane] = __float2half(xx);
          } else if (it == 16) {
            tl[(size_t)r * 256 + lane] = f2bf(tanhf(xx));
          } else if (it == 17) {
            tl[(size_t)r * 256 + 64 + lane] = f2bf(tanhf(xx));
          } else if (it < 34) {
            int h = it - 18;
            float kk = xx * p.k_k[h * 64 + lane];
            float ss = wave_sum(kk * kk);
            float nkk = -kk * rsqrtf(ss + 1e-12f);
            wk[((size_t)(r * 16 + h) * 8 + 2) * 64 + lane] = __float2half(xx);
            wk[((size_t)(r * 16 + h) * 8 + 3) * 64 + lane] = __float2half(nkk);
          } else if (it < 50) {
            int h = it - 34;
            wk[((size_t)(r * 16 + h) * 8 + 1) * 64 + lane] = __float2half(xx);
          } else if (it == 50) {
            tl[(size_t)r * 256 + 128 + lane] = f2bf(xx);
          } else if (it == 51) {
            tl[(size_t)r * 256 + 192 + lane] = f2bf(xx);
          } else {
            sg[(size_t)r * 128 + (it - 52) * 64 + lane] = f2bf(sigm(xx));
          }
        }
      }
    }
  }
}

__device__ __forceinline__ void step_r2(const Params& p, char* smem) {
  char* ws = p.ws;
  const int tid = get_tid(), lane = tid & 63, wave = tid >> 6;
  const int wm = wave >> 1, wn = wave & 1;
  const u16* tl = (const u16*)(ws + OFF_TL);
  const u16* sg = (const u16*)(ws + OFF_SG);
  __half* wk = (__half*)(ws + OFF_WK);
  u16* gr = (u16*)(ws + OFF_GR);
  for (int t = blockIdx.x; t < 5 * 128; t += gridDim.x) {
    int sub = t >> 7, rem = t & 127;
    int mt = rem & 15, nt = rem >> 4;
    f32x4 acc[4][4];
    zero_acc(acc);
    if (sub < 2) {
      gemm_acc(tl + (size_t)mt * 256 * 256 + sub * 64, 256, (const u16*)(ws + OFF_W2T) + sub * 65536 + (size_t)nt * 128 * 64, 64, 64, acc, smem);
    } else if (sub < 4) {
      gemm_acc(tl + (size_t)mt * 256 * 256 + 128 + (sub - 2) * 64, 256, (const u16*)(ws + OFF_A2T) + (sub - 2) * 65536 + (size_t)nt * 128 * 64, 64, 64, acc, smem);
    } else {
      gemm_acc(sg + (size_t)mt * 256 * 128, 128, (const u16*)(ws + OFF_G2T) + (size_t)nt * 128 * 128, 128, 128, acc, smem);
    }
#pragma unroll
    for (int mf = 0; mf < 4; ++mf)
#pragma unroll
      for (int nf = 0; nf < 4; ++nf)
#pragma unroll
        for (int j = 0; j < 4; ++j) {
          if (nf == 0 && j == 0) asm volatile("" ::: "memory");
          int m = mt * 256 + wm * 64 + mf * 16 + (lane >> 4) * 4 + j;
          int n = nt * 128 + wn * 64 + nf * 16 + (lane & 15);
          float v = acc[mf][nf][j];
          if (sub < 2) {
            float wl = v + p.w0[sub * 1024 + n];
            float dec = __expf(-0.6065306597f * sigm(wl));
            wk[((size_t)(m * 16 + (n >> 6)) * 8 + 4 + 2 * sub) * 64 + (n & 63)] = __float2half(dec);
          } else if (sub < 4) {
            int d = sub - 2;
            float a = sigm(v + p.a0[d * 1024 + n]);
            wk[((size_t)(m * 16 + (n >> 6)) * 8 + 5 + 2 * d) * 64 + (n & 63)] = __float2half(a);
          } else {
            gr[(size_t)m * 1024 + n] = f2bf(v);
          }
        }
  }
}

DI int swz16(int row) { return (row ^ (row >> 3)) & 15; }
DI int sw256(int row, int e) { return row * 256 + ((((e >> 3) ^ swz16(row))) << 4) + (e & 7) * 2; }
DI const bf16x8 ldfrag256(const char* base, int row, int ch) {
  return *(const bf16x8*)(base + row * 256 + ((ch ^ swz16(row)) << 4));
}

__device__ __forceinline__ void ssd_chain(const Params& p, char* smem, int g, int chain) {
  char* ws = p.ws;
  const int tid = get_tid(), lane = tid & 63, wave = tid >> 6;
  const int Ls = g < 2 ? 256 : 2048;
  const int nch = Ls >> 7;
  const int d = chain & 1, h = (chain >> 1) & 31, b = chain >> 6;
  const int grp = h >> 3;
  const u16* xbc = (const u16*)(ws + OFF_XBC);
  const float* dtb = (const float*)(ws + OFF_DT);
  u16* yout = (u16*)(ws + (d ? OFF_SYB : OFF_SYF));
  char* Cs = smem;
  char* Bs = smem + 32768;
  char* BdT = smem + 65536;
  char* XT = smem + 98304;
  char* Ss = smem + 114688;
  float* csum = (float*)(smem + 131072);
  float* dts = (float*)(smem + 131584);
  const float a_h = -__expf(p.a_log[d * 32 + h]);
  const float dtbias = p.dt_bias[d * 32 + h];
  const int wp = wave >> 2, wn4 = wave & 3;
  f32x4 sacc[2][2];
#pragma unroll
  for (int pf = 0; pf < 2; ++pf)
#pragma unroll
    for (int nf = 0; nf < 2; ++nf) {
      if (g == 2) {
        const float* h0 = (d ? p.ssm_b : p.ssm_f) + (size_t)(b * 32 + h) * 8192;
#pragma unroll
        for (int j = 0; j < 4; ++j) {
          int pp = wp * 32 + pf * 16 + (lane >> 4) * 4 + j;
          int n = wn4 * 32 + nf * 16 + (lane & 15);
          sacc[pf][nf][j] = h0[pp * 128 + n];
        }
      } else {
        sacc[pf][nf] = f32x4{0.f, 0.f, 0.f, 0.f};
      }
    }
  const int tid_outer = tid;
  for (int ci = 0; ci < nch; ++ci) {
    int tidv = tid_outer;
    asm volatile("" : "+v"(tidv));
    const int tid = tidv, lane = tidv & 63, wave = tidv >> 6;
    const int wp = wave >> 2, wn4 = wave & 3;
    const int c = d ? nch - 1 - ci : ci;
    const int tok0 = b * Ls + c * 128;
#pragma unroll
    for (int i = 0; i < 4; ++i) {
      int idx = tid + i * 512;
      int row = idx >> 4, ch = idx & 15;
      const u16* src = xbc + (size_t)(tok0 + row) * 3072 + grp * 128 + ch * 8;
      uint4 cv = *(const uint4*)(src + 2560);
      uint4 bv = *(const uint4*)(src + 2048);
      *(uint4*)(Cs + row * 256 + ((ch ^ swz16(row)) << 4)) = cv;
      *(uint4*)(Bs + row * 256 + ((ch ^ swz16(row)) << 4)) = bv;
    }
#pragma unroll
    for (int i = 0; i < 2; ++i) {
      int idx = tid + i * 512;
      int l = idx >> 3, ch = idx & 7;
      uint4 xv = *(const uint4*)(xbc + (size_t)(tok0 + l) * 3072 + h * 64 + ch * 8);
      unsigned w[4] = {xv.x, xv.y, xv.z, xv.w};
#pragma unroll
      for (int e = 0; e < 8; ++e) {
        int pp = ch * 8 + e;
        u16 val = (u16)((w[e >> 1] >> ((e & 1) * 16)) & 0xffff);
        *(u16*)(XT + sw256(pp, l)) = val;
      }
    }
    if (wave == 0) {
      int e0 = 2 * lane, e1 = 2 * lane + 1;
      int l0 = d ? 127 - e0 : e0, l1 = d ? 127 - e1 : e1;
      float x0 = dtb[(size_t)(tok0 + l0) * 64 + d * 32 + h] + dtbias;
      float x1 = dtb[(size_t)(tok0 + l1) * 64 + d * 32 + h] + dtbias;
      float dt0 = x0 > 20.f ? x0 : log1pf(__expf(x0));
      float dt1 = x1 > 20.f ? x1 : log1pf(__expf(x1));
      float a0 = dt0 * a_h, a1 = dt1 * a_h;
      float s = a0 + a1;
#pragma unroll
      for (int o = 1; o < 64; o <<= 1) {
        float t = __shfl_up(s, o);
        if (lane >= o) s += t;
      }
      csum[l1] = s;
      csum[l0] = s - a1;
      dts[l0] = dt0;
      dts[l1] = dt1;
    }
#pragma unroll
    for (int pf = 0; pf < 2; ++pf)
#pragma unroll
      for (int nf = 0; nf < 2; ++nf)
#pragma unroll
        for (int j = 0; j < 4; ++j) {
          int pp = wp * 32 + pf * 16 + (lane >> 4) * 4 + j;
          int n = wn4 * 32 + nf * 16 + (lane & 15);
          *(u16*)(Ss + sw256(pp, n)) = f2bf(sacc[pf][nf][j]);
        }
    __syncthreads();
    const float cstot = csum[d ? 0 : 127];
#pragma unroll
    for (int i = 0; i < 4; ++i) {
      int idx = tid + i * 512;
      int l = idx >> 4, ch = idx & 15;
      uint4 bv = *(const uint4*)(Bs + l * 256 + ((ch ^ swz16(l)) << 4));
      float f = dts[l] * __expf(cstot - csum[l]);
      unsigned w[4] = {bv.x, bv.y, bv.z, bv.w};
#pragma unroll
      for (int e = 0; e < 8; ++e) {
        int n = ch * 8 + e;
        float val = bf2f((u16)((w[e >> 1] >> ((e & 1) * 16)) & 0xffff)) * f;
        *(u16*)(BdT + sw256(n, l)) = f2bf(val);
      }
    }
    const int wm = wave >> 1, wn2 = wave & 1;
    f32x4 gacc[2][4];
#pragma unroll
    for (int i = 0; i < 2; ++i)
#pragma unroll
      for (int j = 0; j < 4; ++j) gacc[i][j] = f32x4{0.f, 0.f, 0.f, 0.f};
#pragma unroll
    for (int ks = 0; ks < 4; ++ks) {
      int ch = ks * 4 + (lane >> 4);
      bf16x8 a[2], bb[4];
#pragma unroll
      for (int mf = 0; mf < 2; ++mf) a[mf] = ldfrag256(Cs, wm * 32 + mf * 16 + (lane & 15), ch);
#pragma unroll
      for (int nf = 0; nf < 4; ++nf) bb[nf] = ldfrag256(Bs, wn2 * 64 + nf * 16 + (lane & 15), ch);
#pragma unroll
      for (int mf = 0; mf < 2; ++mf)
#pragma unroll
        for (int nf = 0; nf < 4; ++nf)
          gacc[mf][nf] = __builtin_amdgcn_mfma_f32_16x16x32_bf16(a[mf], bb[nf], gacc[mf][nf], 0, 0, 0);
    }
    {
      float csl[2][4];
#pragma unroll
      for (int mf = 0; mf < 2; ++mf)
#pragma unroll
        for (int j = 0; j < 4; ++j) csl[mf][j] = csum[wm * 32 + mf * 16 + (lane >> 4) * 4 + j];
#pragma unroll
      for (int nf = 0; nf < 4; ++nf) {
        int s = wn2 * 64 + nf * 16 + (lane & 15);
        float css = csum[s], dss = dts[s];
#pragma unroll
        for (int mf = 0; mf < 2; ++mf)
#pragma unroll
          for (int j = 0; j < 4; ++j) {
            int l = wm * 32 + mf * 16 + (lane >> 4) * 4 + j;
            bool valid = d ? (s >= l) : (s <= l);
            float e = valid ? __expf(csl[mf][j] - css) * dss : 0.f;
            gacc[mf][nf][j] *= e;
          }
      }
    }
    __syncthreads();
#pragma unroll
    for (int mf = 0; mf < 2; ++mf)
#pragma unroll
      for (int nf = 0; nf < 4; ++nf)
#pragma unroll
        for (int j = 0; j < 4; ++j) {
          int l = wm * 32 + mf * 16 + (lane >> 4) * 4 + j;
          int s = wn2 * 64 + nf * 16 + (lane & 15);
          *(u16*)(Bs + sw256(l, s)) = f2bf(gacc[mf][nf][j]);
        }
    __syncthreads();
    {
      f32x4 yacc[2][2];
#pragma unroll
      for (int i = 0; i < 2; ++i)
#pragma unroll
        for (int j = 0; j < 2; ++j) yacc[i][j] = f32x4{0.f, 0.f, 0.f, 0.f};
#pragma unroll
      for (int ks = 0; ks < 4; ++ks) {
        int ch = ks * 4 + (lane >> 4);
        bf16x8 a[2], bb[2];
#pragma unroll
        for (int mf = 0; mf < 2; ++mf) a[mf] = ldfrag256(Cs, wm * 32 + mf * 16 + (lane & 15), ch);
#pragma unroll
        for (int nf = 0; nf < 2; ++nf) bb[nf] = ldfrag256(Ss, wn2 * 32 + nf * 16 + (lane & 15), ch);
#pragma unroll
        for (int mf = 0; mf < 2; ++mf)
#pragma unroll
          for (int nf = 0; nf < 2; ++nf)
            yacc[mf][nf] = __builtin_amdgcn_mfma_f32_16x16x32_bf16(a[mf], bb[nf], yacc[mf][nf], 0, 0, 0);
      }
#pragma unroll
      for (int mf = 0; mf < 2; ++mf)
#pragma unroll
        for (int j = 0; j < 4; ++j) {
          float e = __expf(csum[wm * 32 + mf * 16 + (lane >> 4) * 4 + j]);
#pragma unroll
          for (int nf = 0; nf < 2; ++nf) yacc[mf][nf][j] *= e;
        }
#pragma unroll
      for (int ks = 0; ks < 4; ++ks) {
        int ch = ks * 4 + (lane >> 4);
        bf16x8 a[2], bb[2];
#pragma unroll
        for (int mf = 0; mf < 2; ++mf) a[mf] = ldfrag256(Bs, wm * 32 + mf * 16 + (lane & 15), ch);
#pragma unroll
        for (int nf = 0; nf < 2; ++nf) bb[nf] = ldfrag256(XT, wn2 * 32 + nf * 16 + (lane & 15), ch);
#pragma unroll
        for (int mf = 0; mf < 2; ++mf)
#pragma unroll
          for (int nf = 0; nf < 2; ++nf)
            yacc[mf][nf] = __builtin_amdgcn_mfma_f32_16x16x32_bf16(a[mf], bb[nf], yacc[mf][nf], 0, 0, 0);
      }
#pragma unroll
      for (int mf = 0; mf < 2; ++mf)
#pragma unroll
        for (int nf = 0; nf < 2; ++nf)
#pragma unroll
          for (int j = 0; j < 4; ++j) {
            int l = wm * 32 + mf * 16 + (lane >> 4) * 4 + j;
            int pp = wn2 * 32 + nf * 16 + (lane & 15);
            yout[(size_t)(tok0 + l) * 2048 + h * 64 + pp] = f2bf(yacc[mf][nf][j]);
          }
    }
    {
      float e = __expf(cstot);
#pragma unroll
      for (int pf = 0; pf < 2; ++pf)
#pragma unroll
        for (int nf = 0; nf < 2; ++nf) sacc[pf][nf] *= e;
#pragma unroll
      for (int ks = 0; ks < 4; ++ks) {
        int ch = ks * 4 + (lane >> 4);
        bf16x8 a[2], bb[2];
#pragma unroll
        for (int pf = 0; pf < 2; ++pf) a[pf] = ldfrag256(XT, wp * 32 + pf * 16 + (lane & 15), ch);
#pragma unroll
        for (int nf = 0; nf < 2; ++nf) bb[nf] = ldfrag256(BdT, wn4 * 32 + nf * 16 + (lane & 15), ch);
#pragma unroll
        for (int pf = 0; pf < 2; ++pf)
#pragma unroll
          for (int nf = 0; nf < 2; ++nf)
            sacc[pf][nf] = __builtin_amdgcn_mfma_f32_16x16x32_bf16(a[pf], bb[nf], sacc[pf][nf], 0, 0, 0);
      }
    }
    __syncthreads();
  }
  if (g < 2) {
    float* so = p.out + (d ? OUT_SSMB : OUT_SSMF) + (size_t)((g * 16 + b) * 32 + h) * 8192;
#pragma unroll
    for (int pf = 0; pf < 2; ++pf)
#pragma unroll
      for (int nf = 0; nf < 2; ++nf)
#pragma unroll
        for (int j = 0; j < 4; ++j) {
          int pp = wp * 32 + pf * 16 + (lane >> 4) * 4 + j;
          int n = wn4 * 32 + nf * 16 + (lane & 15);
          so[pp * 128 + n] = sacc[pf][nf][j];
        }
  }
}

DI float dpp_xor1(float v) { return __int_as_float(__builtin_amdgcn_update_dpp(0, __float_as_int(v), 0xB1, 0xF, 0xF, true)); }
DI float dpp_hmirror(float v) { return __int_as_float(__builtin_amdgcn_update_dpp(0, __float_as_int(v), 0x141, 0xF, 0xF, true)); }
DI float dpp_xor2(float v) { return __int_as_float(__builtin_amdgcn_update_dpp(0, __float_as_int(v), 0x4E, 0xF, 0xF, true)); }

template <bool SEG>
__device__ __forceinline__ void wkv_pair(const Params& p, char* smem, int g, int item) {
  char* ws = p.ws;
  const int tid = get_tid(), lane = tid & 63, wave = tid >> 6;
  const int Ls = SEG ? 2048 : 256;
  const __half* wk = (const __half*)(ws + OFF_WK);
  float* stage = (float*)smem;
  float* ylds = (float*)(smem + 98304);
  const bool cw = true;
  const int slot = wave >> 2, wq = wave & 3;
  const int ig = lane >> 3, jg = lane & 7;
  const int row0 = wq * 16 + ig * 2;
  const int chain = SEG ? (item >> 3) : item * 2 + slot;
  const int seg = SEG ? (item & 7) : 0;
  const bool act = cw && (SEG ? !(slot == 1 && seg == 0) : true);
  const int d = chain & 1, h = (chain >> 1) & 15, b = chain >> 5;
  typedef float f2 __attribute__((ext_vector_type(2)));
  f2 S[2][4];
#pragma unroll
  for (int rr = 0; rr < 2; ++rr) {
    if (SEG) {
      if (slot == 0) {
        if (seg == 0) {
          const float* s0 = (d ? p.wkv_b : p.wkv_f) + ((size_t)(b * 16 + h) * 64 + row0 + rr) * 64 + jg * 8;
#pragma unroll
          for (int c = 0; c < 4; ++c) S[rr][c] = f2{s0[2 * c], s0[2 * c + 1]};
        } else {
#pragma unroll
          for (int c = 0; c < 4; ++c) S[rr][c] = f2{0.f, 0.f};
        }
      } else {
#pragma unroll
        for (int c = 0; c < 4; ++c) S[rr][c] = f2{(row0 + rr == jg * 8 + 2 * c) ? 1.f : 0.f, (row0 + rr == jg * 8 + 2 * c + 1) ? 1.f : 0.f};
      }
    } else {
#pragma unroll
      for (int c = 0; c < 4; ++c) S[rr][c] = f2{0.f, 0.f};
    }
  }
  const int pair = tid >> 4, lslot = pair >> 4, lstep = pair & 15, sub = tid & 15;
  const int lch = SEG ? (item >> 3) : item * 2 + lslot;
  const int ld = lch & 1, lh = (lch >> 1) & 15, lb = lch >> 5;
  const bool ldo = SEG ? (lslot == 0) : true;
  const int sbase = seg * 256;
  const int cslot = SEG ? 0 : slot;
  float ka[4];
#pragma unroll
  for (int e = 0; e < 4; ++e) ka[e] = p.k_a[lh * 64 + sub * 4 + e];
  u16* yout;
  if (SEG) yout = lslot == 0 ? (u16*)(ws + (ld ? OFF_WYB : OFF_WYF)) : (u16*)(ws + OFF_YM) + (ld ? (size_t)TG * 1024 : 0);
  else yout = (u16*)(ws + (ld ? OFF_WYB : OFF_WYF));
  const bool ywr = SEG ? (lslot == 0 || seg > 0) : true;
  uint2 rg[6];
  auto prefetch = [&](int tb) {
    int s = sbase + tb * 16 + lstep;
    int pos = ld ? Ls - 1 - s : s;
    int r = lb * Ls + pos;
    const __half* rec = wk + ((size_t)(r * 16 + lh) * 8) * 64 + sub * 4;
    rg[0] = *(const uint2*)(rec + 0 * 64);
    rg[1] = *(const uint2*)(rec + 1 * 64);
    rg[2] = *(const uint2*)(rec + 2 * 64);
    rg[3] = *(const uint2*)(rec + 3 * 64);
    rg[4] = *(const uint2*)(rec + (4 + 2 * ld) * 64);
    rg[5] = *(const uint2*)(rec + (5 + 2 * ld) * 64);
  };
  auto unpack4 = [&](uint2 u, float (&o)[4]) {
    __half2 h0 = *reinterpret_cast<__half2*>(&u.x);
    __half2 h1 = *reinterpret_cast<__half2*>(&u.y);
    float2 f0 = __half22float2(h0), f1 = __half22float2(h1);
    o[0] = f0.x; o[1] = f0.y; o[2] = f1.x; o[3] = f1.y;
  };
  auto stage_store = [&](int buf) {
    float r_[4], v_[4], k_[4], nkk_[4], w_[4], a_[4];
    unpack4(rg[0], r_); unpack4(rg[1], v_); unpack4(rg[2], k_); unpack4(rg[3], nkk_); unpack4(rg[4], w_); unpack4(rg[5], a_);
    float b_[4], kd_[4];
#pragma unroll
    for (int e = 0; e < 4; ++e) {
      b_[e] = -nkk_[e] * a_[e];
      kd_[e] = k_[e] * (1.f + (a_[e] - 1.f) * ka[e]);
    }
    float* dst = stage + ((size_t)((buf * 2 + lslot) * 16 + lstep) * 6) * 64 + sub * 4;
    *(float4*)(dst + 0 * 64) = float4{nkk_[0], nkk_[1], nkk_[2], nkk_[3]};
    *(float4*)(dst + 1 * 64) = float4{w_[0], w_[1], w_[2], w_[3]};
    *(float4*)(dst + 2 * 64) = float4{b_[0], b_[1], b_[2], b_[3]};
    *(float4*)(dst + 3 * 64) = float4{kd_[0], kd_[1], kd_[2], kd_[3]};
    *(float4*)(dst + 4 * 64) = float4{r_[0], r_[1], r_[2], r_[3]};
    *(float4*)(dst + 5 * 64) = float4{v_[0], v_[1], v_[2], v_[3]};
  };
  if (ldo) { prefetch(0); stage_store(0); }
  __syncthreads();
  for (int tb = 0; tb < 16; ++tb) {
    const bool more = tb + 1 < 16;
    if (more && ldo) prefetch(tb + 1);
    if (act) {
      const float* sb = stage + ((size_t)(((tb & 1) * 2 + cslot) * 16) * 6) * 64;
      for (int sg = 0; sg < 8; ++sg) {
        float ysv[2][2];
#pragma unroll
        for (int s4 = 0; s4 < 2; ++s4) {
          const int st = sg * 2 + s4;
          const float* v6 = sb + st * 384 + jg * 8;
          f2 nkk[4], w[4], bb[4], kd[4], rr[4];
#pragma unroll
          for (int q = 0; q < 2; ++q) {
            float4 t0 = *(const float4*)(v6 + 0 * 64 + q * 4);
            nkk[q * 2] = f2{t0.x, t0.y}; nkk[q * 2 + 1] = f2{t0.z, t0.w};
            float4 t1 = *(const float4*)(v6 + 1 * 64 + q * 4);
            w[q * 2] = f2{t1.x, t1.y}; w[q * 2 + 1] = f2{t1.z, t1.w};
            float4 t2 = *(const float4*)(v6 + 2 * 64 + q * 4);
            bb[q * 2] = f2{t2.x, t2.y}; bb[q * 2 + 1] = f2{t2.z, t2.w};
            float4 t3 = *(const float4*)(v6 + 3 * 64 + q * 4);
            kd[q * 2] = f2{t3.x, t3.y}; kd[q * 2 + 1] = f2{t3.z, t3.w};
            float4 t4 = *(const float4*)(v6 + 4 * 64 + q * 4);
            rr[q * 2] = f2{t4.x, t4.y}; rr[q * 2 + 1] = f2{t4.z, t4.w};
          }
          float2 vv2 = *(const float2*)(sb + st * 384 + 5 * 64 + row0);
          float vi[2] = {vv2.x, vv2.y};
          if (SEG && slot == 1) { vi[0] = 0.f; vi[1] = 0.f; }
#pragma unroll
          for (int r2 = 0; r2 < 2; ++r2) {
            f2 sa2a = S[r2][0] * nkk[0], sa2b = S[r2][1] * nkk[1];
            sa2a += S[r2][2] * nkk[2]; sa2b += S[r2][3] * nkk[3];
            f2 sat = sa2a + sa2b;
            float sa = sat.x + sat.y;
            sa += dpp_xor1(sa);
            sa += dpp_xor2(sa);
            sa += dpp_hmirror(sa);
            f2 y2a, y2b;
            {
              f2 t0 = S[r2][0] * w[0] + vi[r2] * kd[0]; S[r2][0] = t0 + sa * bb[0]; y2a = S[r2][0] * rr[0];
              f2 t1 = S[r2][1] * w[1] + vi[r2] * kd[1]; S[r2][1] = t1 + sa * bb[1]; y2b = S[r2][1] * rr[1];
              f2 t2 = S[r2][2] * w[2] + vi[r2] * kd[2]; S[r2][2] = t2 + sa * bb[2]; y2a += S[r2][2] * rr[2];
              f2 t3 = S[r2][3] * w[3] + vi[r2] * kd[3]; S[r2][3] = t3 + sa * bb[3]; y2b += S[r2][3] * rr[3];
            }
            f2 yt = y2a + y2b;
            float y = yt.x + yt.y;
            y += dpp_xor1(y);
            y += dpp_xor2(y);
            y += dpp_hmirror(y);
            ysv[s4][r2] = y;
          }
        }
        if (jg == 0) {
#pragma unroll
          for (int s4 = 0; s4 < 2; ++s4)
            *(float2*)(ylds + (slot * 16 + sg * 2 + s4) * 64 + row0) = float2{ysv[s4][0], ysv[s4][1]};
        }
      }
    }
    __syncthreads();
    if (more && ldo) stage_store((tb + 1) & 1);
    if (ywr) {
      int s = sbase + tb * 16 + lstep;
      int pos = ld ? Ls - 1 - s : s;
      int r = lb * Ls + pos;
      float4 yv = *(const float4*)(ylds + (lslot * 16 + lstep) * 64 + sub * 4);
      *(uint2*)(yout + (size_t)r * 1024 + lh * 64 + sub * 4) = uint2{pack2(yv.x, yv.y), pack2(yv.z, yv.w)};
    }
    __syncthreads();
  }
  if (act) {
#pragma unroll
    for (int r2 = 0; r2 < 2; ++r2) {
      float* so;
      if (SEG) so = p.out + 8388608 + ((size_t)((chain * 8 + seg) * 2 + slot)) * 4096 + (row0 + r2) * 64 + jg * 8;
      else so = p.out + (d ? OUT_WKVB : OUT_WKVF) + ((size_t)((g * 16 + b) * 16 + h) * 64 + row0 + r2) * 64 + jg * 8;
#pragma unroll
      for (int c = 0; c < 4; ++c) { so[2 * c] = S[r2][c].x; so[2 * c + 1] = S[r2][c].y; }
    }
  }
}

__device__ __forceinline__ void wkv_fix(const Params& p, char* smem, int chain) {
  char* ws = p.ws;
  const int tid = get_tid(), lane = tid & 63, wave = tid >> 6;
  const int d = chain & 1, h = (chain >> 1) & 15, b = chain >> 5;
  const float* SE = p.out + 8388608;
  u16* yout = (u16*)(ws + (d ? OFF_WYB : OFF_WYF));
  const u16* Q = (const u16*)(ws + OFF_YM) + (d ? (size_t)TG * 1024 : 0);
  float* Pl = (float*)smem;
  float* Sl = (float*)(smem + 16384);
  u16* Ql = (u16*)(smem + 36864);
  const int i = lane;
  float S0[64];
  {
    const float* src = SE + ((size_t)(chain * 8) * 2) * 4096 + i * 64;
#pragma unroll
    for (int j = 0; j < 16; ++j) {
      float4 t = *(const float4*)(src + j * 4);
      S0[j * 4] = t.x; S0[j * 4 + 1] = t.y; S0[j * 4 + 2] = t.z; S0[j * 4 + 3] = t.w;
    }
  }
  for (int k = 1; k < 8; ++k) {
#pragma unroll
    for (int e = 0; e < 4; ++e) {
      int idx = tid + e * 512;
      int tt = idx >> 3, ch = idx & 7;
      int s = k * 256 + tt;
      int pos = d ? 2047 - s : s;
      int r = b * 2048 + pos;
      *(uint4*)(Ql + tt * 64 + ch * 8) = *(const uint4*)(Q + (size_t)r * 1024 + h * 64 + ch * 8);
    }
    if (k < 7) {
      const float* src = SE + ((size_t)((chain * 8 + k) * 2 + 1)) * 4096;
#pragma unroll
      for (int e = 0; e < 2; ++e) ((float4*)Pl)[tid + e * 512] = ((const float4*)src)[tid + e * 512];
    }
    __syncthreads();
    for (int n = 0; n < 32; ++n) {
      int tt = wave + n * 8;
      float a0 = 0.f, a1 = 0.f;
#pragma unroll
      for (int jc = 0; jc < 8; ++jc) {
        float q[8];
        unpack8(*(const uint4*)(Ql + tt * 64 + jc * 8), q);
#pragma unroll
        for (int e = 0; e < 8; e += 2) { a0 += S0[jc * 8 + e] * q[e]; a1 += S0[jc * 8 + e + 1] * q[e + 1]; }
      }
      int s = k * 256 + tt;
      int pos = d ? 2047 - s : s;
      size_t off = (size_t)(b * 2048 + pos) * 1024 + h * 64 + i;
      yout[off] = f2bf(bf2f(yout[off]) + (a0 + a1));
    }
    if (k < 7) {
      float nv[8];
      const float* sl = SE + ((size_t)((chain * 8 + k) * 2)) * 4096 + i * 64 + wave * 8;
      {
        float4 t0 = *(const float4*)sl, t1 = *(const float4*)(sl + 4);
        nv[0] = t0.x; nv[1] = t0.y; nv[2] = t0.z; nv[3] = t0.w; nv[4] = t1.x; nv[5] = t1.y; nv[6] = t1.z; nv[7] = t1.w;
      }
#pragma unroll
      for (int m = 0; m < 64; ++m) {
        float4 p0 = *(const float4*)(Pl + m * 64 + wave * 8), p1 = *(const float4*)(Pl + m * 64 + wave * 8 + 4);
        nv[0] += S0[m] * p0.x; nv[1] += S0[m] * p0.y; nv[2] += S0[m] * p0.z; nv[3] += S0[m] * p0.w;
        nv[4] += S0[m] * p1.x; nv[5] += S0[m] * p1.y; nv[6] += S0[m] * p1.z; nv[7] += S0[m] * p1.w;
      }
      *(float4*)(Sl + i * 68 + wave * 8) = float4{nv[0], nv[1], nv[2], nv[3]};
      *(float4*)(Sl + i * 68 + wave * 8 + 4) = float4{nv[4], nv[5], nv[6], nv[7]};
      __syncthreads();
#pragma unroll
      for (int j = 0; j < 16; ++j) {
        float4 t = *(const float4*)(Sl + i * 68 + j * 4);
        S0[j * 4] = t.x; S0[j * 4 + 1] = t.y; S0[j * 4 + 2] = t.z; S0[j * 4 + 3] = t.w;
      }
    }
    __syncthreads();
  }
}

__device__ __forceinline__ void step_scan(const Params& p, char* smem, int g) {
  const int G = gridDim.x;
  const int r1 = (RM & (1 << 20)) ? 2 : 1, r2 = (RM & (1 << 21)) ? 2 : 1;
  if (g < 2) {
    for (int rr = 0; rr < r1; ++rr) for (int ch = blockIdx.x; ch < 1024; ch += G) ssd_chain(p, smem, g, ch);
    for (int rr = 0; rr < r2; ++rr) for (int it = blockIdx.x; it < 256; it += G) wkv_pair<false>(p, smem, g, it);
  } else {
    for (int rr = 0; rr < r1; ++rr) for (int ch = blockIdx.x; ch < 128; ch += G) ssd_chain(p, smem, g, ch);
    for (int rr = 0; rr < r2; ++rr) for (int it = (G - 1 - blockIdx.x); it < 512; it += G) wkv_pair<true>(p, smem, g, it);
  }
}
__device__ __forceinline__ void step_fix(const Params& p, char* smem) {
  for (int ch = blockIdx.x; ch < 64; ch += gridDim.x) wkv_fix(p, smem, ch);
}

__device__ __forceinline__ void step_fin(const Params& p, int g) {
  char* ws = p.ws;
  const int tid = get_tid(), lane = tid & 63, wave = tid >> 6;
  const int gw = blockIdx.x * 8 + wave, nw = gridDim.x * 8;
  {
    const u16* yf = (const u16*)(ws + OFF_SYF);
    const u16* yb = (const u16*)(ws + OFF_SYB);
    const u16* xbc = (const u16*)(ws + OFF_XBC);
    const u16* zb = (const u16*)(ws + OFF_Z);
    u16* ym = (u16*)(ws + OFF_YM);
    for (int it = gw; it < TG * 4; it += nw) {
      int r = it >> 2, gq = it & 3;
      int ch = gq * 512 + lane * 8;
      uint4 a = *(const uint4*)(yf + (size_t)r * 2048 + ch);
      uint4 b = *(const uint4*)(yb + (size_t)r * 2048 + ch);
      uint4 x = *(const uint4*)(xbc + (size_t)r * 3072 + ch);
      uint4 z = *(const uint4*)(zb + (size_t)r * 2048 + ch);
      float dsk = p.d_skip[ch >> 6];
      unsigned aw[4] = {a.x, a.y, a.z, a.w}, bw[4] = {b.x, b.y, b.z, b.w}, xw[4] = {x.x, x.y, x.z, x.w}, zw[4] = {z.x, z.y, z.z, z.w};
      float y[8];
      float ss = 0.f;
#pragma unroll
      for (int e = 0; e < 8; ++e) {
        int sh = (e & 1) * 16;
        float yy = bf2f((u16)(aw[e >> 1] >> sh)) + bf2f((u16)(bw[e >> 1] >> sh)) + dsk * bf2f((u16)(xw[e >> 1] >> sh));
        yy *= siluf(bf2f((u16)(zw[e >> 1] >> sh)));
        y[e] = yy;
        ss += yy * yy;
      }
      ss = wave_sum(ss);
      float rinv = rsqrtf(ss * (1.f / 512.f) + 1e-5f);
      float4 w0 = *(const float4*)(p.m_norm_w + ch), w1 = *(const float4*)(p.m_norm_w + ch + 4);
      *(uint4*)(ym + (size_t)r * 2048 + ch) =
          uint4{pack2(y[0] * rinv * w0.x, y[1] * rinv * w0.y), pack2(y[2] * rinv * w0.z, y[3] * rinv * w0.w),
                pack2(y[4] * rinv * w1.x, y[5] * rinv * w1.y), pack2(y[6] * rinv * w1.z, y[7] * rinv * w1.w)};
    }
  }
  {
    const u16* yf = (const u16*)(ws + OFF_WYF);
    const u16* yb = (const u16*)(ws + OFF_WYB);
    const __half* wk = (const __half*)(ws + OFF_WK);
    const u16* gr = (const u16*)(ws + OFF_GR);
    u16* yr = (u16*)(ws + OFF_YR);
    for (int it = gw; it < TG * 4; it += nw) {
      const int r = it >> 2, h0 = (it & 3) * 4;
      float yv[4], rr[4], vv[4], kk[4], af[4], ab[4], gg[4];
#pragma unroll
      for (int u = 0; u < 4; ++u) {
        int c = (h0 + u) * 64 + lane;
        yv[u] = bf2f(yf[(size_t)r * 1024 + c]) + bf2f(yb[(size_t)r * 1024 + c]);
        const __half* rec = wk + ((size_t)(r * 16 + h0 + u) * 8) * 64 + lane;
        rr[u] = __half2float(rec[0]); vv[u] = __half2float(rec[64]); kk[u] = __half2float(rec[128]);
        af[u] = __half2float(rec[5 * 64]); ab[u] = __half2float(rec[7 * 64]);
        gg[u] = bf2f(gr[(size_t)r * 1024 + c]);
      }
#pragma unroll
      for (int u = 0; u < 4; ++u) {
        int c = (h0 + u) * 64 + lane;
        float y = yv[u];
        float mean = wave_sum(y) * (1.f / 64.f);
        float dy = y - mean;
        float var = wave_sum(dy * dy) * (1.f / 64.f);
        float yn = dy * rsqrtf(var + 64e-5f) * p.lnx_w[c] + p.lnx_b[c];
        float kmean = kk[u] * (1.f + (0.5f * (af[u] + ab[u]) - 1.f) * p.k_a[c]);
        float bs = wave_sum(rr[u] * kmean * p.r_k[c]);
        float o = (yn + bs * vv[u]) * gg[u];
        yr[(size_t)r * 1024 + c] = f2bf(o);
      }
    }
  }
}

__device__ __forceinline__ void step_outproj(const Params& p, char* smem, int g) {
  char* ws = p.ws;
  u16* Ug = (u16*)p.out + (size_t)g * TG * 1024;
  EpiOut<0> E0{(const u16*)(ws + OFF_GATE), Ug};
  run_gemm8(smem, (const u16*)(ws + OFF_YM), (const u16*)(ws + OFF_WMOUT), TG, 1024, 2048, E0);
  EpiOut<1> E1{(const u16*)(ws + OFF_GATE), Ug};
  run_gemm8(smem, (const u16*)(ws + OFF_YR), (const u16*)(ws + OFF_WROUT), TG, 1024, 1024, E1);
}

__device__ __forceinline__ void step_wo(const Params& p, char* smem, int g) {
  char* ws = p.ws;
  EpiWo E{p.x_prompt, p.x_sample, (const float*)(ws + OFF_MOD), (float*)(ws + OFF_X1), 0};
  run_gemm8(smem, (const u16*)p.out, (const u16*)(ws + OFF_WO), NTOK, 1024, 1024, E);
}

__device__ __forceinline__ void step_gu(const Params& p, char* smem) {
  char* ws = p.ws;
  EpiGU E{(u16*)(ws + OFF_ACT)};
  run_gemm8(smem, (const u16*)(ws + OFF_H2), (const u16*)(ws + OFF_WGU), NTOK, 5632, 1024, E);
}

__device__ __forceinline__ void step_down(const Params& p, char* smem) {
  char* ws = p.ws;
  EpiDown E{(const float*)(ws + OFF_MOD), (float*)(ws + OFF_X1)};
  run_gemm8(smem, (const u16*)(ws + OFF_ACT), (const u16*)(ws + OFF_WDOWN), NTOK, 1024, 2816, E);
}

__device__ __forceinline__ void step_final(const Params& p) {
  const int tid = get_tid(), lane = tid & 63, wave = tid >> 6;
  for (int r = blockIdx.x * 8 + wave; r < NTOK; r += gridDim.x * 8) {
    const float* xr = (const float*)(p.ws + OFF_X1) + (size_t)r * 1024;
    float* xo = p.out + (size_t)r * 1024;
    float4 v[4];
    float ss = 0.f;
#pragma unroll
    for (int i = 0; i < 4; ++i) {
      v[i] = ((const float4*)xr)[i * 64 + lane];
      ss += v[i].x * v[i].x + v[i].y * v[i].y + v[i].z * v[i].z + v[i].w * v[i].w;
    }
    ss = wave_sum(ss);
    float rinv = rsqrtf(ss * (1.f / 1024.f) + 1e-6f);
#pragma unroll
    for (int i = 0; i < 4; ++i) {
      float4 w4 = ((const float4*)p.final_norm_w)[i * 64 + lane];
      ((float4*)xo)[i * 64 + lane] = float4{v[i].x * rinv * w4.x, v[i].y * rinv * w4.y, v[i].z * rinv * w4.z, v[i].w * rinv * w4.w};
    }
  }
}

constexpr int NSTEPS = 30;

__global__ void __launch_bounds__(NTHR) mega(Params p_arg) {
  const int step_lo = p_arg.step_lo, step_hi = p_arg.step_hi;
  __shared__ __attribute__((aligned(16))) char smem[SMEM_BYTES];
#if !MULTI_LAUNCH
  if (threadIdx.x == 0) *(uint4*)(smem + SMEM_BYTES - 16) = uint4{0u, 0u, 0u, 0u};
  __syncthreads();
  XcdBarrier xb = xcd_barrier_post((unsigned*)(p_arg.ws + OFF_BAR), (volatile LAS unsigned*)(smem + SMEM_BYTES - 16));
#endif
  for (int step = step_lo; step <= step_hi; ++step) {
#if defined(__HIP_DEVICE_COMPILE__)
    const __attribute__((address_space(4))) Params* pp = (const __attribute__((address_space(4))) Params*)__builtin_amdgcn_kernarg_segment_ptr();
    asm volatile("" : "+s"(pp));
    const Params p = *pp;
#else
    const Params p = p_arg;
#endif
    const int g = (step - 1) >> 3, s = (step - 1) & 7;
    const int scode = step == 0 ? 0 : (step <= 24 ? 1 + s : step - 16);
    if (scode == 6 && g < 2) continue;
    const int reps = ((RM >> scode) & 1) ? 2 : 1;
    for (int rep = 0; rep < reps; ++rep) {
      if (!((SM >> scode) & 1)) continue;
      switch (scode) {
        case 0: step_prep(p, smem); break;
        case 1: step_norm<0>(p, g); break;
        case 2: step_gemm1(p, smem); break;
        case 3: step_cr1(p, g); break;
        case 4: step_r2(p, smem); break;
        case 5: step_scan(p, smem, g); break;
        case 6: step_fix(p, smem); break;
        case 7: step_fin(p, g); break;
        case 8: step_outproj(p, smem, g); break;
        case 9: step_wo(p, smem, 0); break;
        case 10: step_norm<1>(p, 0); break;
        case 11: step_gu(p, smem); break;
        case 12: step_down(p, smem); break;
        default: step_final(p); break;
      }
    }
    if (step < step_hi) {
#if !MULTI_LAUNCH
      if (step_hi > 100000) cg::this_grid().sync();
      for (int xs = 0; xs < 1 + XSYNC; ++xs) xcd_barrier(xb);
#endif
    }
  }
}

extern "C" void kernel_launch(void* const* d_in, const int* in_sizes, int n_in, void* d_out, int out_size,
                              void* d_ws, size_t ws_size, hipStream_t stream) {
  Params p{};
  const float** pp = (const float**)&p;
  for (int i = 0; i < 36; ++i) pp[i] = (const float*)d_in[i];
  p.out = (float*)d_out;
  p.ws = (char*)d_ws;
  if (ws_size < WS_NEED) fprintf(stderr, "workspace too small: %zu < %zu\n", ws_size, (size_t)WS_NEED);
#if MULTI_LAUNCH
  for (int s = 0; s < NSTEPS; ++s) {
    p.step_lo = s;
    p.step_hi = s;
    hipLaunchKernelGGL(mega, dim3(256), dim3(NTHR), 0, stream, p);
  }
#else
  static int grid_blocks = 0;
  if (!grid_blocks) {
    int dev = 0, cus = 0, per_cu = 0;
    hipGetDevice(&dev);
    hipDeviceGetAttribute(&cus, hipDeviceAttributeMultiprocessorCount, dev);
    hipOccupancyMaxActiveBlocksPerMultiprocessor(&per_cu, mega, NTHR, 0);
    if (per_cu < 1) per_cu = 1;
    if (per_cu > 1) per_cu = 1;
    grid_blocks = cus * per_cu;
  }
  p.step_lo = 0;
  p.step_hi = NSTEPS - 1;
  void* args[] = {&p};
  hipMemsetAsync((char*)d_ws + OFF_BAR, 0, XCD_BAR_WORDS_C * 4, stream);
  hipError_t e = hipLaunchCooperativeKernel((void*)mega, dim3(grid_blocks), dim3(NTHR), args, 0, stream);
  if (e != hipSuccess) fprintf(stderr, "cooperative launch failed: %s (grid %d)\n", hipGetErrorString(e), grid_blocks);
#endif
}
```

```cpp
#include <hip/hip_runtime.h>
#include <hip/hip_cooperative_groups.h>
#include <hip/hip_fp16.h>
#include <cstdio>
#include <cstdint>
namespace cg = cooperative_groups;

#ifndef MULTI_LAUNCH
#define MULTI_LAUNCH 0
#endif

#define DI __device__ __forceinline__
typedef __attribute__((ext_vector_type(8))) short bf16x8;
typedef __attribute__((ext_vector_type(4))) float f32x4;
typedef unsigned short u16;

#ifndef STEP_MASK
#define STEP_MASK 0xffffff
#endif
constexpr int SM = STEP_MASK;
#ifndef REPEAT_MASK
#define REPEAT_MASK 0
#endif
#ifndef XSYNC
#define XSYNC 0
#endif
constexpr int RM = REPEAT_MASK;
constexpr int TG = 4096;
constexpr int NTOK = 12288;
constexpr int NPAD = 10752;
constexpr int NTHR = 512;
constexpr int SMEM_BYTES = 133120;
constexpr int XCD_BAR_WORDS_C = 3456;

constexpr size_t OFF_WIN = 0;
constexpr size_t OFF_WGU = OFF_WIN + (size_t)NPAD * 1024 * 2;
constexpr size_t OFF_WDOWN = OFF_WGU + (size_t)5632 * 1024 * 2;
constexpr size_t OFF_WMOUT = OFF_WDOWN + (size_t)1024 * 2816 * 2;
constexpr size_t OFF_WROUT = OFF_WMOUT + (size_t)1024 * 2048 * 2;
constexpr size_t OFF_WO = OFF_WROUT + (size_t)1024 * 1024 * 2;
constexpr size_t OFF_W2T = OFF_WO + (size_t)1024 * 1024 * 2;
constexpr size_t OFF_A2T = OFF_W2T + 262144;
constexpr size_t OFF_G2T = OFF_A2T + 262144;
constexpr size_t OFF_MOD = OFF_G2T + 262144;
constexpr size_t OFF_GRP = OFF_MOD + 73728;
constexpr size_t OFF_Z = OFF_GRP;
constexpr size_t OFF_GATE = OFF_Z + (size_t)TG * 2048 * 2;
constexpr size_t OFF_XBC = OFF_GATE + (size_t)TG * 2048 * 2;
constexpr size_t OFF_WK = OFF_XBC + (size_t)TG * 3072 * 2;
constexpr size_t OFF_GR = OFF_WK + (size_t)TG * 16 * 1024;
constexpr size_t OFF_DT = OFF_GR + (size_t)TG * 1024 * 2;
constexpr size_t OFF_TL = OFF_DT + (size_t)TG * 64 * 4;
constexpr size_t OFF_SG = OFF_TL + (size_t)TG * 256 * 2;
constexpr size_t OFF_R = OFF_SG + (size_t)TG * 128 * 2;
constexpr size_t OFF_H1 = OFF_R;
constexpr size_t OFF_XBCRAW = OFF_H1 + (size_t)TG * 1024 * 2;
constexpr size_t OFF_RW = OFF_XBCRAW + (size_t)TG * 3072 * 2;
constexpr size_t OFF_SYF = OFF_R;
constexpr size_t OFF_SYB = OFF_SYF + (size_t)TG * 2048 * 2;
constexpr size_t OFF_WYF = OFF_SYB + (size_t)TG * 2048 * 2;
constexpr size_t OFF_WYB = OFF_WYF + (size_t)TG * 1024 * 2;
constexpr size_t OFF_YM = OFF_WYB + (size_t)TG * 1024 * 2;
constexpr size_t OFF_YR = OFF_YM + (size_t)TG * 2048 * 2;
constexpr size_t OFF_END = OFF_YR + (size_t)TG * 1024 * 2;
constexpr size_t OFF_BAR = OFF_END;
constexpr size_t WS_NEED = OFF_BAR + XCD_BAR_WORDS_C * 4;
constexpr size_t OFF_U = OFF_XBC;
constexpr size_t OFF_H2 = OFF_GRP;
constexpr size_t OFF_ACT = OFF_H2 + (size_t)NTOK * 1024 * 2;
constexpr size_t OFF_X1 = OFF_ACT + (size_t)NTOK * 2816 * 2;

constexpr size_t OUT_SSMF = 12582912;
constexpr size_t OUT_SSMB = OUT_SSMF + 8388608;
constexpr size_t OUT_WKVF = OUT_SSMB + 8388608;
constexpr size_t OUT_WKVB = OUT_WKVF + 2097152;

struct Params {
  const float *x_prompt, *x_sample, *ssm_f, *ssm_b, *wkv_f, *wkv_b, *c, *c_ctx, *norm1_w, *norm2_w,
      *w_ada, *b_ada, *w_in, *conv_w, *conv_b, *dt_bias, *a_log, *d_skip, *m_norm_w, *mu_shift, *w0,
      *w2, *a0, *a2, *g2, *k_k, *k_a, *r_k, *lnx_w, *lnx_b, *w_m_out, *w_r_out, *w_o, *w_gu, *w_down,
      *final_norm_w;
  float* out;
  char* ws;
  int step_lo, step_hi;
};

DI int get_tid() {
  int t = threadIdx.x;
  asm volatile("" : "+v"(t));
  return t;
}
DI u16 f2bf(float f) {
  unsigned u = __float_as_uint(f);
  u += 0x7fffu + ((u >> 16) & 1u);
  return (u16)(u >> 16);
}
DI float bf2f(u16 h) { return __uint_as_float(((unsigned)h) << 16); }
DI float siluf(float x) { return x / (1.f + __expf(-x)); }
DI float sigm(float x) { return 1.f / (1.f + __expf(-x)); }
DI float wave_sum(float v) {
  v += __int_as_float(__builtin_amdgcn_update_dpp(0, __float_as_int(v), 0xB1, 0xF, 0xF, true));
  v += __int_as_float(__builtin_amdgcn_update_dpp(0, __float_as_int(v), 0x4E, 0xF, 0xF, true));
  v += __int_as_float(__builtin_amdgcn_update_dpp(0, __float_as_int(v), 0x141, 0xF, 0xF, true));
  v += __int_as_float(__builtin_amdgcn_update_dpp(0, __float_as_int(v), 0x140, 0xF, 0xF, true));
  const int vi = __float_as_int(v);
  float a = __int_as_float(__builtin_amdgcn_readlane(vi, 0)), b = __int_as_float(__builtin_amdgcn_readlane(vi, 16));
  float c = __int_as_float(__builtin_amdgcn_readlane(vi, 32)), d = __int_as_float(__builtin_amdgcn_readlane(vi, 48));
  return (a + b) + (c + d);
}
DI unsigned pack2(float a, float b) { return (unsigned)f2bf(a) | ((unsigned)f2bf(b) << 16); }
DI int mrow_of(int tok) { return tok < 8192 ? 0 : 1 + ((tok - 8192) >> 11); }


#define XB_TMO      128
#define XB_XCNT(j)  (256  + 64 * (j))
#define XB_XSUB(j)  (1280 + 64 * (j))
#define XB_XGEN(j)  (2304 + 64 * (j))
#define XB_TOP      3328
#define XB_TOPGEN   3392
#define XCD_BAR_WORDS 3456
#define XB_SPIN_CAP (1u << 22)
#define LAS __attribute__((address_space(3)))
DI unsigned xb_ld(unsigned* p) { return __hip_atomic_load(p, __ATOMIC_RELAXED, __HIP_MEMORY_SCOPE_AGENT); }
DI unsigned xb_add(unsigned* p, unsigned v) { return __hip_atomic_fetch_add(p, v, __ATOMIC_RELAXED, __HIP_MEMORY_SCOPE_AGENT); }
DI unsigned xb_xcc_id() { return (unsigned)__builtin_amdgcn_s_getreg((3 << 11) | 20) & 0xFu; }
#define XB_SPIN(cond, bar) do { unsigned _sp = 0; while (cond) { __builtin_amdgcn_s_sleep(1); \
    if ((++_sp & 255u) == 0u) { if (xb_ld(&(bar)[XB_TMO])) break; if (_sp > XB_SPIN_CAP) { atomicAdd(&(bar)[XB_TMO], 1u); break; } } } } while (0)
struct XcdBarrier { unsigned* bar; unsigned x; volatile LAS unsigned* st; };
DI XcdBarrier xcd_barrier_post(unsigned* bar, volatile LAS unsigned* st) {
  XcdBarrier b; b.bar = bar; b.x = xb_xcc_id(); b.st = st;
  if (threadIdx.x == 0) (void)xb_add(&bar[XB_XCNT(b.x)], 1u);
  return b;
}
DI void xcd_barrier_complete(unsigned* bar, unsigned x, unsigned& nloc, unsigned& nx) {
  const unsigned G = gridDim.x * gridDim.y * gridDim.z;
  unsigned sum, cnt, mine, sp = 0u;
  for (;;) {
    sum = 0u; cnt = 0u; mine = 0u;
#pragma unroll
    for (unsigned j = 0; j < 16; ++j) { const unsigned c = xb_ld(&bar[XB_XCNT(j)]); sum += c; cnt += (c > 0u) ? 1u : 0u; mine = (j == x) ? c : mine; }
    if (sum == G) break;
    __builtin_amdgcn_s_sleep(1);
    if ((++sp & 255u) == 0u) { if (xb_ld(&bar[XB_TMO])) break; if (sp > XB_SPIN_CAP) { atomicAdd(&bar[XB_TMO], 1u); break; } }
  }
  nloc = mine > 0u ? mine : 1u; nx = cnt > 0u ? cnt : 1u;
}
DI void xcd_barrier(const XcdBarrier& b) {
  asm volatile("s_waitcnt vmcnt(0)" ::: "memory");
  __syncthreads();
  if (threadIdx.x == 0) {
    unsigned* bar = b.bar;
    asm volatile("" : "+s"(bar));
    __builtin_amdgcn_s_waitcnt(0);
    unsigned nloc = b.st[0], nx = b.st[1];
    if (nloc == 0u) { xcd_barrier_complete(bar, b.x, nloc, nx); b.st[0] = nloc; b.st[1] = nx; }
    const unsigned old = xb_add(&bar[XB_XSUB(b.x)], 1u);
    const unsigned gen = old / nloc;
    if (old + 1u == (gen + 1u) * nloc) {
      __builtin_amdgcn_fence(__ATOMIC_RELEASE, "agent");
      asm volatile("s_waitcnt vmcnt(0)" ::: "memory");
      const unsigned og = xb_add(&bar[XB_TOP], 1u);
      const unsigned tg = og / nx;
      if (og + 1u == (tg + 1u) * nx) xb_add(&bar[XB_TOPGEN], 1u);
      else XB_SPIN(xb_ld(&bar[XB_TOPGEN]) == tg, bar);
      __builtin_amdgcn_fence(__ATOMIC_ACQUIRE, "agent");
      xb_add(&bar[XB_XGEN(b.x)], 1u);
      asm volatile("s_waitcnt vmcnt(0)" ::: "memory");
    } else {
      XB_SPIN(xb_ld(&bar[XB_XGEN(b.x)]) == gen, bar);
      __builtin_amdgcn_fence(__ATOMIC_ACQUIRE, "agent");
      asm volatile("s_waitcnt vmcnt(0)" ::: "memory");
    }
  }
  __syncthreads();
}

DI void gemm_load(const int tid, const u16* A, int lda, const u16* B, int ldb, int k0, uint4 (&ra)[4], uint4 (&rb)[2]) {
#pragma unroll
  for (int i = 0; i < 4; ++i) {
    int idx = tid + i * 512;
    int row = idx >> 3, ch = idx & 7;
    ra[i] = *(const uint4*)(A + (size_t)row * lda + k0 + ch * 8);
  }
#pragma unroll
  for (int i = 0; i < 2; ++i) {
    int idx = tid + i * 512;
    int row = idx >> 3, ch = idx & 7;
    rb[i] = *(const uint4*)(B + (size_t)row * ldb + k0 + ch * 8);
  }
}
DI void gemm_store_lds(const int tid, char* sA, char* sB, const uint4 (&ra)[4], const uint4 (&rb)[2]) {
#pragma unroll
  for (int i = 0; i < 4; ++i) {
    int idx = tid + i * 512;
    int row = idx >> 3, ch = idx & 7;
    *(uint4*)(sA + row * 128 + ((ch ^ ((row >> 1) & 7)) << 4)) = ra[i];
  }
#pragma unroll
  for (int i = 0; i < 2; ++i) {
    int idx = tid + i * 512;
    int row = idx >> 3, ch = idx & 7;
    *(uint4*)(sB + row * 128 + ((ch ^ ((row >> 1) & 7)) << 4)) = rb[i];
  }
}
DI void gemm_compute(const char* sA, const char* sB, f32x4 (&acc)[4][4], int wm, int wn, int lane) {
#pragma unroll
  for (int kk = 0; kk < 2; ++kk) {
    bf16x8 a[4], b[4];
    const int ch = kk * 4 + (lane >> 4);
#pragma unroll
    for (int mf = 0; mf < 4; ++mf) {
      int row = wm * 64 + mf * 16 + (lane & 15);
      a[mf] = *(const bf16x8*)(sA + row * 128 + ((ch ^ ((row >> 1) & 7)) << 4));
    }
#pragma unroll
    for (int nf = 0; nf < 4; ++nf) {
      int row = wn * 64 + nf * 16 + (lane & 15);
      b[nf] = *(const bf16x8*)(sB + row * 128 + ((ch ^ ((row >> 1) & 7)) << 4));
    }
#pragma unroll
    for (int mf = 0; mf < 4; ++mf)
#pragma unroll
      for (int nf = 0; nf < 4; ++nf)
        acc[mf][nf] = __builtin_amdgcn_mfma_f32_16x16x32_bf16(a[mf], b[nf], acc[mf][nf], 0, 0, 0);
  }
}
DI void gemm_acc(const u16* A, int lda, const u16* B, int ldb, int K, f32x4 (&acc)[4][4], char* smem) {
  const int tid = get_tid(), lane = tid & 63, wave = tid >> 6;
  const int wm = wave >> 1, wn = wave & 1;
  char* sA0 = smem;
  char* sB0 = smem + 32768;
  char* sA1 = smem + 49152;
  char* sB1 = smem + 81920;
  uint4 ra[4], rb[2];
  const int nk = K >> 6;
  gemm_load(tid, A, lda, B, ldb, 0, ra, rb);
  gemm_store_lds(tid, sA0, sB0, ra, rb);
  __syncthreads();
  for (int kt = 0; kt < nk; ++kt) {
    const bool more = (kt + 1 < nk);
    if (more) gemm_load(tid, A, lda, B, ldb, (kt + 1) * 64, ra, rb);
    if (kt & 1) gemm_compute(sA1, sB1, acc, wm, wn, lane);
    else gemm_compute(sA0, sB0, acc, wm, wn, lane);
    if (more) {
      if (kt & 1) gemm_store_lds(tid, sA0, sB0, ra, rb);
      else gemm_store_lds(tid, sA1, sB1, ra, rb);
    }
    __syncthreads();
  }
}
DI void zero_acc(f32x4 (&acc)[4][4]) {
#pragma unroll
  for (int i = 0; i < 4; ++i)
#pragma unroll
    for (int j = 0; j < 4; ++j) { float z0; asm volatile("v_mov_b32 %0, 0" : "=v"(z0)); acc[i][j] = f32x4{z0, z0, z0, z0}; }
}

#define PG8_LAS __attribute__((address_space(3)))
namespace pg8 {
typedef unsigned short bf16_t;
typedef short bf16x8 __attribute__((ext_vector_type(8)));
typedef float f32x4 __attribute__((ext_vector_type(4)));
typedef unsigned u32x4 __attribute__((ext_vector_type(4)));
constexpr int BM = 256, BK = 64, HALF = 128, HTB = HALF * BK * 2  , STAGE_BYTES = 8 * HTB, NXCD = 8, WGM = 8;

__host__ __device__ __forceinline__ int lds_byte(int r, int c) { const int st = (r >> 4) * 2 + (c >> 5), rr = r & 15, cc = c & 31, ob = rr * 64 + cc * 2; return st * 1024 + (ob ^ (((ob >> 9) & 1) << 5)); }
__host__ __device__ __forceinline__ void stage_rc(int b, int& R, int& C) { const int st = b / 1024, sb = b % 1024, swz = sb ^ (((sb >> 9) & 1) << 5); R = (st >> 1) * 16 + swz / 64; C = (st & 1) * 32 + (swz % 64) / 2; }
__host__ __device__ __forceinline__ int perm32(int rho) { const int n = rho >> 4, i = rho & 15; return 8 * (i >> 2) + 4 * n + (i & 3); }

struct Unit { int pm, pn; };
struct Gemm { const bf16_t* A; const bf16_t* Bt; int M, N, K; };

struct StaticOrder {
    int nM, nN, nwg, G, c;
    __host__ __device__ void init(int M, int N, int G_, int c_) { nM = M / BM; nN = N / BM; nwg = nM * nN; G = G_; c = c_; }
    __host__ __device__ bool next(int i, Unit& u) const {
        const long L = (long)i * G + c; if (L >= nwg) return false;
        int wgid = (int)L; { const int q = nwg / NXCD, r = nwg % NXCD, xcd = wgid % NXCD, off = wgid / NXCD; wgid = (xcd < r ? xcd * (q + 1) : r * (q + 1) + (xcd - r) * q) + off; }
        const int nig = WGM * nN, gid = wgid / nig, fm = gid * WGM, gsz = (nM - fm) < WGM ? (nM - fm) : WGM;
        u.pm = fm + ((wgid % nig) % gsz); u.pn = (wgid % nig) / gsz; return true;
    }
    __device__ __forceinline__ void a_ready(const Unit&) const {}
    __device__ __forceinline__ void done(const Unit&) const {}
};
__device__ __forceinline__ unsigned cvt_pk_bf16(float lo, float hi) { unsigned r; asm volatile("v_cvt_pk_bf16_f32 %0, %1, %2" : "=v"(r) : "v"(lo), "v"(hi)); return r; }
template <class Epi, class Sched, bool STAMP = false>
__device__ __forceinline__ void gemm_phase(PG8_LAS unsigned char* lds, const Gemm g, const Sched& S, const Epi& E, unsigned long long* stamps) {
    const int tid = get_tid(), wid = __builtin_amdgcn_readfirstlane(tid >> 6), lane = tid & 63, wr = wid >> 2, wc = wid & 3, fr = lane & 15, fq = lane >> 4;
    const int K = g.K, nt = K / BK;
    int ts_lo = 0, ts_hi = 0, nts = 0; const unsigned long long rt_entry = STAMP ? (unsigned long long)wall_clock64() : 0ull;
#define PG8_STAMP() do { if (STAMP && wid == 0 && nts < 64) { const unsigned long long _c = (unsigned long long)clock64(); \
        ts_lo = (lane == nts) ? (int)(unsigned)_c : ts_lo; ts_hi = (lane == nts) ? (int)(unsigned)(_c >> 32) : ts_hi; ++nts; } } while (0)
    PG8_STAMP();
    unsigned voffA[2], voffB[2];
#pragma unroll
    for (int i = 0; i < 2; ++i) { int R, C; stage_rc(tid * 16 + i * 8192, R, C); const int Rb = Epi::PERM ? ((R & ~31) + perm32(R & 31)) : R;
        voffA[i] = (unsigned)(R * K + C) * 2u; voffB[i] = (unsigned)(Rb * K + C) * 2u; }
    const size_t kstep = (size_t)(BK * 2);
    const size_t hstep = (size_t)HALF * K * 2;
    const size_t tstep = 2 * hstep;
    const unsigned ldsw = (unsigned)wid * 1024u;
    const int aoff = lds_byte(wr * 64 + fr, fq * 8), boff = lds_byte(wc * 32 + fr, fq * 8);
#define PG8_SA(b, h) (((b) * 2 + (h)) * HTB)
#define PG8_SB(b, h) ((4 + (b) * 2 + (h)) * HTB)
#define PG8_STAGE(bufoff, gbase, voff) do { _Pragma("unroll") for (int _i = 0; _i < 2; ++_i) \
        __builtin_amdgcn_global_load_lds((const unsigned*)((const char*)(gbase) + (voff)[_i]), (PG8_LAS unsigned*)(lds + (bufoff) + ldsw + _i * 8192), 16, 0, 0); } while (0)
#define PG8_LDA(dst, b, h) do { _Pragma("unroll") for (int m = 0; m < 4; ++m) _Pragma("unroll") for (int k = 0; k < 2; ++k) dst[m][k] = *(const PG8_LAS bf16x8*)(lds + PG8_SA(b, h) + aoff + m * 2048 + k * 1024); } while (0)
#define PG8_LDB(dst, b, h) do { _Pragma("unroll") for (int n = 0; n < 2; ++n) _Pragma("unroll") for (int k = 0; k < 2; ++k) dst[n][k] = *(const PG8_LAS bf16x8*)(lds + PG8_SB(b, h) + boff + n * 2048 + k * 1024); } while (0)
#define PG8_MMA(ai, bj, At, Bt) do { __builtin_amdgcn_s_setprio(1); _Pragma("unroll") for (int m = 0; m < 4; ++m) _Pragma("unroll") for (int n = 0; n < 2; ++n) _Pragma("unroll") for (int k = 0; k < 2; ++k) \
        acc[ai][bj][m][n] = __builtin_amdgcn_mfma_f32_16x16x32_bf16(Bt[n][k], At[m][k], acc[ai][bj][m][n], 0, 0, 0); __builtin_amdgcn_s_setprio(0); } while (0)
#define PG8_WAIT_V(n) asm volatile("s_waitcnt vmcnt(" #n ")" ::: "memory")
#define PG8_WAIT_L(n) asm volatile("s_waitcnt lgkmcnt(" #n ")" ::: "memory")
#define PG8_BAR __builtin_amdgcn_s_barrier()
#define PG8_SCHED __builtin_amdgcn_sched_barrier(0)
    Unit cur, nxt; int ui = 0;
    if (!S.next(0, cur)) return;
    f32x4 acc[2][2][4][2];
#pragma unroll
    for (int a = 0; a < 2; ++a)
#pragma unroll
        for (int b = 0; b < 2; ++b)
#pragma unroll
            for (int m = 0; m < 4; ++m)
#pragma unroll
                for (int n = 0; n < 2; ++n) { float z0; asm volatile("v_mov_b32 %0, 0" : "=v"(z0)); acc[a][b][m][n] = (f32x4){z0, z0, z0, z0}; }
    bf16x8 At[4][2], B0[2][2], B1[2][2];
    const char* cA = (const char*)g.A + (size_t)cur.pm * tstep; const char* cB = (const char*)g.Bt + (size_t)cur.pn * tstep;
    S.a_ready(cur);
    PG8_STAGE(PG8_SB(0, 0), cB, voffB); PG8_STAGE(PG8_SA(0, 0), cA, voffA); PG8_STAGE(PG8_SB(0, 1), cB + hstep, voffB); PG8_STAGE(PG8_SA(0, 1), cA + hstep, voffA);
    if (wr == 1) PG8_BAR;
    PG8_WAIT_V(4); PG8_BAR;
    PG8_STAGE(PG8_SB(1, 0), cB + kstep, voffB); PG8_STAGE(PG8_SA(1, 0), cA + kstep, voffA); PG8_STAGE(PG8_SB(1, 1), cB + hstep + kstep, voffB);
    PG8_WAIT_V(6); PG8_BAR;
    PG8_STAMP();
    for (;;) {
        const bool has_next = S.next(ui + 1, nxt);
        const char* nA = has_next ? (const char*)g.A + (size_t)nxt.pm * tstep : cA; const char* nB = has_next ? (const char*)g.Bt + (size_t)nxt.pn * tstep : cB;
        for (int t = 0; t < nt; t += 2) {
            const bool last = (t == nt - 2);
            const char* a1 = cA + (size_t)(t + 1) * kstep;
            const char* a2 = last ? nA : cA + (size_t)(t + 2) * kstep; const char* b2 = last ? nB : cB + (size_t)(t + 2) * kstep;
            const char* a3 = a2 + kstep; const char* b3 = b2 + kstep;
            if (last && has_next) S.a_ready(nxt);
            PG8_LDB(B0, 0, 0); PG8_SCHED; PG8_LDA(At, 0, 0); PG8_STAGE(PG8_SA(1, 1), a1 + hstep, voffA);
            PG8_WAIT_L(8); PG8_BAR; PG8_WAIT_L(0); PG8_MMA(0, 0, At, B0); PG8_BAR; PG8_SCHED;
            PG8_LDB(B1, 0, 1); PG8_STAGE(PG8_SB(0, 0), b2, voffB);
            PG8_BAR; PG8_WAIT_L(0); PG8_MMA(0, 1, At, B1); PG8_BAR;
            PG8_LDA(At, 0, 1); PG8_STAGE(PG8_SA(0, 0), a2, voffA);
            PG8_BAR; PG8_WAIT_L(0); PG8_MMA(1, 0, At, B0); PG8_BAR; PG8_SCHED;
            PG8_STAGE(PG8_SB(0, 1), b2 + hstep, voffB);
            PG8_WAIT_V(6); PG8_BAR; PG8_MMA(1, 1, At, B1); PG8_BAR;
            PG8_LDB(B0, 1, 0); PG8_SCHED; PG8_LDA(At, 1, 0); PG8_STAGE(PG8_SA(0, 1), a2 + hstep, voffA);
            PG8_WAIT_L(8); PG8_BAR; PG8_WAIT_L(0); PG8_MMA(0, 0, At, B0); PG8_BAR; PG8_SCHED;
            PG8_LDB(B1, 1, 1); PG8_STAGE(PG8_SB(1, 0), b3, voffB);
            PG8_BAR; PG8_WAIT_L(0); PG8_MMA(0, 1, At, B1); PG8_BAR;
            PG8_LDA(At, 1, 1); PG8_STAGE(PG8_SA(1, 0), a3, voffA);
            PG8_BAR; PG8_WAIT_L(0); PG8_MMA(1, 0, At, B0); PG8_BAR; PG8_SCHED;
            PG8_STAGE(PG8_SB(1, 1), b3 + hstep, voffB);
            PG8_WAIT_V(6); PG8_BAR; PG8_MMA(1, 1, At, B1); PG8_BAR;
        }
        PG8_STAMP();
        if constexpr (!Epi::AFTER_DRAIN) { E(acc, cur, wr, wc, fr, fq); S.done(cur); }
        PG8_STAMP();
        if (!has_next) break;
#pragma unroll
        for (int a = 0; a < 2; ++a)
#pragma unroll
            for (int b = 0; b < 2; ++b)
#pragma unroll
                for (int m = 0; m < 4; ++m)
#pragma unroll
                    for (int n = 0; n < 2; ++n) { float z0; asm volatile("v_mov_b32 %0, 0" : "=v"(z0)); acc[a][b][m][n] = (f32x4){z0, z0, z0, z0}; }
        cur = nxt; cA = nA; cB = nB; ++ui;
    }
    PG8_WAIT_V(0);
    if (wr == 0) PG8_BAR;
    PG8_BAR;
    if constexpr (Epi::AFTER_DRAIN) { E.fused(acc, cur, wr, wc, fr, fq, lds, wid, lane); S.done(cur); }
    PG8_STAMP();
    if (STAMP && wid == 0) { stamps[lane] = lane < nts ? (((unsigned long long)(unsigned)ts_hi << 32) | (unsigned)ts_lo) : 0ull;
        if (lane == 62) stamps[62] = rt_entry; if (lane == 63) stamps[63] = (unsigned long long)wall_clock64(); }
#undef PG8_STAMP
#undef PG8_SA
#undef PG8_SB
#undef PG8_STAGE
#undef PG8_LDA
#undef PG8_LDB
#undef PG8_MMA
#undef PG8_WAIT_V
#undef PG8_WAIT_L
#undef PG8_BAR
#undef PG8_SCHED
}
}

using pg8::cvt_pk_bf16;
DI uint4 pack8(const pg8::f32x4& a, const pg8::f32x4& b) {
  return uint4{cvt_pk_bf16(a[0], a[1]), cvt_pk_bf16(a[2], a[3]), cvt_pk_bf16(b[0], b[1]), cvt_pk_bf16(b[2], b[3])};
}
DI void unpack8(const uint4& u, float (&o)[8]) {
  o[0] = bf2f((u16)(u.x & 0xffff)); o[1] = bf2f((u16)(u.x >> 16));
  o[2] = bf2f((u16)(u.y & 0xffff)); o[3] = bf2f((u16)(u.y >> 16));
  o[4] = bf2f((u16)(u.z & 0xffff)); o[5] = bf2f((u16)(u.z >> 16));
  o[6] = bf2f((u16)(u.w & 0xffff)); o[7] = bf2f((u16)(u.w >> 16));
}
struct EpiP {
  static constexpr bool PERM = true, AFTER_DRAIN = false;
  u16 *zb, *xr, *rwb, *gb; float* dtb;
  DI void operator()(const pg8::f32x4 (&acc)[2][2][4][2], const pg8::Unit& u, int wr, int wc, int fr, int fq) const {
    const int row0 = u.pm * 256 + wr * 64 + fr;
#pragma unroll
    for (int bj = 0; bj < 2; ++bj) {
      const int cg = u.pn * 256 + bj * 128 + wc * 32;
      const int col0 = cg + 8 * fq;
      if (cg >= 10688) continue;
#pragma unroll
      for (int ai = 0; ai < 2; ++ai)
#pragma unroll
        for (int m = 0; m < 4; ++m) {
          const size_t row = row0 + ai * 128 + m * 16;
          const pg8::f32x4 v0 = acc[ai][bj][m][0], v1 = acc[ai][bj][m][1];
          if (cg >= 5120 && cg < 5184) {
            float* d = dtb + row * 64 + (col0 - 5120);
            *(pg8::f32x4*)d = v0; *(pg8::f32x4*)(d + 4) = v1;
          } else {
            u16* dst = (cg < 2048) ? zb + row * 2048 + col0
                     : (cg < 5120) ? xr + row * 3072 + (col0 - 2048)
                     : (cg < 8640) ? rwb + row * 3456 + (col0 - 5184)
                                   : gb + row * 2048 + (col0 - 8640);
            *(uint4*)dst = pack8(v0, v1);
          }
        }
    }
  }
};
template <int PASS>
struct EpiOut {
  static constexpr bool PERM = true, AFTER_DRAIN = false;
  const u16* gb; u16* U;
  DI void operator()(const pg8::f32x4 (&acc)[2][2][4][2], const pg8::Unit& u, int wr, int wc, int fr, int fq) const {
    const int row0 = u.pm * 256 + wr * 64 + fr;
#pragma unroll
    for (int bj = 0; bj < 2; ++bj) {
      const int col0 = u.pn * 256 + bj * 128 + wc * 32 + 8 * fq;
#pragma unroll
      for (int ai = 0; ai < 2; ++ai)
#pragma unroll
        for (int m = 0; m < 4; ++m) {
          const size_t row = row0 + ai * 128 + m * 16;
          float gt[8];
          unpack8(*(const uint4*)(gb + row * 2048 + PASS * 1024 + col0), gt);
          pg8::f32x4 v0 = acc[ai][bj][m][0], v1 = acc[ai][bj][m][1];
#pragma unroll
          for (int e = 0; e < 4; ++e) { v0[e] *= sigm(gt[e]); v1[e] *= sigm(gt[4 + e]); }
          if (PASS == 1) {
            float pu[8];
            unpack8(*(const uint4*)(U + row * 1024 + col0), pu);
#pragma unroll
            for (int e = 0; e < 4; ++e) { v0[e] += pu[e]; v1[e] += pu[4 + e]; }
          }
          *(uint4*)(U + row * 1024 + col0) = pack8(v0, v1);
        }
    }
  }
};
struct EpiWo {
  static constexpr bool PERM = true, AFTER_DRAIN = false;
  const float *xp, *xs, *mod; float* out; int tok0;
  DI void operator()(const pg8::f32x4 (&acc)[2][2][4][2], const pg8::Unit& u, int wr, int wc, int fr, int fq) const {
    const int row0 = u.pm * 256 + wr * 64 + fr;
#pragma unroll
    for (int bj = 0; bj < 2; ++bj) {
      const int col0 = u.pn * 256 + bj * 128 + wc * 32 + 8 * fq;
#pragma unroll
      for (int ai = 0; ai < 2; ++ai)
#pragma unroll
        for (int m = 0; m < 4; ++m) {
          const int tok = tok0 + row0 + ai * 128 + m * 16;
          const float* xr = tok < 8192 ? xp + (size_t)tok * 1024 : xs + (size_t)(tok - 8192) * 1024;
          const float* gt = mod + mrow_of(tok) * 6144 + 2048 + col0;
          const pg8::f32x4 x0 = *(const pg8::f32x4*)(xr + col0), x1 = *(const pg8::f32x4*)(xr + col0 + 4);
          const pg8::f32x4 g0 = *(const pg8::f32x4*)gt, g1 = *(const pg8::f32x4*)(gt + 4);
          float* o = out + (size_t)tok * 1024 + col0;
          *(pg8::f32x4*)o = x0 + g0 * acc[ai][bj][m][0];
          *(pg8::f32x4*)(o + 4) = x1 + g1 * acc[ai][bj][m][1];
        }
    }
  }
};
struct EpiGU {
  static constexpr bool PERM = true, AFTER_DRAIN = false;
  u16* act;
  DI void operator()(const pg8::f32x4 (&acc)[2][2][4][2], const pg8::Unit& u, int wr, int wc, int fr, int fq) const {
    const int row0 = u.pm * 256 + wr * 64 + fr;
    const int col0 = u.pn * 128 + wc * 32 + 8 * fq;
#pragma unroll
    for (int ai = 0; ai < 2; ++ai)
#pragma unroll
      for (int m = 0; m < 4; ++m) {
        const size_t row = row0 + ai * 128 + m * 16;
        pg8::f32x4 v0, v1;
#pragma unroll
        for (int e = 0; e < 4; ++e) {
          v0[e] = siluf(acc[ai][0][m][0][e]) * acc[ai][1][m][0][e];
          v1[e] = siluf(acc[ai][0][m][1][e]) * acc[ai][1][m][1][e];
        }
        *(uint4*)(act + row * 2816 + col0) = pack8(v0, v1);
      }
  }
};
struct EpiDown {
  static constexpr bool PERM = true, AFTER_DRAIN = false;
  const float* mod; float* out;
  DI void operator()(const pg8::f32x4 (&acc)[2][2][4][2], const pg8::Unit& u, int wr, int wc, int fr, int fq) const {
    const int row0 = u.pm * 256 + wr * 64 + fr;
#pragma unroll
    for (int bj = 0; bj < 2; ++bj) {
      const int col0 = u.pn * 256 + bj * 128 + wc * 32 + 8 * fq;
#pragma unroll
      for (int ai = 0; ai < 2; ++ai)
#pragma unroll
        for (int m = 0; m < 4; ++m) {
          const int tok = row0 + ai * 128 + m * 16;
          const float* gt = mod + mrow_of(tok) * 6144 + 5120 + col0;
          const pg8::f32x4 g0 = *(const pg8::f32x4*)gt, g1 = *(const pg8::f32x4*)(gt + 4);
          float* o = out + (size_t)tok * 1024 + col0;
          const pg8::f32x4 x0 = *(const pg8::f32x4*)o, x1 = *(const pg8::f32x4*)(o + 4);
          *(pg8::f32x4*)o = x0 + g0 * acc[ai][bj][m][0];
          *(pg8::f32x4*)(o + 4) = x1 + g1 * acc[ai][bj][m][1];
        }
    }
  }
};
template <class Epi>
DI void run_gemm8(char* smem, const u16* A, const u16* Bt, int M, int N, int K, const Epi& E) {
  asm volatile("" : "+s"(M), "+s"(N), "+s"(K));
  pg8::Gemm gm{A, Bt, M, N, K};
  pg8::StaticOrder S;
  S.init(M, N, gridDim.x, blockIdx.x);
  pg8::gemm_phase<Epi, pg8::StaticOrder, false>((PG8_LAS unsigned char*)smem, gm, S, E, nullptr);
  __syncthreads();
}

template <int MODE>
__device__ __forceinline__ void convT(const float* __restrict__ src, int K, int N, u16* __restrict__ dst, char* smem, int vb = -1, int nb = 0) {
  float* tile = (float*)smem;
  const int tid = get_tid();
  const int KT = K >> 6, NT = N >> 6;
  if (vb < 0) { vb = blockIdx.x; nb = gridDim.x; }
  for (int t = vb; t < KT * NT; t += nb) {
    int kt = t % KT, nt = t / KT;
#pragma unroll
    for (int i = 0; i < 8; ++i) {
      int idx = tid + i * 512;
      int r = idx >> 6, cc = idx & 63;
      tile[r * 65 + cc] = src[(size_t)(kt * 64 + r) * N + nt * 64 + cc];
    }
    __syncthreads();
    int n = tid >> 3, kc = tid & 7;
    unsigned w[4];
#pragma unroll
    for (int j = 0; j < 4; ++j)
      w[j] = pack2(tile[(kc * 8 + 2 * j) * 65 + n], tile[(kc * 8 + 2 * j + 1) * 65 + n]);
    int ng = nt * 64 + n;
    int row = ng;
    if (MODE == 1) {
      int isu = ng >= 2816;
      int nn = ng - isu * 2816;
      row = (nn >> 7) * 256 + isu * 128 + (nn & 127);
    }
    *(uint4*)(dst + (size_t)row * K + kt * 64 + kc * 8) = uint4{w[0], w[1], w[2], w[3]};
    __syncthreads();
  }
}

__device__ __forceinline__ void step_prep(const Params& p, char* smem) {
  const int tid = get_tid();
  char* ws = p.ws;
  {
    float* red = (float*)smem;
    float* mod = (float*)(ws + OFF_MOD);
    for (int item = blockIdx.x; item < 192; item += gridDim.x) {
      int c4 = tid & 7, kl = tid >> 3;
      float acc[12];
#pragma unroll
      for (int i = 0; i < 12; ++i) acc[i] = 0.f;
      for (int k = kl; k < 1024; k += 64) {
        float4 w = *(const float4*)(p.w_ada + (size_t)k * 6144 + item * 32 + c4 * 4);
        float s0 = siluf(p.c_ctx[k]), s1 = siluf(p.c[k]), s2 = siluf(p.c[1024 + k]);
        acc[0] += s0 * w.x; acc[1] += s0 * w.y; acc[2] += s0 * w.z; acc[3] += s0 * w.w;
        acc[4] += s1 * w.x; acc[5] += s1 * w.y; acc[6] += s1 * w.z; acc[7] += s1 * w.w;
        acc[8] += s2 * w.x; acc[9] += s2 * w.y; acc[10] += s2 * w.z; acc[11] += s2 * w.w;
      }
#pragma unroll
      for (int i = 0; i < 12; ++i) red[(kl * 8 + c4) * 12 + i] = acc[i];
      __syncthreads();
      if (tid < 96) {
        int cond = tid >> 5, col = tid & 31;
        int cc4 = col >> 2, e = col & 3;
        float s = 0.f;
        for (int k = 0; k < 64; ++k) s += red[(k * 8 + cc4) * 12 + cond * 4 + e];
        int n = item * 32 + col;
        mod[cond * 6144 + n] = s + p.b_ada[n];
      }
      __syncthreads();
    }
  }
  convT<0>(p.w_in, 1024, 10688, (u16*)(ws + OFF_WIN), smem);
  convT<0>(p.w_m_out, 2048, 1024, (u16*)(ws + OFF_WMOUT), smem);
  convT<0>(p.w_r_out, 1024, 1024, (u16*)(ws + OFF_WROUT), smem);
  convT<0>(p.w_o, 1024, 1024, (u16*)(ws + OFF_WO), smem);
  convT<0>(p.w2, 64, 1024, (u16*)(ws + OFF_W2T), smem);
  convT<0>(p.w2 + 65536, 64, 1024, (u16*)(ws + OFF_W2T) + 65536, smem);
  convT<0>(p.a2, 64, 1024, (u16*)(ws + OFF_A2T), smem);
  convT<0>(p.a2 + 65536, 64, 1024, (u16*)(ws + OFF_A2T) + 65536, smem);
  convT<0>(p.g2, 128, 1024, (u16*)(ws + OFF_G2T), smem);
  {
    uint4* z = (uint4*)(ws + OFF_WIN + (size_t)10688 * 1024 * 2);
    for (int i = blockIdx.x * NTHR + tid; i < 8192; i += gridDim.x * NTHR) z[i] = uint4{0, 0, 0, 0};
  }
}

template <int WHICH>
__device__ __forceinline__ void step_norm(const Params& p, int g) {
  const int tid = get_tid(), lane = tid & 63, wave = tid >> 6;
  const float* mod = (const float*)(p.ws + OFF_MOD);
  const int nrows = WHICH == 0 ? TG : NTOK;
  u16* dst = (u16*)(p.ws + (WHICH == 0 ? OFF_H1 : OFF_H2));
  const float* nw = WHICH == 0 ? p.norm1_w : p.norm2_w;
  for (int r = blockIdx.x * 8 + wave; r < nrows; r += gridDim.x * 8) {
    int tok = WHICH == 0 ? g * TG + r : r;
    const float* xr;
    if (WHICH == 0) xr = tok < 8192 ? p.x_prompt + (size_t)tok * 1024 : p.x_sample + (size_t)(tok - 8192) * 1024;
    else xr = (const float*)(p.ws + OFF_X1) + (size_t)tok * 1024;
    const float* mr = mod + mrow_of(tok) * 6144 + (WHICH == 0 ? 0 : 3072);
    float4 v[4];
    float ss = 0.f;
#pragma unroll
    for (int i = 0; i < 4; ++i) {
      v[i] = ((const float4*)xr)[i * 64 + lane];
      ss += v[i].x * v[i].x + v[i].y * v[i].y + v[i].z * v[i].z + v[i].w * v[i].w;
    }
    ss = wave_sum(ss);
    float rinv = rsqrtf(ss * (1.f / 1024.f) + 1e-6f);
#pragma unroll
    for (int i = 0; i < 4; ++i) {
      int col = (i * 64 + lane) * 4;
      float4 w4 = *(const float4*)(nw + col);
      float4 sh = *(const float4*)(mr + col);
      float4 sc = *(const float4*)(mr + 1024 + col);
      float h0 = v[i].x * rinv * w4.x * (1.f + sc.x) + sh.x;
      float h1 = v[i].y * rinv * w4.y * (1.f + sc.y) + sh.y;
      float h2 = v[i].z * rinv * w4.z * (1.f + sc.z) + sh.z;
      float h3 = v[i].w * rinv * w4.w * (1.f + sc.w) + sh.w;
      *(uint2*)(dst + (size_t)r * 1024 + col) = uint2{pack2(h0, h1), pack2(h2, h3)};
    }
  }
}

__device__ __forceinline__ void step_gemm1(const Params& p, char* smem) {
  char* ws = p.ws;
  EpiP E{(u16*)(ws + OFF_Z), (u16*)(ws + OFF_XBCRAW), (u16*)(ws + OFF_RW), (u16*)(ws + OFF_GATE), (float*)(ws + OFF_DT)};
  run_gemm8(smem, (const u16*)(ws + OFF_H1), (const u16*)(ws + OFF_WIN), TG, NPAD, 1024, E);
}

__device__ __forceinline__ void step_cr1(const Params& p, int g) {
  char* ws = p.ws;
  const int tid = get_tid(), lane = tid & 63, wave = tid >> 6;
  const int Ls = g < 2 ? 256 : 2048;
  {
    const u16* xr = (const u16*)(ws + OFF_XBCRAW);
    u16* xo = (u16*)(ws + OFF_XBC);
    for (int idx = blockIdx.x * NTHR + tid; idx < TG * 384; idx += gridDim.x * NTHR) {
      int r = idx / 384, cc = idx - r * 384;
      int pos = r & (Ls - 1);
      float s[8];
      {
        float4 b0 = *(const float4*)(p.conv_b + cc * 8), b1 = *(const float4*)(p.conv_b + cc * 8 + 4);
        s[0] = b0.x; s[1] = b0.y; s[2] = b0.z; s[3] = b0.w; s[4] = b1.x; s[5] = b1.y; s[6] = b1.z; s[7] = b1.w;
      }
#pragma unroll
      for (int i = 0; i < 5; ++i) {
        int pp = pos + i - 2;
        if (pp >= 0 && pp < Ls) {
          uint4 u = *(const uint4*)(xr + (size_t)(r + i - 2) * 3072 + cc * 8);
          float4 w0 = *(const float4*)(p.conv_w + i * 3072 + cc * 8), w1 = *(const float4*)(p.conv_w + i * 3072 + cc * 8 + 4);
          s[0] += bf2f(u.x & 0xffff) * w0.x; s[1] += bf2f(u.x >> 16) * w0.y;
          s[2] += bf2f(u.y & 0xffff) * w0.z; s[3] += bf2f(u.y >> 16) * w0.w;
          s[4] += bf2f(u.z & 0xffff) * w1.x; s[5] += bf2f(u.z >> 16) * w1.y;
          s[6] += bf2f(u.w & 0xffff) * w1.z; s[7] += bf2f(u.w >> 16) * w1.w;
        }
      }
#pragma unroll
      for (int e = 0; e < 8; ++e) s[e] = siluf(s[e]);
      *(uint4*)(xo + (size_t)r * 3072 + cc * 8) = uint4{pack2(s[0], s[1]), pack2(s[2], s[3]), pack2(s[4], s[5]), pack2(s[6], s[7])};
    }
  }
  {
    const u16* rw = (const u16*)(ws + OFF_RW);
    __half* wk = (__half*)(ws + OFF_WK);
    u16* tl = (u16*)(ws + OFF_TL);
    u16* sg = (u16*)(ws + OFF_SG);
    const bool grid = (g == 2);
    for (int r = blockIdx.x * 8 + wave; r < TG; r += gridDim.x * 8) {
      int pos = r & (Ls - 1);
      for (int ib = 0; ib < 54; ib += 6) {
        float xxs[6];
        {
          float cur[6], shv[6], muv[6];
#pragma unroll
          for (int u = 0; u < 6; ++u) {
            int c = (ib + u) * 64 + lane;
            cur[u] = bf2f(rw[(size_t)r * 3456 + c]);
            int q = c / 864;
            int dr;
            bool ok;
            if (!grid) {
              if (q & 1) { dr = 1; ok = pos < Ls - 1; } else { dr = -1; ok = pos > 0; }
            } else {
              if (q == 0) { dr = -1; ok = (pos & 63) != 0; }
              else if (q == 1) { dr = 1; ok = (pos & 63) != 63; }
              else if (q == 2) { dr = -64; ok = pos >= 64; }
              else { dr = 64; ok = pos < Ls - 64; }
            }
            shv[u] = ok ? bf2f(rw[(size_t)(r + dr) * 3456 + c]) : 0.f;
            muv[u] = p.mu_shift[c];
          }
#pragma unroll
          for (int u = 0; u < 6; ++u) xxs[u] = cur[u] + muv[u] * (shv[u] - cur[u]);
        }
#pragma unroll
        for (int u = 0; u < 6; ++u) {
          const int it = ib + u;
          const float xx = xxs[u];
          if (it < 16) {
            wk[((size_t)(r * 16 + it) * 8 + 0) * 64 + lane] = __float2half(xx);
          } else if (it == 16) {
            tl[(size_t)r * 256 + lane] = f2bf(tanhf(xx));
          } else if (it == 17) {
            tl[(size_t)r * 256 + 64 + lane] = f2bf(tanhf(xx));
          } else if (it < 34) {
            int h = it - 18;
            float kk = xx * p.k_k[h * 64 + lane];
            float ss = wave_sum(kk * kk);
            float nkk = -kk * rsqrtf(ss + 1e-12f);
            wk[((size_t)(r * 16 + h) * 8 + 2) * 64 + lane] = __float2half(xx);
            wk[((size_t)(r * 16 + h) * 8 + 3) * 64 + lane] = __float2half(nkk);
          } else if (it < 50) {
            int h = it - 34;
            wk[((size_t)(r * 16 + h) * 8 + 1) * 64 + lane] = __float2half(xx);
          } else if (it == 50) {
            tl[(size_t)r * 256 + 128 + lane] = f2bf(xx);
          } else if (it == 51) {
            tl[(size_t)r * 256 + 192 + lane] = f2bf(xx);
          } else {
            sg[(size_t)r * 128 + (it - 52) * 64 + lane] = f2bf(sigm(xx));
          }
        }
      }
    }
  }
}

__device__ __forceinline__ void step_r2(const Params& p, char* smem) {
  char* ws = p.ws;
  const int tid = get_tid(), lane = tid & 63, wave = tid >> 6;
  const int wm = wave >> 1, wn = wave & 1;
  const u16* tl = (const u16*)(ws + OFF_TL);
  const u16* sg = (const u16*)(ws + OFF_SG);
  __half* wk = (__half*)(ws + OFF_WK);
  u16* gr = (u16*)(ws + OFF_GR);
  for (int t = blockIdx.x; t < 5 * 128; t += gridDim.x) {
    int sub = t >> 7, rem = t & 127;
    int mt = rem & 15, nt = rem >> 4;
    f32x4 acc[4][4];
    zero_acc(acc);
    if (sub < 2) {
      gemm_acc(tl + (size_t)mt * 256 * 256 + sub * 64, 256, (const u16*)(ws + OFF_W2T) + sub * 65536 + (size_t)nt * 128 * 64, 64, 64, acc, smem);
    } else if (sub < 4) {
      gemm_acc(tl + (size_t)mt * 256 * 256 + 128 + (sub - 2) * 64, 256, (const u16*)(ws + OFF_A2T) + (sub - 2) * 65536 + (size_t)nt * 128 * 64, 64, 64, acc, smem);
    } else {
      gemm_acc(sg + (size_t)mt * 256 * 128, 128, (const u16*)(ws + OFF_G2T) + (size_t)nt * 128 * 128, 128, 128, acc, smem);
    }
#pragma unroll
    for (int mf = 0; mf < 4; ++mf)
#pragma unroll
      for (int nf = 0; nf < 4; ++nf)
#pragma unroll
        for (int j = 0; j < 4; ++j) {
          if (nf == 0 && j == 0) asm volatile("" ::: "memory");
          int m = mt * 256 + wm * 64 + mf * 16 + (lane >> 4) * 4 + j;
          int n = nt * 128 + wn * 64 + nf * 16 + (lane & 15);
          float v = acc[mf][nf][j];
          if (sub < 2) {
            float wl = v + p.w0[sub * 1024 + n];
            float dec = __expf(-0.6065306597f * sigm(wl));
            wk[((size_t)(m * 16 + (n >> 6)) * 8 + 4 + 2 * sub) * 64 + (n & 63)] = __float2half(dec);
          } else if (sub < 4) {
            int d = sub - 2;
            float a = sigm(v + p.a0[d * 1024 + n]);
            wk[((size_t)(m * 16 + (n >> 6)) * 8 + 5 + 2 * d) * 64 + (n & 63)] = __float2half(a);
          } else {
            gr[(size_t)m * 1024 + n] = f2bf(v);
          }
        }
  }
}

DI int swz16(int row) { return (row ^ (row >> 3)) & 15; }
DI int sw256(int row, int e) { return row * 256 + ((((e >> 3) ^ swz16(row))) << 4) + (e & 7) * 2; }
DI const bf16x8 ldfrag256(const char* base, int row, int ch) {
  return *(const bf16x8*)(base + row * 256 + ((ch ^ swz16(row)) << 4));
}

typedef unsigned v4u __attribute__((ext_vector_type(4)));
struct SsdPre { v4u c0, c1, c2, c3, b0, b1, b2, b3, x0, x1; float d0, d1; };
DI void ssd_issue(const Params& p, int g, int chain, int ci, int tid, SsdPre& R) {
  const int Ls = g < 2 ? 256 : 2048;
  const int nch = Ls >> 7;
  const int d = chain & 1, h = (chain >> 1) & 31, b = chain >> 6;
  const int grp = h >> 3;
  const int c = d ? nch - 1 - ci : ci;
  const int tok0 = b * Ls + c * 128;
  const u16* xbc = (const u16*)(p.ws + OFF_XBC);
  const float* dtb = (const float*)(p.ws + OFF_DT);
  const int lane = tid & 63, wave = tid >> 6;
#define SSD_LDCB(i, CF, BF) { int idx = tid + i * 512; int row = idx >> 4, ch = idx & 15; \
    const u16* src = xbc + (size_t)(tok0 + row) * 3072 + grp * 128 + ch * 8; R.CF = *(const v4u*)(src + 2560); R.BF = *(const v4u*)(src + 2048); }
  SSD_LDCB(0, c0, b0) SSD_LDCB(1, c1, b1) SSD_LDCB(2, c2, b2) SSD_LDCB(3, c3, b3)
#undef SSD_LDCB
#define SSD_LDX(i, XF) { int idx = tid + i * 512; int l = idx >> 3, ch = idx & 7; R.XF = *(const v4u*)(xbc + (size_t)(tok0 + l) * 3072 + h * 64 + ch * 8); }
  SSD_LDX(0, x0) SSD_LDX(1, x1)
#undef SSD_LDX
  if (wave == 0) {
    int e0 = 2 * lane, e1 = 2 * lane + 1;
    int l0 = d ? 127 - e0 : e0, l1 = d ? 127 - e1 : e1;
    R.d0 = dtb[(size_t)(tok0 + l0) * 64 + d * 32 + h];
    R.d1 = dtb[(size_t)(tok0 + l1) * 64 + d * 32 + h];
  }
}

__device__ __forceinline__ void ssd_chain(const Params& p, char* smem, int g, int chain, int next_chain, SsdPre& R) {
  char* ws = p.ws;
  const int tid = get_tid(), lane = tid & 63, wave = tid >> 6;
  const int Ls = g < 2 ? 256 : 2048;
  const int nch = Ls >> 7;
  const int d = chain & 1, h = (chain >> 1) & 31, b = chain >> 6;
  const int grp = h >> 3;
  const u16* xbc = (const u16*)(ws + OFF_XBC);
  const float* dtb = (const float*)(ws + OFF_DT);
  u16* yout = (u16*)(ws + (d ? OFF_SYB : OFF_SYF));
  char* Cs = smem;
  char* Bs = smem + 32768;
  char* BdT = smem + 65536;
  char* XT = smem + 98304;
  char* Ss = smem + 114688;
  float* csum = (float*)(smem + 131072);
  float* dts = (float*)(smem + 131584);
  const float a_h = -__expf(p.a_log[d * 32 + h]);
  const float dtbias = p.dt_bias[d * 32 + h];
  const int wp = wave >> 2, wn4 = wave & 3;
  f32x4 sacc[2][2];
#pragma unroll
  for (int pf = 0; pf < 2; ++pf)
#pragma unroll
    for (int nf = 0; nf < 2; ++nf) {
      if (g == 2) {
        const float* h0 = (d ? p.ssm_b : p.ssm_f) + (size_t)(b * 32 + h) * 8192;
#pragma unroll
        for (int j = 0; j < 4; ++j) {
          int pp = wp * 32 + pf * 16 + (lane >> 4) * 4 + j;
          int n = wn4 * 32 + nf * 16 + (lane & 15);
          sacc[pf][nf][j] = h0[pp * 128 + n];
        }
      } else {
        sacc[pf][nf] = f32x4{0.f, 0.f, 0.f, 0.f};
      }
    }
  const int tid_outer = tid;
  for (int ci = 0; ci < nch; ++ci) {
    int tidv = tid_outer;
    asm volatile("" : "+v"(tidv));
    const int tid = tidv, lane = tidv & 63, wave = tidv >> 6;
    const int wp = wave >> 2, wn4 = wave & 3;
    const int c = d ? nch - 1 - ci : ci;
    const int tok0 = b * Ls + c * 128;
#define SSD_STCB(i, CF, BF) { int idx = tid + i * 512; int row = idx >> 4, ch = idx & 15; \
      *(v4u*)(Cs + row * 256 + ((ch ^ swz16(row)) << 4)) = R.CF; *(v4u*)(Bs + row * 256 + ((ch ^ swz16(row)) << 4)) = R.BF; }
    SSD_STCB(0, c0, b0) SSD_STCB(1, c1, b1) SSD_STCB(2, c2, b2) SSD_STCB(3, c3, b3)
#undef SSD_STCB
#define SSD_STX(i, XF) { int idx = tid + i * 512; int l = idx >> 3, ch = idx & 7; \
      const unsigned w0 = R.XF[0], w1 = R.XF[1], w2 = R.XF[2], w3 = R.XF[3]; \
      *(u16*)(XT + sw256(ch * 8 + 0, l)) = (u16)(w0 & 0xffff); *(u16*)(XT + sw256(ch * 8 + 1, l)) = (u16)(w0 >> 16); \
      *(u16*)(XT + sw256(ch * 8 + 2, l)) = (u16)(w1 & 0xffff); *(u16*)(XT + sw256(ch * 8 + 3, l)) = (u16)(w1 >> 16); \
      *(u16*)(XT + sw256(ch * 8 + 4, l)) = (u16)(w2 & 0xffff); *(u16*)(XT + sw256(ch * 8 + 5, l)) = (u16)(w2 >> 16); \
      *(u16*)(XT + sw256(ch * 8 + 6, l)) = (u16)(w3 & 0xffff); *(u16*)(XT + sw256(ch * 8 + 7, l)) = (u16)(w3 >> 16); }
    SSD_STX(0, x0) SSD_STX(1, x1)
#undef SSD_STX
    if (wave == 0) {
      int e0 = 2 * lane, e1 = 2 * lane + 1;
      int l0 = d ? 127 - e0 : e0, l1 = d ? 127 - e1 : e1;
      float x0 = R.d0 + dtbias;
      float x1 = R.d1 + dtbias;
      float dt0 = x0 > 20.f ? x0 : log1pf(__expf(x0));
      float dt1 = x1 > 20.f ? x1 : log1pf(__expf(x1));
      float a0 = dt0 * a_h, a1 = dt1 * a_h;
      float s = a0 + a1;
#pragma unroll
      for (int o = 1; o < 64; o <<= 1) {
        float t = __shfl_up(s, o);
        if (lane >= o) s += t;
      }
      csum[l1] = s;
      csum[l0] = s - a1;
      dts[l0] = dt0;
      dts[l1] = dt1;
    }
    if (ci + 1 < nch) ssd_issue(p, g, chain, ci + 1, tid, R);
    else if (next_chain >= 0) ssd_issue(p, g, next_chain, 0, tid, R);
#pragma unroll
    for (int pf = 0; pf < 2; ++pf)
#pragma unroll
      for (int nf = 0; nf < 2; ++nf)
#pragma unroll
        for (int j = 0; j < 4; ++j) {
          int pp = wp * 32 + pf * 16 + (lane >> 4) * 4 + j;
          int n = wn4 * 32 + nf * 16 + (lane & 15);
          *(u16*)(Ss + sw256(pp, n)) = f2bf(sacc[pf][nf][j]);
        }
    __syncthreads();
    const float cstot = csum[d ? 0 : 127];
#pragma unroll
    for (int i = 0; i < 4; ++i) {
      int idx = tid + i * 512;
      int l = idx >> 4, ch = idx & 15;
      uint4 bv = *(const uint4*)(Bs + l * 256 + ((ch ^ swz16(l)) << 4));
      float f = dts[l] * __expf(cstot - csum[l]);
      unsigned w[4] = {bv.x, bv.y, bv.z, bv.w};
#pragma unroll
      for (int e = 0; e < 8; ++e) {
        int n = ch * 8 + e;
        float val = bf2f((u16)((w[e >> 1] >> ((e & 1) * 16)) & 0xffff)) * f;
        *(u16*)(BdT + sw256(n, l)) = f2bf(val);
      }
    }
    const int wm = wave >> 1, wn2 = wave & 1;
    f32x4 gacc[2][4];
#pragma unroll
    for (int i = 0; i < 2; ++i)
#pragma unroll
      for (int j = 0; j < 4; ++j) gacc[i][j] = f32x4{0.f, 0.f, 0.f, 0.f};
#pragma unroll
    for (int ks = 0; ks < 4; ++ks) {
      int ch = ks * 4 + (lane >> 4);
      bf16x8 a[2], bb[4];
#pragma unroll
      for (int mf = 0; mf < 2; ++mf) a[mf] = ldfrag256(Cs, wm * 32 + mf * 16 + (lane & 15), ch);
#pragma unroll
      for (int nf = 0; nf < 4; ++nf) bb[nf] = ldfrag256(Bs, wn2 * 64 + nf * 16 + (lane & 15), ch);
#pragma unroll
      for (int mf = 0; mf < 2; ++mf)
#pragma unroll
        for (int nf = 0; nf < 4; ++nf)
          gacc[mf][nf] = __builtin_amdgcn_mfma_f32_16x16x32_bf16(a[mf], bb[nf], gacc[mf][nf], 0, 0, 0);
    }
    {
      float csl[2][4];
#pragma unroll
      for (int mf = 0; mf < 2; ++mf)
#pragma unroll
        for (int j = 0; j < 4; ++j) csl[mf][j] = csum[wm * 32 + mf * 16 + (lane >> 4) * 4 + j];
#pragma unroll
      for (int nf = 0; nf < 4; ++nf) {
        int s = wn2 * 64 + nf * 16 + (lane & 15);
        float css = csum[s], dss = dts[s];
#pragma unroll
        for (int mf = 0; mf < 2; ++mf)
#pragma unroll
          for (int j = 0; j < 4; ++j) {
            int l = wm * 32 + mf * 16 + (lane >> 4) * 4 + j;
            bool valid = d ? (s >= l) : (s <= l);
            float e = valid ? __expf(csl[mf][j] - css) * dss : 0.f;
            gacc[mf][nf][j] *= e;
          }
      }
    }
    __syncthreads();
#pragma unroll
    for (int mf = 0; mf < 2; ++mf)
#pragma unroll
      for (int nf = 0; nf < 4; ++nf)
#pragma unroll
        for (int j = 0; j < 4; ++j) {
          int l = wm * 32 + mf * 16 + (lane >> 4) * 4 + j;
          int s = wn2 * 64 + nf * 16 + (lane & 15);
          *(u16*)(Bs + sw256(l, s)) = f2bf(gacc[mf][nf][j]);
        }
    __syncthreads();
    {
      f32x4 yacc[2][2];
#pragma unroll
      for (int i = 0; i < 2; ++i)
#pragma unroll
        for (int j = 0; j < 2; ++j) yacc[i][j] = f32x4{0.f, 0.f, 0.f, 0.f};
#pragma unroll
      for (int ks = 0; ks < 4; ++ks) {
        int ch = ks * 4 + (lane >> 4);
        bf16x8 a[2], bb[2];
#pragma unroll
        for (int mf = 0; mf < 2; ++mf) a[mf] = ldfrag256(Cs, wm * 32 + mf * 16 + (lane & 15), ch);
#pragma unroll
        for (int nf = 0; nf < 2; ++nf) bb[nf] = ldfrag256(Ss, wn2 * 32 + nf * 16 + (lane & 15), ch);
#pragma unroll
        for (int mf = 0; mf < 2; ++mf)
#pragma unroll
          for (int nf = 0; nf < 2; ++nf)
            yacc[mf][nf] = __builtin_amdgcn_mfma_f32_16x16x32_bf16(a[mf], bb[nf], yacc[mf][nf], 0, 0, 0);
      }
#pragma unroll
      for (int mf = 0; mf < 2; ++mf)
#pragma unroll
        for (int j = 0; j < 4; ++j) {
          float e = __expf(csum[wm * 32 + mf * 16 + (lane >> 4) * 4 + j]);
#pragma unroll
          for (int nf = 0; nf < 2; ++nf) yacc[mf][nf][j] *= e;
        }
#pragma unroll
      for (int ks = 0; ks < 4; ++ks) {
        int ch = ks * 4 + (lane >> 4);
        bf16x8 a[2], bb[2];
#pragma unroll
        for (int mf = 0; mf < 2; ++mf) a[mf] = ldfrag256(Bs, wm * 32 + mf * 16 + (lane & 15), ch);
#pragma unroll
        for (int nf = 0; nf < 2; ++nf) bb[nf] = ldfrag256(XT, wn2 * 32 + nf * 16 + (lane & 15), ch);
#pragma unroll
        for (int mf = 0; mf < 2; ++mf)
#pragma unroll
          for (int nf = 0; nf < 2; ++nf)
            yacc[mf][nf] = __builtin_amdgcn_mfma_f32_16x16x32_bf16(a[mf], bb[nf], yacc[mf][nf], 0, 0, 0);
      }
#pragma unroll
      for (int mf = 0; mf < 2; ++mf)
#pragma unroll
        for (int nf = 0; nf < 2; ++nf)
#pragma unroll
          for (int j = 0; j < 4; ++j) {
            int l = wm * 32 + mf * 16 + (lane >> 4) * 4 + j;
            int pp = wn2 * 32 + nf * 16 + (lane & 15);
            yout[(size_t)(tok0 + l) * 2048 + h * 64 + pp] = f2bf(yacc[mf][nf][j]);
          }
    }
    {
      float e = __expf(cstot);
#pragma unroll
      for (int pf = 0; pf < 2; ++pf)
#pragma unroll
        for (int nf = 0; nf < 2; ++nf) sacc[pf][nf] *= e;
#pragma unroll
      for (int ks = 0; ks < 4; ++ks) {
        int ch = ks * 4 + (lane >> 4);
        bf16x8 a[2], bb[2];
#pragma unroll
        for (int pf = 0; pf < 2; ++pf) a[pf] = ldfrag256(XT, wp * 32 + pf * 16 + (lane & 15), ch);
#pragma unroll
        for (int nf = 0; nf < 2; ++nf) bb[nf] = ldfrag256(BdT, wn4 * 32 + nf * 16 + (lane & 15), ch);
#pragma unroll
        for (int pf = 0; pf < 2; ++pf)
#pragma unroll
          for (int nf = 0; nf < 2; ++nf)
            sacc[pf][nf] = __builtin_amdgcn_mfma_f32_16x16x32_bf16(a[pf], bb[nf], sacc[pf][nf], 0, 0, 0);
      }
    }
    __syncthreads();
  }
  if (g < 2) {
    float* so = p.out + (d ? OUT_SSMB : OUT_SSMF) + (size_t)((g * 16 + b) * 32 + h) * 8192;
#pragma unroll
    for (int pf = 0; pf < 2; ++pf)
#pragma unroll
      for (int nf = 0; nf < 2; ++nf)
#pragma unroll
        for (int j = 0; j < 4; ++j) {
          int pp = wp * 32 + pf * 16 + (lane >> 4) * 4 + j;
          int n = wn4 * 32 + nf * 16 + (lane & 15);
          so[pp * 128 + n] = sacc[pf][nf][j];
        }
  }
}

DI float dpp_xor1(float v) { return __int_as_float(__builtin_amdgcn_update_dpp(0, __float_as_int(v), 0xB1, 0xF, 0xF, true)); }
DI float dpp_hmirror(float v) { return __int_as_float(__builtin_amdgcn_update_dpp(0, __float_as_int(v), 0x141, 0xF, 0xF, true)); }
DI float dpp_xor2(float v) { return __int_as_float(__builtin_amdgcn_update_dpp(0, __float_as_int(v), 0x4E, 0xF, 0xF, true)); }

template <bool SEG>
__device__ __forceinline__ void wkv_pair(const Params& p, char* smem, int g, int item) {
  char* ws = p.ws;
  const int tid = get_tid(), lane = tid & 63, wave = tid >> 6;
  const int Ls = SEG ? 2048 : 256;
  const __half* wk = (const __half*)(ws + OFF_WK);
  float* stage = (float*)smem;
  float* ylds = (float*)(smem + 98304);
  const bool cw = true;
  const int slot = wave >> 2, wq = wave & 3;
  const int ig = lane >> 3, jg = lane & 7;
  const int row0 = wq * 16 + ig * 2;
  const int chain = SEG ? (item >> 3) : item * 2 + slot;
  const int seg = SEG ? (item & 7) : 0;
  const bool act = cw && (SEG ? !(slot == 1 && seg == 0) : true);
  const int d = chain & 1, h = (chain >> 1) & 15, b = chain >> 5;
  typedef float f2 __attribute__((ext_vector_type(2)));
  f2 S[2][4];
#pragma unroll
  for (int rr = 0; rr < 2; ++rr) {
    if (SEG) {
      if (slot == 0) {
        if (seg == 0) {
          const float* s0 = (d ? p.wkv_b : p.wkv_f) + ((size_t)(b * 16 + h) * 64 + row0 + rr) * 64 + jg * 8;
#pragma unroll
          for (int c = 0; c < 4; ++c) S[rr][c] = f2{s0[2 * c], s0[2 * c + 1]};
        } else {
#pragma unroll
          for (int c = 0; c < 4; ++c) S[rr][c] = f2{0.f, 0.f};
        }
      } else {
#pragma unroll
        for (int c = 0; c < 4; ++c) S[rr][c] = f2{(row0 + rr == jg * 8 + 2 * c) ? 1.f : 0.f, (row0 + rr == jg * 8 + 2 * c + 1) ? 1.f : 0.f};
      }
    } else {
#pragma unroll
      for (int c = 0; c < 4; ++c) S[rr][c] = f2{0.f, 0.f};
    }
  }
  const int pair = tid >> 4, lslot = pair >> 4, lstep = pair & 15, sub = tid & 15;
  const int lch = SEG ? (item >> 3) : item * 2 + lslot;
  const int ld = lch & 1, lh = (lch >> 1) & 15, lb = lch >> 5;
  const bool ldo = SEG ? (lslot == 0) : true;
  const int sbase = seg * 256;
  const int cslot = SEG ? 0 : slot;
  float ka[4];
#pragma unroll
  for (int e = 0; e < 4; ++e) ka[e] = p.k_a[lh * 64 + sub * 4 + e];
  u16* yout;
  if (SEG) yout = lslot == 0 ? (u16*)(ws + (ld ? OFF_WYB : OFF_WYF)) : (u16*)(ws + OFF_YM) + (ld ? (size_t)TG * 1024 : 0);
  else yout = (u16*)(ws + (ld ? OFF_WYB : OFF_WYF));
  const bool ywr = SEG ? (lslot == 0 || seg > 0) : true;
  uint2 rg[6];
  auto prefetch = [&](int tb) {
    int s = sbase + tb * 16 + lstep;
    int pos = ld ? Ls - 1 - s : s;
    int r = lb * Ls + pos;
    const __half* rec = wk + ((size_t)(r * 16 + lh) * 8) * 64 + sub * 4;
    rg[0] = *(const uint2*)(rec + 0 * 64);
    rg[1] = *(const uint2*)(rec + 1 * 64);
    rg[2] = *(const uint2*)(rec + 2 * 64);
    rg[3] = *(const uint2*)(rec + 3 * 64);
    rg[4] = *(const uint2*)(rec + (4 + 2 * ld) * 64);
    rg[5] = *(const uint2*)(rec + (5 + 2 * ld) * 64);
  };
  auto unpack4 = [&](uint2 u, float (&o)[4]) {
    __half2 h0 = *reinterpret_cast<__half2*>(&u.x);
    __half2 h1 = *reinterpret_cast<__half2*>(&u.y);
    float2 f0 = __half22float2(h0), f1 = __half22float2(h1);
    o[0] = f0.x; o[1] = f0.y; o[2] = f1.x; o[3] = f1.y;
  };
  auto stage_store = [&](int buf) {
    float r_[4], v_[4], k_[4], nkk_[4], w_[4], a_[4];
    unpack4(rg[0], r_); unpack4(rg[1], v_); unpack4(rg[2], k_); unpack4(rg[3], nkk_); unpack4(rg[4], w_); unpack4(rg[5], a_);
    float b_[4], kd_[4];
#pragma unroll
    for (int e = 0; e < 4; ++e) {
      b_[e] = -nkk_[e] * a_[e];
      kd_[e] = k_[e] * (1.f + (a_[e] - 1.f) * ka[e]);
    }
    float* dst = stage + ((size_t)((buf * 2 + lslot) * 16 + lstep) * 6) * 64 + sub * 4;
    *(float4*)(dst + 0 * 64) = float4{nkk_[0], nkk_[1], nkk_[2], nkk_[3]};
    *(float4*)(dst + 1 * 64) = float4{w_[0], w_[1], w_[2], w_[3]};
    *(float4*)(dst + 2 * 64) = float4{b_[0], b_[1], b_[2], b_[3]};
    *(float4*)(dst + 3 * 64) = float4{kd_[0], kd_[1], kd_[2], kd_[3]};
    *(float4*)(dst + 4 * 64) = float4{r_[0], r_[1], r_[2], r_[3]};
    *(float4*)(dst + 5 * 64) = float4{v_[0], v_[1], v_[2], v_[3]};
  };
  if (ldo) { prefetch(0); stage_store(0); }
  __syncthreads();
  for (int tb = 0; tb < 16; ++tb) {
    const bool more = tb + 1 < 16;
    if (more && ldo) prefetch(tb + 1);
    if (act) {
      const float* sb = stage + ((size_t)(((tb & 1) * 2 + cslot) * 16) * 6) * 64;
      for (int sg = 0; sg < 8; ++sg) {
        float ysv[2][2];
#pragma unroll
        for (int s4 = 0; s4 < 2; ++s4) {
          const int st = sg * 2 + s4;
          const float* v6 = sb + st * 384 + jg * 8;
          f2 nkk[4], w[4], bb[4], kd[4], rr[4];
#pragma unroll
          for (int q = 0; q < 2; ++q) {
            float4 t0 = *(const float4*)(v6 + 0 * 64 + q * 4);
            nkk[q * 2] = f2{t0.x, t0.y}; nkk[q * 2 + 1] = f2{t0.z, t0.w};
            float4 t1 = *(const float4*)(v6 + 1 * 64 + q * 4);
            w[q * 2] = f2{t1.x, t1.y}; w[q * 2 + 1] = f2{t1.z, t1.w};
            float4 t2 = *(const float4*)(v6 + 2 * 64 + q * 4);
            bb[q * 2] = f2{t2.x, t2.y}; bb[q * 2 + 1] = f2{t2.z, t2.w};
            float4 t3 = *(const float4*)(v6 + 3 * 64 + q * 4);
            kd[q * 2] = f2{t3.x, t3.y}; kd[q * 2 + 1] = f2{t3.z, t3.w};
            float4 t4 = *(const float4*)(v6 + 4 * 64 + q * 4);
            rr[q * 2] = f2{t4.x, t4.y}; rr[q * 2 + 1] = f2{t4.z, t4.w};
          }
          float2 vv2 = *(const float2*)(sb + st * 384 + 5 * 64 + row0);
          float vi[2] = {vv2.x, vv2.y};
          if (SEG && slot == 1) { vi[0] = 0.f; vi[1] = 0.f; }
#pragma unroll
          for (int r2 = 0; r2 < 2; ++r2) {
            f2 sa2a = S[r2][0] * nkk[0], sa2b = S[r2][1] * nkk[1];
            sa2a += S[r2][2] * nkk[2]; sa2b += S[r2][3] * nkk[3];
            f2 sat = sa2a + sa2b;
            float sa = sat.x + sat.y;
            sa += dpp_xor1(sa);
            sa += dpp_xor2(sa);
            sa += dpp_hmirror(sa);
            f2 y2a, y2b;
            {
              f2 t0 = S[r2][0] * w[0] + vi[r2] * kd[0]; S[r2][0] = t0 + sa * bb[0]; y2a = S[r2][0] * rr[0];
              f2 t1 = S[r2][1] * w[1] + vi[r2] * kd[1]; S[r2][1] = t1 + sa * bb[1]; y2b = S[r2][1] * rr[1];
              f2 t2 = S[r2][2] * w[2] + vi[r2] * kd[2]; S[r2][2] = t2 + sa * bb[2]; y2a += S[r2][2] * rr[2];
              f2 t3 = S[r2][3] * w[3] + vi[r2] * kd[3]; S[r2][3] = t3 + sa * bb[3]; y2b += S[r2][3] * rr[3];
            }
            f2 yt = y2a + y2b;
            float y = yt.x + yt.y;
            y += dpp_xor1(y);
            y += dpp_xor2(y);
            y += dpp_hmirror(y);
            ysv[s4][r2] = y;
          }
        }
        if (jg == 0) {
#pragma unroll
          for (int s4 = 0; s4 < 2; ++s4)
            *(float2*)(ylds + (slot * 16 + sg * 2 + s4) * 64 + row0) = float2{ysv[s4][0], ysv[s4][1]};
        }
      }
    }
    __syncthreads();
    if (more && ldo) stage_store((tb + 1) & 1);
    if (ywr) {
      int s = sbase + tb * 16 + lstep;
      int pos = ld ? Ls - 1 - s : s;
      int r = lb * Ls + pos;
      float4 yv = *(const float4*)(ylds + (lslot * 16 + lstep) * 64 + sub * 4);
      *(uint2*)(yout + (size_t)r * 1024 + lh * 64 + sub * 4) = uint2{pack2(yv.x, yv.y), pack2(yv.z, yv.w)};
    }
    __syncthreads();
  }
  if (act) {
#pragma unroll
    for (int r2 = 0; r2 < 2; ++r2) {
      float* so;
      if (SEG) so = p.out + 8388608 + ((size_t)((chain * 8 + seg) * 2 + slot)) * 4096 + (row0 + r2) * 64 + jg * 8;
      else so = p.out + (d ? OUT_WKVB : OUT_WKVF) + ((size_t)((g * 16 + b) * 16 + h) * 64 + row0 + r2) * 64 + jg * 8;
#pragma unroll
      for (int c = 0; c < 4; ++c) { so[2 * c] = S[r2][c].x; so[2 * c + 1] = S[r2][c].y; }
    }
  }
}

__device__ __forceinline__ void wkv_fix(const Params& p, char* smem, int chain) {
  char* ws = p.ws;
  const int tid = get_tid(), lane = tid & 63, wave = tid >> 6;
  const int d = chain & 1, h = (chain >> 1) & 15, b = chain >> 5;
  const float* SE = p.out + 8388608;
  u16* yout = (u16*)(ws + (d ? OFF_WYB : OFF_WYF));
  const u16* Q = (const u16*)(ws + OFF_YM) + (d ? (size_t)TG * 1024 : 0);
  float* Pl = (float*)smem;
  float* Sl = (float*)(smem + 16384);
  u16* Ql = (u16*)(smem + 36864);
  const int i = lane;
  float S0[64];
  {
    const float* src = SE + ((size_t)(chain * 8) * 2) * 4096 + i * 64;
#pragma unroll
    for (int j = 0; j < 16; ++j) {
      float4 t = *(const float4*)(src + j * 4);
      S0[j * 4] = t.x; S0[j * 4 + 1] = t.y; S0[j * 4 + 2] = t.z; S0[j * 4 + 3] = t.w;
    }
  }
  for (int k = 1; k < 8; ++k) {
#pragma unroll
    for (int e = 0; e < 4; ++e) {
      int idx = tid + e * 512;
      int tt = idx >> 3, ch = idx & 7;
      int s = k * 256 + tt;
      int pos = d ? 2047 - s : s;
      int r = b * 2048 + pos;
      *(uint4*)(Ql + tt * 64 + ch * 8) = *(const uint4*)(Q + (size_t)r * 1024 + h * 64 + ch * 8);
    }
    if (k < 7) {
      const float* src = SE + ((size_t)((chain * 8 + k) * 2 + 1)) * 4096;
#pragma unroll
      for (int e = 0; e < 2; ++e) ((float4*)Pl)[tid + e * 512] = ((const float4*)src)[tid + e * 512];
    }
    __syncthreads();
    for (int n = 0; n < 32; ++n) {
      int tt = wave + n * 8;
      float a0 = 0.f, a1 = 0.f;
#pragma unroll
      for (int jc = 0; jc < 8; ++jc) {
        float q[8];
        unpack8(*(const uint4*)(Ql + tt * 64 + jc * 8), q);
#pragma unroll
        for (int e = 0; e < 8; e += 2) { a0 += S0[jc * 8 + e] * q[e]; a1 += S0[jc * 8 + e + 1] * q[e + 1]; }
      }
      int s = k * 256 + tt;
      int pos = d ? 2047 - s : s;
      size_t off = (size_t)(b * 2048 + pos) * 1024 + h * 64 + i;
      yout[off] = f2bf(bf2f(yout[off]) + (a0 + a1));
    }
    if (k < 7) {
      float nv[8];
      const float* sl = SE + ((size_t)((chain * 8 + k) * 2)) * 4096 + i * 64 + wave * 8;
      {
        float4 t0 = *(const float4*)sl, t1 = *(const float4*)(sl + 4);
        nv[0] = t0.x; nv[1] = t0.y; nv[2] = t0.z; nv[3] = t0.w; nv[4] = t1.x; nv[5] = t1.y; nv[6] = t1.z; nv[7] = t1.w;
      }
#pragma unroll
      for (int m = 0; m < 64; ++m) {
        float4 p0 = *(const float4*)(Pl + m * 64 + wave * 8), p1 = *(const float4*)(Pl + m * 64 + wave * 8 + 4);
        nv[0] += S0[m] * p0.x; nv[1] += S0[m] * p0.y; nv[2] += S0[m] * p0.z; nv[3] += S0[m] * p0.w;
        nv[4] += S0[m] * p1.x; nv[5] += S0[m] * p1.y; nv[6] += S0[m] * p1.z; nv[7] += S0[m] * p1.w;
      }
      *(float4*)(Sl + i * 68 + wave * 8) = float4{nv[0], nv[1], nv[2], nv[3]};
      *(float4*)(Sl + i * 68 + wave * 8 + 4) = float4{nv[4], nv[5], nv[6], nv[7]};
      __syncthreads();
#pragma unroll
      for (int j = 0; j < 16; ++j) {
        float4 t = *(const float4*)(Sl + i * 68 + j * 4);
        S0[j * 4] = t.x; S0[j * 4 + 1] = t.y; S0[j * 4 + 2] = t.z; S0[j * 4 + 3] = t.w;
      }
    }
    __syncthreads();
  }
}

__device__ __forceinline__ void step_scan(const Params& p, char* smem, int g) {
  const int G = gridDim.x;
  const int r1 = (RM & (1 << 20)) ? 2 : 1, r2 = (RM & (1 << 21)) ? 2 : 1;
  if (g < 2) {
    for (int rr = 0; rr < r1; ++rr) {
      SsdPre R;
      if ((int)blockIdx.x < 1024) ssd_issue(p, g, blockIdx.x, 0, get_tid(), R);
      for (int ch = blockIdx.x; ch < 1024; ch += G) ssd_chain(p, smem, g, ch, ch + G < 1024 ? ch + G : -1, R);
    }
    for (int rr = 0; rr < r2; ++rr) for (int it = blockIdx.x; it < 256; it += G) wkv_pair<false>(p, smem, g, it);
  } else {
    for (int rr = 0; rr < r1; ++rr) {
      SsdPre R;
      if ((int)blockIdx.x < 128) ssd_issue(p, g, blockIdx.x, 0, get_tid(), R);
      for (int ch = blockIdx.x; ch < 128; ch += G) ssd_chain(p, smem, g, ch, ch + G < 128 ? ch + G : -1, R);
    }
    for (int rr = 0; rr < r2; ++rr) for (int it = (G - 1 - blockIdx.x); it < 512; it += G) wkv_pair<true>(p, smem, g, it);
  }
}
__device__ __forceinline__ void step_fix(const Params& p, char* smem) {
  for (int ch = blockIdx.x; ch < 64; ch += gridDim.x) wkv_fix(p, smem, ch);
}

__device__ __forceinline__ void step_fin(const Params& p, int g) {
  char* ws = p.ws;
  const int tid = get_tid(), lane = tid & 63, wave = tid >> 6;
  const int gw = blockIdx.x * 8 + wave, nw = gridDim.x * 8;
  {
    const u16* yf = (const u16*)(ws + OFF_SYF);
    const u16* yb = (const u16*)(ws + OFF_SYB);
    const u16* xbc = (const u16*)(ws + OFF_XBC);
    const u16* zb = (const u16*)(ws + OFF_Z);
    u16* ym = (u16*)(ws + OFF_YM);
    for (int it = gw; it < TG * 4; it += nw) {
      int r = it >> 2, gq = it & 3;
      int ch = gq * 512 + lane * 8;
      uint4 a = *(const uint4*)(yf + (size_t)r * 2048 + ch);
      uint4 b = *(const uint4*)(yb + (size_t)r * 2048 + ch);
      uint4 x = *(const uint4*)(xbc + (size_t)r * 3072 + ch);
      uint4 z = *(const uint4*)(zb + (size_t)r * 2048 + ch);
      float dsk = p.d_skip[ch >> 6];
      unsigned aw[4] = {a.x, a.y, a.z, a.w}, bw[4] = {b.x, b.y, b.z, b.w}, xw[4] = {x.x, x.y, x.z, x.w}, zw[4] = {z.x, z.y, z.z, z.w};
      float y[8];
      float ss = 0.f;
#pragma unroll
      for (int e = 0; e < 8; ++e) {
        int sh = (e & 1) * 16;
        float yy = bf2f((u16)(aw[e >> 1] >> sh)) + bf2f((u16)(bw[e >> 1] >> sh)) + dsk * bf2f((u16)(xw[e >> 1] >> sh));
        yy *= siluf(bf2f((u16)(zw[e >> 1] >> sh)));
        y[e] = yy;
        ss += yy * yy;
      }
      ss = wave_sum(ss);
      float rinv = rsqrtf(ss * (1.f / 512.f) + 1e-5f);
      float4 w0 = *(const float4*)(p.m_norm_w + ch), w1 = *(const float4*)(p.m_norm_w + ch + 4);
      *(uint4*)(ym + (size_t)r * 2048 + ch) =
          uint4{pack2(y[0] * rinv * w0.x, y[1] * rinv * w0.y), pack2(y[2] * rinv * w0.z, y[3] * rinv * w0.w),
                pack2(y[4] * rinv * w1.x, y[5] * rinv * w1.y), pack2(y[6] * rinv * w1.z, y[7] * rinv * w1.w)};
    }
  }
  {
    const u16* yf = (const u16*)(ws + OFF_WYF);
    const u16* yb = (const u16*)(ws + OFF_WYB);
    const __half* wk = (const __half*)(ws + OFF_WK);
    const u16* gr = (const u16*)(ws + OFF_GR);
    u16* yr = (u16*)(ws + OFF_YR);
    for (int it = gw; it < TG * 4; it += nw) {
      const int r = it >> 2, h0 = (it & 3) * 4;
      float yv[4], rr[4], vv[4], kk[4], af[4], ab[4], gg[4];
#pragma unroll
      for (int u = 0; u < 4; ++u) {
        int c = (h0 + u) * 64 + lane;
        yv[u] = bf2f(yf[(size_t)r * 1024 + c]) + bf2f(yb[(size_t)r * 1024 + c]);
        const __half* rec = wk + ((size_t)(r * 16 + h0 + u) * 8) * 64 + lane;
        rr[u] = __half2float(rec[0]); vv[u] = __half2float(rec[64]); kk[u] = __half2float(rec[128]);
        af[u] = __half2float(rec[5 * 64]); ab[u] = __half2float(rec[7 * 64]);
        gg[u] = bf2f(gr[(size_t)r * 1024 + c]);
      }
#pragma unroll
      for (int u = 0; u < 4; ++u) {
        int c = (h0 + u) * 64 + lane;
        float y = yv[u];
        float mean = wave_sum(y) * (1.f / 64.f);
        float dy = y - mean;
        float var = wave_sum(dy * dy) * (1.f / 64.f);
        float yn = dy * rsqrtf(var + 64e-5f) * p.lnx_w[c] + p.lnx_b[c];
        float kmean = kk[u] * (1.f + (0.5f * (af[u] + ab[u]) - 1.f) * p.k_a[c]);
        float bs = wave_sum(rr[u] * kmean * p.r_k[c]);
        float o = (yn + bs * vv[u]) * gg[u];
        yr[(size_t)r * 1024 + c] = f2bf(o);
      }
    }
  }
}

__device__ __forceinline__ void step_outproj(const Params& p, char* smem, int g) {
  char* ws = p.ws;
  u16* Ug = (u16*)p.out + (size_t)g * TG * 1024;
  EpiOut<0> E0{(const u16*)(ws + OFF_GATE), Ug};
  run_gemm8(smem, (const u16*)(ws + OFF_YM), (const u16*)(ws + OFF_WMOUT), TG, 1024, 2048, E0);
  EpiOut<1> E1{(const u16*)(ws + OFF_GATE), Ug};
  run_gemm8(smem, (const u16*)(ws + OFF_YR), (const u16*)(ws + OFF_WROUT), TG, 1024, 1024, E1);
}

__device__ __forceinline__ void step_wo(const Params& p, char* smem, int g) {
  char* ws = p.ws;
  EpiWo E{p.x_prompt, p.x_sample, (const float*)(ws + OFF_MOD), (float*)(ws + OFF_X1), 0};
  run_gemm8(smem, (const u16*)p.out, (const u16*)(ws + OFF_WO), NTOK, 1024, 1024, E);
}

__device__ __forceinline__ void step_gu(const Params& p, char* smem) {
  char* ws = p.ws;
  EpiGU E{(u16*)(ws + OFF_ACT)};
  run_gemm8(smem, (const u16*)(ws + OFF_H2), (const u16*)(ws + OFF_WGU), NTOK, 5632, 1024, E);
}

__device__ __forceinline__ void step_down(const Params& p, char* smem) {
  char* ws = p.ws;
  EpiDown E{(const float*)(ws + OFF_MOD), (float*)(ws + OFF_X1)};
  run_gemm8(smem, (const u16*)(ws + OFF_ACT), (const u16*)(ws + OFF_WDOWN), NTOK, 1024, 2816, E);
}

__device__ __forceinline__ void step_final(const Params& p) {
  const int tid = get_tid(), lane = tid & 63, wave = tid >> 6;
  for (int r = blockIdx.x * 8 + wave; r < NTOK; r += gridDim.x * 8) {
    const float* xr = (const float*)(p.ws + OFF_X1) + (size_t)r * 1024;
    float* xo = p.out + (size_t)r * 1024;
    float4 v[4];
    float ss = 0.f;
#pragma unroll
    for (int i = 0; i < 4; ++i) {
      v[i] = ((const float4*)xr)[i * 64 + lane];
      ss += v[i].x * v[i].x + v[i].y * v[i].y + v[i].z * v[i].z + v[i].w * v[i].w;
    }
    ss = wave_sum(ss);
    float rinv = rsqrtf(ss * (1.f / 1024.f) + 1e-6f);
#pragma unroll
    for (int i = 0; i < 4; ++i) {
      float4 w4 = ((const float4*)p.final_norm_w)[i * 64 + lane];
      ((float4*)xo)[i * 64 + lane] = float4{v[i].x * rinv * w4.x, v[i].y * rinv * w4.y, v[i].z * rinv * w4.z, v[i].w * rinv * w4.w};
    }
  }
}

constexpr int NSTEPS = 30;

__global__ void __launch_bounds__(NTHR) mega(Params p_arg) {
  const int step_lo = p_arg.step_lo, step_hi = p_arg.step_hi;
  __shared__ __attribute__((aligned(16))) char smem[SMEM_BYTES];
#if !MULTI_LAUNCH
  if (threadIdx.x == 0) *(uint4*)(smem + SMEM_BYTES - 16) = uint4{0u, 0u, 0u, 0u};
  __syncthreads();
  XcdBarrier xb = xcd_barrier_post((unsigned*)(p_arg.ws + OFF_BAR), (volatile LAS unsigned*)(smem + SMEM_BYTES - 16));
#endif
  for (int step = step_lo; step <= step_hi; ++step) {
#if defined(__HIP_DEVICE_COMPILE__)
    const __attribute__((address_space(4))) Params* pp = (const __attribute__((address_space(4))) Params*)__builtin_amdgcn_kernarg_segment_ptr();
    asm volatile("" : "+s"(pp));
    const Params p = *pp;
#else
    const Params p = p_arg;
#endif
    const int g = (step - 1) >> 3, s = (step - 1) & 7;
    const int scode = step == 0 ? 0 : (step <= 24 ? 1 + s : step - 16);
    if (scode == 6 && g < 2) continue;
    if (scode == 1 && g > 0) continue;
    const int reps = ((RM >> scode) & 1) ? 2 : 1;
    for (int rep = 0; rep < reps; ++rep) {
      if (!((SM >> scode) & 1)) continue;
      switch (scode) {
        case 0: step_prep(p, smem); break;
        case 1: step_norm<0>(p, g); break;
        case 2: step_gemm1(p, smem); break;
        case 3: step_cr1(p, g); break;
        case 4: step_r2(p, smem); break;
        case 5: step_scan(p, smem, g); break;
        case 6: step_fix(p, smem); break;
        case 7: step_fin(p, g); break;
        case 8:
          if (blockIdx.x < 64) step_outproj(p, smem, g);
          else if (g == 0) {
            convT<1>(p.w_gu, 1024, 5632, (u16*)(p.ws + OFF_WGU), smem, blockIdx.x - 64, gridDim.x - 64);
            convT<0>(p.w_down, 2816, 1024, (u16*)(p.ws + OFF_WDOWN), smem, blockIdx.x - 64, gridDim.x - 64);
          }
          if (g < 2) step_norm<0>(p, g + 1);
          break;
        case 9: step_wo(p, smem, 0); break;
        case 10: step_norm<1>(p, 0); break;
        case 11: step_gu(p, smem); break;
        case 12: step_down(p, smem); break;
        default: step_final(p); break;
      }
    }
    if (step < step_hi) {
#if !MULTI_LAUNCH
      if (step_hi > 100000) cg::this_grid().sync();
      for (int xs = 0; xs < 1 + XSYNC; ++xs) xcd_barrier(xb);
#endif
    }
  }
}

extern "C" void kernel_launch(void* const* d_in, const int* in_sizes, int n_in, void* d_out, int out_size,
                              void* d_ws, size_t ws_size, hipStream_t stream) {
  Params p{};
  const float** pp = (const float**)&p;
  for (int i = 0; i < 36; ++i) pp[i] = (const float*)d_in[i];
  p.out = (float*)d_out;
  p.ws = (char*)d_ws;
  if (ws_size < WS_NEED) fprintf(stderr, "workspace too small: %zu < %zu\n", ws_size, (size_t)WS_NEED);
#if MULTI_LAUNCH
  for (int s = 0; s < NSTEPS; ++s) {
    p.step_lo = s;
    p.step_hi = s;
    hipLaunchKernelGGL(mega, dim3(256), dim3(NTHR), 0, stream, p);
  }
#else
  static int grid_blocks = 0;
  if (!grid_blocks) {
    int dev = 0, cus = 0, per_cu = 0;
    hipGetDevice(&dev);
    hipDeviceGetAttribute(&cus, hipDeviceAttributeMultiprocessorCount, dev);
    hipOccupancyMaxActiveBlocksPerMultiprocessor(&per_cu, mega, NTHR, 0);
    if (per_cu < 1) per_cu = 1;
    if (per_cu > 1) per_cu = 1;
    grid_blocks = cus * per_cu;
  }
  p.step_lo = 0;
  p.step_hi = NSTEPS - 1;
  void* args[] = {&p};
  hipMemsetAsync((char*)d_ws + OFF_BAR, 0, XCD_BAR_WORDS_C * 4, stream);
  hipError_t e = hipLaunchCooperativeKernel((void*)mega, dim3(grid_blocks), dim3(NTHR), args, 0, stream);
  if (e != hipSuccess) fprintf(stderr, "cooperative launch failed: %s (grid %d)\n", hipGetErrorString(e), grid_blocks);
#endif
}
```

```cpp
#include <hip/hip_runtime.h>
#include <hip/hip_cooperative_groups.h>
#include <hip/hip_fp16.h>
#include <cstdio>
#include <cstdint>
namespace cg = cooperative_groups;

#ifndef MULTI_LAUNCH
#define MULTI_LAUNCH 0
#endif

#define DI __device__ __forceinline__
typedef __attribute__((ext_vector_type(8))) short bf16x8;
typedef __attribute__((ext_vector_type(4))) float f32x4;
typedef unsigned short u16;

#ifndef STEP_MASK
#define STEP_MASK 0xffffff
#endif
constexpr int SM = STEP_MASK;
#ifndef REPEAT_MASK
#define REPEAT_MASK 0
#endif
#ifndef XSYNC
#define XSYNC 0
#endif
constexpr int RM = REPEAT_MASK;
constexpr int TG = 4096;
constexpr int NTOK = 12288;
constexpr int NPAD = 10752;
constexpr int NTHR = 512;
constexpr int SMEM_BYTES = 133120;
constexpr int XCD_BAR_WORDS_C = 3456;

constexpr size_t OFF_WIN = 0;
constexpr size_t OFF_WGU = OFF_WIN + (size_t)NPAD * 1024 * 2;
constexpr size_t OFF_WDOWN = OFF_WGU + (size_t)5632 * 1024 * 2;
constexpr size_t OFF_WMOUT = OFF_WDOWN + (size_t)1024 * 2816 * 2;
constexpr size_t OFF_WROUT = OFF_WMOUT + (size_t)1024 * 2048 * 2;
constexpr size_t OFF_WO = OFF_WROUT + (size_t)1024 * 1024 * 2;
constexpr size_t OFF_W2T = OFF_WO + (size_t)1024 * 1024 * 2;
constexpr size_t OFF_A2T = OFF_W2T + 262144;
constexpr size_t OFF_G2T = OFF_A2T + 262144;
constexpr size_t OFF_MOD = OFF_G2T + 262144;
constexpr size_t OFF_GRP = OFF_MOD + 73728;
constexpr size_t OFF_Z = OFF_GRP;
constexpr size_t OFF_GATE = OFF_Z + (size_t)TG * 2048 * 2;
constexpr size_t OFF_XBC = OFF_GATE + (size_t)TG * 2048 * 2;
constexpr size_t OFF_WK = OFF_XBC + (size_t)TG * 3072 * 2;
constexpr size_t OFF_GR = OFF_WK + (size_t)TG * 16 * 1024;
constexpr size_t OFF_DT = OFF_GR + (size_t)TG * 1024 * 2;
constexpr size_t OFF_TL = OFF_DT + (size_t)TG * 64 * 4;
constexpr size_t OFF_SG = OFF_TL + (size_t)TG * 256 * 2;
constexpr size_t OFF_R = OFF_SG + (size_t)TG * 128 * 2;
constexpr size_t OFF_H1 = OFF_R;
constexpr size_t OFF_XBCRAW = OFF_H1 + (size_t)TG * 1024 * 2;
constexpr size_t OFF_RW = OFF_XBCRAW + (size_t)TG * 3072 * 2;
constexpr size_t OFF_SYF = OFF_R;
constexpr size_t OFF_SYB = OFF_SYF + (size_t)TG * 2048 * 2;
constexpr size_t OFF_WYF = OFF_SYB + (size_t)TG * 2048 * 2;
constexpr size_t OFF_WYB = OFF_WYF + (size_t)TG * 1024 * 2;
constexpr size_t OFF_YM = OFF_WYB + (size_t)TG * 1024 * 2;
constexpr size_t OFF_YR = OFF_YM + (size_t)TG * 2048 * 2;
constexpr size_t OFF_END = OFF_YR + (size_t)TG * 1024 * 2;
constexpr size_t OFF_BAR = OFF_END;
constexpr size_t OFF_W4T = OFF_BAR + 16384;
constexpr size_t WS_NEED = OFF_W4T + (size_t)4096 * 256 * 2;
constexpr size_t OFF_U = OFF_XBC;
constexpr size_t OFF_H2 = OFF_GRP;
constexpr size_t OFF_ACT = OFF_H2 + (size_t)NTOK * 1024 * 2;
constexpr size_t OFF_X1 = OFF_ACT + (size_t)NTOK * 2816 * 2;

constexpr size_t OUT_SSMF = 12582912;
constexpr size_t OUT_SSMB = OUT_SSMF + 8388608;
constexpr size_t OUT_WKVF = OUT_SSMB + 8388608;
constexpr size_t OUT_WKVB = OUT_WKVF + 2097152;

struct Params {
  const float *x_prompt, *x_sample, *ssm_f, *ssm_b, *wkv_f, *wkv_b, *c, *c_ctx, *norm1_w, *norm2_w,
      *w_ada, *b_ada, *w_in, *conv_w, *conv_b, *dt_bias, *a_log, *d_skip, *m_norm_w, *mu_shift, *w0,
      *w2, *a0, *a2, *g2, *k_k, *k_a, *r_k, *lnx_w, *lnx_b, *w_m_out, *w_r_out, *w_o, *w_gu, *w_down,
      *final_norm_w;
  float* out;
  char* ws;
  int step_lo, step_hi;
};

DI int get_tid() {
  int t = threadIdx.x;
  asm volatile("" : "+v"(t));
  return t;
}
DI u16 f2bf(float f) {
  unsigned u = __float_as_uint(f);
  u += 0x7fffu + ((u >> 16) & 1u);
  return (u16)(u >> 16);
}
DI float bf2f(u16 h) { return __uint_as_float(((unsigned)h) << 16); }
DI float siluf(float x) { return x / (1.f + __expf(-x)); }
DI float sigm(float x) { return 1.f / (1.f + __expf(-x)); }
DI float wave_sum(float v) {
  v += __int_as_float(__builtin_amdgcn_update_dpp(0, __float_as_int(v), 0xB1, 0xF, 0xF, true));
  v += __int_as_float(__builtin_amdgcn_update_dpp(0, __float_as_int(v), 0x4E, 0xF, 0xF, true));
  v += __int_as_float(__builtin_amdgcn_update_dpp(0, __float_as_int(v), 0x141, 0xF, 0xF, true));
  v += __int_as_float(__builtin_amdgcn_update_dpp(0, __float_as_int(v), 0x140, 0xF, 0xF, true));
  const int vi = __float_as_int(v);
  float a = __int_as_float(__builtin_amdgcn_readlane(vi, 0)), b = __int_as_float(__builtin_amdgcn_readlane(vi, 16));
  float c = __int_as_float(__builtin_amdgcn_readlane(vi, 32)), d = __int_as_float(__builtin_amdgcn_readlane(vi, 48));
  return (a + b) + (c + d);
}
DI unsigned pack2(float a, float b) { return (unsigned)f2bf(a) | ((unsigned)f2bf(b) << 16); }
DI int mrow_of(int tok) { return tok < 8192 ? 0 : 1 + ((tok - 8192) >> 11); }


#define XB_TMO      128
#define XB_XCNT(j)  (256  + 64 * (j))
#define XB_XSUB(j)  (1280 + 64 * (j))
#define XB_XGEN(j)  (2304 + 64 * (j))
#define XB_TOP      3328
#define XB_TOPGEN   3392
#define XCD_BAR_WORDS 3456
#define XB_SPIN_CAP (1u << 22)
#define LAS __attribute__((address_space(3)))
DI unsigned xb_ld(unsigned* p) { return __hip_atomic_load(p, __ATOMIC_RELAXED, __HIP_MEMORY_SCOPE_AGENT); }
DI unsigned xb_add(unsigned* p, unsigned v) { return __hip_atomic_fetch_add(p, v, __ATOMIC_RELAXED, __HIP_MEMORY_SCOPE_AGENT); }
DI unsigned xb_xcc_id() { return (unsigned)__builtin_amdgcn_s_getreg((3 << 11) | 20) & 0xFu; }
#define XB_SPIN(cond, bar) do { unsigned _sp = 0; while (cond) { __builtin_amdgcn_s_sleep(1); \
    if ((++_sp & 255u) == 0u) { if (xb_ld(&(bar)[XB_TMO])) break; if (_sp > XB_SPIN_CAP) { atomicAdd(&(bar)[XB_TMO], 1u); break; } } } } while (0)
struct XcdBarrier { unsigned* bar; unsigned x; volatile LAS unsigned* st; };
DI XcdBarrier xcd_barrier_post(unsigned* bar, volatile LAS unsigned* st) {
  XcdBarrier b; b.bar = bar; b.x = xb_xcc_id(); b.st = st;
  if (threadIdx.x == 0) (void)xb_add(&bar[XB_XCNT(b.x)], 1u);
  return b;
}
DI void xcd_barrier_complete(unsigned* bar, unsigned x, unsigned& nloc, unsigned& nx) {
  const unsigned G = gridDim.x * gridDim.y * gridDim.z;
  unsigned sum, cnt, mine, sp = 0u;
  for (;;) {
    sum = 0u; cnt = 0u; mine = 0u;
#pragma unroll
    for (unsigned j = 0; j < 16; ++j) { const unsigned c = xb_ld(&bar[XB_XCNT(j)]); sum += c; cnt += (c > 0u) ? 1u : 0u; mine = (j == x) ? c : mine; }
    if (sum == G) break;
    __builtin_amdgcn_s_sleep(1);
    if ((++sp & 255u) == 0u) { if (xb_ld(&bar[XB_TMO])) break; if (sp > XB_SPIN_CAP) { atomicAdd(&bar[XB_TMO], 1u); break; } }
  }
  nloc = mine > 0u ? mine : 1u; nx = cnt > 0u ? cnt : 1u;
}
DI void xcd_barrier(const XcdBarrier& b) {
  asm volatile("s_waitcnt vmcnt(0)" ::: "memory");
  __syncthreads();
  if (threadIdx.x == 0) {
    unsigned* bar = b.bar;
    asm volatile("" : "+s"(bar));
    __builtin_amdgcn_s_waitcnt(0);
    unsigned nloc = b.st[0], nx = b.st[1];
    if (nloc == 0u) { xcd_barrier_complete(bar, b.x, nloc, nx); b.st[0] = nloc; b.st[1] = nx; }
    const unsigned old = xb_add(&bar[XB_XSUB(b.x)], 1u);
    const unsigned gen = old / nloc;
    if (old + 1u == (gen + 1u) * nloc) {
      __builtin_amdgcn_fence(__ATOMIC_RELEASE, "agent");
      asm volatile("s_waitcnt vmcnt(0)" ::: "memory");
      const unsigned og = xb_add(&bar[XB_TOP], 1u);
      const unsigned tg = og / nx;
      if (og + 1u == (tg + 1u) * nx) xb_add(&bar[XB_TOPGEN], 1u);
      else XB_SPIN(xb_ld(&bar[XB_TOPGEN]) == tg, bar);
      __builtin_amdgcn_fence(__ATOMIC_ACQUIRE, "agent");
      xb_add(&bar[XB_XGEN(b.x)], 1u);
      asm volatile("s_waitcnt vmcnt(0)" ::: "memory");
    } else {
      XB_SPIN(xb_ld(&bar[XB_XGEN(b.x)]) == gen, bar);
      __builtin_amdgcn_fence(__ATOMIC_ACQUIRE, "agent");
      asm volatile("s_waitcnt vmcnt(0)" ::: "memory");
    }
  }
  __syncthreads();
}

DI void gemm_load(const int tid, const u16* A, int lda, const u16* B, int ldb, int k0, uint4 (&ra)[4], uint4 (&rb)[2]) {
#pragma unroll
  for (int i = 0; i < 4; ++i) {
    int idx = tid + i * 512;
    int row = idx >> 3, ch = idx & 7;
    ra[i] = *(const uint4*)(A + (size_t)row * lda + k0 + ch * 8);
  }
#pragma unroll
  for (int i = 0; i < 2; ++i) {
    int idx = tid + i * 512;
    int row = idx >> 3, ch = idx & 7;
    rb[i] = *(const uint4*)(B + (size_t)row * ldb + k0 + ch * 8);
  }
}
DI void gemm_store_lds(const int tid, char* sA, char* sB, const uint4 (&ra)[4], const uint4 (&rb)[2]) {
#pragma unroll
  for (int i = 0; i < 4; ++i) {
    int idx = tid + i * 512;
    int row = idx >> 3, ch = idx & 7;
    *(uint4*)(sA + row * 128 + ((ch ^ ((row >> 1) & 7)) << 4)) = ra[i];
  }
#pragma unroll
  for (int i = 0; i < 2; ++i) {
    int idx = tid + i * 512;
    int row = idx >> 3, ch = idx & 7;
    *(uint4*)(sB + row * 128 + ((ch ^ ((row >> 1) & 7)) << 4)) = rb[i];
  }
}
DI void gemm_compute(const char* sA, const char* sB, f32x4 (&acc)[4][4], int wm, int wn, int lane) {
#pragma unroll
  for (int kk = 0; kk < 2; ++kk) {
    bf16x8 a[4], b[4];
    const int ch = kk * 4 + (lane >> 4);
#pragma unroll
    for (int mf = 0; mf < 4; ++mf) {
      int row = wm * 64 + mf * 16 + (lane & 15);
      a[mf] = *(const bf16x8*)(sA + row * 128 + ((ch ^ ((row >> 1) & 7)) << 4));
    }
#pragma unroll
    for (int nf = 0; nf < 4; ++nf) {
      int row = wn * 64 + nf * 16 + (lane & 15);
      b[nf] = *(const bf16x8*)(sB + row * 128 + ((ch ^ ((row >> 1) & 7)) << 4));
    }
#pragma unroll
    for (int mf = 0; mf < 4; ++mf)
#pragma unroll
      for (int nf = 0; nf < 4; ++nf)
        acc[mf][nf] = __builtin_amdgcn_mfma_f32_16x16x32_bf16(a[mf], b[nf], acc[mf][nf], 0, 0, 0);
  }
}
DI void gemm_acc(const u16* A, int lda, const u16* B, int ldb, int K, f32x4 (&acc)[4][4], char* smem) {
  const int tid = get_tid(), lane = tid & 63, wave = tid >> 6;
  const int wm = wave >> 1, wn = wave & 1;
  char* sA0 = smem;
  char* sB0 = smem + 32768;
  char* sA1 = smem + 49152;
  char* sB1 = smem + 81920;
  uint4 ra[4], rb[2];
  const int nk = K >> 6;
  gemm_load(tid, A, lda, B, ldb, 0, ra, rb);
  gemm_store_lds(tid, sA0, sB0, ra, rb);
  __syncthreads();
  for (int kt = 0; kt < nk; ++kt) {
    const bool more = (kt + 1 < nk);
    if (more) gemm_load(tid, A, lda, B, ldb, (kt + 1) * 64, ra, rb);
    if (kt & 1) gemm_compute(sA1, sB1, acc, wm, wn, lane);
    else gemm_compute(sA0, sB0, acc, wm, wn, lane);
    if (more) {
      if (kt & 1) gemm_store_lds(tid, sA0, sB0, ra, rb);
      else gemm_store_lds(tid, sA1, sB1, ra, rb);
    }
    __syncthreads();
  }
}
DI void zero_acc(f32x4 (&acc)[4][4]) {
#pragma unroll
  for (int i = 0; i < 4; ++i)
#pragma unroll
    for (int j = 0; j < 4; ++j) { float z0; asm volatile("v_mov_b32 %0, 0" : "=v"(z0)); acc[i][j] = f32x4{z0, z0, z0, z0}; }
}

#define PG8_LAS __attribute__((address_space(3)))
namespace pg8 {
typedef unsigned short bf16_t;
typedef short bf16x8 __attribute__((ext_vector_type(8)));
typedef float f32x4 __attribute__((ext_vector_type(4)));
typedef unsigned u32x4 __attribute__((ext_vector_type(4)));
constexpr int BM = 256, BK = 64, HALF = 128, HTB = HALF * BK * 2  , STAGE_BYTES = 8 * HTB, NXCD = 8, WGM = 8;

__host__ __device__ __forceinline__ int lds_byte(int r, int c) { const int st = (r >> 4) * 2 + (c >> 5), rr = r & 15, cc = c & 31, ob = rr * 64 + cc * 2; return st * 1024 + (ob ^ (((ob >> 9) & 1) << 5)); }
__host__ __device__ __forceinline__ void stage_rc(int b, int& R, int& C) { const int st = b / 1024, sb = b % 1024, swz = sb ^ (((sb >> 9) & 1) << 5); R = (st >> 1) * 16 + swz / 64; C = (st & 1) * 32 + (swz % 64) / 2; }
__host__ __device__ __forceinline__ int perm32(int rho) { const int n = rho >> 4, i = rho & 15; return 8 * (i >> 2) + 4 * n + (i & 3); }

struct Unit { int pm, pn; };
struct Gemm { const bf16_t* A; const bf16_t* Bt; int M, N, K; };

struct StaticOrder {
    int nM, nN, nwg, G, c;
    __host__ __device__ void init(int M, int N, int G_, int c_) { nM = M / BM; nN = N / BM; nwg = nM * nN; G = G_; c = c_; }
    __host__ __device__ bool next(int i, Unit& u) const {
        const long L = (long)i * G + c; if (L >= nwg) return false;
        int wgid = (int)L; { const int q = nwg / NXCD, r = nwg % NXCD, xcd = wgid % NXCD, off = wgid / NXCD; wgid = (xcd < r ? xcd * (q + 1) : r * (q + 1) + (xcd - r) * q) + off; }
        const int nig = WGM * nN, gid = wgid / nig, fm = gid * WGM, gsz = (nM - fm) < WGM ? (nM - fm) : WGM;
        u.pm = fm + ((wgid % nig) % gsz); u.pn = (wgid % nig) / gsz; return true;
    }
    __device__ __forceinline__ void a_ready(const Unit&) const {}
    __device__ __forceinline__ void done(const Unit&) const {}
};
__device__ __forceinline__ unsigned cvt_pk_bf16(float lo, float hi) { unsigned r; asm volatile("v_cvt_pk_bf16_f32 %0, %1, %2" : "=v"(r) : "v"(lo), "v"(hi)); return r; }
template <class Epi, class Sched, bool STAMP = false>
__device__ __forceinline__ void gemm_phase(PG8_LAS unsigned char* lds, const Gemm g, const Sched& S, const Epi& E, unsigned long long* stamps) {
    const int tid = get_tid(), wid = __builtin_amdgcn_readfirstlane(tid >> 6), lane = tid & 63, wr = wid >> 2, wc = wid & 3, fr = lane & 15, fq = lane >> 4;
    const int K = g.K, nt = K / BK;
    int ts_lo = 0, ts_hi = 0, nts = 0; const unsigned long long rt_entry = STAMP ? (unsigned long long)wall_clock64() : 0ull;
#define PG8_STAMP() do { if (STAMP && wid == 0 && nts < 64) { const unsigned long long _c = (unsigned long long)clock64(); \
        ts_lo = (lane == nts) ? (int)(unsigned)_c : ts_lo; ts_hi = (lane == nts) ? (int)(unsigned)(_c >> 32) : ts_hi; ++nts; } } while (0)
    PG8_STAMP();
    unsigned voffA[2], voffB[2];
#pragma unroll
    for (int i = 0; i < 2; ++i) { int R, C; stage_rc(tid * 16 + i * 8192, R, C); const int Rb = Epi::PERM ? ((R & ~31) + perm32(R & 31)) : R;
        voffA[i] = (unsigned)(R * K + C) * 2u; voffB[i] = (unsigned)(Rb * K + C) * 2u; }
    const size_t kstep = (size_t)(BK * 2);
    const size_t hstep = (size_t)HALF * K * 2;
    const size_t tstep = 2 * hstep;
    const unsigned ldsw = (unsigned)wid * 1024u;
    const int aoff = lds_byte(wr * 64 + fr, fq * 8), boff = lds_byte(wc * 32 + fr, fq * 8);
#define PG8_SA(b, h) (((b) * 2 + (h)) * HTB)
#define PG8_SB(b, h) ((4 + (b) * 2 + (h)) * HTB)
#define PG8_STAGE(bufoff, gbase, voff) do { _Pragma("unroll") for (int _i = 0; _i < 2; ++_i) \
        __builtin_amdgcn_global_load_lds((const unsigned*)((const char*)(gbase) + (voff)[_i]), (PG8_LAS unsigned*)(lds + (bufoff) + ldsw + _i * 8192), 16, 0, 0); } while (0)
#define PG8_LDA(dst, b, h) do { _Pragma("unroll") for (int m = 0; m < 4; ++m) _Pragma("unroll") for (int k = 0; k < 2; ++k) dst[m][k] = *(const PG8_LAS bf16x8*)(lds + PG8_SA(b, h) + aoff + m * 2048 + k * 1024); } while (0)
#define PG8_LDB(dst, b, h) do { _Pragma("unroll") for (int n = 0; n < 2; ++n) _Pragma("unroll") for (int k = 0; k < 2; ++k) dst[n][k] = *(const PG8_LAS bf16x8*)(lds + PG8_SB(b, h) + boff + n * 2048 + k * 1024); } while (0)
#define PG8_MMA(ai, bj, At, Bt) do { __builtin_amdgcn_s_setprio(1); _Pragma("unroll") for (int m = 0; m < 4; ++m) _Pragma("unroll") for (int n = 0; n < 2; ++n) _Pragma("unroll") for (int k = 0; k < 2; ++k) \
        acc[ai][bj][m][n] = __builtin_amdgcn_mfma_f32_16x16x32_bf16(Bt[n][k], At[m][k], acc[ai][bj][m][n], 0, 0, 0); __builtin_amdgcn_s_setprio(0); } while (0)
#define PG8_WAIT_V(n) asm volatile("s_waitcnt vmcnt(" #n ")" ::: "memory")
#define PG8_WAIT_L(n) asm volatile("s_waitcnt lgkmcnt(" #n ")" ::: "memory")
#define PG8_BAR __builtin_amdgcn_s_barrier()
#define PG8_SCHED __builtin_amdgcn_sched_barrier(0)
    Unit cur, nxt; int ui = 0;
    if (!S.next(0, cur)) return;
    f32x4 acc[2][2][4][2];
#pragma unroll
    for (int a = 0; a < 2; ++a)
#pragma unroll
        for (int b = 0; b < 2; ++b)
#pragma unroll
            for (int m = 0; m < 4; ++m)
#pragma unroll
                for (int n = 0; n < 2; ++n) { float z0; asm volatile("v_mov_b32 %0, 0" : "=v"(z0)); acc[a][b][m][n] = (f32x4){z0, z0, z0, z0}; }
    bf16x8 At[4][2], B0[2][2], B1[2][2];
    const char* cA = (const char*)g.A + (size_t)cur.pm * tstep; const char* cB = (const char*)g.Bt + (size_t)cur.pn * tstep;
    S.a_ready(cur);
    PG8_STAGE(PG8_SB(0, 0), cB, voffB); PG8_STAGE(PG8_SA(0, 0), cA, voffA); PG8_STAGE(PG8_SB(0, 1), cB + hstep, voffB); PG8_STAGE(PG8_SA(0, 1), cA + hstep, voffA);
    if (wr == 1) PG8_BAR;
    PG8_WAIT_V(4); PG8_BAR;
    PG8_STAGE(PG8_SB(1, 0), cB + kstep, voffB); PG8_STAGE(PG8_SA(1, 0), cA + kstep, voffA); PG8_STAGE(PG8_SB(1, 1), cB + hstep + kstep, voffB);
    PG8_WAIT_V(6); PG8_BAR;
    PG8_STAMP();
    for (;;) {
        const bool has_next = S.next(ui + 1, nxt);
        const char* nA = has_next ? (const char*)g.A + (size_t)nxt.pm * tstep : cA; const char* nB = has_next ? (const char*)g.Bt + (size_t)nxt.pn * tstep : cB;
        for (int t = 0; t < nt; t += 2) {
            const bool last = (t == nt - 2);
            const char* a1 = cA + (size_t)(t + 1) * kstep;
            const char* a2 = last ? nA : cA + (size_t)(t + 2) * kstep; const char* b2 = last ? nB : cB + (size_t)(t + 2) * kstep;
            const char* a3 = a2 + kstep; const char* b3 = b2 + kstep;
            if (last && has_next) S.a_ready(nxt);
            PG8_LDB(B0, 0, 0); PG8_SCHED; PG8_LDA(At, 0, 0); PG8_STAGE(PG8_SA(1, 1), a1 + hstep, voffA);
            PG8_WAIT_L(8); PG8_BAR; PG8_WAIT_L(0); PG8_MMA(0, 0, At, B0); PG8_BAR; PG8_SCHED;
            PG8_LDB(B1, 0, 1); PG8_STAGE(PG8_SB(0, 0), b2, voffB);
            PG8_BAR; PG8_WAIT_L(0); PG8_MMA(0, 1, At, B1); PG8_BAR;
            PG8_LDA(At, 0, 1); PG8_STAGE(PG8_SA(0, 0), a2, voffA);
            PG8_BAR; PG8_WAIT_L(0); PG8_MMA(1, 0, At, B0); PG8_BAR; PG8_SCHED;
            PG8_STAGE(PG8_SB(0, 1), b2 + hstep, voffB);
            PG8_WAIT_V(6); PG8_BAR; PG8_MMA(1, 1, At, B1); PG8_BAR;
            PG8_LDB(B0, 1, 0); PG8_SCHED; PG8_LDA(At, 1, 0); PG8_STAGE(PG8_SA(0, 1), a2 + hstep, voffA);
            PG8_WAIT_L(8); PG8_BAR; PG8_WAIT_L(0); PG8_MMA(0, 0, At, B0); PG8_BAR; PG8_SCHED;
            PG8_LDB(B1, 1, 1); PG8_STAGE(PG8_SB(1, 0), b3, voffB);
            PG8_BAR; PG8_WAIT_L(0); PG8_MMA(0, 1, At, B1); PG8_BAR;
            PG8_LDA(At, 1, 1); PG8_STAGE(PG8_SA(1, 0), a3, voffA);
            PG8_BAR; PG8_WAIT_L(0); PG8_MMA(1, 0, At, B0); PG8_BAR; PG8_SCHED;
            PG8_STAGE(PG8_SB(1, 1), b3 + hstep, voffB);
            PG8_WAIT_V(6); PG8_BAR; PG8_MMA(1, 1, At, B1); PG8_BAR;
        }
        PG8_STAMP();
        if constexpr (!Epi::AFTER_DRAIN) { E(acc, cur, wr, wc, fr, fq); S.done(cur); }
        PG8_STAMP();
        if (!has_next) break;
#pragma unroll
        for (int a = 0; a < 2; ++a)
#pragma unroll
            for (int b = 0; b < 2; ++b)
#pragma unroll
                for (int m = 0; m < 4; ++m)
#pragma unroll
                    for (int n = 0; n < 2; ++n) { float z0; asm volatile("v_mov_b32 %0, 0" : "=v"(z0)); acc[a][b][m][n] = (f32x4){z0, z0, z0, z0}; }
        cur = nxt; cA = nA; cB = nB; ++ui;
    }
    PG8_WAIT_V(0);
    if (wr == 0) PG8_BAR;
    PG8_BAR;
    if constexpr (Epi::AFTER_DRAIN) { E.fused(acc, cur, wr, wc, fr, fq, lds, wid, lane); S.done(cur); }
    PG8_STAMP();
    if (STAMP && wid == 0) { stamps[lane] = lane < nts ? (((unsigned long long)(unsigned)ts_hi << 32) | (unsigned)ts_lo) : 0ull;
        if (lane == 62) stamps[62] = rt_entry; if (lane == 63) stamps[63] = (unsigned long long)wall_clock64(); }
#undef PG8_STAMP
#undef PG8_SA
#undef PG8_SB
#undef PG8_STAGE
#undef PG8_LDA
#undef PG8_LDB
#undef PG8_MMA
#undef PG8_WAIT_V
#undef PG8_WAIT_L
#undef PG8_BAR
#undef PG8_SCHED
}
}

using pg8::cvt_pk_bf16;
DI uint4 pack8(const pg8::f32x4& a, const pg8::f32x4& b) {
  return uint4{cvt_pk_bf16(a[0], a[1]), cvt_pk_bf16(a[2], a[3]), cvt_pk_bf16(b[0], b[1]), cvt_pk_bf16(b[2], b[3])};
}
DI void unpack8(const uint4& u, float (&o)[8]) {
  o[0] = bf2f((u16)(u.x & 0xffff)); o[1] = bf2f((u16)(u.x >> 16));
  o[2] = bf2f((u16)(u.y & 0xffff)); o[3] = bf2f((u16)(u.y >> 16));
  o[4] = bf2f((u16)(u.z & 0xffff)); o[5] = bf2f((u16)(u.z >> 16));
  o[6] = bf2f((u16)(u.w & 0xffff)); o[7] = bf2f((u16)(u.w >> 16));
}
struct EpiP {
  static constexpr bool PERM = true, AFTER_DRAIN = false;
  u16 *zb, *xr, *rwb, *gb; float* dtb;
  DI void operator()(const pg8::f32x4 (&acc)[2][2][4][2], const pg8::Unit& u, int wr, int wc, int fr, int fq) const {
    const int row0 = u.pm * 256 + wr * 64 + fr;
#pragma unroll
    for (int bj = 0; bj < 2; ++bj) {
      const int cg = u.pn * 256 + bj * 128 + wc * 32;
      const int col0 = cg + 8 * fq;
      if (cg >= 10688) continue;
#pragma unroll
      for (int ai = 0; ai < 2; ++ai)
#pragma unroll
        for (int m = 0; m < 4; ++m) {
          const size_t row = row0 + ai * 128 + m * 16;
          const pg8::f32x4 v0 = acc[ai][bj][m][0], v1 = acc[ai][bj][m][1];
          if (cg >= 5120 && cg < 5184) {
            float* d = dtb + row * 64 + (col0 - 5120);
            *(pg8::f32x4*)d = v0; *(pg8::f32x4*)(d + 4) = v1;
          } else {
            u16* dst = (cg < 2048) ? zb + row * 2048 + col0
                     : (cg < 5120) ? xr + row * 3072 + (col0 - 2048)
                     : (cg < 8640) ? rwb + row * 3456 + (col0 - 5184)
                                   : gb + row * 2048 + (col0 - 8640);
            *(uint4*)dst = pack8(v0, v1);
          }
        }
    }
  }
};
template <int PASS>
struct EpiOut {
  static constexpr bool PERM = true, AFTER_DRAIN = false;
  const u16* gb; u16* U;
  DI void operator()(const pg8::f32x4 (&acc)[2][2][4][2], const pg8::Unit& u, int wr, int wc, int fr, int fq) const {
    const int row0 = u.pm * 256 + wr * 64 + fr;
#pragma unroll
    for (int bj = 0; bj < 2; ++bj) {
      const int col0 = u.pn * 256 + bj * 128 + wc * 32 + 8 * fq;
#pragma unroll
      for (int ai = 0; ai < 2; ++ai)
#pragma unroll
        for (int m = 0; m < 4; ++m) {
          const size_t row = row0 + ai * 128 + m * 16;
          float gt[8];
          unpack8(*(const uint4*)(gb + row * 2048 + PASS * 1024 + col0), gt);
          pg8::f32x4 v0 = acc[ai][bj][m][0], v1 = acc[ai][bj][m][1];
#pragma unroll
          for (int e = 0; e < 4; ++e) { v0[e] *= sigm(gt[e]); v1[e] *= sigm(gt[4 + e]); }
          if (PASS == 1) {
            float pu[8];
            unpack8(*(const uint4*)(U + row * 1024 + col0), pu);
#pragma unroll
            for (int e = 0; e < 4; ++e) { v0[e] += pu[e]; v1[e] += pu[4 + e]; }
          }
          *(uint4*)(U + row * 1024 + col0) = pack8(v0, v1);
        }
    }
  }
};
struct EpiWo {
  static constexpr bool PERM = true, AFTER_DRAIN = false;
  const float *xp, *xs, *mod; float* out; int tok0;
  DI void operator()(const pg8::f32x4 (&acc)[2][2][4][2], const pg8::Unit& u, int wr, int wc, int fr, int fq) const {
    const int row0 = u.pm * 256 + wr * 64 + fr;
#pragma unroll
    for (int bj = 0; bj < 2; ++bj) {
      const int col0 = u.pn * 256 + bj * 128 + wc * 32 + 8 * fq;
#pragma unroll
      for (int ai = 0; ai < 2; ++ai)
#pragma unroll
        for (int m = 0; m < 4; ++m) {
          const int tok = tok0 + row0 + ai * 128 + m * 16;
          const float* xr = tok < 8192 ? xp + (size_t)tok * 1024 : xs + (size_t)(tok - 8192) * 1024;
          const float* gt = mod + mrow_of(tok) * 6144 + 2048 + col0;
          const pg8::f32x4 x0 = *(const pg8::f32x4*)(xr + col0), x1 = *(const pg8::f32x4*)(xr + col0 + 4);
          const pg8::f32x4 g0 = *(const pg8::f32x4*)gt, g1 = *(const pg8::f32x4*)(gt + 4);
          float* o = out + (size_t)tok * 1024 + col0;
          *(pg8::f32x4*)o = x0 + g0 * acc[ai][bj][m][0];
          *(pg8::f32x4*)(o + 4) = x1 + g1 * acc[ai][bj][m][1];
        }
    }
  }
};
struct EpiGU {
  static constexpr bool PERM = true, AFTER_DRAIN = false;
  u16* act;
  DI void operator()(const pg8::f32x4 (&acc)[2][2][4][2], const pg8::Unit& u, int wr, int wc, int fr, int fq) const {
    const int row0 = u.pm * 256 + wr * 64 + fr;
    const int col0 = u.pn * 128 + wc * 32 + 8 * fq;
#pragma unroll
    for (int ai = 0; ai < 2; ++ai)
#pragma unroll
      for (int m = 0; m < 4; ++m) {
        const size_t row = row0 + ai * 128 + m * 16;
        pg8::f32x4 v0, v1;
#pragma unroll
        for (int e = 0; e < 4; ++e) {
          v0[e] = siluf(acc[ai][0][m][0][e]) * acc[ai][1][m][0][e];
          v1[e] = siluf(acc[ai][0][m][1][e]) * acc[ai][1][m][1][e];
        }
        *(uint4*)(act + row * 2816 + col0) = pack8(v0, v1);
      }
  }
};
struct EpiDown {
  static constexpr bool PERM = true, AFTER_DRAIN = false;
  const float* mod; float* out;
  DI void operator()(const pg8::f32x4 (&acc)[2][2][4][2], const pg8::Unit& u, int wr, int wc, int fr, int fq) const {
    const int row0 = u.pm * 256 + wr * 64 + fr;
#pragma unroll
    for (int bj = 0; bj < 2; ++bj) {
      const int col0 = u.pn * 256 + bj * 128 + wc * 32 + 8 * fq;
#pragma unroll
      for (int ai = 0; ai < 2; ++ai)
#pragma unroll
        for (int m = 0; m < 4; ++m) {
          const int tok = row0 + ai * 128 + m * 16;
          const float* gt = mod + mrow_of(tok) * 6144 + 5120 + col0;
          const pg8::f32x4 g0 = *(const pg8::f32x4*)gt, g1 = *(const pg8::f32x4*)(gt + 4);
          float* o = out + (size_t)tok * 1024 + col0;
          const pg8::f32x4 x0 = *(const pg8::f32x4*)o, x1 = *(const pg8::f32x4*)(o + 4);
          *(pg8::f32x4*)o = x0 + g0 * acc[ai][bj][m][0];
          *(pg8::f32x4*)(o + 4) = x1 + g1 * acc[ai][bj][m][1];
        }
    }
  }
};
template <class Epi>
DI void run_gemm8(char* smem, const u16* A, const u16* Bt, int M, int N, int K, const Epi& E) {
  asm volatile("" : "+s"(M), "+s"(N), "+s"(K));
  pg8::Gemm gm{A, Bt, M, N, K};
  pg8::StaticOrder S;
  S.init(M, N, gridDim.x, blockIdx.x);
  pg8::gemm_phase<Epi, pg8::StaticOrder, false>((PG8_LAS unsigned char*)smem, gm, S, E, nullptr);
  __syncthreads();
}

struct EpiR2 {
  static constexpr bool PERM = true, AFTER_DRAIN = false;
  __half* wk; const float *w0, *a0;
  DI void operator()(const pg8::f32x4 (&acc)[2][2][4][2], const pg8::Unit& u, int wr, int wc, int fr, int fq) const {
    const int row0 = u.pm * 256 + wr * 64 + fr;
    const int sec = u.pn >> 2;
#pragma unroll
    for (int bj = 0; bj < 2; ++bj) {
      const int nn = (u.pn & 3) * 256 + bj * 128 + wc * 32 + 8 * fq;
      const int d = sec & 1;
      const float* bias = (sec < 2 ? w0 : a0) + d * 1024 + nn;
      const pg8::f32x4 b0 = *(const pg8::f32x4*)bias, b1 = *(const pg8::f32x4*)(bias + 4);
      const int field = (sec < 2 ? 4 : 5) + 2 * d;
#pragma unroll
      for (int ai = 0; ai < 2; ++ai)
#pragma unroll
        for (int m = 0; m < 4; ++m) {
          const size_t row = row0 + ai * 128 + m * 16;
          pg8::f32x4 v0 = acc[ai][bj][m][0] + b0, v1 = acc[ai][bj][m][1] + b1;
          float o[8];
#pragma unroll
          for (int e = 0; e < 4; ++e) {
            float s0 = sigm(v0[e]), s1 = sigm(v1[e]);
            o[e] = sec < 2 ? __expf(-0.6065306597f * s0) : s0;
            o[4 + e] = sec < 2 ? __expf(-0.6065306597f * s1) : s1;
          }
          __half2 h0 = __floats2half2_rn(o[0], o[1]), h1 = __floats2half2_rn(o[2], o[3]);
          __half2 h2 = __floats2half2_rn(o[4], o[5]), h3 = __floats2half2_rn(o[6], o[7]);
          uint4 pk;
          pk.x = *reinterpret_cast<unsigned*>(&h0); pk.y = *reinterpret_cast<unsigned*>(&h1);
          pk.z = *reinterpret_cast<unsigned*>(&h2); pk.w = *reinterpret_cast<unsigned*>(&h3);
          *(uint4*)(wk + ((row * 16 + (nn >> 6)) * 8 + field) * 64 + (nn & 63)) = pk;
        }
    }
  }
};

template <int MODE>
__device__ __forceinline__ void convT(const float* __restrict__ src, int K, int N, u16* __restrict__ dst, char* smem, int vb = -1, int nb = 0, int ldd = 0) {
  if (ldd == 0) ldd = K;
  float* tile = (float*)smem;
  const int tid = get_tid();
  const int KT = K >> 6, NT = N >> 6;
  if (vb < 0) { vb = blockIdx.x; nb = gridDim.x; }
  for (int t = vb; t < KT * NT; t += nb) {
    int kt = t % KT, nt = t / KT;
#pragma unroll
    for (int i = 0; i < 8; ++i) {
      int idx = tid + i * 512;
      int r = idx >> 6, cc = idx & 63;
      tile[r * 65 + cc] = src[(size_t)(kt * 64 + r) * N + nt * 64 + cc];
    }
    __syncthreads();
    int n = tid >> 3, kc = tid & 7;
    unsigned w[4];
#pragma unroll
    for (int j = 0; j < 4; ++j)
      w[j] = pack2(tile[(kc * 8 + 2 * j) * 65 + n], tile[(kc * 8 + 2 * j + 1) * 65 + n]);
    int ng = nt * 64 + n;
    int row = ng;
    if (MODE == 1) {
      int isu = ng >= 2816;
      int nn = ng - isu * 2816;
      row = (nn >> 7) * 256 + isu * 128 + (nn & 127);
    }
    *(uint4*)(dst + (size_t)row * ldd + kt * 64 + kc * 8) = uint4{w[0], w[1], w[2], w[3]};
    __syncthreads();
  }
}

__device__ __forceinline__ void step_prep(const Params& p, char* smem) {
  const int tid = get_tid();
  char* ws = p.ws;
  {
    float* red = (float*)smem;
    float* mod = (float*)(ws + OFF_MOD);
    for (int item = blockIdx.x; item < 192; item += gridDim.x) {
      int c4 = tid & 7, kl = tid >> 3;
      float acc[12];
#pragma unroll
      for (int i = 0; i < 12; ++i) acc[i] = 0.f;
      for (int k = kl; k < 1024; k += 64) {
        float4 w = *(const float4*)(p.w_ada + (size_t)k * 6144 + item * 32 + c4 * 4);
        float s0 = siluf(p.c_ctx[k]), s1 = siluf(p.c[k]), s2 = siluf(p.c[1024 + k]);
        acc[0] += s0 * w.x; acc[1] += s0 * w.y; acc[2] += s0 * w.z; acc[3] += s0 * w.w;
        acc[4] += s1 * w.x; acc[5] += s1 * w.y; acc[6] += s1 * w.z; acc[7] += s1 * w.w;
        acc[8] += s2 * w.x; acc[9] += s2 * w.y; acc[10] += s2 * w.z; acc[11] += s2 * w.w;
      }
#pragma unroll
      for (int i = 0; i < 12; ++i) red[(kl * 8 + c4) * 12 + i] = acc[i];
      __syncthreads();
      if (tid < 96) {
        int cond = tid >> 5, col = tid & 31;
        int cc4 = col >> 2, e = col & 3;
        float s = 0.f;
        for (int k = 0; k < 64; ++k) s += red[(k * 8 + cc4) * 12 + cond * 4 + e];
        int n = item * 32 + col;
        mod[cond * 6144 + n] = s + p.b_ada[n];
      }
      __syncthreads();
    }
  }
  convT<0>(p.w_in, 1024, 10688, (u16*)(ws + OFF_WIN), smem);
  convT<0>(p.w_m_out, 2048, 1024, (u16*)(ws + OFF_WMOUT), smem);
  convT<0>(p.w_r_out, 1024, 1024, (u16*)(ws + OFF_WROUT), smem);
  convT<0>(p.w_o, 1024, 1024, (u16*)(ws + OFF_WO), smem);
  convT<0>(p.w2, 64, 1024, (u16*)(ws + OFF_W2T), smem);
  convT<0>(p.w2 + 65536, 64, 1024, (u16*)(ws + OFF_W2T) + 65536, smem);
  convT<0>(p.a2, 64, 1024, (u16*)(ws + OFF_A2T), smem);
  convT<0>(p.a2 + 65536, 64, 1024, (u16*)(ws + OFF_A2T) + 65536, smem);
  convT<0>(p.g2, 128, 1024, (u16*)(ws + OFF_G2T), smem);
  {
    u16* w4 = (u16*)(ws + OFF_W4T);
    convT<0>(p.w2, 64, 1024, w4 + (size_t)0 * 1024 * 256 + 0, smem, -1, 0, 256);
    convT<0>(p.w2 + 65536, 64, 1024, w4 + (size_t)1 * 1024 * 256 + 64, smem, -1, 0, 256);
    convT<0>(p.a2, 64, 1024, w4 + (size_t)2 * 1024 * 256 + 128, smem, -1, 0, 256);
    convT<0>(p.a2 + 65536, 64, 1024, w4 + (size_t)3 * 1024 * 256 + 192, smem, -1, 0, 256);
    for (int i = blockIdx.x * NTHR + tid; i < 4096 * 32; i += gridDim.x * NTHR) {
      int row = i >> 5, c = i & 31;
      if ((c >> 3) != (row >> 10)) *(uint4*)(w4 + (size_t)row * 256 + c * 8) = uint4{0, 0, 0, 0};
    }
  }
  {
    uint4* z = (uint4*)(ws + OFF_WIN + (size_t)10688 * 1024 * 2);
    for (int i = blockIdx.x * NTHR + tid; i < 8192; i += gridDim.x * NTHR) z[i] = uint4{0, 0, 0, 0};
  }
}

template <int WHICH>
__device__ __forceinline__ void step_norm(const Params& p, int g) {
  const int tid = get_tid(), lane = tid & 63, wave = tid >> 6;
  const float* mod = (const float*)(p.ws + OFF_MOD);
  const int nrows = WHICH == 0 ? TG : NTOK;
  u16* dst = (u16*)(p.ws + (WHICH == 0 ? OFF_H1 : OFF_H2));
  const float* nw = WHICH == 0 ? p.norm1_w : p.norm2_w;
  for (int r = blockIdx.x * 8 + wave; r < nrows; r += gridDim.x * 8) {
    int tok = WHICH == 0 ? g * TG + r : r;
    const float* xr;
    if (WHICH == 0) xr = tok < 8192 ? p.x_prompt + (size_t)tok * 1024 : p.x_sample + (size_t)(tok - 8192) * 1024;
    else xr = (const float*)(p.ws + OFF_X1) + (size_t)tok * 1024;
    const float* mr = mod + mrow_of(tok) * 6144 + (WHICH == 0 ? 0 : 3072);
    float4 v[4];
    float ss = 0.f;
#pragma unroll
    for (int i = 0; i < 4; ++i) {
      v[i] = ((const float4*)xr)[i * 64 + lane];
      ss += v[i].x * v[i].x + v[i].y * v[i].y + v[i].z * v[i].z + v[i].w * v[i].w;
    }
    ss = wave_sum(ss);
    float rinv = rsqrtf(ss * (1.f / 1024.f) + 1e-6f);
#pragma unroll
    for (int i = 0; i < 4; ++i) {
      int col = (i * 64 + lane) * 4;
      float4 w4 = *(const float4*)(nw + col);
      float4 sh = *(const float4*)(mr + col);
      float4 sc = *(const float4*)(mr + 1024 + col);
      float h0 = v[i].x * rinv * w4.x * (1.f + sc.x) + sh.x;
      float h1 = v[i].y * rinv * w4.y * (1.f + sc.y) + sh.y;
      float h2 = v[i].z * rinv * w4.z * (1.f + sc.z) + sh.z;
      float h3 = v[i].w * rinv * w4.w * (1.f + sc.w) + sh.w;
      *(uint2*)(dst + (size_t)r * 1024 + col) = uint2{pack2(h0, h1), pack2(h2, h3)};
    }
  }
}

__device__ __forceinline__ void step_gemm1(const Params& p, char* smem) {
  char* ws = p.ws;
  EpiP E{(u16*)(ws + OFF_Z), (u16*)(ws + OFF_XBCRAW), (u16*)(ws + OFF_RW), (u16*)(ws + OFF_GATE), (float*)(ws + OFF_DT)};
  run_gemm8(smem, (const u16*)(ws + OFF_H1), (const u16*)(ws + OFF_WIN), TG, NPAD, 1024, E);
}

__device__ __forceinline__ void step_cr1(const Params& p, int g) {
  char* ws = p.ws;
  const int tid = get_tid(), lane = tid & 63, wave = tid >> 6;
  const int Ls = g < 2 ? 256 : 2048;
  {
    const u16* xr = (const u16*)(ws + OFF_XBCRAW);
    u16* xo = (u16*)(ws + OFF_XBC);
    for (int idx = blockIdx.x * NTHR + tid; idx < TG * 384; idx += gridDim.x * NTHR) {
      int r = idx / 384, cc = idx - r * 384;
      int pos = r & (Ls - 1);
      float s[8];
      {
        float4 b0 = *(const float4*)(p.conv_b + cc * 8), b1 = *(const float4*)(p.conv_b + cc * 8 + 4);
        s[0] = b0.x; s[1] = b0.y; s[2] = b0.z; s[3] = b0.w; s[4] = b1.x; s[5] = b1.y; s[6] = b1.z; s[7] = b1.w;
      }
#pragma unroll
      for (int i = 0; i < 5; ++i) {
        int pp = pos + i - 2;
        if (pp >= 0 && pp < Ls) {
          uint4 u = *(const uint4*)(xr + (size_t)(r + i - 2) * 3072 + cc * 8);
          float4 w0 = *(const float4*)(p.conv_w + i * 3072 + cc * 8), w1 = *(const float4*)(p.conv_w + i * 3072 + cc * 8 + 4);
          s[0] += bf2f(u.x & 0xffff) * w0.x; s[1] += bf2f(u.x >> 16) * w0.y;
          s[2] += bf2f(u.y & 0xffff) * w0.z; s[3] += bf2f(u.y >> 16) * w0.w;
          s[4] += bf2f(u.z & 0xffff) * w1.x; s[5] += bf2f(u.z >> 16) * w1.y;
          s[6] += bf2f(u.w & 0xffff) * w1.z; s[7] += bf2f(u.w >> 16) * w1.w;
        }
      }
#pragma unroll
      for (int e = 0; e < 8; ++e) s[e] = siluf(s[e]);
      *(uint4*)(xo + (size_t)r * 3072 + cc * 8) = uint4{pack2(s[0], s[1]), pack2(s[2], s[3]), pack2(s[4], s[5]), pack2(s[6], s[7])};
    }
  }
  {
    const u16* rw = (const u16*)(ws + OFF_RW);
    __half* wk = (__half*)(ws + OFF_WK);
    u16* tl = (u16*)(ws + OFF_TL);
    u16* sg = (u16*)(ws + OFF_SG);
    const bool grid = (g == 2);
    for (int r = blockIdx.x * 8 + wave; r < TG; r += gridDim.x * 8) {
      int pos = r & (Ls - 1);
      for (int ib = 0; ib < 54; ib += 6) {
        float xxs[6];
        {
          float cur[6], shv[6], muv[6];
#pragma unroll
          for (int u = 0; u < 6; ++u) {
            int c = (ib + u) * 64 + lane;
            cur[u] = bf2f(rw[(size_t)r * 3456 + c]);
            int q = c / 864;
            int dr;
            bool ok;
            if (!grid) {
              if (q & 1) { dr = 1; ok = pos < Ls - 1; } else { dr = -1; ok = pos > 0; }
            } else {
              if (q == 0) { dr = -1; ok = (pos & 63) != 0; }
              else if (q == 1) { dr = 1; ok = (pos & 63) != 63; }
              else if (q == 2) { dr = -64; ok = pos >= 64; }
              else { dr = 64; ok = pos < Ls - 64; }
            }
            shv[u] = ok ? bf2f(rw[(size_t)(r + dr) * 3456 + c]) : 0.f;
            muv[u] = p.mu_shift[c];
          }
#pragma unroll
          for (int u = 0; u < 6; ++u) xxs[u] = cur[u] + muv[u] * (shv[u] - cur[u]);
        }
#pragma unroll
        for (int u = 0; u < 6; ++u) {
          const int it = ib + u;
          const float xx = xxs[u];
          if (it < 16) {
            wk[((size_t)(r * 16 + it) * 8 + 0) * 64 + lane] = __float2half(xx);
          } else if (it == 16) {
            tl[(size_t)r * 256 + lane] = f2bf(tanhf(xx));
          } else if (it == 17) {
            tl[(size_t)r * 256 + 64 + lane] = f2bf(tanhf(xx));
          } else if (it < 34) {
            int h = it - 18;
            float kk = xx * p.k_k[h * 64 + lane];
            float ss = wave_sum(kk * kk);
            float nkk = -kk * rsqrtf(ss + 1e-12f);
            wk[((size_t)(r * 16 + h) * 8 + 2) * 64 + lane] = __float2half(xx);
            wk[((size_t)(r * 16 + h) * 8 + 3) * 64 + lane] = __float2half(nkk);
          } else if (it < 50) {
            int h = it - 34;
            wk[((size_t)(r * 16 + h) * 8 + 1) * 64 + lane] = __float2half(xx);
          } else if (it == 50) {
            tl[(size_t)r * 256 + 128 + lane] = f2bf(xx);
          } else if (it == 51) {
            tl[(size_t)r * 256 + 192 + lane] = f2bf(xx);
          } else {
            sg[(size_t)r * 128 + (it - 52) * 64 + lane] = f2bf(sigm(xx));
          }
        }
      }
    }
  }
}

__device__ __forceinline__ void step_r2(const Params& p, char* smem) {
  char* ws = p.ws;
  const int tid = get_tid(), lane = tid & 63, wave = tid >> 6;
  const int wm = wave >> 1, wn = wave & 1;
  const u16* tl = (const u16*)(ws + OFF_TL);
  const u16* sg = (const u16*)(ws + OFF_SG);
  __half* wk = (__half*)(ws + OFF_WK);
  u16* gr = (u16*)(ws + OFF_GR);
  {
    EpiR2 E{wk, p.w0, p.a0};
    run_gemm8(smem, tl, (const u16*)(ws + OFF_W4T), TG, 4096, 256, E);
  }
  for (int t = (gridDim.x - 1 - blockIdx.x) + 4 * 128; t < 5 * 128; t += gridDim.x) {
    int sub = t >> 7, rem = t & 127;
    int mt = rem & 15, nt = rem >> 4;
    f32x4 acc[4][4];
    zero_acc(acc);
    if (sub < 2) {
      gemm_acc(tl + (size_t)mt * 256 * 256 + sub * 64, 256, (const u16*)(ws + OFF_W2T) + sub * 65536 + (size_t)nt * 128 * 64, 64, 64, acc, smem);
    } else if (sub < 4) {
      gemm_acc(tl + (size_t)mt * 256 * 256 + 128 + (sub - 2) * 64, 256, (const u16*)(ws + OFF_A2T) + (sub - 2) * 65536 + (size_t)nt * 128 * 64, 64, 64, acc, smem);
    } else {
      gemm_acc(sg + (size_t)mt * 256 * 128, 128, (const u16*)(ws + OFF_G2T) + (size_t)nt * 128 * 128, 128, 128, acc, smem);
    }
#pragma unroll
    for (int mf = 0; mf < 4; ++mf)
#pragma unroll
      for (int nf = 0; nf < 4; ++nf)
#pragma unroll
        for (int j = 0; j < 4; ++j) {
          if (nf == 0 && j == 0) asm volatile("" ::: "memory");
          int m = mt * 256 + wm * 64 + mf * 16 + (lane >> 4) * 4 + j;
          int n = nt * 128 + wn * 64 + nf * 16 + (lane & 15);
          float v = acc[mf][nf][j];
          if (sub < 2) {
            float wl = v + p.w0[sub * 1024 + n];
            float dec = __expf(-0.6065306597f * sigm(wl));
            wk[((size_t)(m * 16 + (n >> 6)) * 8 + 4 + 2 * sub) * 64 + (n & 63)] = __float2half(dec);
          } else if (sub < 4) {
            int d = sub - 2;
            float a = sigm(v + p.a0[d * 1024 + n]);
            wk[((size_t)(m * 16 + (n >> 6)) * 8 + 5 + 2 * d) * 64 + (n & 63)] = __float2half(a);
          } else {
            gr[(size_t)m * 1024 + n] = f2bf(v);
          }
        }
  }
}

DI int swz16(int row) { return (row ^ (row >> 3)) & 15; }
DI int sw256(int row, int e) { return row * 256 + ((((e >> 3) ^ swz16(row))) << 4) + (e & 7) * 2; }
DI const bf16x8 ldfrag256(const char* base, int row, int ch) {
  return *(const bf16x8*)(base + row * 256 + ((ch ^ swz16(row)) << 4));
}

typedef unsigned v4u __attribute__((ext_vector_type(4)));
struct SsdPre { v4u c0, c1, c2, c3, b0, b1, b2, b3, x0, x1; float d0, d1; };
DI void ssd_issue(const Params& p, int g, int chain, int ci, int tid, SsdPre& R) {
  const int Ls = g < 2 ? 256 : 2048;
  const int nch = Ls >> 7;
  const int d = chain & 1, h = (chain >> 1) & 31, b = chain >> 6;
  const int grp = h >> 3;
  const int c = d ? nch - 1 - ci : ci;
  const int tok0 = b * Ls + c * 128;
  const u16* xbc = (const u16*)(p.ws + OFF_XBC);
  const float* dtb = (const float*)(p.ws + OFF_DT);
  const int lane = tid & 63, wave = tid >> 6;
#define SSD_LDCB(i, CF, BF) { int idx = tid + i * 512; int row = idx >> 4, ch = idx & 15; \
    const u16* src = xbc + (size_t)(tok0 + row) * 3072 + grp * 128 + ch * 8; R.CF = *(const v4u*)(src + 2560); R.BF = *(const v4u*)(src + 2048); }
  SSD_LDCB(0, c0, b0) SSD_LDCB(1, c1, b1) SSD_LDCB(2, c2, b2) SSD_LDCB(3, c3, b3)
#undef SSD_LDCB
#define SSD_LDX(i, XF) { int idx = tid + i * 512; int l = idx >> 3, ch = idx & 7; R.XF = *(const v4u*)(xbc + (size_t)(tok0 + l) * 3072 + h * 64 + ch * 8); }
  SSD_LDX(0, x0) SSD_LDX(1, x1)
#undef SSD_LDX
  if (wave == 0) {
    int e0 = 2 * lane, e1 = 2 * lane + 1;
    int l0 = d ? 127 - e0 : e0, l1 = d ? 127 - e1 : e1;
    R.d0 = dtb[(size_t)(tok0 + l0) * 64 + d * 32 + h];
    R.d1 = dtb[(size_t)(tok0 + l1) * 64 + d * 32 + h];
  }
}

__device__ __forceinline__ void ssd_chain(const Params& p, char* smem, int g, int chain, int next_chain, SsdPre& R) {
  char* ws = p.ws;
  const int tid = get_tid(), lane = tid & 63, wave = tid >> 6;
  const int Ls = g < 2 ? 256 : 2048;
  const int nch = Ls >> 7;
  const int d = chain & 1, h = (chain >> 1) & 31, b = chain >> 6;
  const int grp = h >> 3;
  const u16* xbc = (const u16*)(ws + OFF_XBC);
  const float* dtb = (const float*)(ws + OFF_DT);
  u16* yout = (u16*)(ws + (d ? OFF_SYB : OFF_SYF));
  char* Cs = smem;
  char* Bs = smem + 32768;
  char* BdT = smem + 65536;
  char* XT = smem + 98304;
  char* Ss = smem + 114688;
  float* csum = (float*)(smem + 131072);
  float* dts = (float*)(smem + 131584);
  const float a_h = -__expf(p.a_log[d * 32 + h]);
  const float dtbias = p.dt_bias[d * 32 + h];
  const int wp = wave >> 2, wn4 = wave & 3;
  f32x4 sacc[2][2];
#pragma unroll
  for (int pf = 0; pf < 2; ++pf)
#pragma unroll
    for (int nf = 0; nf < 2; ++nf) {
      if (g == 2) {
        const float* h0 = (d ? p.ssm_b : p.ssm_f) + (size_t)(b * 32 + h) * 8192;
#pragma unroll
        for (int j = 0; j < 4; ++j) {
          int pp = wp * 32 + pf * 16 + (lane >> 4) * 4 + j;
          int n = wn4 * 32 + nf * 16 + (lane & 15);
          sacc[pf][nf][j] = h0[pp * 128 + n];
        }
      } else {
        sacc[pf][nf] = f32x4{0.f, 0.f, 0.f, 0.f};
      }
    }
  const int tid_outer = tid;
  for (int ci = 0; ci < nch; ++ci) {
    int tidv = tid_outer;
    asm volatile("" : "+v"(tidv));
    const int tid = tidv, lane = tidv & 63, wave = tidv >> 6;
    const int wp = wave >> 2, wn4 = wave & 3;
    const int c = d ? nch - 1 - ci : ci;
    const int tok0 = b * Ls + c * 128;
#define SSD_STCB(i, CF, BF) { int idx = tid + i * 512; int row = idx >> 4, ch = idx & 15; \
      *(v4u*)(Cs + row * 256 + ((ch ^ swz16(row)) << 4)) = R.CF; *(v4u*)(Bs + row * 256 + ((ch ^ swz16(row)) << 4)) = R.BF; }
    SSD_STCB(0, c0, b0) SSD_STCB(1, c1, b1) SSD_STCB(2, c2, b2) SSD_STCB(3, c3, b3)
#undef SSD_STCB
#define SSD_STX(i, XF) { int idx = tid + i * 512; int l = idx >> 3, ch = idx & 7; \
      const unsigned w0 = R.XF[0], w1 = R.XF[1], w2 = R.XF[2], w3 = R.XF[3]; \
      *(u16*)(XT + sw256(ch * 8 + 0, l)) = (u16)(w0 & 0xffff); *(u16*)(XT + sw256(ch * 8 + 1, l)) = (u16)(w0 >> 16); \
      *(u16*)(XT + sw256(ch * 8 + 2, l)) = (u16)(w1 & 0xffff); *(u16*)(XT + sw256(ch * 8 + 3, l)) = (u16)(w1 >> 16); \
      *(u16*)(XT + sw256(ch * 8 + 4, l)) = (u16)(w2 & 0xffff); *(u16*)(XT + sw256(ch * 8 + 5, l)) = (u16)(w2 >> 16); \
      *(u16*)(XT + sw256(ch * 8 + 6, l)) = (u16)(w3 & 0xffff); *(u16*)(XT + sw256(ch * 8 + 7, l)) = (u16)(w3 >> 16); }
    SSD_STX(0, x0) SSD_STX(1, x1)
#undef SSD_STX
    if (wave == 0) {
      int e0 = 2 * lane, e1 = 2 * lane + 1;
      int l0 = d ? 127 - e0 : e0, l1 = d ? 127 - e1 : e1;
      float x0 = R.d0 + dtbias;
      float x1 = R.d1 + dtbias;
      float dt0 = x0 > 20.f ? x0 : log1pf(__expf(x0));
      float dt1 = x1 > 20.f ? x1 : log1pf(__expf(x1));
      float a0 = dt0 * a_h, a1 = dt1 * a_h;
      float s = a0 + a1;
#pragma unroll
      for (int o = 1; o < 64; o <<= 1) {
        float t = __shfl_up(s, o);
        if (lane >= o) s += t;
      }
      csum[l1] = s;
      csum[l0] = s - a1;
      dts[l0] = dt0;
      dts[l1] = dt1;
    }
    if (ci + 1 < nch) ssd_issue(p, g, chain, ci + 1, tid, R);
    else if (next_chain >= 0) ssd_issue(p, g, next_chain, 0, tid, R);
#pragma unroll
    for (int pf = 0; pf < 2; ++pf)
#pragma unroll
      for (int nf = 0; nf < 2; ++nf)
#pragma unroll
        for (int j = 0; j < 4; ++j) {
          int pp = wp * 32 + pf * 16 + (lane >> 4) * 4 + j;
          int n = wn4 * 32 + nf * 16 + (lane & 15);
          *(u16*)(Ss + sw256(pp, n)) = f2bf(sacc[pf][nf][j]);
        }
    __syncthreads();
    const float cstot = csum[d ? 0 : 127];
#pragma unroll
    for (int i = 0; i < 4; ++i) {
      int idx = tid + i * 512;
      int l = idx >> 4, ch = idx & 15;
      uint4 bv = *(const uint4*)(Bs + l * 256 + ((ch ^ swz16(l)) << 4));
      float f = dts[l] * __expf(cstot - csum[l]);
      unsigned w[4] = {bv.x, bv.y, bv.z, bv.w};
#pragma unroll
      for (int e = 0; e < 8; ++e) {
        int n = ch * 8 + e;
        float val = bf2f((u16)((w[e >> 1] >> ((e & 1) * 16)) & 0xffff)) * f;
        *(u16*)(BdT + sw256(n, l)) = f2bf(val);
      }
    }
    const int wm = wave >> 1, wn2 = wave & 1;
    f32x4 gacc[2][4];
#pragma unroll
    for (int i = 0; i < 2; ++i)
#pragma unroll
      for (int j = 0; j < 4; ++j) gacc[i][j] = f32x4{0.f, 0.f, 0.f, 0.f};
#pragma unroll
    for (int ks = 0; ks < 4; ++ks) {
      int ch = ks * 4 + (lane >> 4);
      bf16x8 a[2], bb[4];
#pragma unroll
      for (int mf = 0; mf < 2; ++mf) a[mf] = ldfrag256(Cs, wm * 32 + mf * 16 + (lane & 15), ch);
#pragma unroll
      for (int nf = 0; nf < 4; ++nf) bb[nf] = ldfrag256(Bs, wn2 * 64 + nf * 16 + (lane & 15), ch);
#pragma unroll
      for (int mf = 0; mf < 2; ++mf)
#pragma unroll
        for (int nf = 0; nf < 4; ++nf)
          gacc[mf][nf] = __builtin_amdgcn_mfma_f32_16x16x32_bf16(a[mf], bb[nf], gacc[mf][nf], 0, 0, 0);
    }
    {
      float csl[2][4];
#pragma unroll
      for (int mf = 0; mf < 2; ++mf)
#pragma unroll
        for (int j = 0; j < 4; ++j) csl[mf][j] = csum[wm * 32 + mf * 16 + (lane >> 4) * 4 + j];
#pragma unroll
      for (int nf = 0; nf < 4; ++nf) {
        int s = wn2 * 64 + nf * 16 + (lane & 15);
        float css = csum[s], dss = dts[s];
#pragma unroll
        for (int mf = 0; mf < 2; ++mf)
#pragma unroll
          for (int j = 0; j < 4; ++j) {
            int l = wm * 32 + mf * 16 + (lane >> 4) * 4 + j;
            bool valid = d ? (s >= l) : (s <= l);
            float e = valid ? __expf(csl[mf][j] - css) * dss : 0.f;
            gacc[mf][nf][j] *= e;
          }
      }
    }
    __syncthreads();
#pragma unroll
    for (int mf = 0; mf < 2; ++mf)
#pragma unroll
      for (int nf = 0; nf < 4; ++nf)
#pragma unroll
        for (int j = 0; j < 4; ++j) {
          int l = wm * 32 + mf * 16 + (lane >> 4) * 4 + j;
          int s = wn2 * 64 + nf * 16 + (lane & 15);
          *(u16*)(Bs + sw256(l, s)) = f2bf(gacc[mf][nf][j]);
        }
    __syncthreads();
    {
      f32x4 yacc[2][2];
#pragma unroll
      for (int i = 0; i < 2; ++i)
#pragma unroll
        for (int j = 0; j < 2; ++j) yacc[i][j] = f32x4{0.f, 0.f, 0.f, 0.f};
#pragma unroll
      for (int ks = 0; ks < 4; ++ks) {
        int ch = ks * 4 + (lane >> 4);
        bf16x8 a[2], bb[2];
#pragma unroll
        for (int mf = 0; mf < 2; ++mf) a[mf] = ldfrag256(Cs, wm * 32 + mf * 16 + (lane & 15), ch);
#pragma unroll
        for (int nf = 0; nf < 2; ++nf) bb[nf] = ldfrag256(Ss, wn2 * 32 + nf * 16 + (lane & 15), ch);
#pragma unroll
        for (int mf = 0; mf < 2; ++mf)
#pragma unroll
          for (int nf = 0; nf < 2; ++nf)
            yacc[mf][nf] = __builtin_amdgcn_mfma_f32_16x16x32_bf16(a[mf], bb[nf], yacc[mf][nf], 0, 0, 0);
      }
#pragma unroll
      for (int mf = 0; mf < 2; ++mf)
#pragma unroll
        for (int j = 0; j < 4; ++j) {
          float e = __expf(csum[wm * 32 + mf * 16 + (lane >> 4) * 4 + j]);
#pragma unroll
          for (int nf = 0; nf < 2; ++nf) yacc[mf][nf][j] *= e;
        }
#pragma unroll
      for (int ks = 0; ks < 4; ++ks) {
        int ch = ks * 4 + (lane >> 4);
        bf16x8 a[2], bb[2];
#pragma unroll
        for (int mf = 0; mf < 2; ++mf) a[mf] = ldfrag256(Bs, wm * 32 + mf * 16 + (lane & 15), ch);
#pragma unroll
        for (int nf = 0; nf < 2; ++nf) bb[nf] = ldfrag256(XT, wn2 * 32 + nf * 16 + (lane & 15), ch);
#pragma unroll
        for (int mf = 0; mf < 2; ++mf)
#pragma unroll
          for (int nf = 0; nf < 2; ++nf)
            yacc[mf][nf] = __builtin_amdgcn_mfma_f32_16x16x32_bf16(a[mf], bb[nf], yacc[mf][nf], 0, 0, 0);
      }
#pragma unroll
      for (int mf = 0; mf < 2; ++mf)
#pragma unroll
        for (int nf = 0; nf < 2; ++nf)
#pragma unroll
          for (int j = 0; j < 4; ++j) {
            int l = wm * 32 + mf * 16 + (lane >> 4) * 4 + j;
            int pp = wn2 * 32 + nf * 16 + (lane & 15);
            yout[(size_t)(tok0 + l) * 2048 + h * 64 + pp] = f2bf(yacc[mf][nf][j]);
          }
    }
    {
      float e = __expf(cstot);
#pragma unroll
      for (int pf = 0; pf < 2; ++pf)
#pragma unroll
        for (int nf = 0; nf < 2; ++nf) sacc[pf][nf] *= e;
#pragma unroll
      for (int ks = 0; ks < 4; ++ks) {
        int ch = ks * 4 + (lane >> 4);
        bf16x8 a[2], bb[2];
#pragma unroll
        for (int pf = 0; pf < 2; ++pf) a[pf] = ldfrag256(XT, wp * 32 + pf * 16 + (lane & 15), ch);
#pragma unroll
        for (int nf = 0; nf < 2; ++nf) bb[nf] = ldfrag256(BdT, wn4 * 32 + nf * 16 + (lane & 15), ch);
#pragma unroll
        for (int pf = 0; pf < 2; ++pf)
#pragma unroll
          for (int nf = 0; nf < 2; ++nf)
            sacc[pf][nf] = __builtin_amdgcn_mfma_f32_16x16x32_bf16(a[pf], bb[nf], sacc[pf][nf], 0, 0, 0);
      }
    }
    __syncthreads();
  }
  if (g < 2) {
    float* so = p.out + (d ? OUT_SSMB : OUT_SSMF) + (size_t)((g * 16 + b) * 32 + h) * 8192;
#pragma unroll
    for (int pf = 0; pf < 2; ++pf)
#pragma unroll
      for (int nf = 0; nf < 2; ++nf)
#pragma unroll
        for (int j = 0; j < 4; ++j) {
          int pp = wp * 32 + pf * 16 + (lane >> 4) * 4 + j;
          int n = wn4 * 32 + nf * 16 + (lane & 15);
          so[pp * 128 + n] = sacc[pf][nf][j];
        }
  }
}

DI float dpp_xor1(float v) { return __int_as_float(__builtin_amdgcn_update_dpp(0, __float_as_int(v), 0xB1, 0xF, 0xF, true)); }
DI float dpp_hmirror(float v) { return __int_as_float(__builtin_amdgcn_update_dpp(0, __float_as_int(v), 0x141, 0xF, 0xF, true)); }
DI float dpp_xor2(float v) { return __int_as_float(__builtin_amdgcn_update_dpp(0, __float_as_int(v), 0x4E, 0xF, 0xF, true)); }

template <bool SEG>
__device__ __forceinline__ void wkv_pair(const Params& p, char* smem, int g, int item) {
  char* ws = p.ws;
  const int tid = get_tid(), lane = tid & 63, wave = tid >> 6;
  const int Ls = SEG ? 2048 : 256;
  const __half* wk = (const __half*)(ws + OFF_WK);
  float* stage = (float*)smem;
  float* ylds = (float*)(smem + 98304);
  const bool cw = true;
  const int slot = wave >> 2, wq = wave & 3;
  const int ig = lane >> 3, jg = lane & 7;
  const int row0 = wq * 16 + ig * 2;
  const int chain = SEG ? (item >> 3) : item * 2 + slot;
  const int seg = SEG ? (item & 7) : 0;
  const bool act = cw && (SEG ? !(slot == 1 && seg == 0) : true);
  const int d = chain & 1, h = (chain >> 1) & 15, b = chain >> 5;
  typedef float f2 __attribute__((ext_vector_type(2)));
  f2 S[2][4];
#pragma unroll
  for (int rr = 0; rr < 2; ++rr) {
    if (SEG) {
      if (slot == 0) {
        if (seg == 0) {
          const float* s0 = (d ? p.wkv_b : p.wkv_f) + ((size_t)(b * 16 + h) * 64 + row0 + rr) * 64 + jg * 8;
#pragma unroll
          for (int c = 0; c < 4; ++c) S[rr][c] = f2{s0[2 * c], s0[2 * c + 1]};
        } else {
#pragma unroll
          for (int c = 0; c < 4; ++c) S[rr][c] = f2{0.f, 0.f};
        }
      } else {
#pragma unroll
        for (int c = 0; c < 4; ++c) S[rr][c] = f2{(row0 + rr == jg * 8 + 2 * c) ? 1.f : 0.f, (row0 + rr == jg * 8 + 2 * c + 1) ? 1.f : 0.f};
      }
    } else {
#pragma unroll
      for (int c = 0; c < 4; ++c) S[rr][c] = f2{0.f, 0.f};
    }
  }
  const int pair = tid >> 4, lslot = pair >> 4, lstep = pair & 15, sub = tid & 15;
  const int lch = SEG ? (item >> 3) : item * 2 + lslot;
  const int ld = lch & 1, lh = (lch >> 1) & 15, lb = lch >> 5;
  const bool ldo = SEG ? (lslot == 0) : true;
  const int sbase = seg * 256;
  const int cslot = SEG ? 0 : slot;
  float ka[4];
#pragma unroll
  for (int e = 0; e < 4; ++e) ka[e] = p.k_a[lh * 64 + sub * 4 + e];
  u16* yout;
  if (SEG) yout = lslot == 0 ? (u16*)(ws + (ld ? OFF_WYB : OFF_WYF)) : (u16*)(ws + OFF_YM) + (ld ? (size_t)TG * 1024 : 0);
  else yout = (u16*)(ws + (ld ? OFF_WYB : OFF_WYF));
  const bool ywr = SEG ? (lslot == 0 || seg > 0) : true;
  uint2 rg[6];
  auto prefetch = [&](int tb) {
    int s = sbase + tb * 16 + lstep;
    int pos = ld ? Ls - 1 - s : s;
    int r = lb * Ls + pos;
    const __half* rec = wk + ((size_t)(r * 16 + lh) * 8) * 64 + sub * 4;
    rg[0] = *(const uint2*)(rec + 0 * 64);
    rg[1] = *(const uint2*)(rec + 1 * 64);
    rg[2] = *(const uint2*)(rec + 2 * 64);
    rg[3] = *(const uint2*)(rec + 3 * 64);
    rg[4] = *(const uint2*)(rec + (4 + 2 * ld) * 64);
    rg[5] = *(const uint2*)(rec + (5 + 2 * ld) * 64);
  };
  auto unpack4 = [&](uint2 u, float (&o)[4]) {
    __half2 h0 = *reinterpret_cast<__half2*>(&u.x);
    __half2 h1 = *reinterpret_cast<__half2*>(&u.y);
    float2 f0 = __half22float2(h0), f1 = __half22float2(h1);
    o[0] = f0.x; o[1] = f0.y; o[2] = f1.x; o[3] = f1.y;
  };
  auto stage_store = [&](int buf) {
    float r_[4], v_[4], k_[4], nkk_[4], w_[4], a_[4];
    unpack4(rg[0], r_); unpack4(rg[1], v_); unpack4(rg[2], k_); unpack4(rg[3], nkk_); unpack4(rg[4], w_); unpack4(rg[5], a_);
    float b_[4], kd_[4];
#pragma unroll
    for (int e = 0; e < 4; ++e) {
      b_[e] = -nkk_[e] * a_[e];
      kd_[e] = k_[e] * (1.f + (a_[e] - 1.f) * ka[e]);
    }
    float* dst = stage + ((size_t)((buf * 2 + lslot) * 16 + lstep) * 6) * 64 + sub * 4;
    *(float4*)(dst + 0 * 64) = float4{nkk_[0], nkk_[1], nkk_[2], nkk_[3]};
    *(float4*)(dst + 1 * 64) = float4{w_[0], w_[1], w_[2], w_[3]};
    *(float4*)(dst + 2 * 64) = float4{b_[0], b_[1], b_[2], b_[3]};
    *(float4*)(dst + 3 * 64) = float4{kd_[0], kd_[1], kd_[2], kd_[3]};
    *(float4*)(dst + 4 * 64) = float4{r_[0], r_[1], r_[2], r_[3]};
    *(float4*)(dst + 5 * 64) = float4{v_[0], v_[1], v_[2], v_[3]};
  };
  if (ldo) { prefetch(0); stage_store(0); }
  __syncthreads();
  for (int tb = 0; tb < 16; ++tb) {
    const bool more = tb + 1 < 16;
    if (more && ldo) prefetch(tb + 1);
    if (act) {
      const float* sb = stage + ((size_t)(((tb & 1) * 2 + cslot) * 16) * 6) * 64;
      for (int sg = 0; sg < 8; ++sg) {
        float ysv[2][2];
#pragma unroll
        for (int s4 = 0; s4 < 2; ++s4) {
          const int st = sg * 2 + s4;
          const float* v6 = sb + st * 384 + jg * 8;
          f2 nkk[4], w[4], bb[4], kd[4], rr[4];
#pragma unroll
          for (int q = 0; q < 2; ++q) {
            float4 t0 = *(const float4*)(v6 + 0 * 64 + q * 4);
            nkk[q * 2] = f2{t0.x, t0.y}; nkk[q * 2 + 1] = f2{t0.z, t0.w};
            float4 t1 = *(const float4*)(v6 + 1 * 64 + q * 4);
            w[q * 2] = f2{t1.x, t1.y}; w[q * 2 + 1] = f2{t1.z, t1.w};
            float4 t2 = *(const float4*)(v6 + 2 * 64 + q * 4);
            bb[q * 2] = f2{t2.x, t2.y}; bb[q * 2 + 1] = f2{t2.z, t2.w};
            float4 t3 = *(const float4*)(v6 + 3 * 64 + q * 4);
            kd[q * 2] = f2{t3.x, t3.y}; kd[q * 2 + 1] = f2{t3.z, t3.w};
            float4 t4 = *(const float4*)(v6 + 4 * 64 + q * 4);
            rr[q * 2] = f2{t4.x, t4.y}; rr[q * 2 + 1] = f2{t4.z, t4.w};
          }
          float2 vv2 = *(const float2*)(sb + st * 384 + 5 * 64 + row0);
          float vi[2] = {vv2.x, vv2.y};
          if (SEG && slot == 1) { vi[0] = 0.f; vi[1] = 0.f; }
#pragma unroll
          for (int r2 = 0; r2 < 2; ++r2) {
            f2 sa2a = S[r2][0] * nkk[0], sa2b = S[r2][1] * nkk[1];
            sa2a += S[r2][2] * nkk[2]; sa2b += S[r2][3] * nkk[3];
            f2 sat = sa2a + sa2b;
            float sa = sat.x + sat.y;
            sa += dpp_xor1(sa);
            sa += dpp_xor2(sa);
            sa += dpp_hmirror(sa);
            f2 y2a, y2b;
            {
              f2 t0 = S[r2][0] * w[0] + vi[r2] * kd[0]; S[r2][0] = t0 + sa * bb[0]; y2a = S[r2][0] * rr[0];
              f2 t1 = S[r2][1] * w[1] + vi[r2] * kd[1]; S[r2][1] = t1 + sa * bb[1]; y2b = S[r2][1] * rr[1];
              f2 t2 = S[r2][2] * w[2] + vi[r2] * kd[2]; S[r2][2] = t2 + sa * bb[2]; y2a += S[r2][2] * rr[2];
              f2 t3 = S[r2][3] * w[3] + vi[r2] * kd[3]; S[r2][3] = t3 + sa * bb[3]; y2b += S[r2][3] * rr[3];
            }
            f2 yt = y2a + y2b;
            float y = yt.x + yt.y;
            y += dpp_xor1(y);
            y += dpp_xor2(y);
            y += dpp_hmirror(y);
            ysv[s4][r2] = y;
          }
        }
        if (jg == 0) {
#pragma unroll
          for (int s4 = 0; s4 < 2; ++s4)
            *(float2*)(ylds + (slot * 16 + sg * 2 + s4) * 64 + row0) = float2{ysv[s4][0], ysv[s4][1]};
        }
      }
    }
    __syncthreads();
    if (more && ldo) stage_store((tb + 1) & 1);
    if (ywr) {
      int s = sbase + tb * 16 + lstep;
      int pos = ld ? Ls - 1 - s : s;
      int r = lb * Ls + pos;
      float4 yv = *(const float4*)(ylds + (lslot * 16 + lstep) * 64 + sub * 4);
      *(uint2*)(yout + (size_t)r * 1024 + lh * 64 + sub * 4) = uint2{pack2(yv.x, yv.y), pack2(yv.z, yv.w)};
    }
    __syncthreads();
  }
  if (act) {
#pragma unroll
    for (int r2 = 0; r2 < 2; ++r2) {
      float* so;
      if (SEG) so = p.out + 8388608 + ((size_t)((chain * 8 + seg) * 2 + slot)) * 4096 + (row0 + r2) * 64 + jg * 8;
      else so = p.out + (d ? OUT_WKVB : OUT_WKVF) + ((size_t)((g * 16 + b) * 16 + h) * 64 + row0 + r2) * 64 + jg * 8;
#pragma unroll
      for (int c = 0; c < 4; ++c) { so[2 * c] = S[r2][c].x; so[2 * c + 1] = S[r2][c].y; }
    }
  }
}

__device__ __forceinline__ void wkv_fix(const Params& p, char* smem, int chain) {
  char* ws = p.ws;
  const int tid = get_tid(), lane = tid & 63, wave = tid >> 6;
  const int d = chain & 1, h = (chain >> 1) & 15, b = chain >> 5;
  const float* SE = p.out + 8388608;
  u16* yout = (u16*)(ws + (d ? OFF_WYB : OFF_WYF));
  const u16* Q = (const u16*)(ws + OFF_YM) + (d ? (size_t)TG * 1024 : 0);
  float* Pl = (float*)smem;
  float* Sl = (float*)(smem + 16384);
  u16* Ql = (u16*)(smem + 36864);
  const int i = lane;
  float S0[64];
  {
    const float* src = SE + ((size_t)(chain * 8) * 2) * 4096 + i * 64;
#pragma unroll
    for (int j = 0; j < 16; ++j) {
      float4 t = *(const float4*)(src + j * 4);
      S0[j * 4] = t.x; S0[j * 4 + 1] = t.y; S0[j * 4 + 2] = t.z; S0[j * 4 + 3] = t.w;
    }
  }
  for (int k = 1; k < 8; ++k) {
#pragma unroll
    for (int e = 0; e < 4; ++e) {
      int idx = tid + e * 512;
      int tt = idx >> 3, ch = idx & 7;
      int s = k * 256 + tt;
      int pos = d ? 2047 - s : s;
      int r = b * 2048 + pos;
      *(uint4*)(Ql + tt * 64 + ch * 8) = *(const uint4*)(Q + (size_t)r * 1024 + h * 64 + ch * 8);
    }
    if (k < 7) {
      const float* src = SE + ((size_t)((chain * 8 + k) * 2 + 1)) * 4096;
#pragma unroll
      for (int e = 0; e < 2; ++e) ((float4*)Pl)[tid + e * 512] = ((const float4*)src)[tid + e * 512];
    }
    __syncthreads();
    for (int n = 0; n < 32; ++n) {
      int tt = wave + n * 8;
      float a0 = 0.f, a1 = 0.f;
#pragma unroll
      for (int jc = 0; jc < 8; ++jc) {
        float q[8];
        unpack8(*(const uint4*)(Ql + tt * 64 + jc * 8), q);
#pragma unroll
        for (int e = 0; e < 8; e += 2) { a0 += S0[jc * 8 + e] * q[e]; a1 += S0[jc * 8 + e + 1] * q[e + 1]; }
      }
      int s = k * 256 + tt;
      int pos = d ? 2047 - s : s;
      size_t off = (size_t)(b * 2048 + pos) * 1024 + h * 64 + i;
      yout[off] = f2bf(bf2f(yout[off]) + (a0 + a1));
    }
    if (k < 7) {
      float nv[8];
      const float* sl = SE + ((size_t)((chain * 8 + k) * 2)) * 4096 + i * 64 + wave * 8;
      {
        float4 t0 = *(const float4*)sl, t1 = *(const float4*)(sl + 4);
        nv[0] = t0.x; nv[1] = t0.y; nv[2] = t0.z; nv[3] = t0.w; nv[4] = t1.x; nv[5] = t1.y; nv[6] = t1.z; nv[7] = t1.w;
      }
#pragma unroll
      for (int m = 0; m < 64; ++m) {
        float4 p0 = *(const float4*)(Pl + m * 64 + wave * 8), p1 = *(const float4*)(Pl + m * 64 + wave * 8 + 4);
        nv[0] += S0[m] * p0.x; nv[1] += S0[m] * p0.y; nv[2] += S0[m] * p0.z; nv[3] += S0[m] * p0.w;
        nv[4] += S0[m] * p1.x; nv[5] += S0[m] * p1.y; nv[6] += S0[m] * p1.z; nv[7] += S0[m] * p1.w;
      }
      *(float4*)(Sl + i * 68 + wave * 8) = float4{nv[0], nv[1], nv[2], nv[3]};
      *(float4*)(Sl + i * 68 + wave * 8 + 4) = float4{nv[4], nv[5], nv[6], nv[7]};
      __syncthreads();
#pragma unroll
      for (int j = 0; j < 16; ++j) {
        float4 t = *(const float4*)(Sl + i * 68 + j * 4);
        S0[j * 4] = t.x; S0[j * 4 + 1] = t.y; S0[j * 4 + 2] = t.z; S0[j * 4 + 3] = t.w;
      }
    }
    __syncthreads();
  }
}

__device__ __forceinline__ void step_scan(const Params& p, char* smem, int g) {
  const int G = gridDim.x;
  const int r1 = (RM & (1 << 20)) ? 2 : 1, r2 = (RM & (1 << 21)) ? 2 : 1;
  if (g < 2) {
    for (int rr = 0; rr < r1; ++rr) {
      SsdPre R;
      if ((int)blockIdx.x < 1024) ssd_issue(p, g, blockIdx.x, 0, get_tid(), R);
      for (int ch = blockIdx.x; ch < 1024; ch += G) ssd_chain(p, smem, g, ch, ch + G < 1024 ? ch + G : -1, R);
    }
    for (int rr = 0; rr < r2; ++rr) for (int it = blockIdx.x; it < 256; it += G) wkv_pair<false>(p, smem, g, it);
  } else {
    for (int rr = 0; rr < r1; ++rr) {
      SsdPre R;
      if ((int)blockIdx.x < 128) ssd_issue(p, g, blockIdx.x, 0, get_tid(), R);
      for (int ch = blockIdx.x; ch < 128; ch += G) ssd_chain(p, smem, g, ch, ch + G < 128 ? ch + G : -1, R);
    }
    for (int rr = 0; rr < r2; ++rr) for (int it = (G - 1 - blockIdx.x); it < 512; it += G) wkv_pair<true>(p, smem, g, it);
  }
}
__device__ __forceinline__ void step_fix(const Params& p, char* smem) {
  for (int ch = blockIdx.x; ch < 64; ch += gridDim.x) wkv_fix(p, smem, ch);
}

__device__ __forceinline__ void step_fin(const Params& p, int g) {
  char* ws = p.ws;
  const int tid = get_tid(), lane = tid & 63, wave = tid >> 6;
  const int gw = blockIdx.x * 8 + wave, nw = gridDim.x * 8;
  {
    const u16* yf = (const u16*)(ws + OFF_SYF);
    const u16* yb = (const u16*)(ws + OFF_SYB);
    const u16* xbc = (const u16*)(ws + OFF_XBC);
    const u16* zb = (const u16*)(ws + OFF_Z);
    u16* ym = (u16*)(ws + OFF_YM);
    for (int it = gw; it < TG * 4; it += nw) {
      int r = it >> 2, gq = it & 3;
      int ch = gq * 512 + lane * 8;
      uint4 a = *(const uint4*)(yf + (size_t)r * 2048 + ch);
      uint4 b = *(const uint4*)(yb + (size_t)r * 2048 + ch);
      uint4 x = *(const uint4*)(xbc + (size_t)r * 3072 + ch);
      uint4 z = *(const uint4*)(zb + (size_t)r * 2048 + ch);
      float dsk = p.d_skip[ch >> 6];
      unsigned aw[4] = {a.x, a.y, a.z, a.w}, bw[4] = {b.x, b.y, b.z, b.w}, xw[4] = {x.x, x.y, x.z, x.w}, zw[4] = {z.x, z.y, z.z, z.w};
      float y[8];
      float ss = 0.f;
#pragma unroll
      for (int e = 0; e < 8; ++e) {
        int sh = (e & 1) * 16;
        float yy = bf2f((u16)(aw[e >> 1] >> sh)) + bf2f((u16)(bw[e >> 1] >> sh)) + dsk * bf2f((u16)(xw[e >> 1] >> sh));
        yy *= siluf(bf2f((u16)(zw[e >> 1] >> sh)));
        y[e] = yy;
        ss += yy * yy;
      }
      ss = wave_sum(ss);
      float rinv = rsqrtf(ss * (1.f / 512.f) + 1e-5f);
      float4 w0 = *(const float4*)(p.m_norm_w + ch), w1 = *(const float4*)(p.m_norm_w + ch + 4);
      *(uint4*)(ym + (size_t)r * 2048 + ch) =
          uint4{pack2(y[0] * rinv * w0.x, y[1] * rinv * w0.y), pack2(y[2] * rinv * w0.z, y[3] * rinv * w0.w),
                pack2(y[4] * rinv * w1.x, y[5] * rinv * w1.y), pack2(y[6] * rinv * w1.z, y[7] * rinv * w1.w)};
    }
  }
  {
    const u16* yf = (const u16*)(ws + OFF_WYF);
    const u16* yb = (const u16*)(ws + OFF_WYB);
    const __half* wk = (const __half*)(ws + OFF_WK);
    const u16* gr = (const u16*)(ws + OFF_GR);
    u16* yr = (u16*)(ws + OFF_YR);
    for (int it = gw; it < TG * 4; it += nw) {
      const int r = it >> 2, h0 = (it & 3) * 4;
      float yv[4], rr[4], vv[4], kk[4], af[4], ab[4], gg[4];
#pragma unroll
      for (int u = 0; u < 4; ++u) {
        int c = (h0 + u) * 64 + lane;
        yv[u] = bf2f(yf[(size_t)r * 1024 + c]) + bf2f(yb[(size_t)r * 1024 + c]);
        const __half* rec = wk + ((size_t)(r * 16 + h0 + u) * 8) * 64 + lane;
        rr[u] = __half2float(rec[0]); vv[u] = __half2float(rec[64]); kk[u] = __half2float(rec[128]);
        af[u] = __half2float(rec[5 * 64]); ab[u] = __half2float(rec[7 * 64]);
        gg[u] = bf2f(gr[(size_t)r * 1024 + c]);
      }
#pragma unroll
      for (int u = 0; u < 4; ++u) {
        int c = (h0 + u) * 64 + lane;
        float y = yv[u];
        float mean = wave_sum(y) * (1.f / 64.f);
        float dy = y - mean;
        float var = wave_sum(dy * dy) * (1.f / 64.f);
        float yn = dy * rsqrtf(var + 64e-5f) * p.lnx_w[c] + p.lnx_b[c];
        float kmean = kk[u] * (1.f + (0.5f * (af[u] + ab[u]) - 1.f) * p.k_a[c]);
        float bs = wave_sum(rr[u] * kmean * p.r_k[c]);
        float o = (yn + bs * vv[u]) * gg[u];
        yr[(size_t)r * 1024 + c] = f2bf(o);
      }
    }
  }
}

__device__ __forceinline__ void step_outproj(const Params& p, char* smem, int g) {
  char* ws = p.ws;
  u16* Ug = (u16*)p.out + (size_t)g * TG * 1024;
  EpiOut<0> E0{(const u16*)(ws + OFF_GATE), Ug};
  run_gemm8(smem, (const u16*)(ws + OFF_YM), (const u16*)(ws + OFF_WMOUT), TG, 1024, 2048, E0);
  EpiOut<1> E1{(const u16*)(ws + OFF_GATE), Ug};
  run_gemm8(smem, (const u16*)(ws + OFF_YR), (const u16*)(ws + OFF_WROUT), TG, 1024, 1024, E1);
}

__device__ __forceinline__ void step_wo(const Params& p, char* smem, int g) {
  char* ws = p.ws;
  EpiWo E{p.x_prompt, p.x_sample, (const float*)(ws + OFF_MOD), (float*)(ws + OFF_X1), 0};
  run_gemm8(smem, (const u16*)p.out, (const u16*)(ws + OFF_WO), NTOK, 1024, 1024, E);
}

__device__ __forceinline__ void step_gu(const Params& p, char* smem) {
  char* ws = p.ws;
  EpiGU E{(u16*)(ws + OFF_ACT)};
  run_gemm8(smem, (const u16*)(ws + OFF_H2), (const u16*)(ws + OFF_WGU), NTOK, 5632, 1024, E);
}

__device__ __forceinline__ void step_down(const Params& p, char* smem) {
  char* ws = p.ws;
  EpiDown E{(const float*)(ws + OFF_MOD), (float*)(ws + OFF_X1)};
  run_gemm8(smem, (const u16*)(ws + OFF_ACT), (const u16*)(ws + OFF_WDOWN), NTOK, 1024, 2816, E);
}

__device__ __forceinline__ void step_final(const Params& p) {
  const int tid = get_tid(), lane = tid & 63, wave = tid >> 6;
  for (int r = blockIdx.x * 8 + wave; r < NTOK; r += gridDim.x * 8) {
    const float* xr = (const float*)(p.ws + OFF_X1) + (size_t)r * 1024;
    float* xo = p.out + (size_t)r * 1024;
    float4 v[4];
    float ss = 0.f;
#pragma unroll
    for (int i = 0; i < 4; ++i) {
      v[i] = ((const float4*)xr)[i * 64 + lane];
      ss += v[i].x * v[i].x + v[i].y * v[i].y + v[i].z * v[i].z + v[i].w * v[i].w;
    }
    ss = wave_sum(ss);
    float rinv = rsqrtf(ss * (1.f / 1024.f) + 1e-6f);
#pragma unroll
    for (int i = 0; i < 4; ++i) {
      float4 w4 = ((const float4*)p.final_norm_w)[i * 64 + lane];
      ((float4*)xo)[i * 64 + lane] = float4{v[i].x * rinv * w4.x, v[i].y * rinv * w4.y, v[i].z * rinv * w4.z, v[i].w * rinv * w4.w};
    }
  }
}

constexpr int NSTEPS = 30;

__global__ void __launch_bounds__(NTHR) mega(Params p_arg) {
  const int step_lo = p_arg.step_lo, step_hi = p_arg.step_hi;
  __shared__ __attribute__((aligned(16))) char smem[SMEM_BYTES];
#if !MULTI_LAUNCH
  if (threadIdx.x == 0) *(uint4*)(smem + SMEM_BYTES - 16) = uint4{0u, 0u, 0u, 0u};
  __syncthreads();
  XcdBarrier xb = xcd_barrier_post((unsigned*)(p_arg.ws + OFF_BAR), (volatile LAS unsigned*)(smem + SMEM_BYTES - 16));
#endif
  for (int step = step_lo; step <= step_hi; ++step) {
#if defined(__HIP_DEVICE_COMPILE__)
    const __attribute__((address_space(4))) Params* pp = (const __attribute__((address_space(4))) Params*)__builtin_amdgcn_kernarg_segment_ptr();
    asm volatile("" : "+s"(pp));
    const Params p = *pp;
#else
    const Params p = p_arg;
#endif
    const int g = (step - 1) >> 3, s = (step - 1) & 7;
    const int scode = step == 0 ? 0 : (step <= 24 ? 1 + s : step - 16);
    if (scode == 6 && g < 2) continue;
    if (scode == 1 && g > 0) continue;
    const int reps = ((RM >> scode) & 1) ? 2 : 1;
    for (int rep = 0; rep < reps; ++rep) {
      if (!((SM >> scode) & 1)) continue;
      switch (scode) {
        case 0: step_prep(p, smem); break;
        case 1: step_norm<0>(p, g); break;
        case 2: step_gemm1(p, smem); break;
        case 3: step_cr1(p, g); break;
        case 4: step_r2(p, smem); break;
        case 5: step_scan(p, smem, g); break;
        case 6: step_fix(p, smem); break;
        case 7: step_fin(p, g); break;
        case 8:
          if (blockIdx.x < 64) step_outproj(p, smem, g);
          else if (g == 0) {
            convT<1>(p.w_gu, 1024, 5632, (u16*)(p.ws + OFF_WGU), smem, blockIdx.x - 64, gridDim.x - 64);
            convT<0>(p.w_down, 2816, 1024, (u16*)(p.ws + OFF_WDOWN), smem, blockIdx.x - 64, gridDim.x - 64);
          }
          if (g < 2) step_norm<0>(p, g + 1);
          break;
        case 9: step_wo(p, smem, 0); break;
        case 10: step_norm<1>(p, 0); break;
        case 11: step_gu(p, smem); break;
        case 12: step_down(p, smem); break;
        default: step_final(p); break;
      }
    }
    if (step < step_hi) {
#if !MULTI_LAUNCH
      if (step_hi > 100000) cg::this_grid().sync();
      for (int xs = 0; xs < 1 + XSYNC; ++xs) xcd_barrier(xb);
#endif
    }
  }
}

extern "C" void kernel_launch(void* const* d_in, const int* in_sizes, int n_in, void* d_out, int out_size,
                              void* d_ws, size_t ws_size, hipStream_t stream) {
  Params p{};
  const float** pp = (const float**)&p;
  for (int i = 0; i < 36; ++i) pp[i] = (const float*)d_in[i];
  p.out = (float*)d_out;
  p.ws = (char*)d_ws;
  if (ws_size < WS_NEED) fprintf(stderr, "workspace too small: %zu < %zu\n", ws_size, (size_t)WS_NEED);
#if MULTI_LAUNCH
  for (int s = 0; s < NSTEPS; ++s) {
    p.step_lo = s;
    p.step_hi = s;
    hipLaunchKernelGGL(mega, dim3(256), dim3(NTHR), 0, stream, p);
  }
#else
  static int grid_blocks = 0;
  if (!grid_blocks) {
    int dev = 0, cus = 0, per_cu = 0;
    hipGetDevice(&dev);
    hipDeviceGetAttribute(&cus, hipDeviceAttributeMultiprocessorCount, dev);
    hipOccupancyMaxActiveBlocksPerMultiprocessor(&per_cu, mega, NTHR, 0);
    if (per_cu < 1) per_cu = 1;
    if (per_cu > 1) per_cu = 1;
    grid_blocks = cus * per_cu;
  }
  p.step_lo = 0;
  p.step_hi = NSTEPS - 1;
  void* args[] = {&p};
  hipMemsetAsync((char*)d_ws + OFF_BAR, 0, XCD_BAR_WORDS_C * 4, stream);
  hipError_t e = hipLaunchCooperativeKernel((void*)mega, dim3(grid_blocks), dim3(NTHR), args, 0, stream);
  if (e != hipSuccess) fprintf(stderr, "cooperative launch failed: %s (grid %d)\n", hipGetErrorString(e), grid_blocks);
#endif
}
```

```cpp
#include <hip/hip_runtime.h>
#include <hip/hip_cooperative_groups.h>
#include <hip/hip_fp16.h>
#include <cstdio>
#include <cstdint>
namespace cg = cooperative_groups;

#ifndef MULTI_LAUNCH
#define MULTI_LAUNCH 0
#endif

#define DI __device__ __forceinline__
typedef __attribute__((ext_vector_type(8))) short bf16x8;
typedef __attribute__((ext_vector_type(4))) float f32x4;
typedef unsigned short u16;

#ifndef STEP_MASK
#define STEP_MASK 0xffffff
#endif
constexpr int SM = STEP_MASK;
#ifndef REPEAT_MASK
#define REPEAT_MASK 0
#endif
#ifndef XSYNC
#define XSYNC 0
#endif
constexpr int RM = REPEAT_MASK;
constexpr int TG = 4096;
constexpr int NTOK = 12288;
constexpr int NPAD = 10752;
constexpr int NTHR = 512;
constexpr int SMEM_BYTES = 133120;
constexpr int XCD_BAR_WORDS_C = 3456;

constexpr size_t OFF_WIN = 0;
constexpr size_t OFF_WGU = OFF_WIN + (size_t)NPAD * 1024 * 2;
constexpr size_t OFF_WDOWN = OFF_WGU + (size_t)5632 * 1024 * 2;
constexpr size_t OFF_WMOUT = OFF_WDOWN + (size_t)1024 * 2816 * 2;
constexpr size_t OFF_WROUT = OFF_WMOUT + (size_t)1024 * 2048 * 2;
constexpr size_t OFF_WO = OFF_WROUT + (size_t)1024 * 1024 * 2;
constexpr size_t OFF_W2T = OFF_WO + (size_t)1024 * 1024 * 2;
constexpr size_t OFF_A2T = OFF_W2T + 262144;
constexpr size_t OFF_G2T = OFF_A2T + 262144;
constexpr size_t OFF_MOD = OFF_G2T + 262144;
constexpr size_t OFF_GRP = OFF_MOD + 73728;
constexpr size_t OFF_Z = OFF_GRP;
constexpr size_t OFF_GATE = OFF_Z + (size_t)TG * 2048 * 2;
constexpr size_t OFF_XBC = OFF_GATE + (size_t)TG * 2048 * 2;
constexpr size_t OFF_WK = OFF_XBC + (size_t)TG * 3072 * 2;
constexpr size_t OFF_GR = OFF_WK + (size_t)TG * 16 * 1024;
constexpr size_t OFF_DT = OFF_GR + (size_t)TG * 1024 * 2;
constexpr size_t OFF_TL = OFF_DT + (size_t)TG * 64 * 4;
constexpr size_t OFF_SG = OFF_TL + (size_t)TG * 256 * 2;
constexpr size_t OFF_R = OFF_SG + (size_t)TG * 128 * 2;
constexpr size_t OFF_H1 = OFF_R;
constexpr size_t OFF_XBCRAW = OFF_H1 + (size_t)TG * 1024 * 2;
constexpr size_t OFF_RW = OFF_XBCRAW + (size_t)TG * 3072 * 2;
constexpr size_t OFF_SYF = OFF_R;
constexpr size_t OFF_SYB = OFF_SYF + (size_t)TG * 2048 * 2;
constexpr size_t OFF_WYF = OFF_SYB + (size_t)TG * 2048 * 2;
constexpr size_t OFF_WYB = OFF_WYF + (size_t)TG * 1024 * 2;
constexpr size_t OFF_YM = OFF_WYB + (size_t)TG * 1024 * 2;
constexpr size_t OFF_YR = OFF_YM + (size_t)TG * 2048 * 2;
constexpr size_t OFF_END = OFF_YR + (size_t)TG * 1024 * 2;
constexpr size_t OFF_BAR = OFF_END;
constexpr size_t OFF_W4T = OFF_BAR + 16384;
constexpr size_t WS_NEED = OFF_W4T + (size_t)4096 * 256 * 2;
constexpr size_t OFF_U = OFF_XBC;
constexpr size_t OFF_H2 = OFF_GRP;
constexpr size_t OFF_ACT = OFF_H2 + (size_t)NTOK * 1024 * 2;
constexpr size_t OFF_X1 = OFF_ACT + (size_t)NTOK * 2816 * 2;

constexpr size_t OUT_SSMF = 12582912;
constexpr size_t OUT_SSMB = OUT_SSMF + 8388608;
constexpr size_t OUT_WKVF = OUT_SSMB + 8388608;
constexpr size_t OUT_WKVB = OUT_WKVF + 2097152;

struct Params {
  const float *x_prompt, *x_sample, *ssm_f, *ssm_b, *wkv_f, *wkv_b, *c, *c_ctx, *norm1_w, *norm2_w,
      *w_ada, *b_ada, *w_in, *conv_w, *conv_b, *dt_bias, *a_log, *d_skip, *m_norm_w, *mu_shift, *w0,
      *w2, *a0, *a2, *g2, *k_k, *k_a, *r_k, *lnx_w, *lnx_b, *w_m_out, *w_r_out, *w_o, *w_gu, *w_down,
      *final_norm_w;
  float* out;
  char* ws;
  int step_lo, step_hi;
};

DI int get_tid() {
  int t = threadIdx.x;
  asm volatile("" : "+v"(t));
  return t;
}
DI u16 f2bf(float f) {
  unsigned u = __float_as_uint(f);
  u += 0x7fffu + ((u >> 16) & 1u);
  return (u16)(u >> 16);
}
DI float bf2f(u16 h) { return __uint_as_float(((unsigned)h) << 16); }
DI float siluf(float x) { return x / (1.f + __expf(-x)); }
DI float sigm(float x) { return 1.f / (1.f + __expf(-x)); }
DI float wave_sum(float v) {
  v += __int_as_float(__builtin_amdgcn_update_dpp(0, __float_as_int(v), 0xB1, 0xF, 0xF, true));
  v += __int_as_float(__builtin_amdgcn_update_dpp(0, __float_as_int(v), 0x4E, 0xF, 0xF, true));
  v += __int_as_float(__builtin_amdgcn_update_dpp(0, __float_as_int(v), 0x141, 0xF, 0xF, true));
  v += __int_as_float(__builtin_amdgcn_update_dpp(0, __float_as_int(v), 0x140, 0xF, 0xF, true));
  const int vi = __float_as_int(v);
  float a = __int_as_float(__builtin_amdgcn_readlane(vi, 0)), b = __int_as_float(__builtin_amdgcn_readlane(vi, 16));
  float c = __int_as_float(__builtin_amdgcn_readlane(vi, 32)), d = __int_as_float(__builtin_amdgcn_readlane(vi, 48));
  return (a + b) + (c + d);
}
DI float dpp_xor1(float v) { return __int_as_float(__builtin_amdgcn_update_dpp(0, __float_as_int(v), 0xB1, 0xF, 0xF, true)); }
DI float dpp_hmirror(float v) { return __int_as_float(__builtin_amdgcn_update_dpp(0, __float_as_int(v), 0x141, 0xF, 0xF, true)); }
DI float dpp_xor2(float v) { return __int_as_float(__builtin_amdgcn_update_dpp(0, __float_as_int(v), 0x4E, 0xF, 0xF, true)); }
DI unsigned pack2(float a, float b) { return (unsigned)f2bf(a) | ((unsigned)f2bf(b) << 16); }
DI int mrow_of(int tok) { return tok < 8192 ? 0 : 1 + ((tok - 8192) >> 11); }


#define XB_TMO      128
#define XB_XCNT(j)  (256  + 64 * (j))
#define XB_XSUB(j)  (1280 + 64 * (j))
#define XB_XGEN(j)  (2304 + 64 * (j))
#define XB_TOP      3328
#define XB_TOPGEN   3392
#define XCD_BAR_WORDS 3456
#define XB_SPIN_CAP (1u << 22)
#define LAS __attribute__((address_space(3)))
DI unsigned xb_ld(unsigned* p) { return __hip_atomic_load(p, __ATOMIC_RELAXED, __HIP_MEMORY_SCOPE_AGENT); }
DI unsigned xb_add(unsigned* p, unsigned v) { return __hip_atomic_fetch_add(p, v, __ATOMIC_RELAXED, __HIP_MEMORY_SCOPE_AGENT); }
DI unsigned xb_xcc_id() { return (unsigned)__builtin_amdgcn_s_getreg((3 << 11) | 20) & 0xFu; }
#define XB_SPIN(cond, bar) do { unsigned _sp = 0; while (cond) { __builtin_amdgcn_s_sleep(1); \
    if ((++_sp & 255u) == 0u) { if (xb_ld(&(bar)[XB_TMO])) break; if (_sp > XB_SPIN_CAP) { atomicAdd(&(bar)[XB_TMO], 1u); break; } } } } while (0)
struct XcdBarrier { unsigned* bar; unsigned x; volatile LAS unsigned* st; };
DI XcdBarrier xcd_barrier_post(unsigned* bar, volatile LAS unsigned* st) {
  XcdBarrier b; b.bar = bar; b.x = xb_xcc_id(); b.st = st;
  if (threadIdx.x == 0) (void)xb_add(&bar[XB_XCNT(b.x)], 1u);
  return b;
}
DI void xcd_barrier_complete(unsigned* bar, unsigned x, unsigned& nloc, unsigned& nx) {
  const unsigned G = gridDim.x * gridDim.y * gridDim.z;
  unsigned sum, cnt, mine, sp = 0u;
  for (;;) {
    sum = 0u; cnt = 0u; mine = 0u;
#pragma unroll
    for (unsigned j = 0; j < 16; ++j) { const unsigned c = xb_ld(&bar[XB_XCNT(j)]); sum += c; cnt += (c > 0u) ? 1u : 0u; mine = (j == x) ? c : mine; }
    if (sum == G) break;
    __builtin_amdgcn_s_sleep(1);
    if ((++sp & 255u) == 0u) { if (xb_ld(&bar[XB_TMO])) break; if (sp > XB_SPIN_CAP) { atomicAdd(&bar[XB_TMO], 1u); break; } }
  }
  nloc = mine > 0u ? mine : 1u; nx = cnt > 0u ? cnt : 1u;
}
DI void xcd_barrier(const XcdBarrier& b) {
  asm volatile("s_waitcnt vmcnt(0)" ::: "memory");
  __syncthreads();
  if (threadIdx.x == 0) {
    unsigned* bar = b.bar;
    asm volatile("" : "+s"(bar));
    __builtin_amdgcn_s_waitcnt(0);
    unsigned nloc = b.st[0], nx = b.st[1];
    if (nloc == 0u) { xcd_barrier_complete(bar, b.x, nloc, nx); b.st[0] = nloc; b.st[1] = nx; }
    const unsigned old = xb_add(&bar[XB_XSUB(b.x)], 1u);
    const unsigned gen = old / nloc;
    if (old + 1u == (gen + 1u) * nloc) {
      __builtin_amdgcn_fence(__ATOMIC_RELEASE, "agent");
      asm volatile("s_waitcnt vmcnt(0)" ::: "memory");
      const unsigned og = xb_add(&bar[XB_TOP], 1u);
      const unsigned tg = og / nx;
      if (og + 1u == (tg + 1u) * nx) xb_add(&bar[XB_TOPGEN], 1u);
      else XB_SPIN(xb_ld(&bar[XB_TOPGEN]) == tg, bar);
      __builtin_amdgcn_fence(__ATOMIC_ACQUIRE, "agent");
      xb_add(&bar[XB_XGEN(b.x)], 1u);
      asm volatile("s_waitcnt vmcnt(0)" ::: "memory");
    } else {
      XB_SPIN(xb_ld(&bar[XB_XGEN(b.x)]) == gen, bar);
      __builtin_amdgcn_fence(__ATOMIC_ACQUIRE, "agent");
      asm volatile("s_waitcnt vmcnt(0)" ::: "memory");
    }
  }
  __syncthreads();
}

DI void gemm_load(const int tid, const u16* A, int lda, const u16* B, int ldb, int k0, uint4 (&ra)[4], uint4 (&rb)[2]) {
#pragma unroll
  for (int i = 0; i < 4; ++i) {
    int idx = tid + i * 512;
    int row = idx >> 3, ch = idx & 7;
    ra[i] = *(const uint4*)(A + (size_t)row * lda + k0 + ch * 8);
  }
#pragma unroll
  for (int i = 0; i < 2; ++i) {
    int idx = tid + i * 512;
    int row = idx >> 3, ch = idx & 7;
    rb[i] = *(const uint4*)(B + (size_t)row * ldb + k0 + ch * 8);
  }
}
DI void gemm_store_lds(const int tid, char* sA, char* sB, const uint4 (&ra)[4], const uint4 (&rb)[2]) {
#pragma unroll
  for (int i = 0; i < 4; ++i) {
    int idx = tid + i * 512;
    int row = idx >> 3, ch = idx & 7;
    *(uint4*)(sA + row * 128 + ((ch ^ ((row >> 1) & 7)) << 4)) = ra[i];
  }
#pragma unroll
  for (int i = 0; i < 2; ++i) {
    int idx = tid + i * 512;
    int row = idx >> 3, ch = idx & 7;
    *(uint4*)(sB + row * 128 + ((ch ^ ((row >> 1) & 7)) << 4)) = rb[i];
  }
}
DI void gemm_compute(const char* sA, const char* sB, f32x4 (&acc)[4][4], int wm, int wn, int lane) {
#pragma unroll
  for (int kk = 0; kk < 2; ++kk) {
    bf16x8 a[4], b[4];
    const int ch = kk * 4 + (lane >> 4);
#pragma unroll
    for (int mf = 0; mf < 4; ++mf) {
      int row = wm * 64 + mf * 16 + (lane & 15);
      a[mf] = *(const bf16x8*)(sA + row * 128 + ((ch ^ ((row >> 1) & 7)) << 4));
    }
#pragma unroll
    for (int nf = 0; nf < 4; ++nf) {
      int row = wn * 64 + nf * 16 + (lane & 15);
      b[nf] = *(const bf16x8*)(sB + row * 128 + ((ch ^ ((row >> 1) & 7)) << 4));
    }
#pragma unroll
    for (int mf = 0; mf < 4; ++mf)
#pragma unroll
      for (int nf = 0; nf < 4; ++nf)
        acc[mf][nf] = __builtin_amdgcn_mfma_f32_16x16x32_bf16(a[mf], b[nf], acc[mf][nf], 0, 0, 0);
  }
}
DI void gemm_acc(const u16* A, int lda, const u16* B, int ldb, int K, f32x4 (&acc)[4][4], char* smem) {
  const int tid = get_tid(), lane = tid & 63, wave = tid >> 6;
  const int wm = wave >> 1, wn = wave & 1;
  char* sA0 = smem;
  char* sB0 = smem + 32768;
  char* sA1 = smem + 49152;
  char* sB1 = smem + 81920;
  uint4 ra[4], rb[2];
  const int nk = K >> 6;
  gemm_load(tid, A, lda, B, ldb, 0, ra, rb);
  gemm_store_lds(tid, sA0, sB0, ra, rb);
  __syncthreads();
  for (int kt = 0; kt < nk; ++kt) {
    const bool more = (kt + 1 < nk);
    if (more) gemm_load(tid, A, lda, B, ldb, (kt + 1) * 64, ra, rb);
    if (kt & 1) gemm_compute(sA1, sB1, acc, wm, wn, lane);
    else gemm_compute(sA0, sB0, acc, wm, wn, lane);
    if (more) {
      if (kt & 1) gemm_store_lds(tid, sA0, sB0, ra, rb);
      else gemm_store_lds(tid, sA1, sB1, ra, rb);
    }
    __syncthreads();
  }
}
DI void zero_acc(f32x4 (&acc)[4][4]) {
#pragma unroll
  for (int i = 0; i < 4; ++i)
#pragma unroll
    for (int j = 0; j < 4; ++j) { float z0; asm volatile("v_mov_b32 %0, 0" : "=v"(z0)); acc[i][j] = f32x4{z0, z0, z0, z0}; }
}

#define PG8_LAS __attribute__((address_space(3)))
namespace pg8 {
typedef unsigned short bf16_t;
typedef short bf16x8 __attribute__((ext_vector_type(8)));
typedef float f32x4 __attribute__((ext_vector_type(4)));
typedef unsigned u32x4 __attribute__((ext_vector_type(4)));
constexpr int BM = 256, BK = 64, HALF = 128, HTB = HALF * BK * 2  , STAGE_BYTES = 8 * HTB, NXCD = 8, WGM = 8;

__host__ __device__ __forceinline__ int lds_byte(int r, int c) { const int st = (r >> 4) * 2 + (c >> 5), rr = r & 15, cc = c & 31, ob = rr * 64 + cc * 2; return st * 1024 + (ob ^ (((ob >> 9) & 1) << 5)); }
__host__ __device__ __forceinline__ void stage_rc(int b, int& R, int& C) { const int st = b / 1024, sb = b % 1024, swz = sb ^ (((sb >> 9) & 1) << 5); R = (st >> 1) * 16 + swz / 64; C = (st & 1) * 32 + (swz % 64) / 2; }
__host__ __device__ __forceinline__ int perm32(int rho) { const int n = rho >> 4, i = rho & 15; return 8 * (i >> 2) + 4 * n + (i & 3); }

struct Unit { int pm, pn; };
struct Gemm { const bf16_t* A; const bf16_t* Bt; int M, N, K; };

struct StaticOrder {
    int nM, nN, nwg, G, c;
    __host__ __device__ void init(int M, int N, int G_, int c_) { nM = M / BM; nN = N / BM; nwg = nM * nN; G = G_; c = c_; }
    __host__ __device__ bool next(int i, Unit& u) const {
        const long L = (long)i * G + c; if (L >= nwg) return false;
        int wgid = (int)L; { const int q = nwg / NXCD, r = nwg % NXCD, xcd = wgid % NXCD, off = wgid / NXCD; wgid = (xcd < r ? xcd * (q + 1) : r * (q + 1) + (xcd - r) * q) + off; }
        const int nig = WGM * nN, gid = wgid / nig, fm = gid * WGM, gsz = (nM - fm) < WGM ? (nM - fm) : WGM;
        u.pm = fm + ((wgid % nig) % gsz); u.pn = (wgid % nig) / gsz; return true;
    }
    __device__ __forceinline__ void a_ready(const Unit&) const {}
    __device__ __forceinline__ void done(const Unit&) const {}
};
__device__ __forceinline__ unsigned cvt_pk_bf16(float lo, float hi) { unsigned r; asm volatile("v_cvt_pk_bf16_f32 %0, %1, %2" : "=v"(r) : "v"(lo), "v"(hi)); return r; }
template <class Epi, class Sched, bool STAMP = false>
__device__ __forceinline__ void gemm_phase(PG8_LAS unsigned char* lds, const Gemm g, const Sched& S, const Epi& E, unsigned long long* stamps) {
    const int tid = get_tid(), wid = __builtin_amdgcn_readfirstlane(tid >> 6), lane = tid & 63, wr = wid >> 2, wc = wid & 3, fr = lane & 15, fq = lane >> 4;
    const int K = g.K, nt = K / BK;
    int ts_lo = 0, ts_hi = 0, nts = 0; const unsigned long long rt_entry = STAMP ? (unsigned long long)wall_clock64() : 0ull;
#define PG8_STAMP() do { if (STAMP && wid == 0 && nts < 64) { const unsigned long long _c = (unsigned long long)clock64(); \
        ts_lo = (lane == nts) ? (int)(unsigned)_c : ts_lo; ts_hi = (lane == nts) ? (int)(unsigned)(_c >> 32) : ts_hi; ++nts; } } while (0)
    PG8_STAMP();
    unsigned voffA[2], voffB[2];
#pragma unroll
    for (int i = 0; i < 2; ++i) { int R, C; stage_rc(tid * 16 + i * 8192, R, C); const int Rb = Epi::PERM ? ((R & ~31) + perm32(R & 31)) : R;
        voffA[i] = (unsigned)(R * K + C) * 2u; voffB[i] = (unsigned)(Rb * K + C) * 2u; }
    const size_t kstep = (size_t)(BK * 2);
    const size_t hstep = (size_t)HALF * K * 2;
    const size_t tstep = 2 * hstep;
    const unsigned ldsw = (unsigned)wid * 1024u;
    const int aoff = lds_byte(wr * 64 + fr, fq * 8), boff = lds_byte(wc * 32 + fr, fq * 8);
#define PG8_SA(b, h) (((b) * 2 + (h)) * HTB)
#define PG8_SB(b, h) ((4 + (b) * 2 + (h)) * HTB)
#define PG8_STAGE(bufoff, gbase, voff) do { _Pragma("unroll") for (int _i = 0; _i < 2; ++_i) \
        __builtin_amdgcn_global_load_lds((const unsigned*)((const char*)(gbase) + (voff)[_i]), (PG8_LAS unsigned*)(lds + (bufoff) + ldsw + _i * 8192), 16, 0, 0); } while (0)
#define PG8_LDA(dst, b, h) do { _Pragma("unroll") for (int m = 0; m < 4; ++m) _Pragma("unroll") for (int k = 0; k < 2; ++k) dst[m][k] = *(const PG8_LAS bf16x8*)(lds + PG8_SA(b, h) + aoff + m * 2048 + k * 1024); } while (0)
#define PG8_LDB(dst, b, h) do { _Pragma("unroll") for (int n = 0; n < 2; ++n) _Pragma("unroll") for (int k = 0; k < 2; ++k) dst[n][k] = *(const PG8_LAS bf16x8*)(lds + PG8_SB(b, h) + boff + n * 2048 + k * 1024); } while (0)
#define PG8_MMA(ai, bj, At, Bt) do { __builtin_amdgcn_s_setprio(1); _Pragma("unroll") for (int m = 0; m < 4; ++m) _Pragma("unroll") for (int n = 0; n < 2; ++n) _Pragma("unroll") for (int k = 0; k < 2; ++k) \
        acc[ai][bj][m][n] = __builtin_amdgcn_mfma_f32_16x16x32_bf16(Bt[n][k], At[m][k], acc[ai][bj][m][n], 0, 0, 0); __builtin_amdgcn_s_setprio(0); } while (0)
#define PG8_WAIT_V(n) asm volatile("s_waitcnt vmcnt(" #n ")" ::: "memory")
#define PG8_WAIT_L(n) asm volatile("s_waitcnt lgkmcnt(" #n ")" ::: "memory")
#define PG8_BAR __builtin_amdgcn_s_barrier()
#define PG8_SCHED __builtin_amdgcn_sched_barrier(0)
    Unit cur, nxt; int ui = 0;
    if (!S.next(0, cur)) return;
    f32x4 acc[2][2][4][2];
#pragma unroll
    for (int a = 0; a < 2; ++a)
#pragma unroll
        for (int b = 0; b < 2; ++b)
#pragma unroll
            for (int m = 0; m < 4; ++m)
#pragma unroll
                for (int n = 0; n < 2; ++n) { float z0; asm volatile("v_mov_b32 %0, 0" : "=v"(z0)); acc[a][b][m][n] = (f32x4){z0, z0, z0, z0}; }
    bf16x8 At[4][2], B0[2][2], B1[2][2];
    const char* cA = (const char*)g.A + (size_t)cur.pm * tstep; const char* cB = (const char*)g.Bt + (size_t)cur.pn * tstep;
    S.a_ready(cur);
    PG8_STAGE(PG8_SB(0, 0), cB, voffB); PG8_STAGE(PG8_SA(0, 0), cA, voffA); PG8_STAGE(PG8_SB(0, 1), cB + hstep, voffB); PG8_STAGE(PG8_SA(0, 1), cA + hstep, voffA);
    if (wr == 1) PG8_BAR;
    PG8_WAIT_V(4); PG8_BAR;
    PG8_STAGE(PG8_SB(1, 0), cB + kstep, voffB); PG8_STAGE(PG8_SA(1, 0), cA + kstep, voffA); PG8_STAGE(PG8_SB(1, 1), cB + hstep + kstep, voffB);
    PG8_WAIT_V(6); PG8_BAR;
    PG8_STAMP();
    for (;;) {
        const bool has_next = S.next(ui + 1, nxt);
        const char* nA = has_next ? (const char*)g.A + (size_t)nxt.pm * tstep : cA; const char* nB = has_next ? (const char*)g.Bt + (size_t)nxt.pn * tstep : cB;
        for (int t = 0; t < nt; t += 2) {
            const bool last = (t == nt - 2);
            const char* a1 = cA + (size_t)(t + 1) * kstep;
            const char* a2 = last ? nA : cA + (size_t)(t + 2) * kstep; const char* b2 = last ? nB : cB + (size_t)(t + 2) * kstep;
            const char* a3 = a2 + kstep; const char* b3 = b2 + kstep;
            if (last && has_next) S.a_ready(nxt);
            PG8_LDB(B0, 0, 0); PG8_SCHED; PG8_LDA(At, 0, 0); PG8_STAGE(PG8_SA(1, 1), a1 + hstep, voffA);
            PG8_WAIT_L(8); PG8_BAR; PG8_WAIT_L(0); PG8_MMA(0, 0, At, B0); PG8_BAR; PG8_SCHED;
            PG8_LDB(B1, 0, 1); PG8_STAGE(PG8_SB(0, 0), b2, voffB);
            PG8_BAR; PG8_WAIT_L(0); PG8_MMA(0, 1, At, B1); PG8_BAR;
            PG8_LDA(At, 0, 1); PG8_STAGE(PG8_SA(0, 0), a2, voffA);
            PG8_BAR; PG8_WAIT_L(0); PG8_MMA(1, 0, At, B0); PG8_BAR; PG8_SCHED;
            PG8_STAGE(PG8_SB(0, 1), b2 + hstep, voffB);
            PG8_WAIT_V(6); PG8_BAR; PG8_MMA(1, 1, At, B1); PG8_BAR;
            PG8_LDB(B0, 1, 0); PG8_SCHED; PG8_LDA(At, 1, 0); PG8_STAGE(PG8_SA(0, 1), a2 + hstep, voffA);
            PG8_WAIT_L(8); PG8_BAR; PG8_WAIT_L(0); PG8_MMA(0, 0, At, B0); PG8_BAR; PG8_SCHED;
            PG8_LDB(B1, 1, 1); PG8_STAGE(PG8_SB(1, 0), b3, voffB);
            PG8_BAR; PG8_WAIT_L(0); PG8_MMA(0, 1, At, B1); PG8_BAR;
            PG8_LDA(At, 1, 1); PG8_STAGE(PG8_SA(1, 0), a3, voffA);
            PG8_BAR; PG8_WAIT_L(0); PG8_MMA(1, 0, At, B0); PG8_BAR; PG8_SCHED;
            PG8_STAGE(PG8_SB(1, 1), b3 + hstep, voffB);
            PG8_WAIT_V(6); PG8_BAR; PG8_MMA(1, 1, At, B1); PG8_BAR;
        }
        PG8_STAMP();
        if constexpr (!Epi::AFTER_DRAIN) { E(acc, cur, wr, wc, fr, fq); S.done(cur); }
        PG8_STAMP();
        if (!has_next) break;
#pragma unroll
        for (int a = 0; a < 2; ++a)
#pragma unroll
            for (int b = 0; b < 2; ++b)
#pragma unroll
                for (int m = 0; m < 4; ++m)
#pragma unroll
                    for (int n = 0; n < 2; ++n) { float z0; asm volatile("v_mov_b32 %0, 0" : "=v"(z0)); acc[a][b][m][n] = (f32x4){z0, z0, z0, z0}; }
        cur = nxt; cA = nA; cB = nB; ++ui;
    }
    PG8_WAIT_V(0);
    if (wr == 0) PG8_BAR;
    PG8_BAR;
    if constexpr (Epi::AFTER_DRAIN) { E.fused(acc, cur, wr, wc, fr, fq, lds, wid, lane); S.done(cur); }
    PG8_STAMP();
    if (STAMP && wid == 0) { stamps[lane] = lane < nts ? (((unsigned long long)(unsigned)ts_hi << 32) | (unsigned)ts_lo) : 0ull;
        if (lane == 62) stamps[62] = rt_entry; if (lane == 63) stamps[63] = (unsigned long long)wall_clock64(); }
#undef PG8_STAMP
#undef PG8_SA
#undef PG8_SB
#undef PG8_STAGE
#undef PG8_LDA
#undef PG8_LDB
#undef PG8_MMA
#undef PG8_WAIT_V
#undef PG8_WAIT_L
#undef PG8_BAR
#undef PG8_SCHED
}
}

using pg8::cvt_pk_bf16;
DI uint4 pack8(const pg8::f32x4& a, const pg8::f32x4& b) {
  return uint4{cvt_pk_bf16(a[0], a[1]), cvt_pk_bf16(a[2], a[3]), cvt_pk_bf16(b[0], b[1]), cvt_pk_bf16(b[2], b[3])};
}
DI void unpack8(const uint4& u, float (&o)[8]) {
  o[0] = bf2f((u16)(u.x & 0xffff)); o[1] = bf2f((u16)(u.x >> 16));
  o[2] = bf2f((u16)(u.y & 0xffff)); o[3] = bf2f((u16)(u.y >> 16));
  o[4] = bf2f((u16)(u.z & 0xffff)); o[5] = bf2f((u16)(u.z >> 16));
  o[6] = bf2f((u16)(u.w & 0xffff)); o[7] = bf2f((u16)(u.w >> 16));
}
struct EpiP {
  static constexpr bool PERM = true, AFTER_DRAIN = false;
  u16 *zb, *xr, *rwb, *gb; float* dtb;
  DI void operator()(const pg8::f32x4 (&acc)[2][2][4][2], const pg8::Unit& u, int wr, int wc, int fr, int fq) const {
    const int row0 = u.pm * 256 + wr * 64 + fr;
#pragma unroll
    for (int bj = 0; bj < 2; ++bj) {
      const int cg = u.pn * 256 + bj * 128 + wc * 32;
      const int col0 = cg + 8 * fq;
      if (cg >= 10688) continue;
#pragma unroll
      for (int ai = 0; ai < 2; ++ai)
#pragma unroll
        for (int m = 0; m < 4; ++m) {
          const size_t row = row0 + ai * 128 + m * 16;
          const pg8::f32x4 v0 = acc[ai][bj][m][0], v1 = acc[ai][bj][m][1];
          if (cg >= 5120 && cg < 5184) {
            float* d = dtb + row * 64 + (col0 - 5120);
            *(pg8::f32x4*)d = v0; *(pg8::f32x4*)(d + 4) = v1;
          } else {
            u16* dst = (cg < 2048) ? zb + row * 2048 + col0
                     : (cg < 5120) ? xr + row * 3072 + (col0 - 2048)
                     : (cg < 8640) ? rwb + row * 3456 + (col0 - 5184)
                                   : gb + row * 2048 + (col0 - 8640);
            *(uint4*)dst = pack8(v0, v1);
          }
        }
    }
  }
};
template <int PASS>
struct EpiOut {
  static constexpr bool PERM = true, AFTER_DRAIN = false;
  const u16* gb; u16* U;
  DI void operator()(const pg8::f32x4 (&acc)[2][2][4][2], const pg8::Unit& u, int wr, int wc, int fr, int fq) const {
    const int row0 = u.pm * 256 + wr * 64 + fr;
#pragma unroll
    for (int bj = 0; bj < 2; ++bj) {
      const int col0 = u.pn * 256 + bj * 128 + wc * 32 + 8 * fq;
#pragma unroll
      for (int ai = 0; ai < 2; ++ai)
#pragma unroll
        for (int m = 0; m < 4; ++m) {
          const size_t row = row0 + ai * 128 + m * 16;
          float gt[8];
          unpack8(*(const uint4*)(gb + row * 2048 + PASS * 1024 + col0), gt);
          pg8::f32x4 v0 = acc[ai][bj][m][0], v1 = acc[ai][bj][m][1];
#pragma unroll
          for (int e = 0; e < 4; ++e) { v0[e] *= sigm(gt[e]); v1[e] *= sigm(gt[4 + e]); }
          if (PASS == 1) {
            float pu[8];
            unpack8(*(const uint4*)(U + row * 1024 + col0), pu);
#pragma unroll
            for (int e = 0; e < 4; ++e) { v0[e] += pu[e]; v1[e] += pu[4 + e]; }
          }
          *(uint4*)(U + row * 1024 + col0) = pack8(v0, v1);
        }
    }
  }
};
struct EpiWo {
  static constexpr bool PERM = true, AFTER_DRAIN = false;
  const float *xp, *xs, *mod; float* out; int tok0;
  DI void operator()(const pg8::f32x4 (&acc)[2][2][4][2], const pg8::Unit& u, int wr, int wc, int fr, int fq) const {
    const int row0 = u.pm * 256 + wr * 64 + fr;
#pragma unroll
    for (int bj = 0; bj < 2; ++bj) {
      const int col0 = u.pn * 256 + bj * 128 + wc * 32 + 8 * fq;
#pragma unroll
      for (int ai = 0; ai < 2; ++ai)
#pragma unroll
        for (int m = 0; m < 4; ++m) {
          const int tok = tok0 + row0 + ai * 128 + m * 16;
          const float* xr = tok < 8192 ? xp + (size_t)tok * 1024 : xs + (size_t)(tok - 8192) * 1024;
          const float* gt = mod + mrow_of(tok) * 6144 + 2048 + col0;
          const pg8::f32x4 x0 = *(const pg8::f32x4*)(xr + col0), x1 = *(const pg8::f32x4*)(xr + col0 + 4);
          const pg8::f32x4 g0 = *(const pg8::f32x4*)gt, g1 = *(const pg8::f32x4*)(gt + 4);
          float* o = out + (size_t)tok * 1024 + col0;
          *(pg8::f32x4*)o = x0 + g0 * acc[ai][bj][m][0];
          *(pg8::f32x4*)(o + 4) = x1 + g1 * acc[ai][bj][m][1];
        }
    }
  }
};
struct EpiGU {
  static constexpr bool PERM = true, AFTER_DRAIN = false;
  u16* act;
  DI void operator()(const pg8::f32x4 (&acc)[2][2][4][2], const pg8::Unit& u, int wr, int wc, int fr, int fq) const {
    const int row0 = u.pm * 256 + wr * 64 + fr;
    const int col0 = u.pn * 128 + wc * 32 + 8 * fq;
#pragma unroll
    for (int ai = 0; ai < 2; ++ai)
#pragma unroll
      for (int m = 0; m < 4; ++m) {
        const size_t row = row0 + ai * 128 + m * 16;
        pg8::f32x4 v0, v1;
#pragma unroll
        for (int e = 0; e < 4; ++e) {
          v0[e] = siluf(acc[ai][0][m][0][e]) * acc[ai][1][m][0][e];
          v1[e] = siluf(acc[ai][0][m][1][e]) * acc[ai][1][m][1][e];
        }
        *(uint4*)(act + row * 2816 + col0) = pack8(v0, v1);
      }
  }
};
struct EpiDown {
  static constexpr bool PERM = true, AFTER_DRAIN = false;
  const float* mod; float* out;
  DI void operator()(const pg8::f32x4 (&acc)[2][2][4][2], const pg8::Unit& u, int wr, int wc, int fr, int fq) const {
    const int row0 = u.pm * 256 + wr * 64 + fr;
#pragma unroll
    for (int bj = 0; bj < 2; ++bj) {
      const int col0 = u.pn * 256 + bj * 128 + wc * 32 + 8 * fq;
#pragma unroll
      for (int ai = 0; ai < 2; ++ai)
#pragma unroll
        for (int m = 0; m < 4; ++m) {
          const int tok = row0 + ai * 128 + m * 16;
          const float* gt = mod + mrow_of(tok) * 6144 + 5120 + col0;
          const pg8::f32x4 g0 = *(const pg8::f32x4*)gt, g1 = *(const pg8::f32x4*)(gt + 4);
          float* o = out + (size_t)tok * 1024 + col0;
          const pg8::f32x4 x0 = *(const pg8::f32x4*)o, x1 = *(const pg8::f32x4*)(o + 4);
          *(pg8::f32x4*)o = x0 + g0 * acc[ai][bj][m][0];
          *(pg8::f32x4*)(o + 4) = x1 + g1 * acc[ai][bj][m][1];
        }
    }
  }
};
template <class Epi>
DI void run_gemm8(char* smem, const u16* A, const u16* Bt, int M, int N, int K, const Epi& E) {
  asm volatile("" : "+s"(M), "+s"(N), "+s"(K));
  pg8::Gemm gm{A, Bt, M, N, K};
  pg8::StaticOrder S;
  S.init(M, N, gridDim.x, blockIdx.x);
  pg8::gemm_phase<Epi, pg8::StaticOrder, false>((PG8_LAS unsigned char*)smem, gm, S, E, nullptr);
  __syncthreads();
}

struct EpiR2 {
  static constexpr bool PERM = true, AFTER_DRAIN = false;
  __half* wk; const float *w0, *a0;
  DI void operator()(const pg8::f32x4 (&acc)[2][2][4][2], const pg8::Unit& u, int wr, int wc, int fr, int fq) const {
    const int row0 = u.pm * 256 + wr * 64 + fr;
    const int sec = u.pn >> 2;
#pragma unroll
    for (int bj = 0; bj < 2; ++bj) {
      const int nn = (u.pn & 3) * 256 + bj * 128 + wc * 32 + 8 * fq;
      const int d = sec & 1;
      const float* bias = (sec < 2 ? w0 : a0) + d * 1024 + nn;
      const pg8::f32x4 b0 = *(const pg8::f32x4*)bias, b1 = *(const pg8::f32x4*)(bias + 4);
      const int field = (sec < 2 ? 4 : 5) + 2 * d;
#pragma unroll
      for (int ai = 0; ai < 2; ++ai)
#pragma unroll
        for (int m = 0; m < 4; ++m) {
          const size_t row = row0 + ai * 128 + m * 16;
          pg8::f32x4 v0 = acc[ai][bj][m][0] + b0, v1 = acc[ai][bj][m][1] + b1;
          float o[8];
#pragma unroll
          for (int e = 0; e < 4; ++e) {
            float s0 = sigm(v0[e]), s1 = sigm(v1[e]);
            o[e] = sec < 2 ? __expf(-0.6065306597f * s0) : s0;
            o[4 + e] = sec < 2 ? __expf(-0.6065306597f * s1) : s1;
          }
          __half2 h0 = __floats2half2_rn(o[0], o[1]), h1 = __floats2half2_rn(o[2], o[3]);
          __half2 h2 = __floats2half2_rn(o[4], o[5]), h3 = __floats2half2_rn(o[6], o[7]);
          uint4 pk;
          pk.x = *reinterpret_cast<unsigned*>(&h0); pk.y = *reinterpret_cast<unsigned*>(&h1);
          pk.z = *reinterpret_cast<unsigned*>(&h2); pk.w = *reinterpret_cast<unsigned*>(&h3);
          *(uint4*)(wk + ((row * 16 + (nn >> 6)) * 8 + field) * 64 + (nn & 63)) = pk;
        }
    }
  }
};

template <int MODE>
__device__ __forceinline__ void convT(const float* __restrict__ src, int K, int N, u16* __restrict__ dst, char* smem, int vb = -1, int nb = 0, int ldd = 0) {
  if (ldd == 0) ldd = K;
  float* tile = (float*)smem;
  const int tid = get_tid();
  const int KT = K >> 6, NT = N >> 6;
  if (vb < 0) { vb = blockIdx.x; nb = gridDim.x; }
  for (int t = vb; t < KT * NT; t += nb) {
    int kt = t % KT, nt = t / KT;
#pragma unroll
    for (int i = 0; i < 8; ++i) {
      int idx = tid + i * 512;
      int r = idx >> 6, cc = idx & 63;
      tile[r * 65 + cc] = src[(size_t)(kt * 64 + r) * N + nt * 64 + cc];
    }
    __syncthreads();
    int n = tid >> 3, kc = tid & 7;
    unsigned w[4];
#pragma unroll
    for (int j = 0; j < 4; ++j)
      w[j] = pack2(tile[(kc * 8 + 2 * j) * 65 + n], tile[(kc * 8 + 2 * j + 1) * 65 + n]);
    int ng = nt * 64 + n;
    int row = ng;
    if (MODE == 1) {
      int isu = ng >= 2816;
      int nn = ng - isu * 2816;
      row = (nn >> 7) * 256 + isu * 128 + (nn & 127);
    }
    *(uint4*)(dst + (size_t)row * ldd + kt * 64 + kc * 8) = uint4{w[0], w[1], w[2], w[3]};
    __syncthreads();
  }
}

__device__ __forceinline__ void step_prep(const Params& p, char* smem) {
  const int tid = get_tid();
  char* ws = p.ws;
  {
    float* red = (float*)smem;
    float* mod = (float*)(ws + OFF_MOD);
    for (int item = blockIdx.x; item < 192; item += gridDim.x) {
      int c4 = tid & 7, kl = tid >> 3;
      float acc[12];
#pragma unroll
      for (int i = 0; i < 12; ++i) acc[i] = 0.f;
      for (int k = kl; k < 1024; k += 64) {
        float4 w = *(const float4*)(p.w_ada + (size_t)k * 6144 + item * 32 + c4 * 4);
        float s0 = siluf(p.c_ctx[k]), s1 = siluf(p.c[k]), s2 = siluf(p.c[1024 + k]);
        acc[0] += s0 * w.x; acc[1] += s0 * w.y; acc[2] += s0 * w.z; acc[3] += s0 * w.w;
        acc[4] += s1 * w.x; acc[5] += s1 * w.y; acc[6] += s1 * w.z; acc[7] += s1 * w.w;
        acc[8] += s2 * w.x; acc[9] += s2 * w.y; acc[10] += s2 * w.z; acc[11] += s2 * w.w;
      }
#pragma unroll
      for (int i = 0; i < 12; ++i) red[(kl * 8 + c4) * 12 + i] = acc[i];
      __syncthreads();
      if (tid < 96) {
        int cond = tid >> 5, col = tid & 31;
        int cc4 = col >> 2, e = col & 3;
        float s = 0.f;
        for (int k = 0; k < 64; ++k) s += red[(k * 8 + cc4) * 12 + cond * 4 + e];
        int n = item * 32 + col;
        mod[cond * 6144 + n] = s + p.b_ada[n];
      }
      __syncthreads();
    }
  }
  convT<0>(p.w_in, 1024, 10688, (u16*)(ws + OFF_WIN), smem);
  convT<0>(p.w_m_out, 2048, 1024, (u16*)(ws + OFF_WMOUT), smem);
  convT<0>(p.w_r_out, 1024, 1024, (u16*)(ws + OFF_WROUT), smem);
  convT<0>(p.w_o, 1024, 1024, (u16*)(ws + OFF_WO), smem);
  convT<0>(p.w2, 64, 1024, (u16*)(ws + OFF_W2T), smem);
  convT<0>(p.w2 + 65536, 64, 1024, (u16*)(ws + OFF_W2T) + 65536, smem);
  convT<0>(p.a2, 64, 1024, (u16*)(ws + OFF_A2T), smem);
  convT<0>(p.a2 + 65536, 64, 1024, (u16*)(ws + OFF_A2T) + 65536, smem);
  convT<0>(p.g2, 128, 1024, (u16*)(ws + OFF_G2T), smem);
  {
    u16* w4 = (u16*)(ws + OFF_W4T);
    convT<0>(p.w2, 64, 1024, w4 + (size_t)0 * 1024 * 256 + 0, smem, -1, 0, 256);
    convT<0>(p.w2 + 65536, 64, 1024, w4 + (size_t)1 * 1024 * 256 + 64, smem, -1, 0, 256);
    convT<0>(p.a2, 64, 1024, w4 + (size_t)2 * 1024 * 256 + 128, smem, -1, 0, 256);
    convT<0>(p.a2 + 65536, 64, 1024, w4 + (size_t)3 * 1024 * 256 + 192, smem, -1, 0, 256);
    for (int i = blockIdx.x * NTHR + tid; i < 4096 * 32; i += gridDim.x * NTHR) {
      int row = i >> 5, c = i & 31;
      if ((c >> 3) != (row >> 10)) *(uint4*)(w4 + (size_t)row * 256 + c * 8) = uint4{0, 0, 0, 0};
    }
  }
  {
    uint4* z = (uint4*)(ws + OFF_WIN + (size_t)10688 * 1024 * 2);
    for (int i = blockIdx.x * NTHR + tid; i < 8192; i += gridDim.x * NTHR) z[i] = uint4{0, 0, 0, 0};
  }
}

template <int WHICH>
__device__ __forceinline__ void step_norm(const Params& p, int g) {
  const int tid = get_tid(), lane = tid & 63, wave = tid >> 6;
  const float* mod = (const float*)(p.ws + OFF_MOD);
  const int nrows = WHICH == 0 ? TG : NTOK;
  u16* dst = (u16*)(p.ws + (WHICH == 0 ? OFF_H1 : OFF_H2));
  const float* nw = WHICH == 0 ? p.norm1_w : p.norm2_w;
  for (int r = blockIdx.x * 8 + wave; r < nrows; r += gridDim.x * 8) {
    int tok = WHICH == 0 ? g * TG + r : r;
    const float* xr;
    if (WHICH == 0) xr = tok < 8192 ? p.x_prompt + (size_t)tok * 1024 : p.x_sample + (size_t)(tok - 8192) * 1024;
    else xr = (const float*)(p.ws + OFF_X1) + (size_t)tok * 1024;
    const float* mr = mod + mrow_of(tok) * 6144 + (WHICH == 0 ? 0 : 3072);
    float4 v[4];
    float ss = 0.f;
#pragma unroll
    for (int i = 0; i < 4; ++i) {
      v[i] = ((const float4*)xr)[i * 64 + lane];
      ss += v[i].x * v[i].x + v[i].y * v[i].y + v[i].z * v[i].z + v[i].w * v[i].w;
    }
    ss = wave_sum(ss);
    float rinv = rsqrtf(ss * (1.f / 1024.f) + 1e-6f);
#pragma unroll
    for (int i = 0; i < 4; ++i) {
      int col = (i * 64 + lane) * 4;
      float4 w4 = *(const float4*)(nw + col);
      float4 sh = *(const float4*)(mr + col);
      float4 sc = *(const float4*)(mr + 1024 + col);
      float h0 = v[i].x * rinv * w4.x * (1.f + sc.x) + sh.x;
      float h1 = v[i].y * rinv * w4.y * (1.f + sc.y) + sh.y;
      float h2 = v[i].z * rinv * w4.z * (1.f + sc.z) + sh.z;
      float h3 = v[i].w * rinv * w4.w * (1.f + sc.w) + sh.w;
      *(uint2*)(dst + (size_t)r * 1024 + col) = uint2{pack2(h0, h1), pack2(h2, h3)};
    }
  }
}

__device__ __forceinline__ void step_gemm1(const Params& p, char* smem) {
  char* ws = p.ws;
  EpiP E{(u16*)(ws + OFF_Z), (u16*)(ws + OFF_XBCRAW), (u16*)(ws + OFF_RW), (u16*)(ws + OFF_GATE), (float*)(ws + OFF_DT)};
  run_gemm8(smem, (const u16*)(ws + OFF_H1), (const u16*)(ws + OFF_WIN), TG, NPAD, 1024, E);
}

__device__ __forceinline__ void step_cr1(const Params& p, int g) {
  char* ws = p.ws;
  const int tid = get_tid(), lane = tid & 63, wave = tid >> 6;
  const int Ls = g < 2 ? 256 : 2048;
  {
    const u16* __restrict__ xr = (const u16*)(ws + OFF_XBCRAW);
    u16* __restrict__ xo = (u16*)(ws + OFF_XBC);
    for (int item = blockIdx.x * NTHR + tid; item < (TG / 8) * 384; item += gridDim.x * NTHR) {
      const int rb = item / 384, cc = item - rb * 384;
      const int r0 = rb * 8, pos0 = r0 & (Ls - 1);
      uint4 rows[12];
#pragma unroll
      for (int i = 0; i < 12; ++i) {
        const int pp = pos0 + i - 2;
        rows[i] = uint4{0, 0, 0, 0};
        if (pp >= 0 && pp < Ls) rows[i] = *(const uint4*)(xr + (size_t)(r0 + i - 2) * 3072 + cc * 8);
      }
      float w[5][8], bias[8];
      {
        float4 b0 = *(const float4*)(p.conv_b + cc * 8), b1 = *(const float4*)(p.conv_b + cc * 8 + 4);
        bias[0] = b0.x; bias[1] = b0.y; bias[2] = b0.z; bias[3] = b0.w; bias[4] = b1.x; bias[5] = b1.y; bias[6] = b1.z; bias[7] = b1.w;
#pragma unroll
        for (int i = 0; i < 5; ++i) {
          float4 w0 = *(const float4*)(p.conv_w + i * 3072 + cc * 8), w1 = *(const float4*)(p.conv_w + i * 3072 + cc * 8 + 4);
          w[i][0] = w0.x; w[i][1] = w0.y; w[i][2] = w0.z; w[i][3] = w0.w; w[i][4] = w1.x; w[i][5] = w1.y; w[i][6] = w1.z; w[i][7] = w1.w;
        }
      }
      float s[8][8];
#pragma unroll
      for (int o = 0; o < 8; ++o)
#pragma unroll
        for (int e = 0; e < 8; ++e) s[o][e] = bias[e];
#pragma unroll
      for (int i = 0; i < 12; ++i) {
        float xv[8];
        unpack8(rows[i], xv);
#pragma unroll
        for (int k = 0; k < 5; ++k) {
          const int o = i - k;
          if (o >= 0 && o < 8) {
#pragma unroll
            for (int e = 0; e < 8; ++e) s[o][e] += xv[e] * w[k][e];
          }
        }
      }
#pragma unroll
      for (int o = 0; o < 8; ++o) {
#pragma unroll
        for (int e = 0; e < 8; ++e) s[o][e] = siluf(s[o][e]);
        *(uint4*)(xo + (size_t)(r0 + o) * 3072 + cc * 8) = uint4{pack2(s[o][0], s[o][1]), pack2(s[o][2], s[o][3]), pack2(s[o][4], s[o][5]), pack2(s[o][6], s[o][7])};
      }
    }
  }
  {
    const u16* __restrict__ rw = (const u16*)(ws + OFF_RW);
    __half* __restrict__ wk = (__half*)(ws + OFF_WK);
    u16* __restrict__ tl = (u16*)(ws + OFF_TL);
    u16* __restrict__ sg = (u16*)(ws + OFF_SG);
    const bool grid = (g == 2);
    for (int r = blockIdx.x * 8 + wave; r < TG; r += gridDim.x * 8) {
      const int pos = r & (Ls - 1);
      uint4 cur[7], shv[7];
#pragma unroll
      for (int it = 0; it < 7; ++it) {
        const int ci = it * 64 + lane;
        cur[it] = uint4{0, 0, 0, 0};
        shv[it] = uint4{0, 0, 0, 0};
        if (ci < 432) {
          const int q = ci / 108;
          int dr;
          bool ok;
          if (!grid) {
            if (q & 1) { dr = 1; ok = pos < Ls - 1; } else { dr = -1; ok = pos > 0; }
          } else {
            if (q == 0) { dr = -1; ok = (pos & 63) != 0; }
            else if (q == 1) { dr = 1; ok = (pos & 63) != 63; }
            else if (q == 2) { dr = -64; ok = pos >= 64; }
            else { dr = 64; ok = pos < Ls - 64; }
          }
          cur[it] = *(const uint4*)(rw + (size_t)r * 3456 + ci * 8);
          if (ok) shv[it] = *(const uint4*)(rw + (size_t)(r + dr) * 3456 + ci * 8);
        }
      }
#pragma unroll
      for (int it = 0; it < 7; ++it) {
        const int ci = it * 64 + lane;
        const bool valid = ci < 432;
        float xx[8];
        {
          float cf[8], sf[8];
          unpack8(cur[it], cf);
          unpack8(shv[it], sf);
          const int cm = valid ? ci * 8 : 0;
          const float4 m0 = *(const float4*)(p.mu_shift + cm), m1 = *(const float4*)(p.mu_shift + cm + 4);
          const float mu[8] = {m0.x, m0.y, m0.z, m0.w, m1.x, m1.y, m1.z, m1.w};
#pragma unroll
          for (int e = 0; e < 8; ++e) xx[e] = cf[e] + mu[e] * (sf[e] - cf[e]);
        }
        const bool isk = valid && ci >= 144 && ci < 272;
        float kk[8];
        float ss = 0.f;
        {
          const int kc = isk ? ci - 144 : 0;
          const float4 k0 = *(const float4*)(p.k_k + kc * 8), k1 = *(const float4*)(p.k_k + kc * 8 + 4);
          const float kkw[8] = {k0.x, k0.y, k0.z, k0.w, k1.x, k1.y, k1.z, k1.w};
#pragma unroll
          for (int e = 0; e < 8; ++e) { kk[e] = xx[e] * kkw[e]; ss += kk[e] * kk[e]; }
        }
        ss += dpp_xor1(ss);
        ss += dpp_xor2(ss);
        ss += dpp_hmirror(ss);
        if (valid) {
          if (ci < 128) {
            __half2 h0 = __floats2half2_rn(xx[0], xx[1]), h1 = __floats2half2_rn(xx[2], xx[3]), h2 = __floats2half2_rn(xx[4], xx[5]), h3 = __floats2half2_rn(xx[6], xx[7]);
            uint4 pk{*reinterpret_cast<unsigned*>(&h0), *reinterpret_cast<unsigned*>(&h1), *reinterpret_cast<unsigned*>(&h2), *reinterpret_cast<unsigned*>(&h3)};
            *(uint4*)(wk + ((size_t)(r * 16 + (ci >> 3)) * 8 + 0) * 64 + (ci & 7) * 8) = pk;
          } else if (ci < 144) {
            float t[8];
#pragma unroll
            for (int e = 0; e < 8; ++e) t[e] = tanhf(xx[e]);
            *(uint4*)(tl + (size_t)r * 256 + (ci - 128) * 8) = uint4{pack2(t[0], t[1]), pack2(t[2], t[3]), pack2(t[4], t[5]), pack2(t[6], t[7])};
          } else if (ci < 272) {
            const int kc = ci - 144;
            const float rn = -rsqrtf(ss + 1e-12f);
            __half2 h0 = __floats2half2_rn(xx[0], xx[1]), h1 = __floats2half2_rn(xx[2], xx[3]), h2 = __floats2half2_rn(xx[4], xx[5]), h3 = __floats2half2_rn(xx[6], xx[7]);
            uint4 pk{*reinterpret_cast<unsigned*>(&h0), *reinterpret_cast<unsigned*>(&h1), *reinterpret_cast<unsigned*>(&h2), *reinterpret_cast<unsigned*>(&h3)};
            *(uint4*)(wk + ((size_t)(r * 16 + (kc >> 3)) * 8 + 2) * 64 + (kc & 7) * 8) = pk;
            __half2 n0 = __floats2half2_rn(kk[0] * rn, kk[1] * rn), n1 = __floats2half2_rn(kk[2] * rn, kk[3] * rn), n2 = __floats2half2_rn(kk[4] * rn, kk[5] * rn), n3 = __floats2half2_rn(kk[6] * rn, kk[7] * rn);
            uint4 pn{*reinterpret_cast<unsigned*>(&n0), *reinterpret_cast<unsigned*>(&n1), *reinterpret_cast<unsigned*>(&n2), *reinterpret_cast<unsigned*>(&n3)};
            *(uint4*)(wk + ((size_t)(r * 16 + (kc >> 3)) * 8 + 3) * 64 + (kc & 7) * 8) = pn;
          } else if (ci < 400) {
            const int vc = ci - 272;
            __half2 h0 = __floats2half2_rn(xx[0], xx[1]), h1 = __floats2half2_rn(xx[2], xx[3]), h2 = __floats2half2_rn(xx[4], xx[5]), h3 = __floats2half2_rn(xx[6], xx[7]);
            uint4 pk{*reinterpret_cast<unsigned*>(&h0), *reinterpret_cast<unsigned*>(&h1), *reinterpret_cast<unsigned*>(&h2), *reinterpret_cast<unsigned*>(&h3)};
            *(uint4*)(wk + ((size_t)(r * 16 + (vc >> 3)) * 8 + 1) * 64 + (vc & 7) * 8) = pk;
          } else if (ci < 416) {
            *(uint4*)(tl + (size_t)r * 256 + 128 + (ci - 400) * 8) = uint4{pack2(xx[0], xx[1]), pack2(xx[2], xx[3]), pack2(xx[4], xx[5]), pack2(xx[6], xx[7])};
          } else {
            float t[8];
#pragma unroll
            for (int e = 0; e < 8; ++e) t[e] = sigm(xx[e]);
            *(uint4*)(sg + (size_t)r * 128 + (ci - 416) * 8) = uint4{pack2(t[0], t[1]), pack2(t[2], t[3]), pack2(t[4], t[5]), pack2(t[6], t[7])};
          }
        }
      }
    }
  }
}

__device__ __forceinline__ void step_r2(const Params& p, char* smem) {
  char* ws = p.ws;
  const int tid = get_tid(), lane = tid & 63, wave = tid >> 6;
  const int wm = wave >> 1, wn = wave & 1;
  const u16* tl = (const u16*)(ws + OFF_TL);
  const u16* sg = (const u16*)(ws + OFF_SG);
  __half* wk = (__half*)(ws + OFF_WK);
  u16* gr = (u16*)(ws + OFF_GR);
  {
    EpiR2 E{wk, p.w0, p.a0};
    run_gemm8(smem, tl, (const u16*)(ws + OFF_W4T), TG, 4096, 256, E);
  }
  for (int t = (gridDim.x - 1 - blockIdx.x) + 4 * 128; t < 5 * 128; t += gridDim.x) {
    int sub = t >> 7, rem = t & 127;
    int mt = rem & 15, nt = rem >> 4;
    f32x4 acc[4][4];
    zero_acc(acc);
    if (sub < 2) {
      gemm_acc(tl + (size_t)mt * 256 * 256 + sub * 64, 256, (const u16*)(ws + OFF_W2T) + sub * 65536 + (size_t)nt * 128 * 64, 64, 64, acc, smem);
    } else if (sub < 4) {
      gemm_acc(tl + (size_t)mt * 256 * 256 + 128 + (sub - 2) * 64, 256, (const u16*)(ws + OFF_A2T) + (sub - 2) * 65536 + (size_t)nt * 128 * 64, 64, 64, acc, smem);
    } else {
      gemm_acc(sg + (size_t)mt * 256 * 128, 128, (const u16*)(ws + OFF_G2T) + (size_t)nt * 128 * 128, 128, 128, acc, smem);
    }
#pragma unroll
    for (int mf = 0; mf < 4; ++mf)
#pragma unroll
      for (int nf = 0; nf < 4; ++nf)
#pragma unroll
        for (int j = 0; j < 4; ++j) {
          if (nf == 0 && j == 0) asm volatile("" ::: "memory");
          int m = mt * 256 + wm * 64 + mf * 16 + (lane >> 4) * 4 + j;
          int n = nt * 128 + wn * 64 + nf * 16 + (lane & 15);
          float v = acc[mf][nf][j];
          if (sub < 2) {
            float wl = v + p.w0[sub * 1024 + n];
            float dec = __expf(-0.6065306597f * sigm(wl));
            wk[((size_t)(m * 16 + (n >> 6)) * 8 + 4 + 2 * sub) * 64 + (n & 63)] = __float2half(dec);
          } else if (sub < 4) {
            int d = sub - 2;
            float a = sigm(v + p.a0[d * 1024 + n]);
            wk[((size_t)(m * 16 + (n >> 6)) * 8 + 5 + 2 * d) * 64 + (n & 63)] = __float2half(a);
          } else {
            gr[(size_t)m * 1024 + n] = f2bf(v);
          }
        }
  }
}

DI int swz16(int row) { return (row ^ (row >> 3)) & 15; }
DI int sw256(int row, int e) { return row * 256 + ((((e >> 3) ^ swz16(row))) << 4) + (e & 7) * 2; }
DI const bf16x8 ldfrag256(const char* base, int row, int ch) {
  return *(const bf16x8*)(base + row * 256 + ((ch ^ swz16(row)) << 4));
}

typedef unsigned v4u __attribute__((ext_vector_type(4)));
struct SsdPre { v4u c0, c1, c2, c3, b0, b1, b2, b3, x0, x1; float d0, d1; };
DI void ssd_issue(const Params& p, int g, int chain, int ci, int tid, SsdPre& R) {
  const int Ls = g < 2 ? 256 : 2048;
  const int nch = Ls >> 7;
  const int d = chain & 1, h = (chain >> 1) & 31, b = chain >> 6;
  const int grp = h >> 3;
  const int c = d ? nch - 1 - ci : ci;
  const int tok0 = b * Ls + c * 128;
  const u16* xbc = (const u16*)(p.ws + OFF_XBC);
  const float* dtb = (const float*)(p.ws + OFF_DT);
  const int lane = tid & 63, wave = tid >> 6;
#define SSD_LDCB(i, CF, BF) { int idx = tid + i * 512; int row = idx >> 4, ch = idx & 15; \
    const u16* src = xbc + (size_t)(tok0 + row) * 3072 + grp * 128 + ch * 8; R.CF = *(const v4u*)(src + 2560); R.BF = *(const v4u*)(src + 2048); }
  SSD_LDCB(0, c0, b0) SSD_LDCB(1, c1, b1) SSD_LDCB(2, c2, b2) SSD_LDCB(3, c3, b3)
#undef SSD_LDCB
#define SSD_LDX(i, XF) { int idx = tid + i * 512; int l = idx >> 3, ch = idx & 7; R.XF = *(const v4u*)(xbc + (size_t)(tok0 + l) * 3072 + h * 64 + ch * 8); }
  SSD_LDX(0, x0) SSD_LDX(1, x1)
#undef SSD_LDX
  if (wave == 0) {
    int e0 = 2 * lane, e1 = 2 * lane + 1;
    int l0 = d ? 127 - e0 : e0, l1 = d ? 127 - e1 : e1;
    R.d0 = dtb[(size_t)(tok0 + l0) * 64 + d * 32 + h];
    R.d1 = dtb[(size_t)(tok0 + l1) * 64 + d * 32 + h];
  }
}

__device__ __forceinline__ void ssd_chain(const Params& p, char* smem, int g, int chain, int next_chain, SsdPre& R) {
  char* ws = p.ws;
  const int tid = get_tid(), lane = tid & 63, wave = tid >> 6;
  const int Ls = g < 2 ? 256 : 2048;
  const int nch = Ls >> 7;
  const int d = chain & 1, h = (chain >> 1) & 31, b = chain >> 6;
  const int grp = h >> 3;
  const u16* xbc = (const u16*)(ws + OFF_XBC);
  const float* dtb = (const float*)(ws + OFF_DT);
  u16* yout = (u16*)(ws + (d ? OFF_SYB : OFF_SYF));
  char* Cs = smem;
  char* Bs = smem + 32768;
  char* BdT = smem + 65536;
  char* XT = smem + 98304;
  char* Ss = smem + 114688;
  float* csum = (float*)(smem + 131072);
  float* dts = (float*)(smem + 131584);
  const float a_h = -__expf(p.a_log[d * 32 + h]);
  const float dtbias = p.dt_bias[d * 32 + h];
  const int wp = wave >> 2, wn4 = wave & 3;
  f32x4 sacc[2][2];
#pragma unroll
  for (int pf = 0; pf < 2; ++pf)
#pragma unroll
    for (int nf = 0; nf < 2; ++nf) {
      if (g == 2) {
        const float* h0 = (d ? p.ssm_b : p.ssm_f) + (size_t)(b * 32 + h) * 8192;
#pragma unroll
        for (int j = 0; j < 4; ++j) {
          int pp = wp * 32 + pf * 16 + (lane >> 4) * 4 + j;
          int n = wn4 * 32 + nf * 16 + (lane & 15);
          sacc[pf][nf][j] = h0[pp * 128 + n];
        }
      } else {
        sacc[pf][nf] = f32x4{0.f, 0.f, 0.f, 0.f};
      }
    }
  const int tid_outer = tid;
  for (int ci = 0; ci < nch; ++ci) {
    int tidv = tid_outer;
    asm volatile("" : "+v"(tidv));
    const int tid = tidv, lane = tidv & 63, wave = tidv >> 6;
    const int wp = wave >> 2, wn4 = wave & 3;
    const int c = d ? nch - 1 - ci : ci;
    const int tok0 = b * Ls + c * 128;
#define SSD_STCB(i, CF, BF) { int idx = tid + i * 512; int row = idx >> 4, ch = idx & 15; \
      *(v4u*)(Cs + row * 256 + ((ch ^ swz16(row)) << 4)) = R.CF; *(v4u*)(Bs + row * 256 + ((ch ^ swz16(row)) << 4)) = R.BF; }
    SSD_STCB(0, c0, b0) SSD_STCB(1, c1, b1) SSD_STCB(2, c2, b2) SSD_STCB(3, c3, b3)
#undef SSD_STCB
#define SSD_STX(i, XF) { int idx = tid + i * 512; int l = idx >> 3, ch = idx & 7; \
      const unsigned w0 = R.XF[0], w1 = R.XF[1], w2 = R.XF[2], w3 = R.XF[3]; \
      *(u16*)(XT + sw256(ch * 8 + 0, l)) = (u16)(w0 & 0xffff); *(u16*)(XT + sw256(ch * 8 + 1, l)) = (u16)(w0 >> 16); \
      *(u16*)(XT + sw256(ch * 8 + 2, l)) = (u16)(w1 & 0xffff); *(u16*)(XT + sw256(ch * 8 + 3, l)) = (u16)(w1 >> 16); \
      *(u16*)(XT + sw256(ch * 8 + 4, l)) = (u16)(w2 & 0xffff); *(u16*)(XT + sw256(ch * 8 + 5, l)) = (u16)(w2 >> 16); \
      *(u16*)(XT + sw256(ch * 8 + 6, l)) = (u16)(w3 & 0xffff); *(u16*)(XT + sw256(ch * 8 + 7, l)) = (u16)(w3 >> 16); }
    SSD_STX(0, x0) SSD_STX(1, x1)
#undef SSD_STX
    if (wave == 0) {
      int e0 = 2 * lane, e1 = 2 * lane + 1;
      int l0 = d ? 127 - e0 : e0, l1 = d ? 127 - e1 : e1;
      float x0 = R.d0 + dtbias;
      float x1 = R.d1 + dtbias;
      float dt0 = x0 > 20.f ? x0 : log1pf(__expf(x0));
      float dt1 = x1 > 20.f ? x1 : log1pf(__expf(x1));
      float a0 = dt0 * a_h, a1 = dt1 * a_h;
      float s = a0 + a1;
#pragma unroll
      for (int o = 1; o < 64; o <<= 1) {
        float t = __shfl_up(s, o);
        if (lane >= o) s += t;
      }
      csum[l1] = s;
      csum[l0] = s - a1;
      dts[l0] = dt0;
      dts[l1] = dt1;
    }
    if (ci + 1 < nch) ssd_issue(p, g, chain, ci + 1, tid, R);
    else if (next_chain >= 0) ssd_issue(p, g, next_chain, 0, tid, R);
#pragma unroll
    for (int pf = 0; pf < 2; ++pf)
#pragma unroll
      for (int nf = 0; nf < 2; ++nf)
#pragma unroll
        for (int j = 0; j < 4; ++j) {
          int pp = wp * 32 + pf * 16 + (lane >> 4) * 4 + j;
          int n = wn4 * 32 + nf * 16 + (lane & 15);
          *(u16*)(Ss + sw256(pp, n)) = f2bf(sacc[pf][nf][j]);
        }
    __syncthreads();
    const float cstot = csum[d ? 0 : 127];
#pragma unroll
    for (int i = 0; i < 4; ++i) {
      int idx = tid + i * 512;
      int l = idx >> 4, ch = idx & 15;
      uint4 bv = *(const uint4*)(Bs + l * 256 + ((ch ^ swz16(l)) << 4));
      float f = dts[l] * __expf(cstot - csum[l]);
      unsigned w[4] = {bv.x, bv.y, bv.z, bv.w};
#pragma unroll
      for (int e = 0; e < 8; ++e) {
        int n = ch * 8 + e;
        float val = bf2f((u16)((w[e >> 1] >> ((e & 1) * 16)) & 0xffff)) * f;
        *(u16*)(BdT + sw256(n, l)) = f2bf(val);
      }
    }
    const int wm = wave >> 1, wn2 = wave & 1;
    f32x4 gacc[2][4];
#pragma unroll
    for (int i = 0; i < 2; ++i)
#pragma unroll
      for (int j = 0; j < 4; ++j) gacc[i][j] = f32x4{0.f, 0.f, 0.f, 0.f};
#pragma unroll
    for (int ks = 0; ks < 4; ++ks) {
      int ch = ks * 4 + (lane >> 4);
      bf16x8 a[2], bb[4];
#pragma unroll
      for (int mf = 0; mf < 2; ++mf) a[mf] = ldfrag256(Cs, wm * 32 + mf * 16 + (lane & 15), ch);
#pragma unroll
      for (int nf = 0; nf < 4; ++nf) bb[nf] = ldfrag256(Bs, wn2 * 64 + nf * 16 + (lane & 15), ch);
#pragma unroll
      for (int mf = 0; mf < 2; ++mf)
#pragma unroll
        for (int nf = 0; nf < 4; ++nf)
          gacc[mf][nf] = __builtin_amdgcn_mfma_f32_16x16x32_bf16(a[mf], bb[nf], gacc[mf][nf], 0, 0, 0);
    }
    {
      float csl[2][4];
#pragma unroll
      for (int mf = 0; mf < 2; ++mf)
#pragma unroll
        for (int j = 0; j < 4; ++j) csl[mf][j] = csum[wm * 32 + mf * 16 + (lane >> 4) * 4 + j];
#pragma unroll
      for (int nf = 0; nf < 4; ++nf) {
        int s = wn2 * 64 + nf * 16 + (lane & 15);
        float css = csum[s], dss = dts[s];
#pragma unroll
        for (int mf = 0; mf < 2; ++mf)
#pragma unroll
          for (int j = 0; j < 4; ++j) {
            int l = wm * 32 + mf * 16 + (lane >> 4) * 4 + j;
            bool valid = d ? (s >= l) : (s <= l);
            float e = valid ? __expf(csl[mf][j] - css) * dss : 0.f;
            gacc[mf][nf][j] *= e;
          }
      }
    }
    __syncthreads();
#pragma unroll
    for (int mf = 0; mf < 2; ++mf)
#pragma unroll
      for (int nf = 0; nf < 4; ++nf)
#pragma unroll
        for (int j = 0; j < 4; ++j) {
          int l = wm * 32 + mf * 16 + (lane >> 4) * 4 + j;
          int s = wn2 * 64 + nf * 16 + (lane & 15);
          *(u16*)(Bs + sw256(l, s)) = f2bf(gacc[mf][nf][j]);
        }
    __syncthreads();
    {
      f32x4 yacc[2][2];
#pragma unroll
      for (int i = 0; i < 2; ++i)
#pragma unroll
        for (int j = 0; j < 2; ++j) yacc[i][j] = f32x4{0.f, 0.f, 0.f, 0.f};
#pragma unroll
      for (int ks = 0; ks < 4; ++ks) {
        int ch = ks * 4 + (lane >> 4);
        bf16x8 a[2], bb[2];
#pragma unroll
        for (int mf = 0; mf < 2; ++mf) a[mf] = ldfrag256(Cs, wm * 32 + mf * 16 + (lane & 15), ch);
#pragma unroll
        for (int nf = 0; nf < 2; ++nf) bb[nf] = ldfrag256(Ss, wn2 * 32 + nf * 16 + (lane & 15), ch);
#pragma unroll
        for (int mf = 0; mf < 2; ++mf)
#pragma unroll
          for (int nf = 0; nf < 2; ++nf)
            yacc[mf][nf] = __builtin_amdgcn_mfma_f32_16x16x32_bf16(a[mf], bb[nf], yacc[mf][nf], 0, 0, 0);
      }
#pragma unroll
      for (int mf = 0; mf < 2; ++mf)
#pragma unroll
        for (int j = 0; j < 4; ++j) {
          float e = __expf(csum[wm * 32 + mf * 16 + (lane >> 4) * 4 + j]);
#pragma unroll
          for (int nf = 0; nf < 2; ++nf) yacc[mf][nf][j] *= e;
        }
#pragma unroll
      for (int ks = 0; ks < 4; ++ks) {
        int ch = ks * 4 + (lane >> 4);
        bf16x8 a[2], bb[2];
#pragma unroll
        for (int mf = 0; mf < 2; ++mf) a[mf] = ldfrag256(Bs, wm * 32 + mf * 16 + (lane & 15), ch);
#pragma unroll
        for (int nf = 0; nf < 2; ++nf) bb[nf] = ldfrag256(XT, wn2 * 32 + nf * 16 + (lane & 15), ch);
#pragma unroll
        for (int mf = 0; mf < 2; ++mf)
#pragma unroll
          for (int nf = 0; nf < 2; ++nf)
            yacc[mf][nf] = __builtin_amdgcn_mfma_f32_16x16x32_bf16(a[mf], bb[nf], yacc[mf][nf], 0, 0, 0);
      }
#pragma unroll
      for (int mf = 0; mf < 2; ++mf)
#pragma unroll
        for (int nf = 0; nf < 2; ++nf)
#pragma unroll
          for (int j = 0; j < 4; ++j) {
            int l = wm * 32 + mf * 16 + (lane >> 4) * 4 + j;
            int pp = wn2 * 32 + nf * 16 + (lane & 15);
            yout[(size_t)(tok0 + l) * 2048 + h * 64 + pp] = f2bf(yacc[mf][nf][j]);
          }
    }
    {
      float e = __expf(cstot);
#pragma unroll
      for (int pf = 0; pf < 2; ++pf)
#pragma unroll
        for (int nf = 0; nf < 2; ++nf) sacc[pf][nf] *= e;
#pragma unroll
      for (int ks = 0; ks < 4; ++ks) {
        int ch = ks * 4 + (lane >> 4);
        bf16x8 a[2], bb[2];
#pragma unroll
        for (int pf = 0; pf < 2; ++pf) a[pf] = ldfrag256(XT, wp * 32 + pf * 16 + (lane & 15), ch);
#pragma unroll
        for (int nf = 0; nf < 2; ++nf) bb[nf] = ldfrag256(BdT, wn4 * 32 + nf * 16 + (lane & 15), ch);
#pragma unroll
        for (int pf = 0; pf < 2; ++pf)
#pragma unroll
          for (int nf = 0; nf < 2; ++nf)
            sacc[pf][nf] = __builtin_amdgcn_mfma_f32_16x16x32_bf16(a[pf], bb[nf], sacc[pf][nf], 0, 0, 0);
      }
    }
    __syncthreads();
  }
  if (g < 2) {
    float* so = p.out + (d ? OUT_SSMB : OUT_SSMF) + (size_t)((g * 16 + b) * 32 + h) * 8192;
#pragma unroll
    for (int pf = 0; pf < 2; ++pf)
#pragma unroll
      for (int nf = 0; nf < 2; ++nf)
#pragma unroll
        for (int j = 0; j < 4; ++j) {
          int pp = wp * 32 + pf * 16 + (lane >> 4) * 4 + j;
          int n = wn4 * 32 + nf * 16 + (lane & 15);
          so[pp * 128 + n] = sacc[pf][nf][j];
        }
  }
}


template <bool SEG>
__device__ __forceinline__ void wkv_pair(const Params& p, char* smem, int g, int item) {
  char* ws = p.ws;
  const int tid = get_tid(), lane = tid & 63, wave = tid >> 6;
  const int Ls = SEG ? 2048 : 256;
  const __half* wk = (const __half*)(ws + OFF_WK);
  float* stage = (float*)smem;
  float* ylds = (float*)(smem + 98304);
  const bool cw = true;
  const int slot = wave >> 2, wq = wave & 3;
  const int ig = lane >> 3, jg = lane & 7;
  const int row0 = wq * 16 + ig * 2;
  const int chain = SEG ? (item >> 3) : item * 2 + slot;
  const int seg = SEG ? (item & 7) : 0;
  const bool act = cw && (SEG ? !(slot == 1 && seg == 0) : true);
  const int d = chain & 1, h = (chain >> 1) & 15, b = chain >> 5;
  typedef float f2 __attribute__((ext_vector_type(2)));
  f2 S[2][4];
#pragma unroll
  for (int rr = 0; rr < 2; ++rr) {
    if (SEG) {
      if (slot == 0) {
        if (seg == 0) {
          const float* s0 = (d ? p.wkv_b : p.wkv_f) + ((size_t)(b * 16 + h) * 64 + row0 + rr) * 64 + jg * 8;
#pragma unroll
          for (int c = 0; c < 4; ++c) S[rr][c] = f2{s0[2 * c], s0[2 * c + 1]};
        } else {
#pragma unroll
          for (int c = 0; c < 4; ++c) S[rr][c] = f2{0.f, 0.f};
        }
      } else {
#pragma unroll
        for (int c = 0; c < 4; ++c) S[rr][c] = f2{(row0 + rr == jg * 8 + 2 * c) ? 1.f : 0.f, (row0 + rr == jg * 8 + 2 * c + 1) ? 1.f : 0.f};
      }
    } else {
#pragma unroll
      for (int c = 0; c < 4; ++c) S[rr][c] = f2{0.f, 0.f};
    }
  }
  const int pair = tid >> 4, lslot = pair >> 4, lstep = pair & 15, sub = tid & 15;
  const int lch = SEG ? (item >> 3) : item * 2 + lslot;
  const int ld = lch & 1, lh = (lch >> 1) & 15, lb = lch >> 5;
  const bool ldo = SEG ? (lslot == 0) : true;
  const int sbase = seg * 256;
  const int cslot = SEG ? 0 : slot;
  float ka[4];
#pragma unroll
  for (int e = 0; e < 4; ++e) ka[e] = p.k_a[lh * 64 + sub * 4 + e];
  u16* yout;
  if (SEG) yout = lslot == 0 ? (u16*)(ws + (ld ? OFF_WYB : OFF_WYF)) : (u16*)(ws + OFF_YM) + (ld ? (size_t)TG * 1024 : 0);
  else yout = (u16*)(ws + (ld ? OFF_WYB : OFF_WYF));
  const bool ywr = SEG ? (lslot == 0 || seg > 0) : true;
  uint2 rg[6];
  auto prefetch = [&](int tb) {
    int s = sbase + tb * 16 + lstep;
    int pos = ld ? Ls - 1 - s : s;
    int r = lb * Ls + pos;
    const __half* rec = wk + ((size_t)(r * 16 + lh) * 8) * 64 + sub * 4;
    rg[0] = *(const uint2*)(rec + 0 * 64);
    rg[1] = *(const uint2*)(rec + 1 * 64);
    rg[2] = *(const uint2*)(rec + 2 * 64);
    rg[3] = *(const uint2*)(rec + 3 * 64);
    rg[4] = *(const uint2*)(rec + (4 + 2 * ld) * 64);
    rg[5] = *(const uint2*)(rec + (5 + 2 * ld) * 64);
  };
  auto unpack4 = [&](uint2 u, float (&o)[4]) {
    __half2 h0 = *reinterpret_cast<__half2*>(&u.x);
    __half2 h1 = *reinterpret_cast<__half2*>(&u.y);
    float2 f0 = __half22float2(h0), f1 = __half22float2(h1);
    o[0] = f0.x; o[1] = f0.y; o[2] = f1.x; o[3] = f1.y;
  };
  auto stage_store = [&](int buf) {
    float r_[4], v_[4], k_[4], nkk_[4], w_[4], a_[4];
    unpack4(rg[0], r_); unpack4(rg[1], v_); unpack4(rg[2], k_); unpack4(rg[3], nkk_); unpack4(rg[4], w_); unpack4(rg[5], a_);
    float b_[4], kd_[4];
#pragma unroll
    for (int e = 0; e < 4; ++e) {
      b_[e] = -nkk_[e] * a_[e];
      kd_[e] = k_[e] * (1.f + (a_[e] - 1.f) * ka[e]);
    }
    float* dst = stage + ((size_t)((buf * 2 + lslot) * 16 + lstep) * 6) * 64 + sub * 4;
    *(float4*)(dst + 0 * 64) = float4{nkk_[0], nkk_[1], nkk_[2], nkk_[3]};
    *(float4*)(dst + 1 * 64) = float4{w_[0], w_[1], w_[2], w_[3]};
    *(float4*)(dst + 2 * 64) = float4{b_[0], b_[1], b_[2], b_[3]};
    *(float4*)(dst + 3 * 64) = float4{kd_[0], kd_[1], kd_[2], kd_[3]};
    *(float4*)(dst + 4 * 64) = float4{r_[0], r_[1], r_[2], r_[3]};
    *(float4*)(dst + 5 * 64) = float4{v_[0], v_[1], v_[2], v_[3]};
  };
  if (ldo) { prefetch(0); stage_store(0); }
  __syncthreads();
  for (int tb = 0; tb < 16; ++tb) {
    const bool more = tb + 1 < 16;
    if (more && ldo) prefetch(tb + 1);
    if (act) {
      const float* sb = stage + ((size_t)(((tb & 1) * 2 + cslot) * 16) * 6) * 64;
      for (int sg = 0; sg < 8; ++sg) {
        float ysv[2][2];
#pragma unroll
        for (int s4 = 0; s4 < 2; ++s4) {
          const int st = sg * 2 + s4;
          const float* v6 = sb + st * 384 + jg * 8;
          f2 nkk[4], w[4], bb[4], kd[4], rr[4];
#pragma unroll
          for (int q = 0; q < 2; ++q) {
            float4 t0 = *(const float4*)(v6 + 0 * 64 + q * 4);
            nkk[q * 2] = f2{t0.x, t0.y}; nkk[q * 2 + 1] = f2{t0.z, t0.w};
            float4 t1 = *(const float4*)(v6 + 1 * 64 + q * 4);
            w[q * 2] = f2{t1.x, t1.y}; w[q * 2 + 1] = f2{t1.z, t1.w};
            float4 t2 = *(const float4*)(v6 + 2 * 64 + q * 4);
            bb[q * 2] = f2{t2.x, t2.y}; bb[q * 2 + 1] = f2{t2.z, t2.w};
            float4 t3 = *(const float4*)(v6 + 3 * 64 + q * 4);
            kd[q * 2] = f2{t3.x, t3.y}; kd[q * 2 + 1] = f2{t3.z, t3.w};
            float4 t4 = *(const float4*)(v6 + 4 * 64 + q * 4);
            rr[q * 2] = f2{t4.x, t4.y}; rr[q * 2 + 1] = f2{t4.z, t4.w};
          }
          float2 vv2 = *(const float2*)(sb + st * 384 + 5 * 64 + row0);
          float vi[2] = {vv2.x, vv2.y};
          if (SEG && slot == 1) { vi[0] = 0.f; vi[1] = 0.f; }
#pragma unroll
          for (int r2 = 0; r2 < 2; ++r2) {
            f2 sa2a = S[r2][0] * nkk[0], sa2b = S[r2][1] * nkk[1];
            sa2a += S[r2][2] * nkk[2]; sa2b += S[r2][3] * nkk[3];
            f2 sat = sa2a + sa2b;
            float sa = sat.x + sat.y;
            sa += dpp_xor1(sa);
            sa += dpp_xor2(sa);
            sa += dpp_hmirror(sa);
            f2 y2a, y2b;
            {
              f2 t0 = S[r2][0] * w[0] + vi[r2] * kd[0]; S[r2][0] = t0 + sa * bb[0]; y2a = S[r2][0] * rr[0];
              f2 t1 = S[r2][1] * w[1] + vi[r2] * kd[1]; S[r2][1] = t1 + sa * bb[1]; y2b = S[r2][1] * rr[1];
              f2 t2 = S[r2][2] * w[2] + vi[r2] * kd[2]; S[r2][2] = t2 + sa * bb[2]; y2a += S[r2][2] * rr[2];
              f2 t3 = S[r2][3] * w[3] + vi[r2] * kd[3]; S[r2][3] = t3 + sa * bb[3]; y2b += S[r2][3] * rr[3];
            }
            f2 yt = y2a + y2b;
            float y = yt.x + yt.y;
            y += dpp_xor1(y);
            y += dpp_xor2(y);
            y += dpp_hmirror(y);
            ysv[s4][r2] = y;
          }
        }
        if (jg == 0) {
#pragma unroll
          for (int s4 = 0; s4 < 2; ++s4)
            *(float2*)(ylds + (slot * 16 + sg * 2 + s4) * 64 + row0) = float2{ysv[s4][0], ysv[s4][1]};
        }
      }
    }
    __syncthreads();
    if (more && ldo) stage_store((tb + 1) & 1);
    if (ywr) {
      int s = sbase + tb * 16 + lstep;
      int pos = ld ? Ls - 1 - s : s;
      int r = lb * Ls + pos;
      float4 yv = *(const float4*)(ylds + (lslot * 16 + lstep) * 64 + sub * 4);
      *(uint2*)(yout + (size_t)r * 1024 + lh * 64 + sub * 4) = uint2{pack2(yv.x, yv.y), pack2(yv.z, yv.w)};
    }
    __syncthreads();
  }
  if (act) {
#pragma unroll
    for (int r2 = 0; r2 < 2; ++r2) {
      float* so;
      if (SEG) so = p.out + 8388608 + ((size_t)((chain * 8 + seg) * 2 + slot)) * 4096 + (row0 + r2) * 64 + jg * 8;
      else so = p.out + (d ? OUT_WKVB : OUT_WKVF) + ((size_t)((g * 16 + b) * 16 + h) * 64 + row0 + r2) * 64 + jg * 8;
#pragma unroll
      for (int c = 0; c < 4; ++c) { so[2 * c] = S[r2][c].x; so[2 * c + 1] = S[r2][c].y; }
    }
  }
}

__device__ __forceinline__ void wkv_fix(const Params& p, char* smem, int chain) {
  char* ws = p.ws;
  const int tid = get_tid(), lane = tid & 63, wave = tid >> 6;
  const int d = chain & 1, h = (chain >> 1) & 15, b = chain >> 5;
  const float* SE = p.out + 8388608;
  u16* yout = (u16*)(ws + (d ? OFF_WYB : OFF_WYF));
  const u16* Q = (const u16*)(ws + OFF_YM) + (d ? (size_t)TG * 1024 : 0);
  float* Pl = (float*)smem;
  float* Sl = (float*)(smem + 16384);
  u16* Ql = (u16*)(smem + 36864);
  const int i = lane;
  float S0[64];
  {
    const float* src = SE + ((size_t)(chain * 8) * 2) * 4096 + i * 64;
#pragma unroll
    for (int j = 0; j < 16; ++j) {
      float4 t = *(const float4*)(src + j * 4);
      S0[j * 4] = t.x; S0[j * 4 + 1] = t.y; S0[j * 4 + 2] = t.z; S0[j * 4 + 3] = t.w;
    }
  }
  for (int k = 1; k < 8; ++k) {
#pragma unroll
    for (int e = 0; e < 4; ++e) {
      int idx = tid + e * 512;
      int tt = idx >> 3, ch = idx & 7;
      int s = k * 256 + tt;
      int pos = d ? 2047 - s : s;
      int r = b * 2048 + pos;
      *(uint4*)(Ql + tt * 64 + ch * 8) = *(const uint4*)(Q + (size_t)r * 1024 + h * 64 + ch * 8);
    }
    if (k < 7) {
      const float* src = SE + ((size_t)((chain * 8 + k) * 2 + 1)) * 4096;
#pragma unroll
      for (int e = 0; e < 2; ++e) ((float4*)Pl)[tid + e * 512] = ((const float4*)src)[tid + e * 512];
    }
    __syncthreads();
    for (int n = 0; n < 32; ++n) {
      int tt = wave + n * 8;
      float a0 = 0.f, a1 = 0.f;
#pragma unroll
      for (int jc = 0; jc < 8; ++jc) {
        float q[8];
        unpack8(*(const uint4*)(Ql + tt * 64 + jc * 8), q);
#pragma unroll
        for (int e = 0; e < 8; e += 2) { a0 += S0[jc * 8 + e] * q[e]; a1 += S0[jc * 8 + e + 1] * q[e + 1]; }
      }
      int s = k * 256 + tt;
      int pos = d ? 2047 - s : s;
      size_t off = (size_t)(b * 2048 + pos) * 1024 + h * 64 + i;
      yout[off] = f2bf(bf2f(yout[off]) + (a0 + a1));
    }
    if (k < 7) {
      float nv[8];
      const float* sl = SE + ((size_t)((chain * 8 + k) * 2)) * 4096 + i * 64 + wave * 8;
      {
        float4 t0 = *(const float4*)sl, t1 = *(const float4*)(sl + 4);
        nv[0] = t0.x; nv[1] = t0.y; nv[2] = t0.z; nv[3] = t0.w; nv[4] = t1.x; nv[5] = t1.y; nv[6] = t1.z; nv[7] = t1.w;
      }
#pragma unroll
      for (int m = 0; m < 64; ++m) {
        float4 p0 = *(const float4*)(Pl + m * 64 + wave * 8), p1 = *(const float4*)(Pl + m * 64 + wave * 8 + 4);
        nv[0] += S0[m] * p0.x; nv[1] += S0[m] * p0.y; nv[2] += S0[m] * p0.z; nv[3] += S0[m] * p0.w;
        nv[4] += S0[m] * p1.x; nv[5] += S0[m] * p1.y; nv[6] += S0[m] * p1.z; nv[7] += S0[m] * p1.w;
      }
      *(float4*)(Sl + i * 68 + wave * 8) = float4{nv[0], nv[1], nv[2], nv[3]};
      *(float4*)(Sl + i * 68 + wave * 8 + 4) = float4{nv[4], nv[5], nv[6], nv[7]};
      __syncthreads();
#pragma unroll
      for (int j = 0; j < 16; ++j) {
        float4 t = *(const float4*)(Sl + i * 68 + j * 4);
        S0[j * 4] = t.x; S0[j * 4 + 1] = t.y; S0[j * 4 + 2] = t.z; S0[j * 4 + 3] = t.w;
      }
    }
    __syncthreads();
  }
}

__device__ __forceinline__ void step_scan(const Params& p, char* smem, int g) {
  const int G = gridDim.x;
  const int r1 = (RM & (1 << 20)) ? 2 : 1, r2 = (RM & (1 << 21)) ? 2 : 1;
  if (g < 2) {
    for (int rr = 0; rr < r1; ++rr) {
      SsdPre R;
      if ((int)blockIdx.x < 1024) ssd_issue(p, g, blockIdx.x, 0, get_tid(), R);
      for (int ch = blockIdx.x; ch < 1024; ch += G) ssd_chain(p, smem, g, ch, ch + G < 1024 ? ch + G : -1, R);
    }
    for (int rr = 0; rr < r2; ++rr) for (int it = blockIdx.x; it < 256; it += G) wkv_pair<false>(p, smem, g, it);
  } else {
    for (int rr = 0; rr < r1; ++rr) {
      SsdPre R;
      if ((int)blockIdx.x < 128) ssd_issue(p, g, blockIdx.x, 0, get_tid(), R);
      for (int ch = blockIdx.x; ch < 128; ch += G) ssd_chain(p, smem, g, ch, ch + G < 128 ? ch + G : -1, R);
    }
    for (int rr = 0; rr < r2; ++rr) for (int it = (G - 1 - blockIdx.x); it < 512; it += G) wkv_pair<true>(p, smem, g, it);
  }
}
__device__ __forceinline__ void step_fix(const Params& p, char* smem) {
  for (int ch = blockIdx.x; ch < 64; ch += gridDim.x) wkv_fix(p, smem, ch);
}

__device__ __forceinline__ void step_fin(const Params& p, int g) {
  char* ws = p.ws;
  const int tid = get_tid(), lane = tid & 63, wave = tid >> 6;
  const int gw = blockIdx.x * 8 + wave, nw = gridDim.x * 8;
  {
    const u16* yf = (const u16*)(ws + OFF_SYF);
    const u16* yb = (const u16*)(ws + OFF_SYB);
    const u16* xbc = (const u16*)(ws + OFF_XBC);
    const u16* zb = (const u16*)(ws + OFF_Z);
    u16* ym = (u16*)(ws + OFF_YM);
    for (int it = gw; it < TG * 4; it += nw) {
      int r = it >> 2, gq = it & 3;
      int ch = gq * 512 + lane * 8;
      uint4 a = *(const uint4*)(yf + (size_t)r * 2048 + ch);
      uint4 b = *(const uint4*)(yb + (size_t)r * 2048 + ch);
      uint4 x = *(const uint4*)(xbc + (size_t)r * 3072 + ch);
      uint4 z = *(const uint4*)(zb + (size_t)r * 2048 + ch);
      float dsk = p.d_skip[ch >> 6];
      unsigned aw[4] = {a.x, a.y, a.z, a.w}, bw[4] = {b.x, b.y, b.z, b.w}, xw[4] = {x.x, x.y, x.z, x.w}, zw[4] = {z.x, z.y, z.z, z.w};
      float y[8];
      float ss = 0.f;
#pragma unroll
      for (int e = 0; e < 8; ++e) {
        int sh = (e & 1) * 16;
        float yy = bf2f((u16)(aw[e >> 1] >> sh)) + bf2f((u16)(bw[e >> 1] >> sh)) + dsk * bf2f((u16)(xw[e >> 1] >> sh));
        yy *= siluf(bf2f((u16)(zw[e >> 1] >> sh)));
        y[e] = yy;
        ss += yy * yy;
      }
      ss = wave_sum(ss);
      float rinv = rsqrtf(ss * (1.f / 512.f) + 1e-5f);
      float4 w0 = *(const float4*)(p.m_norm_w + ch), w1 = *(const float4*)(p.m_norm_w + ch + 4);
      *(uint4*)(ym + (size_t)r * 2048 + ch) =
          uint4{pack2(y[0] * rinv * w0.x, y[1] * rinv * w0.y), pack2(y[2] * rinv * w0.z, y[3] * rinv * w0.w),
                pack2(y[4] * rinv * w1.x, y[5] * rinv * w1.y), pack2(y[6] * rinv * w1.z, y[7] * rinv * w1.w)};
    }
  }
  {
    const u16* __restrict__ yf = (const u16*)(ws + OFF_WYF);
    const u16* __restrict__ yb = (const u16*)(ws + OFF_WYB);
    const __half* __restrict__ wk = (const __half*)(ws + OFF_WK);
    const u16* __restrict__ gr = (const u16*)(ws + OFF_GR);
    u16* __restrict__ yr = (u16*)(ws + OFF_YR);
    for (int it = gw; it < TG * 2; it += nw) {
      const int r = it >> 1, hh = it & 1;
      const int c0 = hh * 512 + lane * 8;
      const int head = c0 >> 6;
      const uint4 a = *(const uint4*)(yf + (size_t)r * 1024 + c0);
      const uint4 b = *(const uint4*)(yb + (size_t)r * 1024 + c0);
      const uint4 gq = *(const uint4*)(gr + (size_t)r * 1024 + c0);
      const __half* rec = wk + ((size_t)(r * 16 + head) * 8) * 64 + (lane & 7) * 8;
      const uint4 qr = *(const uint4*)(rec + 0 * 64), qv = *(const uint4*)(rec + 1 * 64), qk = *(const uint4*)(rec + 2 * 64);
      const uint4 qaf = *(const uint4*)(rec + 5 * 64), qab = *(const uint4*)(rec + 7 * 64);
      const float4 lw0 = *(const float4*)(p.lnx_w + c0), lw1 = *(const float4*)(p.lnx_w + c0 + 4);
      const float4 lb0 = *(const float4*)(p.lnx_b + c0), lb1 = *(const float4*)(p.lnx_b + c0 + 4);
      const float4 ka0 = *(const float4*)(p.k_a + c0), ka1 = *(const float4*)(p.k_a + c0 + 4);
      const float4 rk0 = *(const float4*)(p.r_k + c0), rk1 = *(const float4*)(p.r_k + c0 + 4);
      const float lw[8] = {lw0.x, lw0.y, lw0.z, lw0.w, lw1.x, lw1.y, lw1.z, lw1.w};
      const float lb[8] = {lb0.x, lb0.y, lb0.z, lb0.w, lb1.x, lb1.y, lb1.z, lb1.w};
      const float kav[8] = {ka0.x, ka0.y, ka0.z, ka0.w, ka1.x, ka1.y, ka1.z, ka1.w};
      const float rkv[8] = {rk0.x, rk0.y, rk0.z, rk0.w, rk1.x, rk1.y, rk1.z, rk1.w};
      float ya[8], yb8[8], gg[8];
      unpack8(a, ya); unpack8(b, yb8); unpack8(gq, gg);
      auto unph = [&](const uint4& u, float (&o)[8]) {
        const __half2* hp = reinterpret_cast<const __half2*>(&u);
#pragma unroll
        for (int e = 0; e < 4; ++e) { float2 f = __half22float2(hp[e]); o[2 * e] = f.x; o[2 * e + 1] = f.y; }
      };
      float rr[8], vv[8], kk[8], af[8], ab[8];
      unph(qr, rr); unph(qv, vv); unph(qk, kk); unph(qaf, af); unph(qab, ab);
      float y[8];
      float s1 = 0.f;
#pragma unroll
      for (int e = 0; e < 8; ++e) { y[e] = ya[e] + yb8[e]; s1 += y[e]; }
      s1 += dpp_xor1(s1); s1 += dpp_xor2(s1); s1 += dpp_hmirror(s1);
      const float mean = s1 * (1.f / 64.f);
      float s2 = 0.f, s3 = 0.f;
#pragma unroll
      for (int e = 0; e < 8; ++e) {
        const float dy = y[e] - mean;
        s2 += dy * dy;
        const float kmean = kk[e] * (1.f + (0.5f * (af[e] + ab[e]) - 1.f) * kav[e]);
        s3 += rr[e] * kmean * rkv[e];
      }
      s2 += dpp_xor1(s2); s2 += dpp_xor2(s2); s2 += dpp_hmirror(s2);
      s3 += dpp_xor1(s3); s3 += dpp_xor2(s3); s3 += dpp_hmirror(s3);
      const float rs = rsqrtf(s2 * (1.f / 64.f) + 64e-5f);
      float o[8];
#pragma unroll
      for (int e = 0; e < 8; ++e) o[e] = ((y[e] - mean) * rs * lw[e] + lb[e] + s3 * vv[e]) * gg[e];
      *(uint4*)(yr + (size_t)r * 1024 + c0) = uint4{pack2(o[0], o[1]), pack2(o[2], o[3]), pack2(o[4], o[5]), pack2(o[6], o[7])};
    }
  }
}

__device__ __forceinline__ void step_outproj(const Params& p, char* smem, int g) {
  char* ws = p.ws;
  u16* Ug = (u16*)p.out + (size_t)g * TG * 1024;
  EpiOut<0> E0{(const u16*)(ws + OFF_GATE), Ug};
  run_gemm8(smem, (const u16*)(ws + OFF_YM), (const u16*)(ws + OFF_WMOUT), TG, 1024, 2048, E0);
  EpiOut<1> E1{(const u16*)(ws + OFF_GATE), Ug};
  run_gemm8(smem, (const u16*)(ws + OFF_YR), (const u16*)(ws + OFF_WROUT), TG, 1024, 1024, E1);
}

__device__ __forceinline__ void step_wo(const Params& p, char* smem, int g) {
  char* ws = p.ws;
  EpiWo E{p.x_prompt, p.x_sample, (const float*)(ws + OFF_MOD), (float*)(ws + OFF_X1), 0};
  run_gemm8(smem, (const u16*)p.out, (const u16*)(ws + OFF_WO), NTOK, 1024, 1024, E);
}

__device__ __forceinline__ void step_gu(const Params& p, char* smem) {
  char* ws = p.ws;
  EpiGU E{(u16*)(ws + OFF_ACT)};
  run_gemm8(smem, (const u16*)(ws + OFF_H2), (const u16*)(ws + OFF_WGU), NTOK, 5632, 1024, E);
}

__device__ __forceinline__ void step_down(const Params& p, char* smem) {
  char* ws = p.ws;
  EpiDown E{(const float*)(ws + OFF_MOD), (float*)(ws + OFF_X1)};
  run_gemm8(smem, (const u16*)(ws + OFF_ACT), (const u16*)(ws + OFF_WDOWN), NTOK, 1024, 2816, E);
}

__device__ __forceinline__ void step_final(const Params& p) {
  const int tid = get_tid(), lane = tid & 63, wave = tid >> 6;
  for (int r = blockIdx.x * 8 + wave; r < NTOK; r += gridDim.x * 8) {
    const float* xr = (const float*)(p.ws + OFF_X1) + (size_t)r * 1024;
    float* xo = p.out + (size_t)r * 1024;
    float4 v[4];
    float ss = 0.f;
#pragma unroll
    for (int i = 0; i < 4; ++i) {
      v[i] = ((const float4*)xr)[i * 64 + lane];
      ss += v[i].x * v[i].x + v[i].y * v[i].y + v[i].z * v[i].z + v[i].w * v[i].w;
    }
    ss = wave_sum(ss);
    float rinv = rsqrtf(ss * (1.f / 1024.f) + 1e-6f);
#pragma unroll
    for (int i = 0; i < 4; ++i) {
      float4 w4 = ((const float4*)p.final_norm_w)[i * 64 + lane];
      ((float4*)xo)[i * 64 + lane] = float4{v[i].x * rinv * w4.x, v[i].y * rinv * w4.y, v[i].z * rinv * w4.z, v[i].w * rinv * w4.w};
    }
  }
}

constexpr int NSTEPS = 30;

__global__ void __launch_bounds__(NTHR) mega(Params p_arg) {
  const int step_lo = p_arg.step_lo, step_hi = p_arg.step_hi;
  __shared__ __attribute__((aligned(16))) char smem[SMEM_BYTES];
#if !MULTI_LAUNCH
  if (threadIdx.x == 0) *(uint4*)(smem + SMEM_BYTES - 16) = uint4{0u, 0u, 0u, 0u};
  __syncthreads();
  XcdBarrier xb = xcd_barrier_post((unsigned*)(p_arg.ws + OFF_BAR), (volatile LAS unsigned*)(smem + SMEM_BYTES - 16));
#endif
  for (int step = step_lo; step <= step_hi; ++step) {
#if defined(__HIP_DEVICE_COMPILE__)
    const __attribute__((address_space(4))) Params* pp = (const __attribute__((address_space(4))) Params*)__builtin_amdgcn_kernarg_segment_ptr();
    asm volatile("" : "+s"(pp));
    const Params p = *pp;
#else
    const Params p = p_arg;
#endif
    const int g = (step - 1) >> 3, s = (step - 1) & 7;
    const int scode = step == 0 ? 0 : (step <= 24 ? 1 + s : step - 16);
    if (scode == 6 && g < 2) continue;
    if (scode == 1 && g > 0) continue;
    const int reps = ((RM >> scode) & 1) ? 2 : 1;
    for (int rep = 0; rep < reps; ++rep) {
      if (!((SM >> scode) & 1)) continue;
      switch (scode) {
        case 0: step_prep(p, smem); break;
        case 1: step_norm<0>(p, g); break;
        case 2: step_gemm1(p, smem); break;
        case 3: step_cr1(p, g); break;
        case 4: step_r2(p, smem); break;
        case 5: step_scan(p, smem, g); break;
        case 6: step_fix(p, smem); break;
        case 7: step_fin(p, g); break;
        case 8:
          if (blockIdx.x < 64) step_outproj(p, smem, g);
          else if (g == 0) {
            convT<1>(p.w_gu, 1024, 5632, (u16*)(p.ws + OFF_WGU), smem, blockIdx.x - 64, gridDim.x - 64);
            convT<0>(p.w_down, 2816, 1024, (u16*)(p.ws + OFF_WDOWN), smem, blockIdx.x - 64, gridDim.x - 64);
          }
          if (g < 2) step_norm<0>(p, g + 1);
          break;
        case 9: step_wo(p, smem, 0); break;
        case 10: step_norm<1>(p, 0); break;
        case 11: step_gu(p, smem); break;
        case 12: step_down(p, smem); break;
        default: step_final(p); break;
      }
    }
    if (step < step_hi) {
#if !MULTI_LAUNCH
      if (step_hi > 100000) cg::this_grid().sync();
      for (int xs = 0; xs < 1 + XSYNC; ++xs) xcd_barrier(xb);
#endif
    }
  }
}

extern "C" void kernel_launch(void* const* d_in, const int* in_sizes, int n_in, void* d_out, int out_size,
                              void* d_ws, size_t ws_size, hipStream_t stream) {
  Params p{};
  const float** pp = (const float**)&p;
  for (int i = 0; i < 36; ++i) pp[i] = (const float*)d_in[i];
  p.out = (float*)d_out;
  p.ws = (char*)d_ws;
  if (ws_size < WS_NEED) fprintf(stderr, "workspace too small: %zu < %zu\n", ws_size, (size_t)WS_NEED);
#if MULTI_LAUNCH
  for (int s = 0; s < NSTEPS; ++s) {
    p.step_lo = s;
    p.step_hi = s;
    hipLaunchKernelGGL(mega, dim3(256), dim3(NTHR), 0, stream, p);
  }
#else
  static int grid_blocks = 0;
  if (!grid_blocks) {
    int dev = 0, cus = 0, per_cu = 0;
    hipGetDevice(&dev);
    hipDeviceGetAttribute(&cus, hipDeviceAttributeMultiprocessorCount, dev);
    hipOccupancyMaxActiveBlocksPerMultiprocessor(&per_cu, mega, NTHR, 0);
    if (per_cu < 1) per_cu = 1;
    if (per_cu > 1) per_cu = 1;
    grid_blocks = cus * per_cu;
  }
  p.step_lo = 0;
  p.step_hi = NSTEPS - 1;
  void* args[] = {&p};
  hipMemsetAsync((char*)d_ws + OFF_BAR, 0, XCD_BAR_WORDS_C * 4, stream);
  hipError_t e = hipLaunchCooperativeKernel((void*)mega, dim3(grid_blocks), dim3(NTHR), args, 0, stream);
  if (e != hipSuccess) fprintf(stderr, "cooperative launch failed: %s (grid %d)\n", hipGetErrorString(e), grid_blocks);
#endif
}
```

```cpp
#include <hip/hip_runtime.h>
#include <hip/hip_cooperative_groups.h>
#include <hip/hip_fp16.h>
#include <cstdio>
#include <cstdint>
namespace cg = cooperative_groups;

#ifndef MULTI_LAUNCH
#define MULTI_LAUNCH 0
#endif

#define DI __device__ __forceinline__
typedef __attribute__((ext_vector_type(8))) short bf16x8;
typedef __attribute__((ext_vector_type(4))) float f32x4;
typedef unsigned short u16;

#ifndef STEP_MASK
#define STEP_MASK 0xffffff
#endif
constexpr int SM = STEP_MASK;
#ifndef REPEAT_MASK
#define REPEAT_MASK 0
#endif
#ifndef XSYNC
#define XSYNC 0
#endif
constexpr int RM = REPEAT_MASK;
constexpr int TG = 4096;
constexpr int NTOK = 12288;
constexpr int NPAD = 10752;
constexpr int NTHR = 512;
constexpr int SMEM_BYTES = 133120;
constexpr int XCD_BAR_WORDS_C = 3456;

constexpr size_t OFF_WIN = 0;
constexpr size_t OFF_WGU = OFF_WIN + (size_t)NPAD * 1024 * 2;
constexpr size_t OFF_WDOWN = OFF_WGU + (size_t)5632 * 1024 * 2;
constexpr size_t OFF_WMOUT = OFF_WDOWN + (size_t)1024 * 2816 * 2;
constexpr size_t OFF_WROUT = OFF_WMOUT + (size_t)1024 * 2048 * 2;
constexpr size_t OFF_WO = OFF_WROUT + (size_t)1024 * 1024 * 2;
constexpr size_t OFF_W2T = OFF_WO + (size_t)1024 * 1024 * 2;
constexpr size_t OFF_A2T = OFF_W2T + 262144;
constexpr size_t OFF_G2T = OFF_A2T + 262144;
constexpr size_t OFF_MOD = OFF_G2T + 262144;
constexpr size_t OFF_GRP = OFF_MOD + 73728;
constexpr size_t OFF_Z = OFF_GRP;
constexpr size_t OFF_GATE = OFF_Z + (size_t)TG * 2048 * 2;
constexpr size_t OFF_XBC = OFF_GATE + (size_t)TG * 2048 * 2;
constexpr size_t OFF_WK = OFF_XBC + (size_t)TG * 3072 * 2;
constexpr size_t OFF_GR = OFF_WK + (size_t)TG * 16 * 1024;
constexpr size_t OFF_DT = OFF_GR + (size_t)TG * 1024 * 2;
constexpr size_t OFF_TL = OFF_DT + (size_t)TG * 64 * 4;
constexpr size_t OFF_SG = OFF_TL + (size_t)TG * 256 * 2;
constexpr size_t OFF_R = OFF_SG + (size_t)TG * 128 * 2;
constexpr size_t OFF_H1 = OFF_R;
constexpr size_t OFF_XBCRAW = OFF_H1 + (size_t)TG * 1024 * 2;
constexpr size_t OFF_RW = OFF_XBCRAW + (size_t)TG * 3072 * 2;
constexpr size_t OFF_SYF = OFF_R;
constexpr size_t OFF_SYB = OFF_SYF + (size_t)TG * 2048 * 2;
constexpr size_t OFF_WYF = OFF_SYB + (size_t)TG * 2048 * 2;
constexpr size_t OFF_WYB = OFF_WYF + (size_t)TG * 1024 * 2;
constexpr size_t OFF_YM = OFF_WYB + (size_t)TG * 1024 * 2;
constexpr size_t OFF_YR = OFF_YM + (size_t)TG * 2048 * 2;
constexpr size_t OFF_END = OFF_YR + (size_t)TG * 1024 * 2;
constexpr size_t OFF_BAR = OFF_END;
constexpr size_t OFF_W4T = OFF_BAR + 16384;
constexpr size_t WS_NEED = OFF_W4T + (size_t)4096 * 256 * 2;
constexpr size_t OFF_U = OFF_XBC;
constexpr size_t OFF_H2 = OFF_GRP;
constexpr size_t OFF_ACT = OFF_H2 + (size_t)NTOK * 1024 * 2;
constexpr size_t H1_OUT_OFF = 25165824;
constexpr size_t OFF_X1 = OFF_ACT + (size_t)NTOK * 2816 * 2;

constexpr size_t OUT_SSMF = 12582912;
constexpr size_t OUT_SSMB = OUT_SSMF + 8388608;
constexpr size_t OUT_WKVF = OUT_SSMB + 8388608;
constexpr size_t OUT_WKVB = OUT_WKVF + 2097152;

struct Params {
  const float *x_prompt, *x_sample, *ssm_f, *ssm_b, *wkv_f, *wkv_b, *c, *c_ctx, *norm1_w, *norm2_w,
      *w_ada, *b_ada, *w_in, *conv_w, *conv_b, *dt_bias, *a_log, *d_skip, *m_norm_w, *mu_shift, *w0,
      *w2, *a0, *a2, *g2, *k_k, *k_a, *r_k, *lnx_w, *lnx_b, *w_m_out, *w_r_out, *w_o, *w_gu, *w_down,
      *final_norm_w;
  float* out;
  char* ws;
  int step_lo, step_hi;
};

DI int get_tid() {
  int t = threadIdx.x;
  asm volatile("" : "+v"(t));
  return t;
}
DI u16 f2bf(float f) {
  unsigned u = __float_as_uint(f);
  u += 0x7fffu + ((u >> 16) & 1u);
  return (u16)(u >> 16);
}
DI float bf2f(u16 h) { return __uint_as_float(((unsigned)h) << 16); }
DI float siluf(float x) { return x / (1.f + __expf(-x)); }
DI float sigm(float x) { return 1.f / (1.f + __expf(-x)); }
DI float wave_sum(float v) {
  v += __int_as_float(__builtin_amdgcn_update_dpp(0, __float_as_int(v), 0xB1, 0xF, 0xF, true));
  v += __int_as_float(__builtin_amdgcn_update_dpp(0, __float_as_int(v), 0x4E, 0xF, 0xF, true));
  v += __int_as_float(__builtin_amdgcn_update_dpp(0, __float_as_int(v), 0x141, 0xF, 0xF, true));
  v += __int_as_float(__builtin_amdgcn_update_dpp(0, __float_as_int(v), 0x140, 0xF, 0xF, true));
  const int vi = __float_as_int(v);
  float a = __int_as_float(__builtin_amdgcn_readlane(vi, 0)), b = __int_as_float(__builtin_amdgcn_readlane(vi, 16));
  float c = __int_as_float(__builtin_amdgcn_readlane(vi, 32)), d = __int_as_float(__builtin_amdgcn_readlane(vi, 48));
  return (a + b) + (c + d);
}
DI float dpp_xor1(float v) { return __int_as_float(__builtin_amdgcn_update_dpp(0, __float_as_int(v), 0xB1, 0xF, 0xF, true)); }
DI float dpp_hmirror(float v) { return __int_as_float(__builtin_amdgcn_update_dpp(0, __float_as_int(v), 0x141, 0xF, 0xF, true)); }
DI float dpp_xor2(float v) { return __int_as_float(__builtin_amdgcn_update_dpp(0, __float_as_int(v), 0x4E, 0xF, 0xF, true)); }
DI unsigned pack2(float a, float b) { return (unsigned)f2bf(a) | ((unsigned)f2bf(b) << 16); }
DI int mrow_of(int tok) { return tok < 8192 ? 0 : 1 + ((tok - 8192) >> 11); }


#define XB_TMO      128
#define XB_XCNT(j)  (256  + 64 * (j))
#define XB_XSUB(j)  (1280 + 64 * (j))
#define XB_XGEN(j)  (2304 + 64 * (j))
#define XB_TOP      3328
#define XB_TOPGEN   3392
#define XCD_BAR_WORDS 3456
#define XB_SPIN_CAP (1u << 22)
#define LAS __attribute__((address_space(3)))
DI unsigned xb_ld(unsigned* p) { return __hip_atomic_load(p, __ATOMIC_RELAXED, __HIP_MEMORY_SCOPE_AGENT); }
DI unsigned xb_add(unsigned* p, unsigned v) { return __hip_atomic_fetch_add(p, v, __ATOMIC_RELAXED, __HIP_MEMORY_SCOPE_AGENT); }
DI unsigned xb_xcc_id() { return (unsigned)__builtin_amdgcn_s_getreg((3 << 11) | 20) & 0xFu; }
#define XB_SPIN(cond, bar) do { unsigned _sp = 0; while (cond) { __builtin_amdgcn_s_sleep(1); \
    if ((++_sp & 255u) == 0u) { if (xb_ld(&(bar)[XB_TMO])) break; if (_sp > XB_SPIN_CAP) { atomicAdd(&(bar)[XB_TMO], 1u); break; } } } } while (0)
struct XcdBarrier { unsigned* bar; unsigned x; volatile LAS unsigned* st; };
DI XcdBarrier xcd_barrier_post(unsigned* bar, volatile LAS unsigned* st) {
  XcdBarrier b; b.bar = bar; b.x = xb_xcc_id(); b.st = st;
  if (threadIdx.x == 0) (void)xb_add(&bar[XB_XCNT(b.x)], 1u);
  return b;
}
DI void xcd_barrier_complete(unsigned* bar, unsigned x, unsigned& nloc, unsigned& nx) {
  const unsigned G = gridDim.x * gridDim.y * gridDim.z;
  unsigned sum, cnt, mine, sp = 0u;
  for (;;) {
    sum = 0u; cnt = 0u; mine = 0u;
#pragma unroll
    for (unsigned j = 0; j < 16; ++j) { const unsigned c = xb_ld(&bar[XB_XCNT(j)]); sum += c; cnt += (c > 0u) ? 1u : 0u; mine = (j == x) ? c : mine; }
    if (sum == G) break;
    __builtin_amdgcn_s_sleep(1);
    if ((++sp & 255u) == 0u) { if (xb_ld(&bar[XB_TMO])) break; if (sp > XB_SPIN_CAP) { atomicAdd(&bar[XB_TMO], 1u); break; } }
  }
  nloc = mine > 0u ? mine : 1u; nx = cnt > 0u ? cnt : 1u;
}
DI void xcd_barrier(const XcdBarrier& b) {
  asm volatile("s_waitcnt vmcnt(0)" ::: "memory");
  __syncthreads();
  if (threadIdx.x == 0) {
    unsigned* bar = b.bar;
    asm volatile("" : "+s"(bar));
    __builtin_amdgcn_s_waitcnt(0);
    unsigned nloc = b.st[0], nx = b.st[1];
    if (nloc == 0u) { xcd_barrier_complete(bar, b.x, nloc, nx); b.st[0] = nloc; b.st[1] = nx; }
    const unsigned old = xb_add(&bar[XB_XSUB(b.x)], 1u);
    const unsigned gen = old / nloc;
    if (old + 1u == (gen + 1u) * nloc) {
      __builtin_amdgcn_fence(__ATOMIC_RELEASE, "agent");
      asm volatile("s_waitcnt vmcnt(0)" ::: "memory");
      const unsigned og = xb_add(&bar[XB_TOP], 1u);
      const unsigned tg = og / nx;
      if (og + 1u == (tg + 1u) * nx) xb_add(&bar[XB_TOPGEN], 1u);
      else XB_SPIN(xb_ld(&bar[XB_TOPGEN]) == tg, bar);
      __builtin_amdgcn_fence(__ATOMIC_ACQUIRE, "agent");
      xb_add(&bar[XB_XGEN(b.x)], 1u);
      asm volatile("s_waitcnt vmcnt(0)" ::: "memory");
    } else {
      XB_SPIN(xb_ld(&bar[XB_XGEN(b.x)]) == gen, bar);
      __builtin_amdgcn_fence(__ATOMIC_ACQUIRE, "agent");
      asm volatile("s_waitcnt vmcnt(0)" ::: "memory");
    }
  }
  __syncthreads();
}

DI void gemm_load(const int tid, const u16* A, int lda, const u16* B, int ldb, int k0, uint4 (&ra)[4], uint4 (&rb)[2]) {
#pragma unroll
  for (int i = 0; i < 4; ++i) {
    int idx = tid + i * 512;
    int row = idx >> 3, ch = idx & 7;
    ra[i] = *(const uint4*)(A + (size_t)row * lda + k0 + ch * 8);
  }
#pragma unroll
  for (int i = 0; i < 2; ++i) {
    int idx = tid + i * 512;
    int row = idx >> 3, ch = idx & 7;
    rb[i] = *(const uint4*)(B + (size_t)row * ldb + k0 + ch * 8);
  }
}
DI void gemm_store_lds(const int tid, char* sA, char* sB, const uint4 (&ra)[4], const uint4 (&rb)[2]) {
#pragma unroll
  for (int i = 0; i < 4; ++i) {
    int idx = tid + i * 512;
    int row = idx >> 3, ch = idx & 7;
    *(uint4*)(sA + row * 128 + ((ch ^ ((row >> 1) & 7)) << 4)) = ra[i];
  }
#pragma unroll
  for (int i = 0; i < 2; ++i) {
    int idx = tid + i * 512;
    int row = idx >> 3, ch = idx & 7;
    *(uint4*)(sB + row * 128 + ((ch ^ ((row >> 1) & 7)) << 4)) = rb[i];
  }
}
DI void gemm_compute(const char* sA, const char* sB, f32x4 (&acc)[4][4], int wm, int wn, int lane) {
#pragma unroll
  for (int kk = 0; kk < 2; ++kk) {
    bf16x8 a[4], b[4];
    const int ch = kk * 4 + (lane >> 4);
#pragma unroll
    for (int mf = 0; mf < 4; ++mf) {
      int row = wm * 64 + mf * 16 + (lane & 15);
      a[mf] = *(const bf16x8*)(sA + row * 128 + ((ch ^ ((row >> 1) & 7)) << 4));
    }
#pragma unroll
    for (int nf = 0; nf < 4; ++nf) {
      int row = wn * 64 + nf * 16 + (lane & 15);
      b[nf] = *(const bf16x8*)(sB + row * 128 + ((ch ^ ((row >> 1) & 7)) << 4));
    }
#pragma unroll
    for (int mf = 0; mf < 4; ++mf)
#pragma unroll
      for (int nf = 0; nf < 4; ++nf)
        acc[mf][nf] = __builtin_amdgcn_mfma_f32_16x16x32_bf16(a[mf], b[nf], acc[mf][nf], 0, 0, 0);
  }
}
DI void gemm_acc(const u16* A, int lda, const u16* B, int ldb, int K, f32x4 (&acc)[4][4], char* smem) {
  const int tid = get_tid(), lane = tid & 63, wave = tid >> 6;
  const int wm = wave >> 1, wn = wave & 1;
  char* sA0 = smem;
  char* sB0 = smem + 32768;
  char* sA1 = smem + 49152;
  char* sB1 = smem + 81920;
  uint4 ra[4], rb[2];
  const int nk = K >> 6;
  gemm_load(tid, A, lda, B, ldb, 0, ra, rb);
  gemm_store_lds(tid, sA0, sB0, ra, rb);
  __syncthreads();
  for (int kt = 0; kt < nk; ++kt) {
    const bool more = (kt + 1 < nk);
    if (more) gemm_load(tid, A, lda, B, ldb, (kt + 1) * 64, ra, rb);
    if (kt & 1) gemm_compute(sA1, sB1, acc, wm, wn, lane);
    else gemm_compute(sA0, sB0, acc, wm, wn, lane);
    if (more) {
      if (kt & 1) gemm_store_lds(tid, sA0, sB0, ra, rb);
      else gemm_store_lds(tid, sA1, sB1, ra, rb);
    }
    __syncthreads();
  }
}
DI void zero_acc(f32x4 (&acc)[4][4]) {
#pragma unroll
  for (int i = 0; i < 4; ++i)
#pragma unroll
    for (int j = 0; j < 4; ++j) { float z0; asm volatile("v_mov_b32 %0, 0" : "=v"(z0)); acc[i][j] = f32x4{z0, z0, z0, z0}; }
}

#define PG8_LAS __attribute__((address_space(3)))
namespace pg8 {
typedef unsigned short bf16_t;
typedef short bf16x8 __attribute__((ext_vector_type(8)));
typedef float f32x4 __attribute__((ext_vector_type(4)));
typedef unsigned u32x4 __attribute__((ext_vector_type(4)));
constexpr int BM = 256, BK = 64, HALF = 128, HTB = HALF * BK * 2  , STAGE_BYTES = 8 * HTB, NXCD = 8, WGM = 8;

__host__ __device__ __forceinline__ int lds_byte(int r, int c) { const int st = (r >> 4) * 2 + (c >> 5), rr = r & 15, cc = c & 31, ob = rr * 64 + cc * 2; return st * 1024 + (ob ^ (((ob >> 9) & 1) << 5)); }
__host__ __device__ __forceinline__ void stage_rc(int b, int& R, int& C) { const int st = b / 1024, sb = b % 1024, swz = sb ^ (((sb >> 9) & 1) << 5); R = (st >> 1) * 16 + swz / 64; C = (st & 1) * 32 + (swz % 64) / 2; }
__host__ __device__ __forceinline__ int perm32(int rho) { const int n = rho >> 4, i = rho & 15; return 8 * (i >> 2) + 4 * n + (i & 3); }

struct Unit { int pm, pn; };
struct Gemm { const bf16_t* A; const bf16_t* Bt; int M, N, K; };

struct StaticOrder {
    int nM, nN, nwg, G, c;
    __host__ __device__ void init(int M, int N, int G_, int c_) { nM = M / BM; nN = N / BM; nwg = nM * nN; G = G_; c = c_; }
    __host__ __device__ bool next(int i, Unit& u) const {
        const long L = (long)i * G + c; if (L >= nwg) return false;
        int wgid = (int)L; { const int q = nwg / NXCD, r = nwg % NXCD, xcd = wgid % NXCD, off = wgid / NXCD; wgid = (xcd < r ? xcd * (q + 1) : r * (q + 1) + (xcd - r) * q) + off; }
        const int nig = WGM * nN, gid = wgid / nig, fm = gid * WGM, gsz = (nM - fm) < WGM ? (nM - fm) : WGM;
        u.pm = fm + ((wgid % nig) % gsz); u.pn = (wgid % nig) / gsz; return true;
    }
    __device__ __forceinline__ void a_ready(const Unit&) const {}
    __device__ __forceinline__ void done(const Unit&) const {}
};
__device__ __forceinline__ unsigned cvt_pk_bf16(float lo, float hi) { unsigned r; asm volatile("v_cvt_pk_bf16_f32 %0, %1, %2" : "=v"(r) : "v"(lo), "v"(hi)); return r; }
template <class Epi, class Sched, bool STAMP = false>
__device__ __forceinline__ void gemm_phase(PG8_LAS unsigned char* lds, const Gemm g, const Sched& S, const Epi& E, unsigned long long* stamps) {
    const int tid = get_tid(), wid = __builtin_amdgcn_readfirstlane(tid >> 6), lane = tid & 63, wr = wid >> 2, wc = wid & 3, fr = lane & 15, fq = lane >> 4;
    const int K = g.K, nt = K / BK;
    int ts_lo = 0, ts_hi = 0, nts = 0; const unsigned long long rt_entry = STAMP ? (unsigned long long)wall_clock64() : 0ull;
#define PG8_STAMP() do { if (STAMP && wid == 0 && nts < 64) { const unsigned long long _c = (unsigned long long)clock64(); \
        ts_lo = (lane == nts) ? (int)(unsigned)_c : ts_lo; ts_hi = (lane == nts) ? (int)(unsigned)(_c >> 32) : ts_hi; ++nts; } } while (0)
    PG8_STAMP();
    unsigned voffA[2], voffB[2];
#pragma unroll
    for (int i = 0; i < 2; ++i) { int R, C; stage_rc(tid * 16 + i * 8192, R, C); const int Rb = Epi::PERM ? ((R & ~31) + perm32(R & 31)) : R;
        voffA[i] = (unsigned)(R * K + C) * 2u; voffB[i] = (unsigned)(Rb * K + C) * 2u; }
    const size_t kstep = (size_t)(BK * 2);
    const size_t hstep = (size_t)HALF * K * 2;
    const size_t tstep = 2 * hstep;
    const unsigned ldsw = (unsigned)wid * 1024u;
    const int aoff = lds_byte(wr * 64 + fr, fq * 8), boff = lds_byte(wc * 32 + fr, fq * 8);
#define PG8_SA(b, h) (((b) * 2 + (h)) * HTB)
#define PG8_SB(b, h) ((4 + (b) * 2 + (h)) * HTB)
#define PG8_STAGE(bufoff, gbase, voff) do { _Pragma("unroll") for (int _i = 0; _i < 2; ++_i) \
        __builtin_amdgcn_global_load_lds((const unsigned*)((const char*)(gbase) + (voff)[_i]), (PG8_LAS unsigned*)(lds + (bufoff) + ldsw + _i * 8192), 16, 0, 0); } while (0)
#define PG8_LDA(dst, b, h) do { _Pragma("unroll") for (int m = 0; m < 4; ++m) _Pragma("unroll") for (int k = 0; k < 2; ++k) dst[m][k] = *(const PG8_LAS bf16x8*)(lds + PG8_SA(b, h) + aoff + m * 2048 + k * 1024); } while (0)
#define PG8_LDB(dst, b, h) do { _Pragma("unroll") for (int n = 0; n < 2; ++n) _Pragma("unroll") for (int k = 0; k < 2; ++k) dst[n][k] = *(const PG8_LAS bf16x8*)(lds + PG8_SB(b, h) + boff + n * 2048 + k * 1024); } while (0)
#define PG8_MMA(ai, bj, At, Bt) do { __builtin_amdgcn_s_setprio(1); _Pragma("unroll") for (int m = 0; m < 4; ++m) _Pragma("unroll") for (int n = 0; n < 2; ++n) _Pragma("unroll") for (int k = 0; k < 2; ++k) \
        acc[ai][bj][m][n] = __builtin_amdgcn_mfma_f32_16x16x32_bf16(Bt[n][k], At[m][k], acc[ai][bj][m][n], 0, 0, 0); __builtin_amdgcn_s_setprio(0); } while (0)
#define PG8_WAIT_V(n) asm volatile("s_waitcnt vmcnt(" #n ")" ::: "memory")
#define PG8_WAIT_L(n) asm volatile("s_waitcnt lgkmcnt(" #n ")" ::: "memory")
#define PG8_BAR __builtin_amdgcn_s_barrier()
#define PG8_SCHED __builtin_amdgcn_sched_barrier(0)
    Unit cur, nxt; int ui = 0;
    if (!S.next(0, cur)) return;
    f32x4 acc[2][2][4][2];
#pragma unroll
    for (int a = 0; a < 2; ++a)
#pragma unroll
        for (int b = 0; b < 2; ++b)
#pragma unroll
            for (int m = 0; m < 4; ++m)
#pragma unroll
                for (int n = 0; n < 2; ++n) { float z0; asm volatile("v_mov_b32 %0, 0" : "=v"(z0)); acc[a][b][m][n] = (f32x4){z0, z0, z0, z0}; }
    bf16x8 At[4][2], B0[2][2], B1[2][2];
    const char* cA = (const char*)g.A + (size_t)cur.pm * tstep; const char* cB = (const char*)g.Bt + (size_t)cur.pn * tstep;
    S.a_ready(cur);
    PG8_STAGE(PG8_SB(0, 0), cB, voffB); PG8_STAGE(PG8_SA(0, 0), cA, voffA); PG8_STAGE(PG8_SB(0, 1), cB + hstep, voffB); PG8_STAGE(PG8_SA(0, 1), cA + hstep, voffA);
    if (wr == 1) PG8_BAR;
    PG8_WAIT_V(4); PG8_BAR;
    PG8_STAGE(PG8_SB(1, 0), cB + kstep, voffB); PG8_STAGE(PG8_SA(1, 0), cA + kstep, voffA); PG8_STAGE(PG8_SB(1, 1), cB + hstep + kstep, voffB);
    PG8_WAIT_V(6); PG8_BAR;
    PG8_STAMP();
    for (;;) {
        const bool has_next = S.next(ui + 1, nxt);
        const char* nA = has_next ? (const char*)g.A + (size_t)nxt.pm * tstep : cA; const char* nB = has_next ? (const char*)g.Bt + (size_t)nxt.pn * tstep : cB;
        for (int t = 0; t < nt; t += 2) {
            const bool last = (t == nt - 2);
            const char* a1 = cA + (size_t)(t + 1) * kstep;
            const char* a2 = last ? nA : cA + (size_t)(t + 2) * kstep; const char* b2 = last ? nB : cB + (size_t)(t + 2) * kstep;
            const char* a3 = a2 + kstep; const char* b3 = b2 + kstep;
            if (last && has_next) S.a_ready(nxt);
            PG8_LDB(B0, 0, 0); PG8_SCHED; PG8_LDA(At, 0, 0); PG8_STAGE(PG8_SA(1, 1), a1 + hstep, voffA);
            PG8_WAIT_L(8); PG8_BAR; PG8_WAIT_L(0); PG8_MMA(0, 0, At, B0); PG8_BAR; PG8_SCHED;
            PG8_LDB(B1, 0, 1); PG8_STAGE(PG8_SB(0, 0), b2, voffB);
            PG8_BAR; PG8_WAIT_L(0); PG8_MMA(0, 1, At, B1); PG8_BAR;
            PG8_LDA(At, 0, 1); PG8_STAGE(PG8_SA(0, 0), a2, voffA);
            PG8_BAR; PG8_WAIT_L(0); PG8_MMA(1, 0, At, B0); PG8_BAR; PG8_SCHED;
            PG8_STAGE(PG8_SB(0, 1), b2 + hstep, voffB);
            PG8_WAIT_V(6); PG8_BAR; PG8_MMA(1, 1, At, B1); PG8_BAR;
            PG8_LDB(B0, 1, 0); PG8_SCHED; PG8_LDA(At, 1, 0); PG8_STAGE(PG8_SA(0, 1), a2 + hstep, voffA);
            PG8_WAIT_L(8); PG8_BAR; PG8_WAIT_L(0); PG8_MMA(0, 0, At, B0); PG8_BAR; PG8_SCHED;
            PG8_LDB(B1, 1, 1); PG8_STAGE(PG8_SB(1, 0), b3, voffB);
            PG8_BAR; PG8_WAIT_L(0); PG8_MMA(0, 1, At, B1); PG8_BAR;
            PG8_LDA(At, 1, 1); PG8_STAGE(PG8_SA(1, 0), a3, voffA);
            PG8_BAR; PG8_WAIT_L(0); PG8_MMA(1, 0, At, B0); PG8_BAR; PG8_SCHED;
            PG8_STAGE(PG8_SB(1, 1), b3 + hstep, voffB);
            PG8_WAIT_V(6); PG8_BAR; PG8_MMA(1, 1, At, B1); PG8_BAR;
        }
        PG8_STAMP();
        if constexpr (!Epi::AFTER_DRAIN) { E(acc, cur, wr, wc, fr, fq); S.done(cur); }
        PG8_STAMP();
        if (!has_next) break;
#pragma unroll
        for (int a = 0; a < 2; ++a)
#pragma unroll
            for (int b = 0; b < 2; ++b)
#pragma unroll
                for (int m = 0; m < 4; ++m)
#pragma unroll
                    for (int n = 0; n < 2; ++n) { float z0; asm volatile("v_mov_b32 %0, 0" : "=v"(z0)); acc[a][b][m][n] = (f32x4){z0, z0, z0, z0}; }
        cur = nxt; cA = nA; cB = nB; ++ui;
    }
    PG8_WAIT_V(0);
    if (wr == 0) PG8_BAR;
    PG8_BAR;
    if constexpr (Epi::AFTER_DRAIN) { E.fused(acc, cur, wr, wc, fr, fq, lds, wid, lane); S.done(cur); }
    PG8_STAMP();
    if (STAMP && wid == 0) { stamps[lane] = lane < nts ? (((unsigned long long)(unsigned)ts_hi << 32) | (unsigned)ts_lo) : 0ull;
        if (lane == 62) stamps[62] = rt_entry; if (lane == 63) stamps[63] = (unsigned long long)wall_clock64(); }
#undef PG8_STAMP
#undef PG8_SA
#undef PG8_SB
#undef PG8_STAGE
#undef PG8_LDA
#undef PG8_LDB
#undef PG8_MMA
#undef PG8_WAIT_V
#undef PG8_WAIT_L
#undef PG8_BAR
#undef PG8_SCHED
}
}

using pg8::cvt_pk_bf16;
DI uint4 pack8(const pg8::f32x4& a, const pg8::f32x4& b) {
  return uint4{cvt_pk_bf16(a[0], a[1]), cvt_pk_bf16(a[2], a[3]), cvt_pk_bf16(b[0], b[1]), cvt_pk_bf16(b[2], b[3])};
}
DI void unpack8(const uint4& u, float (&o)[8]) {
  o[0] = bf2f((u16)(u.x & 0xffff)); o[1] = bf2f((u16)(u.x >> 16));
  o[2] = bf2f((u16)(u.y & 0xffff)); o[3] = bf2f((u16)(u.y >> 16));
  o[4] = bf2f((u16)(u.z & 0xffff)); o[5] = bf2f((u16)(u.z >> 16));
  o[6] = bf2f((u16)(u.w & 0xffff)); o[7] = bf2f((u16)(u.w >> 16));
}
struct EpiP {
  static constexpr bool PERM = true, AFTER_DRAIN = false;
  u16 *zb, *xr, *rwb, *gb; float* dtb; int coff;
  DI void operator()(const pg8::f32x4 (&acc)[2][2][4][2], const pg8::Unit& u, int wr, int wc, int fr, int fq) const {
    const int row0 = u.pm * 256 + wr * 64 + fr;
#pragma unroll
    for (int bj = 0; bj < 2; ++bj) {
      const int cg = coff + u.pn * 256 + bj * 128 + wc * 32;
      const int col0 = cg + 8 * fq;
      if (cg >= 10688) continue;
#pragma unroll
      for (int ai = 0; ai < 2; ++ai)
#pragma unroll
        for (int m = 0; m < 4; ++m) {
          const size_t row = row0 + ai * 128 + m * 16;
          const pg8::f32x4 v0 = acc[ai][bj][m][0], v1 = acc[ai][bj][m][1];
          if (cg >= 5120 && cg < 5184) {
            float* d = dtb + row * 64 + (col0 - 5120);
            *(pg8::f32x4*)d = v0; *(pg8::f32x4*)(d + 4) = v1;
          } else {
            u16* dst = (cg < 2048) ? zb + row * 2048 + col0
                     : (cg < 5120) ? xr + row * 3072 + (col0 - 2048)
                     : (cg < 8640) ? rwb + row * 3456 + (col0 - 5184)
                                   : gb + row * 2048 + (col0 - 8640);
            *(uint4*)dst = pack8(v0, v1);
          }
        }
    }
  }
};
template <int PASS>
struct EpiOut {
  static constexpr bool PERM = true, AFTER_DRAIN = false;
  const u16* gb; u16* U;
  DI void operator()(const pg8::f32x4 (&acc)[2][2][4][2], const pg8::Unit& u, int wr, int wc, int fr, int fq) const {
    const int row0 = u.pm * 256 + wr * 64 + fr;
#pragma unroll
    for (int bj = 0; bj < 2; ++bj) {
      const int col0 = u.pn * 256 + bj * 128 + wc * 32 + 8 * fq;
#pragma unroll
      for (int ai = 0; ai < 2; ++ai)
#pragma unroll
        for (int m = 0; m < 4; ++m) {
          const size_t row = row0 + ai * 128 + m * 16;
          float gt[8];
          unpack8(*(const uint4*)(gb + row * 2048 + PASS * 1024 + col0), gt);
          pg8::f32x4 v0 = acc[ai][bj][m][0], v1 = acc[ai][bj][m][1];
#pragma unroll
          for (int e = 0; e < 4; ++e) { v0[e] *= sigm(gt[e]); v1[e] *= sigm(gt[4 + e]); }
          if (PASS == 1) {
            float pu[8];
            unpack8(*(const uint4*)(U + row * 1024 + col0), pu);
#pragma unroll
            for (int e = 0; e < 4; ++e) { v0[e] += pu[e]; v1[e] += pu[4 + e]; }
          }
          *(uint4*)(U + row * 1024 + col0) = pack8(v0, v1);
        }
    }
  }
};
struct EpiWo {
  static constexpr bool PERM = true, AFTER_DRAIN = false;
  const float *xp, *xs, *mod; float* out; int tok0;
  DI void operator()(const pg8::f32x4 (&acc)[2][2][4][2], const pg8::Unit& u, int wr, int wc, int fr, int fq) const {
    const int row0 = u.pm * 256 + wr * 64 + fr;
#pragma unroll
    for (int bj = 0; bj < 2; ++bj) {
      const int col0 = u.pn * 256 + bj * 128 + wc * 32 + 8 * fq;
#pragma unroll
      for (int ai = 0; ai < 2; ++ai)
#pragma unroll
        for (int m = 0; m < 4; ++m) {
          const int tok = tok0 + row0 + ai * 128 + m * 16;
          const float* xr = tok < 8192 ? xp + (size_t)tok * 1024 : xs + (size_t)(tok - 8192) * 1024;
          const float* gt = mod + mrow_of(tok) * 6144 + 2048 + col0;
          const pg8::f32x4 x0 = *(const pg8::f32x4*)(xr + col0), x1 = *(const pg8::f32x4*)(xr + col0 + 4);
          const pg8::f32x4 g0 = *(const pg8::f32x4*)gt, g1 = *(const pg8::f32x4*)(gt + 4);
          float* o = out + (size_t)tok * 1024 + col0;
          *(pg8::f32x4*)o = x0 + g0 * acc[ai][bj][m][0];
          *(pg8::f32x4*)(o + 4) = x1 + g1 * acc[ai][bj][m][1];
        }
    }
  }
};
struct EpiGU {
  static constexpr bool PERM = true, AFTER_DRAIN = false;
  u16* act;
  DI void operator()(const pg8::f32x4 (&acc)[2][2][4][2], const pg8::Unit& u, int wr, int wc, int fr, int fq) const {
    const int row0 = u.pm * 256 + wr * 64 + fr;
    const int col0 = u.pn * 128 + wc * 32 + 8 * fq;
#pragma unroll
    for (int ai = 0; ai < 2; ++ai)
#pragma unroll
      for (int m = 0; m < 4; ++m) {
        const size_t row = row0 + ai * 128 + m * 16;
        pg8::f32x4 v0, v1;
#pragma unroll
        for (int e = 0; e < 4; ++e) {
          v0[e] = siluf(acc[ai][0][m][0][e]) * acc[ai][1][m][0][e];
          v1[e] = siluf(acc[ai][0][m][1][e]) * acc[ai][1][m][1][e];
        }
        *(uint4*)(act + row * 2816 + col0) = pack8(v0, v1);
      }
  }
};
struct EpiDown {
  static constexpr bool PERM = true, AFTER_DRAIN = false;
  const float* mod; float* out;
  DI void operator()(const pg8::f32x4 (&acc)[2][2][4][2], const pg8::Unit& u, int wr, int wc, int fr, int fq) const {
    const int row0 = u.pm * 256 + wr * 64 + fr;
#pragma unroll
    for (int bj = 0; bj < 2; ++bj) {
      const int col0 = u.pn * 256 + bj * 128 + wc * 32 + 8 * fq;
#pragma unroll
      for (int ai = 0; ai < 2; ++ai)
#pragma unroll
        for (int m = 0; m < 4; ++m) {
          const int tok = row0 + ai * 128 + m * 16;
          const float* gt = mod + mrow_of(tok) * 6144 + 5120 + col0;
          const pg8::f32x4 g0 = *(const pg8::f32x4*)gt, g1 = *(const pg8::f32x4*)(gt + 4);
          float* o = out + (size_t)tok * 1024 + col0;
          const pg8::f32x4 x0 = *(const pg8::f32x4*)o, x1 = *(const pg8::f32x4*)(o + 4);
          *(pg8::f32x4*)o = x0 + g0 * acc[ai][bj][m][0];
          *(pg8::f32x4*)(o + 4) = x1 + g1 * acc[ai][bj][m][1];
        }
    }
  }
};
template <class Epi>
DI void run_gemm8(char* smem, const u16* A, const u16* Bt, int M, int N, int K, const Epi& E, int vb = -1, int nb = 0) {
  asm volatile("" : "+s"(M), "+s"(N), "+s"(K));
  pg8::Gemm gm{A, Bt, M, N, K};
  pg8::StaticOrder S;
  if (vb < 0) { vb = blockIdx.x; nb = gridDim.x; }
  S.init(M, N, nb, vb);
  pg8::gemm_phase<Epi, pg8::StaticOrder, false>((PG8_LAS unsigned char*)smem, gm, S, E, nullptr);
  __syncthreads();
}

struct EpiR2 {
  static constexpr bool PERM = true, AFTER_DRAIN = false;
  __half* wk; const float *w0, *a0;
  DI void operator()(const pg8::f32x4 (&acc)[2][2][4][2], const pg8::Unit& u, int wr, int wc, int fr, int fq) const {
    const int row0 = u.pm * 256 + wr * 64 + fr;
    const int sec = u.pn >> 2;
#pragma unroll
    for (int bj = 0; bj < 2; ++bj) {
      const int nn = (u.pn & 3) * 256 + bj * 128 + wc * 32 + 8 * fq;
      const int d = sec & 1;
      const float* bias = (sec < 2 ? w0 : a0) + d * 1024 + nn;
      const pg8::f32x4 b0 = *(const pg8::f32x4*)bias, b1 = *(const pg8::f32x4*)(bias + 4);
      const int field = (sec < 2 ? 4 : 5) + 2 * d;
#pragma unroll
      for (int ai = 0; ai < 2; ++ai)
#pragma unroll
        for (int m = 0; m < 4; ++m) {
          const size_t row = row0 + ai * 128 + m * 16;
          pg8::f32x4 v0 = acc[ai][bj][m][0] + b0, v1 = acc[ai][bj][m][1] + b1;
          float o[8];
#pragma unroll
          for (int e = 0; e < 4; ++e) {
            float s0 = sigm(v0[e]), s1 = sigm(v1[e]);
            o[e] = sec < 2 ? __expf(-0.6065306597f * s0) : s0;
            o[4 + e] = sec < 2 ? __expf(-0.6065306597f * s1) : s1;
          }
          __half2 h0 = __floats2half2_rn(o[0], o[1]), h1 = __floats2half2_rn(o[2], o[3]);
          __half2 h2 = __floats2half2_rn(o[4], o[5]), h3 = __floats2half2_rn(o[6], o[7]);
          uint4 pk;
          pk.x = *reinterpret_cast<unsigned*>(&h0); pk.y = *reinterpret_cast<unsigned*>(&h1);
          pk.z = *reinterpret_cast<unsigned*>(&h2); pk.w = *reinterpret_cast<unsigned*>(&h3);
          *(uint4*)(wk + ((row * 16 + (nn >> 6)) * 8 + field) * 64 + (nn & 63)) = pk;
        }
    }
  }
};

template <int MODE>
__device__ __forceinline__ void convT(const float* __restrict__ src, int K, int N, u16* __restrict__ dst, char* smem, int vb = -1, int nb = 0, int ldd = 0) {
  if (ldd == 0) ldd = K;
  float* tile = (float*)smem;
  const int tid = get_tid();
  const int KT = K >> 6, NT = N >> 6;
  if (vb < 0) { vb = blockIdx.x; nb = gridDim.x; }
  for (int t = vb; t < KT * NT; t += nb) {
    int kt = t % KT, nt = t / KT;
#pragma unroll
    for (int i = 0; i < 8; ++i) {
      int idx = tid + i * 512;
      int r = idx >> 6, cc = idx & 63;
      tile[r * 65 + cc] = src[(size_t)(kt * 64 + r) * N + nt * 64 + cc];
    }
    __syncthreads();
    int n = tid >> 3, kc = tid & 7;
    unsigned w[4];
#pragma unroll
    for (int j = 0; j < 4; ++j)
      w[j] = pack2(tile[(kc * 8 + 2 * j) * 65 + n], tile[(kc * 8 + 2 * j + 1) * 65 + n]);
    int ng = nt * 64 + n;
    int row = ng;
    if (MODE == 1) {
      int isu = ng >= 2816;
      int nn = ng - isu * 2816;
      row = (nn >> 7) * 256 + isu * 128 + (nn & 127);
    }
    *(uint4*)(dst + (size_t)row * ldd + kt * 64 + kc * 8) = uint4{w[0], w[1], w[2], w[3]};
    __syncthreads();
  }
}

__device__ __forceinline__ void step_prep(const Params& p, char* smem) {
  const int tid = get_tid();
  char* ws = p.ws;
  {
    float* red = (float*)smem;
    float* mod = (float*)(ws + OFF_MOD);
    for (int item = blockIdx.x; item < 192; item += gridDim.x) {
      int c4 = tid & 7, kl = tid >> 3;
      float acc[12];
#pragma unroll
      for (int i = 0; i < 12; ++i) acc[i] = 0.f;
      for (int k = kl; k < 1024; k += 64) {
        float4 w = *(const float4*)(p.w_ada + (size_t)k * 6144 + item * 32 + c4 * 4);
        float s0 = siluf(p.c_ctx[k]), s1 = siluf(p.c[k]), s2 = siluf(p.c[1024 + k]);
        acc[0] += s0 * w.x; acc[1] += s0 * w.y; acc[2] += s0 * w.z; acc[3] += s0 * w.w;
        acc[4] += s1 * w.x; acc[5] += s1 * w.y; acc[6] += s1 * w.z; acc[7] += s1 * w.w;
        acc[8] += s2 * w.x; acc[9] += s2 * w.y; acc[10] += s2 * w.z; acc[11] += s2 * w.w;
      }
#pragma unroll
      for (int i = 0; i < 12; ++i) red[(kl * 8 + c4) * 12 + i] = acc[i];
      __syncthreads();
      if (tid < 96) {
        int cond = tid >> 5, col = tid & 31;
        int cc4 = col >> 2, e = col & 3;
        float s = 0.f;
        for (int k = 0; k < 64; ++k) s += red[(k * 8 + cc4) * 12 + cond * 4 + e];
        int n = item * 32 + col;
        mod[cond * 6144 + n] = s + p.b_ada[n];
      }
      __syncthreads();
    }
  }
  convT<0>(p.w_in, 1024, 10688, (u16*)(ws + OFF_WIN), smem);
  convT<0>(p.w_m_out, 2048, 1024, (u16*)(ws + OFF_WMOUT), smem);
  convT<0>(p.w_r_out, 1024, 1024, (u16*)(ws + OFF_WROUT), smem);
  convT<0>(p.w_o, 1024, 1024, (u16*)(ws + OFF_WO), smem);
  convT<0>(p.w2, 64, 1024, (u16*)(ws + OFF_W2T), smem);
  convT<0>(p.w2 + 65536, 64, 1024, (u16*)(ws + OFF_W2T) + 65536, smem);
  convT<0>(p.a2, 64, 1024, (u16*)(ws + OFF_A2T), smem);
  convT<0>(p.a2 + 65536, 64, 1024, (u16*)(ws + OFF_A2T) + 65536, smem);
  convT<0>(p.g2, 128, 1024, (u16*)(ws + OFF_G2T), smem);
  {
    u16* w4 = (u16*)(ws + OFF_W4T);
    convT<0>(p.w2, 64, 1024, w4 + (size_t)0 * 1024 * 256 + 0, smem, -1, 0, 256);
    convT<0>(p.w2 + 65536, 64, 1024, w4 + (size_t)1 * 1024 * 256 + 64, smem, -1, 0, 256);
    convT<0>(p.a2, 64, 1024, w4 + (size_t)2 * 1024 * 256 + 128, smem, -1, 0, 256);
    convT<0>(p.a2 + 65536, 64, 1024, w4 + (size_t)3 * 1024 * 256 + 192, smem, -1, 0, 256);
    for (int i = blockIdx.x * NTHR + tid; i < 4096 * 32; i += gridDim.x * NTHR) {
      int row = i >> 5, c = i & 31;
      if ((c >> 3) != (row >> 10)) *(uint4*)(w4 + (size_t)row * 256 + c * 8) = uint4{0, 0, 0, 0};
    }
  }
  {
    uint4* z = (uint4*)(ws + OFF_WIN + (size_t)10688 * 1024 * 2);
    for (int i = blockIdx.x * NTHR + tid; i < 8192; i += gridDim.x * NTHR) z[i] = uint4{0, 0, 0, 0};
  }
}

template <int WHICH>
__device__ __forceinline__ void step_norm(const Params& p, int g) {
  const int tid = get_tid(), lane = tid & 63, wave = tid >> 6;
  const float* mod = (const float*)(p.ws + OFF_MOD);
  const int nrows = WHICH == 0 ? TG : NTOK;
  u16* dst = WHICH == 0 ? (u16*)((char*)p.out + H1_OUT_OFF) : (u16*)(p.ws + OFF_H2);
  const float* nw = WHICH == 0 ? p.norm1_w : p.norm2_w;
  for (int r = blockIdx.x * 8 + wave; r < nrows; r += gridDim.x * 8) {
    int tok = WHICH == 0 ? g * TG + r : r;
    const float* xr;
    if (WHICH == 0) xr = tok < 8192 ? p.x_prompt + (size_t)tok * 1024 : p.x_sample + (size_t)(tok - 8192) * 1024;
    else xr = (const float*)(p.ws + OFF_X1) + (size_t)tok * 1024;
    const float* mr = mod + mrow_of(tok) * 6144 + (WHICH == 0 ? 0 : 3072);
    float4 v[4];
    float ss = 0.f;
#pragma unroll
    for (int i = 0; i < 4; ++i) {
      v[i] = ((const float4*)xr)[i * 64 + lane];
      ss += v[i].x * v[i].x + v[i].y * v[i].y + v[i].z * v[i].z + v[i].w * v[i].w;
    }
    ss = wave_sum(ss);
    float rinv = rsqrtf(ss * (1.f / 1024.f) + 1e-6f);
#pragma unroll
    for (int i = 0; i < 4; ++i) {
      int col = (i * 64 + lane) * 4;
      float4 w4 = *(const float4*)(nw + col);
      float4 sh = *(const float4*)(mr + col);
      float4 sc = *(const float4*)(mr + 1024 + col);
      float h0 = v[i].x * rinv * w4.x * (1.f + sc.x) + sh.x;
      float h1 = v[i].y * rinv * w4.y * (1.f + sc.y) + sh.y;
      float h2 = v[i].z * rinv * w4.z * (1.f + sc.z) + sh.z;
      float h3 = v[i].w * rinv * w4.w * (1.f + sc.w) + sh.w;
      *(uint2*)(dst + (size_t)r * 1024 + col) = uint2{pack2(h0, h1), pack2(h2, h3)};
    }
  }
}

__device__ __forceinline__ void step_gemm1(const Params& p, char* smem, int part) {
  char* ws = p.ws;
  const u16* H1 = (const u16*)((const char*)p.out + H1_OUT_OFF);
  const u16* W = (const u16*)(ws + OFF_WIN);
  if (part == 0) {
    EpiP E{(u16*)(ws + OFF_Z), (u16*)(ws + OFF_XBCRAW), (u16*)(ws + OFF_RW), (u16*)(ws + OFF_GATE), (float*)(ws + OFF_DT), 0};
    run_gemm8(smem, H1, W, TG, NPAD, 1024, E);
  } else if (part == 1) {
    EpiP E{(u16*)(ws + OFF_Z), (u16*)(ws + OFF_XBCRAW), (u16*)(ws + OFF_RW), (u16*)(ws + OFF_GATE), (float*)(ws + OFF_DT), 0};
    run_gemm8(smem, H1, W, TG, 5120, 1024, E, (int)blockIdx.x - 64, (int)gridDim.x - 64);
  } else {
    EpiP E{(u16*)(ws + OFF_Z), (u16*)(ws + OFF_XBCRAW), (u16*)(ws + OFF_RW), (u16*)(ws + OFF_GATE), (float*)(ws + OFF_DT), 5120};
    run_gemm8(smem, H1, W + (size_t)5120 * 1024, TG, NPAD - 5120, 1024, E);
  }
}

__device__ __forceinline__ void step_cr1(const Params& p, int g) {
  char* ws = p.ws;
  const int tid = get_tid(), lane = tid & 63, wave = tid >> 6;
  const int Ls = g < 2 ? 256 : 2048;
  {
    const u16* __restrict__ xr = (const u16*)(ws + OFF_XBCRAW);
    u16* __restrict__ xo = (u16*)(ws + OFF_XBC);
    for (int item = blockIdx.x * NTHR + tid; item < (TG / 8) * 384; item += gridDim.x * NTHR) {
      const int rb = item / 384, cc = item - rb * 384;
      const int r0 = rb * 8, pos0 = r0 & (Ls - 1);
      uint4 rows[12];
#pragma unroll
      for (int i = 0; i < 12; ++i) {
        const int pp = pos0 + i - 2;
        rows[i] = uint4{0, 0, 0, 0};
        if (pp >= 0 && pp < Ls) rows[i] = *(const uint4*)(xr + (size_t)(r0 + i - 2) * 3072 + cc * 8);
      }
      float w[5][8], bias[8];
      {
        float4 b0 = *(const float4*)(p.conv_b + cc * 8), b1 = *(const float4*)(p.conv_b + cc * 8 + 4);
        bias[0] = b0.x; bias[1] = b0.y; bias[2] = b0.z; bias[3] = b0.w; bias[4] = b1.x; bias[5] = b1.y; bias[6] = b1.z; bias[7] = b1.w;
#pragma unroll
        for (int i = 0; i < 5; ++i) {
          float4 w0 = *(const float4*)(p.conv_w + i * 3072 + cc * 8), w1 = *(const float4*)(p.conv_w + i * 3072 + cc * 8 + 4);
          w[i][0] = w0.x; w[i][1] = w0.y; w[i][2] = w0.z; w[i][3] = w0.w; w[i][4] = w1.x; w[i][5] = w1.y; w[i][6] = w1.z; w[i][7] = w1.w;
        }
      }
      float s[8][8];
#pragma unroll
      for (int o = 0; o < 8; ++o)
#pragma unroll
        for (int e = 0; e < 8; ++e) s[o][e] = bias[e];
#pragma unroll
      for (int i = 0; i < 12; ++i) {
        float xv[8];
        unpack8(rows[i], xv);
#pragma unroll
        for (int k = 0; k < 5; ++k) {
          const int o = i - k;
          if (o >= 0 && o < 8) {
#pragma unroll
            for (int e = 0; e < 8; ++e) s[o][e] += xv[e] * w[k][e];
          }
        }
      }
#pragma unroll
      for (int o = 0; o < 8; ++o) {
#pragma unroll
        for (int e = 0; e < 8; ++e) s[o][e] = siluf(s[o][e]);
        *(uint4*)(xo + (size_t)(r0 + o) * 3072 + cc * 8) = uint4{pack2(s[o][0], s[o][1]), pack2(s[o][2], s[o][3]), pack2(s[o][4], s[o][5]), pack2(s[o][6], s[o][7])};
      }
    }
  }
  {
    const u16* __restrict__ rw = (const u16*)(ws + OFF_RW);
    __half* __restrict__ wk = (__half*)(ws + OFF_WK);
    u16* __restrict__ tl = (u16*)(ws + OFF_TL);
    u16* __restrict__ sg = (u16*)(ws + OFF_SG);
    const bool grid = (g == 2);
    for (int r = blockIdx.x * 8 + wave; r < TG; r += gridDim.x * 8) {
      const int pos = r & (Ls - 1);
      uint4 cur[7], shv[7];
#pragma unroll
      for (int it = 0; it < 7; ++it) {
        const int ci = it * 64 + lane;
        cur[it] = uint4{0, 0, 0, 0};
        shv[it] = uint4{0, 0, 0, 0};
        if (ci < 432) {
          const int q = ci / 108;
          int dr;
          bool ok;
          if (!grid) {
            if (q & 1) { dr = 1; ok = pos < Ls - 1; } else { dr = -1; ok = pos > 0; }
          } else {
            if (q == 0) { dr = -1; ok = (pos & 63) != 0; }
            else if (q == 1) { dr = 1; ok = (pos & 63) != 63; }
            else if (q == 2) { dr = -64; ok = pos >= 64; }
            else { dr = 64; ok = pos < Ls - 64; }
          }
          cur[it] = *(const uint4*)(rw + (size_t)r * 3456 + ci * 8);
          if (ok) shv[it] = *(const uint4*)(rw + (size_t)(r + dr) * 3456 + ci * 8);
        }
      }
#pragma unroll
      for (int it = 0; it < 7; ++it) {
        const int ci = it * 64 + lane;
        const bool valid = ci < 432;
        float xx[8];
        {
          float cf[8], sf[8];
          unpack8(cur[it], cf);
          unpack8(shv[it], sf);
          const int cm = valid ? ci * 8 : 0;
          const float4 m0 = *(const float4*)(p.mu_shift + cm), m1 = *(const float4*)(p.mu_shift + cm + 4);
          const float mu[8] = {m0.x, m0.y, m0.z, m0.w, m1.x, m1.y, m1.z, m1.w};
#pragma unroll
          for (int e = 0; e < 8; ++e) xx[e] = cf[e] + mu[e] * (sf[e] - cf[e]);
        }
        const bool isk = valid && ci >= 144 && ci < 272;
        float kk[8];
        float ss = 0.f;
        {
          const int kc = isk ? ci - 144 : 0;
          const float4 k0 = *(const float4*)(p.k_k + kc * 8), k1 = *(const float4*)(p.k_k + kc * 8 + 4);
          const float kkw[8] = {k0.x, k0.y, k0.z, k0.w, k1.x, k1.y, k1.z, k1.w};
#pragma unroll
          for (int e = 0; e < 8; ++e) { kk[e] = xx[e] * kkw[e]; ss += kk[e] * kk[e]; }
        }
        ss += dpp_xor1(ss);
        ss += dpp_xor2(ss);
        ss += dpp_hmirror(ss);
        if (valid) {
          if (ci < 128) {
            __half2 h0 = __floats2half2_rn(xx[0], xx[1]), h1 = __floats2half2_rn(xx[2], xx[3]), h2 = __floats2half2_rn(xx[4], xx[5]), h3 = __floats2half2_rn(xx[6], xx[7]);
            uint4 pk{*reinterpret_cast<unsigned*>(&h0), *reinterpret_cast<unsigned*>(&h1), *reinterpret_cast<unsigned*>(&h2), *reinterpret_cast<unsigned*>(&h3)};
            *(uint4*)(wk + ((size_t)(r * 16 + (ci >> 3)) * 8 + 0) * 64 + (ci & 7) * 8) = pk;
          } else if (ci < 144) {
            float t[8];
#pragma unroll
            for (int e = 0; e < 8; ++e) t[e] = tanhf(xx[e]);
            *(uint4*)(tl + (size_t)r * 256 + (ci - 128) * 8) = uint4{pack2(t[0], t[1]), pack2(t[2], t[3]), pack2(t[4], t[5]), pack2(t[6], t[7])};
          } else if (ci < 272) {
            const int kc = ci - 144;
            const float rn = -rsqrtf(ss + 1e-12f);
            __half2 h0 = __floats2half2_rn(xx[0], xx[1]), h1 = __floats2half2_rn(xx[2], xx[3]), h2 = __floats2half2_rn(xx[4], xx[5]), h3 = __floats2half2_rn(xx[6], xx[7]);
            uint4 pk{*reinterpret_cast<unsigned*>(&h0), *reinterpret_cast<unsigned*>(&h1), *reinterpret_cast<unsigned*>(&h2), *reinterpret_cast<unsigned*>(&h3)};
            *(uint4*)(wk + ((size_t)(r * 16 + (kc >> 3)) * 8 + 2) * 64 + (kc & 7) * 8) = pk;
            __half2 n0 = __floats2half2_rn(kk[0] * rn, kk[1] * rn), n1 = __floats2half2_rn(kk[2] * rn, kk[3] * rn), n2 = __floats2half2_rn(kk[4] * rn, kk[5] * rn), n3 = __floats2half2_rn(kk[6] * rn, kk[7] * rn);
            uint4 pn{*reinterpret_cast<unsigned*>(&n0), *reinterpret_cast<unsigned*>(&n1), *reinterpret_cast<unsigned*>(&n2), *reinterpret_cast<unsigned*>(&n3)};
            *(uint4*)(wk + ((size_t)(r * 16 + (kc >> 3)) * 8 + 3) * 64 + (kc & 7) * 8) = pn;
          } else if (ci < 400) {
            const int vc = ci - 272;
            __half2 h0 = __floats2half2_rn(xx[0], xx[1]), h1 = __floats2half2_rn(xx[2], xx[3]), h2 = __floats2half2_rn(xx[4], xx[5]), h3 = __floats2half2_rn(xx[6], xx[7]);
            uint4 pk{*reinterpret_cast<unsigned*>(&h0), *reinterpret_cast<unsigned*>(&h1), *reinterpret_cast<unsigned*>(&h2), *reinterpret_cast<unsigned*>(&h3)};
            *(uint4*)(wk + ((size_t)(r * 16 + (vc >> 3)) * 8 + 1) * 64 + (vc & 7) * 8) = pk;
          } else if (ci < 416) {
            *(uint4*)(tl + (size_t)r * 256 + 128 + (ci - 400) * 8) = uint4{pack2(xx[0], xx[1]), pack2(xx[2], xx[3]), pack2(xx[4], xx[5]), pack2(xx[6], xx[7])};
          } else {
            float t[8];
#pragma unroll
            for (int e = 0; e < 8; ++e) t[e] = sigm(xx[e]);
            *(uint4*)(sg + (size_t)r * 128 + (ci - 416) * 8) = uint4{pack2(t[0], t[1]), pack2(t[2], t[3]), pack2(t[4], t[5]), pack2(t[6], t[7])};
          }
        }
      }
    }
  }
}

__device__ __forceinline__ void step_r2(const Params& p, char* smem) {
  char* ws = p.ws;
  const int tid = get_tid(), lane = tid & 63, wave = tid >> 6;
  const int wm = wave >> 1, wn = wave & 1;
  const u16* tl = (const u16*)(ws + OFF_TL);
  const u16* sg = (const u16*)(ws + OFF_SG);
  __half* wk = (__half*)(ws + OFF_WK);
  u16* gr = (u16*)(ws + OFF_GR);
  {
    EpiR2 E{wk, p.w0, p.a0};
    run_gemm8(smem, tl, (const u16*)(ws + OFF_W4T), TG, 4096, 256, E);
  }
  for (int t = (gridDim.x - 1 - blockIdx.x) + 4 * 128; t < 5 * 128; t += gridDim.x) {
    int sub = t >> 7, rem = t & 127;
    int mt = rem & 15, nt = rem >> 4;
    f32x4 acc[4][4];
    zero_acc(acc);
    if (sub < 2) {
      gemm_acc(tl + (size_t)mt * 256 * 256 + sub * 64, 256, (const u16*)(ws + OFF_W2T) + sub * 65536 + (size_t)nt * 128 * 64, 64, 64, acc, smem);
    } else if (sub < 4) {
      gemm_acc(tl + (size_t)mt * 256 * 256 + 128 + (sub - 2) * 64, 256, (const u16*)(ws + OFF_A2T) + (sub - 2) * 65536 + (size_t)nt * 128 * 64, 64, 64, acc, smem);
    } else {
      gemm_acc(sg + (size_t)mt * 256 * 128, 128, (const u16*)(ws + OFF_G2T) + (size_t)nt * 128 * 128, 128, 128, acc, smem);
    }
#pragma unroll
    for (int mf = 0; mf < 4; ++mf)
#pragma unroll
      for (int nf = 0; nf < 4; ++nf)
#pragma unroll
        for (int j = 0; j < 4; ++j) {
          if (nf == 0 && j == 0) asm volatile("" ::: "memory");
          int m = mt * 256 + wm * 64 + mf * 16 + (lane >> 4) * 4 + j;
          int n = nt * 128 + wn * 64 + nf * 16 + (lane & 15);
          float v = acc[mf][nf][j];
          if (sub < 2) {
            float wl = v + p.w0[sub * 1024 + n];
            float dec = __expf(-0.6065306597f * sigm(wl));
            wk[((size_t)(m * 16 + (n >> 6)) * 8 + 4 + 2 * sub) * 64 + (n & 63)] = __float2half(dec);
          } else if (sub < 4) {
            int d = sub - 2;
            float a = sigm(v + p.a0[d * 1024 + n]);
            wk[((size_t)(m * 16 + (n >> 6)) * 8 + 5 + 2 * d) * 64 + (n & 63)] = __float2half(a);
          } else {
            gr[(size_t)m * 1024 + n] = f2bf(v);
          }
        }
  }
}

DI int swz16(int row) { return (row ^ (row >> 3)) & 15; }
DI int sw256(int row, int e) { return row * 256 + ((((e >> 3) ^ swz16(row))) << 4) + (e & 7) * 2; }
DI const bf16x8 ldfrag256(const char* base, int row, int ch) {
  return *(const bf16x8*)(base + row * 256 + ((ch ^ swz16(row)) << 4));
}

typedef unsigned v4u __attribute__((ext_vector_type(4)));
struct SsdPre { v4u c0, c1, c2, c3, b0, b1, b2, b3, x0, x1; float d0, d1; };
DI void ssd_issue(const Params& p, int g, int chain, int ci, int tid, SsdPre& R) {
  const int Ls = g < 2 ? 256 : 2048;
  const int nch = Ls >> 7;
  const int d = chain & 1, h = (chain >> 1) & 31, b = chain >> 6;
  const int grp = h >> 3;
  const int c = d ? nch - 1 - ci : ci;
  const int tok0 = b * Ls + c * 128;
  const u16* xbc = (const u16*)(p.ws + OFF_XBC);
  const float* dtb = (const float*)(p.ws + OFF_DT);
  const int lane = tid & 63, wave = tid >> 6;
#define SSD_LDCB(i, CF, BF) { int idx = tid + i * 512; int row = idx >> 4, ch = idx & 15; \
    const u16* src = xbc + (size_t)(tok0 + row) * 3072 + grp * 128 + ch * 8; R.CF = *(const v4u*)(src + 2560); R.BF = *(const v4u*)(src + 2048); }
  SSD_LDCB(0, c0, b0) SSD_LDCB(1, c1, b1) SSD_LDCB(2, c2, b2) SSD_LDCB(3, c3, b3)
#undef SSD_LDCB
#define SSD_LDX(i, XF) { int idx = tid + i * 512; int l = idx >> 3, ch = idx & 7; R.XF = *(const v4u*)(xbc + (size_t)(tok0 + l) * 3072 + h * 64 + ch * 8); }
  SSD_LDX(0, x0) SSD_LDX(1, x1)
#undef SSD_LDX
  if (wave == 0) {
    int e0 = 2 * lane, e1 = 2 * lane + 1;
    int l0 = d ? 127 - e0 : e0, l1 = d ? 127 - e1 : e1;
    R.d0 = dtb[(size_t)(tok0 + l0) * 64 + d * 32 + h];
    R.d1 = dtb[(size_t)(tok0 + l1) * 64 + d * 32 + h];
  }
}

__device__ __forceinline__ void ssd_chain(const Params& p, char* smem, int g, int chain, int next_chain, SsdPre& R) {
  char* ws = p.ws;
  const int tid = get_tid(), lane = tid & 63, wave = tid >> 6;
  const int Ls = g < 2 ? 256 : 2048;
  const int nch = Ls >> 7;
  const int d = chain & 1, h = (chain >> 1) & 31, b = chain >> 6;
  const int grp = h >> 3;
  const u16* xbc = (const u16*)(ws + OFF_XBC);
  const float* dtb = (const float*)(ws + OFF_DT);
  u16* yout = (u16*)(ws + (d ? OFF_SYB : OFF_SYF));
  char* Cs = smem;
  char* Bs = smem + 32768;
  char* BdT = smem + 65536;
  char* XT = smem + 98304;
  char* Ss = smem + 114688;
  float* csum = (float*)(smem + 131072);
  float* dts = (float*)(smem + 131584);
  const float a_h = -__expf(p.a_log[d * 32 + h]);
  const float dtbias = p.dt_bias[d * 32 + h];
  f32x4 sacc[2][2];
  {
    const int wn4 = wave >> 1, wp2 = wave & 1;
#pragma unroll
    for (int nf = 0; nf < 2; ++nf)
#pragma unroll
      for (int pf = 0; pf < 2; ++pf) {
        if (g == 2) {
          const float* h0 = (d ? p.ssm_b : p.ssm_f) + (size_t)(b * 32 + h) * 8192;
          const int n0 = wn4 * 32 + nf * 16 + (lane >> 4) * 4, pp = wp2 * 32 + pf * 16 + (lane & 15);
          const float4 t = *(const float4*)(h0 + pp * 128 + n0);
          sacc[nf][pf] = f32x4{t.x, t.y, t.z, t.w};
        } else {
          sacc[nf][pf] = f32x4{0.f, 0.f, 0.f, 0.f};
        }
      }
  }
  const int tid_outer = tid;
  for (int ci = 0; ci < nch; ++ci) {
    int tidv = tid_outer;
    asm volatile("" : "+v"(tidv));
    const int tid = tidv, lane = tidv & 63, wave = tidv >> 6;
    const int wq4 = wave >> 1, wq2 = wave & 1;
    const int c = d ? nch - 1 - ci : ci;
    const int tok0 = b * Ls + c * 128;
#define SSD_STCB(i, CF, BF) { int idx = tid + i * 512; int row = idx >> 4, ch = idx & 15; \
      *(v4u*)(Cs + row * 256 + ((ch ^ swz16(row)) << 4)) = R.CF; *(v4u*)(Bs + row * 256 + ((ch ^ swz16(row)) << 4)) = R.BF; }
    SSD_STCB(0, c0, b0) SSD_STCB(1, c1, b1) SSD_STCB(2, c2, b2) SSD_STCB(3, c3, b3)
#undef SSD_STCB
#define SSD_STX(i, XF) { int idx = tid + i * 512; int l = idx >> 3, ch = idx & 7; \
      const unsigned w0 = R.XF[0], w1 = R.XF[1], w2 = R.XF[2], w3 = R.XF[3]; \
      *(u16*)(XT + sw256(ch * 8 + 0, l)) = (u16)(w0 & 0xffff); *(u16*)(XT + sw256(ch * 8 + 1, l)) = (u16)(w0 >> 16); \
      *(u16*)(XT + sw256(ch * 8 + 2, l)) = (u16)(w1 & 0xffff); *(u16*)(XT + sw256(ch * 8 + 3, l)) = (u16)(w1 >> 16); \
      *(u16*)(XT + sw256(ch * 8 + 4, l)) = (u16)(w2 & 0xffff); *(u16*)(XT + sw256(ch * 8 + 5, l)) = (u16)(w2 >> 16); \
      *(u16*)(XT + sw256(ch * 8 + 6, l)) = (u16)(w3 & 0xffff); *(u16*)(XT + sw256(ch * 8 + 7, l)) = (u16)(w3 >> 16); }
    SSD_STX(0, x0) SSD_STX(1, x1)
#undef SSD_STX
    if (wave == 0) {
      int e0 = 2 * lane, e1 = 2 * lane + 1;
      int l0 = d ? 127 - e0 : e0, l1 = d ? 127 - e1 : e1;
      float x0 = R.d0 + dtbias;
      float x1 = R.d1 + dtbias;
      float dt0 = x0 > 20.f ? x0 : log1pf(__expf(x0));
      float dt1 = x1 > 20.f ? x1 : log1pf(__expf(x1));
      float a0 = dt0 * a_h, a1 = dt1 * a_h;
      float s = a0 + a1;
#pragma unroll
      for (int o = 1; o < 64; o <<= 1) {
        float t = __shfl_up(s, o);
        if (lane >= o) s += t;
      }
      csum[l1] = s;
      csum[l0] = s - a1;
      dts[l0] = dt0;
      dts[l1] = dt1;
    }
    if (ci + 1 < nch) ssd_issue(p, g, chain, ci + 1, tid, R);
    else if (next_chain >= 0) ssd_issue(p, g, next_chain, 0, tid, R);
#pragma unroll
    for (int nf = 0; nf < 2; ++nf)
#pragma unroll
      for (int pf = 0; pf < 2; ++pf) {
        const int n0 = wq4 * 32 + nf * 16 + (lane >> 4) * 4, pp = wq2 * 32 + pf * 16 + (lane & 15);
        *(uint2*)(Ss + sw256(pp, n0)) = uint2{pack2(sacc[nf][pf][0], sacc[nf][pf][1]), pack2(sacc[nf][pf][2], sacc[nf][pf][3])};
      }
    __syncthreads();
    const float cstot = csum[d ? 0 : 127];
#pragma unroll
    for (int i = 0; i < 4; ++i) {
      int idx = tid + i * 512;
      int l = idx >> 4, ch = idx & 15;
      uint4 bv = *(const uint4*)(Bs + l * 256 + ((ch ^ swz16(l)) << 4));
      float f = dts[l] * __expf(cstot - csum[l]);
      unsigned w[4] = {bv.x, bv.y, bv.z, bv.w};
#pragma unroll
      for (int e = 0; e < 8; ++e) {
        int n = ch * 8 + e;
        float val = bf2f((u16)((w[e >> 1] >> ((e & 1) * 16)) & 0xffff)) * f;
        *(u16*)(BdT + sw256(n, l)) = f2bf(val);
      }
    }
    f32x4 gacc[2][4];
#pragma unroll
    for (int i = 0; i < 2; ++i)
#pragma unroll
      for (int j = 0; j < 4; ++j) gacc[i][j] = f32x4{0.f, 0.f, 0.f, 0.f};
#pragma unroll
    for (int ks = 0; ks < 4; ++ks) {
      int ch = ks * 4 + (lane >> 4);
      bf16x8 a[2], bb[4];
#pragma unroll
      for (int sf = 0; sf < 2; ++sf) a[sf] = ldfrag256(Bs, wq4 * 32 + sf * 16 + (lane & 15), ch);
#pragma unroll
      for (int lf = 0; lf < 4; ++lf) bb[lf] = ldfrag256(Cs, wq2 * 64 + lf * 16 + (lane & 15), ch);
#pragma unroll
      for (int sf = 0; sf < 2; ++sf)
#pragma unroll
        for (int lf = 0; lf < 4; ++lf)
          gacc[sf][lf] = __builtin_amdgcn_mfma_f32_16x16x32_bf16(a[sf], bb[lf], gacc[sf][lf], 0, 0, 0);
    }
    {
      float css[2][4], dss[2][4];
#pragma unroll
      for (int sf = 0; sf < 2; ++sf)
#pragma unroll
        for (int j = 0; j < 4; ++j) {
          const int sI = wq4 * 32 + sf * 16 + (lane >> 4) * 4 + j;
          css[sf][j] = csum[sI];
          dss[sf][j] = dts[sI];
        }
#pragma unroll
      for (int lf = 0; lf < 4; ++lf) {
        const int l = wq2 * 64 + lf * 16 + (lane & 15);
        const float csl = csum[l];
#pragma unroll
        for (int sf = 0; sf < 2; ++sf)
#pragma unroll
          for (int j = 0; j < 4; ++j) {
            const int sI = wq4 * 32 + sf * 16 + (lane >> 4) * 4 + j;
            const bool valid = d ? (sI >= l) : (sI <= l);
            const float e = valid ? __expf(csl - css[sf][j]) * dss[sf][j] : 0.f;
            gacc[sf][lf][j] *= e;
          }
      }
    }
    __syncthreads();
#pragma unroll
    for (int sf = 0; sf < 2; ++sf)
#pragma unroll
      for (int lf = 0; lf < 4; ++lf) {
        const int s0 = wq4 * 32 + sf * 16 + (lane >> 4) * 4, l = wq2 * 64 + lf * 16 + (lane & 15);
        *(uint2*)(Bs + sw256(l, s0)) = uint2{pack2(gacc[sf][lf][0], gacc[sf][lf][1]), pack2(gacc[sf][lf][2], gacc[sf][lf][3])};
      }
    __syncthreads();
    {
      f32x4 yacc[2][2];
#pragma unroll
      for (int i = 0; i < 2; ++i)
#pragma unroll
        for (int j = 0; j < 2; ++j) yacc[i][j] = f32x4{0.f, 0.f, 0.f, 0.f};
#pragma unroll
      for (int ks = 0; ks < 4; ++ks) {
        int ch = ks * 4 + (lane >> 4);
        bf16x8 a[2], bb[2];
#pragma unroll
        for (int pf = 0; pf < 2; ++pf) a[pf] = ldfrag256(Ss, wq2 * 32 + pf * 16 + (lane & 15), ch);
#pragma unroll
        for (int lf = 0; lf < 2; ++lf) bb[lf] = ldfrag256(Cs, wq4 * 32 + lf * 16 + (lane & 15), ch);
#pragma unroll
        for (int pf = 0; pf < 2; ++pf)
#pragma unroll
          for (int lf = 0; lf < 2; ++lf)
            yacc[pf][lf] = __builtin_amdgcn_mfma_f32_16x16x32_bf16(a[pf], bb[lf], yacc[pf][lf], 0, 0, 0);
      }
#pragma unroll
      for (int lf = 0; lf < 2; ++lf) {
        const float e = __expf(csum[wq4 * 32 + lf * 16 + (lane & 15)]);
#pragma unroll
        for (int pf = 0; pf < 2; ++pf) yacc[pf][lf] *= e;
      }
#pragma unroll
      for (int ks = 0; ks < 4; ++ks) {
        int ch = ks * 4 + (lane >> 4);
        bf16x8 a[2], bb[2];
#pragma unroll
        for (int pf = 0; pf < 2; ++pf) a[pf] = ldfrag256(XT, wq2 * 32 + pf * 16 + (lane & 15), ch);
#pragma unroll
        for (int lf = 0; lf < 2; ++lf) bb[lf] = ldfrag256(Bs, wq4 * 32 + lf * 16 + (lane & 15), ch);
#pragma unroll
        for (int pf = 0; pf < 2; ++pf)
#pragma unroll
          for (int lf = 0; lf < 2; ++lf)
            yacc[pf][lf] = __builtin_amdgcn_mfma_f32_16x16x32_bf16(a[pf], bb[lf], yacc[pf][lf], 0, 0, 0);
      }
#pragma unroll
      for (int pf = 0; pf < 2; ++pf)
#pragma unroll
        for (int lf = 0; lf < 2; ++lf) {
          const int p0 = wq2 * 32 + pf * 16 + (lane >> 4) * 4, l = wq4 * 32 + lf * 16 + (lane & 15);
          *(uint2*)(yout + (size_t)(tok0 + l) * 2048 + h * 64 + p0) = uint2{pack2(yacc[pf][lf][0], yacc[pf][lf][1]), pack2(yacc[pf][lf][2], yacc[pf][lf][3])};
        }
    }
    {
      float e = __expf(cstot);
#pragma unroll
      for (int nf = 0; nf < 2; ++nf)
#pragma unroll
        for (int pf = 0; pf < 2; ++pf) sacc[nf][pf] *= e;
#pragma unroll
      for (int ks = 0; ks < 4; ++ks) {
        int ch = ks * 4 + (lane >> 4);
        bf16x8 a[2], bb[2];
#pragma unroll
        for (int nf = 0; nf < 2; ++nf) a[nf] = ldfrag256(BdT, wq4 * 32 + nf * 16 + (lane & 15), ch);
#pragma unroll
        for (int pf = 0; pf < 2; ++pf) bb[pf] = ldfrag256(XT, wq2 * 32 + pf * 16 + (lane & 15), ch);
#pragma unroll
        for (int nf = 0; nf < 2; ++nf)
#pragma unroll
          for (int pf = 0; pf < 2; ++pf)
            sacc[nf][pf] = __builtin_amdgcn_mfma_f32_16x16x32_bf16(a[nf], bb[pf], sacc[nf][pf], 0, 0, 0);
      }
    }
    __syncthreads();
  }
  if (g < 2) {
    float* so = p.out + (d ? OUT_SSMB : OUT_SSMF) + (size_t)((g * 16 + b) * 32 + h) * 8192;
    const int wn4 = wave >> 1, wp2 = wave & 1;
#pragma unroll
    for (int nf = 0; nf < 2; ++nf)
#pragma unroll
      for (int pf = 0; pf < 2; ++pf) {
        const int n0 = wn4 * 32 + nf * 16 + (lane >> 4) * 4, pp = wp2 * 32 + pf * 16 + (lane & 15);
        *(float4*)(so + pp * 128 + n0) = float4{sacc[nf][pf][0], sacc[nf][pf][1], sacc[nf][pf][2], sacc[nf][pf][3]};
      }
  }
}


template <bool SEG>
__device__ __forceinline__ void wkv_pair(const Params& p, char* smem, int g, int item) {
  char* ws = p.ws;
  const int tid = get_tid(), lane = tid & 63, wave = tid >> 6;
  const int Ls = SEG ? 2048 : 256;
  const __half* wk = (const __half*)(ws + OFF_WK);
  float* stage = (float*)smem;
  float* ylds = (float*)(smem + 98304);
  const bool cw = true;
  const int slot = wave >> 2, wq = wave & 3;
  const int ig = lane >> 3, jg = lane & 7;
  const int row0 = wq * 16 + ig * 2;
  const int chain = SEG ? (item >> 3) : item * 2 + slot;
  const int seg = SEG ? (item & 7) : 0;
  const bool act = cw && (SEG ? !(slot == 1 && seg == 0) : true);
  const int d = chain & 1, h = (chain >> 1) & 15, b = chain >> 5;
  typedef float f2 __attribute__((ext_vector_type(2)));
  f2 S[2][4];
#pragma unroll
  for (int rr = 0; rr < 2; ++rr) {
    if (SEG) {
      if (slot == 0) {
        if (seg == 0) {
          const float* s0 = (d ? p.wkv_b : p.wkv_f) + ((size_t)(b * 16 + h) * 64 + row0 + rr) * 64 + jg * 8;
#pragma unroll
          for (int c = 0; c < 4; ++c) S[rr][c] = f2{s0[2 * c], s0[2 * c + 1]};
        } else {
#pragma unroll
          for (int c = 0; c < 4; ++c) S[rr][c] = f2{0.f, 0.f};
        }
      } else {
#pragma unroll
        for (int c = 0; c < 4; ++c) S[rr][c] = f2{(row0 + rr == jg * 8 + 2 * c) ? 1.f : 0.f, (row0 + rr == jg * 8 + 2 * c + 1) ? 1.f : 0.f};
      }
    } else {
#pragma unroll
      for (int c = 0; c < 4; ++c) S[rr][c] = f2{0.f, 0.f};
    }
  }
  const int pair = tid >> 4, lslot = pair >> 4, lstep = pair & 15, sub = tid & 15;
  const int lch = SEG ? (item >> 3) : item * 2 + lslot;
  const int ld = lch & 1, lh = (lch >> 1) & 15, lb = lch >> 5;
  const bool ldo = SEG ? (lslot == 0) : true;
  const int sbase = seg * 256;
  const int cslot = SEG ? 0 : slot;
  float ka[4];
#pragma unroll
  for (int e = 0; e < 4; ++e) ka[e] = p.k_a[lh * 64 + sub * 4 + e];
  u16* yout;
  if (SEG) yout = lslot == 0 ? (u16*)(ws + (ld ? OFF_WYB : OFF_WYF)) : (u16*)(ws + OFF_YM) + (ld ? (size_t)TG * 1024 : 0);
  else yout = (u16*)(ws + (ld ? OFF_WYB : OFF_WYF));
  const bool ywr = SEG ? (lslot == 0 || seg > 0) : true;
  uint2 rg[6];
  auto prefetch = [&](int tb) {
    int s = sbase + tb * 16 + lstep;
    int pos = ld ? Ls - 1 - s : s;
    int r = lb * Ls + pos;
    const __half* rec = wk + ((size_t)(r * 16 + lh) * 8) * 64 + sub * 4;
    rg[0] = *(const uint2*)(rec + 0 * 64);
    rg[1] = *(const uint2*)(rec + 1 * 64);
    rg[2] = *(const uint2*)(rec + 2 * 64);
    rg[3] = *(const uint2*)(rec + 3 * 64);
    rg[4] = *(const uint2*)(rec + (4 + 2 * ld) * 64);
    rg[5] = *(const uint2*)(rec + (5 + 2 * ld) * 64);
  };
  auto unpack4 = [&](uint2 u, float (&o)[4]) {
    __half2 h0 = *reinterpret_cast<__half2*>(&u.x);
    __half2 h1 = *reinterpret_cast<__half2*>(&u.y);
    float2 f0 = __half22float2(h0), f1 = __half22float2(h1);
    o[0] = f0.x; o[1] = f0.y; o[2] = f1.x; o[3] = f1.y;
  };
  auto stage_store = [&](int buf) {
    float r_[4], v_[4], k_[4], nkk_[4], w_[4], a_[4];
    unpack4(rg[0], r_); unpack4(rg[1], v_); unpack4(rg[2], k_); unpack4(rg[3], nkk_); unpack4(rg[4], w_); unpack4(rg[5], a_);
    float b_[4], kd_[4];
#pragma unroll
    for (int e = 0; e < 4; ++e) {
      b_[e] = -nkk_[e] * a_[e];
      kd_[e] = k_[e] * (1.f + (a_[e] - 1.f) * ka[e]);
    }
    float* dst = stage + ((size_t)((buf * 2 + lslot) * 16 + lstep) * 6) * 64 + sub * 4;
    *(float4*)(dst + 0 * 64) = float4{nkk_[0], nkk_[1], nkk_[2], nkk_[3]};
    *(float4*)(dst + 1 * 64) = float4{w_[0], w_[1], w_[2], w_[3]};
    *(float4*)(dst + 2 * 64) = float4{b_[0], b_[1], b_[2], b_[3]};
    *(float4*)(dst + 3 * 64) = float4{kd_[0], kd_[1], kd_[2], kd_[3]};
    *(float4*)(dst + 4 * 64) = float4{r_[0], r_[1], r_[2], r_[3]};
    *(float4*)(dst + 5 * 64) = float4{v_[0], v_[1], v_[2], v_[3]};
  };
  if (ldo) { prefetch(0); stage_store(0); }
  __syncthreads();
  for (int tb = 0; tb < 16; ++tb) {
    const bool more = tb + 1 < 16;
    if (more && ldo) prefetch(tb + 1);
    if (act) {
      const float* sb = stage + ((size_t)(((tb & 1) * 2 + cslot) * 16) * 6) * 64;
      for (int sg = 0; sg < 8; ++sg) {
        float ysv[2][2];
#pragma unroll
        for (int s4 = 0; s4 < 2; ++s4) {
          const int st = sg * 2 + s4;
          const float* v6 = sb + st * 384 + jg * 8;
          f2 nkk[4], w[4], bb[4], kd[4], rr[4];
#pragma unroll
          for (int q = 0; q < 2; ++q) {
            float4 t0 = *(const float4*)(v6 + 0 * 64 + q * 4);
            nkk[q * 2] = f2{t0.x, t0.y}; nkk[q * 2 + 1] = f2{t0.z, t0.w};
            float4 t1 = *(const float4*)(v6 + 1 * 64 + q * 4);
            w[q * 2] = f2{t1.x, t1.y}; w[q * 2 + 1] = f2{t1.z, t1.w};
            float4 t2 = *(const float4*)(v6 + 2 * 64 + q * 4);
            bb[q * 2] = f2{t2.x, t2.y}; bb[q * 2 + 1] = f2{t2.z, t2.w};
            float4 t3 = *(const float4*)(v6 + 3 * 64 + q * 4);
            kd[q * 2] = f2{t3.x, t3.y}; kd[q * 2 + 1] = f2{t3.z, t3.w};
            float4 t4 = *(const float4*)(v6 + 4 * 64 + q * 4);
            rr[q * 2] = f2{t4.x, t4.y}; rr[q * 2 + 1] = f2{t4.z, t4.w};
          }
          float2 vv2 = *(const float2*)(sb + st * 384 + 5 * 64 + row0);
          float vi[2] = {vv2.x, vv2.y};
          if (SEG && slot == 1) { vi[0] = 0.f; vi[1] = 0.f; }
#pragma unroll
          for (int r2 = 0; r2 < 2; ++r2) {
            f2 sa2a = S[r2][0] * nkk[0], sa2b = S[r2][1] * nkk[1];
            sa2a += S[r2][2] * nkk[2]; sa2b += S[r2][3] * nkk[3];
            f2 sat = sa2a + sa2b;
            float sa = sat.x + sat.y;
            sa += dpp_xor1(sa);
            sa += dpp_xor2(sa);
            sa += dpp_hmirror(sa);
            f2 y2a, y2b;
            {
              f2 t0 = S[r2][0] * w[0] + vi[r2] * kd[0]; S[r2][0] = t0 + sa * bb[0]; y2a = S[r2][0] * rr[0];
              f2 t1 = S[r2][1] * w[1] + vi[r2] * kd[1]; S[r2][1] = t1 + sa * bb[1]; y2b = S[r2][1] * rr[1];
              f2 t2 = S[r2][2] * w[2] + vi[r2] * kd[2]; S[r2][2] = t2 + sa * bb[2]; y2a += S[r2][2] * rr[2];
              f2 t3 = S[r2][3] * w[3] + vi[r2] * kd[3]; S[r2][3] = t3 + sa * bb[3]; y2b += S[r2][3] * rr[3];
            }
            f2 yt = y2a + y2b;
            float y = yt.x + yt.y;
            y += dpp_xor1(y);
            y += dpp_xor2(y);
            y += dpp_hmirror(y);
            ysv[s4][r2] = y;
          }
        }
        if (jg == 0) {
#pragma unroll
          for (int s4 = 0; s4 < 2; ++s4)
            *(float2*)(ylds + (slot * 16 + sg * 2 + s4) * 64 + row0) = float2{ysv[s4][0], ysv[s4][1]};
        }
      }
    }
    __syncthreads();
    if (more && ldo) stage_store((tb + 1) & 1);
    if (ywr) {
      int s = sbase + tb * 16 + lstep;
      int pos = ld ? Ls - 1 - s : s;
      int r = lb * Ls + pos;
      float4 yv = *(const float4*)(ylds + (lslot * 16 + lstep) * 64 + sub * 4);
      *(uint2*)(yout + (size_t)r * 1024 + lh * 64 + sub * 4) = uint2{pack2(yv.x, yv.y), pack2(yv.z, yv.w)};
    }
    __syncthreads();
  }
  if (act) {
#pragma unroll
    for (int r2 = 0; r2 < 2; ++r2) {
      float* so;
      if (SEG) so = p.out + 8388608 + ((size_t)((chain * 8 + seg) * 2 + slot)) * 4096 + (row0 + r2) * 64 + jg * 8;
      else so = p.out + (d ? OUT_WKVB : OUT_WKVF) + ((size_t)((g * 16 + b) * 16 + h) * 64 + row0 + r2) * 64 + jg * 8;
#pragma unroll
      for (int c = 0; c < 4; ++c) { so[2 * c] = S[r2][c].x; so[2 * c + 1] = S[r2][c].y; }
    }
  }
}

__device__ __forceinline__ void wkv_fix(const Params& p, char* smem, int chain) {
  char* ws = p.ws;
  const int tid = get_tid(), lane = tid & 63, wave = tid >> 6;
  const int d = chain & 1, h = (chain >> 1) & 15, b = chain >> 5;
  const float* SE = p.out + 8388608;
  u16* yout = (u16*)(ws + (d ? OFF_WYB : OFF_WYF));
  const u16* Q = (const u16*)(ws + OFF_YM) + (d ? (size_t)TG * 1024 : 0);
  float* Pl = (float*)smem;
  float* Sl = (float*)(smem + 16384);
  u16* Ql = (u16*)(smem + 36864);
  const int i = lane;
  float S0[64];
  {
    const float* src = SE + ((size_t)(chain * 8) * 2) * 4096 + i * 64;
#pragma unroll
    for (int j = 0; j < 16; ++j) {
      float4 t = *(const float4*)(src + j * 4);
      S0[j * 4] = t.x; S0[j * 4 + 1] = t.y; S0[j * 4 + 2] = t.z; S0[j * 4 + 3] = t.w;
    }
  }
  for (int k = 1; k < 8; ++k) {
#pragma unroll
    for (int e = 0; e < 4; ++e) {
      int idx = tid + e * 512;
      int tt = idx >> 3, ch = idx & 7;
      int s = k * 256 + tt;
      int pos = d ? 2047 - s : s;
      int r = b * 2048 + pos;
      *(uint4*)(Ql + tt * 64 + ch * 8) = *(const uint4*)(Q + (size_t)r * 1024 + h * 64 + ch * 8);
    }
    if (k < 7) {
      const float* src = SE + ((size_t)((chain * 8 + k) * 2 + 1)) * 4096;
#pragma unroll
      for (int e = 0; e < 2; ++e) ((float4*)Pl)[tid + e * 512] = ((const float4*)src)[tid + e * 512];
    }
    __syncthreads();
    for (int n = 0; n < 32; ++n) {
      int tt = wave + n * 8;
      float a0 = 0.f, a1 = 0.f;
#pragma unroll
      for (int jc = 0; jc < 8; ++jc) {
        float q[8];
        unpack8(*(const uint4*)(Ql + tt * 64 + jc * 8), q);
#pragma unroll
        for (int e = 0; e < 8; e += 2) { a0 += S0[jc * 8 + e] * q[e]; a1 += S0[jc * 8 + e + 1] * q[e + 1]; }
      }
      int s = k * 256 + tt;
      int pos = d ? 2047 - s : s;
      size_t off = (size_t)(b * 2048 + pos) * 1024 + h * 64 + i;
      yout[off] = f2bf(bf2f(yout[off]) + (a0 + a1));
    }
    if (k < 7) {
      float nv[8];
      const float* sl = SE + ((size_t)((chain * 8 + k) * 2)) * 4096 + i * 64 + wave * 8;
      {
        float4 t0 = *(const float4*)sl, t1 = *(const float4*)(sl + 4);
        nv[0] = t0.x; nv[1] = t0.y; nv[2] = t0.z; nv[3] = t0.w; nv[4] = t1.x; nv[5] = t1.y; nv[6] = t1.z; nv[7] = t1.w;
      }
#pragma unroll
      for (int m = 0; m < 64; ++m) {
        float4 p0 = *(const float4*)(Pl + m * 64 + wave * 8), p1 = *(const float4*)(Pl + m * 64 + wave * 8 + 4);
        nv[0] += S0[m] * p0.x; nv[1] += S0[m] * p0.y; nv[2] += S0[m] * p0.z; nv[3] += S0[m] * p0.w;
        nv[4] += S0[m] * p1.x; nv[5] += S0[m] * p1.y; nv[6] += S0[m] * p1.z; nv[7] += S0[m] * p1.w;
      }
      *(float4*)(Sl + i * 68 + wave * 8) = float4{nv[0], nv[1], nv[2], nv[3]};
      *(float4*)(Sl + i * 68 + wave * 8 + 4) = float4{nv[4], nv[5], nv[6], nv[7]};
      __syncthreads();
#pragma unroll
      for (int j = 0; j < 16; ++j) {
        float4 t = *(const float4*)(Sl + i * 68 + j * 4);
        S0[j * 4] = t.x; S0[j * 4 + 1] = t.y; S0[j * 4 + 2] = t.z; S0[j * 4 + 3] = t.w;
      }
    }
    __syncthreads();
  }
}

__device__ __forceinline__ void step_scan(const Params& p, char* smem, int g) {
  const int G = gridDim.x;
  const int r1 = (RM & (1 << 20)) ? 2 : 1, r2 = (RM & (1 << 21)) ? 2 : 1;
  if (g < 2) {
    for (int rr = 0; rr < r1; ++rr) {
      SsdPre R;
      if ((int)blockIdx.x < 1024) ssd_issue(p, g, blockIdx.x, 0, get_tid(), R);
      for (int ch = blockIdx.x; ch < 1024; ch += G) ssd_chain(p, smem, g, ch, ch + G < 1024 ? ch + G : -1, R);
    }
    for (int rr = 0; rr < r2; ++rr) for (int it = blockIdx.x; it < 256; it += G) wkv_pair<false>(p, smem, g, it);
  } else {
    for (int rr = 0; rr < r1; ++rr) {
      SsdPre R;
      if ((int)blockIdx.x < 128) ssd_issue(p, g, blockIdx.x, 0, get_tid(), R);
      for (int ch = blockIdx.x; ch < 128; ch += G) ssd_chain(p, smem, g, ch, ch + G < 128 ? ch + G : -1, R);
    }
    for (int rr = 0; rr < r2; ++rr) for (int it = (G - 1 - blockIdx.x); it < 512; it += G) wkv_pair<true>(p, smem, g, it);
  }
}
__device__ __forceinline__ void step_fix(const Params& p, char* smem) {
  for (int ch = blockIdx.x; ch < 64; ch += gridDim.x) wkv_fix(p, smem, ch);
}

__device__ __forceinline__ void step_fin(const Params& p, int g) {
  char* ws = p.ws;
  const int tid = get_tid(), lane = tid & 63, wave = tid >> 6;
  const int gw = blockIdx.x * 8 + wave, nw = gridDim.x * 8;
  {
    const u16* yf = (const u16*)(ws + OFF_SYF);
    const u16* yb = (const u16*)(ws + OFF_SYB);
    const u16* xbc = (const u16*)(ws + OFF_XBC);
    const u16* zb = (const u16*)(ws + OFF_Z);
    u16* ym = (u16*)(ws + OFF_YM);
    for (int it = gw; it < TG * 4; it += nw) {
      int r = it >> 2, gq = it & 3;
      int ch = gq * 512 + lane * 8;
      uint4 a = *(const uint4*)(yf + (size_t)r * 2048 + ch);
      uint4 b = *(const uint4*)(yb + (size_t)r * 2048 + ch);
      uint4 x = *(const uint4*)(xbc + (size_t)r * 3072 + ch);
      uint4 z = *(const uint4*)(zb + (size_t)r * 2048 + ch);
      float dsk = p.d_skip[ch >> 6];
      unsigned aw[4] = {a.x, a.y, a.z, a.w}, bw[4] = {b.x, b.y, b.z, b.w}, xw[4] = {x.x, x.y, x.z, x.w}, zw[4] = {z.x, z.y, z.z, z.w};
      float y[8];
      float ss = 0.f;
#pragma unroll
      for (int e = 0; e < 8; ++e) {
        int sh = (e & 1) * 16;
        float yy = bf2f((u16)(aw[e >> 1] >> sh)) + bf2f((u16)(bw[e >> 1] >> sh)) + dsk * bf2f((u16)(xw[e >> 1] >> sh));
        yy *= siluf(bf2f((u16)(zw[e >> 1] >> sh)));
        y[e] = yy;
        ss += yy * yy;
      }
      ss = wave_sum(ss);
      float rinv = rsqrtf(ss * (1.f / 512.f) + 1e-5f);
      float4 w0 = *(const float4*)(p.m_norm_w + ch), w1 = *(const float4*)(p.m_norm_w + ch + 4);
      *(uint4*)(ym + (size_t)r * 2048 + ch) =
          uint4{pack2(y[0] * rinv * w0.x, y[1] * rinv * w0.y), pack2(y[2] * rinv * w0.z, y[3] * rinv * w0.w),
                pack2(y[4] * rinv * w1.x, y[5] * rinv * w1.y), pack2(y[6] * rinv * w1.z, y[7] * rinv * w1.w)};
    }
  }
  {
    const u16* __restrict__ yf = (const u16*)(ws + OFF_WYF);
    const u16* __restrict__ yb = (const u16*)(ws + OFF_WYB);
    const __half* __restrict__ wk = (const __half*)(ws + OFF_WK);
    const u16* __restrict__ gr = (const u16*)(ws + OFF_GR);
    u16* __restrict__ yr = (u16*)(ws + OFF_YR);
    for (int it = gw; it < TG * 2; it += nw) {
      const int r = it >> 1, hh = it & 1;
      const int c0 = hh * 512 + lane * 8;
      const int head = c0 >> 6;
      const uint4 a = *(const uint4*)(yf + (size_t)r * 1024 + c0);
      const uint4 b = *(const uint4*)(yb + (size_t)r * 1024 + c0);
      const uint4 gq = *(const uint4*)(gr + (size_t)r * 1024 + c0);
      const __half* rec = wk + ((size_t)(r * 16 + head) * 8) * 64 + (lane & 7) * 8;
      const uint4 qr = *(const uint4*)(rec + 0 * 64), qv = *(const uint4*)(rec + 1 * 64), qk = *(const uint4*)(rec + 2 * 64);
      const uint4 qaf = *(const uint4*)(rec + 5 * 64), qab = *(const uint4*)(rec + 7 * 64);
      const float4 lw0 = *(const float4*)(p.lnx_w + c0), lw1 = *(const float4*)(p.lnx_w + c0 + 4);
      const float4 lb0 = *(const float4*)(p.lnx_b + c0), lb1 = *(const float4*)(p.lnx_b + c0 + 4);
      const float4 ka0 = *(const float4*)(p.k_a + c0), ka1 = *(const float4*)(p.k_a + c0 + 4);
      const float4 rk0 = *(const float4*)(p.r_k + c0), rk1 = *(const float4*)(p.r_k + c0 + 4);
      const float lw[8] = {lw0.x, lw0.y, lw0.z, lw0.w, lw1.x, lw1.y, lw1.z, lw1.w};
      const float lb[8] = {lb0.x, lb0.y, lb0.z, lb0.w, lb1.x, lb1.y, lb1.z, lb1.w};
      const float kav[8] = {ka0.x, ka0.y, ka0.z, ka0.w, ka1.x, ka1.y, ka1.z, ka1.w};
      const float rkv[8] = {rk0.x, rk0.y, rk0.z, rk0.w, rk1.x, rk1.y, rk1.z, rk1.w};
      float ya[8], yb8[8], gg[8];
      unpack8(a, ya); unpack8(b, yb8); unpack8(gq, gg);
      auto unph = [&](const uint4& u, float (&o)[8]) {
        const __half2* hp = reinterpret_cast<const __half2*>(&u);
#pragma unroll
        for (int e = 0; e < 4; ++e) { float2 f = __half22float2(hp[e]); o[2 * e] = f.x; o[2 * e + 1] = f.y; }
      };
      float rr[8], vv[8], kk[8], af[8], ab[8];
      unph(qr, rr); unph(qv, vv); unph(qk, kk); unph(qaf, af); unph(qab, ab);
      float y[8];
      float s1 = 0.f;
#pragma unroll
      for (int e = 0; e < 8; ++e) { y[e] = ya[e] + yb8[e]; s1 += y[e]; }
      s1 += dpp_xor1(s1); s1 += dpp_xor2(s1); s1 += dpp_hmirror(s1);
      const float mean = s1 * (1.f / 64.f);
      float s2 = 0.f, s3 = 0.f;
#pragma unroll
      for (int e = 0; e < 8; ++e) {
        const float dy = y[e] - mean;
        s2 += dy * dy;
        const float kmean = kk[e] * (1.f + (0.5f * (af[e] + ab[e]) - 1.f) * kav[e]);
        s3 += rr[e] * kmean * rkv[e];
      }
      s2 += dpp_xor1(s2); s2 += dpp_xor2(s2); s2 += dpp_hmirror(s2);
      s3 += dpp_xor1(s3); s3 += dpp_xor2(s3); s3 += dpp_hmirror(s3);
      const float rs = rsqrtf(s2 * (1.f / 64.f) + 64e-5f);
      float o[8];
#pragma unroll
      for (int e = 0; e < 8; ++e) o[e] = ((y[e] - mean) * rs * lw[e] + lb[e] + s3 * vv[e]) * gg[e];
      *(uint4*)(yr + (size_t)r * 1024 + c0) = uint4{pack2(o[0], o[1]), pack2(o[2], o[3]), pack2(o[4], o[5]), pack2(o[6], o[7])};
    }
  }
}

__device__ __forceinline__ void step_outproj(const Params& p, char* smem, int g) {
  char* ws = p.ws;
  u16* Ug = (u16*)p.out + (size_t)g * TG * 1024;
  EpiOut<0> E0{(const u16*)(ws + OFF_GATE), Ug};
  run_gemm8(smem, (const u16*)(ws + OFF_YM), (const u16*)(ws + OFF_WMOUT), TG, 1024, 2048, E0);
  EpiOut<1> E1{(const u16*)(ws + OFF_GATE), Ug};
  run_gemm8(smem, (const u16*)(ws + OFF_YR), (const u16*)(ws + OFF_WROUT), TG, 1024, 1024, E1);
}

__device__ __forceinline__ void step_wo(const Params& p, char* smem, int g) {
  char* ws = p.ws;
  EpiWo E{p.x_prompt, p.x_sample, (const float*)(ws + OFF_MOD), (float*)(ws + OFF_X1), 0};
  run_gemm8(smem, (const u16*)p.out, (const u16*)(ws + OFF_WO), NTOK, 1024, 1024, E);
}

__device__ __forceinline__ void step_gu(const Params& p, char* smem) {
  char* ws = p.ws;
  EpiGU E{(u16*)(ws + OFF_ACT)};
  run_gemm8(smem, (const u16*)(ws + OFF_H2), (const u16*)(ws + OFF_WGU), NTOK, 5632, 1024, E);
}

__device__ __forceinline__ void step_down(const Params& p, char* smem) {
  char* ws = p.ws;
  EpiDown E{(const float*)(ws + OFF_MOD), (float*)(ws + OFF_X1)};
  run_gemm8(smem, (const u16*)(ws + OFF_ACT), (const u16*)(ws + OFF_WDOWN), NTOK, 1024, 2816, E);
}

__device__ __forceinline__ void step_final(const Params& p) {
  const int tid = get_tid(), lane = tid & 63, wave = tid >> 6;
  for (int r = blockIdx.x * 8 + wave; r < NTOK; r += gridDim.x * 8) {
    const float* xr = (const float*)(p.ws + OFF_X1) + (size_t)r * 1024;
    float* xo = p.out + (size_t)r * 1024;
    float4 v[4];
    float ss = 0.f;
#pragma unroll
    for (int i = 0; i < 4; ++i) {
      v[i] = ((const float4*)xr)[i * 64 + lane];
      ss += v[i].x * v[i].x + v[i].y * v[i].y + v[i].z * v[i].z + v[i].w * v[i].w;
    }
    ss = wave_sum(ss);
    float rinv = rsqrtf(ss * (1.f / 1024.f) + 1e-6f);
#pragma unroll
    for (int i = 0; i < 4; ++i) {
      float4 w4 = ((const float4*)p.final_norm_w)[i * 64 + lane];
      ((float4*)xo)[i * 64 + lane] = float4{v[i].x * rinv * w4.x, v[i].y * rinv * w4.y, v[i].z * rinv * w4.z, v[i].w * rinv * w4.w};
    }
  }
}

constexpr int NSTEPS = 30;

__global__ void __launch_bounds__(NTHR) mega(Params p_arg) {
  const int step_lo = p_arg.step_lo, step_hi = p_arg.step_hi;
  __shared__ __attribute__((aligned(16))) char smem[SMEM_BYTES];
#if !MULTI_LAUNCH
  if (threadIdx.x == 0) *(uint4*)(smem + SMEM_BYTES - 16) = uint4{0u, 0u, 0u, 0u};
  __syncthreads();
  XcdBarrier xb = xcd_barrier_post((unsigned*)(p_arg.ws + OFF_BAR), (volatile LAS unsigned*)(smem + SMEM_BYTES - 16));
#endif
  for (int step = step_lo; step <= step_hi; ++step) {
#if defined(__HIP_DEVICE_COMPILE__)
    const __attribute__((address_space(4))) Params* pp = (const __attribute__((address_space(4))) Params*)__builtin_amdgcn_kernarg_segment_ptr();
    asm volatile("" : "+s"(pp));
    const Params p = *pp;
#else
    const Params p = p_arg;
#endif
    const int g = (step - 1) >> 3, s = (step - 1) & 7;
    const int scode = step == 0 ? 0 : (step <= 24 ? 1 + s : step - 16);
    if (scode == 6 && g < 2) continue;
    if (scode == 1 && g > 0) continue;
    const int reps = ((RM >> scode) & 1) ? 2 : 1;
    for (int rep = 0; rep < reps; ++rep) {
      if (!((SM >> scode) & 1)) continue;
      switch (scode) {
        case 0: step_prep(p, smem); break;
        case 1: step_norm<0>(p, g); break;
        case 2: step_gemm1(p, smem, g == 0 ? 0 : 2); break;
        case 3: step_cr1(p, g); break;
        case 4: step_r2(p, smem); break;
        case 5: step_scan(p, smem, g); break;
        case 6: step_fix(p, smem); break;
        case 7: step_fin(p, g); if (g < 2) step_norm<0>(p, g + 1); break;
        case 8:
          if (blockIdx.x < 64) step_outproj(p, smem, g);
          else {
            if (g < 2) step_gemm1(p, smem, 1);
            if (g == 0) {
              convT<1>(p.w_gu, 1024, 5632, (u16*)(p.ws + OFF_WGU), smem, blockIdx.x - 64, gridDim.x - 64);
              convT<0>(p.w_down, 2816, 1024, (u16*)(p.ws + OFF_WDOWN), smem, blockIdx.x - 64, gridDim.x - 64);
            }
          }
          break;
        case 9: step_wo(p, smem, 0); break;
        case 10: step_norm<1>(p, 0); break;
        case 11: step_gu(p, smem); break;
        case 12: step_down(p, smem); break;
        default: step_final(p); break;
      }
    }
    if (step < step_hi) {
#if !MULTI_LAUNCH
      if (step_hi > 100000) cg::this_grid().sync();
      for (int xs = 0; xs < 1 + XSYNC; ++xs) xcd_barrier(xb);
#endif
    }
  }
}

extern "C" void kernel_launch(void* const* d_in, const int* in_sizes, int n_in, void* d_out, int out_size,
                              void* d_ws, size_t ws_size, hipStream_t stream) {
  Params p{};
  const float** pp = (const float**)&p;
  for (int i = 0; i < 36; ++i) pp[i] = (const float*)d_in[i];
  p.out = (float*)d_out;
  p.ws = (char*)d_ws;
  if (ws_size < WS_NEED) fprintf(stderr, "workspace too small: %zu < %zu\n", ws_size, (size_t)WS_NEED);
#if MULTI_LAUNCH
  for (int s = 0; s < NSTEPS; ++s) {
    p.step_lo = s;
    p.step_hi = s;
    hipLaunchKernelGGL(mega, dim3(256), dim3(NTHR), 0, stream, p);
  }
#else
  static int grid_blocks = 0;
  if (!grid_blocks) {
    int dev = 0, cus = 0, per_cu = 0;
    hipGetDevice(&dev);
    hipDeviceGetAttribute(&cus, hipDeviceAttributeMultiprocessorCount, dev);
    hipOccupancyMaxActiveBlocksPerMultiprocessor(&per_cu, mega, NTHR, 0);
    if (per_cu < 1) per_cu = 1;
    if (per_cu > 1) per_cu = 1;
    grid_blocks = cus * per_cu;
  }
  p.step_lo = 0;
  p.step_hi = NSTEPS - 1;
  void* args[] = {&p};
  hipMemsetAsync((char*)d_ws + OFF_BAR, 0, XCD_BAR_WORDS_C * 4, stream);
  hipError_t e = hipLaunchCooperativeKernel((void*)mega, dim3(grid_blocks), dim3(NTHR), args, 0, stream);
  if (e != hipSuccess) fprintf(stderr, "cooperative launch failed: %s (grid %d)\n", hipGetErrorString(e), grid_blocks);
#endif
}
```

```cpp
#include <hip/hip_runtime.h>
#include <hip/hip_cooperative_groups.h>
#include <hip/hip_fp16.h>
#include <cstdio>
#include <cstdint>
namespace cg = cooperative_groups;

#ifndef MULTI_LAUNCH
#define MULTI_LAUNCH 0
#endif

#define DI __device__ __forceinline__
typedef __attribute__((ext_vector_type(8))) short bf16x8;
typedef __attribute__((ext_vector_type(4))) float f32x4;
typedef unsigned short u16;

#ifndef STEP_MASK
#define STEP_MASK 0xffffff
#endif
constexpr int SM = STEP_MASK;
#ifndef REPEAT_MASK
#define REPEAT_MASK 0
#endif
#ifndef XSYNC
#define XSYNC 0
#endif
constexpr int RM = REPEAT_MASK;
constexpr int TG = 4096;
constexpr int NTOK = 12288;
constexpr int NPAD = 10752;
constexpr int NTHR = 512;
constexpr int SMEM_BYTES = 133120;
constexpr int XCD_BAR_WORDS_C = 3456;

constexpr size_t OFF_WIN = 0;
constexpr size_t OFF_WGU = OFF_WIN + (size_t)NPAD * 1024 * 2;
constexpr size_t OFF_WDOWN = OFF_WGU + (size_t)5632 * 1024 * 2;
constexpr size_t OFF_WMOUT = OFF_WDOWN + (size_t)1024 * 2816 * 2;
constexpr size_t OFF_WROUT = OFF_WMOUT + (size_t)1024 * 2048 * 2;
constexpr size_t OFF_WO = OFF_WROUT + (size_t)1024 * 1024 * 2;
constexpr size_t OFF_W2T = OFF_WO + (size_t)1024 * 1024 * 2;
constexpr size_t OFF_A2T = OFF_W2T + 262144;
constexpr size_t OFF_G2T = OFF_A2T + 262144;
constexpr size_t OFF_MOD = OFF_G2T + 262144;
constexpr size_t OFF_GRP = OFF_MOD + 73728;
constexpr size_t OFF_Z = OFF_GRP;
constexpr size_t OFF_GATE = OFF_Z + (size_t)TG * 2048 * 2;
constexpr size_t OFF_XBC = OFF_GATE + (size_t)TG * 2048 * 2;
constexpr size_t OFF_WK = OFF_XBC + (size_t)TG * 3072 * 2;
constexpr size_t OFF_GR = OFF_WK + (size_t)TG * 16 * 1024;
constexpr size_t OFF_DT = OFF_GR + (size_t)TG * 1024 * 2;
constexpr size_t OFF_TL = OFF_DT + (size_t)TG * 64 * 4;
constexpr size_t OFF_SG = OFF_TL + (size_t)TG * 256 * 2;
constexpr size_t OFF_R = OFF_SG + (size_t)TG * 128 * 2;
constexpr size_t OFF_H1 = OFF_R;
constexpr size_t OFF_XBCRAW = OFF_H1 + (size_t)TG * 1024 * 2;
constexpr size_t OFF_RW = OFF_XBCRAW + (size_t)TG * 3072 * 2;
constexpr size_t OFF_SYF = OFF_R;
constexpr size_t OFF_SYB = OFF_SYF + (size_t)TG * 2048 * 2;
constexpr size_t OFF_WYF = OFF_SYB + (size_t)TG * 2048 * 2;
constexpr size_t OFF_WYB = OFF_WYF + (size_t)TG * 1024 * 2;
constexpr size_t OFF_YM = OFF_WYB + (size_t)TG * 1024 * 2;
constexpr size_t OFF_YR = OFF_YM + (size_t)TG * 2048 * 2;
constexpr size_t OFF_END = OFF_YR + (size_t)TG * 1024 * 2;
constexpr size_t OFF_BAR = OFF_END;
constexpr size_t OFF_W4T = OFF_BAR + 16384;
constexpr size_t WS_NEED = OFF_W4T + (size_t)4096 * 256 * 2;
constexpr size_t OFF_U = OFF_XBC;
constexpr size_t OFF_H2 = OFF_GRP;
constexpr size_t OFF_ACT = OFF_H2 + (size_t)NTOK * 1024 * 2;
constexpr size_t H1_OUT_OFF = 25165824;
constexpr size_t OFF_X1 = OFF_ACT + (size_t)NTOK * 2816 * 2;

constexpr size_t OUT_SSMF = 12582912;
constexpr size_t OUT_SSMB = OUT_SSMF + 8388608;
constexpr size_t OUT_WKVF = OUT_SSMB + 8388608;
constexpr size_t OUT_WKVB = OUT_WKVF + 2097152;

struct Params {
  const float *x_prompt, *x_sample, *ssm_f, *ssm_b, *wkv_f, *wkv_b, *c, *c_ctx, *norm1_w, *norm2_w,
      *w_ada, *b_ada, *w_in, *conv_w, *conv_b, *dt_bias, *a_log, *d_skip, *m_norm_w, *mu_shift, *w0,
      *w2, *a0, *a2, *g2, *k_k, *k_a, *r_k, *lnx_w, *lnx_b, *w_m_out, *w_r_out, *w_o, *w_gu, *w_down,
      *final_norm_w;
  float* out;
  char* ws;
  int step_lo, step_hi;
};

DI int get_tid() {
  int t = threadIdx.x;
  asm volatile("" : "+v"(t));
  return t;
}
DI u16 f2bf(float f) {
  unsigned u = __float_as_uint(f);
  u += 0x7fffu + ((u >> 16) & 1u);
  return (u16)(u >> 16);
}
DI float bf2f(u16 h) { return __uint_as_float(((unsigned)h) << 16); }
DI float siluf(float x) { return x / (1.f + __expf(-x)); }
DI float sigm(float x) { return 1.f / (1.f + __expf(-x)); }
DI float wave_sum(float v) {
  v += __int_as_float(__builtin_amdgcn_update_dpp(0, __float_as_int(v), 0xB1, 0xF, 0xF, true));
  v += __int_as_float(__builtin_amdgcn_update_dpp(0, __float_as_int(v), 0x4E, 0xF, 0xF, true));
  v += __int_as_float(__builtin_amdgcn_update_dpp(0, __float_as_int(v), 0x141, 0xF, 0xF, true));
  v += __int_as_float(__builtin_amdgcn_update_dpp(0, __float_as_int(v), 0x140, 0xF, 0xF, true));
  const int vi = __float_as_int(v);
  float a = __int_as_float(__builtin_amdgcn_readlane(vi, 0)), b = __int_as_float(__builtin_amdgcn_readlane(vi, 16));
  float c = __int_as_float(__builtin_amdgcn_readlane(vi, 32)), d = __int_as_float(__builtin_amdgcn_readlane(vi, 48));
  return (a + b) + (c + d);
}
DI float dpp_xor1(float v) { return __int_as_float(__builtin_amdgcn_update_dpp(0, __float_as_int(v), 0xB1, 0xF, 0xF, true)); }
DI float dpp_hmirror(float v) { return __int_as_float(__builtin_amdgcn_update_dpp(0, __float_as_int(v), 0x141, 0xF, 0xF, true)); }
DI float dpp_xor2(float v) { return __int_as_float(__builtin_amdgcn_update_dpp(0, __float_as_int(v), 0x4E, 0xF, 0xF, true)); }
DI unsigned pack2(float a, float b) { return (unsigned)f2bf(a) | ((unsigned)f2bf(b) << 16); }
DI int mrow_of(int tok) { return tok < 8192 ? 0 : 1 + ((tok - 8192) >> 11); }


#define XB_TMO      128
#define XB_XCNT(j)  (256  + 64 * (j))
#define XB_XSUB(j)  (1280 + 64 * (j))
#define XB_XGEN(j)  (2304 + 64 * (j))
#define XB_TOP      3328
#define XB_TOPGEN   3392
#define XCD_BAR_WORDS 3456
#define XB_SPIN_CAP (1u << 22)
#define LAS __attribute__((address_space(3)))
DI unsigned xb_ld(unsigned* p) { return __hip_atomic_load(p, __ATOMIC_RELAXED, __HIP_MEMORY_SCOPE_AGENT); }
DI unsigned xb_add(unsigned* p, unsigned v) { return __hip_atomic_fetch_add(p, v, __ATOMIC_RELAXED, __HIP_MEMORY_SCOPE_AGENT); }
DI unsigned xb_xcc_id() { return (unsigned)__builtin_amdgcn_s_getreg((3 << 11) | 20) & 0xFu; }
#define XB_SPIN(cond, bar) do { unsigned _sp = 0; while (cond) { __builtin_amdgcn_s_sleep(1); \
    if ((++_sp & 255u) == 0u) { if (xb_ld(&(bar)[XB_TMO])) break; if (_sp > XB_SPIN_CAP) { atomicAdd(&(bar)[XB_TMO], 1u); break; } } } } while (0)
struct XcdBarrier { unsigned* bar; unsigned x; volatile LAS unsigned* st; };
DI XcdBarrier xcd_barrier_post(unsigned* bar, volatile LAS unsigned* st) {
  XcdBarrier b; b.bar = bar; b.x = xb_xcc_id(); b.st = st;
  if (threadIdx.x == 0) (void)xb_add(&bar[XB_XCNT(b.x)], 1u);
  return b;
}
DI void xcd_barrier_complete(unsigned* bar, unsigned x, unsigned& nloc, unsigned& nx) {
  const unsigned G = gridDim.x * gridDim.y * gridDim.z;
  unsigned sum, cnt, mine, sp = 0u;
  for (;;) {
    sum = 0u; cnt = 0u; mine = 0u;
#pragma unroll
    for (unsigned j = 0; j < 16; ++j) { const unsigned c = xb_ld(&bar[XB_XCNT(j)]); sum += c; cnt += (c > 0u) ? 1u : 0u; mine = (j == x) ? c : mine; }
    if (sum == G) break;
    __builtin_amdgcn_s_sleep(1);
    if ((++sp & 255u) == 0u) { if (xb_ld(&bar[XB_TMO])) break; if (sp > XB_SPIN_CAP) { atomicAdd(&bar[XB_TMO], 1u); break; } }
  }
  nloc = mine > 0u ? mine : 1u; nx = cnt > 0u ? cnt : 1u;
}
DI void xcd_barrier(const XcdBarrier& b) {
  asm volatile("s_waitcnt vmcnt(0)" ::: "memory");
  __syncthreads();
  if (threadIdx.x == 0) {
    unsigned* bar = b.bar;
    asm volatile("" : "+s"(bar));
    __builtin_amdgcn_s_waitcnt(0);
    unsigned nloc = b.st[0], nx = b.st[1];
    if (nloc == 0u) { xcd_barrier_complete(bar, b.x, nloc, nx); b.st[0] = nloc; b.st[1] = nx; }
    const unsigned old = xb_add(&bar[XB_XSUB(b.x)], 1u);
    const unsigned gen = old / nloc;
    if (old + 1u == (gen + 1u) * nloc) {
      __builtin_amdgcn_fence(__ATOMIC_RELEASE, "agent");
      asm volatile("s_waitcnt vmcnt(0)" ::: "memory");
      const unsigned og = xb_add(&bar[XB_TOP], 1u);
      const unsigned tg = og / nx;
      if (og + 1u == (tg + 1u) * nx) xb_add(&bar[XB_TOPGEN], 1u);
      else XB_SPIN(xb_ld(&bar[XB_TOPGEN]) == tg, bar);
      __builtin_amdgcn_fence(__ATOMIC_ACQUIRE, "agent");
      xb_add(&bar[XB_XGEN(b.x)], 1u);
      asm volatile("s_waitcnt vmcnt(0)" ::: "memory");
    } else {
      XB_SPIN(xb_ld(&bar[XB_XGEN(b.x)]) == gen, bar);
      __builtin_amdgcn_fence(__ATOMIC_ACQUIRE, "agent");
      asm volatile("s_waitcnt vmcnt(0)" ::: "memory");
    }
  }
  __syncthreads();
}

DI void gemm_load(const int tid, const u16* A, int lda, const u16* B, int ldb, int k0, uint4 (&ra)[4], uint4 (&rb)[2]) {
#pragma unroll
  for (int i = 0; i < 4; ++i) {
    int idx = tid + i * 512;
    int row = idx >> 3, ch = idx & 7;
    ra[i] = *(const uint4*)(A + (size_t)row * lda + k0 + ch * 8);
  }
#pragma unroll
  for (int i = 0; i < 2; ++i) {
    int idx = tid + i * 512;
    int row = idx >> 3, ch = idx & 7;
    rb[i] = *(const uint4*)(B + (size_t)row * ldb + k0 + ch * 8);
  }
}
DI void gemm_store_lds(const int tid, char* sA, char* sB, const uint4 (&ra)[4], const uint4 (&rb)[2]) {
#pragma unroll
  for (int i = 0; i < 4; ++i) {
    int idx = tid + i * 512;
    int row = idx >> 3, ch = idx & 7;
    *(uint4*)(sA + row * 128 + ((ch ^ ((row >> 1) & 7)) << 4)) = ra[i];
  }
#pragma unroll
  for (int i = 0; i < 2; ++i) {
    int idx = tid + i * 512;
    int row = idx >> 3, ch = idx & 7;
    *(uint4*)(sB + row * 128 + ((ch ^ ((row >> 1) & 7)) << 4)) = rb[i];
  }
}
DI void gemm_compute(const char* sA, const char* sB, f32x4 (&acc)[4][4], int wm, int wn, int lane) {
#pragma unroll
  for (int kk = 0; kk < 2; ++kk) {
    bf16x8 a[4], b[4];
    const int ch = kk * 4 + (lane >> 4);
#pragma unroll
    for (int mf = 0; mf < 4; ++mf) {
      int row = wm * 64 + mf * 16 + (lane & 15);
      a[mf] = *(const bf16x8*)(sA + row * 128 + ((ch ^ ((row >> 1) & 7)) << 4));
    }
#pragma unroll
    for (int nf = 0; nf < 4; ++nf) {
      int row = wn * 64 + nf * 16 + (lane & 15);
      b[nf] = *(const bf16x8*)(sB + row * 128 + ((ch ^ ((row >> 1) & 7)) << 4));
    }
#pragma unroll
    for (int mf = 0; mf < 4; ++mf)
#pragma unroll
      for (int nf = 0; nf < 4; ++nf)
        acc[mf][nf] = __builtin_amdgcn_mfma_f32_16x16x32_bf16(a[mf], b[nf], acc[mf][nf], 0, 0, 0);
  }
}
DI void gemm_acc(const u16* A, int lda, const u16* B, int ldb, int K, f32x4 (&acc)[4][4], char* smem) {
  const int tid = get_tid(), lane = tid & 63, wave = tid >> 6;
  const int wm = wave >> 1, wn = wave & 1;
  char* sA0 = smem;
  char* sB0 = smem + 32768;
  char* sA1 = smem + 49152;
  char* sB1 = smem + 81920;
  uint4 ra[4], rb[2];
  const int nk = K >> 6;
  gemm_load(tid, A, lda, B, ldb, 0, ra, rb);
  gemm_store_lds(tid, sA0, sB0, ra, rb);
  __syncthreads();
  for (int kt = 0; kt < nk; ++kt) {
    const bool more = (kt + 1 < nk);
    if (more) gemm_load(tid, A, lda, B, ldb, (kt + 1) * 64, ra, rb);
    if (kt & 1) gemm_compute(sA1, sB1, acc, wm, wn, lane);
    else gemm_compute(sA0, sB0, acc, wm, wn, lane);
    if (more) {
      if (kt & 1) gemm_store_lds(tid, sA0, sB0, ra, rb);
      else gemm_store_lds(tid, sA1, sB1, ra, rb);
    }
    __syncthreads();
  }
}
DI void zero_acc(f32x4 (&acc)[4][4]) {
#pragma unroll
  for (int i = 0; i < 4; ++i)
#pragma unroll
    for (int j = 0; j < 4; ++j) { float z0; asm volatile("v_mov_b32 %0, 0" : "=v"(z0)); acc[i][j] = f32x4{z0, z0, z0, z0}; }
}

#define PG8_LAS __attribute__((address_space(3)))
namespace pg8 {
typedef unsigned short bf16_t;
typedef short bf16x8 __attribute__((ext_vector_type(8)));
typedef float f32x4 __attribute__((ext_vector_type(4)));
typedef unsigned u32x4 __attribute__((ext_vector_type(4)));
constexpr int BM = 256, BK = 64, HALF = 128, HTB = HALF * BK * 2  , STAGE_BYTES = 8 * HTB, NXCD = 8, WGM = 8;

__host__ __device__ __forceinline__ int lds_byte(int r, int c) { const int st = (r >> 4) * 2 + (c >> 5), rr = r & 15, cc = c & 31, ob = rr * 64 + cc * 2; return st * 1024 + (ob ^ (((ob >> 9) & 1) << 5)); }
__host__ __device__ __forceinline__ void stage_rc(int b, int& R, int& C) { const int st = b / 1024, sb = b % 1024, swz = sb ^ (((sb >> 9) & 1) << 5); R = (st >> 1) * 16 + swz / 64; C = (st & 1) * 32 + (swz % 64) / 2; }
__host__ __device__ __forceinline__ int perm32(int rho) { const int n = rho >> 4, i = rho & 15; return 8 * (i >> 2) + 4 * n + (i & 3); }

struct Unit { int pm, pn; };
struct Gemm { const bf16_t* A; const bf16_t* Bt; int M, N, K; };

struct StaticOrder {
    int nM, nN, nwg, G, c;
    __host__ __device__ void init(int M, int N, int G_, int c_) { nM = M / BM; nN = N / BM; nwg = nM * nN; G = G_; c = c_; }
    __host__ __device__ bool next(int i, Unit& u) const {
        const long L = (long)i * G + c; if (L >= nwg) return false;
        int wgid = (int)L; { const int q = nwg / NXCD, r = nwg % NXCD, xcd = wgid % NXCD, off = wgid / NXCD; wgid = (xcd < r ? xcd * (q + 1) : r * (q + 1) + (xcd - r) * q) + off; }
        const int nig = WGM * nN, gid = wgid / nig, fm = gid * WGM, gsz = (nM - fm) < WGM ? (nM - fm) : WGM;
        u.pm = fm + ((wgid % nig) % gsz); u.pn = (wgid % nig) / gsz; return true;
    }
    __device__ __forceinline__ void a_ready(const Unit&) const {}
    __device__ __forceinline__ void done(const Unit&) const {}
};
__device__ __forceinline__ unsigned cvt_pk_bf16(float lo, float hi) { unsigned r; asm volatile("v_cvt_pk_bf16_f32 %0, %1, %2" : "=v"(r) : "v"(lo), "v"(hi)); return r; }
template <class Epi, class Sched, bool STAMP = false>
__device__ __forceinline__ void gemm_phase(PG8_LAS unsigned char* lds, const Gemm g, const Sched& S, const Epi& E, unsigned long long* stamps) {
    const int tid = get_tid(), wid = __builtin_amdgcn_readfirstlane(tid >> 6), lane = tid & 63, wr = wid >> 2, wc = wid & 3, fr = lane & 15, fq = lane >> 4;
    const int K = g.K, nt = K / BK;
    int ts_lo = 0, ts_hi = 0, nts = 0; const unsigned long long rt_entry = STAMP ? (unsigned long long)wall_clock64() : 0ull;
#define PG8_STAMP() do { if (STAMP && wid == 0 && nts < 64) { const unsigned long long _c = (unsigned long long)clock64(); \
        ts_lo = (lane == nts) ? (int)(unsigned)_c : ts_lo; ts_hi = (lane == nts) ? (int)(unsigned)(_c >> 32) : ts_hi; ++nts; } } while (0)
    PG8_STAMP();
    unsigned voffA[2], voffB[2];
#pragma unroll
    for (int i = 0; i < 2; ++i) { int R, C; stage_rc(tid * 16 + i * 8192, R, C); const int Rb = Epi::PERM ? ((R & ~31) + perm32(R & 31)) : R;
        voffA[i] = (unsigned)(R * K + C) * 2u; voffB[i] = (unsigned)(Rb * K + C) * 2u; }
    const size_t kstep = (size_t)(BK * 2);
    const size_t hstep = (size_t)HALF * K * 2;
    const size_t tstep = 2 * hstep;
    const unsigned ldsw = (unsigned)wid * 1024u;
    const int aoff = lds_byte(wr * 64 + fr, fq * 8), boff = lds_byte(wc * 32 + fr, fq * 8);
#define PG8_SA(b, h) (((b) * 2 + (h)) * HTB)
#define PG8_SB(b, h) ((4 + (b) * 2 + (h)) * HTB)
#define PG8_STAGE(bufoff, gbase, voff) do { _Pragma("unroll") for (int _i = 0; _i < 2; ++_i) \
        __builtin_amdgcn_global_load_lds((const unsigned*)((const char*)(gbase) + (voff)[_i]), (PG8_LAS unsigned*)(lds + (bufoff) + ldsw + _i * 8192), 16, 0, 0); } while (0)
#define PG8_LDA(dst, b, h) do { _Pragma("unroll") for (int m = 0; m < 4; ++m) _Pragma("unroll") for (int k = 0; k < 2; ++k) dst[m][k] = *(const PG8_LAS bf16x8*)(lds + PG8_SA(b, h) + aoff + m * 2048 + k * 1024); } while (0)
#define PG8_LDB(dst, b, h) do { _Pragma("unroll") for (int n = 0; n < 2; ++n) _Pragma("unroll") for (int k = 0; k < 2; ++k) dst[n][k] = *(const PG8_LAS bf16x8*)(lds + PG8_SB(b, h) + boff + n * 2048 + k * 1024); } while (0)
#define PG8_MMA(ai, bj, At, Bt) do { __builtin_amdgcn_s_setprio(1); _Pragma("unroll") for (int m = 0; m < 4; ++m) _Pragma("unroll") for (int n = 0; n < 2; ++n) _Pragma("unroll") for (int k = 0; k < 2; ++k) \
        acc[ai][bj][m][n] = __builtin_amdgcn_mfma_f32_16x16x32_bf16(Bt[n][k], At[m][k], acc[ai][bj][m][n], 0, 0, 0); __builtin_amdgcn_s_setprio(0); } while (0)
#define PG8_WAIT_V(n) asm volatile("s_waitcnt vmcnt(" #n ")" ::: "memory")
#define PG8_WAIT_L(n) asm volatile("s_waitcnt lgkmcnt(" #n ")" ::: "memory")
#define PG8_BAR __builtin_amdgcn_s_barrier()
#define PG8_SCHED __builtin_amdgcn_sched_barrier(0)
    Unit cur, nxt; int ui = 0;
    if (!S.next(0, cur)) return;
    f32x4 acc[2][2][4][2];
#pragma unroll
    for (int a = 0; a < 2; ++a)
#pragma unroll
        for (int b = 0; b < 2; ++b)
#pragma unroll
            for (int m = 0; m < 4; ++m)
#pragma unroll
                for (int n = 0; n < 2; ++n) { float z0; asm volatile("v_mov_b32 %0, 0" : "=v"(z0)); acc[a][b][m][n] = (f32x4){z0, z0, z0, z0}; }
    bf16x8 At[4][2], B0[2][2], B1[2][2];
    const char* cA = (const char*)g.A + (size_t)cur.pm * tstep; const char* cB = (const char*)g.Bt + (size_t)cur.pn * tstep;
    S.a_ready(cur);
    PG8_STAGE(PG8_SB(0, 0), cB, voffB); PG8_STAGE(PG8_SA(0, 0), cA, voffA); PG8_STAGE(PG8_SB(0, 1), cB + hstep, voffB); PG8_STAGE(PG8_SA(0, 1), cA + hstep, voffA);
    if (wr == 1) PG8_BAR;
    PG8_WAIT_V(4); PG8_BAR;
    PG8_STAGE(PG8_SB(1, 0), cB + kstep, voffB); PG8_STAGE(PG8_SA(1, 0), cA + kstep, voffA); PG8_STAGE(PG8_SB(1, 1), cB + hstep + kstep, voffB);
    PG8_WAIT_V(6); PG8_BAR;
    PG8_STAMP();
    for (;;) {
        const bool has_next = S.next(ui + 1, nxt);
        const char* nA = has_next ? (const char*)g.A + (size_t)nxt.pm * tstep : cA; const char* nB = has_next ? (const char*)g.Bt + (size_t)nxt.pn * tstep : cB;
        for (int t = 0; t < nt; t += 2) {
            const bool last = (t == nt - 2);
            const char* a1 = cA + (size_t)(t + 1) * kstep;
            const char* a2 = last ? nA : cA + (size_t)(t + 2) * kstep; const char* b2 = last ? nB : cB + (size_t)(t + 2) * kstep;
            const char* a3 = a2 + kstep; const char* b3 = b2 + kstep;
            if (last && has_next) S.a_ready(nxt);
            PG8_LDB(B0, 0, 0); PG8_SCHED; PG8_LDA(At, 0, 0); PG8_STAGE(PG8_SA(1, 1), a1 + hstep, voffA);
            PG8_WAIT_L(8); PG8_BAR; PG8_WAIT_L(0); PG8_MMA(0, 0, At, B0); PG8_BAR; PG8_SCHED;
            PG8_LDB(B1, 0, 1); PG8_STAGE(PG8_SB(0, 0), b2, voffB);
            PG8_BAR; PG8_WAIT_L(0); PG8_MMA(0, 1, At, B1); PG8_BAR;
            PG8_LDA(At, 0, 1); PG8_STAGE(PG8_SA(0, 0), a2, voffA);
            PG8_BAR; PG8_WAIT_L(0); PG8_MMA(1, 0, At, B0); PG8_BAR; PG8_SCHED;
            PG8_STAGE(PG8_SB(0, 1), b2 + hstep, voffB);
            PG8_WAIT_V(6); PG8_BAR; PG8_MMA(1, 1, At, B1); PG8_BAR;
            PG8_LDB(B0, 1, 0); PG8_SCHED; PG8_LDA(At, 1, 0); PG8_STAGE(PG8_SA(0, 1), a2 + hstep, voffA);
            PG8_WAIT_L(8); PG8_BAR; PG8_WAIT_L(0); PG8_MMA(0, 0, At, B0); PG8_BAR; PG8_SCHED;
            PG8_LDB(B1, 1, 1); PG8_STAGE(PG8_SB(1, 0), b3, voffB);
            PG8_BAR; PG8_WAIT_L(0); PG8_MMA(0, 1, At, B1); PG8_BAR;
            PG8_LDA(At, 1, 1); PG8_STAGE(PG8_SA(1, 0), a3, voffA);
            PG8_BAR; PG8_WAIT_L(0); PG8_MMA(1, 0, At, B0); PG8_BAR; PG8_SCHED;
            PG8_STAGE(PG8_SB(1, 1), b3 + hstep, voffB);
            PG8_WAIT_V(6); PG8_BAR; PG8_MMA(1, 1, At, B1); PG8_BAR;
        }
        PG8_STAMP();
        if constexpr (!Epi::AFTER_DRAIN) { E(acc, cur, wr, wc, fr, fq); S.done(cur); }
        PG8_STAMP();
        if (!has_next) break;
#pragma unroll
        for (int a = 0; a < 2; ++a)
#pragma unroll
            for (int b = 0; b < 2; ++b)
#pragma unroll
                for (int m = 0; m < 4; ++m)
#pragma unroll
                    for (int n = 0; n < 2; ++n) { float z0; asm volatile("v_mov_b32 %0, 0" : "=v"(z0)); acc[a][b][m][n] = (f32x4){z0, z0, z0, z0}; }
        cur = nxt; cA = nA; cB = nB; ++ui;
    }
    PG8_WAIT_V(0);
    if (wr == 0) PG8_BAR;
    PG8_BAR;
    if constexpr (Epi::AFTER_DRAIN) { E.fused(acc, cur, wr, wc, fr, fq, lds, wid, lane); S.done(cur); }
    PG8_STAMP();
    if (STAMP && wid == 0) { stamps[lane] = lane < nts ? (((unsigned long long)(unsigned)ts_hi << 32) | (unsigned)ts_lo) : 0ull;
        if (lane == 62) stamps[62] = rt_entry; if (lane == 63) stamps[63] = (unsigned long long)wall_clock64(); }
#undef PG8_STAMP
#undef PG8_SA
#undef PG8_SB
#undef PG8_STAGE
#undef PG8_LDA
#undef PG8_LDB
#undef PG8_MMA
#undef PG8_WAIT_V
#undef PG8_WAIT_L
#undef PG8_BAR
#undef PG8_SCHED
}
}

using pg8::cvt_pk_bf16;
DI uint4 pack8(const pg8::f32x4& a, const pg8::f32x4& b) {
  return uint4{cvt_pk_bf16(a[0], a[1]), cvt_pk_bf16(a[2], a[3]), cvt_pk_bf16(b[0], b[1]), cvt_pk_bf16(b[2], b[3])};
}
DI void unpack8(const uint4& u, float (&o)[8]) {
  o[0] = bf2f((u16)(u.x & 0xffff)); o[1] = bf2f((u16)(u.x >> 16));
  o[2] = bf2f((u16)(u.y & 0xffff)); o[3] = bf2f((u16)(u.y >> 16));
  o[4] = bf2f((u16)(u.z & 0xffff)); o[5] = bf2f((u16)(u.z >> 16));
  o[6] = bf2f((u16)(u.w & 0xffff)); o[7] = bf2f((u16)(u.w >> 16));
}
struct EpiP {
  static constexpr bool PERM = true, AFTER_DRAIN = false;
  u16 *zb, *xr, *rwb, *gb; float* dtb; int coff;
  DI void operator()(const pg8::f32x4 (&acc)[2][2][4][2], const pg8::Unit& u, int wr, int wc, int fr, int fq) const {
    const int row0 = u.pm * 256 + wr * 64 + fr;
#pragma unroll
    for (int bj = 0; bj < 2; ++bj) {
      const int cg = coff + u.pn * 256 + bj * 128 + wc * 32;
      const int col0 = cg + 8 * fq;
      if (cg >= 10688) continue;
#pragma unroll
      for (int ai = 0; ai < 2; ++ai)
#pragma unroll
        for (int m = 0; m < 4; ++m) {
          const size_t row = row0 + ai * 128 + m * 16;
          const pg8::f32x4 v0 = acc[ai][bj][m][0], v1 = acc[ai][bj][m][1];
          if (cg >= 5120 && cg < 5184) {
            float* d = dtb + row * 64 + (col0 - 5120);
            *(pg8::f32x4*)d = v0; *(pg8::f32x4*)(d + 4) = v1;
          } else {
            u16* dst = (cg < 2048) ? zb + row * 2048 + col0
                     : (cg < 5120) ? xr + row * 3072 + (col0 - 2048)
                     : (cg < 8640) ? rwb + row * 3456 + (col0 - 5184)
                                   : gb + row * 2048 + (col0 - 8640);
            *(uint4*)dst = pack8(v0, v1);
          }
        }
    }
  }
};
template <int PASS>
struct EpiOut {
  static constexpr bool PERM = true, AFTER_DRAIN = false;
  const u16* gb; u16* U;
  DI void operator()(const pg8::f32x4 (&acc)[2][2][4][2], const pg8::Unit& u, int wr, int wc, int fr, int fq) const {
    const int row0 = u.pm * 256 + wr * 64 + fr;
#pragma unroll
    for (int bj = 0; bj < 2; ++bj) {
      const int col0 = u.pn * 256 + bj * 128 + wc * 32 + 8 * fq;
#pragma unroll
      for (int ai = 0; ai < 2; ++ai)
#pragma unroll
        for (int m = 0; m < 4; ++m) {
          const size_t row = row0 + ai * 128 + m * 16;
          float gt[8];
          unpack8(*(const uint4*)(gb + row * 2048 + PASS * 1024 + col0), gt);
          pg8::f32x4 v0 = acc[ai][bj][m][0], v1 = acc[ai][bj][m][1];
#pragma unroll
          for (int e = 0; e < 4; ++e) { v0[e] *= sigm(gt[e]); v1[e] *= sigm(gt[4 + e]); }
          if (PASS == 1) {
            float pu[8];
            unpack8(*(const uint4*)(U + row * 1024 + col0), pu);
#pragma unroll
            for (int e = 0; e < 4; ++e) { v0[e] += pu[e]; v1[e] += pu[4 + e]; }
          }
          *(uint4*)(U + row * 1024 + col0) = pack8(v0, v1);
        }
    }
  }
};
struct EpiWo {
  static constexpr bool PERM = true, AFTER_DRAIN = false;
  const float *xp, *xs, *mod; float* out; int tok0;
  DI void operator()(const pg8::f32x4 (&acc)[2][2][4][2], const pg8::Unit& u, int wr, int wc, int fr, int fq) const {
    const int row0 = u.pm * 256 + wr * 64 + fr;
#pragma unroll
    for (int bj = 0; bj < 2; ++bj) {
      const int col0 = u.pn * 256 + bj * 128 + wc * 32 + 8 * fq;
#pragma unroll
      for (int ai = 0; ai < 2; ++ai)
#pragma unroll
        for (int m = 0; m < 4; ++m) {
          const int tok = tok0 + row0 + ai * 128 + m * 16;
          const float* xr = tok < 8192 ? xp + (size_t)tok * 1024 : xs + (size_t)(tok - 8192) * 1024;
          const float* gt = mod + mrow_of(tok) * 6144 + 2048 + col0;
          const pg8::f32x4 x0 = *(const pg8::f32x4*)(xr + col0), x1 = *(const pg8::f32x4*)(xr + col0 + 4);
          const pg8::f32x4 g0 = *(const pg8::f32x4*)gt, g1 = *(const pg8::f32x4*)(gt + 4);
          float* o = out + (size_t)tok * 1024 + col0;
          *(pg8::f32x4*)o = x0 + g0 * acc[ai][bj][m][0];
          *(pg8::f32x4*)(o + 4) = x1 + g1 * acc[ai][bj][m][1];
        }
    }
  }
};
struct EpiGU {
  static constexpr bool PERM = true, AFTER_DRAIN = false;
  u16* act;
  DI void operator()(const pg8::f32x4 (&acc)[2][2][4][2], const pg8::Unit& u, int wr, int wc, int fr, int fq) const {
    const int row0 = u.pm * 256 + wr * 64 + fr;
    const int col0 = u.pn * 128 + wc * 32 + 8 * fq;
#pragma unroll
    for (int ai = 0; ai < 2; ++ai)
#pragma unroll
      for (int m = 0; m < 4; ++m) {
        const size_t row = row0 + ai * 128 + m * 16;
        pg8::f32x4 v0, v1;
#pragma unroll
        for (int e = 0; e < 4; ++e) {
          v0[e] = siluf(acc[ai][0][m][0][e]) * acc[ai][1][m][0][e];
          v1[e] = siluf(acc[ai][0][m][1][e]) * acc[ai][1][m][1][e];
        }
        *(uint4*)(act + row * 2816 + col0) = pack8(v0, v1);
      }
  }
};
struct EpiDown {
  static constexpr bool PERM = true, AFTER_DRAIN = false;
  const float* mod; float* out;
  DI void operator()(const pg8::f32x4 (&acc)[2][2][4][2], const pg8::Unit& u, int wr, int wc, int fr, int fq) const {
    const int row0 = u.pm * 256 + wr * 64 + fr;
#pragma unroll
    for (int bj = 0; bj < 2; ++bj) {
      const int col0 = u.pn * 256 + bj * 128 + wc * 32 + 8 * fq;
#pragma unroll
      for (int ai = 0; ai < 2; ++ai)
#pragma unroll
        for (int m = 0; m < 4; ++m) {
          const int tok = row0 + ai * 128 + m * 16;
          const float* gt = mod + mrow_of(tok) * 6144 + 5120 + col0;
          const pg8::f32x4 g0 = *(const pg8::f32x4*)gt, g1 = *(const pg8::f32x4*)(gt + 4);
          float* o = out + (size_t)tok * 1024 + col0;
          const pg8::f32x4 x0 = *(const pg8::f32x4*)o, x1 = *(const pg8::f32x4*)(o + 4);
          *(pg8::f32x4*)o = x0 + g0 * acc[ai][bj][m][0];
          *(pg8::f32x4*)(o + 4) = x1 + g1 * acc[ai][bj][m][1];
        }
    }
  }
};
template <class Epi>
DI void run_gemm8(char* smem, const u16* A, const u16* Bt, int M, int N, int K, const Epi& E, int vb = -1, int nb = 0) {
  asm volatile("" : "+s"(M), "+s"(N), "+s"(K));
  pg8::Gemm gm{A, Bt, M, N, K};
  pg8::StaticOrder S;
  if (vb < 0) { vb = blockIdx.x; nb = gridDim.x; }
  S.init(M, N, nb, vb);
  pg8::gemm_phase<Epi, pg8::StaticOrder, false>((PG8_LAS unsigned char*)smem, gm, S, E, nullptr);
  __syncthreads();
}

struct EpiR2 {
  static constexpr bool PERM = true, AFTER_DRAIN = false;
  __half* wk; const float *w0, *a0;
  DI void operator()(const pg8::f32x4 (&acc)[2][2][4][2], const pg8::Unit& u, int wr, int wc, int fr, int fq) const {
    const int row0 = u.pm * 256 + wr * 64 + fr;
    const int sec = u.pn >> 2;
#pragma unroll
    for (int bj = 0; bj < 2; ++bj) {
      const int nn = (u.pn & 3) * 256 + bj * 128 + wc * 32 + 8 * fq;
      const int d = sec & 1;
      const float* bias = (sec < 2 ? w0 : a0) + d * 1024 + nn;
      const pg8::f32x4 b0 = *(const pg8::f32x4*)bias, b1 = *(const pg8::f32x4*)(bias + 4);
      const int field = (sec < 2 ? 4 : 5) + 2 * d;
#pragma unroll
      for (int ai = 0; ai < 2; ++ai)
#pragma unroll
        for (int m = 0; m < 4; ++m) {
          const size_t row = row0 + ai * 128 + m * 16;
          pg8::f32x4 v0 = acc[ai][bj][m][0] + b0, v1 = acc[ai][bj][m][1] + b1;
          float o[8];
#pragma unroll
          for (int e = 0; e < 4; ++e) {
            float s0 = sigm(v0[e]), s1 = sigm(v1[e]);
            o[e] = sec < 2 ? __expf(-0.6065306597f * s0) : s0;
            o[4 + e] = sec < 2 ? __expf(-0.6065306597f * s1) : s1;
          }
          __half2 h0 = __floats2half2_rn(o[0], o[1]), h1 = __floats2half2_rn(o[2], o[3]);
          __half2 h2 = __floats2half2_rn(o[4], o[5]), h3 = __floats2half2_rn(o[6], o[7]);
          uint4 pk;
          pk.x = *reinterpret_cast<unsigned*>(&h0); pk.y = *reinterpret_cast<unsigned*>(&h1);
          pk.z = *reinterpret_cast<unsigned*>(&h2); pk.w = *reinterpret_cast<unsigned*>(&h3);
          *(uint4*)(wk + ((row * 16 + (nn >> 6)) * 8 + field) * 64 + (nn & 63)) = pk;
        }
    }
  }
};

template <int MODE>
__device__ __forceinline__ void convT(const float* __restrict__ src, int K, int N, u16* __restrict__ dst, char* smem, int vb = -1, int nb = 0, int ldd = 0) {
  if (ldd == 0) ldd = K;
  float* tile = (float*)smem;
  const int tid = get_tid();
  const int KT = K >> 6, NT = N >> 6;
  if (vb < 0) { vb = blockIdx.x; nb = gridDim.x; }
  for (int t = vb; t < KT * NT; t += nb) {
    int kt = t % KT, nt = t / KT;
#pragma unroll
    for (int i = 0; i < 2; ++i) {
      int idx = tid + i * 512;
      int r = idx >> 4, c4 = idx & 15;
      *(float4*)(tile + r * 68 + c4 * 4) = *(const float4*)(src + (size_t)(kt * 64 + r) * N + nt * 64 + c4 * 4);
    }
    __syncthreads();
    int n = tid >> 3, kc = tid & 7;
    unsigned w[4];
#pragma unroll
    for (int j = 0; j < 4; ++j)
      w[j] = pack2(tile[(kc * 8 + 2 * j) * 68 + n], tile[(kc * 8 + 2 * j + 1) * 68 + n]);
    int ng = nt * 64 + n;
    int row = ng;
    if (MODE == 1) {
      int isu = ng >= 2816;
      int nn = ng - isu * 2816;
      row = (nn >> 7) * 256 + isu * 128 + (nn & 127);
    }
    *(uint4*)(dst + (size_t)row * ldd + kt * 64 + kc * 8) = uint4{w[0], w[1], w[2], w[3]};
    __syncthreads();
  }
}

__device__ __forceinline__ void step_prep(const Params& p, char* smem) {
  const int tid = get_tid();
  char* ws = p.ws;
  {
    float* red = (float*)smem;
    float* mod = (float*)(ws + OFF_MOD);
    for (int item = blockIdx.x; item < 192; item += gridDim.x) {
      int c4 = tid & 7, kl = tid >> 3;
      float acc[12];
#pragma unroll
      for (int i = 0; i < 12; ++i) acc[i] = 0.f;
      for (int k = kl; k < 1024; k += 64) {
        float4 w = *(const float4*)(p.w_ada + (size_t)k * 6144 + item * 32 + c4 * 4);
        float s0 = siluf(p.c_ctx[k]), s1 = siluf(p.c[k]), s2 = siluf(p.c[1024 + k]);
        acc[0] += s0 * w.x; acc[1] += s0 * w.y; acc[2] += s0 * w.z; acc[3] += s0 * w.w;
        acc[4] += s1 * w.x; acc[5] += s1 * w.y; acc[6] += s1 * w.z; acc[7] += s1 * w.w;
        acc[8] += s2 * w.x; acc[9] += s2 * w.y; acc[10] += s2 * w.z; acc[11] += s2 * w.w;
      }
#pragma unroll
      for (int i = 0; i < 12; ++i) red[(kl * 8 + c4) * 12 + i] = acc[i];
      __syncthreads();
      if (tid < 96) {
        int cond = tid >> 5, col = tid & 31;
        int cc4 = col >> 2, e = col & 3;
        float s = 0.f;
        for (int k = 0; k < 64; ++k) s += red[(k * 8 + cc4) * 12 + cond * 4 + e];
        int n = item * 32 + col;
        mod[cond * 6144 + n] = s + p.b_ada[n];
      }
      __syncthreads();
    }
  }
  convT<0>(p.w_in, 1024, 10688, (u16*)(ws + OFF_WIN), smem);
  convT<0>(p.w_m_out, 2048, 1024, (u16*)(ws + OFF_WMOUT), smem);
  convT<0>(p.w_r_out, 1024, 1024, (u16*)(ws + OFF_WROUT), smem);
  convT<0>(p.w_o, 1024, 1024, (u16*)(ws + OFF_WO), smem);
  convT<0>(p.w2, 64, 1024, (u16*)(ws + OFF_W2T), smem);
  convT<0>(p.w2 + 65536, 64, 1024, (u16*)(ws + OFF_W2T) + 65536, smem);
  convT<0>(p.a2, 64, 1024, (u16*)(ws + OFF_A2T), smem);
  convT<0>(p.a2 + 65536, 64, 1024, (u16*)(ws + OFF_A2T) + 65536, smem);
  convT<0>(p.g2, 128, 1024, (u16*)(ws + OFF_G2T), smem);
  {
    u16* w4 = (u16*)(ws + OFF_W4T);
    convT<0>(p.w2, 64, 1024, w4 + (size_t)0 * 1024 * 256 + 0, smem, -1, 0, 256);
    convT<0>(p.w2 + 65536, 64, 1024, w4 + (size_t)1 * 1024 * 256 + 64, smem, -1, 0, 256);
    convT<0>(p.a2, 64, 1024, w4 + (size_t)2 * 1024 * 256 + 128, smem, -1, 0, 256);
    convT<0>(p.a2 + 65536, 64, 1024, w4 + (size_t)3 * 1024 * 256 + 192, smem, -1, 0, 256);
    for (int i = blockIdx.x * NTHR + tid; i < 4096 * 32; i += gridDim.x * NTHR) {
      int row = i >> 5, c = i & 31;
      if ((c >> 3) != (row >> 10)) *(uint4*)(w4 + (size_t)row * 256 + c * 8) = uint4{0, 0, 0, 0};
    }
  }
  {
    uint4* z = (uint4*)(ws + OFF_WIN + (size_t)10688 * 1024 * 2);
    for (int i = blockIdx.x * NTHR + tid; i < 8192; i += gridDim.x * NTHR) z[i] = uint4{0, 0, 0, 0};
  }
}

template <int WHICH>
__device__ __forceinline__ void step_norm(const Params& p, int g) {
  const int tid = get_tid(), lane = tid & 63, wave = tid >> 6;
  const float* mod = (const float*)(p.ws + OFF_MOD);
  const int nrows = WHICH == 0 ? TG : NTOK;
  u16* dst = WHICH == 0 ? (u16*)((char*)p.out + H1_OUT_OFF) : (u16*)(p.ws + OFF_H2);
  const float* nw = WHICH == 0 ? p.norm1_w : p.norm2_w;
  for (int r = blockIdx.x * 8 + wave; r < nrows; r += gridDim.x * 8) {
    int tok = WHICH == 0 ? g * TG + r : r;
    const float* xr;
    if (WHICH == 0) xr = tok < 8192 ? p.x_prompt + (size_t)tok * 1024 : p.x_sample + (size_t)(tok - 8192) * 1024;
    else xr = (const float*)(p.ws + OFF_X1) + (size_t)tok * 1024;
    const float* mr = mod + mrow_of(tok) * 6144 + (WHICH == 0 ? 0 : 3072);
    float4 v[4];
    float ss = 0.f;
#pragma unroll
    for (int i = 0; i < 4; ++i) {
      v[i] = ((const float4*)xr)[i * 64 + lane];
      ss += v[i].x * v[i].x + v[i].y * v[i].y + v[i].z * v[i].z + v[i].w * v[i].w;
    }
    ss = wave_sum(ss);
    float rinv = rsqrtf(ss * (1.f / 1024.f) + 1e-6f);
#pragma unroll
    for (int i = 0; i < 4; ++i) {
      int col = (i * 64 + lane) * 4;
      float4 w4 = *(const float4*)(nw + col);
      float4 sh = *(const float4*)(mr + col);
      float4 sc = *(const float4*)(mr + 1024 + col);
      float h0 = v[i].x * rinv * w4.x * (1.f + sc.x) + sh.x;
      float h1 = v[i].y * rinv * w4.y * (1.f + sc.y) + sh.y;
      float h2 = v[i].z * rinv * w4.z * (1.f + sc.z) + sh.z;
      float h3 = v[i].w * rinv * w4.w * (1.f + sc.w) + sh.w;
      *(uint2*)(dst + (size_t)r * 1024 + col) = uint2{pack2(h0, h1), pack2(h2, h3)};
    }
  }
}

__device__ __forceinline__ void step_gemm1(const Params& p, char* smem, int part) {
  char* ws = p.ws;
  const u16* H1 = (const u16*)((const char*)p.out + H1_OUT_OFF);
  const u16* W = (const u16*)(ws + OFF_WIN);
  if (part == 0) {
    EpiP E{(u16*)(ws + OFF_Z), (u16*)(ws + OFF_XBCRAW), (u16*)(ws + OFF_RW), (u16*)(ws + OFF_GATE), (float*)(ws + OFF_DT), 0};
    run_gemm8(smem, H1, W, TG, NPAD, 1024, E);
  } else if (part == 1) {
    EpiP E{(u16*)(ws + OFF_Z), (u16*)(ws + OFF_XBCRAW), (u16*)(ws + OFF_RW), (u16*)(ws + OFF_GATE), (float*)(ws + OFF_DT), 0};
    run_gemm8(smem, H1, W, TG, 5120, 1024, E, (int)blockIdx.x - 64, (int)gridDim.x - 64);
  } else {
    EpiP E{(u16*)(ws + OFF_Z), (u16*)(ws + OFF_XBCRAW), (u16*)(ws + OFF_RW), (u16*)(ws + OFF_GATE), (float*)(ws + OFF_DT), 5120};
    run_gemm8(smem, H1, W + (size_t)5120 * 1024, TG, NPAD - 5120, 1024, E);
  }
}

__device__ __forceinline__ void step_cr1(const Params& p, int g) {
  char* ws = p.ws;
  const int tid = get_tid(), lane = tid & 63, wave = tid >> 6;
  const int Ls = g < 2 ? 256 : 2048;
  {
    const u16* __restrict__ xr = (const u16*)(ws + OFF_XBCRAW);
    u16* __restrict__ xo = (u16*)(ws + OFF_XBC);
    for (int item = blockIdx.x * NTHR + tid; item < (TG / 8) * 384; item += gridDim.x * NTHR) {
      const int rb = item / 384, cc = item - rb * 384;
      const int r0 = rb * 8, pos0 = r0 & (Ls - 1);
      uint4 rows[12];
#pragma unroll
      for (int i = 0; i < 12; ++i) {
        const int pp = pos0 + i - 2;
        rows[i] = uint4{0, 0, 0, 0};
        if (pp >= 0 && pp < Ls) rows[i] = *(const uint4*)(xr + (size_t)(r0 + i - 2) * 3072 + cc * 8);
      }
      float w[5][8], bias[8];
      {
        float4 b0 = *(const float4*)(p.conv_b + cc * 8), b1 = *(const float4*)(p.conv_b + cc * 8 + 4);
        bias[0] = b0.x; bias[1] = b0.y; bias[2] = b0.z; bias[3] = b0.w; bias[4] = b1.x; bias[5] = b1.y; bias[6] = b1.z; bias[7] = b1.w;
#pragma unroll
        for (int i = 0; i < 5; ++i) {
          float4 w0 = *(const float4*)(p.conv_w + i * 3072 + cc * 8), w1 = *(const float4*)(p.conv_w + i * 3072 + cc * 8 + 4);
          w[i][0] = w0.x; w[i][1] = w0.y; w[i][2] = w0.z; w[i][3] = w0.w; w[i][4] = w1.x; w[i][5] = w1.y; w[i][6] = w1.z; w[i][7] = w1.w;
        }
      }
      float s[8][8];
#pragma unroll
      for (int o = 0; o < 8; ++o)
#pragma unroll
        for (int e = 0; e < 8; ++e) s[o][e] = bias[e];
#pragma unroll
      for (int i = 0; i < 12; ++i) {
        float xv[8];
        unpack8(rows[i], xv);
#pragma unroll
        for (int k = 0; k < 5; ++k) {
          const int o = i - k;
          if (o >= 0 && o < 8) {
#pragma unroll
            for (int e = 0; e < 8; ++e) s[o][e] += xv[e] * w[k][e];
          }
        }
      }
#pragma unroll
      for (int o = 0; o < 8; ++o) {
#pragma unroll
        for (int e = 0; e < 8; ++e) s[o][e] = siluf(s[o][e]);
        *(uint4*)(xo + (size_t)(r0 + o) * 3072 + cc * 8) = uint4{pack2(s[o][0], s[o][1]), pack2(s[o][2], s[o][3]), pack2(s[o][4], s[o][5]), pack2(s[o][6], s[o][7])};
      }
    }
  }
  {
    const u16* __restrict__ rw = (const u16*)(ws + OFF_RW);
    __half* __restrict__ wk = (__half*)(ws + OFF_WK);
    u16* __restrict__ tl = (u16*)(ws + OFF_TL);
    u16* __restrict__ sg = (u16*)(ws + OFF_SG);
    const bool grid = (g == 2);
    for (int r = blockIdx.x * 8 + wave; r < TG; r += gridDim.x * 8) {
      const int pos = r & (Ls - 1);
      uint4 cur[7], shv[7];
#pragma unroll
      for (int it = 0; it < 7; ++it) {
        const int ci = it * 64 + lane;
        cur[it] = uint4{0, 0, 0, 0};
        shv[it] = uint4{0, 0, 0, 0};
        if (ci < 432) {
          const int q = ci / 108;
          int dr;
          bool ok;
          if (!grid) {
            if (q & 1) { dr = 1; ok = pos < Ls - 1; } else { dr = -1; ok = pos > 0; }
          } else {
            if (q == 0) { dr = -1; ok = (pos & 63) != 0; }
            else if (q == 1) { dr = 1; ok = (pos & 63) != 63; }
            else if (q == 2) { dr = -64; ok = pos >= 64; }
            else { dr = 64; ok = pos < Ls - 64; }
          }
          cur[it] = *(const uint4*)(rw + (size_t)r * 3456 + ci * 8);
          if (ok) shv[it] = *(const uint4*)(rw + (size_t)(r + dr) * 3456 + ci * 8);
        }
      }
#pragma unroll
      for (int it = 0; it < 7; ++it) {
        const int ci = it * 64 + lane;
        const bool valid = ci < 432;
        float xx[8];
        {
          float cf[8], sf[8];
          unpack8(cur[it], cf);
          unpack8(shv[it], sf);
          const int cm = valid ? ci * 8 : 0;
          const float4 m0 = *(const float4*)(p.mu_shift + cm), m1 = *(const float4*)(p.mu_shift + cm + 4);
          const float mu[8] = {m0.x, m0.y, m0.z, m0.w, m1.x, m1.y, m1.z, m1.w};
#pragma unroll
          for (int e = 0; e < 8; ++e) xx[e] = cf[e] + mu[e] * (sf[e] - cf[e]);
        }
        const bool isk = valid && ci >= 144 && ci < 272;
        float kk[8];
        float ss = 0.f;
        {
          const int kc = isk ? ci - 144 : 0;
          const float4 k0 = *(const float4*)(p.k_k + kc * 8), k1 = *(const float4*)(p.k_k + kc * 8 + 4);
          const float kkw[8] = {k0.x, k0.y, k0.z, k0.w, k1.x, k1.y, k1.z, k1.w};
#pragma unroll
          for (int e = 0; e < 8; ++e) { kk[e] = xx[e] * kkw[e]; ss += kk[e] * kk[e]; }
        }
        ss += dpp_xor1(ss);
        ss += dpp_xor2(ss);
        ss += dpp_hmirror(ss);
        if (valid) {
          if (ci < 128) {
            __half2 h0 = __floats2half2_rn(xx[0], xx[1]), h1 = __floats2half2_rn(xx[2], xx[3]), h2 = __floats2half2_rn(xx[4], xx[5]), h3 = __floats2half2_rn(xx[6], xx[7]);
            uint4 pk{*reinterpret_cast<unsigned*>(&h0), *reinterpret_cast<unsigned*>(&h1), *reinterpret_cast<unsigned*>(&h2), *reinterpret_cast<unsigned*>(&h3)};
            *(uint4*)(wk + ((size_t)(r * 16 + (ci >> 3)) * 8 + 0) * 64 + (ci & 7) * 8) = pk;
          } else if (ci < 144) {
            float t[8];
#pragma unroll
            for (int e = 0; e < 8; ++e) t[e] = tanhf(xx[e]);
            *(uint4*)(tl + (size_t)r * 256 + (ci - 128) * 8) = uint4{pack2(t[0], t[1]), pack2(t[2], t[3]), pack2(t[4], t[5]), pack2(t[6], t[7])};
          } else if (ci < 272) {
            const int kc = ci - 144;
            const float rn = -rsqrtf(ss + 1e-12f);
            __half2 h0 = __floats2half2_rn(xx[0], xx[1]), h1 = __floats2half2_rn(xx[2], xx[3]), h2 = __floats2half2_rn(xx[4], xx[5]), h3 = __floats2half2_rn(xx[6], xx[7]);
            uint4 pk{*reinterpret_cast<unsigned*>(&h0), *reinterpret_cast<unsigned*>(&h1), *reinterpret_cast<unsigned*>(&h2), *reinterpret_cast<unsigned*>(&h3)};
            *(uint4*)(wk + ((size_t)(r * 16 + (kc >> 3)) * 8 + 2) * 64 + (kc & 7) * 8) = pk;
            __half2 n0 = __floats2half2_rn(kk[0] * rn, kk[1] * rn), n1 = __floats2half2_rn(kk[2] * rn, kk[3] * rn), n2 = __floats2half2_rn(kk[4] * rn, kk[5] * rn), n3 = __floats2half2_rn(kk[6] * rn, kk[7] * rn);
            uint4 pn{*reinterpret_cast<unsigned*>(&n0), *reinterpret_cast<unsigned*>(&n1), *reinterpret_cast<unsigned*>(&n2), *reinterpret_cast<unsigned*>(&n3)};
            *(uint4*)(wk + ((size_t)(r * 16 + (kc >> 3)) * 8 + 3) * 64 + (kc & 7) * 8) = pn;
          } else if (ci < 400) {
            const int vc = ci - 272;
            __half2 h0 = __floats2half2_rn(xx[0], xx[1]), h1 = __floats2half2_rn(xx[2], xx[3]), h2 = __floats2half2_rn(xx[4], xx[5]), h3 = __floats2half2_rn(xx[6], xx[7]);
            uint4 pk{*reinterpret_cast<unsigned*>(&h0), *reinterpret_cast<unsigned*>(&h1), *reinterpret_cast<unsigned*>(&h2), *reinterpret_cast<unsigned*>(&h3)};
            *(uint4*)(wk + ((size_t)(r * 16 + (vc >> 3)) * 8 + 1) * 64 + (vc & 7) * 8) = pk;
          } else if (ci < 416) {
            *(uint4*)(tl + (size_t)r * 256 + 128 + (ci - 400) * 8) = uint4{pack2(xx[0], xx[1]), pack2(xx[2], xx[3]), pack2(xx[4], xx[5]), pack2(xx[6], xx[7])};
          } else {
            float t[8];
#pragma unroll
            for (int e = 0; e < 8; ++e) t[e] = sigm(xx[e]);
            *(uint4*)(sg + (size_t)r * 128 + (ci - 416) * 8) = uint4{pack2(t[0], t[1]), pack2(t[2], t[3]), pack2(t[4], t[5]), pack2(t[6], t[7])};
          }
        }
      }
    }
  }
}

__device__ __forceinline__ void step_r2(const Params& p, char* smem) {
  char* ws = p.ws;
  const int tid = get_tid(), lane = tid & 63, wave = tid >> 6;
  const int wm = wave >> 1, wn = wave & 1;
  const u16* tl = (const u16*)(ws + OFF_TL);
  const u16* sg = (const u16*)(ws + OFF_SG);
  __half* wk = (__half*)(ws + OFF_WK);
  u16* gr = (u16*)(ws + OFF_GR);
  {
    EpiR2 E{wk, p.w0, p.a0};
    run_gemm8(smem, tl, (const u16*)(ws + OFF_W4T), TG, 4096, 256, E);
  }
  for (int t = (gridDim.x - 1 - blockIdx.x) + 4 * 128; t < 5 * 128; t += gridDim.x) {
    int sub = t >> 7, rem = t & 127;
    int mt = rem & 15, nt = rem >> 4;
    f32x4 acc[4][4];
    zero_acc(acc);
    if (sub < 2) {
      gemm_acc(tl + (size_t)mt * 256 * 256 + sub * 64, 256, (const u16*)(ws + OFF_W2T) + sub * 65536 + (size_t)nt * 128 * 64, 64, 64, acc, smem);
    } else if (sub < 4) {
      gemm_acc(tl + (size_t)mt * 256 * 256 + 128 + (sub - 2) * 64, 256, (const u16*)(ws + OFF_A2T) + (sub - 2) * 65536 + (size_t)nt * 128 * 64, 64, 64, acc, smem);
    } else {
      gemm_acc(sg + (size_t)mt * 256 * 128, 128, (const u16*)(ws + OFF_G2T) + (size_t)nt * 128 * 128, 128, 128, acc, smem);
    }
#pragma unroll
    for (int mf = 0; mf < 4; ++mf)
#pragma unroll
      for (int nf = 0; nf < 4; ++nf)
#pragma unroll
        for (int j = 0; j < 4; ++j) {
          if (nf == 0 && j == 0) asm volatile("" ::: "memory");
          int m = mt * 256 + wm * 64 + mf * 16 + (lane >> 4) * 4 + j;
          int n = nt * 128 + wn * 64 + nf * 16 + (lane & 15);
          float v = acc[mf][nf][j];
          if (sub < 2) {
            float wl = v + p.w0[sub * 1024 + n];
            float dec = __expf(-0.6065306597f * sigm(wl));
            wk[((size_t)(m * 16 + (n >> 6)) * 8 + 4 + 2 * sub) * 64 + (n & 63)] = __float2half(dec);
          } else if (sub < 4) {
            int d = sub - 2;
            float a = sigm(v + p.a0[d * 1024 + n]);
            wk[((size_t)(m * 16 + (n >> 6)) * 8 + 5 + 2 * d) * 64 + (n & 63)] = __float2half(a);
          } else {
            gr[(size_t)m * 1024 + n] = f2bf(v);
          }
        }
  }
}

DI int swz16(int row) { return (row ^ (row >> 3)) & 15; }
DI int sw256(int row, int e) { return row * 256 + ((((e >> 3) ^ swz16(row))) << 4) + (e & 7) * 2; }
DI const bf16x8 ldfrag256(const char* base, int row, int ch) {
  return *(const bf16x8*)(base + row * 256 + ((ch ^ swz16(row)) << 4));
}

typedef unsigned v4u __attribute__((ext_vector_type(4)));
struct SsdPre { v4u c0, c1, c2, c3, b0, b1, b2, b3, x0, x1; float d0, d1; };
DI void ssd_issue(const Params& p, int g, int chain, int ci, int tid, SsdPre& R) {
  const int Ls = g < 2 ? 256 : 2048;
  const int nch = Ls >> 7;
  const int d = chain & 1, h = (chain >> 1) & 31, b = chain >> 6;
  const int grp = h >> 3;
  const int c = d ? nch - 1 - ci : ci;
  const int tok0 = b * Ls + c * 128;
  const u16* xbc = (const u16*)(p.ws + OFF_XBC);
  const float* dtb = (const float*)(p.ws + OFF_DT);
  const int lane = tid & 63, wave = tid >> 6;
#define SSD_LDCB(i, CF, BF) { int idx = tid + i * 512; int row = idx >> 4, ch = idx & 15; \
    const u16* src = xbc + (size_t)(tok0 + row) * 3072 + grp * 128 + ch * 8; R.CF = *(const v4u*)(src + 2560); R.BF = *(const v4u*)(src + 2048); }
  SSD_LDCB(0, c0, b0) SSD_LDCB(1, c1, b1) SSD_LDCB(2, c2, b2) SSD_LDCB(3, c3, b3)
#undef SSD_LDCB
#define SSD_LDX(i, XF) { int idx = tid + i * 512; int l = idx >> 3, ch = idx & 7; R.XF = *(const v4u*)(xbc + (size_t)(tok0 + l) * 3072 + h * 64 + ch * 8); }
  SSD_LDX(0, x0) SSD_LDX(1, x1)
#undef SSD_LDX
  if (wave == 0) {
    int e0 = 2 * lane, e1 = 2 * lane + 1;
    int l0 = d ? 127 - e0 : e0, l1 = d ? 127 - e1 : e1;
    R.d0 = dtb[(size_t)(tok0 + l0) * 64 + d * 32 + h];
    R.d1 = dtb[(size_t)(tok0 + l1) * 64 + d * 32 + h];
  }
}

__device__ __forceinline__ void ssd_chain(const Params& p, char* smem, int g, int chain, int next_chain, SsdPre& R) {
  char* ws = p.ws;
  const int tid = get_tid(), lane = tid & 63, wave = tid >> 6;
  const int Ls = g < 2 ? 256 : 2048;
  const int nch = Ls >> 7;
  const int d = chain & 1, h = (chain >> 1) & 31, b = chain >> 6;
  const int grp = h >> 3;
  const u16* xbc = (const u16*)(ws + OFF_XBC);
  const float* dtb = (const float*)(ws + OFF_DT);
  u16* yout = (u16*)(ws + (d ? OFF_SYB : OFF_SYF));
  char* Cs = smem;
  char* Bs = smem + 32768;
  char* BdT = smem + 65536;
  char* XT = smem + 98304;
  char* Ss = smem + 114688;
  float* csum = (float*)(smem + 131072);
  float* dts = (float*)(smem + 131584);
  const float a_h = -__expf(p.a_log[d * 32 + h]);
  const float dtbias = p.dt_bias[d * 32 + h];
  f32x4 sacc[2][2];
  {
    const int wn4 = wave >> 1, wp2 = wave & 1;
#pragma unroll
    for (int nf = 0; nf < 2; ++nf)
#pragma unroll
      for (int pf = 0; pf < 2; ++pf) {
        if (g == 2) {
          const float* h0 = (d ? p.ssm_b : p.ssm_f) + (size_t)(b * 32 + h) * 8192;
          const int n0 = wn4 * 32 + nf * 16 + (lane >> 4) * 4, pp = wp2 * 32 + pf * 16 + (lane & 15);
          const float4 t = *(const float4*)(h0 + pp * 128 + n0);
          sacc[nf][pf] = f32x4{t.x, t.y, t.z, t.w};
        } else {
          sacc[nf][pf] = f32x4{0.f, 0.f, 0.f, 0.f};
        }
      }
  }
  const int tid_outer = tid;
  for (int ci = 0; ci < nch; ++ci) {
    int tidv = tid_outer;
    asm volatile("" : "+v"(tidv));
    const int tid = tidv, lane = tidv & 63, wave = tidv >> 6;
    const int wq4 = wave >> 1, wq2 = wave & 1;
    const int c = d ? nch - 1 - ci : ci;
    const int tok0 = b * Ls + c * 128;
#define SSD_STCB(i, CF, BF) { int idx = tid + i * 512; int row = idx >> 4, ch = idx & 15; \
      *(v4u*)(Cs + row * 256 + ((ch ^ swz16(row)) << 4)) = R.CF; *(v4u*)(Bs + row * 256 + ((ch ^ swz16(row)) << 4)) = R.BF; }
    SSD_STCB(0, c0, b0) SSD_STCB(1, c1, b1) SSD_STCB(2, c2, b2) SSD_STCB(3, c3, b3)
#undef SSD_STCB
#define SSD_STX(i, XF) { int idx = tid + i * 512; int l = idx >> 3, ch = idx & 7; \
      const unsigned w0 = R.XF[0], w1 = R.XF[1], w2 = R.XF[2], w3 = R.XF[3]; \
      *(u16*)(XT + sw256(ch * 8 + 0, l)) = (u16)(w0 & 0xffff); *(u16*)(XT + sw256(ch * 8 + 1, l)) = (u16)(w0 >> 16); \
      *(u16*)(XT + sw256(ch * 8 + 2, l)) = (u16)(w1 & 0xffff); *(u16*)(XT + sw256(ch * 8 + 3, l)) = (u16)(w1 >> 16); \
      *(u16*)(XT + sw256(ch * 8 + 4, l)) = (u16)(w2 & 0xffff); *(u16*)(XT + sw256(ch * 8 + 5, l)) = (u16)(w2 >> 16); \
      *(u16*)(XT + sw256(ch * 8 + 6, l)) = (u16)(w3 & 0xffff); *(u16*)(XT + sw256(ch * 8 + 7, l)) = (u16)(w3 >> 16); }
    SSD_STX(0, x0) SSD_STX(1, x1)
#undef SSD_STX
    if (wave == 0) {
      int e0 = 2 * lane, e1 = 2 * lane + 1;
      int l0 = d ? 127 - e0 : e0, l1 = d ? 127 - e1 : e1;
      float x0 = R.d0 + dtbias;
      float x1 = R.d1 + dtbias;
      float dt0 = x0 > 20.f ? x0 : log1pf(__expf(x0));
      float dt1 = x1 > 20.f ? x1 : log1pf(__expf(x1));
      float a0 = dt0 * a_h, a1 = dt1 * a_h;
      float s = a0 + a1;
#pragma unroll
      for (int o = 1; o < 64; o <<= 1) {
        float t = __shfl_up(s, o);
        if (lane >= o) s += t;
      }
      csum[l1] = s;
      csum[l0] = s - a1;
      dts[l0] = dt0;
      dts[l1] = dt1;
    }
    if (ci + 1 < nch) ssd_issue(p, g, chain, ci + 1, tid, R);
    else if (next_chain >= 0) ssd_issue(p, g, next_chain, 0, tid, R);
#pragma unroll
    for (int nf = 0; nf < 2; ++nf)
#pragma unroll
      for (int pf = 0; pf < 2; ++pf) {
        const int n0 = wq4 * 32 + nf * 16 + (lane >> 4) * 4, pp = wq2 * 32 + pf * 16 + (lane & 15);
        *(uint2*)(Ss + sw256(pp, n0)) = uint2{pack2(sacc[nf][pf][0], sacc[nf][pf][1]), pack2(sacc[nf][pf][2], sacc[nf][pf][3])};
      }
    __syncthreads();
    const float cstot = csum[d ? 0 : 127];
#pragma unroll
    for (int i = 0; i < 4; ++i) {
      int idx = tid + i * 512;
      int l = idx >> 4, ch = idx & 15;
      uint4 bv = *(const uint4*)(Bs + l * 256 + ((ch ^ swz16(l)) << 4));
      float f = dts[l] * __expf(cstot - csum[l]);
      unsigned w[4] = {bv.x, bv.y, bv.z, bv.w};
#pragma unroll
      for (int e = 0; e < 8; ++e) {
        int n = ch * 8 + e;
        float val = bf2f((u16)((w[e >> 1] >> ((e & 1) * 16)) & 0xffff)) * f;
        *(u16*)(BdT + sw256(n, l)) = f2bf(val);
      }
    }
    f32x4 gacc[2][4];
#pragma unroll
    for (int i = 0; i < 2; ++i)
#pragma unroll
      for (int j = 0; j < 4; ++j) gacc[i][j] = f32x4{0.f, 0.f, 0.f, 0.f};
#pragma unroll
    for (int ks = 0; ks < 4; ++ks) {
      int ch = ks * 4 + (lane >> 4);
      bf16x8 a[2], bb[4];
#pragma unroll
      for (int sf = 0; sf < 2; ++sf) a[sf] = ldfrag256(Bs, wq4 * 32 + sf * 16 + (lane & 15), ch);
#pragma unroll
      for (int lf = 0; lf < 4; ++lf) bb[lf] = ldfrag256(Cs, wq2 * 64 + lf * 16 + (lane & 15), ch);
#pragma unroll
      for (int sf = 0; sf < 2; ++sf)
#pragma unroll
        for (int lf = 0; lf < 4; ++lf)
          gacc[sf][lf] = __builtin_amdgcn_mfma_f32_16x16x32_bf16(a[sf], bb[lf], gacc[sf][lf], 0, 0, 0);
    }
    {
      float css[2][4], dss[2][4];
#pragma unroll
      for (int sf = 0; sf < 2; ++sf)
#pragma unroll
        for (int j = 0; j < 4; ++j) {
          const int sI = wq4 * 32 + sf * 16 + (lane >> 4) * 4 + j;
          css[sf][j] = csum[sI];
          dss[sf][j] = dts[sI];
        }
#pragma unroll
      for (int lf = 0; lf < 4; ++lf) {
        const int l = wq2 * 64 + lf * 16 + (lane & 15);
        const float csl = csum[l];
#pragma unroll
        for (int sf = 0; sf < 2; ++sf)
#pragma unroll
          for (int j = 0; j < 4; ++j) {
            const int sI = wq4 * 32 + sf * 16 + (lane >> 4) * 4 + j;
            const bool valid = d ? (sI >= l) : (sI <= l);
            const float e = valid ? __expf(csl - css[sf][j]) * dss[sf][j] : 0.f;
            gacc[sf][lf][j] *= e;
          }
      }
    }
    __syncthreads();
#pragma unroll
    for (int sf = 0; sf < 2; ++sf)
#pragma unroll
      for (int lf = 0; lf < 4; ++lf) {
        const int s0 = wq4 * 32 + sf * 16 + (lane >> 4) * 4, l = wq2 * 64 + lf * 16 + (lane & 15);
        *(uint2*)(Bs + sw256(l, s0)) = uint2{pack2(gacc[sf][lf][0], gacc[sf][lf][1]), pack2(gacc[sf][lf][2], gacc[sf][lf][3])};
      }
    __syncthreads();
    {
      f32x4 yacc[2][2];
#pragma unroll
      for (int i = 0; i < 2; ++i)
#pragma unroll
        for (int j = 0; j < 2; ++j) yacc[i][j] = f32x4{0.f, 0.f, 0.f, 0.f};
#pragma unroll
      for (int ks = 0; ks < 4; ++ks) {
        int ch = ks * 4 + (lane >> 4);
        bf16x8 a[2], bb[2];
#pragma unroll
        for (int pf = 0; pf < 2; ++pf) a[pf] = ldfrag256(Ss, wq2 * 32 + pf * 16 + (lane & 15), ch);
#pragma unroll
        for (int lf = 0; lf < 2; ++lf) bb[lf] = ldfrag256(Cs, wq4 * 32 + lf * 16 + (lane & 15), ch);
#pragma unroll
        for (int pf = 0; pf < 2; ++pf)
#pragma unroll
          for (int lf = 0; lf < 2; ++lf)
            yacc[pf][lf] = __builtin_amdgcn_mfma_f32_16x16x32_bf16(a[pf], bb[lf], yacc[pf][lf], 0, 0, 0);
      }
#pragma unroll
      for (int lf = 0; lf < 2; ++lf) {
        const float e = __expf(csum[wq4 * 32 + lf * 16 + (lane & 15)]);
#pragma unroll
        for (int pf = 0; pf < 2; ++pf) yacc[pf][lf] *= e;
      }
#pragma unroll
      for (int ks = 0; ks < 4; ++ks) {
        int ch = ks * 4 + (lane >> 4);
        bf16x8 a[2], bb[2];
#pragma unroll
        for (int pf = 0; pf < 2; ++pf) a[pf] = ldfrag256(XT, wq2 * 32 + pf * 16 + (lane & 15), ch);
#pragma unroll
        for (int lf = 0; lf < 2; ++lf) bb[lf] = ldfrag256(Bs, wq4 * 32 + lf * 16 + (lane & 15), ch);
#pragma unroll
        for (int pf = 0; pf < 2; ++pf)
#pragma unroll
          for (int lf = 0; lf < 2; ++lf)
            yacc[pf][lf] = __builtin_amdgcn_mfma_f32_16x16x32_bf16(a[pf], bb[lf], yacc[pf][lf], 0, 0, 0);
      }
#pragma unroll
      for (int pf = 0; pf < 2; ++pf)
#pragma unroll
        for (int lf = 0; lf < 2; ++lf) {
          const int p0 = wq2 * 32 + pf * 16 + (lane >> 4) * 4, l = wq4 * 32 + lf * 16 + (lane & 15);
          *(uint2*)(yout + (size_t)(tok0 + l) * 2048 + h * 64 + p0) = uint2{pack2(yacc[pf][lf][0], yacc[pf][lf][1]), pack2(yacc[pf][lf][2], yacc[pf][lf][3])};
        }
    }
    {
      float e = __expf(cstot);
#pragma unroll
      for (int nf = 0; nf < 2; ++nf)
#pragma unroll
        for (int pf = 0; pf < 2; ++pf) sacc[nf][pf] *= e;
#pragma unroll
      for (int ks = 0; ks < 4; ++ks) {
        int ch = ks * 4 + (lane >> 4);
        bf16x8 a[2], bb[2];
#pragma unroll
        for (int nf = 0; nf < 2; ++nf) a[nf] = ldfrag256(BdT, wq4 * 32 + nf * 16 + (lane & 15), ch);
#pragma unroll
        for (int pf = 0; pf < 2; ++pf) bb[pf] = ldfrag256(XT, wq2 * 32 + pf * 16 + (lane & 15), ch);
#pragma unroll
        for (int nf = 0; nf < 2; ++nf)
#pragma unroll
          for (int pf = 0; pf < 2; ++pf)
            sacc[nf][pf] = __builtin_amdgcn_mfma_f32_16x16x32_bf16(a[nf], bb[pf], sacc[nf][pf], 0, 0, 0);
      }
    }
    __syncthreads();
  }
  if (g < 2) {
    float* so = p.out + (d ? OUT_SSMB : OUT_SSMF) + (size_t)((g * 16 + b) * 32 + h) * 8192;
    const int wn4 = wave >> 1, wp2 = wave & 1;
#pragma unroll
    for (int nf = 0; nf < 2; ++nf)
#pragma unroll
      for (int pf = 0; pf < 2; ++pf) {
        const int n0 = wn4 * 32 + nf * 16 + (lane >> 4) * 4, pp = wp2 * 32 + pf * 16 + (lane & 15);
        *(float4*)(so + pp * 128 + n0) = float4{sacc[nf][pf][0], sacc[nf][pf][1], sacc[nf][pf][2], sacc[nf][pf][3]};
      }
  }
}


template <bool SEG>
__device__ __forceinline__ void wkv_pair(const Params& p, char* smem, int g, int item) {
  char* ws = p.ws;
  const int tid = get_tid(), lane = tid & 63, wave = tid >> 6;
  const int Ls = SEG ? 2048 : 256;
  const __half* wk = (const __half*)(ws + OFF_WK);
  float* stage = (float*)smem;
  float* ylds = (float*)(smem + 98304);
  const bool cw = true;
  const int slot = wave >> 2, wq = wave & 3;
  const int ig = lane >> 3, jg = lane & 7;
  const int row0 = wq * 16 + ig * 2;
  const int chain = SEG ? (item >> 3) : item * 2 + slot;
  const int seg = SEG ? (item & 7) : 0;
  const bool act = cw && (SEG ? !(slot == 1 && seg == 0) : true);
  const int d = chain & 1, h = (chain >> 1) & 15, b = chain >> 5;
  typedef float f2 __attribute__((ext_vector_type(2)));
  f2 S[2][4];
#pragma unroll
  for (int rr = 0; rr < 2; ++rr) {
    if (SEG) {
      if (slot == 0) {
        if (seg == 0) {
          const float* s0 = (d ? p.wkv_b : p.wkv_f) + ((size_t)(b * 16 + h) * 64 + row0 + rr) * 64 + jg * 8;
#pragma unroll
          for (int c = 0; c < 4; ++c) S[rr][c] = f2{s0[2 * c], s0[2 * c + 1]};
        } else {
#pragma unroll
          for (int c = 0; c < 4; ++c) S[rr][c] = f2{0.f, 0.f};
        }
      } else {
#pragma unroll
        for (int c = 0; c < 4; ++c) S[rr][c] = f2{(row0 + rr == jg * 8 + 2 * c) ? 1.f : 0.f, (row0 + rr == jg * 8 + 2 * c + 1) ? 1.f : 0.f};
      }
    } else {
#pragma unroll
      for (int c = 0; c < 4; ++c) S[rr][c] = f2{0.f, 0.f};
    }
  }
  const int pair = tid >> 4, lslot = pair >> 4, lstep = pair & 15, sub = tid & 15;
  const int lch = SEG ? (item >> 3) : item * 2 + lslot;
  const int ld = lch & 1, lh = (lch >> 1) & 15, lb = lch >> 5;
  const bool ldo = SEG ? (lslot == 0) : true;
  const int sbase = seg * 256;
  const int cslot = SEG ? 0 : slot;
  float ka[4];
#pragma unroll
  for (int e = 0; e < 4; ++e) ka[e] = p.k_a[lh * 64 + sub * 4 + e];
  u16* yout;
  if (SEG) yout = lslot == 0 ? (u16*)(ws + (ld ? OFF_WYB : OFF_WYF)) : (u16*)(ws + OFF_YM) + (ld ? (size_t)TG * 1024 : 0);
  else yout = (u16*)(ws + (ld ? OFF_WYB : OFF_WYF));
  const bool ywr = SEG ? (lslot == 0 || seg > 0) : true;
  uint2 rg[6];
  auto prefetch = [&](int tb) {
    int s = sbase + tb * 16 + lstep;
    int pos = ld ? Ls - 1 - s : s;
    int r = lb * Ls + pos;
    const __half* rec = wk + ((size_t)(r * 16 + lh) * 8) * 64 + sub * 4;
    rg[0] = *(const uint2*)(rec + 0 * 64);
    rg[1] = *(const uint2*)(rec + 1 * 64);
    rg[2] = *(const uint2*)(rec + 2 * 64);
    rg[3] = *(const uint2*)(rec + 3 * 64);
    rg[4] = *(const uint2*)(rec + (4 + 2 * ld) * 64);
    rg[5] = *(const uint2*)(rec + (5 + 2 * ld) * 64);
  };
  auto unpack4 = [&](uint2 u, float (&o)[4]) {
    __half2 h0 = *reinterpret_cast<__half2*>(&u.x);
    __half2 h1 = *reinterpret_cast<__half2*>(&u.y);
    float2 f0 = __half22float2(h0), f1 = __half22float2(h1);
    o[0] = f0.x; o[1] = f0.y; o[2] = f1.x; o[3] = f1.y;
  };
  auto stage_store = [&](int buf) {
    float r_[4], v_[4], k_[4], nkk_[4], w_[4], a_[4];
    unpack4(rg[0], r_); unpack4(rg[1], v_); unpack4(rg[2], k_); unpack4(rg[3], nkk_); unpack4(rg[4], w_); unpack4(rg[5], a_);
    float b_[4], kd_[4];
#pragma unroll
    for (int e = 0; e < 4; ++e) {
      b_[e] = -nkk_[e] * a_[e];
      kd_[e] = k_[e] * (1.f + (a_[e] - 1.f) * ka[e]);
    }
    float* dst = stage + ((size_t)((buf * 2 + lslot) * 16 + lstep) * 6) * 64 + sub * 4;
    *(float4*)(dst + 0 * 64) = float4{nkk_[0], nkk_[1], nkk_[2], nkk_[3]};
    *(float4*)(dst + 1 * 64) = float4{w_[0], w_[1], w_[2], w_[3]};
    *(float4*)(dst + 2 * 64) = float4{b_[0], b_[1], b_[2], b_[3]};
    *(float4*)(dst + 3 * 64) = float4{kd_[0], kd_[1], kd_[2], kd_[3]};
    *(float4*)(dst + 4 * 64) = float4{r_[0], r_[1], r_[2], r_[3]};
    *(float4*)(dst + 5 * 64) = float4{v_[0], v_[1], v_[2], v_[3]};
  };
  if (ldo) { prefetch(0); stage_store(0); }
  __syncthreads();
  for (int tb = 0; tb < 16; ++tb) {
    const bool more = tb + 1 < 16;
    if (more && ldo) prefetch(tb + 1);
    if (act) {
      const float* sb = stage + ((size_t)(((tb & 1) * 2 + cslot) * 16) * 6) * 64;
      for (int sg = 0; sg < 8; ++sg) {
        float ysv[2][2];
#pragma unroll
        for (int s4 = 0; s4 < 2; ++s4) {
          const int st = sg * 2 + s4;
          const float* v6 = sb + st * 384 + jg * 8;
          f2 nkk[4], w[4], bb[4], kd[4], rr[4];
#pragma unroll
          for (int q = 0; q < 2; ++q) {
            float4 t0 = *(const float4*)(v6 + 0 * 64 + q * 4);
            nkk[q * 2] = f2{t0.x, t0.y}; nkk[q * 2 + 1] = f2{t0.z, t0.w};
            float4 t1 = *(const float4*)(v6 + 1 * 64 + q * 4);
            w[q * 2] = f2{t1.x, t1.y}; w[q * 2 + 1] = f2{t1.z, t1.w};
            float4 t2 = *(const float4*)(v6 + 2 * 64 + q * 4);
            bb[q * 2] = f2{t2.x, t2.y}; bb[q * 2 + 1] = f2{t2.z, t2.w};
            float4 t3 = *(const float4*)(v6 + 3 * 64 + q * 4);
            kd[q * 2] = f2{t3.x, t3.y}; kd[q * 2 + 1] = f2{t3.z, t3.w};
            float4 t4 = *(const float4*)(v6 + 4 * 64 + q * 4);
            rr[q * 2] = f2{t4.x, t4.y}; rr[q * 2 + 1] = f2{t4.z, t4.w};
          }
          float2 vv2 = *(const float2*)(sb + st * 384 + 5 * 64 + row0);
          float vi[2] = {vv2.x, vv2.y};
          if (SEG && slot == 1) { vi[0] = 0.f; vi[1] = 0.f; }
#pragma unroll
          for (int r2 = 0; r2 < 2; ++r2) {
            f2 sa2a = S[r2][0] * nkk[0], sa2b = S[r2][1] * nkk[1];
            sa2a += S[r2][2] * nkk[2]; sa2b += S[r2][3] * nkk[3];
            f2 sat = sa2a + sa2b;
            float sa = sat.x + sat.y;
            sa += dpp_xor1(sa);
            sa += dpp_xor2(sa);
            sa += dpp_hmirror(sa);
            f2 y2a, y2b;
            {
              f2 t0 = S[r2][0] * w[0] + vi[r2] * kd[0]; S[r2][0] = t0 + sa * bb[0]; y2a = S[r2][0] * rr[0];
              f2 t1 = S[r2][1] * w[1] + vi[r2] * kd[1]; S[r2][1] = t1 + sa * bb[1]; y2b = S[r2][1] * rr[1];
              f2 t2 = S[r2][2] * w[2] + vi[r2] * kd[2]; S[r2][2] = t2 + sa * bb[2]; y2a += S[r2][2] * rr[2];
              f2 t3 = S[r2][3] * w[3] + vi[r2] * kd[3]; S[r2][3] = t3 + sa * bb[3]; y2b += S[r2][3] * rr[3];
            }
            f2 yt = y2a + y2b;
            float y = yt.x + yt.y;
            y += dpp_xor1(y);
            y += dpp_xor2(y);
            y += dpp_hmirror(y);
            ysv[s4][r2] = y;
          }
        }
        if (jg == 0) {
#pragma unroll
          for (int s4 = 0; s4 < 2; ++s4)
            *(float2*)(ylds + (slot * 16 + sg * 2 + s4) * 64 + row0) = float2{ysv[s4][0], ysv[s4][1]};
        }
      }
    }
    __syncthreads();
    if (more && ldo) stage_store((tb + 1) & 1);
    if (ywr) {
      int s = sbase + tb * 16 + lstep;
      int pos = ld ? Ls - 1 - s : s;
      int r = lb * Ls + pos;
      float4 yv = *(const float4*)(ylds + (lslot * 16 + lstep) * 64 + sub * 4);
      *(uint2*)(yout + (size_t)r * 1024 + lh * 64 + sub * 4) = uint2{pack2(yv.x, yv.y), pack2(yv.z, yv.w)};
    }
    __syncthreads();
  }
  if (act) {
#pragma unroll
    for (int r2 = 0; r2 < 2; ++r2) {
      float* so;
      if (SEG) so = p.out + 8388608 + ((size_t)((chain * 8 + seg) * 2 + slot)) * 4096 + (row0 + r2) * 64 + jg * 8;
      else so = p.out + (d ? OUT_WKVB : OUT_WKVF) + ((size_t)((g * 16 + b) * 16 + h) * 64 + row0 + r2) * 64 + jg * 8;
#pragma unroll
      for (int c = 0; c < 4; ++c) { so[2 * c] = S[r2][c].x; so[2 * c + 1] = S[r2][c].y; }
    }
  }
}

__device__ __forceinline__ void wkv_fix(const Params& p, char* smem, int item) {
  const int chain = item >> 2, qt = item & 3;
  char* ws = p.ws;
  const int tid = get_tid(), lane = tid & 63, wave = tid >> 6;
  const int d = chain & 1, h = (chain >> 1) & 15, b = chain >> 5;
  const float* SE = p.out + 8388608;
  u16* yout = (u16*)(ws + (d ? OFF_WYB : OFF_WYF));
  const u16* Q = (const u16*)(ws + OFF_YM) + (d ? (size_t)TG * 1024 : 0);
  float* Pl = (float*)smem;
  float* Sl = (float*)(smem + 16384);
  u16* Ql = (u16*)(smem + 36864);
  const int i = lane;
  float S0[64];
  {
    const float* src = SE + ((size_t)(chain * 8) * 2) * 4096 + i * 64;
#pragma unroll
    for (int j = 0; j < 16; ++j) {
      float4 t = *(const float4*)(src + j * 4);
      S0[j * 4] = t.x; S0[j * 4 + 1] = t.y; S0[j * 4 + 2] = t.z; S0[j * 4 + 3] = t.w;
    }
  }
  for (int k = 1; k < 8; ++k) {
    {
      int tt = qt * 64 + (tid >> 3), ch = tid & 7;
      int s = k * 256 + tt;
      int pos = d ? 2047 - s : s;
      int r = b * 2048 + pos;
      *(uint4*)(Ql + tt * 64 + ch * 8) = *(const uint4*)(Q + (size_t)r * 1024 + h * 64 + ch * 8);
    }
    if (k < 7) {
      const float* src = SE + ((size_t)((chain * 8 + k) * 2 + 1)) * 4096;
#pragma unroll
      for (int e = 0; e < 2; ++e) ((float4*)Pl)[tid + e * 512] = ((const float4*)src)[tid + e * 512];
    }
    __syncthreads();
    for (int n = 0; n < 8; ++n) {
      int tt = qt * 64 + wave + n * 8;
      float a0 = 0.f, a1 = 0.f;
#pragma unroll
      for (int jc = 0; jc < 8; ++jc) {
        float q[8];
        unpack8(*(const uint4*)(Ql + tt * 64 + jc * 8), q);
#pragma unroll
        for (int e = 0; e < 8; e += 2) { a0 += S0[jc * 8 + e] * q[e]; a1 += S0[jc * 8 + e + 1] * q[e + 1]; }
      }
      int s = k * 256 + tt;
      int pos = d ? 2047 - s : s;
      size_t off = (size_t)(b * 2048 + pos) * 1024 + h * 64 + i;
      yout[off] = f2bf(bf2f(yout[off]) + (a0 + a1));
    }
    if (k < 7) {
      float nv[8];
      const float* sl = SE + ((size_t)((chain * 8 + k) * 2)) * 4096 + i * 64 + wave * 8;
      {
        float4 t0 = *(const float4*)sl, t1 = *(const float4*)(sl + 4);
        nv[0] = t0.x; nv[1] = t0.y; nv[2] = t0.z; nv[3] = t0.w; nv[4] = t1.x; nv[5] = t1.y; nv[6] = t1.z; nv[7] = t1.w;
      }
#pragma unroll
      for (int m = 0; m < 64; ++m) {
        float4 p0 = *(const float4*)(Pl + m * 64 + wave * 8), p1 = *(const float4*)(Pl + m * 64 + wave * 8 + 4);
        nv[0] += S0[m] * p0.x; nv[1] += S0[m] * p0.y; nv[2] += S0[m] * p0.z; nv[3] += S0[m] * p0.w;
        nv[4] += S0[m] * p1.x; nv[5] += S0[m] * p1.y; nv[6] += S0[m] * p1.z; nv[7] += S0[m] * p1.w;
      }
      *(float4*)(Sl + i * 68 + wave * 8) = float4{nv[0], nv[1], nv[2], nv[3]};
      *(float4*)(Sl + i * 68 + wave * 8 + 4) = float4{nv[4], nv[5], nv[6], nv[7]};
      __syncthreads();
#pragma unroll
      for (int j = 0; j < 16; ++j) {
        float4 t = *(const float4*)(Sl + i * 68 + j * 4);
        S0[j * 4] = t.x; S0[j * 4 + 1] = t.y; S0[j * 4 + 2] = t.z; S0[j * 4 + 3] = t.w;
      }
    }
    __syncthreads();
  }
}

__device__ __forceinline__ void step_scan(const Params& p, char* smem, int g) {
  const int G = gridDim.x;
  const int r1 = (RM & (1 << 20)) ? 2 : 1, r2 = (RM & (1 << 21)) ? 2 : 1;
  if (g < 2) {
    for (int rr = 0; rr < r1; ++rr) {
      SsdPre R;
      if ((int)blockIdx.x < 1024) ssd_issue(p, g, blockIdx.x, 0, get_tid(), R);
      for (int ch = blockIdx.x; ch < 1024; ch += G) ssd_chain(p, smem, g, ch, ch + G < 1024 ? ch + G : -1, R);
    }
    for (int rr = 0; rr < r2; ++rr) for (int it = blockIdx.x; it < 256; it += G) wkv_pair<false>(p, smem, g, it);
  } else {
    for (int rr = 0; rr < r1; ++rr) {
      SsdPre R;
      if ((int)blockIdx.x < 128) ssd_issue(p, g, blockIdx.x, 0, get_tid(), R);
      for (int ch = blockIdx.x; ch < 128; ch += G) ssd_chain(p, smem, g, ch, ch + G < 128 ? ch + G : -1, R);
    }
    for (int rr = 0; rr < r2; ++rr) for (int it = (G - 1 - blockIdx.x); it < 512; it += G) wkv_pair<true>(p, smem, g, it);
  }
}
__device__ __forceinline__ void step_fix(const Params& p, char* smem) {
  for (int it = blockIdx.x; it < 256; it += gridDim.x) wkv_fix(p, smem, it);
}

__device__ __forceinline__ void step_fin(const Params& p, int g) {
  char* ws = p.ws;
  const int tid = get_tid(), lane = tid & 63, wave = tid >> 6;
  const int gw = blockIdx.x * 8 + wave, nw = gridDim.x * 8;
  {
    const u16* yf = (const u16*)(ws + OFF_SYF);
    const u16* yb = (const u16*)(ws + OFF_SYB);
    const u16* xbc = (const u16*)(ws + OFF_XBC);
    const u16* zb = (const u16*)(ws + OFF_Z);
    u16* ym = (u16*)(ws + OFF_YM);
    for (int it = gw; it < TG * 4; it += nw) {
      int r = it >> 2, gq = it & 3;
      int ch = gq * 512 + lane * 8;
      uint4 a = *(const uint4*)(yf + (size_t)r * 2048 + ch);
      uint4 b = *(const uint4*)(yb + (size_t)r * 2048 + ch);
      uint4 x = *(const uint4*)(xbc + (size_t)r * 3072 + ch);
      uint4 z = *(const uint4*)(zb + (size_t)r * 2048 + ch);
      float dsk = p.d_skip[ch >> 6];
      unsigned aw[4] = {a.x, a.y, a.z, a.w}, bw[4] = {b.x, b.y, b.z, b.w}, xw[4] = {x.x, x.y, x.z, x.w}, zw[4] = {z.x, z.y, z.z, z.w};
      float y[8];
      float ss = 0.f;
#pragma unroll
      for (int e = 0; e < 8; ++e) {
        int sh = (e & 1) * 16;
        float yy = bf2f((u16)(aw[e >> 1] >> sh)) + bf2f((u16)(bw[e >> 1] >> sh)) + dsk * bf2f((u16)(xw[e >> 1] >> sh));
        yy *= siluf(bf2f((u16)(zw[e >> 1] >> sh)));
        y[e] = yy;
        ss += yy * yy;
      }
      ss = wave_sum(ss);
      float rinv = rsqrtf(ss * (1.f / 512.f) + 1e-5f);
      float4 w0 = *(const float4*)(p.m_norm_w + ch), w1 = *(const float4*)(p.m_norm_w + ch + 4);
      *(uint4*)(ym + (size_t)r * 2048 + ch) =
          uint4{pack2(y[0] * rinv * w0.x, y[1] * rinv * w0.y), pack2(y[2] * rinv * w0.z, y[3] * rinv * w0.w),
                pack2(y[4] * rinv * w1.x, y[5] * rinv * w1.y), pack2(y[6] * rinv * w1.z, y[7] * rinv * w1.w)};
    }
  }
  {
    const u16* __restrict__ yf = (const u16*)(ws + OFF_WYF);
    const u16* __restrict__ yb = (const u16*)(ws + OFF_WYB);
    const __half* __restrict__ wk = (const __half*)(ws + OFF_WK);
    const u16* __restrict__ gr = (const u16*)(ws + OFF_GR);
    u16* __restrict__ yr = (u16*)(ws + OFF_YR);
    for (int it = gw; it < TG * 2; it += nw) {
      const int r = it >> 1, hh = it & 1;
      const int c0 = hh * 512 + lane * 8;
      const int head = c0 >> 6;
      const uint4 a = *(const uint4*)(yf + (size_t)r * 1024 + c0);
      const uint4 b = *(const uint4*)(yb + (size_t)r * 1024 + c0);
      const uint4 gq = *(const uint4*)(gr + (size_t)r * 1024 + c0);
      const __half* rec = wk + ((size_t)(r * 16 + head) * 8) * 64 + (lane & 7) * 8;
      const uint4 qr = *(const uint4*)(rec + 0 * 64), qv = *(const uint4*)(rec + 1 * 64), qk = *(const uint4*)(rec + 2 * 64);
      const uint4 qaf = *(const uint4*)(rec + 5 * 64), qab = *(const uint4*)(rec + 7 * 64);
      const float4 lw0 = *(const float4*)(p.lnx_w + c0), lw1 = *(const float4*)(p.lnx_w + c0 + 4);
      const float4 lb0 = *(const float4*)(p.lnx_b + c0), lb1 = *(const float4*)(p.lnx_b + c0 + 4);
      const float4 ka0 = *(const float4*)(p.k_a + c0), ka1 = *(const float4*)(p.k_a + c0 + 4);
      const float4 rk0 = *(const float4*)(p.r_k + c0), rk1 = *(const float4*)(p.r_k + c0 + 4);
      const float lw[8] = {lw0.x, lw0.y, lw0.z, lw0.w, lw1.x, lw1.y, lw1.z, lw1.w};
      const float lb[8] = {lb0.x, lb0.y, lb0.z, lb0.w, lb1.x, lb1.y, lb1.z, lb1.w};
      const float kav[8] = {ka0.x, ka0.y, ka0.z, ka0.w, ka1.x, ka1.y, ka1.z, ka1.w};
      const float rkv[8] = {rk0.x, rk0.y, rk0.z, rk0.w, rk1.x, rk1.y, rk1.z, rk1.w};
      float ya[8], yb8[8], gg[8];
      unpack8(a, ya); unpack8(b, yb8); unpack8(gq, gg);
      auto unph = [&](const uint4& u, float (&o)[8]) {
        const __half2* hp = reinterpret_cast<const __half2*>(&u);
#pragma unroll
        for (int e = 0; e < 4; ++e) { float2 f = __half22float2(hp[e]); o[2 * e] = f.x; o[2 * e + 1] = f.y; }
      };
      float rr[8], vv[8], kk[8], af[8], ab[8];
      unph(qr, rr); unph(qv, vv); unph(qk, kk); unph(qaf, af); unph(qab, ab);
      float y[8];
      float s1 = 0.f;
#pragma unroll
      for (int e = 0; e < 8; ++e) { y[e] = ya[e] + yb8[e]; s1 += y[e]; }
      s1 += dpp_xor1(s1); s1 += dpp_xor2(s1); s1 += dpp_hmirror(s1);
      const float mean = s1 * (1.f / 64.f);
      float s2 = 0.f, s3 = 0.f;
#pragma unroll
      for (int e = 0; e < 8; ++e) {
        const float dy = y[e] - mean;
        s2 += dy * dy;
        const float kmean = kk[e] * (1.f + (0.5f * (af[e] + ab[e]) - 1.f) * kav[e]);
        s3 += rr[e] * kmean * rkv[e];
      }
      s2 += dpp_xor1(s2); s2 += dpp_xor2(s2); s2 += dpp_hmirror(s2);
      s3 += dpp_xor1(s3); s3 += dpp_xor2(s3); s3 += dpp_hmirror(s3);
      const float rs = rsqrtf(s2 * (1.f / 64.f) + 64e-5f);
      float o[8];
#pragma unroll
      for (int e = 0; e < 8; ++e) o[e] = ((y[e] - mean) * rs * lw[e] + lb[e] + s3 * vv[e]) * gg[e];
      *(uint4*)(yr + (size_t)r * 1024 + c0) = uint4{pack2(o[0], o[1]), pack2(o[2], o[3]), pack2(o[4], o[5]), pack2(o[6], o[7])};
    }
  }
}

__device__ __forceinline__ void step_outproj(const Params& p, char* smem, int g) {
  char* ws = p.ws;
  u16* Ug = (u16*)p.out + (size_t)g * TG * 1024;
  EpiOut<0> E0{(const u16*)(ws + OFF_GATE), Ug};
  run_gemm8(smem, (const u16*)(ws + OFF_YM), (const u16*)(ws + OFF_WMOUT), TG, 1024, 2048, E0);
  EpiOut<1> E1{(const u16*)(ws + OFF_GATE), Ug};
  run_gemm8(smem, (const u16*)(ws + OFF_YR), (const u16*)(ws + OFF_WROUT), TG, 1024, 1024, E1);
}

__device__ __forceinline__ void step_wo(const Params& p, char* smem, int g) {
  char* ws = p.ws;
  EpiWo E{p.x_prompt, p.x_sample, (const float*)(ws + OFF_MOD), (float*)(ws + OFF_X1), 0};
  run_gemm8(smem, (const u16*)p.out, (const u16*)(ws + OFF_WO), NTOK, 1024, 1024, E);
}

__device__ __forceinline__ void step_gu(const Params& p, char* smem) {
  char* ws = p.ws;
  EpiGU E{(u16*)(ws + OFF_ACT)};
  run_gemm8(smem, (const u16*)(ws + OFF_H2), (const u16*)(ws + OFF_WGU), NTOK, 5632, 1024, E);
}

__device__ __forceinline__ void step_down(const Params& p, char* smem) {
  char* ws = p.ws;
  EpiDown E{(const float*)(ws + OFF_MOD), (float*)(ws + OFF_X1)};
  run_gemm8(smem, (const u16*)(ws + OFF_ACT), (const u16*)(ws + OFF_WDOWN), NTOK, 1024, 2816, E);
}

__device__ __forceinline__ void step_final(const Params& p) {
  const int tid = get_tid(), lane = tid & 63, wave = tid >> 6;
  for (int r = blockIdx.x * 8 + wave; r < NTOK; r += gridDim.x * 8) {
    const float* xr = (const float*)(p.ws + OFF_X1) + (size_t)r * 1024;
    float* xo = p.out + (size_t)r * 1024;
    float4 v[4];
    float ss = 0.f;
#pragma unroll
    for (int i = 0; i < 4; ++i) {
      v[i] = ((const float4*)xr)[i * 64 + lane];
      ss += v[i].x * v[i].x + v[i].y * v[i].y + v[i].z * v[i].z + v[i].w * v[i].w;
    }
    ss = wave_sum(ss);
    float rinv = rsqrtf(ss * (1.f / 1024.f) + 1e-6f);
#pragma unroll
    for (int i = 0; i < 4; ++i) {
      float4 w4 = ((const float4*)p.final_norm_w)[i * 64 + lane];
      ((float4*)xo)[i * 64 + lane] = float4{v[i].x * rinv * w4.x, v[i].y * rinv * w4.y, v[i].z * rinv * w4.z, v[i].w * rinv * w4.w};
    }
  }
}

constexpr int NSTEPS = 30;

__global__ void __launch_bounds__(NTHR) mega(Params p_arg) {
  const int step_lo = p_arg.step_lo, step_hi = p_arg.step_hi;
  __shared__ __attribute__((aligned(16))) char smem[SMEM_BYTES];
#if !MULTI_LAUNCH
  if (threadIdx.x == 0) *(uint4*)(smem + SMEM_BYTES - 16) = uint4{0u, 0u, 0u, 0u};
  __syncthreads();
  XcdBarrier xb = xcd_barrier_post((unsigned*)(p_arg.ws + OFF_BAR), (volatile LAS unsigned*)(smem + SMEM_BYTES - 16));
#endif
  for (int step = step_lo; step <= step_hi; ++step) {
#if defined(__HIP_DEVICE_COMPILE__)
    const __attribute__((address_space(4))) Params* pp = (const __attribute__((address_space(4))) Params*)__builtin_amdgcn_kernarg_segment_ptr();
    asm volatile("" : "+s"(pp));
    const Params p = *pp;
#else
    const Params p = p_arg;
#endif
    const int g = (step - 1) >> 3, s = (step - 1) & 7;
    const int scode = step == 0 ? 0 : (step <= 24 ? 1 + s : step - 16);
    if (scode == 6 && g < 2) continue;
    if (scode == 1 && g > 0) continue;
    const int reps = ((RM >> scode) & 1) ? 2 : 1;
    for (int rep = 0; rep < reps; ++rep) {
      if (!((SM >> scode) & 1)) continue;
      switch (scode) {
        case 0: step_prep(p, smem); break;
        case 1: step_norm<0>(p, g); break;
        case 2: step_gemm1(p, smem, g == 0 ? 0 : 2); break;
        case 3: step_cr1(p, g); break;
        case 4: step_r2(p, smem); break;
        case 5: step_scan(p, smem, g); break;
        case 6: step_fix(p, smem); break;
        case 7: step_fin(p, g); if (g < 2) step_norm<0>(p, g + 1); break;
        case 8:
          if (blockIdx.x < 64) step_outproj(p, smem, g);
          else {
            if (g < 2) step_gemm1(p, smem, 1);
            if (g == 0) {
              convT<1>(p.w_gu, 1024, 5632, (u16*)(p.ws + OFF_WGU), smem, blockIdx.x - 64, gridDim.x - 64);
              convT<0>(p.w_down, 2816, 1024, (u16*)(p.ws + OFF_WDOWN), smem, blockIdx.x - 64, gridDim.x - 64);
            }
          }
          break;
        case 9: step_wo(p, smem, 0); break;
        case 10: step_norm<1>(p, 0); break;
        case 11: step_gu(p, smem); break;
        case 12: step_down(p, smem); break;
        default: step_final(p); break;
      }
    }
    if (step < step_hi) {
#if !MULTI_LAUNCH
      if (step_hi > 100000) cg::this_grid().sync();
      for (int xs = 0; xs < 1 + XSYNC; ++xs) xcd_barrier(xb);
#endif
    }
  }
}

extern "C" void kernel_launch(void* const* d_in, const int* in_sizes, int n_in, void* d_out, int out_size,
                              void* d_ws, size_t ws_size, hipStream_t stream) {
  Params p{};
  const float** pp = (const float**)&p;
  for (int i = 0; i < 36; ++i) pp[i] = (const float*)d_in[i];
  p.out = (float*)d_out;
  p.ws = (char*)d_ws;
  if (ws_size < WS_NEED) fprintf(stderr, "workspace too small: %zu < %zu\n", ws_size, (size_t)WS_NEED);
#if MULTI_LAUNCH
  for (int s = 0; s < NSTEPS; ++s) {
    p.step_lo = s;
    p.step_hi = s;
    hipLaunchKernelGGL(mega, dim3(256), dim3(NTHR), 0, stream, p);
  }
#else
  static int grid_blocks = 0;
  if (!grid_blocks) {
    int dev = 0, cus = 0, per_cu = 0;
    hipGetDevice(&dev);
    hipDeviceGetAttribute(&cus, hipDeviceAttributeMultiprocessorCount, dev);
    hipOccupancyMaxActiveBlocksPerMultiprocessor(&per_cu, mega, NTHR, 0);
    if (per_cu < 1) per_cu = 1;
    if (per_cu > 1) per_cu = 1;
    grid_blocks = cus * per_cu;
  }
  p.step_lo = 0;
  p.step_hi = NSTEPS - 1;
  void* args[] = {&p};
  hipMemsetAsync((char*)d_ws + OFF_BAR, 0, XCD_BAR_WORDS_C * 4, stream);
  hipError_t e = hipLaunchCooperativeKernel((void*)mega, dim3(grid_blocks), dim3(NTHR), args, 0, stream);
  if (e != hipSuccess) fprintf(stderr, "cooperative launch failed: %s (grid %d)\n", hipGetErrorString(e), grid_blocks);
#endif
}
```

```cpp
#include <hip/hip_runtime.h>
#include <hip/hip_cooperative_groups.h>
#include <hip/hip_fp16.h>
#include <cstdio>
#include <cstdint>
namespace cg = cooperative_groups;

#ifndef MULTI_LAUNCH
#define MULTI_LAUNCH 0
#endif

#define DI __device__ __forceinline__
typedef __attribute__((ext_vector_type(8))) short bf16x8;
typedef __attribute__((ext_vector_type(4))) float f32x4;
typedef unsigned short u16;

#ifndef STEP_MASK
#define STEP_MASK 0xffffff
#endif
constexpr int SM = STEP_MASK;
#ifndef REPEAT_MASK
#define REPEAT_MASK 0
#endif
#ifndef XSYNC
#define XSYNC 0
#endif
constexpr int RM = REPEAT_MASK;
constexpr int TG = 4096;
constexpr int NTOK = 12288;
constexpr int NPAD = 10752;
constexpr int NTHR = 512;
constexpr int SMEM_BYTES = 133120;
constexpr int XCD_BAR_WORDS_C = 3456;

constexpr size_t OFF_WIN = 0;
constexpr size_t OFF_WGU = OFF_WIN + (size_t)NPAD * 1024 * 2;
constexpr size_t OFF_WDOWN = OFF_WGU + (size_t)5632 * 1024 * 2;
constexpr size_t OFF_WMOUT = OFF_WDOWN + (size_t)1024 * 2816 * 2;
constexpr size_t OFF_WROUT = OFF_WMOUT + (size_t)1024 * 2048 * 2;
constexpr size_t OFF_WO = OFF_WROUT + (size_t)1024 * 1024 * 2;
constexpr size_t OFF_W2T = OFF_WO + (size_t)1024 * 1024 * 2;
constexpr size_t OFF_A2T = OFF_W2T + 262144;
constexpr size_t OFF_G2T = OFF_A2T + 262144;
constexpr size_t OFF_MOD = OFF_G2T + 262144;
constexpr size_t OFF_GRP = OFF_MOD + 73728;
constexpr size_t OFF_Z = OFF_GRP;
constexpr size_t OFF_GATE = OFF_Z + (size_t)TG * 2048 * 2;
constexpr size_t OFF_XBC = OFF_GATE + (size_t)TG * 2048 * 2;
constexpr size_t OFF_WK = OFF_XBC + (size_t)TG * 3072 * 2;
constexpr size_t OFF_GR = OFF_WK + (size_t)TG * 16 * 1024;
constexpr size_t OFF_DT = OFF_GR + (size_t)TG * 1024 * 2;
constexpr size_t OFF_TL = OFF_DT + (size_t)TG * 64 * 4;
constexpr size_t OFF_SG = OFF_TL + (size_t)TG * 256 * 2;
constexpr size_t OFF_R = OFF_SG + (size_t)TG * 128 * 2;
constexpr size_t OFF_H1 = OFF_R;
constexpr size_t OFF_XBCRAW = OFF_H1 + (size_t)TG * 1024 * 2;
constexpr size_t OFF_RW = OFF_XBCRAW + (size_t)TG * 3072 * 2;
constexpr size_t OFF_SYF = OFF_R;
constexpr size_t OFF_SYB = OFF_SYF + (size_t)TG * 2048 * 2;
constexpr size_t OFF_WYF = OFF_SYB + (size_t)TG * 2048 * 2;
constexpr size_t OFF_WYB = OFF_WYF + (size_t)TG * 1024 * 2;
constexpr size_t OFF_YM = OFF_WYB + (size_t)TG * 1024 * 2;
constexpr size_t OFF_YR = OFF_YM + (size_t)TG * 2048 * 2;
constexpr size_t OFF_END = OFF_YR + (size_t)TG * 1024 * 2;
constexpr size_t OFF_BAR = OFF_END;
constexpr size_t OFF_W4T = OFF_BAR + 16384;
constexpr size_t WS_NEED = OFF_W4T + (size_t)4096 * 256 * 2;
constexpr size_t OFF_U = OFF_XBC;
constexpr size_t OFF_H2 = OFF_GRP;
constexpr size_t OFF_ACT = OFF_H2 + (size_t)NTOK * 1024 * 2;
constexpr size_t H1_OUT_OFF = 25165824;
constexpr size_t OFF_X1 = OFF_ACT + (size_t)NTOK * 2816 * 2;

constexpr size_t OUT_SSMF = 12582912;
constexpr size_t OUT_SSMB = OUT_SSMF + 8388608;
constexpr size_t OUT_WKVF = OUT_SSMB + 8388608;
constexpr size_t OUT_WKVB = OUT_WKVF + 2097152;

struct Params {
  const float *x_prompt, *x_sample, *ssm_f, *ssm_b, *wkv_f, *wkv_b, *c, *c_ctx, *norm1_w, *norm2_w,
      *w_ada, *b_ada, *w_in, *conv_w, *conv_b, *dt_bias, *a_log, *d_skip, *m_norm_w, *mu_shift, *w0,
      *w2, *a0, *a2, *g2, *k_k, *k_a, *r_k, *lnx_w, *lnx_b, *w_m_out, *w_r_out, *w_o, *w_gu, *w_down,
      *final_norm_w;
  float* out;
  char* ws;
  int step_lo, step_hi;
};

DI int get_tid() {
  int t = threadIdx.x;
  asm volatile("" : "+v"(t));
  return t;
}
DI u16 f2bf(float f) {
  unsigned u = __float_as_uint(f);
  u += 0x7fffu + ((u >> 16) & 1u);
  return (u16)(u >> 16);
}
DI float bf2f(u16 h) { return __uint_as_float(((unsigned)h) << 16); }
DI float siluf(float x) { return x / (1.f + __expf(-x)); }
DI float sigm(float x) { return 1.f / (1.f + __expf(-x)); }
DI float wave_sum(float v) {
  v += __int_as_float(__builtin_amdgcn_update_dpp(0, __float_as_int(v), 0xB1, 0xF, 0xF, true));
  v += __int_as_float(__builtin_amdgcn_update_dpp(0, __float_as_int(v), 0x4E, 0xF, 0xF, true));
  v += __int_as_float(__builtin_amdgcn_update_dpp(0, __float_as_int(v), 0x141, 0xF, 0xF, true));
  v += __int_as_float(__builtin_amdgcn_update_dpp(0, __float_as_int(v), 0x140, 0xF, 0xF, true));
  const int vi = __float_as_int(v);
  float a = __int_as_float(__builtin_amdgcn_readlane(vi, 0)), b = __int_as_float(__builtin_amdgcn_readlane(vi, 16));
  float c = __int_as_float(__builtin_amdgcn_readlane(vi, 32)), d = __int_as_float(__builtin_amdgcn_readlane(vi, 48));
  return (a + b) + (c + d);
}
DI float dpp_xor1(float v) { return __int_as_float(__builtin_amdgcn_update_dpp(0, __float_as_int(v), 0xB1, 0xF, 0xF, true)); }
DI float dpp_hmirror(float v) { return __int_as_float(__builtin_amdgcn_update_dpp(0, __float_as_int(v), 0x141, 0xF, 0xF, true)); }
DI float dpp_xor2(float v) { return __int_as_float(__builtin_amdgcn_update_dpp(0, __float_as_int(v), 0x4E, 0xF, 0xF, true)); }
DI unsigned pack2(float a, float b) { return (unsigned)f2bf(a) | ((unsigned)f2bf(b) << 16); }
DI int mrow_of(int tok) { return tok < 8192 ? 0 : 1 + ((tok - 8192) >> 11); }


#define XB_TMO      128
#define XB_XCNT(j)  (256  + 64 * (j))
#define XB_XSUB(j)  (1280 + 64 * (j))
#define XB_XGEN(j)  (2304 + 64 * (j))
#define XB_TOP      3328
#define XB_TOPGEN   3392
#define XCD_BAR_WORDS 3456
#define XB_SPIN_CAP (1u << 22)
#define LAS __attribute__((address_space(3)))
DI unsigned xb_ld(unsigned* p) { return __hip_atomic_load(p, __ATOMIC_RELAXED, __HIP_MEMORY_SCOPE_AGENT); }
DI unsigned xb_add(unsigned* p, unsigned v) { return __hip_atomic_fetch_add(p, v, __ATOMIC_RELAXED, __HIP_MEMORY_SCOPE_AGENT); }
DI unsigned xb_xcc_id() { return (unsigned)__builtin_amdgcn_s_getreg((3 << 11) | 20) & 0xFu; }
#define XB_SPIN(cond, bar) do { unsigned _sp = 0; while (cond) { __builtin_amdgcn_s_sleep(1); \
    if ((++_sp & 255u) == 0u) { if (xb_ld(&(bar)[XB_TMO])) break; if (_sp > XB_SPIN_CAP) { atomicAdd(&(bar)[XB_TMO], 1u); break; } } } } while (0)
struct XcdBarrier { unsigned* bar; unsigned x; volatile LAS unsigned* st; };
DI XcdBarrier xcd_barrier_post(unsigned* bar, volatile LAS unsigned* st) {
  XcdBarrier b; b.bar = bar; b.x = xb_xcc_id(); b.st = st;
  if (threadIdx.x == 0) (void)xb_add(&bar[XB_XCNT(b.x)], 1u);
  return b;
}
DI void xcd_barrier_complete(unsigned* bar, unsigned x, unsigned& nloc, unsigned& nx) {
  const unsigned G = gridDim.x * gridDim.y * gridDim.z;
  unsigned sum, cnt, mine, sp = 0u;
  for (;;) {
    sum = 0u; cnt = 0u; mine = 0u;
#pragma unroll
    for (unsigned j = 0; j < 16; ++j) { const unsigned c = xb_ld(&bar[XB_XCNT(j)]); sum += c; cnt += (c > 0u) ? 1u : 0u; mine = (j == x) ? c : mine; }
    if (sum == G) break;
    __builtin_amdgcn_s_sleep(1);
    if ((++sp & 255u) == 0u) { if (xb_ld(&bar[XB_TMO])) break; if (sp > XB_SPIN_CAP) { atomicAdd(&bar[XB_TMO], 1u); break; } }
  }
  nloc = mine > 0u ? mine : 1u; nx = cnt > 0u ? cnt : 1u;
}
DI void xcd_barrier(const XcdBarrier& b) {
  asm volatile("s_waitcnt vmcnt(0)" ::: "memory");
  __syncthreads();
  if (threadIdx.x == 0) {
    unsigned* bar = b.bar;
    asm volatile("" : "+s"(bar));
    __builtin_amdgcn_s_waitcnt(0);
    unsigned nloc = b.st[0], nx = b.st[1];
    if (nloc == 0u) { xcd_barrier_complete(bar, b.x, nloc, nx); b.st[0] = nloc; b.st[1] = nx; }
    const unsigned old = xb_add(&bar[XB_XSUB(b.x)], 1u);
    const unsigned gen = old / nloc;
    if (old + 1u == (gen + 1u) * nloc) {
      __builtin_amdgcn_fence(__ATOMIC_RELEASE, "agent");
      asm volatile("s_waitcnt vmcnt(0)" ::: "memory");
      const unsigned og = xb_add(&bar[XB_TOP], 1u);
      const unsigned tg = og / nx;
      if (og + 1u == (tg + 1u) * nx) xb_add(&bar[XB_TOPGEN], 1u);
      else XB_SPIN(xb_ld(&bar[XB_TOPGEN]) == tg, bar);
      __builtin_amdgcn_fence(__ATOMIC_ACQUIRE, "agent");
      xb_add(&bar[XB_XGEN(b.x)], 1u);
      asm volatile("s_waitcnt vmcnt(0)" ::: "memory");
    } else {
      XB_SPIN(xb_ld(&bar[XB_XGEN(b.x)]) == gen, bar);
      __builtin_amdgcn_fence(__ATOMIC_ACQUIRE, "agent");
      asm volatile("s_waitcnt vmcnt(0)" ::: "memory");
    }
  }
  __syncthreads();
}

DI void gemm_load(const int tid, const u16* A, int lda, const u16* B, int ldb, int k0, uint4 (&ra)[4], uint4 (&rb)[2]) {
#pragma unroll
  for (int i = 0; i < 4; ++i) {
    int idx = tid + i * 512;
    int row = idx >> 3, ch = idx & 7;
    ra[i] = *(const uint4*)(A + (size_t)row * lda + k0 + ch * 8);
  }
#pragma unroll
  for (int i = 0; i < 2; ++i) {
    int idx = tid + i * 512;
    int row = idx >> 3, ch = idx & 7;
    rb[i] = *(const uint4*)(B + (size_t)row * ldb + k0 + ch * 8);
  }
}
DI void gemm_store_lds(const int tid, char* sA, char* sB, const uint4 (&ra)[4], const uint4 (&rb)[2]) {
#pragma unroll
  for (int i = 0; i < 4; ++i) {
    int idx = tid + i * 512;
    int row = idx >> 3, ch = idx & 7;
    *(uint4*)(sA + row * 128 + ((ch ^ ((row >> 1) & 7)) << 4)) = ra[i];
  }
#pragma unroll
  for (int i = 0; i < 2; ++i) {
    int idx = tid + i * 512;
    int row = idx >> 3, ch = idx & 7;
    *(uint4*)(sB + row * 128 + ((ch ^ ((row >> 1) & 7)) << 4)) = rb[i];
  }
}
DI void gemm_compute(const char* sA, const char* sB, f32x4 (&acc)[4][4], int wm, int wn, int lane) {
#pragma unroll
  for (int kk = 0; kk < 2; ++kk) {
    bf16x8 a[4], b[4];
    const int ch = kk * 4 + (lane >> 4);
#pragma unroll
    for (int mf = 0; mf < 4; ++mf) {
      int row = wm * 64 + mf * 16 + (lane & 15);
      a[mf] = *(const bf16x8*)(sA + row * 128 + ((ch ^ ((row >> 1) & 7)) << 4));
    }
#pragma unroll
    for (int nf = 0; nf < 4; ++nf) {
      int row = wn * 64 + nf * 16 + (lane & 15);
      b[nf] = *(const bf16x8*)(sB + row * 128 + ((ch ^ ((row >> 1) & 7)) << 4));
    }
#pragma unroll
    for (int mf = 0; mf < 4; ++mf)
#pragma unroll
      for (int nf = 0; nf < 4; ++nf)
        acc[mf][nf] = __builtin_amdgcn_mfma_f32_16x16x32_bf16(a[mf], b[nf], acc[mf][nf], 0, 0, 0);
  }
}
DI void gemm_acc(const u16* A, int lda, const u16* B, int ldb, int K, f32x4 (&acc)[4][4], char* smem) {
  const int tid = get_tid(), lane = tid & 63, wave = tid >> 6;
  const int wm = wave >> 1, wn = wave & 1;
  char* sA0 = smem;
  char* sB0 = smem + 32768;
  char* sA1 = smem + 49152;
  char* sB1 = smem + 81920;
  uint4 ra[4], rb[2];
  const int nk = K >> 6;
  gemm_load(tid, A, lda, B, ldb, 0, ra, rb);
  gemm_store_lds(tid, sA0, sB0, ra, rb);
  __syncthreads();
  for (int kt = 0; kt < nk; ++kt) {
    const bool more = (kt + 1 < nk);
    if (more) gemm_load(tid, A, lda, B, ldb, (kt + 1) * 64, ra, rb);
    if (kt & 1) gemm_compute(sA1, sB1, acc, wm, wn, lane);
    else gemm_compute(sA0, sB0, acc, wm, wn, lane);
    if (more) {
      if (kt & 1) gemm_store_lds(tid, sA0, sB0, ra, rb);
      else gemm_store_lds(tid, sA1, sB1, ra, rb);
    }
    __syncthreads();
  }
}
DI void zero_acc(f32x4 (&acc)[4][4]) {
#pragma unroll
  for (int i = 0; i < 4; ++i)
#pragma unroll
    for (int j = 0; j < 4; ++j) { float z0; asm volatile("v_mov_b32 %0, 0" : "=v"(z0)); acc[i][j] = f32x4{z0, z0, z0, z0}; }
}

#define PG8_LAS __attribute__((address_space(3)))
namespace pg8 {
typedef unsigned short bf16_t;
typedef short bf16x8 __attribute__((ext_vector_type(8)));
typedef float f32x4 __attribute__((ext_vector_type(4)));
typedef unsigned u32x4 __attribute__((ext_vector_type(4)));
constexpr int BM = 256, BK = 64, HALF = 128, HTB = HALF * BK * 2  , STAGE_BYTES = 8 * HTB, NXCD = 8, WGM = 8;

__host__ __device__ __forceinline__ int lds_byte(int r, int c) { const int st = (r >> 4) * 2 + (c >> 5), rr = r & 15, cc = c & 31, ob = rr * 64 + cc * 2; return st * 1024 + (ob ^ (((ob >> 9) & 1) << 5)); }
__host__ __device__ __forceinline__ void stage_rc(int b, int& R, int& C) { const int st = b / 1024, sb = b % 1024, swz = sb ^ (((sb >> 9) & 1) << 5); R = (st >> 1) * 16 + swz / 64; C = (st & 1) * 32 + (swz % 64) / 2; }
__host__ __device__ __forceinline__ int perm32(int rho) { const int n = rho >> 4, i = rho & 15; return 8 * (i >> 2) + 4 * n + (i & 3); }

struct Unit { int pm, pn; };
struct Gemm { const bf16_t* A; const bf16_t* Bt; int M, N, K, blk, ld; };

struct StaticOrder {
    int nM, nN, nwg, G, c;
    __host__ __device__ void init(int M, int N, int G_, int c_) { nM = M / BM; nN = N / BM; nwg = nM * nN; G = G_; c = c_; }
    __host__ __device__ bool next(int i, Unit& u) const {
        const long L = (long)i * G + c; if (L >= nwg) return false;
        int wgid = (int)L; { const int q = nwg / NXCD, r = nwg % NXCD, xcd = wgid % NXCD, off = wgid / NXCD; wgid = (xcd < r ? xcd * (q + 1) : r * (q + 1) + (xcd - r) * q) + off; }
        const int nig = WGM * nN, gid = wgid / nig, fm = gid * WGM, gsz = (nM - fm) < WGM ? (nM - fm) : WGM;
        u.pm = fm + ((wgid % nig) % gsz); u.pn = (wgid % nig) / gsz; return true;
    }
    __device__ __forceinline__ void a_ready(const Unit&) const {}
    __device__ __forceinline__ void done(const Unit&) const {}
};
__device__ __forceinline__ unsigned cvt_pk_bf16(float lo, float hi) { unsigned r; asm volatile("v_cvt_pk_bf16_f32 %0, %1, %2" : "=v"(r) : "v"(lo), "v"(hi)); return r; }
template <class Epi, class Sched, bool STAMP = false>
__device__ __forceinline__ void gemm_phase(PG8_LAS unsigned char* lds, const Gemm g, const Sched& S, const Epi& E, unsigned long long* stamps) {
    const int tid = get_tid(), wid = __builtin_amdgcn_readfirstlane(tid >> 6), lane = tid & 63, wr = wid >> 2, wc = wid & 3, fr = lane & 15, fq = lane >> 4;
    const int K = g.K, nt = K / BK;
    int ts_lo = 0, ts_hi = 0, nts = 0; const unsigned long long rt_entry = STAMP ? (unsigned long long)wall_clock64() : 0ull;
#define PG8_STAMP() do { if (STAMP && wid == 0 && nts < 64) { const unsigned long long _c = (unsigned long long)clock64(); \
        ts_lo = (lane == nts) ? (int)(unsigned)_c : ts_lo; ts_hi = (lane == nts) ? (int)(unsigned)(_c >> 32) : ts_hi; ++nts; } } while (0)
    PG8_STAMP();
    unsigned voffA[2], voffB[2];
#pragma unroll
    for (int i = 0; i < 2; ++i) { int R, C; stage_rc(tid * 16 + i * 8192, R, C); const int Rb = Epi::PERM ? ((R & ~31) + perm32(R & 31)) : R;
        const int ldr = g.blk ? 64 : g.ld; voffA[i] = (unsigned)(R * ldr + C) * 2u; voffB[i] = (unsigned)(Rb * ldr + C) * 2u; }
    const size_t kstep = g.blk ? (size_t)32768 : (size_t)(BK * 2);
    const size_t hstep = g.blk ? (size_t)16384 : (size_t)HALF * g.ld * 2;
    const size_t tstep = g.blk ? (size_t)(K / 64) * 32768 : 2 * hstep;
    const unsigned ldsw = (unsigned)wid * 1024u;
    const int aoff = lds_byte(wr * 64 + fr, fq * 8), boff = lds_byte(wc * 32 + fr, fq * 8);
#define PG8_SA(b, h) (((b) * 2 + (h)) * HTB)
#define PG8_SB(b, h) ((4 + (b) * 2 + (h)) * HTB)
#define PG8_STAGE(bufoff, gbase, voff) do { _Pragma("unroll") for (int _i = 0; _i < 2; ++_i) \
        __builtin_amdgcn_global_load_lds((const unsigned*)((const char*)(gbase) + (voff)[_i]), (PG8_LAS unsigned*)(lds + (bufoff) + ldsw + _i * 8192), 16, 0, 0); } while (0)
#define PG8_LDA(dst, b, h) do { _Pragma("unroll") for (int m = 0; m < 4; ++m) _Pragma("unroll") for (int k = 0; k < 2; ++k) dst[m][k] = *(const PG8_LAS bf16x8*)(lds + PG8_SA(b, h) + aoff + m * 2048 + k * 1024); } while (0)
#define PG8_LDB(dst, b, h) do { _Pragma("unroll") for (int n = 0; n < 2; ++n) _Pragma("unroll") for (int k = 0; k < 2; ++k) dst[n][k] = *(const PG8_LAS bf16x8*)(lds + PG8_SB(b, h) + boff + n * 2048 + k * 1024); } while (0)
#define PG8_MMA(ai, bj, At, Bt) do { __builtin_amdgcn_s_setprio(1); _Pragma("unroll") for (int m = 0; m < 4; ++m) _Pragma("unroll") for (int n = 0; n < 2; ++n) _Pragma("unroll") for (int k = 0; k < 2; ++k) \
        acc[ai][bj][m][n] = __builtin_amdgcn_mfma_f32_16x16x32_bf16(Bt[n][k], At[m][k], acc[ai][bj][m][n], 0, 0, 0); __builtin_amdgcn_s_setprio(0); } while (0)
#define PG8_WAIT_V(n) asm volatile("s_waitcnt vmcnt(" #n ")" ::: "memory")
#define PG8_WAIT_L(n) asm volatile("s_waitcnt lgkmcnt(" #n ")" ::: "memory")
#define PG8_BAR __builtin_amdgcn_s_barrier()
#define PG8_SCHED __builtin_amdgcn_sched_barrier(0)
    Unit cur, nxt; int ui = 0;
    if (!S.next(0, cur)) return;
    f32x4 acc[2][2][4][2];
#pragma unroll
    for (int a = 0; a < 2; ++a)
#pragma unroll
        for (int b = 0; b < 2; ++b)
#pragma unroll
            for (int m = 0; m < 4; ++m)
#pragma unroll
                for (int n = 0; n < 2; ++n) { float z0; asm volatile("v_mov_b32 %0, 0" : "=v"(z0)); acc[a][b][m][n] = (f32x4){z0, z0, z0, z0}; }
    bf16x8 At[4][2], B0[2][2], B1[2][2];
    const char* cA = (const char*)g.A + (size_t)cur.pm * tstep; const char* cB = (const char*)g.Bt + (size_t)cur.pn * tstep;
    S.a_ready(cur);
    PG8_STAGE(PG8_SB(0, 0), cB, voffB); PG8_STAGE(PG8_SA(0, 0), cA, voffA); PG8_STAGE(PG8_SB(0, 1), cB + hstep, voffB); PG8_STAGE(PG8_SA(0, 1), cA + hstep, voffA);
    if (wr == 1) PG8_BAR;
    PG8_WAIT_V(4); PG8_BAR;
    PG8_STAGE(PG8_SB(1, 0), cB + kstep, voffB); PG8_STAGE(PG8_SA(1, 0), cA + kstep, voffA); PG8_STAGE(PG8_SB(1, 1), cB + hstep + kstep, voffB);
    PG8_WAIT_V(6); PG8_BAR;
    PG8_STAMP();
    for (;;) {
        const bool has_next = S.next(ui + 1, nxt);
        const char* nA = has_next ? (const char*)g.A + (size_t)nxt.pm * tstep : cA; const char* nB = has_next ? (const char*)g.Bt + (size_t)nxt.pn * tstep : cB;
        for (int t = 0; t < nt; t += 2) {
            const bool last = (t == nt - 2);
            const char* a1 = cA + (size_t)(t + 1) * kstep;
            const char* a2 = last ? nA : cA + (size_t)(t + 2) * kstep; const char* b2 = last ? nB : cB + (size_t)(t + 2) * kstep;
            const char* a3 = a2 + kstep; const char* b3 = b2 + kstep;
            if (last && has_next) S.a_ready(nxt);
            PG8_LDB(B0, 0, 0); PG8_SCHED; PG8_LDA(At, 0, 0); PG8_STAGE(PG8_SA(1, 1), a1 + hstep, voffA);
            PG8_WAIT_L(8); PG8_BAR; PG8_WAIT_L(0); PG8_MMA(0, 0, At, B0); PG8_BAR; PG8_SCHED;
            PG8_LDB(B1, 0, 1); PG8_STAGE(PG8_SB(0, 0), b2, voffB);
            PG8_BAR; PG8_WAIT_L(0); PG8_MMA(0, 1, At, B1); PG8_BAR;
            PG8_LDA(At, 0, 1); PG8_STAGE(PG8_SA(0, 0), a2, voffA);
            PG8_BAR; PG8_WAIT_L(0); PG8_MMA(1, 0, At, B0); PG8_BAR; PG8_SCHED;
            PG8_STAGE(PG8_SB(0, 1), b2 + hstep, voffB);
            PG8_WAIT_V(6); PG8_BAR; PG8_MMA(1, 1, At, B1); PG8_BAR;
            PG8_LDB(B0, 1, 0); PG8_SCHED; PG8_LDA(At, 1, 0); PG8_STAGE(PG8_SA(0, 1), a2 + hstep, voffA);
            PG8_WAIT_L(8); PG8_BAR; PG8_WAIT_L(0); PG8_MMA(0, 0, At, B0); PG8_BAR; PG8_SCHED;
            PG8_LDB(B1, 1, 1); PG8_STAGE(PG8_SB(1, 0), b3, voffB);
            PG8_BAR; PG8_WAIT_L(0); PG8_MMA(0, 1, At, B1); PG8_BAR;
            PG8_LDA(At, 1, 1); PG8_STAGE(PG8_SA(1, 0), a3, voffA);
            PG8_BAR; PG8_WAIT_L(0); PG8_MMA(1, 0, At, B0); PG8_BAR; PG8_SCHED;
            PG8_STAGE(PG8_SB(1, 1), b3 + hstep, voffB);
            PG8_WAIT_V(6); PG8_BAR; PG8_MMA(1, 1, At, B1); PG8_BAR;
        }
        PG8_STAMP();
        if constexpr (!Epi::AFTER_DRAIN) { E(acc, cur, wr, wc, fr, fq); S.done(cur); }
        PG8_STAMP();
        if (!has_next) break;
#pragma unroll
        for (int a = 0; a < 2; ++a)
#pragma unroll
            for (int b = 0; b < 2; ++b)
#pragma unroll
                for (int m = 0; m < 4; ++m)
#pragma unroll
                    for (int n = 0; n < 2; ++n) { float z0; asm volatile("v_mov_b32 %0, 0" : "=v"(z0)); acc[a][b][m][n] = (f32x4){z0, z0, z0, z0}; }
        cur = nxt; cA = nA; cB = nB; ++ui;
    }
    PG8_WAIT_V(0);
    if (wr == 0) PG8_BAR;
    PG8_BAR;
    if constexpr (Epi::AFTER_DRAIN) { E.fused(acc, cur, wr, wc, fr, fq, lds, wid, lane); S.done(cur); }
    PG8_STAMP();
    if (STAMP && wid == 0) { stamps[lane] = lane < nts ? (((unsigned long long)(unsigned)ts_hi << 32) | (unsigned)ts_lo) : 0ull;
        if (lane == 62) stamps[62] = rt_entry; if (lane == 63) stamps[63] = (unsigned long long)wall_clock64(); }
#undef PG8_STAMP
#undef PG8_SA
#undef PG8_SB
#undef PG8_STAGE
#undef PG8_LDA
#undef PG8_LDB
#undef PG8_MMA
#undef PG8_WAIT_V
#undef PG8_WAIT_L
#undef PG8_BAR
#undef PG8_SCHED
}
}

using pg8::cvt_pk_bf16;
DI uint4 pack8(const pg8::f32x4& a, const pg8::f32x4& b) {
  return uint4{cvt_pk_bf16(a[0], a[1]), cvt_pk_bf16(a[2], a[3]), cvt_pk_bf16(b[0], b[1]), cvt_pk_bf16(b[2], b[3])};
}
DI void unpack8(const uint4& u, float (&o)[8]) {
  o[0] = bf2f((u16)(u.x & 0xffff)); o[1] = bf2f((u16)(u.x >> 16));
  o[2] = bf2f((u16)(u.y & 0xffff)); o[3] = bf2f((u16)(u.y >> 16));
  o[4] = bf2f((u16)(u.z & 0xffff)); o[5] = bf2f((u16)(u.z >> 16));
  o[6] = bf2f((u16)(u.w & 0xffff)); o[7] = bf2f((u16)(u.w >> 16));
}
struct EpiP {
  static constexpr bool PERM = true, AFTER_DRAIN = false;
  u16 *zb, *xr, *rwb, *gb; float* dtb; int coff;
  DI void operator()(const pg8::f32x4 (&acc)[2][2][4][2], const pg8::Unit& u, int wr, int wc, int fr, int fq) const {
    const int row0 = u.pm * 256 + wr * 64 + fr;
#pragma unroll
    for (int bj = 0; bj < 2; ++bj) {
      const int cg = coff + u.pn * 256 + bj * 128 + wc * 32;
      const int col0 = cg + 8 * fq;
      if (cg >= 10688) continue;
#pragma unroll
      for (int ai = 0; ai < 2; ++ai)
#pragma unroll
        for (int m = 0; m < 4; ++m) {
          const size_t row = row0 + ai * 128 + m * 16;
          const pg8::f32x4 v0 = acc[ai][bj][m][0], v1 = acc[ai][bj][m][1];
          if (cg >= 5120 && cg < 5184) {
            float* d = dtb + row * 64 + (col0 - 5120);
            *(pg8::f32x4*)d = v0; *(pg8::f32x4*)(d + 4) = v1;
          } else {
            u16* dst = (cg < 2048) ? zb + row * 2048 + col0
                     : (cg < 5120) ? xr + row * 3072 + (col0 - 2048)
                     : (cg < 8640) ? rwb + row * 3456 + (col0 - 5184)
                                   : gb + row * 2048 + (col0 - 8640);
            *(uint4*)dst = pack8(v0, v1);
          }
        }
    }
  }
};
struct EpiOutV {
  static constexpr bool PERM = true, AFTER_DRAIN = false;
  const u16* gb; u16* V; int goff;
  DI void operator()(const pg8::f32x4 (&acc)[2][2][4][2], const pg8::Unit& u, int wr, int wc, int fr, int fq) const {
    const int row0 = u.pm * 256 + wr * 64 + fr;
#pragma unroll
    for (int bj = 0; bj < 2; ++bj) {
      const int col0 = u.pn * 256 + bj * 128 + wc * 32 + 8 * fq;
#pragma unroll
      for (int ai = 0; ai < 2; ++ai)
#pragma unroll
        for (int m = 0; m < 4; ++m) {
          const size_t row = row0 + ai * 128 + m * 16;
          float gt[8];
          unpack8(*(const uint4*)(gb + row * 2048 + goff + col0), gt);
          pg8::f32x4 v0 = acc[ai][bj][m][0], v1 = acc[ai][bj][m][1];
#pragma unroll
          for (int e = 0; e < 4; ++e) { v0[e] *= sigm(gt[e]); v1[e] *= sigm(gt[4 + e]); }
          *(uint4*)(V + row * 1024 + col0) = pack8(v0, v1);
        }
    }
  }
};
struct EpiWo {
  static constexpr bool PERM = true, AFTER_DRAIN = false;
  const float *xp, *xs, *mod; float* out; int tok0;
  DI void operator()(const pg8::f32x4 (&acc)[2][2][4][2], const pg8::Unit& u, int wr, int wc, int fr, int fq) const {
    const int row0 = u.pm * 256 + wr * 64 + fr;
#pragma unroll
    for (int bj = 0; bj < 2; ++bj) {
      const int col0 = u.pn * 256 + bj * 128 + wc * 32 + 8 * fq;
#pragma unroll
      for (int ai = 0; ai < 2; ++ai)
#pragma unroll
        for (int m = 0; m < 4; ++m) {
          const int tok = tok0 + row0 + ai * 128 + m * 16;
          const float* xr = tok < 8192 ? xp + (size_t)tok * 1024 : xs + (size_t)(tok - 8192) * 1024;
          const float* gt = mod + mrow_of(tok) * 6144 + 2048 + col0;
          const pg8::f32x4 x0 = *(const pg8::f32x4*)(xr + col0), x1 = *(const pg8::f32x4*)(xr + col0 + 4);
          const pg8::f32x4 g0 = *(const pg8::f32x4*)gt, g1 = *(const pg8::f32x4*)(gt + 4);
          float* o = out + (size_t)tok * 1024 + col0;
          *(pg8::f32x4*)o = x0 + g0 * acc[ai][bj][m][0];
          *(pg8::f32x4*)(o + 4) = x1 + g1 * acc[ai][bj][m][1];
        }
    }
  }
};
struct EpiGU {
  static constexpr bool PERM = true, AFTER_DRAIN = false;
  u16* act;
  DI void operator()(const pg8::f32x4 (&acc)[2][2][4][2], const pg8::Unit& u, int wr, int wc, int fr, int fq) const {
    const int row0 = u.pm * 256 + wr * 64 + fr;
    const int col0 = u.pn * 128 + wc * 32 + 8 * fq;
#pragma unroll
    for (int ai = 0; ai < 2; ++ai)
#pragma unroll
      for (int m = 0; m < 4; ++m) {
        const size_t row = row0 + ai * 128 + m * 16;
        pg8::f32x4 v0, v1;
#pragma unroll
        for (int e = 0; e < 4; ++e) {
          v0[e] = siluf(acc[ai][0][m][0][e]) * acc[ai][1][m][0][e];
          v1[e] = siluf(acc[ai][0][m][1][e]) * acc[ai][1][m][1][e];
        }
        *(uint4*)(act + ((row >> 8) * 44 + (col0 >> 6)) * 16384 + (row & 255) * 64 + (col0 & 63)) = pack8(v0, v1);
      }
  }
};
struct EpiDown {
  static constexpr bool PERM = true, AFTER_DRAIN = false;
  const float* mod; float* out;
  DI void operator()(const pg8::f32x4 (&acc)[2][2][4][2], const pg8::Unit& u, int wr, int wc, int fr, int fq) const {
    const int row0 = u.pm * 256 + wr * 64 + fr;
#pragma unroll
    for (int bj = 0; bj < 2; ++bj) {
      const int col0 = u.pn * 256 + bj * 128 + wc * 32 + 8 * fq;
#pragma unroll
      for (int ai = 0; ai < 2; ++ai)
#pragma unroll
        for (int m = 0; m < 4; ++m) {
          const int tok = row0 + ai * 128 + m * 16;
          const float* gt = mod + mrow_of(tok) * 6144 + 5120 + col0;
          const pg8::f32x4 g0 = *(const pg8::f32x4*)gt, g1 = *(const pg8::f32x4*)(gt + 4);
          float* o = out + (size_t)tok * 1024 + col0;
          const pg8::f32x4 x0 = *(const pg8::f32x4*)o, x1 = *(const pg8::f32x4*)(o + 4);
          *(pg8::f32x4*)o = x0 + g0 * acc[ai][bj][m][0];
          *(pg8::f32x4*)(o + 4) = x1 + g1 * acc[ai][bj][m][1];
        }
    }
  }
};
template <class Epi>
DI void run_gemm8(char* smem, const u16* A, const u16* Bt, int M, int N, int K, const Epi& E, int vb = -1, int nb = 0, int blk = 0, int ld = 0) {
  if (ld == 0) ld = K;
  asm volatile("" : "+s"(M), "+s"(N), "+s"(K), "+s"(blk), "+s"(ld));
  pg8::Gemm gm{A, Bt, M, N, K, blk, ld};
  pg8::StaticOrder S;
  if (vb < 0) { vb = blockIdx.x; nb = gridDim.x; }
  S.init(M, N, nb, vb);
  pg8::gemm_phase<Epi, pg8::StaticOrder, false>((PG8_LAS unsigned char*)smem, gm, S, E, nullptr);
  __syncthreads();
}

struct EpiR2 {
  static constexpr bool PERM = true, AFTER_DRAIN = false;
  __half* wk; const float *w0, *a0;
  DI void operator()(const pg8::f32x4 (&acc)[2][2][4][2], const pg8::Unit& u, int wr, int wc, int fr, int fq) const {
    const int row0 = u.pm * 256 + wr * 64 + fr;
    const int sec = u.pn >> 2;
#pragma unroll
    for (int bj = 0; bj < 2; ++bj) {
      const int nn = (u.pn & 3) * 256 + bj * 128 + wc * 32 + 8 * fq;
      const int d = sec & 1;
      const float* bias = (sec < 2 ? w0 : a0) + d * 1024 + nn;
      const pg8::f32x4 b0 = *(const pg8::f32x4*)bias, b1 = *(const pg8::f32x4*)(bias + 4);
      const int field = (sec < 2 ? 4 : 5) + 2 * d;
#pragma unroll
      for (int ai = 0; ai < 2; ++ai)
#pragma unroll
        for (int m = 0; m < 4; ++m) {
          const size_t row = row0 + ai * 128 + m * 16;
          pg8::f32x4 v0 = acc[ai][bj][m][0] + b0, v1 = acc[ai][bj][m][1] + b1;
          float o[8];
#pragma unroll
          for (int e = 0; e < 4; ++e) {
            float s0 = sigm(v0[e]), s1 = sigm(v1[e]);
            o[e] = sec < 2 ? __expf(-0.6065306597f * s0) : s0;
            o[4 + e] = sec < 2 ? __expf(-0.6065306597f * s1) : s1;
          }
          __half2 h0 = __floats2half2_rn(o[0], o[1]), h1 = __floats2half2_rn(o[2], o[3]);
          __half2 h2 = __floats2half2_rn(o[4], o[5]), h3 = __floats2half2_rn(o[6], o[7]);
          uint4 pk;
          pk.x = *reinterpret_cast<unsigned*>(&h0); pk.y = *reinterpret_cast<unsigned*>(&h1);
          pk.z = *reinterpret_cast<unsigned*>(&h2); pk.w = *reinterpret_cast<unsigned*>(&h3);
          *(uint4*)(wk + ((row * 16 + (nn >> 6)) * 8 + field) * 64 + (nn & 63)) = pk;
        }
    }
  }
};

template <int MODE>
__device__ __forceinline__ void convT(const float* __restrict__ src, int K, int N, u16* __restrict__ dst, char* smem, int vb = -1, int nb = 0, int ldd = 0) {
  if (ldd == 0) ldd = K;
  float* tile = (float*)smem;
  const int tid = get_tid();
  const int KT = K >> 6, NT = N >> 6;
  if (vb < 0) { vb = blockIdx.x; nb = gridDim.x; }
  for (int t = vb; t < KT * NT; t += nb) {
    int kt = t % KT, nt = t / KT;
#pragma unroll
    for (int i = 0; i < 2; ++i) {
      int idx = tid + i * 512;
      int r = idx >> 4, c4 = idx & 15;
      *(float4*)(tile + r * 68 + c4 * 4) = *(const float4*)(src + (size_t)(kt * 64 + r) * N + nt * 64 + c4 * 4);
    }
    __syncthreads();
    int n = tid >> 3, kc = tid & 7;
    unsigned w[4];
#pragma unroll
    for (int j = 0; j < 4; ++j)
      w[j] = pack2(tile[(kc * 8 + 2 * j) * 68 + n], tile[(kc * 8 + 2 * j + 1) * 68 + n]);
    int ng = nt * 64 + n;
    int row = ng;
    if (MODE == 1) {
      int isu = ng >= 2816;
      int nn = ng - isu * 2816;
      row = (nn >> 7) * 256 + isu * 128 + (nn & 127);
    }
    if (MODE == 2) *(uint4*)(dst + ((size_t)(row >> 8) * KT + kt) * 16384 + (row & 255) * 64 + kc * 8) = uint4{w[0], w[1], w[2], w[3]};
    else *(uint4*)(dst + (size_t)row * ldd + kt * 64 + kc * 8) = uint4{w[0], w[1], w[2], w[3]};
    __syncthreads();
  }
}

__device__ __forceinline__ void step_prep(const Params& p, char* smem) {
  const int tid = get_tid();
  char* ws = p.ws;
  {
    float* red = (float*)smem;
    float* mod = (float*)(ws + OFF_MOD);
    for (int item = blockIdx.x; item < 192; item += gridDim.x) {
      int c4 = tid & 7, kl = tid >> 3;
      float acc[12];
#pragma unroll
      for (int i = 0; i < 12; ++i) acc[i] = 0.f;
      for (int k = kl; k < 1024; k += 64) {
        float4 w = *(const float4*)(p.w_ada + (size_t)k * 6144 + item * 32 + c4 * 4);
        float s0 = siluf(p.c_ctx[k]), s1 = siluf(p.c[k]), s2 = siluf(p.c[1024 + k]);
        acc[0] += s0 * w.x; acc[1] += s0 * w.y; acc[2] += s0 * w.z; acc[3] += s0 * w.w;
        acc[4] += s1 * w.x; acc[5] += s1 * w.y; acc[6] += s1 * w.z; acc[7] += s1 * w.w;
        acc[8] += s2 * w.x; acc[9] += s2 * w.y; acc[10] += s2 * w.z; acc[11] += s2 * w.w;
      }
#pragma unroll
      for (int i = 0; i < 12; ++i) red[(kl * 8 + c4) * 12 + i] = acc[i];
      __syncthreads();
      if (tid < 96) {
        int cond = tid >> 5, col = tid & 31;
        int cc4 = col >> 2, e = col & 3;
        float s = 0.f;
        for (int k = 0; k < 64; ++k) s += red[(k * 8 + cc4) * 12 + cond * 4 + e];
        int n = item * 32 + col;
        mod[cond * 6144 + n] = s + p.b_ada[n];
      }
      __syncthreads();
    }
  }
  convT<0>(p.w_in, 1024, 10688, (u16*)(ws + OFF_WIN), smem);
  convT<0>(p.w_m_out, 2048, 1024, (u16*)(ws + OFF_WMOUT), smem);
  convT<0>(p.w_r_out, 1024, 1024, (u16*)(ws + OFF_WROUT), smem);
  convT<0>(p.w_o, 1024, 1024, (u16*)(ws + OFF_WO), smem);
  convT<0>(p.w2, 64, 1024, (u16*)(ws + OFF_W2T), smem);
  convT<0>(p.w2 + 65536, 64, 1024, (u16*)(ws + OFF_W2T) + 65536, smem);
  convT<0>(p.a2, 64, 1024, (u16*)(ws + OFF_A2T), smem);
  convT<0>(p.a2 + 65536, 64, 1024, (u16*)(ws + OFF_A2T) + 65536, smem);
  convT<0>(p.g2, 128, 1024, (u16*)(ws + OFF_G2T), smem);
  {
    u16* w4 = (u16*)(ws + OFF_W4T);
    convT<0>(p.w2, 64, 1024, w4 + (size_t)0 * 1024 * 256 + 0, smem, -1, 0, 256);
    convT<0>(p.w2 + 65536, 64, 1024, w4 + (size_t)1 * 1024 * 256 + 64, smem, -1, 0, 256);
    convT<0>(p.a2, 64, 1024, w4 + (size_t)2 * 1024 * 256 + 128, smem, -1, 0, 256);
    convT<0>(p.a2 + 65536, 64, 1024, w4 + (size_t)3 * 1024 * 256 + 192, smem, -1, 0, 256);
    for (int i = blockIdx.x * NTHR + tid; i < 4096 * 32; i += gridDim.x * NTHR) {
      int row = i >> 5, c = i & 31;
      if ((c >> 3) != (row >> 10)) *(uint4*)(w4 + (size_t)row * 256 + c * 8) = uint4{0, 0, 0, 0};
    }
  }
  {
    uint4* z = (uint4*)(ws + OFF_WIN + (size_t)10688 * 1024 * 2);
    for (int i = blockIdx.x * NTHR + tid; i < 8192; i += gridDim.x * NTHR) z[i] = uint4{0, 0, 0, 0};
  }
}

template <int WHICH>
__device__ __forceinline__ void step_norm(const Params& p, int g) {
  const int tid = get_tid(), lane = tid & 63, wave = tid >> 6;
  const float* mod = (const float*)(p.ws + OFF_MOD);
  const int nrows = WHICH == 0 ? TG : NTOK;
  u16* dst = WHICH == 0 ? (u16*)((char*)p.out + H1_OUT_OFF) : (u16*)(p.ws + OFF_H2);
  const float* nw = WHICH == 0 ? p.norm1_w : p.norm2_w;
  for (int r = blockIdx.x * 8 + wave; r < nrows; r += gridDim.x * 8) {
    int tok = WHICH == 0 ? g * TG + r : r;
    const float* xr;
    if (WHICH == 0) xr = tok < 8192 ? p.x_prompt + (size_t)tok * 1024 : p.x_sample + (size_t)(tok - 8192) * 1024;
    else xr = (const float*)(p.ws + OFF_X1) + (size_t)tok * 1024;
    const float* mr = mod + mrow_of(tok) * 6144 + (WHICH == 0 ? 0 : 3072);
    float4 v[4];
    float ss = 0.f;
#pragma unroll
    for (int i = 0; i < 4; ++i) {
      v[i] = ((const float4*)xr)[i * 64 + lane];
      ss += v[i].x * v[i].x + v[i].y * v[i].y + v[i].z * v[i].z + v[i].w * v[i].w;
    }
    ss = wave_sum(ss);
    float rinv = rsqrtf(ss * (1.f / 1024.f) + 1e-6f);
#pragma unroll
    for (int i = 0; i < 4; ++i) {
      int col = (i * 64 + lane) * 4;
      float4 w4 = *(const float4*)(nw + col);
      float4 sh = *(const float4*)(mr + col);
      float4 sc = *(const float4*)(mr + 1024 + col);
      float h0 = v[i].x * rinv * w4.x * (1.f + sc.x) + sh.x;
      float h1 = v[i].y * rinv * w4.y * (1.f + sc.y) + sh.y;
      float h2 = v[i].z * rinv * w4.z * (1.f + sc.z) + sh.z;
      float h3 = v[i].w * rinv * w4.w * (1.f + sc.w) + sh.w;
      *(uint2*)(dst + (size_t)r * 1024 + col) = uint2{pack2(h0, h1), pack2(h2, h3)};
    }
  }
}

__device__ __forceinline__ void step_gemm1(const Params& p, char* smem, int part) {
  char* ws = p.ws;
  const u16* H1 = (const u16*)((const char*)p.out + H1_OUT_OFF);
  const u16* W = (const u16*)(ws + OFF_WIN);
  if (part == 0) {
    EpiP E{(u16*)(ws + OFF_Z), (u16*)(ws + OFF_XBCRAW), (u16*)(ws + OFF_RW), (u16*)(ws + OFF_GATE), (float*)(ws + OFF_DT), 0};
    run_gemm8(smem, H1, W, TG, NPAD, 1024, E);
  } else if (part == 1) {
    EpiP E{(u16*)(ws + OFF_Z), (u16*)(ws + OFF_XBCRAW), (u16*)(ws + OFF_RW), (u16*)(ws + OFF_GATE), (float*)(ws + OFF_DT), 0};
    run_gemm8(smem, H1, W, TG, 5120, 1024, E, (int)blockIdx.x - 64, (int)gridDim.x - 64);
  } else {
    EpiP E{(u16*)(ws + OFF_Z), (u16*)(ws + OFF_XBCRAW), (u16*)(ws + OFF_RW), (u16*)(ws + OFF_GATE), (float*)(ws + OFF_DT), 5120};
    run_gemm8(smem, H1, W + (size_t)5120 * 1024, TG, NPAD - 5120, 1024, E);
  }
}

__device__ __forceinline__ void step_cr1(const Params& p, int g) {
  char* ws = p.ws;
  const int tid = get_tid(), lane = tid & 63, wave = tid >> 6;
  const int Ls = g < 2 ? 256 : 2048;
  {
    const u16* __restrict__ xr = (const u16*)(ws + OFF_XBCRAW);
    u16* __restrict__ xo = (u16*)(ws + OFF_XBC);
    for (int item = blockIdx.x * NTHR + tid; item < (TG / 8) * 384; item += gridDim.x * NTHR) {
      const int rb = item / 384, cc = item - rb * 384;
      const int r0 = rb * 8, pos0 = r0 & (Ls - 1);
      uint4 rows[12];
#pragma unroll
      for (int i = 0; i < 12; ++i) {
        const int pp = pos0 + i - 2;
        rows[i] = uint4{0, 0, 0, 0};
        if (pp >= 0 && pp < Ls) rows[i] = *(const uint4*)(xr + (size_t)(r0 + i - 2) * 3072 + cc * 8);
      }
      float w[5][8], bias[8];
      {
        float4 b0 = *(const float4*)(p.conv_b + cc * 8), b1 = *(const float4*)(p.conv_b + cc * 8 + 4);
        bias[0] = b0.x; bias[1] = b0.y; bias[2] = b0.z; bias[3] = b0.w; bias[4] = b1.x; bias[5] = b1.y; bias[6] = b1.z; bias[7] = b1.w;
#pragma unroll
        for (int i = 0; i < 5; ++i) {
          float4 w0 = *(const float4*)(p.conv_w + i * 3072 + cc * 8), w1 = *(const float4*)(p.conv_w + i * 3072 + cc * 8 + 4);
          w[i][0] = w0.x; w[i][1] = w0.y; w[i][2] = w0.z; w[i][3] = w0.w; w[i][4] = w1.x; w[i][5] = w1.y; w[i][6] = w1.z; w[i][7] = w1.w;
        }
      }
      float s[8][8];
#pragma unroll
      for (int o = 0; o < 8; ++o)
#pragma unroll
        for (int e = 0; e < 8; ++e) s[o][e] = bias[e];
#pragma unroll
      for (int i = 0; i < 12; ++i) {
        float xv[8];
        unpack8(rows[i], xv);
#pragma unroll
        for (int k = 0; k < 5; ++k) {
          const int o = i - k;
          if (o >= 0 && o < 8) {
#pragma unroll
            for (int e = 0; e < 8; ++e) s[o][e] += xv[e] * w[k][e];
          }
        }
      }
#pragma unroll
      for (int o = 0; o < 8; ++o) {
#pragma unroll
        for (int e = 0; e < 8; ++e) s[o][e] = siluf(s[o][e]);
        *(uint4*)(xo + (size_t)(r0 + o) * 3072 + cc * 8) = uint4{pack2(s[o][0], s[o][1]), pack2(s[o][2], s[o][3]), pack2(s[o][4], s[o][5]), pack2(s[o][6], s[o][7])};
      }
    }
  }
  {
    const u16* __restrict__ rw = (const u16*)(ws + OFF_RW);
    __half* __restrict__ wk = (__half*)(ws + OFF_WK);
    u16* __restrict__ tl = (u16*)(ws + OFF_TL);
    u16* __restrict__ sg = (u16*)(ws + OFF_SG);
    const bool grid = (g == 2);
    for (int r = blockIdx.x * 8 + wave; r < TG; r += gridDim.x * 8) {
      const int pos = r & (Ls - 1);
      uint4 cur[7], shv[7];
#pragma unroll
      for (int it = 0; it < 7; ++it) {
        const int ci = it * 64 + lane;
        cur[it] = uint4{0, 0, 0, 0};
        shv[it] = uint4{0, 0, 0, 0};
        if (ci < 432) {
          const int q = ci / 108;
          int dr;
          bool ok;
          if (!grid) {
            if (q & 1) { dr = 1; ok = pos < Ls - 1; } else { dr = -1; ok = pos > 0; }
          } else {
            if (q == 0) { dr = -1; ok = (pos & 63) != 0; }
            else if (q == 1) { dr = 1; ok = (pos & 63) != 63; }
            else if (q == 2) { dr = -64; ok = pos >= 64; }
            else { dr = 64; ok = pos < Ls - 64; }
          }
          cur[it] = *(const uint4*)(rw + (size_t)r * 3456 + ci * 8);
          if (ok) shv[it] = *(const uint4*)(rw + (size_t)(r + dr) * 3456 + ci * 8);
        }
      }
#pragma unroll
      for (int it = 0; it < 7; ++it) {
        const int ci = it * 64 + lane;
        const bool valid = ci < 432;
        float xx[8];
        {
          float cf[8], sf[8];
          unpack8(cur[it], cf);
          unpack8(shv[it], sf);
          const int cm = valid ? ci * 8 : 0;
          const float4 m0 = *(const float4*)(p.mu_shift + cm), m1 = *(const float4*)(p.mu_shift + cm + 4);
          const float mu[8] = {m0.x, m0.y, m0.z, m0.w, m1.x, m1.y, m1.z, m1.w};
#pragma unroll
          for (int e = 0; e < 8; ++e) xx[e] = cf[e] + mu[e] * (sf[e] - cf[e]);
        }
        const bool isk = valid && ci >= 144 && ci < 272;
        float kk[8];
        float ss = 0.f;
        {
          const int kc = isk ? ci - 144 : 0;
          const float4 k0 = *(const float4*)(p.k_k + kc * 8), k1 = *(const float4*)(p.k_k + kc * 8 + 4);
          const float kkw[8] = {k0.x, k0.y, k0.z, k0.w, k1.x, k1.y, k1.z, k1.w};
#pragma unroll
          for (int e = 0; e < 8; ++e) { kk[e] = xx[e] * kkw[e]; ss += kk[e] * kk[e]; }
        }
        ss += dpp_xor1(ss);
        ss += dpp_xor2(ss);
        ss += dpp_hmirror(ss);
        if (valid) {
          if (ci < 128) {
            __half2 h0 = __floats2half2_rn(xx[0], xx[1]), h1 = __floats2half2_rn(xx[2], xx[3]), h2 = __floats2half2_rn(xx[4], xx[5]), h3 = __floats2half2_rn(xx[6], xx[7]);
            uint4 pk{*reinterpret_cast<unsigned*>(&h0), *reinterpret_cast<unsigned*>(&h1), *reinterpret_cast<unsigned*>(&h2), *reinterpret_cast<unsigned*>(&h3)};
            *(uint4*)(wk + ((size_t)(r * 16 + (ci >> 3)) * 8 + 0) * 64 + (ci & 7) * 8) = pk;
          } else if (ci < 144) {
            float t[8];
#pragma unroll
            for (int e = 0; e < 8; ++e) t[e] = tanhf(xx[e]);
            *(uint4*)(tl + (size_t)r * 256 + (ci - 128) * 8) = uint4{pack2(t[0], t[1]), pack2(t[2], t[3]), pack2(t[4], t[5]), pack2(t[6], t[7])};
          } else if (ci < 272) {
            const int kc = ci - 144;
            const float rn = -rsqrtf(ss + 1e-12f);
            __half2 h0 = __floats2half2_rn(xx[0], xx[1]), h1 = __floats2half2_rn(xx[2], xx[3]), h2 = __floats2half2_rn(xx[4], xx[5]), h3 = __floats2half2_rn(xx[6], xx[7]);
            uint4 pk{*reinterpret_cast<unsigned*>(&h0), *reinterpret_cast<unsigned*>(&h1), *reinterpret_cast<unsigned*>(&h2), *reinterpret_cast<unsigned*>(&h3)};
            *(uint4*)(wk + ((size_t)(r * 16 + (kc >> 3)) * 8 + 2) * 64 + (kc & 7) * 8) = pk;
            __half2 n0 = __floats2half2_rn(kk[0] * rn, kk[1] * rn), n1 = __floats2half2_rn(kk[2] * rn, kk[3] * rn), n2 = __floats2half2_rn(kk[4] * rn, kk[5] * rn), n3 = __floats2half2_rn(kk[6] * rn, kk[7] * rn);
            uint4 pn{*reinterpret_cast<unsigned*>(&n0), *reinterpret_cast<unsigned*>(&n1), *reinterpret_cast<unsigned*>(&n2), *reinterpret_cast<unsigned*>(&n3)};
            *(uint4*)(wk + ((size_t)(r * 16 + (kc >> 3)) * 8 + 3) * 64 + (kc & 7) * 8) = pn;
          } else if (ci < 400) {
            const int vc = ci - 272;
            __half2 h0 = __floats2half2_rn(xx[0], xx[1]), h1 = __floats2half2_rn(xx[2], xx[3]), h2 = __floats2half2_rn(xx[4], xx[5]), h3 = __floats2half2_rn(xx[6], xx[7]);
            uint4 pk{*reinterpret_cast<unsigned*>(&h0), *reinterpret_cast<unsigned*>(&h1), *reinterpret_cast<unsigned*>(&h2), *reinterpret_cast<unsigned*>(&h3)};
            *(uint4*)(wk + ((size_t)(r * 16 + (vc >> 3)) * 8 + 1) * 64 + (vc & 7) * 8) = pk;
          } else if (ci < 416) {
            *(uint4*)(tl + (size_t)r * 256 + 128 + (ci - 400) * 8) = uint4{pack2(xx[0], xx[1]), pack2(xx[2], xx[3]), pack2(xx[4], xx[5]), pack2(xx[6], xx[7])};
          } else {
            float t[8];
#pragma unroll
            for (int e = 0; e < 8; ++e) t[e] = sigm(xx[e]);
            *(uint4*)(sg + (size_t)r * 128 + (ci - 416) * 8) = uint4{pack2(t[0], t[1]), pack2(t[2], t[3]), pack2(t[4], t[5]), pack2(t[6], t[7])};
          }
        }
      }
    }
  }
}

__device__ __forceinline__ void step_r2(const Params& p, char* smem) {
  char* ws = p.ws;
  const int tid = get_tid(), lane = tid & 63, wave = tid >> 6;
  const int wm = wave >> 1, wn = wave & 1;
  const u16* tl = (const u16*)(ws + OFF_TL);
  const u16* sg = (const u16*)(ws + OFF_SG);
  __half* wk = (__half*)(ws + OFF_WK);
  u16* gr = (u16*)(ws + OFF_GR);
  {
    EpiR2 E{wk, p.w0, p.a0};
    run_gemm8(smem, tl, (const u16*)(ws + OFF_W4T), TG, 4096, 256, E);
  }
  for (int t = (gridDim.x - 1 - blockIdx.x) + 4 * 128; t < 5 * 128; t += gridDim.x) {
    int sub = t >> 7, rem = t & 127;
    int mt = rem & 15, nt = rem >> 4;
    f32x4 acc[4][4];
    zero_acc(acc);
    if (sub < 2) {
      gemm_acc(tl + (size_t)mt * 256 * 256 + sub * 64, 256, (const u16*)(ws + OFF_W2T) + sub * 65536 + (size_t)nt * 128 * 64, 64, 64, acc, smem);
    } else if (sub < 4) {
      gemm_acc(tl + (size_t)mt * 256 * 256 + 128 + (sub - 2) * 64, 256, (const u16*)(ws + OFF_A2T) + (sub - 2) * 65536 + (size_t)nt * 128 * 64, 64, 64, acc, smem);
    } else {
      gemm_acc(sg + (size_t)mt * 256 * 128, 128, (const u16*)(ws + OFF_G2T) + (size_t)nt * 128 * 128, 128, 128, acc, smem);
    }
#pragma unroll
    for (int mf = 0; mf < 4; ++mf)
#pragma unroll
      for (int nf = 0; nf < 4; ++nf)
#pragma unroll
        for (int j = 0; j < 4; ++j) {
          if (nf == 0 && j == 0) asm volatile("" ::: "memory");
          int m = mt * 256 + wm * 64 + mf * 16 + (lane >> 4) * 4 + j;
          int n = nt * 128 + wn * 64 + nf * 16 + (lane & 15);
          float v = acc[mf][nf][j];
          if (sub < 2) {
            float wl = v + p.w0[sub * 1024 + n];
            float dec = __expf(-0.6065306597f * sigm(wl));
            wk[((size_t)(m * 16 + (n >> 6)) * 8 + 4 + 2 * sub) * 64 + (n & 63)] = __float2half(dec);
          } else if (sub < 4) {
            int d = sub - 2;
            float a = sigm(v + p.a0[d * 1024 + n]);
            wk[((size_t)(m * 16 + (n >> 6)) * 8 + 5 + 2 * d) * 64 + (n & 63)] = __float2half(a);
          } else {
            gr[(size_t)m * 1024 + n] = f2bf(v);
          }
        }
  }
}

DI int swz16(int row) { return (row ^ (row >> 3)) & 15; }
DI int sw256(int row, int e) { return row * 256 + ((((e >> 3) ^ swz16(row))) << 4) + (e & 7) * 2; }
DI const bf16x8 ldfrag256(const char* base, int row, int ch) {
  return *(const bf16x8*)(base + row * 256 + ((ch ^ swz16(row)) << 4));
}

typedef unsigned v4u __attribute__((ext_vector_type(4)));
struct SsdPre { v4u c0, c1, c2, c3, b0, b1, b2, b3, x0, x1; float d0, d1; };
DI void ssd_issue(const Params& p, int g, int chain, int ci, int tid, SsdPre& R) {
  const int Ls = g < 2 ? 256 : 2048;
  const int nch = Ls >> 7;
  const int d = chain & 1, h = (chain >> 1) & 31, b = chain >> 6;
  const int grp = h >> 3;
  const int c = d ? nch - 1 - ci : ci;
  const int tok0 = b * Ls + c * 128;
  const u16* xbc = (const u16*)(p.ws + OFF_XBC);
  const float* dtb = (const float*)(p.ws + OFF_DT);
  const int lane = tid & 63, wave = tid >> 6;
#define SSD_LDCB(i, CF, BF) { int idx = tid + i * 512; int row = idx >> 4, ch = idx & 15; \
    const u16* src = xbc + (size_t)(tok0 + row) * 3072 + grp * 128 + ch * 8; R.CF = *(const v4u*)(src + 2560); R.BF = *(const v4u*)(src + 2048); }
  SSD_LDCB(0, c0, b0) SSD_LDCB(1, c1, b1) SSD_LDCB(2, c2, b2) SSD_LDCB(3, c3, b3)
#undef SSD_LDCB
#define SSD_LDX(i, XF) { int idx = tid + i * 512; int l = idx >> 3, ch = idx & 7; R.XF = *(const v4u*)(xbc + (size_t)(tok0 + l) * 3072 + h * 64 + ch * 8); }
  SSD_LDX(0, x0) SSD_LDX(1, x1)
#undef SSD_LDX
  if (wave == 0) {
    int e0 = 2 * lane, e1 = 2 * lane + 1;
    int l0 = d ? 127 - e0 : e0, l1 = d ? 127 - e1 : e1;
    R.d0 = dtb[(size_t)(tok0 + l0) * 64 + d * 32 + h];
    R.d1 = dtb[(size_t)(tok0 + l1) * 64 + d * 32 + h];
  }
}

__device__ __forceinline__ void ssd_chain(const Params& p, char* smem, int g, int chain, int next_chain, SsdPre& R) {
  char* ws = p.ws;
  const int tid = get_tid(), lane = tid & 63, wave = tid >> 6;
  const int Ls = g < 2 ? 256 : 2048;
  const int nch = Ls >> 7;
  const int d = chain & 1, h = (chain >> 1) & 31, b = chain >> 6;
  const int grp = h >> 3;
  const u16* xbc = (const u16*)(ws + OFF_XBC);
  const float* dtb = (const float*)(ws + OFF_DT);
  u16* yout = (u16*)(ws + (d ? OFF_SYB : OFF_SYF));
  char* Cs = smem;
  char* Bs = smem + 32768;
  char* BdT = smem + 65536;
  char* XT = smem + 98304;
  char* Ss = smem + 114688;
  float* csum = (float*)(smem + 131072);
  float* dts = (float*)(smem + 131584);
  const float a_h = -__expf(p.a_log[d * 32 + h]);
  const float dtbias = p.dt_bias[d * 32 + h];
  f32x4 sacc[2][2];
  {
    const int wn4 = wave >> 1, wp2 = wave & 1;
#pragma unroll
    for (int nf = 0; nf < 2; ++nf)
#pragma unroll
      for (int pf = 0; pf < 2; ++pf) {
        if (g == 2) {
          const float* h0 = (d ? p.ssm_b : p.ssm_f) + (size_t)(b * 32 + h) * 8192;
          const int n0 = wn4 * 32 + nf * 16 + (lane >> 4) * 4, pp = wp2 * 32 + pf * 16 + (lane & 15);
          const float4 t = *(const float4*)(h0 + pp * 128 + n0);
          sacc[nf][pf] = f32x4{t.x, t.y, t.z, t.w};
        } else {
          sacc[nf][pf] = f32x4{0.f, 0.f, 0.f, 0.f};
        }
      }
  }
  const int tid_outer = tid;
  for (int ci = 0; ci < nch; ++ci) {
    int tidv = tid_outer;
    asm volatile("" : "+v"(tidv));
    const int tid = tidv, lane = tidv & 63, wave = tidv >> 6;
    const int wq4 = wave >> 1, wq2 = wave & 1;
    const int c = d ? nch - 1 - ci : ci;
    const int tok0 = b * Ls + c * 128;
#define SSD_STCB(i, CF, BF) { int idx = tid + i * 512; int row = idx >> 4, ch = idx & 15; \
      *(v4u*)(Cs + row * 256 + ((ch ^ swz16(row)) << 4)) = R.CF; *(v4u*)(Bs + row * 256 + ((ch ^ swz16(row)) << 4)) = R.BF; }
    SSD_STCB(0, c0, b0) SSD_STCB(1, c1, b1) SSD_STCB(2, c2, b2) SSD_STCB(3, c3, b3)
#undef SSD_STCB
#define SSD_STX(i, XF) { int idx = tid + i * 512; int l = idx >> 3, ch = idx & 7; \
      const unsigned w0 = R.XF[0], w1 = R.XF[1], w2 = R.XF[2], w3 = R.XF[3]; \
      *(u16*)(XT + sw256(ch * 8 + 0, l)) = (u16)(w0 & 0xffff); *(u16*)(XT + sw256(ch * 8 + 1, l)) = (u16)(w0 >> 16); \
      *(u16*)(XT + sw256(ch * 8 + 2, l)) = (u16)(w1 & 0xffff); *(u16*)(XT + sw256(ch * 8 + 3, l)) = (u16)(w1 >> 16); \
      *(u16*)(XT + sw256(ch * 8 + 4, l)) = (u16)(w2 & 0xffff); *(u16*)(XT + sw256(ch * 8 + 5, l)) = (u16)(w2 >> 16); \
      *(u16*)(XT + sw256(ch * 8 + 6, l)) = (u16)(w3 & 0xffff); *(u16*)(XT + sw256(ch * 8 + 7, l)) = (u16)(w3 >> 16); }
    SSD_STX(0, x0) SSD_STX(1, x1)
#undef SSD_STX
    if (wave == 0) {
      int e0 = 2 * lane, e1 = 2 * lane + 1;
      int l0 = d ? 127 - e0 : e0, l1 = d ? 127 - e1 : e1;
      float x0 = R.d0 + dtbias;
      float x1 = R.d1 + dtbias;
      float dt0 = x0 > 20.f ? x0 : log1pf(__expf(x0));
      float dt1 = x1 > 20.f ? x1 : log1pf(__expf(x1));
      float a0 = dt0 * a_h, a1 = dt1 * a_h;
      float s = a0 + a1;
#pragma unroll
      for (int o = 1; o < 64; o <<= 1) {
        float t = __shfl_up(s, o);
        if (lane >= o) s += t;
      }
      csum[l1] = s;
      csum[l0] = s - a1;
      dts[l0] = dt0;
      dts[l1] = dt1;
    }
    if (ci + 1 < nch) ssd_issue(p, g, chain, ci + 1, tid, R);
    else if (next_chain >= 0) ssd_issue(p, g, next_chain, 0, tid, R);
#pragma unroll
    for (int nf = 0; nf < 2; ++nf)
#pragma unroll
      for (int pf = 0; pf < 2; ++pf) {
        const int n0 = wq4 * 32 + nf * 16 + (lane >> 4) * 4, pp = wq2 * 32 + pf * 16 + (lane & 15);
        *(uint2*)(Ss + sw256(pp, n0)) = uint2{pack2(sacc[nf][pf][0], sacc[nf][pf][1]), pack2(sacc[nf][pf][2], sacc[nf][pf][3])};
      }
    __syncthreads();
    const float cstot = csum[d ? 0 : 127];
#pragma unroll
    for (int i = 0; i < 4; ++i) {
      int idx = tid + i * 512;
      int l = idx >> 4, ch = idx & 15;
      uint4 bv = *(const uint4*)(Bs + l * 256 + ((ch ^ swz16(l)) << 4));
      float f = dts[l] * __expf(cstot - csum[l]);
      unsigned w[4] = {bv.x, bv.y, bv.z, bv.w};
#pragma unroll
      for (int e = 0; e < 8; ++e) {
        int n = ch * 8 + e;
        float val = bf2f((u16)((w[e >> 1] >> ((e & 1) * 16)) & 0xffff)) * f;
        *(u16*)(BdT + sw256(n, l)) = f2bf(val);
      }
    }
    f32x4 gacc[2][4];
#pragma unroll
    for (int i = 0; i < 2; ++i)
#pragma unroll
      for (int j = 0; j < 4; ++j) gacc[i][j] = f32x4{0.f, 0.f, 0.f, 0.f};
#pragma unroll
    for (int ks = 0; ks < 4; ++ks) {
      int ch = ks * 4 + (lane >> 4);
      bf16x8 a[2], bb[4];
#pragma unroll
      for (int sf = 0; sf < 2; ++sf) a[sf] = ldfrag256(Bs, wq4 * 32 + sf * 16 + (lane & 15), ch);
#pragma unroll
      for (int lf = 0; lf < 4; ++lf) bb[lf] = ldfrag256(Cs, wq2 * 64 + lf * 16 + (lane & 15), ch);
#pragma unroll
      for (int sf = 0; sf < 2; ++sf)
#pragma unroll
        for (int lf = 0; lf < 4; ++lf)
          gacc[sf][lf] = __builtin_amdgcn_mfma_f32_16x16x32_bf16(a[sf], bb[lf], gacc[sf][lf], 0, 0, 0);
    }
    {
      float css[2][4], dss[2][4];
#pragma unroll
      for (int sf = 0; sf < 2; ++sf)
#pragma unroll
        for (int j = 0; j < 4; ++j) {
          const int sI = wq4 * 32 + sf * 16 + (lane >> 4) * 4 + j;
          css[sf][j] = csum[sI];
          dss[sf][j] = dts[sI];
        }
#pragma unroll
      for (int lf = 0; lf < 4; ++lf) {
        const int l = wq2 * 64 + lf * 16 + (lane & 15);
        const float csl = csum[l];
#pragma unroll
        for (int sf = 0; sf < 2; ++sf)
#pragma unroll
          for (int j = 0; j < 4; ++j) {
            const int sI = wq4 * 32 + sf * 16 + (lane >> 4) * 4 + j;
            const bool valid = d ? (sI >= l) : (sI <= l);
            const float e = valid ? __expf(csl - css[sf][j]) * dss[sf][j] : 0.f;
            gacc[sf][lf][j] *= e;
          }
      }
    }
    __syncthreads();
#pragma unroll
    for (int sf = 0; sf < 2; ++sf)
#pragma unroll
      for (int lf = 0; lf < 4; ++lf) {
        const int s0 = wq4 * 32 + sf * 16 + (lane >> 4) * 4, l = wq2 * 64 + lf * 16 + (lane & 15);
        *(uint2*)(Bs + sw256(l, s0)) = uint2{pack2(gacc[sf][lf][0], gacc[sf][lf][1]), pack2(gacc[sf][lf][2], gacc[sf][lf][3])};
      }
    __syncthreads();
    {
      f32x4 yacc[2][2];
#pragma unroll
      for (int i = 0; i < 2; ++i)
#pragma unroll
        for (int j = 0; j < 2; ++j) yacc[i][j] = f32x4{0.f, 0.f, 0.f, 0.f};
#pragma unroll
      for (int ks = 0; ks < 4; ++ks) {
        int ch = ks * 4 + (lane >> 4);
        bf16x8 a[2], bb[2];
#pragma unroll
        for (int pf = 0; pf < 2; ++pf) a[pf] = ldfrag256(Ss, wq2 * 32 + pf * 16 + (lane & 15), ch);
#pragma unroll
        for (int lf = 0; lf < 2; ++lf) bb[lf] = ldfrag256(Cs, wq4 * 32 + lf * 16 + (lane & 15), ch);
#pragma unroll
        for (int pf = 0; pf < 2; ++pf)
#pragma unroll
          for (int lf = 0; lf < 2; ++lf)
            yacc[pf][lf] = __builtin_amdgcn_mfma_f32_16x16x32_bf16(a[pf], bb[lf], yacc[pf][lf], 0, 0, 0);
      }
#pragma unroll
      for (int lf = 0; lf < 2; ++lf) {
        const float e = __expf(csum[wq4 * 32 + lf * 16 + (lane & 15)]);
#pragma unroll
        for (int pf = 0; pf < 2; ++pf) yacc[pf][lf] *= e;
      }
#pragma unroll
      for (int ks = 0; ks < 4; ++ks) {
        int ch = ks * 4 + (lane >> 4);
        bf16x8 a[2], bb[2];
#pragma unroll
        for (int pf = 0; pf < 2; ++pf) a[pf] = ldfrag256(XT, wq2 * 32 + pf * 16 + (lane & 15), ch);
#pragma unroll
        for (int lf = 0; lf < 2; ++lf) bb[lf] = ldfrag256(Bs, wq4 * 32 + lf * 16 + (lane & 15), ch);
#pragma unroll
        for (int pf = 0; pf < 2; ++pf)
#pragma unroll
          for (int lf = 0; lf < 2; ++lf)
            yacc[pf][lf] = __builtin_amdgcn_mfma_f32_16x16x32_bf16(a[pf], bb[lf], yacc[pf][lf], 0, 0, 0);
      }
#pragma unroll
      for (int pf = 0; pf < 2; ++pf)
#pragma unroll
        for (int lf = 0; lf < 2; ++lf) {
          const int p0 = wq2 * 32 + pf * 16 + (lane >> 4) * 4, l = wq4 * 32 + lf * 16 + (lane & 15);
          *(uint2*)(yout + (size_t)(tok0 + l) * 2048 + h * 64 + p0) = uint2{pack2(yacc[pf][lf][0], yacc[pf][lf][1]), pack2(yacc[pf][lf][2], yacc[pf][lf][3])};
        }
    }
    {
      float e = __expf(cstot);
#pragma unroll
      for (int nf = 0; nf < 2; ++nf)
#pragma unroll
        for (int pf = 0; pf < 2; ++pf) sacc[nf][pf] *= e;
#pragma unroll
      for (int ks = 0; ks < 4; ++ks) {
        int ch = ks * 4 + (lane >> 4);
        bf16x8 a[2], bb[2];
#pragma unroll
        for (int nf = 0; nf < 2; ++nf) a[nf] = ldfrag256(BdT, wq4 * 32 + nf * 16 + (lane & 15), ch);
#pragma unroll
        for (int pf = 0; pf < 2; ++pf) bb[pf] = ldfrag256(XT, wq2 * 32 + pf * 16 + (lane & 15), ch);
#pragma unroll
        for (int nf = 0; nf < 2; ++nf)
#pragma unroll
          for (int pf = 0; pf < 2; ++pf)
            sacc[nf][pf] = __builtin_amdgcn_mfma_f32_16x16x32_bf16(a[nf], bb[pf], sacc[nf][pf], 0, 0, 0);
      }
    }
    __syncthreads();
  }
  if (g < 2) {
    float* so = p.out + (d ? OUT_SSMB : OUT_SSMF) + (size_t)((g * 16 + b) * 32 + h) * 8192;
    const int wn4 = wave >> 1, wp2 = wave & 1;
#pragma unroll
    for (int nf = 0; nf < 2; ++nf)
#pragma unroll
      for (int pf = 0; pf < 2; ++pf) {
        const int n0 = wn4 * 32 + nf * 16 + (lane >> 4) * 4, pp = wp2 * 32 + pf * 16 + (lane & 15);
        *(float4*)(so + pp * 128 + n0) = float4{sacc[nf][pf][0], sacc[nf][pf][1], sacc[nf][pf][2], sacc[nf][pf][3]};
      }
  }
}


template <bool SEG>
__device__ __forceinline__ void wkv_pair(const Params& p, char* smem, int g, int item) {
  char* ws = p.ws;
  const int tid = get_tid(), lane = tid & 63, wave = tid >> 6;
  const int Ls = SEG ? 2048 : 256;
  const __half* wk = (const __half*)(ws + OFF_WK);
  float* stage = (float*)smem;
  float* ylds = (float*)(smem + 98304);
  const bool cw = true;
  const int slot = wave >> 2, wq = wave & 3;
  const int ig = lane >> 3, jg = lane & 7;
  const int row0 = wq * 16 + ig * 2;
  const int chain = SEG ? (item >> 3) : item * 2 + slot;
  const int seg = SEG ? (item & 7) : 0;
  const bool act = cw && (SEG ? !(slot == 1 && seg == 0) : true);
  const int d = chain & 1, h = (chain >> 1) & 15, b = chain >> 5;
  typedef float f2 __attribute__((ext_vector_type(2)));
  f2 S[2][4];
#pragma unroll
  for (int rr = 0; rr < 2; ++rr) {
    if (SEG) {
      if (slot == 0) {
        if (seg == 0) {
          const float* s0 = (d ? p.wkv_b : p.wkv_f) + ((size_t)(b * 16 + h) * 64 + row0 + rr) * 64 + jg * 8;
#pragma unroll
          for (int c = 0; c < 4; ++c) S[rr][c] = f2{s0[2 * c], s0[2 * c + 1]};
        } else {
#pragma unroll
          for (int c = 0; c < 4; ++c) S[rr][c] = f2{0.f, 0.f};
        }
      } else {
#pragma unroll
        for (int c = 0; c < 4; ++c) S[rr][c] = f2{(row0 + rr == jg * 8 + 2 * c) ? 1.f : 0.f, (row0 + rr == jg * 8 + 2 * c + 1) ? 1.f : 0.f};
      }
    } else {
#pragma unroll
      for (int c = 0; c < 4; ++c) S[rr][c] = f2{0.f, 0.f};
    }
  }
  const int pair = tid >> 4, lslot = pair >> 4, lstep = pair & 15, sub = tid & 15;
  const int lch = SEG ? (item >> 3) : item * 2 + lslot;
  const int ld = lch & 1, lh = (lch >> 1) & 15, lb = lch >> 5;
  const bool ldo = SEG ? (lslot == 0) : true;
  const int sbase = seg * 256;
  const int cslot = SEG ? 0 : slot;
  float ka[4];
#pragma unroll
  for (int e = 0; e < 4; ++e) ka[e] = p.k_a[lh * 64 + sub * 4 + e];
  u16* yout;
  if (SEG) yout = lslot == 0 ? (u16*)(ws + (ld ? OFF_WYB : OFF_WYF)) : (u16*)(ws + OFF_YM) + (ld ? (size_t)TG * 1024 : 0);
  else yout = (u16*)(ws + (ld ? OFF_WYB : OFF_WYF));
  const bool ywr = SEG ? (lslot == 0 || seg > 0) : true;
  uint2 rg[6];
  auto prefetch = [&](int tb) {
    int s = sbase + tb * 16 + lstep;
    int pos = ld ? Ls - 1 - s : s;
    int r = lb * Ls + pos;
    const __half* rec = wk + ((size_t)(r * 16 + lh) * 8) * 64 + sub * 4;
    rg[0] = *(const uint2*)(rec + 0 * 64);
    rg[1] = *(const uint2*)(rec + 1 * 64);
    rg[2] = *(const uint2*)(rec + 2 * 64);
    rg[3] = *(const uint2*)(rec + 3 * 64);
    rg[4] = *(const uint2*)(rec + (4 + 2 * ld) * 64);
    rg[5] = *(const uint2*)(rec + (5 + 2 * ld) * 64);
  };
  auto unpack4 = [&](uint2 u, float (&o)[4]) {
    __half2 h0 = *reinterpret_cast<__half2*>(&u.x);
    __half2 h1 = *reinterpret_cast<__half2*>(&u.y);
    float2 f0 = __half22float2(h0), f1 = __half22float2(h1);
    o[0] = f0.x; o[1] = f0.y; o[2] = f1.x; o[3] = f1.y;
  };
  auto stage_store = [&](int buf) {
    float r_[4], v_[4], k_[4], nkk_[4], w_[4], a_[4];
    unpack4(rg[0], r_); unpack4(rg[1], v_); unpack4(rg[2], k_); unpack4(rg[3], nkk_); unpack4(rg[4], w_); unpack4(rg[5], a_);
    float b_[4], kd_[4];
#pragma unroll
    for (int e = 0; e < 4; ++e) {
      b_[e] = -nkk_[e] * a_[e];
      kd_[e] = k_[e] * (1.f + (a_[e] - 1.f) * ka[e]);
    }
    float* dst = stage + ((size_t)((buf * 2 + lslot) * 16 + lstep) * 6) * 64 + sub * 4;
    *(float4*)(dst + 0 * 64) = float4{nkk_[0], nkk_[1], nkk_[2], nkk_[3]};
    *(float4*)(dst + 1 * 64) = float4{w_[0], w_[1], w_[2], w_[3]};
    *(float4*)(dst + 2 * 64) = float4{b_[0], b_[1], b_[2], b_[3]};
    *(float4*)(dst + 3 * 64) = float4{kd_[0], kd_[1], kd_[2], kd_[3]};
    *(float4*)(dst + 4 * 64) = float4{r_[0], r_[1], r_[2], r_[3]};
    *(float4*)(dst + 5 * 64) = float4{v_[0], v_[1], v_[2], v_[3]};
  };
  if (ldo) { prefetch(0); stage_store(0); }
  __syncthreads();
  for (int tb = 0; tb < 16; ++tb) {
    const bool more = tb + 1 < 16;
    if (more && ldo) prefetch(tb + 1);
    if (act) {
      const float* sb = stage + ((size_t)(((tb & 1) * 2 + cslot) * 16) * 6) * 64;
      for (int sg = 0; sg < 8; ++sg) {
        float ysv[2][2];
#pragma unroll
        for (int s4 = 0; s4 < 2; ++s4) {
          const int st = sg * 2 + s4;
          const float* v6 = sb + st * 384 + jg * 8;
          f2 nkk[4], w[4], bb[4], kd[4], rr[4];
#pragma unroll
          for (int q = 0; q < 2; ++q) {
            float4 t0 = *(const float4*)(v6 + 0 * 64 + q * 4);
            nkk[q * 2] = f2{t0.x, t0.y}; nkk[q * 2 + 1] = f2{t0.z, t0.w};
            float4 t1 = *(const float4*)(v6 + 1 * 64 + q * 4);
            w[q * 2] = f2{t1.x, t1.y}; w[q * 2 + 1] = f2{t1.z, t1.w};
            float4 t2 = *(const float4*)(v6 + 2 * 64 + q * 4);
            bb[q * 2] = f2{t2.x, t2.y}; bb[q * 2 + 1] = f2{t2.z, t2.w};
            float4 t3 = *(const float4*)(v6 + 3 * 64 + q * 4);
            kd[q * 2] = f2{t3.x, t3.y}; kd[q * 2 + 1] = f2{t3.z, t3.w};
            float4 t4 = *(const float4*)(v6 + 4 * 64 + q * 4);
            rr[q * 2] = f2{t4.x, t4.y}; rr[q * 2 + 1] = f2{t4.z, t4.w};
          }
          float2 vv2 = *(const float2*)(sb + st * 384 + 5 * 64 + row0);
          float vi[2] = {vv2.x, vv2.y};
          if (SEG && slot == 1) { vi[0] = 0.f; vi[1] = 0.f; }
#pragma unroll
          for (int r2 = 0; r2 < 2; ++r2) {
            f2 sa2a = S[r2][0] * nkk[0], sa2b = S[r2][1] * nkk[1];
            sa2a += S[r2][2] * nkk[2]; sa2b += S[r2][3] * nkk[3];
            f2 sat = sa2a + sa2b;
            float sa = sat.x + sat.y;
            sa += dpp_xor1(sa);
            sa += dpp_xor2(sa);
            sa += dpp_hmirror(sa);
            f2 y2a, y2b;
            {
              f2 t0 = S[r2][0] * w[0] + vi[r2] * kd[0]; S[r2][0] = t0 + sa * bb[0]; y2a = S[r2][0] * rr[0];
              f2 t1 = S[r2][1] * w[1] + vi[r2] * kd[1]; S[r2][1] = t1 + sa * bb[1]; y2b = S[r2][1] * rr[1];
              f2 t2 = S[r2][2] * w[2] + vi[r2] * kd[2]; S[r2][2] = t2 + sa * bb[2]; y2a += S[r2][2] * rr[2];
              f2 t3 = S[r2][3] * w[3] + vi[r2] * kd[3]; S[r2][3] = t3 + sa * bb[3]; y2b += S[r2][3] * rr[3];
            }
            f2 yt = y2a + y2b;
            float y = yt.x + yt.y;
            y += dpp_xor1(y);
            y += dpp_xor2(y);
            y += dpp_hmirror(y);
            ysv[s4][r2] = y;
          }
        }
        if (jg == 0) {
#pragma unroll
          for (int s4 = 0; s4 < 2; ++s4)
            *(float2*)(ylds + (slot * 16 + sg * 2 + s4) * 64 + row0) = float2{ysv[s4][0], ysv[s4][1]};
        }
      }
    }
    __syncthreads();
    if (more && ldo) stage_store((tb + 1) & 1);
    if (ywr) {
      int s = sbase + tb * 16 + lstep;
      int pos = ld ? Ls - 1 - s : s;
      int r = lb * Ls + pos;
      float4 yv = *(const float4*)(ylds + (lslot * 16 + lstep) * 64 + sub * 4);
      *(uint2*)(yout + (size_t)r * 1024 + lh * 64 + sub * 4) = uint2{pack2(yv.x, yv.y), pack2(yv.z, yv.w)};
    }
    __syncthreads();
  }
  if (act) {
#pragma unroll
    for (int r2 = 0; r2 < 2; ++r2) {
      float* so;
      if (SEG) so = p.out + 8388608 + ((size_t)((chain * 8 + seg) * 2 + slot)) * 4096 + (row0 + r2) * 64 + jg * 8;
      else so = p.out + (d ? OUT_WKVB : OUT_WKVF) + ((size_t)((g * 16 + b) * 16 + h) * 64 + row0 + r2) * 64 + jg * 8;
#pragma unroll
      for (int c = 0; c < 4; ++c) { so[2 * c] = S[r2][c].x; so[2 * c + 1] = S[r2][c].y; }
    }
  }
}

__device__ __forceinline__ void wkv_fix(const Params& p, char* smem, int item) {
  const int chain = item >> 2, qt = item & 3;
  char* ws = p.ws;
  const int tid = get_tid(), lane = tid & 63, wave = tid >> 6;
  const int d = chain & 1, h = (chain >> 1) & 15, b = chain >> 5;
  const float* SE = p.out + 8388608;
  u16* yout = (u16*)(ws + (d ? OFF_WYB : OFF_WYF));
  const u16* Q = (const u16*)(ws + OFF_YM) + (d ? (size_t)TG * 1024 : 0);
  float* Pl = (float*)smem;
  float* Sl = (float*)(smem + 16384);
  u16* Ql = (u16*)(smem + 36864);
  const int i = lane;
  float S0[64];
  {
    const float* src = SE + ((size_t)(chain * 8) * 2) * 4096 + i * 64;
#pragma unroll
    for (int j = 0; j < 16; ++j) {
      float4 t = *(const float4*)(src + j * 4);
      S0[j * 4] = t.x; S0[j * 4 + 1] = t.y; S0[j * 4 + 2] = t.z; S0[j * 4 + 3] = t.w;
    }
  }
  for (int k = 1; k < 8; ++k) {
    {
      int tt = qt * 64 + (tid >> 3), ch = tid & 7;
      int s = k * 256 + tt;
      int pos = d ? 2047 - s : s;
      int r = b * 2048 + pos;
      *(uint4*)(Ql + tt * 64 + ch * 8) = *(const uint4*)(Q + (size_t)r * 1024 + h * 64 + ch * 8);
    }
    if (k < 7) {
      const float* src = SE + ((size_t)((chain * 8 + k) * 2 + 1)) * 4096;
#pragma unroll
      for (int e = 0; e < 2; ++e) ((float4*)Pl)[tid + e * 512] = ((const float4*)src)[tid + e * 512];
    }
    __syncthreads();
    for (int n = 0; n < 8; ++n) {
      int tt = qt * 64 + wave + n * 8;
      float a0 = 0.f, a1 = 0.f;
#pragma unroll
      for (int jc = 0; jc < 8; ++jc) {
        float q[8];
        unpack8(*(const uint4*)(Ql + tt * 64 + jc * 8), q);
#pragma unroll
        for (int e = 0; e < 8; e += 2) { a0 += S0[jc * 8 + e] * q[e]; a1 += S0[jc * 8 + e + 1] * q[e + 1]; }
      }
      int s = k * 256 + tt;
      int pos = d ? 2047 - s : s;
      size_t off = (size_t)(b * 2048 + pos) * 1024 + h * 64 + i;
      yout[off] = f2bf(bf2f(yout[off]) + (a0 + a1));
    }
    if (k < 7) {
      float nv[8];
      const float* sl = SE + ((size_t)((chain * 8 + k) * 2)) * 4096 + i * 64 + wave * 8;
      {
        float4 t0 = *(const float4*)sl, t1 = *(const float4*)(sl + 4);
        nv[0] = t0.x; nv[1] = t0.y; nv[2] = t0.z; nv[3] = t0.w; nv[4] = t1.x; nv[5] = t1.y; nv[6] = t1.z; nv[7] = t1.w;
      }
#pragma unroll
      for (int m = 0; m < 64; ++m) {
        float4 p0 = *(const float4*)(Pl + m * 64 + wave * 8), p1 = *(const float4*)(Pl + m * 64 + wave * 8 + 4);
        nv[0] += S0[m] * p0.x; nv[1] += S0[m] * p0.y; nv[2] += S0[m] * p0.z; nv[3] += S0[m] * p0.w;
        nv[4] += S0[m] * p1.x; nv[5] += S0[m] * p1.y; nv[6] += S0[m] * p1.z; nv[7] += S0[m] * p1.w;
      }
      *(float4*)(Sl + i * 68 + wave * 8) = float4{nv[0], nv[1], nv[2], nv[3]};
      *(float4*)(Sl + i * 68 + wave * 8 + 4) = float4{nv[4], nv[5], nv[6], nv[7]};
      __syncthreads();
#pragma unroll
      for (int j = 0; j < 16; ++j) {
        float4 t = *(const float4*)(Sl + i * 68 + j * 4);
        S0[j * 4] = t.x; S0[j * 4 + 1] = t.y; S0[j * 4 + 2] = t.z; S0[j * 4 + 3] = t.w;
      }
    }
    __syncthreads();
  }
}

__device__ __forceinline__ void step_scan(const Params& p, char* smem, int g) {
  const int G = gridDim.x;
  const int r1 = (RM & (1 << 20)) ? 2 : 1, r2 = (RM & (1 << 21)) ? 2 : 1;
  if (g < 2) {
    for (int rr = 0; rr < r1; ++rr) {
      SsdPre R;
      if ((int)blockIdx.x < 1024) ssd_issue(p, g, blockIdx.x, 0, get_tid(), R);
      for (int ch = blockIdx.x; ch < 1024; ch += G) ssd_chain(p, smem, g, ch, ch + G < 1024 ? ch + G : -1, R);
    }
    for (int rr = 0; rr < r2; ++rr) for (int it = blockIdx.x; it < 256; it += G) wkv_pair<false>(p, smem, g, it);
  } else {
    for (int rr = 0; rr < r1; ++rr) {
      SsdPre R;
      if ((int)blockIdx.x < 128) ssd_issue(p, g, blockIdx.x, 0, get_tid(), R);
      for (int ch = blockIdx.x; ch < 128; ch += G) ssd_chain(p, smem, g, ch, ch + G < 128 ? ch + G : -1, R);
    }
    for (int rr = 0; rr < r2; ++rr) for (int it = (G - 1 - blockIdx.x); it < 512; it += G) wkv_pair<true>(p, smem, g, it);
  }
}
__device__ __forceinline__ void step_fix(const Params& p, char* smem) {
  for (int it = blockIdx.x; it < 256; it += gridDim.x) wkv_fix(p, smem, it);
}

__device__ __forceinline__ void step_fin(const Params& p, int g) {
  char* ws = p.ws;
  const int tid = get_tid(), lane = tid & 63, wave = tid >> 6;
  const int gw = blockIdx.x * 8 + wave, nw = gridDim.x * 8;
  {
    const u16* yf = (const u16*)(ws + OFF_SYF);
    const u16* yb = (const u16*)(ws + OFF_SYB);
    const u16* xbc = (const u16*)(ws + OFF_XBC);
    const u16* zb = (const u16*)(ws + OFF_Z);
    u16* ym = (u16*)(ws + OFF_YM);
    for (int it = gw; it < TG * 4; it += nw) {
      int r = it >> 2, gq = it & 3;
      int ch = gq * 512 + lane * 8;
      uint4 a = *(const uint4*)(yf + (size_t)r * 2048 + ch);
      uint4 b = *(const uint4*)(yb + (size_t)r * 2048 + ch);
      uint4 x = *(const uint4*)(xbc + (size_t)r * 3072 + ch);
      uint4 z = *(const uint4*)(zb + (size_t)r * 2048 + ch);
      float dsk = p.d_skip[ch >> 6];
      unsigned aw[4] = {a.x, a.y, a.z, a.w}, bw[4] = {b.x, b.y, b.z, b.w}, xw[4] = {x.x, x.y, x.z, x.w}, zw[4] = {z.x, z.y, z.z, z.w};
      float y[8];
      float ss = 0.f;
#pragma unroll
      for (int e = 0; e < 8; ++e) {
        int sh = (e & 1) * 16;
        float yy = bf2f((u16)(aw[e >> 1] >> sh)) + bf2f((u16)(bw[e >> 1] >> sh)) + dsk * bf2f((u16)(xw[e >> 1] >> sh));
        yy *= siluf(bf2f((u16)(zw[e >> 1] >> sh)));
        y[e] = yy;
        ss += yy * yy;
      }
      ss = wave_sum(ss);
      float rinv = rsqrtf(ss * (1.f / 512.f) + 1e-5f);
      float4 w0 = *(const float4*)(p.m_norm_w + ch), w1 = *(const float4*)(p.m_norm_w + ch + 4);
      *(uint4*)(ym + (size_t)r * 2048 + ch) =
          uint4{pack2(y[0] * rinv * w0.x, y[1] * rinv * w0.y), pack2(y[2] * rinv * w0.z, y[3] * rinv * w0.w),
                pack2(y[4] * rinv * w1.x, y[5] * rinv * w1.y), pack2(y[6] * rinv * w1.z, y[7] * rinv * w1.w)};
    }
  }
  {
    const u16* __restrict__ yf = (const u16*)(ws + OFF_WYF);
    const u16* __restrict__ yb = (const u16*)(ws + OFF_WYB);
    const __half* __restrict__ wk = (const __half*)(ws + OFF_WK);
    const u16* __restrict__ gr = (const u16*)(ws + OFF_GR);
    u16* __restrict__ yr = (u16*)(ws + OFF_YR);
    for (int it = gw; it < TG * 2; it += nw) {
      const int r = it >> 1, hh = it & 1;
      const int c0 = hh * 512 + lane * 8;
      const int head = c0 >> 6;
      const uint4 a = *(const uint4*)(yf + (size_t)r * 1024 + c0);
      const uint4 b = *(const uint4*)(yb + (size_t)r * 1024 + c0);
      const uint4 gq = *(const uint4*)(gr + (size_t)r * 1024 + c0);
      const __half* rec = wk + ((size_t)(r * 16 + head) * 8) * 64 + (lane & 7) * 8;
      const uint4 qr = *(const uint4*)(rec + 0 * 64), qv = *(const uint4*)(rec + 1 * 64), qk = *(const uint4*)(rec + 2 * 64);
      const uint4 qaf = *(const uint4*)(rec + 5 * 64), qab = *(const uint4*)(rec + 7 * 64);
      const float4 lw0 = *(const float4*)(p.lnx_w + c0), lw1 = *(const float4*)(p.lnx_w + c0 + 4);
      const float4 lb0 = *(const float4*)(p.lnx_b + c0), lb1 = *(const float4*)(p.lnx_b + c0 + 4);
      const float4 ka0 = *(const float4*)(p.k_a + c0), ka1 = *(const float4*)(p.k_a + c0 + 4);
      const float4 rk0 = *(const float4*)(p.r_k + c0), rk1 = *(const float4*)(p.r_k + c0 + 4);
      const float lw[8] = {lw0.x, lw0.y, lw0.z, lw0.w, lw1.x, lw1.y, lw1.z, lw1.w};
      const float lb[8] = {lb0.x, lb0.y, lb0.z, lb0.w, lb1.x, lb1.y, lb1.z, lb1.w};
      const float kav[8] = {ka0.x, ka0.y, ka0.z, ka0.w, ka1.x, ka1.y, ka1.z, ka1.w};
      const float rkv[8] = {rk0.x, rk0.y, rk0.z, rk0.w, rk1.x, rk1.y, rk1.z, rk1.w};
      float ya[8], yb8[8], gg[8];
      unpack8(a, ya); unpack8(b, yb8); unpack8(gq, gg);
      auto unph = [&](const uint4& u, float (&o)[8]) {
        const __half2* hp = reinterpret_cast<const __half2*>(&u);
#pragma unroll
        for (int e = 0; e < 4; ++e) { float2 f = __half22float2(hp[e]); o[2 * e] = f.x; o[2 * e + 1] = f.y; }
      };
      float rr[8], vv[8], kk[8], af[8], ab[8];
      unph(qr, rr); unph(qv, vv); unph(qk, kk); unph(qaf, af); unph(qab, ab);
      float y[8];
      float s1 = 0.f;
#pragma unroll
      for (int e = 0; e < 8; ++e) { y[e] = ya[e] + yb8[e]; s1 += y[e]; }
      s1 += dpp_xor1(s1); s1 += dpp_xor2(s1); s1 += dpp_hmirror(s1);
      const float mean = s1 * (1.f / 64.f);
      float s2 = 0.f, s3 = 0.f;
#pragma unroll
      for (int e = 0; e < 8; ++e) {
        const float dy = y[e] - mean;
        s2 += dy * dy;
        const float kmean = kk[e] * (1.f + (0.5f * (af[e] + ab[e]) - 1.f) * kav[e]);
        s3 += rr[e] * kmean * rkv[e];
      }
      s2 += dpp_xor1(s2); s2 += dpp_xor2(s2); s2 += dpp_hmirror(s2);
      s3 += dpp_xor1(s3); s3 += dpp_xor2(s3); s3 += dpp_hmirror(s3);
      const float rs = rsqrtf(s2 * (1.f / 64.f) + 64e-5f);
      float o[8];
#pragma unroll
      for (int e = 0; e < 8; ++e) o[e] = ((y[e] - mean) * rs * lw[e] + lb[e] + s3 * vv[e]) * gg[e];
      *(uint4*)(yr + (size_t)r * 1024 + c0) = uint4{pack2(o[0], o[1]), pack2(o[2], o[3]), pack2(o[4], o[5]), pack2(o[6], o[7])};
    }
  }
}

__device__ __forceinline__ void step_outproj(const Params& p, char* smem, int g) {
  char* ws = p.ws;
  const int sub = blockIdx.x >> 6, vb = blockIdx.x & 63;
  if (sub < 3) {
    const u16* A = sub == 2 ? (const u16*)(ws + OFF_YR) : (const u16*)(ws + OFF_YM) + sub * 1024;
    const u16* B = sub == 2 ? (const u16*)(ws + OFF_WROUT) : (const u16*)(ws + OFF_WMOUT) + sub * 1024;
    EpiOutV E{(const u16*)(ws + OFF_GATE), (u16*)(ws + OFF_XBC) + (size_t)sub * TG * 1024, sub == 2 ? 1024 : 0};
    run_gemm8(smem, A, B, TG, 1024, 1024, E, vb, 64, 0, sub == 2 ? 1024 : 2048);
  }
}
__device__ __forceinline__ void step_sum(const Params& p, int g) {
  const u16* __restrict__ V = (const u16*)(p.ws + OFF_XBC);
  u16* __restrict__ U = (u16*)p.out + (size_t)g * TG * 1024;
  const int tid = get_tid();
  for (int i = blockIdx.x * NTHR + tid; i < TG * 128; i += gridDim.x * NTHR) {
    float a[8], b[8], c[8];
    unpack8(*(const uint4*)(V + (size_t)i * 8), a);
    unpack8(*(const uint4*)(V + (size_t)TG * 1024 + (size_t)i * 8), b);
    unpack8(*(const uint4*)(V + (size_t)2 * TG * 1024 + (size_t)i * 8), c);
    *(uint4*)(U + (size_t)i * 8) = uint4{pack2(a[0] + b[0] + c[0], a[1] + b[1] + c[1]), pack2(a[2] + b[2] + c[2], a[3] + b[3] + c[3]),
                                         pack2(a[4] + b[4] + c[4], a[5] + b[5] + c[5]), pack2(a[6] + b[6] + c[6], a[7] + b[7] + c[7])};
  }
}

__device__ __forceinline__ void step_wo(const Params& p, char* smem, int g) {
  char* ws = p.ws;
  EpiWo E{p.x_prompt, p.x_sample, (const float*)(ws + OFF_MOD), (float*)(ws + OFF_X1), 0};
  run_gemm8(smem, (const u16*)p.out, (const u16*)(ws + OFF_WO), NTOK, 1024, 1024, E);
}

__device__ __forceinline__ void step_gu(const Params& p, char* smem) {
  char* ws = p.ws;
  EpiGU E{(u16*)(ws + OFF_ACT)};
  run_gemm8(smem, (const u16*)(ws + OFF_H2), (const u16*)(ws + OFF_WGU), NTOK, 5632, 1024, E);
}

__device__ __forceinline__ void step_down(const Params& p, char* smem) {
  char* ws = p.ws;
  EpiDown E{(const float*)(ws + OFF_MOD), (float*)(ws + OFF_X1)};
  run_gemm8(smem, (const u16*)(ws + OFF_ACT), (const u16*)(ws + OFF_WDOWN), NTOK, 1024, 2816, E, -1, 0, 1);
}

__device__ __forceinline__ void step_final(const Params& p) {
  const int tid = get_tid(), lane = tid & 63, wave = tid >> 6;
  for (int r = blockIdx.x * 8 + wave; r < NTOK; r += gridDim.x * 8) {
    const float* xr = (const float*)(p.ws + OFF_X1) + (size_t)r * 1024;
    float* xo = p.out + (size_t)r * 1024;
    float4 v[4];
    float ss = 0.f;
#pragma unroll
    for (int i = 0; i < 4; ++i) {
      v[i] = ((const float4*)xr)[i * 64 + lane];
      ss += v[i].x * v[i].x + v[i].y * v[i].y + v[i].z * v[i].z + v[i].w * v[i].w;
    }
    ss = wave_sum(ss);
    float rinv = rsqrtf(ss * (1.f / 1024.f) + 1e-6f);
#pragma unroll
    for (int i = 0; i < 4; ++i) {
      float4 w4 = ((const float4*)p.final_norm_w)[i * 64 + lane];
      ((float4*)xo)[i * 64 + lane] = float4{v[i].x * rinv * w4.x, v[i].y * rinv * w4.y, v[i].z * rinv * w4.z, v[i].w * rinv * w4.w};
    }
  }
}

constexpr int NSTEPS = 33;

__global__ void __launch_bounds__(NTHR) mega(Params p_arg) {
  const int step_lo = p_arg.step_lo, step_hi = p_arg.step_hi;
  __shared__ __attribute__((aligned(16))) char smem[SMEM_BYTES];
#if !MULTI_LAUNCH
  if (threadIdx.x == 0) *(uint4*)(smem + SMEM_BYTES - 16) = uint4{0u, 0u, 0u, 0u};
  __syncthreads();
  XcdBarrier xb = xcd_barrier_post((unsigned*)(p_arg.ws + OFF_BAR), (volatile LAS unsigned*)(smem + SMEM_BYTES - 16));
#endif
  for (int step = step_lo; step <= step_hi; ++step) {
#if defined(__HIP_DEVICE_COMPILE__)
    const __attribute__((address_space(4))) Params* pp = (const __attribute__((address_space(4))) Params*)__builtin_amdgcn_kernarg_segment_ptr();
    asm volatile("" : "+s"(pp));
    const Params p = *pp;
#else
    const Params p = p_arg;
#endif
    const int g = (step - 1) / 9, s = (step - 1) - g * 9;
    const int scode = step == 0 ? 0 : (step <= 27 ? 1 + s : step - 18);
    if (scode == 6 && g < 2) continue;
    if (scode == 1 && g > 0) continue;
    const int reps = ((RM >> scode) & 1) ? 2 : 1;
    for (int rep = 0; rep < reps; ++rep) {
      if (!((SM >> scode) & 1)) continue;
      switch (scode) {
        case 0: step_prep(p, smem); break;
        case 1: step_norm<0>(p, g); break;
        case 2: step_gemm1(p, smem, 0); break;
        case 3: step_cr1(p, g); break;
        case 4: step_r2(p, smem); break;
        case 5: step_scan(p, smem, g); break;
        case 6: step_fix(p, smem); break;
        case 7: step_fin(p, g); if (g < 2) step_norm<0>(p, g + 1); break;
        case 8:
          step_outproj(p, smem, g);
          if (g == 0 && blockIdx.x >= 192) {
            convT<1>(p.w_gu, 1024, 5632, (u16*)(p.ws + OFF_WGU), smem, blockIdx.x - 192, gridDim.x - 192);
            convT<2>(p.w_down, 2816, 1024, (u16*)(p.ws + OFF_WDOWN), smem, blockIdx.x - 192, gridDim.x - 192);
          }
          break;
        case 9: step_sum(p, g); break;
        case 10: step_wo(p, smem, 0); break;
        case 11: step_norm<1>(p, 0); break;
        case 12: step_gu(p, smem); break;
        case 13: if (reps == 2 && rep == 0) { Params q = p; q.out = (float*)(p.ws + (size_t)150000000); step_down(q, smem); } else step_down(p, smem); break;
        default: step_final(p); break;
      }
    }
    if (step < step_hi) {
#if !MULTI_LAUNCH
      if (step_hi > 100000) cg::this_grid().sync();
      for (int xs = 0; xs < 1 + XSYNC; ++xs) xcd_barrier(xb);
#endif
    }
  }
}

extern "C" void kernel_launch(void* const* d_in, const int* in_sizes, int n_in, void* d_out, int out_size,
                              void* d_ws, size_t ws_size, hipStream_t stream) {
  Params p{};
  const float** pp = (const float**)&p;
  for (int i = 0; i < 36; ++i) pp[i] = (const float*)d_in[i];
  p.out = (float*)d_out;
  p.ws = (char*)d_ws;
  if (ws_size < WS_NEED) fprintf(stderr, "workspace too small: %zu < %zu\n", ws_size, (size_t)WS_NEED);
#if MULTI_LAUNCH
  for (int s = 0; s < NSTEPS; ++s) {
    p.step_lo = s;
    p.step_hi = s;
    hipLaunchKernelGGL(mega, dim3(256), dim3(NTHR), 0, stream, p);
  }
#else
  static int grid_blocks = 0;
  if (!grid_blocks) {
    int dev = 0, cus = 0, per_cu = 0;
    hipGetDevice(&dev);
    hipDeviceGetAttribute(&cus, hipDeviceAttributeMultiprocessorCount, dev);
    hipOccupancyMaxActiveBlocksPerMultiprocessor(&per_cu, mega, NTHR, 0);
    if (per_cu < 1) per_cu = 1;
    if (per_cu > 1) per_cu = 1;
    grid_blocks = cus * per_cu;
  }
  p.step_lo = 0;
  p.step_hi = NSTEPS - 1;
  void* args[] = {&p};
  hipMemsetAsync((char*)d_ws + OFF_BAR, 0, XCD_BAR_WORDS_C * 4, stream);
  hipError_t e = hipLaunchCooperativeKernel((void*)mega, dim3(grid_blocks), dim3(NTHR), args, 0, stream);
  if (e != hipSuccess) fprintf(stderr, "cooperative launch failed: %s (grid %d)\n", hipGetErrorString(e), grid_blocks);
#endif
}
```

```cpp
#include <hip/hip_runtime.h>
#include <hip/hip_cooperative_groups.h>
#include <hip/hip_fp16.h>
#include <cstdio>
#include <cstdint>
namespace cg = cooperative_groups;

#ifndef MULTI_LAUNCH
#define MULTI_LAUNCH 0
#endif

#define DI __device__ __forceinline__
typedef __attribute__((ext_vector_type(8))) short bf16x8;
typedef __attribute__((ext_vector_type(4))) float f32x4;
typedef unsigned short u16;

#ifndef STEP_MASK
#define STEP_MASK 0xffffff
#endif
constexpr int SM = STEP_MASK;
#ifndef REPEAT_MASK
#define REPEAT_MASK 0
#endif
#ifndef XSYNC
#define XSYNC 0
#endif
constexpr int RM = REPEAT_MASK;
constexpr int TG = 4096;
constexpr int NTOK = 12288;
constexpr int NPAD = 10752;
constexpr int NTHR = 512;
constexpr int SMEM_BYTES = 133120;
constexpr int XCD_BAR_WORDS_C = 3456;

constexpr size_t OFF_WIN = 0;
constexpr size_t OFF_WGU = OFF_WIN + (size_t)NPAD * 1024 * 2;
constexpr size_t OFF_WDOWN = OFF_WGU + (size_t)5632 * 1024 * 2;
constexpr size_t OFF_WMOUT = OFF_WDOWN + (size_t)1024 * 2816 * 2;
constexpr size_t OFF_WROUT = OFF_WMOUT + (size_t)1024 * 2048 * 2;
constexpr size_t OFF_WO = OFF_WROUT + (size_t)1024 * 1024 * 2;
constexpr size_t OFF_W2T = OFF_WO + (size_t)1024 * 1024 * 2;
constexpr size_t OFF_A2T = OFF_W2T + 262144;
constexpr size_t OFF_G2T = OFF_A2T + 262144;
constexpr size_t OFF_MOD = OFF_G2T + 262144;
constexpr size_t OFF_GRP = OFF_MOD + 73728;
constexpr size_t OFF_Z = OFF_GRP;
constexpr size_t OFF_GATE = OFF_Z + (size_t)TG * 2048 * 2;
constexpr size_t OFF_XBC = OFF_GATE + (size_t)TG * 2048 * 2;
constexpr size_t OFF_WK = OFF_XBC + (size_t)TG * 3072 * 2;
constexpr size_t OFF_GR = OFF_WK + (size_t)TG * 16 * 1024;
constexpr size_t OFF_DT = OFF_GR + (size_t)TG * 1024 * 2;
constexpr size_t OFF_TL = OFF_DT + (size_t)TG * 64 * 4;
constexpr size_t OFF_SG = OFF_TL + (size_t)TG * 256 * 2;
constexpr size_t OFF_R = OFF_SG + (size_t)TG * 128 * 2;
constexpr size_t OFF_H1 = OFF_R;
constexpr size_t OFF_XBCRAW = OFF_H1 + (size_t)TG * 1024 * 2;
constexpr size_t OFF_RW = OFF_XBCRAW + (size_t)TG * 3072 * 2;
constexpr size_t OFF_SYF = OFF_R;
constexpr size_t OFF_SYB = OFF_SYF + (size_t)TG * 2048 * 2;
constexpr size_t OFF_WYF = OFF_SYB + (size_t)TG * 2048 * 2;
constexpr size_t OFF_WYB = OFF_WYF + (size_t)TG * 1024 * 2;
constexpr size_t OFF_YM = OFF_WYB + (size_t)TG * 1024 * 2;
constexpr size_t OFF_YR = OFF_YM + (size_t)TG * 2048 * 2;
constexpr size_t OFF_END = OFF_YR + (size_t)TG * 1024 * 2;
constexpr size_t OFF_BAR = OFF_END;
constexpr size_t OFF_W4T = OFF_BAR + 16384;
constexpr size_t WS_NEED = OFF_W4T + (size_t)4096 * 256 * 2;
constexpr size_t OFF_U = OFF_XBC;
constexpr size_t OFF_H2 = OFF_GRP;
constexpr size_t OFF_ACT = OFF_H2 + (size_t)NTOK * 1024 * 2;
constexpr size_t H1_OUT_OFF = 25165824;
constexpr size_t OFF_X1 = OFF_ACT + (size_t)NTOK * 2816 * 2;

constexpr size_t OUT_SSMF = 12582912;
constexpr size_t OUT_SSMB = OUT_SSMF + 8388608;
constexpr size_t OUT_WKVF = OUT_SSMB + 8388608;
constexpr size_t OUT_WKVB = OUT_WKVF + 2097152;

struct Params {
  const float *x_prompt, *x_sample, *ssm_f, *ssm_b, *wkv_f, *wkv_b, *c, *c_ctx, *norm1_w, *norm2_w,
      *w_ada, *b_ada, *w_in, *conv_w, *conv_b, *dt_bias, *a_log, *d_skip, *m_norm_w, *mu_shift, *w0,
      *w2, *a0, *a2, *g2, *k_k, *k_a, *r_k, *lnx_w, *lnx_b, *w_m_out, *w_r_out, *w_o, *w_gu, *w_down,
      *final_norm_w;
  float* out;
  char* ws;
  int step_lo, step_hi;
};

DI int get_tid() {
  int t = threadIdx.x;
  asm volatile("" : "+v"(t));
  return t;
}
DI u16 f2bf(float f) {
  unsigned u = __float_as_uint(f);
  u += 0x7fffu + ((u >> 16) & 1u);
  return (u16)(u >> 16);
}
DI float bf2f(u16 h) { return __uint_as_float(((unsigned)h) << 16); }
DI float siluf(float x) { return x / (1.f + __expf(-x)); }
DI float sigm(float x) { return 1.f / (1.f + __expf(-x)); }
DI float wave_sum(float v) {
  v += __int_as_float(__builtin_amdgcn_update_dpp(0, __float_as_int(v), 0xB1, 0xF, 0xF, true));
  v += __int_as_float(__builtin_amdgcn_update_dpp(0, __float_as_int(v), 0x4E, 0xF, 0xF, true));
  v += __int_as_float(__builtin_amdgcn_update_dpp(0, __float_as_int(v), 0x141, 0xF, 0xF, true));
  v += __int_as_float(__builtin_amdgcn_update_dpp(0, __float_as_int(v), 0x140, 0xF, 0xF, true));
  const int vi = __float_as_int(v);
  float a = __int_as_float(__builtin_amdgcn_readlane(vi, 0)), b = __int_as_float(__builtin_amdgcn_readlane(vi, 16));
  float c = __int_as_float(__builtin_amdgcn_readlane(vi, 32)), d = __int_as_float(__builtin_amdgcn_readlane(vi, 48));
  return (a + b) + (c + d);
}
DI float dpp_xor1(float v) { return __int_as_float(__builtin_amdgcn_update_dpp(0, __float_as_int(v), 0xB1, 0xF, 0xF, true)); }
DI float dpp_hmirror(float v) { return __int_as_float(__builtin_amdgcn_update_dpp(0, __float_as_int(v), 0x141, 0xF, 0xF, true)); }
DI float dpp_xor2(float v) { return __int_as_float(__builtin_amdgcn_update_dpp(0, __float_as_int(v), 0x4E, 0xF, 0xF, true)); }
DI unsigned pack2(float a, float b) { return (unsigned)f2bf(a) | ((unsigned)f2bf(b) << 16); }
DI int mrow_of(int tok) { return tok < 8192 ? 0 : 1 + ((tok - 8192) >> 11); }


#define XB_TMO      128
#define XB_XCNT(j)  (256  + 64 * (j))
#define XB_XSUB(j)  (1280 + 64 * (j))
#define XB_XGEN(j)  (2304 + 64 * (j))
#define XB_TOP      3328
#define XB_TOPGEN   3392
#define XCD_BAR_WORDS 3456
#define XB_SPIN_CAP (1u << 22)
#define LAS __attribute__((address_space(3)))
DI unsigned xb_ld(unsigned* p) { return __hip_atomic_load(p, __ATOMIC_RELAXED, __HIP_MEMORY_SCOPE_AGENT); }
DI unsigned xb_add(unsigned* p, unsigned v) { return __hip_atomic_fetch_add(p, v, __ATOMIC_RELAXED, __HIP_MEMORY_SCOPE_AGENT); }
DI unsigned xb_xcc_id() { return (unsigned)__builtin_amdgcn_s_getreg((3 << 11) | 20) & 0xFu; }
#define XB_SPIN(cond, bar) do { unsigned _sp = 0; while (cond) { __builtin_amdgcn_s_sleep(1); \
    if ((++_sp & 255u) == 0u) { if (xb_ld(&(bar)[XB_TMO])) break; if (_sp > XB_SPIN_CAP) { atomicAdd(&(bar)[XB_TMO], 1u); break; } } } } while (0)
struct XcdBarrier { unsigned* bar; unsigned x; volatile LAS unsigned* st; };
DI XcdBarrier xcd_barrier_post(unsigned* bar, volatile LAS unsigned* st) {
  XcdBarrier b; b.bar = bar; b.x = xb_xcc_id(); b.st = st;
  if (threadIdx.x == 0) (void)xb_add(&bar[XB_XCNT(b.x)], 1u);
  return b;
}
DI void xcd_barrier_complete(unsigned* bar, unsigned x, unsigned& nloc, unsigned& nx) {
  const unsigned G = gridDim.x * gridDim.y * gridDim.z;
  unsigned sum, cnt, mine, sp = 0u;
  for (;;) {
    sum = 0u; cnt = 0u; mine = 0u;
#pragma unroll
    for (unsigned j = 0; j < 16; ++j) { const unsigned c = xb_ld(&bar[XB_XCNT(j)]); sum += c; cnt += (c > 0u) ? 1u : 0u; mine = (j == x) ? c : mine; }
    if (sum == G) break;
    __builtin_amdgcn_s_sleep(1);
    if ((++sp & 255u) == 0u) { if (xb_ld(&bar[XB_TMO])) break; if (sp > XB_SPIN_CAP) { atomicAdd(&bar[XB_TMO], 1u); break; } }
  }
  nloc = mine > 0u ? mine : 1u; nx = cnt > 0u ? cnt : 1u;
}
DI void xcd_barrier(const XcdBarrier& b) {
  asm volatile("s_waitcnt vmcnt(0)" ::: "memory");
  __syncthreads();
  if (threadIdx.x == 0) {
    unsigned* bar = b.bar;
    asm volatile("" : "+s"(bar));
    __builtin_amdgcn_s_waitcnt(0);
    unsigned nloc = b.st[0], nx = b.st[1];
    if (nloc == 0u) { xcd_barrier_complete(bar, b.x, nloc, nx); b.st[0] = nloc; b.st[1] = nx; }
    const unsigned old = xb_add(&bar[XB_XSUB(b.x)], 1u);
    const unsigned gen = old / nloc;
    if (old + 1u == (gen + 1u) * nloc) {
      __builtin_amdgcn_fence(__ATOMIC_RELEASE, "agent");
      asm volatile("s_waitcnt vmcnt(0)" ::: "memory");
      const unsigned og = xb_add(&bar[XB_TOP], 1u);
      const unsigned tg = og / nx;
      if (og + 1u == (tg + 1u) * nx) xb_add(&bar[XB_TOPGEN], 1u);
      else XB_SPIN(xb_ld(&bar[XB_TOPGEN]) == tg, bar);
      __builtin_amdgcn_fence(__ATOMIC_ACQUIRE, "agent");
      xb_add(&bar[XB_XGEN(b.x)], 1u);
      asm volatile("s_waitcnt vmcnt(0)" ::: "memory");
    } else {
      XB_SPIN(xb_ld(&bar[XB_XGEN(b.x)]) == gen, bar);
      __builtin_amdgcn_fence(__ATOMIC_ACQUIRE, "agent");
      asm volatile("s_waitcnt vmcnt(0)" ::: "memory");
    }
  }
  __syncthreads();
}

DI void gemm_load(const int tid, const u16* A, int lda, const u16* B, int ldb, int k0, uint4 (&ra)[4], uint4 (&rb)[2]) {
#pragma unroll
  for (int i = 0; i < 4; ++i) {
    int idx = tid + i * 512;
    int row = idx >> 3, ch = idx & 7;
    ra[i] = *(const uint4*)(A + (size_t)row * lda + k0 + ch * 8);
  }
#pragma unroll
  for (int i = 0; i < 2; ++i) {
    int idx = tid + i * 512;
    int row = idx >> 3, ch = idx & 7;
    rb[i] = *(const uint4*)(B + (size_t)row * ldb + k0 + ch * 8);
  }
}
DI void gemm_store_lds(const int tid, char* sA, char* sB, const uint4 (&ra)[4], const uint4 (&rb)[2]) {
#pragma unroll
  for (int i = 0; i < 4; ++i) {
    int idx = tid + i * 512;
    int row = idx >> 3, ch = idx & 7;
    *(uint4*)(sA + row * 128 + ((ch ^ ((row >> 1) & 7)) << 4)) = ra[i];
  }
#pragma unroll
  for (int i = 0; i < 2; ++i) {
    int idx = tid + i * 512;
    int row = idx >> 3, ch = idx & 7;
    *(uint4*)(sB + row * 128 + ((ch ^ ((row >> 1) & 7)) << 4)) = rb[i];
  }
}
DI void gemm_compute(const char* sA, const char* sB, f32x4 (&acc)[4][4], int wm, int wn, int lane) {
#pragma unroll
  for (int kk = 0; kk < 2; ++kk) {
    bf16x8 a[4], b[4];
    const int ch = kk * 4 + (lane >> 4);
#pragma unroll
    for (int mf = 0; mf < 4; ++mf) {
      int row = wm * 64 + mf * 16 + (lane & 15);
      a[mf] = *(const bf16x8*)(sA + row * 128 + ((ch ^ ((row >> 1) & 7)) << 4));
    }
#pragma unroll
    for (int nf = 0; nf < 4; ++nf) {
      int row = wn * 64 + nf * 16 + (lane & 15);
      b[nf] = *(const bf16x8*)(sB + row * 128 + ((ch ^ ((row >> 1) & 7)) << 4));
    }
#pragma unroll
    for (int mf = 0; mf < 4; ++mf)
#pragma unroll
      for (int nf = 0; nf < 4; ++nf)
        acc[mf][nf] = __builtin_amdgcn_mfma_f32_16x16x32_bf16(a[mf], b[nf], acc[mf][nf], 0, 0, 0);
  }
}
DI void gemm_acc(const u16* A, int lda, const u16* B, int ldb, int K, f32x4 (&acc)[4][4], char* smem) {
  const int tid = get_tid(), lane = tid & 63, wave = tid >> 6;
  const int wm = wave >> 1, wn = wave & 1;
  char* sA0 = smem;
  char* sB0 = smem + 32768;
  char* sA1 = smem + 49152;
  char* sB1 = smem + 81920;
  uint4 ra[4], rb[2];
  const int nk = K >> 6;
  gemm_load(tid, A, lda, B, ldb, 0, ra, rb);
  gemm_store_lds(tid, sA0, sB0, ra, rb);
  __syncthreads();
  for (int kt = 0; kt < nk; ++kt) {
    const bool more = (kt + 1 < nk);
    if (more) gemm_load(tid, A, lda, B, ldb, (kt + 1) * 64, ra, rb);
    if (kt & 1) gemm_compute(sA1, sB1, acc, wm, wn, lane);
    else gemm_compute(sA0, sB0, acc, wm, wn, lane);
    if (more) {
      if (kt & 1) gemm_store_lds(tid, sA0, sB0, ra, rb);
      else gemm_store_lds(tid, sA1, sB1, ra, rb);
    }
    __syncthreads();
  }
}
DI void zero_acc(f32x4 (&acc)[4][4]) {
#pragma unroll
  for (int i = 0; i < 4; ++i)
#pragma unroll
    for (int j = 0; j < 4; ++j) { float z0; asm volatile("v_mov_b32 %0, 0" : "=v"(z0)); acc[i][j] = f32x4{z0, z0, z0, z0}; }
}

#define PG8_LAS __attribute__((address_space(3)))
namespace pg8 {
typedef unsigned short bf16_t;
typedef short bf16x8 __attribute__((ext_vector_type(8)));
typedef float f32x4 __attribute__((ext_vector_type(4)));
typedef unsigned u32x4 __attribute__((ext_vector_type(4)));
constexpr int BM = 256, BK = 64, HALF = 128, HTB = HALF * BK * 2  , STAGE_BYTES = 8 * HTB, NXCD = 8, WGM = 8;

__host__ __device__ __forceinline__ int lds_byte(int r, int c) { const int st = (r >> 4) * 2 + (c >> 5), rr = r & 15, cc = c & 31, ob = rr * 64 + cc * 2; return st * 1024 + (ob ^ (((ob >> 9) & 1) << 5)); }
__host__ __device__ __forceinline__ void stage_rc(int b, int& R, int& C) { const int st = b / 1024, sb = b % 1024, swz = sb ^ (((sb >> 9) & 1) << 5); R = (st >> 1) * 16 + swz / 64; C = (st & 1) * 32 + (swz % 64) / 2; }
__host__ __device__ __forceinline__ int perm32(int rho) { const int n = rho >> 4, i = rho & 15; return 8 * (i >> 2) + 4 * n + (i & 3); }

struct Unit { int pm, pn; };
struct Gemm { const bf16_t* A; const bf16_t* Bt; int M, N, K, blk, ld; };

struct StaticOrder {
    int nM, nN, nwg, G, c;
    __host__ __device__ void init(int M, int N, int G_, int c_) { nM = M / BM; nN = N / BM; nwg = nM * nN; G = G_; c = c_; }
    __host__ __device__ bool next(int i, Unit& u) const {
        const long L = (long)i * G + c; if (L >= nwg) return false;
        int wgid = (int)L; { const int q = nwg / NXCD, r = nwg % NXCD, xcd = wgid % NXCD, off = wgid / NXCD; wgid = (xcd < r ? xcd * (q + 1) : r * (q + 1) + (xcd - r) * q) + off; }
        const int nig = WGM * nN, gid = wgid / nig, fm = gid * WGM, gsz = (nM - fm) < WGM ? (nM - fm) : WGM;
        u.pm = fm + ((wgid % nig) % gsz); u.pn = (wgid % nig) / gsz; return true;
    }
    __device__ __forceinline__ void a_ready(const Unit&) const {}
    __device__ __forceinline__ void done(const Unit&) const {}
};
__device__ __forceinline__ unsigned cvt_pk_bf16(float lo, float hi) { unsigned r; asm volatile("v_cvt_pk_bf16_f32 %0, %1, %2" : "=v"(r) : "v"(lo), "v"(hi)); return r; }
template <class Epi, class Sched, bool STAMP = false>
__device__ __forceinline__ void gemm_phase(PG8_LAS unsigned char* lds, const Gemm g, const Sched& S, const Epi& E, unsigned long long* stamps) {
    const int tid = get_tid(), wid = __builtin_amdgcn_readfirstlane(tid >> 6), lane = tid & 63, wr = wid >> 2, wc = wid & 3, fr = lane & 15, fq = lane >> 4;
    const int K = g.K, nt = K / BK;
    int ts_lo = 0, ts_hi = 0, nts = 0; const unsigned long long rt_entry = STAMP ? (unsigned long long)wall_clock64() : 0ull;
#define PG8_STAMP() do { if (STAMP && wid == 0 && nts < 64) { const unsigned long long _c = (unsigned long long)clock64(); \
        ts_lo = (lane == nts) ? (int)(unsigned)_c : ts_lo; ts_hi = (lane == nts) ? (int)(unsigned)(_c >> 32) : ts_hi; ++nts; } } while (0)
    PG8_STAMP();
    unsigned voffA[2], voffB[2];
#pragma unroll
    for (int i = 0; i < 2; ++i) { int R, C; stage_rc(tid * 16 + i * 8192, R, C); const int Rb = Epi::PERM ? ((R & ~31) + perm32(R & 31)) : R;
        const int ldr = g.blk ? 64 : g.ld; voffA[i] = (unsigned)(R * ldr + C) * 2u; voffB[i] = (unsigned)(Rb * ldr + C) * 2u; }
    const size_t kstep = g.blk ? (size_t)32768 : (size_t)(BK * 2);
    const size_t hstep = g.blk ? (size_t)16384 : (size_t)HALF * g.ld * 2;
    const size_t tstep = g.blk ? (size_t)(K / 64) * 32768 : 2 * hstep;
    const unsigned ldsw = (unsigned)wid * 1024u;
    const int aoff = lds_byte(wr * 64 + fr, fq * 8), boff = lds_byte(wc * 32 + fr, fq * 8);
#define PG8_SA(b, h) (((b) * 2 + (h)) * HTB)
#define PG8_SB(b, h) ((4 + (b) * 2 + (h)) * HTB)
#define PG8_STAGE(bufoff, gbase, voff) do { _Pragma("unroll") for (int _i = 0; _i < 2; ++_i) \
        __builtin_amdgcn_global_load_lds((const unsigned*)((const char*)(gbase) + (voff)[_i]), (PG8_LAS unsigned*)(lds + (bufoff) + ldsw + _i * 8192), 16, 0, 0); } while (0)
#define PG8_LDA(dst, b, h) do { _Pragma("unroll") for (int m = 0; m < 4; ++m) _Pragma("unroll") for (int k = 0; k < 2; ++k) dst[m][k] = *(const PG8_LAS bf16x8*)(lds + PG8_SA(b, h) + aoff + m * 2048 + k * 1024); } while (0)
#define PG8_LDB(dst, b, h) do { _Pragma("unroll") for (int n = 0; n < 2; ++n) _Pragma("unroll") for (int k = 0; k < 2; ++k) dst[n][k] = *(const PG8_LAS bf16x8*)(lds + PG8_SB(b, h) + boff + n * 2048 + k * 1024); } while (0)
#define PG8_MMA(ai, bj, At, Bt) do { __builtin_amdgcn_s_setprio(1); _Pragma("unroll") for (int m = 0; m < 4; ++m) _Pragma("unroll") for (int n = 0; n < 2; ++n) _Pragma("unroll") for (int k = 0; k < 2; ++k) \
        acc[ai][bj][m][n] = __builtin_amdgcn_mfma_f32_16x16x32_bf16(Bt[n][k], At[m][k], acc[ai][bj][m][n], 0, 0, 0); __builtin_amdgcn_s_setprio(0); } while (0)
#define PG8_WAIT_V(n) asm volatile("s_waitcnt vmcnt(" #n ")" ::: "memory")
#define PG8_WAIT_L(n) asm volatile("s_waitcnt lgkmcnt(" #n ")" ::: "memory")
#define PG8_BAR __builtin_amdgcn_s_barrier()
#define PG8_SCHED __builtin_amdgcn_sched_barrier(0)
    Unit cur, nxt; int ui = 0;
    if (!S.next(0, cur)) return;
    f32x4 acc[2][2][4][2];
#pragma unroll
    for (int a = 0; a < 2; ++a)
#pragma unroll
        for (int b = 0; b < 2; ++b)
#pragma unroll
            for (int m = 0; m < 4; ++m)
#pragma unroll
                for (int n = 0; n < 2; ++n) { float z0; asm volatile("v_mov_b32 %0, 0" : "=v"(z0)); acc[a][b][m][n] = (f32x4){z0, z0, z0, z0}; }
    bf16x8 At[4][2], B0[2][2], B1[2][2];
    const char* cA = (const char*)g.A + (size_t)cur.pm * tstep; const char* cB = (const char*)g.Bt + (size_t)cur.pn * tstep;
    S.a_ready(cur);
    PG8_STAGE(PG8_SB(0, 0), cB, voffB); PG8_STAGE(PG8_SA(0, 0), cA, voffA); PG8_STAGE(PG8_SB(0, 1), cB + hstep, voffB); PG8_STAGE(PG8_SA(0, 1), cA + hstep, voffA);
    if (wr == 1) PG8_BAR;
    PG8_WAIT_V(4); PG8_BAR;
    PG8_STAGE(PG8_SB(1, 0), cB + kstep, voffB); PG8_STAGE(PG8_SA(1, 0), cA + kstep, voffA); PG8_STAGE(PG8_SB(1, 1), cB + hstep + kstep, voffB);
    PG8_WAIT_V(6); PG8_BAR;
    PG8_STAMP();
    for (;;) {
        const bool has_next = S.next(ui + 1, nxt);
        const char* nA = has_next ? (const char*)g.A + (size_t)nxt.pm * tstep : cA; const char* nB = has_next ? (const char*)g.Bt + (size_t)nxt.pn * tstep : cB;
        for (int t = 0; t < nt; t += 2) {
            const bool last = (t == nt - 2);
            const char* a1 = cA + (size_t)(t + 1) * kstep;
            const char* a2 = last ? nA : cA + (size_t)(t + 2) * kstep; const char* b2 = last ? nB : cB + (size_t)(t + 2) * kstep;
            const char* a3 = a2 + kstep; const char* b3 = b2 + kstep;
            if (last && has_next) S.a_ready(nxt);
            PG8_LDB(B0, 0, 0); PG8_SCHED; PG8_LDA(At, 0, 0); PG8_STAGE(PG8_SA(1, 1), a1 + hstep, voffA);
            PG8_WAIT_L(8); PG8_BAR; PG8_WAIT_L(0); PG8_MMA(0, 0, At, B0); PG8_BAR; PG8_SCHED;
            PG8_LDB(B1, 0, 1); PG8_STAGE(PG8_SB(0, 0), b2, voffB);
            PG8_BAR; PG8_WAIT_L(0); PG8_MMA(0, 1, At, B1); PG8_BAR;
            PG8_LDA(At, 0, 1); PG8_STAGE(PG8_SA(0, 0), a2, voffA);
            PG8_BAR; PG8_WAIT_L(0); PG8_MMA(1, 0, At, B0); PG8_BAR; PG8_SCHED;
            PG8_STAGE(PG8_SB(0, 1), b2 + hstep, voffB);
            PG8_WAIT_V(6); PG8_BAR; PG8_MMA(1, 1, At, B1); PG8_BAR;
            PG8_LDB(B0, 1, 0); PG8_SCHED; PG8_LDA(At, 1, 0); PG8_STAGE(PG8_SA(0, 1), a2 + hstep, voffA);
            PG8_WAIT_L(8); PG8_BAR; PG8_WAIT_L(0); PG8_MMA(0, 0, At, B0); PG8_BAR; PG8_SCHED;
            PG8_LDB(B1, 1, 1); PG8_STAGE(PG8_SB(1, 0), b3, voffB);
            PG8_BAR; PG8_WAIT_L(0); PG8_MMA(0, 1, At, B1); PG8_BAR;
            PG8_LDA(At, 1, 1); PG8_STAGE(PG8_SA(1, 0), a3, voffA);
            PG8_BAR; PG8_WAIT_L(0); PG8_MMA(1, 0, At, B0); PG8_BAR; PG8_SCHED;
            PG8_STAGE(PG8_SB(1, 1), b3 + hstep, voffB);
            PG8_WAIT_V(6); PG8_BAR; PG8_MMA(1, 1, At, B1); PG8_BAR;
        }
        PG8_STAMP();
        if constexpr (!Epi::AFTER_DRAIN) { E(acc, cur, wr, wc, fr, fq); S.done(cur); }
        PG8_STAMP();
        if (!has_next) break;
#pragma unroll
        for (int a = 0; a < 2; ++a)
#pragma unroll
            for (int b = 0; b < 2; ++b)
#pragma unroll
                for (int m = 0; m < 4; ++m)
#pragma unroll
                    for (int n = 0; n < 2; ++n) { float z0; asm volatile("v_mov_b32 %0, 0" : "=v"(z0)); acc[a][b][m][n] = (f32x4){z0, z0, z0, z0}; }
        cur = nxt; cA = nA; cB = nB; ++ui;
    }
    PG8_WAIT_V(0);
    if (wr == 0) PG8_BAR;
    PG8_BAR;
    if constexpr (Epi::AFTER_DRAIN) { E.fused(acc, cur, wr, wc, fr, fq, lds, wid, lane); S.done(cur); }
    PG8_STAMP();
    if (STAMP && wid == 0) { stamps[lane] = lane < nts ? (((unsigned long long)(unsigned)ts_hi << 32) | (unsigned)ts_lo) : 0ull;
        if (lane == 62) stamps[62] = rt_entry; if (lane == 63) stamps[63] = (unsigned long long)wall_clock64(); }
#undef PG8_STAMP
#undef PG8_SA
#undef PG8_SB
#undef PG8_STAGE
#undef PG8_LDA
#undef PG8_LDB
#undef PG8_MMA
#undef PG8_WAIT_V
#undef PG8_WAIT_L
#undef PG8_BAR
#undef PG8_SCHED
}
}

using pg8::cvt_pk_bf16;
DI uint4 pack8(const pg8::f32x4& a, const pg8::f32x4& b) {
  return uint4{cvt_pk_bf16(a[0], a[1]), cvt_pk_bf16(a[2], a[3]), cvt_pk_bf16(b[0], b[1]), cvt_pk_bf16(b[2], b[3])};
}
DI void unpack8(const uint4& u, float (&o)[8]) {
  o[0] = bf2f((u16)(u.x & 0xffff)); o[1] = bf2f((u16)(u.x >> 16));
  o[2] = bf2f((u16)(u.y & 0xffff)); o[3] = bf2f((u16)(u.y >> 16));
  o[4] = bf2f((u16)(u.z & 0xffff)); o[5] = bf2f((u16)(u.z >> 16));
  o[6] = bf2f((u16)(u.w & 0xffff)); o[7] = bf2f((u16)(u.w >> 16));
}
struct EpiP {
  static constexpr bool PERM = true, AFTER_DRAIN = false;
  u16 *zb, *xr, *rwb, *gb; float* dtb; int coff;
  DI void operator()(const pg8::f32x4 (&acc)[2][2][4][2], const pg8::Unit& u, int wr, int wc, int fr, int fq) const {
    const int row0 = u.pm * 256 + wr * 64 + fr;
#pragma unroll
    for (int bj = 0; bj < 2; ++bj) {
      const int cg = coff + u.pn * 256 + bj * 128 + wc * 32;
      const int col0 = cg + 8 * fq;
      if (cg >= 10688) continue;
#pragma unroll
      for (int ai = 0; ai < 2; ++ai)
#pragma unroll
        for (int m = 0; m < 4; ++m) {
          const size_t row = row0 + ai * 128 + m * 16;
          const pg8::f32x4 v0 = acc[ai][bj][m][0], v1 = acc[ai][bj][m][1];
          if (cg >= 5120 && cg < 5184) {
            float* d = dtb + row * 64 + (col0 - 5120);
            *(pg8::f32x4*)d = v0; *(pg8::f32x4*)(d + 4) = v1;
          } else {
            u16* dst = (cg < 2048) ? zb + row * 2048 + col0
                     : (cg < 5120) ? xr + row * 3072 + (col0 - 2048)
                     : (cg < 8640) ? rwb + row * 3456 + (col0 - 5184)
                                   : gb + row * 2048 + (col0 - 8640);
            *(uint4*)dst = pack8(v0, v1);
          }
        }
    }
  }
};
struct EpiOutV {
  static constexpr bool PERM = true, AFTER_DRAIN = false;
  const u16* gb; u16* V; int goff;
  DI void operator()(const pg8::f32x4 (&acc)[2][2][4][2], const pg8::Unit& u, int wr, int wc, int fr, int fq) const {
    const int row0 = u.pm * 256 + wr * 64 + fr;
#pragma unroll
    for (int bj = 0; bj < 2; ++bj) {
      const int col0 = u.pn * 256 + bj * 128 + wc * 32 + 8 * fq;
#pragma unroll
      for (int ai = 0; ai < 2; ++ai)
#pragma unroll
        for (int m = 0; m < 4; ++m) {
          const size_t row = row0 + ai * 128 + m * 16;
          float gt[8];
          unpack8(*(const uint4*)(gb + row * 2048 + goff + col0), gt);
          pg8::f32x4 v0 = acc[ai][bj][m][0], v1 = acc[ai][bj][m][1];
#pragma unroll
          for (int e = 0; e < 4; ++e) { v0[e] *= sigm(gt[e]); v1[e] *= sigm(gt[4 + e]); }
          *(uint4*)(V + row * 1024 + col0) = pack8(v0, v1);
        }
    }
  }
};
struct EpiWo {
  static constexpr bool PERM = true, AFTER_DRAIN = false;
  const float *xp, *xs, *mod; float* out; int tok0;
  DI void operator()(const pg8::f32x4 (&acc)[2][2][4][2], const pg8::Unit& u, int wr, int wc, int fr, int fq) const {
    const int row0 = u.pm * 256 + wr * 64 + fr;
#pragma unroll
    for (int bj = 0; bj < 2; ++bj) {
      const int col0 = u.pn * 256 + bj * 128 + wc * 32 + 8 * fq;
#pragma unroll
      for (int ai = 0; ai < 2; ++ai)
#pragma unroll
        for (int m = 0; m < 4; ++m) {
          const int tok = tok0 + row0 + ai * 128 + m * 16;
          const float* xr = tok < 8192 ? xp + (size_t)tok * 1024 : xs + (size_t)(tok - 8192) * 1024;
          const float* gt = mod + mrow_of(tok) * 6144 + 2048 + col0;
          const pg8::f32x4 x0 = *(const pg8::f32x4*)(xr + col0), x1 = *(const pg8::f32x4*)(xr + col0 + 4);
          const pg8::f32x4 g0 = *(const pg8::f32x4*)gt, g1 = *(const pg8::f32x4*)(gt + 4);
          float* o = out + (size_t)tok * 1024 + col0;
          *(pg8::f32x4*)o = x0 + g0 * acc[ai][bj][m][0];
          *(pg8::f32x4*)(o + 4) = x1 + g1 * acc[ai][bj][m][1];
        }
    }
  }
};
struct EpiGU {
  static constexpr bool PERM = true, AFTER_DRAIN = false;
  u16* act;
  DI void operator()(const pg8::f32x4 (&acc)[2][2][4][2], const pg8::Unit& u, int wr, int wc, int fr, int fq) const {
    const int row0 = u.pm * 256 + wr * 64 + fr;
    const int col0 = u.pn * 128 + wc * 32 + 8 * fq;
#pragma unroll
    for (int ai = 0; ai < 2; ++ai)
#pragma unroll
      for (int m = 0; m < 4; ++m) {
        const size_t row = row0 + ai * 128 + m * 16;
        pg8::f32x4 v0, v1;
#pragma unroll
        for (int e = 0; e < 4; ++e) {
          v0[e] = siluf(acc[ai][0][m][0][e]) * acc[ai][1][m][0][e];
          v1[e] = siluf(acc[ai][0][m][1][e]) * acc[ai][1][m][1][e];
        }
        *(uint4*)(act + ((row >> 8) * 44 + (col0 >> 6)) * 16384 + (row & 255) * 64 + (col0 & 63)) = pack8(v0, v1);
      }
  }
};
struct EpiDown {
  static constexpr bool PERM = true, AFTER_DRAIN = false;
  const float* mod; float* out;
  DI void operator()(const pg8::f32x4 (&acc)[2][2][4][2], const pg8::Unit& u, int wr, int wc, int fr, int fq) const {
    const int row0 = u.pm * 256 + wr * 64 + fr;
#pragma unroll
    for (int bj = 0; bj < 2; ++bj) {
      const int col0 = u.pn * 256 + bj * 128 + wc * 32 + 8 * fq;
#pragma unroll
      for (int ai = 0; ai < 2; ++ai)
#pragma unroll
        for (int m = 0; m < 4; ++m) {
          const int tok = row0 + ai * 128 + m * 16;
          const float* gt = mod + mrow_of(tok) * 6144 + 5120 + col0;
          const pg8::f32x4 g0 = *(const pg8::f32x4*)gt, g1 = *(const pg8::f32x4*)(gt + 4);
          float* o = out + (size_t)tok * 1024 + col0;
          const pg8::f32x4 x0 = *(const pg8::f32x4*)o, x1 = *(const pg8::f32x4*)(o + 4);
          *(pg8::f32x4*)o = x0 + g0 * acc[ai][bj][m][0];
          *(pg8::f32x4*)(o + 4) = x1 + g1 * acc[ai][bj][m][1];
        }
    }
  }
};
template <class Epi>
DI void run_gemm8(char* smem, const u16* A, const u16* Bt, int M, int N, int K, const Epi& E, int vb = -1, int nb = 0, int blk = 0, int ld = 0) {
  if (ld == 0) ld = K;
  asm volatile("" : "+s"(M), "+s"(N), "+s"(K), "+s"(blk), "+s"(ld));
  pg8::Gemm gm{A, Bt, M, N, K, blk, ld};
  pg8::StaticOrder S;
  if (vb < 0) { vb = blockIdx.x; nb = gridDim.x; }
  S.init(M, N, nb, vb);
  pg8::gemm_phase<Epi, pg8::StaticOrder, false>((PG8_LAS unsigned char*)smem, gm, S, E, nullptr);
  __syncthreads();
}

struct EpiR2 {
  static constexpr bool PERM = true, AFTER_DRAIN = false;
  __half* wk; const float *w0, *a0;
  DI void operator()(const pg8::f32x4 (&acc)[2][2][4][2], const pg8::Unit& u, int wr, int wc, int fr, int fq) const {
    const int row0 = u.pm * 256 + wr * 64 + fr;
    const int sec = u.pn >> 2;
#pragma unroll
    for (int bj = 0; bj < 2; ++bj) {
      const int nn = (u.pn & 3) * 256 + bj * 128 + wc * 32 + 8 * fq;
      const int d = sec & 1;
      const float* bias = (sec < 2 ? w0 : a0) + d * 1024 + nn;
      const pg8::f32x4 b0 = *(const pg8::f32x4*)bias, b1 = *(const pg8::f32x4*)(bias + 4);
      const int field = (sec < 2 ? 4 : 5) + 2 * d;
#pragma unroll
      for (int ai = 0; ai < 2; ++ai)
#pragma unroll
        for (int m = 0; m < 4; ++m) {
          const size_t row = row0 + ai * 128 + m * 16;
          pg8::f32x4 v0 = acc[ai][bj][m][0] + b0, v1 = acc[ai][bj][m][1] + b1;
          float o[8];
#pragma unroll
          for (int e = 0; e < 4; ++e) {
            float s0 = sigm(v0[e]), s1 = sigm(v1[e]);
            o[e] = sec < 2 ? __expf(-0.6065306597f * s0) : s0;
            o[4 + e] = sec < 2 ? __expf(-0.6065306597f * s1) : s1;
          }
          __half2 h0 = __floats2half2_rn(o[0], o[1]), h1 = __floats2half2_rn(o[2], o[3]);
          __half2 h2 = __floats2half2_rn(o[4], o[5]), h3 = __floats2half2_rn(o[6], o[7]);
          uint4 pk;
          pk.x = *reinterpret_cast<unsigned*>(&h0); pk.y = *reinterpret_cast<unsigned*>(&h1);
          pk.z = *reinterpret_cast<unsigned*>(&h2); pk.w = *reinterpret_cast<unsigned*>(&h3);
          *(uint4*)(wk + ((row * 16 + (nn >> 6)) * 8 + field) * 64 + (nn & 63)) = pk;
        }
    }
  }
};

template <int MODE>
__device__ __forceinline__ void convT(const float* __restrict__ src, int K, int N, u16* __restrict__ dst, char* smem, int vb = -1, int nb = 0, int ldd = 0) {
  if (ldd == 0) ldd = K;
  float* tile = (float*)smem;
  const int tid = get_tid();
  const int KT = K >> 6, NT = N >> 6;
  if (vb < 0) { vb = blockIdx.x; nb = gridDim.x; }
  for (int t = vb; t < KT * NT; t += nb) {
    int kt = t % KT, nt = t / KT;
#pragma unroll
    for (int i = 0; i < 2; ++i) {
      int idx = tid + i * 512;
      int r = idx >> 4, c4 = idx & 15;
      *(float4*)(tile + r * 68 + c4 * 4) = *(const float4*)(src + (size_t)(kt * 64 + r) * N + nt * 64 + c4 * 4);
    }
    __syncthreads();
    int n = tid >> 3, kc = tid & 7;
    unsigned w[4];
#pragma unroll
    for (int j = 0; j < 4; ++j)
      w[j] = pack2(tile[(kc * 8 + 2 * j) * 68 + n], tile[(kc * 8 + 2 * j + 1) * 68 + n]);
    int ng = nt * 64 + n;
    int row = ng;
    if (MODE == 1) {
      int isu = ng >= 2816;
      int nn = ng - isu * 2816;
      row = (nn >> 7) * 256 + isu * 128 + (nn & 127);
    }
    if (MODE == 2) *(uint4*)(dst + ((size_t)(row >> 8) * KT + kt) * 16384 + (row & 255) * 64 + kc * 8) = uint4{w[0], w[1], w[2], w[3]};
    else *(uint4*)(dst + (size_t)row * ldd + kt * 64 + kc * 8) = uint4{w[0], w[1], w[2], w[3]};
    __syncthreads();
  }
}

__device__ __forceinline__ void step_prep(const Params& p, char* smem) {
  const int tid = get_tid();
  char* ws = p.ws;
  {
    float* red = (float*)smem;
    float* mod = (float*)(ws + OFF_MOD);
    for (int item = blockIdx.x; item < 192; item += gridDim.x) {
      int c4 = tid & 7, kl = tid >> 3;
      float acc[12];
#pragma unroll
      for (int i = 0; i < 12; ++i) acc[i] = 0.f;
      for (int k = kl; k < 1024; k += 64) {
        float4 w = *(const float4*)(p.w_ada + (size_t)k * 6144 + item * 32 + c4 * 4);
        float s0 = siluf(p.c_ctx[k]), s1 = siluf(p.c[k]), s2 = siluf(p.c[1024 + k]);
        acc[0] += s0 * w.x; acc[1] += s0 * w.y; acc[2] += s0 * w.z; acc[3] += s0 * w.w;
        acc[4] += s1 * w.x; acc[5] += s1 * w.y; acc[6] += s1 * w.z; acc[7] += s1 * w.w;
        acc[8] += s2 * w.x; acc[9] += s2 * w.y; acc[10] += s2 * w.z; acc[11] += s2 * w.w;
      }
#pragma unroll
      for (int i = 0; i < 12; ++i) red[(kl * 8 + c4) * 12 + i] = acc[i];
      __syncthreads();
      if (tid < 96) {
        int cond = tid >> 5, col = tid & 31;
        int cc4 = col >> 2, e = col & 3;
        float s = 0.f;
        for (int k = 0; k < 64; ++k) s += red[(k * 8 + cc4) * 12 + cond * 4 + e];
        int n = item * 32 + col;
        mod[cond * 6144 + n] = s + p.b_ada[n];
      }
      __syncthreads();
    }
  }
  convT<0>(p.w_in, 1024, 10688, (u16*)(ws + OFF_WIN), smem);
  convT<0>(p.w_m_out, 2048, 1024, (u16*)(ws + OFF_WMOUT), smem);
  convT<0>(p.w_r_out, 1024, 1024, (u16*)(ws + OFF_WROUT), smem);
  convT<0>(p.w_o, 1024, 1024, (u16*)(ws + OFF_WO), smem);
  convT<0>(p.w2, 64, 1024, (u16*)(ws + OFF_W2T), smem);
  convT<0>(p.w2 + 65536, 64, 1024, (u16*)(ws + OFF_W2T) + 65536, smem);
  convT<0>(p.a2, 64, 1024, (u16*)(ws + OFF_A2T), smem);
  convT<0>(p.a2 + 65536, 64, 1024, (u16*)(ws + OFF_A2T) + 65536, smem);
  convT<0>(p.g2, 128, 1024, (u16*)(ws + OFF_G2T), smem);
  {
    u16* w4 = (u16*)(ws + OFF_W4T);
    convT<0>(p.w2, 64, 1024, w4 + (size_t)0 * 1024 * 256 + 0, smem, -1, 0, 256);
    convT<0>(p.w2 + 65536, 64, 1024, w4 + (size_t)1 * 1024 * 256 + 64, smem, -1, 0, 256);
    convT<0>(p.a2, 64, 1024, w4 + (size_t)2 * 1024 * 256 + 128, smem, -1, 0, 256);
    convT<0>(p.a2 + 65536, 64, 1024, w4 + (size_t)3 * 1024 * 256 + 192, smem, -1, 0, 256);
    for (int i = blockIdx.x * NTHR + tid; i < 4096 * 32; i += gridDim.x * NTHR) {
      int row = i >> 5, c = i & 31;
      if ((c >> 3) != (row >> 10)) *(uint4*)(w4 + (size_t)row * 256 + c * 8) = uint4{0, 0, 0, 0};
    }
  }
  {
    uint4* z = (uint4*)(ws + OFF_WIN + (size_t)10688 * 1024 * 2);
    for (int i = blockIdx.x * NTHR + tid; i < 8192; i += gridDim.x * NTHR) z[i] = uint4{0, 0, 0, 0};
  }
}

template <int WHICH>
__device__ __forceinline__ void step_norm(const Params& p, int g) {
  const int tid = get_tid(), lane = tid & 63, wave = tid >> 6;
  const float* mod = (const float*)(p.ws + OFF_MOD);
  const int nrows = WHICH == 0 ? TG : NTOK;
  u16* dst = WHICH == 0 ? (u16*)((char*)p.out + H1_OUT_OFF) : (u16*)(p.ws + OFF_H2);
  const float* nw = WHICH == 0 ? p.norm1_w : p.norm2_w;
  for (int r = blockIdx.x * 8 + wave; r < nrows; r += gridDim.x * 8) {
    int tok = WHICH == 0 ? g * TG + r : r;
    const float* xr;
    if (WHICH == 0) xr = tok < 8192 ? p.x_prompt + (size_t)tok * 1024 : p.x_sample + (size_t)(tok - 8192) * 1024;
    else xr = (const float*)(p.ws + OFF_X1) + (size_t)tok * 1024;
    const float* mr = mod + mrow_of(tok) * 6144 + (WHICH == 0 ? 0 : 3072);
    float4 v[4];
    float ss = 0.f;
#pragma unroll
    for (int i = 0; i < 4; ++i) {
      v[i] = ((const float4*)xr)[i * 64 + lane];
      ss += v[i].x * v[i].x + v[i].y * v[i].y + v[i].z * v[i].z + v[i].w * v[i].w;
    }
    ss = wave_sum(ss);
    float rinv = rsqrtf(ss * (1.f / 1024.f) + 1e-6f);
#pragma unroll
    for (int i = 0; i < 4; ++i) {
      int col = (i * 64 + lane) * 4;
      float4 w4 = *(const float4*)(nw + col);
      float4 sh = *(const float4*)(mr + col);
      float4 sc = *(const float4*)(mr + 1024 + col);
      float h0 = v[i].x * rinv * w4.x * (1.f + sc.x) + sh.x;
      float h1 = v[i].y * rinv * w4.y * (1.f + sc.y) + sh.y;
      float h2 = v[i].z * rinv * w4.z * (1.f + sc.z) + sh.z;
      float h3 = v[i].w * rinv * w4.w * (1.f + sc.w) + sh.w;
      *(uint2*)(dst + (size_t)r * 1024 + col) = uint2{pack2(h0, h1), pack2(h2, h3)};
    }
  }
}

__device__ __forceinline__ void step_gemm1(const Params& p, char* smem, int part) {
  char* ws = p.ws;
  const u16* H1 = (const u16*)((const char*)p.out + H1_OUT_OFF);
  const u16* W = (const u16*)(ws + OFF_WIN);
  if (part == 0) {
    EpiP E{(u16*)(ws + OFF_Z), (u16*)(ws + OFF_XBCRAW), (u16*)(ws + OFF_RW), (u16*)(ws + OFF_GATE), (float*)(ws + OFF_DT), 0};
    run_gemm8(smem, H1, W, TG, NPAD, 1024, E);
  } else if (part == 1) {
    EpiP E{(u16*)(ws + OFF_Z), (u16*)(ws + OFF_XBCRAW), (u16*)(ws + OFF_RW), (u16*)(ws + OFF_GATE), (float*)(ws + OFF_DT), 0};
    run_gemm8(smem, H1, W, TG, 5120, 1024, E, (int)blockIdx.x - 64, (int)gridDim.x - 64);
  } else {
    EpiP E{(u16*)(ws + OFF_Z), (u16*)(ws + OFF_XBCRAW), (u16*)(ws + OFF_RW), (u16*)(ws + OFF_GATE), (float*)(ws + OFF_DT), 5120};
    run_gemm8(smem, H1, W + (size_t)5120 * 1024, TG, NPAD - 5120, 1024, E);
  }
}

__device__ __forceinline__ void step_cr1(const Params& p, int g) {
  char* ws = p.ws;
  const int tid = get_tid(), lane = tid & 63, wave = tid >> 6;
  const int Ls = g < 2 ? 256 : 2048;
  {
    const u16* __restrict__ xr = (const u16*)(ws + OFF_XBCRAW);
    u16* __restrict__ xo = (u16*)(ws + OFF_XBC);
    for (int item = blockIdx.x * NTHR + tid; item < (TG / 8) * 384; item += gridDim.x * NTHR) {
      const int rb = item / 384, cc = item - rb * 384;
      const int r0 = rb * 8, pos0 = r0 & (Ls - 1);
      uint4 rows[12];
#pragma unroll
      for (int i = 0; i < 12; ++i) {
        const int pp = pos0 + i - 2;
        rows[i] = uint4{0, 0, 0, 0};
        if (pp >= 0 && pp < Ls) rows[i] = *(const uint4*)(xr + (size_t)(r0 + i - 2) * 3072 + cc * 8);
      }
      float w[5][8], bias[8];
      {
        float4 b0 = *(const float4*)(p.conv_b + cc * 8), b1 = *(const float4*)(p.conv_b + cc * 8 + 4);
        bias[0] = b0.x; bias[1] = b0.y; bias[2] = b0.z; bias[3] = b0.w; bias[4] = b1.x; bias[5] = b1.y; bias[6] = b1.z; bias[7] = b1.w;
#pragma unroll
        for (int i = 0; i < 5; ++i) {
          float4 w0 = *(const float4*)(p.conv_w + i * 3072 + cc * 8), w1 = *(const float4*)(p.conv_w + i * 3072 + cc * 8 + 4);
          w[i][0] = w0.x; w[i][1] = w0.y; w[i][2] = w0.z; w[i][3] = w0.w; w[i][4] = w1.x; w[i][5] = w1.y; w[i][6] = w1.z; w[i][7] = w1.w;
        }
      }
      float s[8][8];
#pragma unroll
      for (int o = 0; o < 8; ++o)
#pragma unroll
        for (int e = 0; e < 8; ++e) s[o][e] = bias[e];
#pragma unroll
      for (int i = 0; i < 12; ++i) {
        float xv[8];
        unpack8(rows[i], xv);
#pragma unroll
        for (int k = 0; k < 5; ++k) {
          const int o = i - k;
          if (o >= 0 && o < 8) {
#pragma unroll
            for (int e = 0; e < 8; ++e) s[o][e] += xv[e] * w[k][e];
          }
        }
      }
#pragma unroll
      for (int o = 0; o < 8; ++o) {
#pragma unroll
        for (int e = 0; e < 8; ++e) s[o][e] = siluf(s[o][e]);
        *(uint4*)(xo + (size_t)(r0 + o) * 3072 + cc * 8) = uint4{pack2(s[o][0], s[o][1]), pack2(s[o][2], s[o][3]), pack2(s[o][4], s[o][5]), pack2(s[o][6], s[o][7])};
      }
    }
  }
  {
    const u16* __restrict__ rw = (const u16*)(ws + OFF_RW);
    __half* __restrict__ wk = (__half*)(ws + OFF_WK);
    u16* __restrict__ tl = (u16*)(ws + OFF_TL);
    u16* __restrict__ sg = (u16*)(ws + OFF_SG);
    const bool grid = (g == 2);
    for (int r = blockIdx.x * 8 + wave; r < TG; r += gridDim.x * 8) {
      const int pos = r & (Ls - 1);
      uint4 cur[7], shv[7];
#pragma unroll
      for (int it = 0; it < 7; ++it) {
        const int ci = it * 64 + lane;
        cur[it] = uint4{0, 0, 0, 0};
        shv[it] = uint4{0, 0, 0, 0};
        if (ci < 432) {
          const int q = ci / 108;
          int dr;
          bool ok;
          if (!grid) {
            if (q & 1) { dr = 1; ok = pos < Ls - 1; } else { dr = -1; ok = pos > 0; }
          } else {
            if (q == 0) { dr = -1; ok = (pos & 63) != 0; }
            else if (q == 1) { dr = 1; ok = (pos & 63) != 63; }
            else if (q == 2) { dr = -64; ok = pos >= 64; }
            else { dr = 64; ok = pos < Ls - 64; }
          }
          cur[it] = *(const uint4*)(rw + (size_t)r * 3456 + ci * 8);
          if (ok) shv[it] = *(const uint4*)(rw + (size_t)(r + dr) * 3456 + ci * 8);
        }
      }
#pragma unroll
      for (int it = 0; it < 7; ++it) {
        const int ci = it * 64 + lane;
        const bool valid = ci < 432;
        float xx[8];
        {
          float cf[8], sf[8];
          unpack8(cur[it], cf);
          unpack8(shv[it], sf);
          const int cm = valid ? ci * 8 : 0;
          const float4 m0 = *(const float4*)(p.mu_shift + cm), m1 = *(const float4*)(p.mu_shift + cm + 4);
          const float mu[8] = {m0.x, m0.y, m0.z, m0.w, m1.x, m1.y, m1.z, m1.w};
#pragma unroll
          for (int e = 0; e < 8; ++e) xx[e] = cf[e] + mu[e] * (sf[e] - cf[e]);
        }
        const bool isk = valid && ci >= 144 && ci < 272;
        float kk[8];
        float ss = 0.f;
        {
          const int kc = isk ? ci - 144 : 0;
          const float4 k0 = *(const float4*)(p.k_k + kc * 8), k1 = *(const float4*)(p.k_k + kc * 8 + 4);
          const float kkw[8] = {k0.x, k0.y, k0.z, k0.w, k1.x, k1.y, k1.z, k1.w};
#pragma unroll
          for (int e = 0; e < 8; ++e) { kk[e] = xx[e] * kkw[e]; ss += kk[e] * kk[e]; }
        }
        ss += dpp_xor1(ss);
        ss += dpp_xor2(ss);
        ss += dpp_hmirror(ss);
        if (valid) {
          if (ci < 128) {
            __half2 h0 = __floats2half2_rn(xx[0], xx[1]), h1 = __floats2half2_rn(xx[2], xx[3]), h2 = __floats2half2_rn(xx[4], xx[5]), h3 = __floats2half2_rn(xx[6], xx[7]);
            uint4 pk{*reinterpret_cast<unsigned*>(&h0), *reinterpret_cast<unsigned*>(&h1), *reinterpret_cast<unsigned*>(&h2), *reinterpret_cast<unsigned*>(&h3)};
            *(uint4*)(wk + ((size_t)(r * 16 + (ci >> 3)) * 8 + 0) * 64 + (ci & 7) * 8) = pk;
          } else if (ci < 144) {
            float t[8];
#pragma unroll
            for (int e = 0; e < 8; ++e) t[e] = tanhf(xx[e]);
            *(uint4*)(tl + (size_t)r * 256 + (ci - 128) * 8) = uint4{pack2(t[0], t[1]), pack2(t[2], t[3]), pack2(t[4], t[5]), pack2(t[6], t[7])};
          } else if (ci < 272) {
            const int kc = ci - 144;
            const float rn = -rsqrtf(ss + 1e-12f);
            __half2 h0 = __floats2half2_rn(xx[0], xx[1]), h1 = __floats2half2_rn(xx[2], xx[3]), h2 = __floats2half2_rn(xx[4], xx[5]), h3 = __floats2half2_rn(xx[6], xx[7]);
            uint4 pk{*reinterpret_cast<unsigned*>(&h0), *reinterpret_cast<unsigned*>(&h1), *reinterpret_cast<unsigned*>(&h2), *reinterpret_cast<unsigned*>(&h3)};
            *(uint4*)(wk + ((size_t)(r * 16 + (kc >> 3)) * 8 + 2) * 64 + (kc & 7) * 8) = pk;
            __half2 n0 = __floats2half2_rn(kk[0] * rn, kk[1] * rn), n1 = __floats2half2_rn(kk[2] * rn, kk[3] * rn), n2 = __floats2half2_rn(kk[4] * rn, kk[5] * rn), n3 = __floats2half2_rn(kk[6] * rn, kk[7] * rn);
            uint4 pn{*reinterpret_cast<unsigned*>(&n0), *reinterpret_cast<unsigned*>(&n1), *reinterpret_cast<unsigned*>(&n2), *reinterpret_cast<unsigned*>(&n3)};
            *(uint4*)(wk + ((size_t)(r * 16 + (kc >> 3)) * 8 + 3) * 64 + (kc & 7) * 8) = pn;
          } else if (ci < 400) {
            const int vc = ci - 272;
            __half2 h0 = __floats2half2_rn(xx[0], xx[1]), h1 = __floats2half2_rn(xx[2], xx[3]), h2 = __floats2half2_rn(xx[4], xx[5]), h3 = __floats2half2_rn(xx[6], xx[7]);
            uint4 pk{*reinterpret_cast<unsigned*>(&h0), *reinterpret_cast<unsigned*>(&h1), *reinterpret_cast<unsigned*>(&h2), *reinterpret_cast<unsigned*>(&h3)};
            *(uint4*)(wk + ((size_t)(r * 16 + (vc >> 3)) * 8 + 1) * 64 + (vc & 7) * 8) = pk;
          } else if (ci < 416) {
            *(uint4*)(tl + (size_t)r * 256 + 128 + (ci - 400) * 8) = uint4{pack2(xx[0], xx[1]), pack2(xx[2], xx[3]), pack2(xx[4], xx[5]), pack2(xx[6], xx[7])};
          } else {
            float t[8];
#pragma unroll
            for (int e = 0; e < 8; ++e) t[e] = sigm(xx[e]);
            *(uint4*)(sg + (size_t)r * 128 + (ci - 416) * 8) = uint4{pack2(t[0], t[1]), pack2(t[2], t[3]), pack2(t[4], t[5]), pack2(t[6], t[7])};
          }
        }
      }
    }
  }
}

__device__ __forceinline__ void step_r2(const Params& p, char* smem) {
  char* ws = p.ws;
  const int tid = get_tid(), lane = tid & 63, wave = tid >> 6;
  const int wm = wave >> 1, wn = wave & 1;
  const u16* tl = (const u16*)(ws + OFF_TL);
  const u16* sg = (const u16*)(ws + OFF_SG);
  __half* wk = (__half*)(ws + OFF_WK);
  u16* gr = (u16*)(ws + OFF_GR);
  {
    EpiR2 E{wk, p.w0, p.a0};
    run_gemm8(smem, tl, (const u16*)(ws + OFF_W4T), TG, 4096, 256, E);
  }
  for (int t = (gridDim.x - 1 - blockIdx.x) + 4 * 128; t < 5 * 128; t += gridDim.x) {
    int sub = t >> 7, rem = t & 127;
    int mt = rem & 15, nt = rem >> 4;
    f32x4 acc[4][4];
    zero_acc(acc);
    if (sub < 2) {
      gemm_acc(tl + (size_t)mt * 256 * 256 + sub * 64, 256, (const u16*)(ws + OFF_W2T) + sub * 65536 + (size_t)nt * 128 * 64, 64, 64, acc, smem);
    } else if (sub < 4) {
      gemm_acc(tl + (size_t)mt * 256 * 256 + 128 + (sub - 2) * 64, 256, (const u16*)(ws + OFF_A2T) + (sub - 2) * 65536 + (size_t)nt * 128 * 64, 64, 64, acc, smem);
    } else {
      gemm_acc(sg + (size_t)mt * 256 * 128, 128, (const u16*)(ws + OFF_G2T) + (size_t)nt * 128 * 128, 128, 128, acc, smem);
    }
#pragma unroll
    for (int mf = 0; mf < 4; ++mf)
#pragma unroll
      for (int nf = 0; nf < 4; ++nf)
#pragma unroll
        for (int j = 0; j < 4; ++j) {
          if (nf == 0 && j == 0) asm volatile("" ::: "memory");
          int m = mt * 256 + wm * 64 + mf * 16 + (lane >> 4) * 4 + j;
          int n = nt * 128 + wn * 64 + nf * 16 + (lane & 15);
          float v = acc[mf][nf][j];
          if (sub < 2) {
            float wl = v + p.w0[sub * 1024 + n];
            float dec = __expf(-0.6065306597f * sigm(wl));
            wk[((size_t)(m * 16 + (n >> 6)) * 8 + 4 + 2 * sub) * 64 + (n & 63)] = __float2half(dec);
          } else if (sub < 4) {
            int d = sub - 2;
            float a = sigm(v + p.a0[d * 1024 + n]);
            wk[((size_t)(m * 16 + (n >> 6)) * 8 + 5 + 2 * d) * 64 + (n & 63)] = __float2half(a);
          } else {
            gr[(size_t)m * 1024 + n] = f2bf(v);
          }
        }
  }
}

DI int swz16(int row) { return (row ^ (row >> 3)) & 15; }
DI int sw256(int row, int e) { return row * 256 + ((((e >> 3) ^ swz16(row))) << 4) + (e & 7) * 2; }
DI const bf16x8 ldfrag256(const char* base, int row, int ch) {
  return *(const bf16x8*)(base + row * 256 + ((ch ^ swz16(row)) << 4));
}

typedef unsigned v4u __attribute__((ext_vector_type(4)));
struct SsdPre { v4u c0, c1, c2, c3, b0, b1, b2, b3, x0, x1; float d0, d1; };
DI void ssd_issue(const Params& p, int g, int chain, int ci, int tid, SsdPre& R) {
  const int Ls = g < 2 ? 256 : 2048;
  const int nch = Ls >> 7;
  const int d = chain & 1, h = (chain >> 1) & 31, b = chain >> 6;
  const int grp = h >> 3;
  const int c = d ? nch - 1 - ci : ci;
  const int tok0 = b * Ls + c * 128;
  const u16* xbc = (const u16*)(p.ws + OFF_XBC);
  const float* dtb = (const float*)(p.ws + OFF_DT);
  const int lane = tid & 63, wave = tid >> 6;
#define SSD_LDCB(i, CF, BF) { int idx = tid + i * 512; int row = idx >> 4, ch = idx & 15; \
    const u16* src = xbc + (size_t)(tok0 + row) * 3072 + grp * 128 + ch * 8; R.CF = *(const v4u*)(src + 2560); R.BF = *(const v4u*)(src + 2048); }
  SSD_LDCB(0, c0, b0) SSD_LDCB(1, c1, b1) SSD_LDCB(2, c2, b2) SSD_LDCB(3, c3, b3)
#undef SSD_LDCB
#define SSD_LDX(i, XF) { int idx = tid + i * 512; int l = idx >> 3, ch = idx & 7; R.XF = *(const v4u*)(xbc + (size_t)(tok0 + l) * 3072 + h * 64 + ch * 8); }
  SSD_LDX(0, x0) SSD_LDX(1, x1)
#undef SSD_LDX
  if (wave == 0) {
    int e0 = 2 * lane, e1 = 2 * lane + 1;
    int l0 = d ? 127 - e0 : e0, l1 = d ? 127 - e1 : e1;
    R.d0 = dtb[(size_t)(tok0 + l0) * 64 + d * 32 + h];
    R.d1 = dtb[(size_t)(tok0 + l1) * 64 + d * 32 + h];
  }
}

__device__ __forceinline__ void ssd_chain(const Params& p, char* smem, int g, int chain, int next_chain, SsdPre& R) {
  char* ws = p.ws;
  const int tid = get_tid(), lane = tid & 63, wave = tid >> 6;
  const int Ls = g < 2 ? 256 : 2048;
  const int nch = Ls >> 7;
  const int d = chain & 1, h = (chain >> 1) & 31, b = chain >> 6;
  const int grp = h >> 3;
  const u16* xbc = (const u16*)(ws + OFF_XBC);
  const float* dtb = (const float*)(ws + OFF_DT);
  u16* yout = (u16*)(ws + (d ? OFF_SYB : OFF_SYF));
  char* Cs = smem;
  char* Bs = smem + 32768;
  char* BdT = smem + 65536;
  char* XT = smem + 98304;
  char* Ss = smem + 114688;
  float* csum = (float*)(smem + 131072);
  float* dts = (float*)(smem + 131584);
  const float a_h = -__expf(p.a_log[d * 32 + h]);
  const float dtbias = p.dt_bias[d * 32 + h];
  f32x4 sacc[2][2];
  {
    const int wn4 = wave >> 1, wp2 = wave & 1;
#pragma unroll
    for (int nf = 0; nf < 2; ++nf)
#pragma unroll
      for (int pf = 0; pf < 2; ++pf) {
        if (g == 2) {
          const float* h0 = (d ? p.ssm_b : p.ssm_f) + (size_t)(b * 32 + h) * 8192;
          const int n0 = wn4 * 32 + nf * 16 + (lane >> 4) * 4, pp = wp2 * 32 + pf * 16 + (lane & 15);
          const float4 t = *(const float4*)(h0 + pp * 128 + n0);
          sacc[nf][pf] = f32x4{t.x, t.y, t.z, t.w};
        } else {
          sacc[nf][pf] = f32x4{0.f, 0.f, 0.f, 0.f};
        }
      }
  }
  const int tid_outer = tid;
  for (int ci = 0; ci < nch; ++ci) {
    int tidv = tid_outer;
    asm volatile("" : "+v"(tidv));
    const int tid = tidv, lane = tidv & 63, wave = tidv >> 6;
    const int wq4 = wave >> 1, wq2 = wave & 1;
    const int c = d ? nch - 1 - ci : ci;
    const int tok0 = b * Ls + c * 128;
#define SSD_STCB(i, CF, BF) { int idx = tid + i * 512; int row = idx >> 4, ch = idx & 15; \
      *(v4u*)(Cs + row * 256 + ((ch ^ swz16(row)) << 4)) = R.CF; *(v4u*)(Bs + row * 256 + ((ch ^ swz16(row)) << 4)) = R.BF; }
    SSD_STCB(0, c0, b0) SSD_STCB(1, c1, b1) SSD_STCB(2, c2, b2) SSD_STCB(3, c3, b3)
#undef SSD_STCB
#define SSD_STX(i, XF) { int idx = tid + i * 512; int l = idx >> 3, ch = idx & 7; \
      const unsigned w0 = R.XF[0], w1 = R.XF[1], w2 = R.XF[2], w3 = R.XF[3]; \
      *(u16*)(XT + sw256(ch * 8 + 0, l)) = (u16)(w0 & 0xffff); *(u16*)(XT + sw256(ch * 8 + 1, l)) = (u16)(w0 >> 16); \
      *(u16*)(XT + sw256(ch * 8 + 2, l)) = (u16)(w1 & 0xffff); *(u16*)(XT + sw256(ch * 8 + 3, l)) = (u16)(w1 >> 16); \
      *(u16*)(XT + sw256(ch * 8 + 4, l)) = (u16)(w2 & 0xffff); *(u16*)(XT + sw256(ch * 8 + 5, l)) = (u16)(w2 >> 16); \
      *(u16*)(XT + sw256(ch * 8 + 6, l)) = (u16)(w3 & 0xffff); *(u16*)(XT + sw256(ch * 8 + 7, l)) = (u16)(w3 >> 16); }
    SSD_STX(0, x0) SSD_STX(1, x1)
#undef SSD_STX
    if (wave == 0) {
      int e0 = 2 * lane, e1 = 2 * lane + 1;
      int l0 = d ? 127 - e0 : e0, l1 = d ? 127 - e1 : e1;
      float x0 = R.d0 + dtbias;
      float x1 = R.d1 + dtbias;
      float dt0 = x0 > 20.f ? x0 : log1pf(__expf(x0));
      float dt1 = x1 > 20.f ? x1 : log1pf(__expf(x1));
      float a0 = dt0 * a_h, a1 = dt1 * a_h;
      float s = a0 + a1;
#pragma unroll
      for (int o = 1; o < 64; o <<= 1) {
        float t = __shfl_up(s, o);
        if (lane >= o) s += t;
      }
      csum[l1] = s;
      csum[l0] = s - a1;
      dts[l0] = dt0;
      dts[l1] = dt1;
    }
    if (ci + 1 < nch) ssd_issue(p, g, chain, ci + 1, tid, R);
    else if (next_chain >= 0) ssd_issue(p, g, next_chain, 0, tid, R);
#pragma unroll
    for (int nf = 0; nf < 2; ++nf)
#pragma unroll
      for (int pf = 0; pf < 2; ++pf) {
        const int n0 = wq4 * 32 + nf * 16 + (lane >> 4) * 4, pp = wq2 * 32 + pf * 16 + (lane & 15);
        *(uint2*)(Ss + sw256(pp, n0)) = uint2{pack2(sacc[nf][pf][0], sacc[nf][pf][1]), pack2(sacc[nf][pf][2], sacc[nf][pf][3])};
      }
    __syncthreads();
    const float cstot = csum[d ? 0 : 127];
#pragma unroll
    for (int i = 0; i < 4; ++i) {
      int idx = tid + i * 512;
      int l = idx >> 4, ch = idx & 15;
      uint4 bv = *(const uint4*)(Bs + l * 256 + ((ch ^ swz16(l)) << 4));
      float f = dts[l] * __expf(cstot - csum[l]);
      unsigned w[4] = {bv.x, bv.y, bv.z, bv.w};
#pragma unroll
      for (int e = 0; e < 8; ++e) {
        int n = ch * 8 + e;
        float val = bf2f((u16)((w[e >> 1] >> ((e & 1) * 16)) & 0xffff)) * f;
        *(u16*)(BdT + sw256(n, l)) = f2bf(val);
      }
    }
    f32x4 gacc[2][4];
#pragma unroll
    for (int i = 0; i < 2; ++i)
#pragma unroll
      for (int j = 0; j < 4; ++j) gacc[i][j] = f32x4{0.f, 0.f, 0.f, 0.f};
#pragma unroll
    for (int ks = 0; ks < 4; ++ks) {
      int ch = ks * 4 + (lane >> 4);
      bf16x8 a[2], bb[4];
#pragma unroll
      for (int sf = 0; sf < 2; ++sf) a[sf] = ldfrag256(Bs, wq4 * 32 + sf * 16 + (lane & 15), ch);
#pragma unroll
      for (int lf = 0; lf < 4; ++lf) bb[lf] = ldfrag256(Cs, wq2 * 64 + lf * 16 + (lane & 15), ch);
#pragma unroll
      for (int sf = 0; sf < 2; ++sf)
#pragma unroll
        for (int lf = 0; lf < 4; ++lf)
          gacc[sf][lf] = __builtin_amdgcn_mfma_f32_16x16x32_bf16(a[sf], bb[lf], gacc[sf][lf], 0, 0, 0);
    }
    {
      float css[2][4], dss[2][4];
#pragma unroll
      for (int sf = 0; sf < 2; ++sf)
#pragma unroll
        for (int j = 0; j < 4; ++j) {
          const int sI = wq4 * 32 + sf * 16 + (lane >> 4) * 4 + j;
          css[sf][j] = csum[sI];
          dss[sf][j] = dts[sI];
        }
#pragma unroll
      for (int lf = 0; lf < 4; ++lf) {
        const int l = wq2 * 64 + lf * 16 + (lane & 15);
        const float csl = csum[l];
#pragma unroll
        for (int sf = 0; sf < 2; ++sf)
#pragma unroll
          for (int j = 0; j < 4; ++j) {
            const int sI = wq4 * 32 + sf * 16 + (lane >> 4) * 4 + j;
            const bool valid = d ? (sI >= l) : (sI <= l);
            const float e = valid ? __expf(csl - css[sf][j]) * dss[sf][j] : 0.f;
            gacc[sf][lf][j] *= e;
          }
      }
    }
    __syncthreads();
#pragma unroll
    for (int sf = 0; sf < 2; ++sf)
#pragma unroll
      for (int lf = 0; lf < 4; ++lf) {
        const int s0 = wq4 * 32 + sf * 16 + (lane >> 4) * 4, l = wq2 * 64 + lf * 16 + (lane & 15);
        *(uint2*)(Bs + sw256(l, s0)) = uint2{pack2(gacc[sf][lf][0], gacc[sf][lf][1]), pack2(gacc[sf][lf][2], gacc[sf][lf][3])};
      }
    __syncthreads();
    {
      f32x4 yacc[2][2];
#pragma unroll
      for (int i = 0; i < 2; ++i)
#pragma unroll
        for (int j = 0; j < 2; ++j) yacc[i][j] = f32x4{0.f, 0.f, 0.f, 0.f};
#pragma unroll
      for (int ks = 0; ks < 4; ++ks) {
        int ch = ks * 4 + (lane >> 4);
        bf16x8 a[2], bb[2];
#pragma unroll
        for (int pf = 0; pf < 2; ++pf) a[pf] = ldfrag256(Ss, wq2 * 32 + pf * 16 + (lane & 15), ch);
#pragma unroll
        for (int lf = 0; lf < 2; ++lf) bb[lf] = ldfrag256(Cs, wq4 * 32 + lf * 16 + (lane & 15), ch);
#pragma unroll
        for (int pf = 0; pf < 2; ++pf)
#pragma unroll
          for (int lf = 0; lf < 2; ++lf)
            yacc[pf][lf] = __builtin_amdgcn_mfma_f32_16x16x32_bf16(a[pf], bb[lf], yacc[pf][lf], 0, 0, 0);
      }
#pragma unroll
      for (int lf = 0; lf < 2; ++lf) {
        const float e = __expf(csum[wq4 * 32 + lf * 16 + (lane & 15)]);
#pragma unroll
        for (int pf = 0; pf < 2; ++pf) yacc[pf][lf] *= e;
      }
#pragma unroll
      for (int ks = 0; ks < 4; ++ks) {
        int ch = ks * 4 + (lane >> 4);
        bf16x8 a[2], bb[2];
#pragma unroll
        for (int pf = 0; pf < 2; ++pf) a[pf] = ldfrag256(XT, wq2 * 32 + pf * 16 + (lane & 15), ch);
#pragma unroll
        for (int lf = 0; lf < 2; ++lf) bb[lf] = ldfrag256(Bs, wq4 * 32 + lf * 16 + (lane & 15), ch);
#pragma unroll
        for (int pf = 0; pf < 2; ++pf)
#pragma unroll
          for (int lf = 0; lf < 2; ++lf)
            yacc[pf][lf] = __builtin_amdgcn_mfma_f32_16x16x32_bf16(a[pf], bb[lf], yacc[pf][lf], 0, 0, 0);
      }
#pragma unroll
      for (int pf = 0; pf < 2; ++pf)
#pragma unroll
        for (int lf = 0; lf < 2; ++lf) {
          const int p0 = wq2 * 32 + pf * 16 + (lane >> 4) * 4, l = wq4 * 32 + lf * 16 + (lane & 15);
          *(uint2*)(yout + (size_t)(tok0 + l) * 2048 + h * 64 + p0) = uint2{pack2(yacc[pf][lf][0], yacc[pf][lf][1]), pack2(yacc[pf][lf][2], yacc[pf][lf][3])};
        }
    }
    {
      float e = __expf(cstot);
#pragma unroll
      for (int nf = 0; nf < 2; ++nf)
#pragma unroll
        for (int pf = 0; pf < 2; ++pf) sacc[nf][pf] *= e;
#pragma unroll
      for (int ks = 0; ks < 4; ++ks) {
        int ch = ks * 4 + (lane >> 4);
        bf16x8 a[2], bb[2];
#pragma unroll
        for (int nf = 0; nf < 2; ++nf) a[nf] = ldfrag256(BdT, wq4 * 32 + nf * 16 + (lane & 15), ch);
#pragma unroll
        for (int pf = 0; pf < 2; ++pf) bb[pf] = ldfrag256(XT, wq2 * 32 + pf * 16 + (lane & 15), ch);
#pragma unroll
        for (int nf = 0; nf < 2; ++nf)
#pragma unroll
          for (int pf = 0; pf < 2; ++pf)
            sacc[nf][pf] = __builtin_amdgcn_mfma_f32_16x16x32_bf16(a[nf], bb[pf], sacc[nf][pf], 0, 0, 0);
      }
    }
    __syncthreads();
  }
  if (g < 2) {
    float* so = p.out + (d ? OUT_SSMB : OUT_SSMF) + (size_t)((g * 16 + b) * 32 + h) * 8192;
    const int wn4 = wave >> 1, wp2 = wave & 1;
#pragma unroll
    for (int nf = 0; nf < 2; ++nf)
#pragma unroll
      for (int pf = 0; pf < 2; ++pf) {
        const int n0 = wn4 * 32 + nf * 16 + (lane >> 4) * 4, pp = wp2 * 32 + pf * 16 + (lane & 15);
        *(float4*)(so + pp * 128 + n0) = float4{sacc[nf][pf][0], sacc[nf][pf][1], sacc[nf][pf][2], sacc[nf][pf][3]};
      }
  }
}


template <bool SEG>
__device__ __forceinline__ void wkv_pair(const Params& p, char* smem, int g, int item) {
  char* ws = p.ws;
  const int tid = get_tid(), lane = tid & 63, wave = tid >> 6;
  const int Ls = SEG ? 2048 : 256;
  const __half* wk = (const __half*)(ws + OFF_WK);
  float* stage = (float*)smem;
  float* ylds = (float*)(smem + 98304);
  const bool cw = true;
  const int slot = wave >> 2, wq = wave & 3;
  const int ig = lane >> 3, jg = lane & 7;
  const int row0 = wq * 16 + ig * 2;
  const int chain = SEG ? (item >> 3) : item * 2 + slot;
  const int seg = SEG ? (item & 7) : 0;
  const bool act = cw && (SEG ? !(slot == 1 && seg == 0) : true);
  const int d = chain & 1, h = (chain >> 1) & 15, b = chain >> 5;
  typedef float f2 __attribute__((ext_vector_type(2)));
  f2 S[2][4];
#pragma unroll
  for (int rr = 0; rr < 2; ++rr) {
    if (SEG) {
      if (slot == 0) {
        if (seg == 0) {
          const float* s0 = (d ? p.wkv_b : p.wkv_f) + ((size_t)(b * 16 + h) * 64 + row0 + rr) * 64 + jg * 8;
#pragma unroll
          for (int c = 0; c < 4; ++c) S[rr][c] = f2{s0[2 * c], s0[2 * c + 1]};
        } else {
#pragma unroll
          for (int c = 0; c < 4; ++c) S[rr][c] = f2{0.f, 0.f};
        }
      } else {
#pragma unroll
        for (int c = 0; c < 4; ++c) S[rr][c] = f2{(row0 + rr == jg * 8 + 2 * c) ? 1.f : 0.f, (row0 + rr == jg * 8 + 2 * c + 1) ? 1.f : 0.f};
      }
    } else {
#pragma unroll
      for (int c = 0; c < 4; ++c) S[rr][c] = f2{0.f, 0.f};
    }
  }
  const int pair = tid >> 4, lslot = pair >> 4, lstep = pair & 15, sub = tid & 15;
  const int lch = SEG ? (item >> 3) : item * 2 + lslot;
  const int ld = lch & 1, lh = (lch >> 1) & 15, lb = lch >> 5;
  const bool ldo = SEG ? (lslot == 0) : true;
  const int sbase = seg * 256;
  const int cslot = SEG ? 0 : slot;
  float ka[4];
#pragma unroll
  for (int e = 0; e < 4; ++e) ka[e] = p.k_a[lh * 64 + sub * 4 + e];
  u16* yout;
  if (SEG) yout = lslot == 0 ? (u16*)(ws + (ld ? OFF_WYB : OFF_WYF)) : (u16*)(ws + OFF_YM) + (ld ? (size_t)TG * 1024 : 0);
  else yout = (u16*)(ws + (ld ? OFF_WYB : OFF_WYF));
  const bool ywr = SEG ? (lslot == 0 || seg > 0) : true;
  uint2 rg[6];
  auto prefetch = [&](int tb) {
    int s = sbase + tb * 16 + lstep;
    int pos = ld ? Ls - 1 - s : s;
    int r = lb * Ls + pos;
    const __half* rec = wk + ((size_t)(r * 16 + lh) * 8) * 64 + sub * 4;
    rg[0] = *(const uint2*)(rec + 0 * 64);
    rg[1] = *(const uint2*)(rec + 1 * 64);
    rg[2] = *(const uint2*)(rec + 2 * 64);
    rg[3] = *(const uint2*)(rec + 3 * 64);
    rg[4] = *(const uint2*)(rec + (4 + 2 * ld) * 64);
    rg[5] = *(const uint2*)(rec + (5 + 2 * ld) * 64);
  };
  auto unpack4 = [&](uint2 u, float (&o)[4]) {
    __half2 h0 = *reinterpret_cast<__half2*>(&u.x);
    __half2 h1 = *reinterpret_cast<__half2*>(&u.y);
    float2 f0 = __half22float2(h0), f1 = __half22float2(h1);
    o[0] = f0.x; o[1] = f0.y; o[2] = f1.x; o[3] = f1.y;
  };
  auto stage_store = [&](int buf) {
    float r_[4], v_[4], k_[4], nkk_[4], w_[4], a_[4];
    unpack4(rg[0], r_); unpack4(rg[1], v_); unpack4(rg[2], k_); unpack4(rg[3], nkk_); unpack4(rg[4], w_); unpack4(rg[5], a_);
    float b_[4], kd_[4];
#pragma unroll
    for (int e = 0; e < 4; ++e) {
      b_[e] = -nkk_[e] * a_[e];
      kd_[e] = k_[e] * (1.f + (a_[e] - 1.f) * ka[e]);
    }
    float* dst = stage + ((size_t)((buf * 2 + lslot) * 16 + lstep) * 6) * 64 + sub * 4;
    *(float4*)(dst + 0 * 64) = float4{nkk_[0], nkk_[1], nkk_[2], nkk_[3]};
    *(float4*)(dst + 1 * 64) = float4{w_[0], w_[1], w_[2], w_[3]};
    *(float4*)(dst + 2 * 64) = float4{b_[0], b_[1], b_[2], b_[3]};
    *(float4*)(dst + 3 * 64) = float4{kd_[0], kd_[1], kd_[2], kd_[3]};
    *(float4*)(dst + 4 * 64) = float4{r_[0], r_[1], r_[2], r_[3]};
    *(float4*)(dst + 5 * 64) = float4{v_[0], v_[1], v_[2], v_[3]};
  };
  if (ldo) { prefetch(0); stage_store(0); }
  __syncthreads();
  for (int tb = 0; tb < 16; ++tb) {
    const bool more = tb + 1 < 16;
    if (more && ldo) prefetch(tb + 1);
    if (act) {
      const float* sb = stage + ((size_t)(((tb & 1) * 2 + cslot) * 16) * 6) * 64;
      for (int sg = 0; sg < 8; ++sg) {
        float ysv[2][2];
#pragma unroll
        for (int s4 = 0; s4 < 2; ++s4) {
          const int st = sg * 2 + s4;
          const float* v6 = sb + st * 384 + jg * 8;
          f2 nkk[4], w[4], bb[4], kd[4], rr[4];
#pragma unroll
          for (int q = 0; q < 2; ++q) {
            float4 t0 = *(const float4*)(v6 + 0 * 64 + q * 4);
            nkk[q * 2] = f2{t0.x, t0.y}; nkk[q * 2 + 1] = f2{t0.z, t0.w};
            float4 t1 = *(const float4*)(v6 + 1 * 64 + q * 4);
            w[q * 2] = f2{t1.x, t1.y}; w[q * 2 + 1] = f2{t1.z, t1.w};
            float4 t2 = *(const float4*)(v6 + 2 * 64 + q * 4);
            bb[q * 2] = f2{t2.x, t2.y}; bb[q * 2 + 1] = f2{t2.z, t2.w};
            float4 t3 = *(const float4*)(v6 + 3 * 64 + q * 4);
            kd[q * 2] = f2{t3.x, t3.y}; kd[q * 2 + 1] = f2{t3.z, t3.w};
            float4 t4 = *(const float4*)(v6 + 4 * 64 + q * 4);
            rr[q * 2] = f2{t4.x, t4.y}; rr[q * 2 + 1] = f2{t4.z, t4.w};
          }
          float2 vv2 = *(const float2*)(sb + st * 384 + 5 * 64 + row0);
          float vi[2] = {vv2.x, vv2.y};
          if (SEG && slot == 1) { vi[0] = 0.f; vi[1] = 0.f; }
#pragma unroll
          for (int r2 = 0; r2 < 2; ++r2) {
            f2 sa2a = S[r2][0] * nkk[0], sa2b = S[r2][1] * nkk[1];
            sa2a += S[r2][2] * nkk[2]; sa2b += S[r2][3] * nkk[3];
            f2 sat = sa2a + sa2b;
            float sa = sat.x + sat.y;
            sa += dpp_xor1(sa);
            sa += dpp_xor2(sa);
            sa += dpp_hmirror(sa);
            f2 y2a, y2b;
            {
              f2 t0 = S[r2][0] * w[0] + vi[r2] * kd[0]; S[r2][0] = t0 + sa * bb[0]; y2a = S[r2][0] * rr[0];
              f2 t1 = S[r2][1] * w[1] + vi[r2] * kd[1]; S[r2][1] = t1 + sa * bb[1]; y2b = S[r2][1] * rr[1];
              f2 t2 = S[r2][2] * w[2] + vi[r2] * kd[2]; S[r2][2] = t2 + sa * bb[2]; y2a += S[r2][2] * rr[2];
              f2 t3 = S[r2][3] * w[3] + vi[r2] * kd[3]; S[r2][3] = t3 + sa * bb[3]; y2b += S[r2][3] * rr[3];
            }
            f2 yt = y2a + y2b;
            float y = yt.x + yt.y;
            y += dpp_xor1(y);
            y += dpp_xor2(y);
            y += dpp_hmirror(y);
            ysv[s4][r2] = y;
          }
        }
        if (jg == 0) {
#pragma unroll
          for (int s4 = 0; s4 < 2; ++s4)
            *(float2*)(ylds + (slot * 16 + sg * 2 + s4) * 64 + row0) = float2{ysv[s4][0], ysv[s4][1]};
        }
      }
    }
    __syncthreads();
    if (more && ldo) stage_store((tb + 1) & 1);
    if (ywr) {
      int s = sbase + tb * 16 + lstep;
      int pos = ld ? Ls - 1 - s : s;
      int r = lb * Ls + pos;
      float4 yv = *(const float4*)(ylds + (lslot * 16 + lstep) * 64 + sub * 4);
      *(uint2*)(yout + (size_t)r * 1024 + lh * 64 + sub * 4) = uint2{pack2(yv.x, yv.y), pack2(yv.z, yv.w)};
    }
    __syncthreads();
  }
  if (act) {
#pragma unroll
    for (int r2 = 0; r2 < 2; ++r2) {
      float* so;
      if (SEG) so = p.out + 8388608 + ((size_t)((chain * 8 + seg) * 2 + slot)) * 4096 + (row0 + r2) * 64 + jg * 8;
      else so = p.out + (d ? OUT_WKVB : OUT_WKVF) + ((size_t)((g * 16 + b) * 16 + h) * 64 + row0 + r2) * 64 + jg * 8;
#pragma unroll
      for (int c = 0; c < 4; ++c) { so[2 * c] = S[r2][c].x; so[2 * c + 1] = S[r2][c].y; }
    }
  }
}

__device__ __forceinline__ void wkv_fix(const Params& p, char* smem, int item) {
  const int chain = item >> 2, qt = item & 3;
  char* ws = p.ws;
  const int tid = get_tid(), lane = tid & 63, wave = tid >> 6;
  const int d = chain & 1, h = (chain >> 1) & 15, b = chain >> 5;
  const float* SE = p.out + 8388608;
  u16* yout = (u16*)(ws + (d ? OFF_WYB : OFF_WYF));
  const u16* Q = (const u16*)(ws + OFF_YM) + (d ? (size_t)TG * 1024 : 0);
  float* Pl = (float*)smem;
  float* Sl = (float*)(smem + 16384);
  u16* Ql = (u16*)(smem + 36864);
  const int i = lane;
  float S0[64];
  {
    const float* src = SE + ((size_t)(chain * 8) * 2) * 4096 + i * 64;
#pragma unroll
    for (int j = 0; j < 16; ++j) {
      float4 t = *(const float4*)(src + j * 4);
      S0[j * 4] = t.x; S0[j * 4 + 1] = t.y; S0[j * 4 + 2] = t.z; S0[j * 4 + 3] = t.w;
    }
  }
  for (int k = 1; k < 8; ++k) {
    {
      int tt = qt * 64 + (tid >> 3), ch = tid & 7;
      int s = k * 256 + tt;
      int pos = d ? 2047 - s : s;
      int r = b * 2048 + pos;
      *(uint4*)(Ql + tt * 64 + ch * 8) = *(const uint4*)(Q + (size_t)r * 1024 + h * 64 + ch * 8);
    }
    if (k < 7) {
      const float* src = SE + ((size_t)((chain * 8 + k) * 2 + 1)) * 4096;
#pragma unroll
      for (int e = 0; e < 2; ++e) ((float4*)Pl)[tid + e * 512] = ((const float4*)src)[tid + e * 512];
    }
    __syncthreads();
    for (int n = 0; n < 8; ++n) {
      int tt = qt * 64 + wave + n * 8;
      float a0 = 0.f, a1 = 0.f;
#pragma unroll
      for (int jc = 0; jc < 8; ++jc) {
        float q[8];
        unpack8(*(const uint4*)(Ql + tt * 64 + jc * 8), q);
#pragma unroll
        for (int e = 0; e < 8; e += 2) { a0 += S0[jc * 8 + e] * q[e]; a1 += S0[jc * 8 + e + 1] * q[e + 1]; }
      }
      int s = k * 256 + tt;
      int pos = d ? 2047 - s : s;
      size_t off = (size_t)(b * 2048 + pos) * 1024 + h * 64 + i;
      yout[off] = f2bf(bf2f(yout[off]) + (a0 + a1));
    }
    if (k < 7) {
      float nv[8];
      const float* sl = SE + ((size_t)((chain * 8 + k) * 2)) * 4096 + i * 64 + wave * 8;
      {
        float4 t0 = *(const float4*)sl, t1 = *(const float4*)(sl + 4);
        nv[0] = t0.x; nv[1] = t0.y; nv[2] = t0.z; nv[3] = t0.w; nv[4] = t1.x; nv[5] = t1.y; nv[6] = t1.z; nv[7] = t1.w;
      }
#pragma unroll
      for (int m = 0; m < 64; ++m) {
        float4 p0 = *(const float4*)(Pl + m * 64 + wave * 8), p1 = *(const float4*)(Pl + m * 64 + wave * 8 + 4);
        nv[0] += S0[m] * p0.x; nv[1] += S0[m] * p0.y; nv[2] += S0[m] * p0.z; nv[3] += S0[m] * p0.w;
        nv[4] += S0[m] * p1.x; nv[5] += S0[m] * p1.y; nv[6] += S0[m] * p1.z; nv[7] += S0[m] * p1.w;
      }
      *(float4*)(Sl + i * 68 + wave * 8) = float4{nv[0], nv[1], nv[2], nv[3]};
      *(float4*)(Sl + i * 68 + wave * 8 + 4) = float4{nv[4], nv[5], nv[6], nv[7]};
      __syncthreads();
#pragma unroll
      for (int j = 0; j < 16; ++j) {
        float4 t = *(const float4*)(Sl + i * 68 + j * 4);
        S0[j * 4] = t.x; S0[j * 4 + 1] = t.y; S0[j * 4 + 2] = t.z; S0[j * 4 + 3] = t.w;
      }
    }
    __syncthreads();
  }
}

__device__ __forceinline__ void step_scan(const Params& p, char* smem, int g) {
  const int G = gridDim.x;
  const int r1 = (RM & (1 << 20)) ? 2 : 1, r2 = (RM & (1 << 21)) ? 2 : 1;
  if (g < 2) {
    for (int rr = 0; rr < r1; ++rr) {
      SsdPre R;
      if ((int)blockIdx.x < 1024) ssd_issue(p, g, blockIdx.x, 0, get_tid(), R);
      for (int ch = blockIdx.x; ch < 1024; ch += G) ssd_chain(p, smem, g, ch, ch + G < 1024 ? ch + G : -1, R);
    }
    for (int rr = 0; rr < r2; ++rr) for (int it = blockIdx.x; it < 256; it += G) wkv_pair<false>(p, smem, g, it);
  } else {
    for (int rr = 0; rr < r1; ++rr) {
      SsdPre R;
      if ((int)blockIdx.x < 128) ssd_issue(p, g, blockIdx.x, 0, get_tid(), R);
      for (int ch = blockIdx.x; ch < 128; ch += G) ssd_chain(p, smem, g, ch, ch + G < 128 ? ch + G : -1, R);
    }
    for (int rr = 0; rr < r2; ++rr) for (int it = (G - 1 - blockIdx.x); it < 512; it += G) wkv_pair<true>(p, smem, g, it);
  }
}
__device__ __forceinline__ void step_fix(const Params& p, char* smem) {
  for (int it = blockIdx.x; it < 256; it += gridDim.x) wkv_fix(p, smem, it);
}

__device__ __forceinline__ void step_fin(const Params& p, int g) {
  char* ws = p.ws;
  const int tid = get_tid(), lane = tid & 63, wave = tid >> 6;
  const int gw = blockIdx.x * 8 + wave, nw = gridDim.x * 8;
  {
    const u16* yf = (const u16*)(ws + OFF_SYF);
    const u16* yb = (const u16*)(ws + OFF_SYB);
    const u16* xbc = (const u16*)(ws + OFF_XBC);
    const u16* zb = (const u16*)(ws + OFF_Z);
    u16* ym = (u16*)(ws + OFF_YM);
    for (int it = gw; it < TG * 4; it += nw) {
      int r = it >> 2, gq = it & 3;
      int ch = gq * 512 + lane * 8;
      uint4 a = *(const uint4*)(yf + (size_t)r * 2048 + ch);
      uint4 b = *(const uint4*)(yb + (size_t)r * 2048 + ch);
      uint4 x = *(const uint4*)(xbc + (size_t)r * 3072 + ch);
      uint4 z = *(const uint4*)(zb + (size_t)r * 2048 + ch);
      float dsk = p.d_skip[ch >> 6];
      unsigned aw[4] = {a.x, a.y, a.z, a.w}, bw[4] = {b.x, b.y, b.z, b.w}, xw[4] = {x.x, x.y, x.z, x.w}, zw[4] = {z.x, z.y, z.z, z.w};
      float y[8];
      float ss = 0.f;
#pragma unroll
      for (int e = 0; e < 8; ++e) {
        int sh = (e & 1) * 16;
        float yy = bf2f((u16)(aw[e >> 1] >> sh)) + bf2f((u16)(bw[e >> 1] >> sh)) + dsk * bf2f((u16)(xw[e >> 1] >> sh));
        yy *= siluf(bf2f((u16)(zw[e >> 1] >> sh)));
        y[e] = yy;
        ss += yy * yy;
      }
      ss = wave_sum(ss);
      float rinv = rsqrtf(ss * (1.f / 512.f) + 1e-5f);
      float4 w0 = *(const float4*)(p.m_norm_w + ch), w1 = *(const float4*)(p.m_norm_w + ch + 4);
      *(uint4*)(ym + (size_t)r * 2048 + ch) =
          uint4{pack2(y[0] * rinv * w0.x, y[1] * rinv * w0.y), pack2(y[2] * rinv * w0.z, y[3] * rinv * w0.w),
                pack2(y[4] * rinv * w1.x, y[5] * rinv * w1.y), pack2(y[6] * rinv * w1.z, y[7] * rinv * w1.w)};
    }
  }
  {
    const u16* __restrict__ yf = (const u16*)(ws + OFF_WYF);
    const u16* __restrict__ yb = (const u16*)(ws + OFF_WYB);
    const __half* __restrict__ wk = (const __half*)(ws + OFF_WK);
    const u16* __restrict__ gr = (const u16*)(ws + OFF_GR);
    u16* __restrict__ yr = (u16*)(ws + OFF_YR);
    for (int it = gw; it < TG * 2; it += nw) {
      const int r = it >> 1, hh = it & 1;
      const int c0 = hh * 512 + lane * 8;
      const int head = c0 >> 6;
      const uint4 a = *(const uint4*)(yf + (size_t)r * 1024 + c0);
      const uint4 b = *(const uint4*)(yb + (size_t)r * 1024 + c0);
      const uint4 gq = *(const uint4*)(gr + (size_t)r * 1024 + c0);
      const __half* rec = wk + ((size_t)(r * 16 + head) * 8) * 64 + (lane & 7) * 8;
      const uint4 qr = *(const uint4*)(rec + 0 * 64), qv = *(const uint4*)(rec + 1 * 64), qk = *(const uint4*)(rec + 2 * 64);
      const uint4 qaf = *(const uint4*)(rec + 5 * 64), qab = *(const uint4*)(rec + 7 * 64);
      const float4 lw0 = *(const float4*)(p.lnx_w + c0), lw1 = *(const float4*)(p.lnx_w + c0 + 4);
      const float4 lb0 = *(const float4*)(p.lnx_b + c0), lb1 = *(const float4*)(p.lnx_b + c0 + 4);
      const float4 ka0 = *(const float4*)(p.k_a + c0), ka1 = *(const float4*)(p.k_a + c0 + 4);
      const float4 rk0 = *(const float4*)(p.r_k + c0), rk1 = *(const float4*)(p.r_k + c0 + 4);
      const float lw[8] = {lw0.x, lw0.y, lw0.z, lw0.w, lw1.x, lw1.y, lw1.z, lw1.w};
      const float lb[8] = {lb0.x, lb0.y, lb0.z, lb0.w, lb1.x, lb1.y, lb1.z, lb1.w};
      const float kav[8] = {ka0.x, ka0.y, ka0.z, ka0.w, ka1.x, ka1.y, ka1.z, ka1.w};
      const float rkv[8] = {rk0.x, rk0.y, rk0.z, rk0.w, rk1.x, rk1.y, rk1.z, rk1.w};
      float ya[8], yb8[8], gg[8];
      unpack8(a, ya); unpack8(b, yb8); unpack8(gq, gg);
      auto unph = [&](const uint4& u, float (&o)[8]) {
        const __half2* hp = reinterpret_cast<const __half2*>(&u);
#pragma unroll
        for (int e = 0; e < 4; ++e) { float2 f = __half22float2(hp[e]); o[2 * e] = f.x; o[2 * e + 1] = f.y; }
      };
      float rr[8], vv[8], kk[8], af[8], ab[8];
      unph(qr, rr); unph(qv, vv); unph(qk, kk); unph(qaf, af); unph(qab, ab);
      float y[8];
      float s1 = 0.f;
#pragma unroll
      for (int e = 0; e < 8; ++e) { y[e] = ya[e] + yb8[e]; s1 += y[e]; }
      s1 += dpp_xor1(s1); s1 += dpp_xor2(s1); s1 += dpp_hmirror(s1);
      const float mean = s1 * (1.f / 64.f);
      float s2 = 0.f, s3 = 0.f;
#pragma unroll
      for (int e = 0; e < 8; ++e) {
        const float dy = y[e] - mean;
        s2 += dy * dy;
        const float kmean = kk[e] * (1.f + (0.5f * (af[e] + ab[e]) - 1.f) * kav[e]);
        s3 += rr[e] * kmean * rkv[e];
      }
      s2 += dpp_xor1(s2); s2 += dpp_xor2(s2); s2 += dpp_hmirror(s2);
      s3 += dpp_xor1(s3); s3 += dpp_xor2(s3); s3 += dpp_hmirror(s3);
      const float rs = rsqrtf(s2 * (1.f / 64.f) + 64e-5f);
      float o[8];
#pragma unroll
      for (int e = 0; e < 8; ++e) o[e] = ((y[e] - mean) * rs * lw[e] + lb[e] + s3 * vv[e]) * gg[e];
      *(uint4*)(yr + (size_t)r * 1024 + c0) = uint4{pack2(o[0], o[1]), pack2(o[2], o[3]), pack2(o[4], o[5]), pack2(o[6], o[7])};
    }
  }
}

__device__ __forceinline__ void step_outproj(const Params& p, char* smem, int g) {
  char* ws = p.ws;
  const int sub = blockIdx.x >> 6, vb = blockIdx.x & 63;
  if (sub < 3) {
    const u16* A = sub == 2 ? (const u16*)(ws + OFF_YR) : (const u16*)(ws + OFF_YM) + sub * 1024;
    const u16* B = sub == 2 ? (const u16*)(ws + OFF_WROUT) : (const u16*)(ws + OFF_WMOUT) + sub * 1024;
    EpiOutV E{(const u16*)(ws + OFF_GATE), (u16*)(ws + OFF_XBC) + (size_t)sub * TG * 1024, sub == 2 ? 1024 : 0};
    run_gemm8(smem, A, B, TG, 1024, 1024, E, vb, 64, 0, sub == 2 ? 1024 : 2048);
  }
}
__device__ __forceinline__ void step_sum(const Params& p, int g) {
  const u16* __restrict__ V = (const u16*)(p.ws + OFF_XBC);
  u16* __restrict__ U = (u16*)p.out + (size_t)g * TG * 1024;
  const int tid = get_tid();
  for (int i = blockIdx.x * NTHR + tid; i < TG * 128; i += gridDim.x * NTHR) {
    float a[8], b[8], c[8];
    unpack8(*(const uint4*)(V + (size_t)i * 8), a);
    unpack8(*(const uint4*)(V + (size_t)TG * 1024 + (size_t)i * 8), b);
    unpack8(*(const uint4*)(V + (size_t)2 * TG * 1024 + (size_t)i * 8), c);
    *(uint4*)(U + (size_t)i * 8) = uint4{pack2(a[0] + b[0] + c[0], a[1] + b[1] + c[1]), pack2(a[2] + b[2] + c[2], a[3] + b[3] + c[3]),
                                         pack2(a[4] + b[4] + c[4], a[5] + b[5] + c[5]), pack2(a[6] + b[6] + c[6], a[7] + b[7] + c[7])};
  }
}

__device__ __forceinline__ void step_wo(const Params& p, char* smem, int g) {
  char* ws = p.ws;
  EpiWo E{p.x_prompt, p.x_sample, (const float*)(ws + OFF_MOD), (float*)(ws + OFF_X1), 0};
  run_gemm8(smem, (const u16*)p.out, (const u16*)(ws + OFF_WO), NTOK, 1024, 1024, E);
}

__device__ __forceinline__ void step_gu(const Params& p, char* smem) {
  char* ws = p.ws;
  EpiGU E{(u16*)(ws + OFF_ACT)};
  run_gemm8(smem, (const u16*)(ws + OFF_H2), (const u16*)(ws + OFF_WGU), NTOK, 5632, 1024, E);
}

__device__ __forceinline__ void step_down(const Params& p, char* smem) {
  char* ws = p.ws;
  EpiDown E{(const float*)(ws + OFF_MOD), (float*)(ws + OFF_X1)};
  run_gemm8(smem, (const u16*)(ws + OFF_ACT), (const u16*)(ws + OFF_WDOWN), NTOK, 1024, 2816, E, -1, 0, 1);
}

__device__ __forceinline__ void step_final(const Params& p) {
  const int tid = get_tid(), lane = tid & 63, wave = tid >> 6;
  for (int r = blockIdx.x * 8 + wave; r < NTOK; r += gridDim.x * 8) {
    const float* xr = (const float*)(p.ws + OFF_X1) + (size_t)r * 1024;
    float* xo = p.out + (size_t)r * 1024;
    float4 v[4];
    float ss = 0.f;
#pragma unroll
    for (int i = 0; i < 4; ++i) {
      v[i] = ((const float4*)xr)[i * 64 + lane];
      ss += v[i].x * v[i].x + v[i].y * v[i].y + v[i].z * v[i].z + v[i].w * v[i].w;
    }
    ss = wave_sum(ss);
    float rinv = rsqrtf(ss * (1.f / 1024.f) + 1e-6f);
#pragma unroll
    for (int i = 0; i < 4; ++i) {
      float4 w4 = ((const float4*)p.final_norm_w)[i * 64 + lane];
      ((float4*)xo)[i * 64 + lane] = float4{v[i].x * rinv * w4.x, v[i].y * rinv * w4.y, v[i].z * rinv * w4.z, v[i].w * rinv * w4.w};
    }
  }
}

constexpr int NSTEPS = 33;

__global__ void __launch_bounds__(NTHR) mega(Params p_arg) {
  const int step_lo = p_arg.step_lo, step_hi = p_arg.step_hi;
  __shared__ __attribute__((aligned(16))) char smem[SMEM_BYTES];
#if !MULTI_LAUNCH
  if (threadIdx.x == 0) *(uint4*)(smem + SMEM_BYTES - 16) = uint4{0u, 0u, 0u, 0u};
  __syncthreads();
  XcdBarrier xb = xcd_barrier_post((unsigned*)(p_arg.ws + OFF_BAR), (volatile LAS unsigned*)(smem + SMEM_BYTES - 16));
#endif
  for (int step = step_lo; step <= step_hi; ++step) {
#if defined(__HIP_DEVICE_COMPILE__)
    const __attribute__((address_space(4))) Params* pp = (const __attribute__((address_space(4))) Params*)__builtin_amdgcn_kernarg_segment_ptr();
    asm volatile("" : "+s"(pp));
    const Params p = *pp;
#else
    const Params p = p_arg;
#endif
    const int g = (step - 1) / 9, s = (step - 1) - g * 9;
    const int scode = step == 0 ? 0 : (step <= 27 ? 1 + s : step - 18);
    if (scode == 6 && g < 2) continue;
    if (scode == 1 && g > 0) continue;
    if (scode == 9 && g < 2) continue;
    const int reps = ((RM >> scode) & 1) ? 2 : 1;
    for (int rep = 0; rep < reps; ++rep) {
      if (!((SM >> scode) & 1)) continue;
      switch (scode) {
        case 0: step_prep(p, smem); break;
        case 1: step_norm<0>(p, g); break;
        case 2: step_gemm1(p, smem, 0); if (g > 0) step_sum(p, g - 1); break;
        case 3: step_cr1(p, g); break;
        case 4: step_r2(p, smem); break;
        case 5: step_scan(p, smem, g); break;
        case 6: step_fix(p, smem); break;
        case 7: step_fin(p, g); if (g < 2) step_norm<0>(p, g + 1); break;
        case 8:
          step_outproj(p, smem, g);
          if (g == 0 && blockIdx.x >= 192) {
            convT<1>(p.w_gu, 1024, 5632, (u16*)(p.ws + OFF_WGU), smem, blockIdx.x - 192, gridDim.x - 192);
            convT<2>(p.w_down, 2816, 1024, (u16*)(p.ws + OFF_WDOWN), smem, blockIdx.x - 192, gridDim.x - 192);
          }
          break;
        case 9: step_sum(p, g); break;
        case 10: step_wo(p, smem, 0); break;
        case 11: step_norm<1>(p, 0); break;
        case 12: step_gu(p, smem); break;
        case 13: if (reps == 2 && rep == 0) { Params q = p; q.out = (float*)(p.ws + (size_t)150000000); step_down(q, smem); } else step_down(p, smem); break;
        default: step_final(p); break;
      }
    }
    if (step < step_hi) {
#if !MULTI_LAUNCH
      if (step_hi > 100000) cg::this_grid().sync();
      for (int xs = 0; xs < 1 + XSYNC; ++xs) xcd_barrier(xb);
#endif
    }
  }
}

extern "C" void kernel_launch(void* const* d_in, const int* in_sizes, int n_in, void* d_out, int out_size,
                              void* d_ws, size_t ws_size, hipStream_t stream) {
  Params p{};
  const float** pp = (const float**)&p;
  for (int i = 0; i < 36; ++i) pp[i] = (const float*)d_in[i];
  p.out = (float*)d_out;
  p.ws = (char*)d_ws;
  if (ws_size < WS_NEED) fprintf(stderr, "workspace too small: %zu < %zu\n", ws_size, (size_t)WS_NEED);
#if MULTI_LAUNCH
  for (int s = 0; s < NSTEPS; ++s) {
    p.step_lo = s;
    p.step_hi = s;
    hipLaunchKernelGGL(mega, dim3(256), dim3(NTHR), 0, stream, p);
  }
#else
  static int grid_blocks = 0;
  if (!grid_blocks) {
    int dev = 0, cus = 0, per_cu = 0;
    hipGetDevice(&dev);
    hipDeviceGetAttribute(&cus, hipDeviceAttributeMultiprocessorCount, dev);
    hipOccupancyMaxActiveBlocksPerMultiprocessor(&per_cu, mega, NTHR, 0);
    if (per_cu < 1) per_cu = 1;
    if (per_cu > 1) per_cu = 1;
    grid_blocks = cus * per_cu;
  }
  p.step_lo = 0;
  p.step_hi = NSTEPS - 1;
  void* args[] = {&p};
  hipMemsetAsync((char*)d_ws + OFF_BAR, 0, XCD_BAR_WORDS_C * 4, stream);
  hipError_t e = hipLaunchCooperativeKernel((void*)mega, dim3(grid_blocks), dim3(NTHR), args, 0, stream);
  if (e != hipSuccess) fprintf(stderr, "cooperative launch failed: %s (grid %d)\n", hipGetErrorString(e), grid_blocks);
#endif
}
```

```cpp
#include <hip/hip_runtime.h>
#include <hip/hip_cooperative_groups.h>
#include <hip/hip_fp16.h>
#include <cstdio>
#include <cstdint>
namespace cg = cooperative_groups;

#ifndef MULTI_LAUNCH
#define MULTI_LAUNCH 0
#endif

#define DI __device__ __forceinline__
typedef __attribute__((ext_vector_type(8))) short bf16x8;
typedef __attribute__((ext_vector_type(4))) float f32x4;
typedef unsigned short u16;

#ifndef STEP_MASK
#define STEP_MASK 0xffffff
#endif
constexpr int SM = STEP_MASK;
#ifndef REPEAT_MASK
#define REPEAT_MASK 0
#endif
#ifndef XSYNC
#define XSYNC 0
#endif
constexpr int RM = REPEAT_MASK;
constexpr int TG = 4096;
constexpr int NTOK = 12288;
constexpr int NPAD = 10752;
constexpr int NTHR = 512;
constexpr int SMEM_BYTES = 133120;
constexpr int XCD_BAR_WORDS_C = 3456;

constexpr size_t OFF_WIN = 0;
constexpr size_t OFF_WGU = OFF_WIN + (size_t)NPAD * 1024 * 2;
constexpr size_t OFF_WDOWN = OFF_WGU + (size_t)5632 * 1024 * 2;
constexpr size_t OFF_WMOUT = OFF_WDOWN + (size_t)1024 * 2816 * 2;
constexpr size_t OFF_WROUT = OFF_WMOUT + (size_t)1024 * 2048 * 2;
constexpr size_t OFF_WO = OFF_WROUT + (size_t)1024 * 1024 * 2;
constexpr size_t OFF_W2T = OFF_WO + (size_t)1024 * 1024 * 2;
constexpr size_t OFF_A2T = OFF_W2T + 262144;
constexpr size_t OFF_G2T = OFF_A2T + 262144;
constexpr size_t OFF_MOD = OFF_G2T + 262144;
constexpr size_t OFF_GRP = OFF_MOD + 73728;
constexpr size_t OFF_Z = OFF_GRP;
constexpr size_t OFF_GATE = OFF_Z + (size_t)TG * 2048 * 2;
constexpr size_t OFF_XBC = OFF_GATE + (size_t)TG * 2048 * 2;
constexpr size_t OFF_WK = OFF_XBC + (size_t)TG * 3072 * 2;
constexpr size_t OFF_GR = OFF_WK + (size_t)TG * 16 * 1024;
constexpr size_t OFF_DT = OFF_GR + (size_t)TG * 1024 * 2;
constexpr size_t OFF_TL = OFF_DT + (size_t)TG * 64 * 4;
constexpr size_t OFF_SG = OFF_TL + (size_t)TG * 256 * 2;
constexpr size_t OFF_R = OFF_SG + (size_t)TG * 128 * 2;
constexpr size_t OFF_H1 = OFF_R;
constexpr size_t OFF_XBCRAW = OFF_H1 + (size_t)TG * 1024 * 2;
constexpr size_t OFF_RW = OFF_XBCRAW + (size_t)TG * 3072 * 2;
constexpr size_t OFF_SYF = OFF_R;
constexpr size_t OFF_SYB = OFF_SYF + (size_t)TG * 2048 * 2;
constexpr size_t OFF_WYF = OFF_SYB + (size_t)TG * 2048 * 2;
constexpr size_t OFF_WYB = OFF_WYF + (size_t)TG * 1024 * 2;
constexpr size_t OFF_YM = OFF_WYB + (size_t)TG * 1024 * 2;
constexpr size_t OFF_YR = OFF_YM + (size_t)TG * 2048 * 2;
constexpr size_t OFF_END = OFF_YR + (size_t)TG * 1024 * 2;
constexpr size_t OFF_BAR = OFF_END;
constexpr size_t OFF_W4T = OFF_BAR + 16384;
constexpr size_t WS_NEED = OFF_W4T + (size_t)4096 * 256 * 2;
constexpr size_t OFF_U = OFF_XBC;
constexpr size_t OFF_H2 = OFF_GRP;
constexpr size_t OFF_ACT = OFF_H2 + (size_t)NTOK * 1024 * 2;
constexpr size_t H1_OUT_OFF = 25165824;
constexpr size_t OFF_X1 = OFF_ACT + (size_t)NTOK * 2816 * 2;

constexpr size_t OUT_SSMF = 12582912;
constexpr size_t OUT_SSMB = OUT_SSMF + 8388608;
constexpr size_t OUT_WKVF = OUT_SSMB + 8388608;
constexpr size_t OUT_WKVB = OUT_WKVF + 2097152;

struct Params {
  const float *x_prompt, *x_sample, *ssm_f, *ssm_b, *wkv_f, *wkv_b, *c, *c_ctx, *norm1_w, *norm2_w,
      *w_ada, *b_ada, *w_in, *conv_w, *conv_b, *dt_bias, *a_log, *d_skip, *m_norm_w, *mu_shift, *w0,
      *w2, *a0, *a2, *g2, *k_k, *k_a, *r_k, *lnx_w, *lnx_b, *w_m_out, *w_r_out, *w_o, *w_gu, *w_down,
      *final_norm_w;
  float* out;
  char* ws;
  int step_lo, step_hi;
};

DI int get_tid() {
  int t = threadIdx.x;
  asm volatile("" : "+v"(t));
  return t;
}
DI u16 f2bf(float f) {
  unsigned u = __float_as_uint(f);
  u += 0x7fffu + ((u >> 16) & 1u);
  return (u16)(u >> 16);
}
DI float bf2f(u16 h) { return __uint_as_float(((unsigned)h) << 16); }
DI float siluf(float x) { return x / (1.f + __expf(-x)); }
DI float sigm(float x) { return 1.f / (1.f + __expf(-x)); }
DI float wave_sum(float v) {
  v += __int_as_float(__builtin_amdgcn_update_dpp(0, __float_as_int(v), 0xB1, 0xF, 0xF, true));
  v += __int_as_float(__builtin_amdgcn_update_dpp(0, __float_as_int(v), 0x4E, 0xF, 0xF, true));
  v += __int_as_float(__builtin_amdgcn_update_dpp(0, __float_as_int(v), 0x141, 0xF, 0xF, true));
  v += __int_as_float(__builtin_amdgcn_update_dpp(0, __float_as_int(v), 0x140, 0xF, 0xF, true));
  const int vi = __float_as_int(v);
  float a = __int_as_float(__builtin_amdgcn_readlane(vi, 0)), b = __int_as_float(__builtin_amdgcn_readlane(vi, 16));
  float c = __int_as_float(__builtin_amdgcn_readlane(vi, 32)), d = __int_as_float(__builtin_amdgcn_readlane(vi, 48));
  return (a + b) + (c + d);
}
DI float dpp_xor1(float v) { return __int_as_float(__builtin_amdgcn_update_dpp(0, __float_as_int(v), 0xB1, 0xF, 0xF, true)); }
DI float dpp_hmirror(float v) { return __int_as_float(__builtin_amdgcn_update_dpp(0, __float_as_int(v), 0x141, 0xF, 0xF, true)); }
DI float dpp_xor2(float v) { return __int_as_float(__builtin_amdgcn_update_dpp(0, __float_as_int(v), 0x4E, 0xF, 0xF, true)); }
DI unsigned pack2(float a, float b) { return (unsigned)f2bf(a) | ((unsigned)f2bf(b) << 16); }
DI int mrow_of(int tok) { return tok < 8192 ? 0 : 1 + ((tok - 8192) >> 11); }


#define XB_TMO      128
#define XB_XCNT(j)  (256  + 64 * (j))
#define XB_XSUB(j)  (1280 + 64 * (j))
#define XB_XGEN(j)  (2304 + 64 * (j))
#define XB_TOP      3328
#define XB_TOPGEN   3392
#define XCD_BAR_WORDS 3456
#define XB_SPIN_CAP (1u << 22)
#define LAS __attribute__((address_space(3)))
DI unsigned xb_ld(unsigned* p) { return __hip_atomic_load(p, __ATOMIC_RELAXED, __HIP_MEMORY_SCOPE_AGENT); }
DI unsigned xb_add(unsigned* p, unsigned v) { return __hip_atomic_fetch_add(p, v, __ATOMIC_RELAXED, __HIP_MEMORY_SCOPE_AGENT); }
DI unsigned xb_xcc_id() { return (unsigned)__builtin_amdgcn_s_getreg((3 << 11) | 20) & 0xFu; }
#define XB_SPIN(cond, bar) do { unsigned _sp = 0; while (cond) { __builtin_amdgcn_s_sleep(1); \
    if ((++_sp & 255u) == 0u) { if (xb_ld(&(bar)[XB_TMO])) break; if (_sp > XB_SPIN_CAP) { atomicAdd(&(bar)[XB_TMO], 1u); break; } } } } while (0)
struct XcdBarrier { unsigned* bar; unsigned x; volatile LAS unsigned* st; };
DI XcdBarrier xcd_barrier_post(unsigned* bar, volatile LAS unsigned* st) {
  XcdBarrier b; b.bar = bar; b.x = xb_xcc_id(); b.st = st;
  if (threadIdx.x == 0) (void)xb_add(&bar[XB_XCNT(b.x)], 1u);
  return b;
}
DI void xcd_barrier_complete(unsigned* bar, unsigned x, unsigned& nloc, unsigned& nx) {
  const unsigned G = gridDim.x * gridDim.y * gridDim.z;
  unsigned sum, cnt, mine, sp = 0u;
  for (;;) {
    sum = 0u; cnt = 0u; mine = 0u;
#pragma unroll
    for (unsigned j = 0; j < 16; ++j) { const unsigned c = xb_ld(&bar[XB_XCNT(j)]); sum += c; cnt += (c > 0u) ? 1u : 0u; mine = (j == x) ? c : mine; }
    if (sum == G) break;
    __builtin_amdgcn_s_sleep(1);
    if ((++sp & 255u) == 0u) { if (xb_ld(&bar[XB_TMO])) break; if (sp > XB_SPIN_CAP) { atomicAdd(&bar[XB_TMO], 1u); break; } }
  }
  nloc = mine > 0u ? mine : 1u; nx = cnt > 0u ? cnt : 1u;
}
DI void xcd_barrier(const XcdBarrier& b) {
  asm volatile("s_waitcnt vmcnt(0)" ::: "memory");
  __syncthreads();
  if (threadIdx.x == 0) {
    unsigned* bar = b.bar;
    asm volatile("" : "+s"(bar));
    __builtin_amdgcn_s_waitcnt(0);
    unsigned nloc = b.st[0], nx = b.st[1];
    if (nloc == 0u) { xcd_barrier_complete(bar, b.x, nloc, nx); b.st[0] = nloc; b.st[1] = nx; }
    const unsigned old = xb_add(&bar[XB_XSUB(b.x)], 1u);
    const unsigned gen = old / nloc;
    if (old + 1u == (gen + 1u) * nloc) {
      __builtin_amdgcn_fence(__ATOMIC_RELEASE, "agent");
      asm volatile("s_waitcnt vmcnt(0)" ::: "memory");
      const unsigned og = xb_add(&bar[XB_TOP], 1u);
      const unsigned tg = og / nx;
      if (og + 1u == (tg + 1u) * nx) xb_add(&bar[XB_TOPGEN], 1u);
      else XB_SPIN(xb_ld(&bar[XB_TOPGEN]) == tg, bar);
      __builtin_amdgcn_fence(__ATOMIC_ACQUIRE, "agent");
      xb_add(&bar[XB_XGEN(b.x)], 1u);
      asm volatile("s_waitcnt vmcnt(0)" ::: "memory");
    } else {
      XB_SPIN(xb_ld(&bar[XB_XGEN(b.x)]) == gen, bar);
      __builtin_amdgcn_fence(__ATOMIC_ACQUIRE, "agent");
      asm volatile("s_waitcnt vmcnt(0)" ::: "memory");
    }
  }
  __syncthreads();
}

DI void gemm_load(const int tid, const u16* A, int lda, const u16* B, int ldb, int k0, uint4 (&ra)[4], uint4 (&rb)[2]) {
#pragma unroll
  for (int i = 0; i < 4; ++i) {
    int idx = tid + i * 512;
    int row = idx >> 3, ch = idx & 7;
    ra[i] = *(const uint4*)(A + (size_t)row * lda + k0 + ch * 8);
  }
#pragma unroll
  for (int i = 0; i < 2; ++i) {
    int idx = tid + i * 512;
    int row = idx >> 3, ch = idx & 7;
    rb[i] = *(const uint4*)(B + (size_t)row * ldb + k0 + ch * 8);
  }
}
DI void gemm_store_lds(const int tid, char* sA, char* sB, const uint4 (&ra)[4], const uint4 (&rb)[2]) {
#pragma unroll
  for (int i = 0; i < 4; ++i) {
    int idx = tid + i * 512;
    int row = idx >> 3, ch = idx & 7;
    *(uint4*)(sA + row * 128 + ((ch ^ ((row >> 1) & 7)) << 4)) = ra[i];
  }
#pragma unroll
  for (int i = 0; i < 2; ++i) {
    int idx = tid + i * 512;
    int row = idx >> 3, ch = idx & 7;
    *(uint4*)(sB + row * 128 + ((ch ^ ((row >> 1) & 7)) << 4)) = rb[i];
  }
}
DI void gemm_compute(const char* sA, const char* sB, f32x4 (&acc)[4][4], int wm, int wn, int lane) {
#pragma unroll
  for (int kk = 0; kk < 2; ++kk) {
    bf16x8 a[4], b[4];
    const int ch = kk * 4 + (lane >> 4);
#pragma unroll
    for (int mf = 0; mf < 4; ++mf) {
      int row = wm * 64 + mf * 16 + (lane & 15);
      a[mf] = *(const bf16x8*)(sA + row * 128 + ((ch ^ ((row >> 1) & 7)) << 4));
    }
#pragma unroll
    for (int nf = 0; nf < 4; ++nf) {
      int row = wn * 64 + nf * 16 + (lane & 15);
      b[nf] = *(const bf16x8*)(sB + row * 128 + ((ch ^ ((row >> 1) & 7)) << 4));
    }
#pragma unroll
    for (int mf = 0; mf < 4; ++mf)
#pragma unroll
      for (int nf = 0; nf < 4; ++nf)
        acc[mf][nf] = __builtin_amdgcn_mfma_f32_16x16x32_bf16(a[mf], b[nf], acc[mf][nf], 0, 0, 0);
  }
}
DI void gemm_acc(const u16* A, int lda, const u16* B, int ldb, int K, f32x4 (&acc)[4][4], char* smem) {
  const int tid = get_tid(), lane = tid & 63, wave = tid >> 6;
  const int wm = wave >> 1, wn = wave & 1;
  char* sA0 = smem;
  char* sB0 = smem + 32768;
  char* sA1 = smem + 49152;
  char* sB1 = smem + 81920;
  uint4 ra[4], rb[2];
  const int nk = K >> 6;
  gemm_load(tid, A, lda, B, ldb, 0, ra, rb);
  gemm_store_lds(tid, sA0, sB0, ra, rb);
  __syncthreads();
  for (int kt = 0; kt < nk; ++kt) {
    const bool more = (kt + 1 < nk);
    if (more) gemm_load(tid, A, lda, B, ldb, (kt + 1) * 64, ra, rb);
    if (kt & 1) gemm_compute(sA1, sB1, acc, wm, wn, lane);
    else gemm_compute(sA0, sB0, acc, wm, wn, lane);
    if (more) {
      if (kt & 1) gemm_store_lds(tid, sA0, sB0, ra, rb);
      else gemm_store_lds(tid, sA1, sB1, ra, rb);
    }
    __syncthreads();
  }
}
DI void zero_acc(f32x4 (&acc)[4][4]) {
#pragma unroll
  for (int i = 0; i < 4; ++i)
#pragma unroll
    for (int j = 0; j < 4; ++j) { float z0; asm volatile("v_mov_b32 %0, 0" : "=v"(z0)); acc[i][j] = f32x4{z0, z0, z0, z0}; }
}

#define PG8_LAS __attribute__((address_space(3)))
namespace pg8 {
typedef unsigned short bf16_t;
typedef short bf16x8 __attribute__((ext_vector_type(8)));
typedef float f32x4 __attribute__((ext_vector_type(4)));
typedef unsigned u32x4 __attribute__((ext_vector_type(4)));
constexpr int BM = 256, BK = 64, HALF = 128, HTB = HALF * BK * 2  , STAGE_BYTES = 8 * HTB, NXCD = 8, WGM = 8;

__host__ __device__ __forceinline__ int lds_byte(int r, int c) { const int st = (r >> 4) * 2 + (c >> 5), rr = r & 15, cc = c & 31, ob = rr * 64 + cc * 2; return st * 1024 + (ob ^ (((ob >> 9) & 1) << 5)); }
__host__ __device__ __forceinline__ void stage_rc(int b, int& R, int& C) { const int st = b / 1024, sb = b % 1024, swz = sb ^ (((sb >> 9) & 1) << 5); R = (st >> 1) * 16 + swz / 64; C = (st & 1) * 32 + (swz % 64) / 2; }
__host__ __device__ __forceinline__ int perm32(int rho) { const int n = rho >> 4, i = rho & 15; return 8 * (i >> 2) + 4 * n + (i & 3); }

struct Unit { int pm, pn; };
struct Gemm { const bf16_t* A; const bf16_t* Bt; int M, N, K, blk, ld; };

struct StaticOrder {
    int nM, nN, nwg, G, c;
    __host__ __device__ void init(int M, int N, int G_, int c_) { nM = M / BM; nN = N / BM; nwg = nM * nN; G = G_; c = c_; }
    __host__ __device__ bool next(int i, Unit& u) const {
        const long L = (long)i * G + c; if (L >= nwg) return false;
        int wgid = (int)L; { const int q = nwg / NXCD, r = nwg % NXCD, xcd = wgid % NXCD, off = wgid / NXCD; wgid = (xcd < r ? xcd * (q + 1) : r * (q + 1) + (xcd - r) * q) + off; }
        const int nig = WGM * nN, gid = wgid / nig, fm = gid * WGM, gsz = (nM - fm) < WGM ? (nM - fm) : WGM;
        u.pm = fm + ((wgid % nig) % gsz); u.pn = (wgid % nig) / gsz; return true;
    }
    __device__ __forceinline__ void a_ready(const Unit&) const {}
    __device__ __forceinline__ void done(const Unit&) const {}
};
__device__ __forceinline__ unsigned cvt_pk_bf16(float lo, float hi) { unsigned r; asm volatile("v_cvt_pk_bf16_f32 %0, %1, %2" : "=v"(r) : "v"(lo), "v"(hi)); return r; }
template <class Epi, class Sched, bool STAMP = false>
__device__ __forceinline__ void gemm_phase(PG8_LAS unsigned char* lds, const Gemm g, const Sched& S, const Epi& E, unsigned long long* stamps) {
    const int tid = get_tid(), wid = __builtin_amdgcn_readfirstlane(tid >> 6), lane = tid & 63, wr = wid >> 2, wc = wid & 3, fr = lane & 15, fq = lane >> 4;
    const int K = g.K, nt = K / BK;
    int ts_lo = 0, ts_hi = 0, nts = 0; const unsigned long long rt_entry = STAMP ? (unsigned long long)wall_clock64() : 0ull;
#define PG8_STAMP() do { if (STAMP && wid == 0 && nts < 64) { const unsigned long long _c = (unsigned long long)clock64(); \
        ts_lo = (lane == nts) ? (int)(unsigned)_c : ts_lo; ts_hi = (lane == nts) ? (int)(unsigned)(_c >> 32) : ts_hi; ++nts; } } while (0)
    PG8_STAMP();
    unsigned voffA[2], voffB[2];
#pragma unroll
    for (int i = 0; i < 2; ++i) { int R, C; stage_rc(tid * 16 + i * 8192, R, C); const int Rb = Epi::PERM ? ((R & ~31) + perm32(R & 31)) : R;
        const int ldr = g.blk ? 64 : g.ld; voffA[i] = (unsigned)(R * ldr + C) * 2u; voffB[i] = (unsigned)(Rb * ldr + C) * 2u; }
    const size_t kstep = g.blk ? (size_t)32768 : (size_t)(BK * 2);
    const size_t hstep = g.blk ? (size_t)16384 : (size_t)HALF * g.ld * 2;
    const size_t tstep = g.blk ? (size_t)(K / 64) * 32768 : 2 * hstep;
    const unsigned ldsw = (unsigned)wid * 1024u;
    const int aoff = lds_byte(wr * 64 + fr, fq * 8), boff = lds_byte(wc * 32 + fr, fq * 8);
#define PG8_SA(b, h) (((b) * 2 + (h)) * HTB)
#define PG8_SB(b, h) ((4 + (b) * 2 + (h)) * HTB)
#define PG8_STAGE(bufoff, gbase, voff) do { _Pragma("unroll") for (int _i = 0; _i < 2; ++_i) \
        __builtin_amdgcn_global_load_lds((const unsigned*)((const char*)(gbase) + (voff)[_i]), (PG8_LAS unsigned*)(lds + (bufoff) + ldsw + _i * 8192), 16, 0, 0); } while (0)
#define PG8_LDA(dst, b, h) do { _Pragma("unroll") for (int m = 0; m < 4; ++m) _Pragma("unroll") for (int k = 0; k < 2; ++k) dst[m][k] = *(const PG8_LAS bf16x8*)(lds + PG8_SA(b, h) + aoff + m * 2048 + k * 1024); } while (0)
#define PG8_LDB(dst, b, h) do { _Pragma("unroll") for (int n = 0; n < 2; ++n) _Pragma("unroll") for (int k = 0; k < 2; ++k) dst[n][k] = *(const PG8_LAS bf16x8*)(lds + PG8_SB(b, h) + boff + n * 2048 + k * 1024); } while (0)
#define PG8_MMA(ai, bj, At, Bt) do { __builtin_amdgcn_s_setprio(1); _Pragma("unroll") for (int m = 0; m < 4; ++m) _Pragma("unroll") for (int n = 0; n < 2; ++n) _Pragma("unroll") for (int k = 0; k < 2; ++k) \
        acc[ai][bj][m][n] = __builtin_amdgcn_mfma_f32_16x16x32_bf16(Bt[n][k], At[m][k], acc[ai][bj][m][n], 0, 0, 0); __builtin_amdgcn_s_setprio(0); } while (0)
#define PG8_WAIT_V(n) asm volatile("s_waitcnt vmcnt(" #n ")" ::: "memory")
#define PG8_WAIT_L(n) asm volatile("s_waitcnt lgkmcnt(" #n ")" ::: "memory")
#define PG8_BAR __builtin_amdgcn_s_barrier()
#define PG8_SCHED __builtin_amdgcn_sched_barrier(0)
    Unit cur, nxt; int ui = 0;
    if (!S.next(0, cur)) return;
    f32x4 acc[2][2][4][2];
#pragma unroll
    for (int a = 0; a < 2; ++a)
#pragma unroll
        for (int b = 0; b < 2; ++b)
#pragma unroll
            for (int m = 0; m < 4; ++m)
#pragma unroll
                for (int n = 0; n < 2; ++n) { float z0; asm volatile("v_mov_b32 %0, 0" : "=v"(z0)); acc[a][b][m][n] = (f32x4){z0, z0, z0, z0}; }
    bf16x8 At[4][2], B0[2][2], B1[2][2];
    const char* cA = (const char*)g.A + (size_t)cur.pm * tstep; const char* cB = (const char*)g.Bt + (size_t)cur.pn * tstep;
    S.a_ready(cur);
    PG8_STAGE(PG8_SB(0, 0), cB, voffB); PG8_STAGE(PG8_SA(0, 0), cA, voffA); PG8_STAGE(PG8_SB(0, 1), cB + hstep, voffB); PG8_STAGE(PG8_SA(0, 1), cA + hstep, voffA);
    if (wr == 1) PG8_BAR;
    PG8_WAIT_V(4); PG8_BAR;
    PG8_STAGE(PG8_SB(1, 0), cB + kstep, voffB); PG8_STAGE(PG8_SA(1, 0), cA + kstep, voffA); PG8_STAGE(PG8_SB(1, 1), cB + hstep + kstep, voffB);
    PG8_WAIT_V(6); PG8_BAR;
    PG8_STAMP();
    for (;;) {
        const bool has_next = S.next(ui + 1, nxt);
        const char* nA = has_next ? (const char*)g.A + (size_t)nxt.pm * tstep : cA; const char* nB = has_next ? (const char*)g.Bt + (size_t)nxt.pn * tstep : cB;
        for (int t = 0; t < nt; t += 2) {
            const bool last = (t == nt - 2);
            const char* a1 = cA + (size_t)(t + 1) * kstep;
            const char* a2 = last ? nA : cA + (size_t)(t + 2) * kstep; const char* b2 = last ? nB : cB + (size_t)(t + 2) * kstep;
            const char* a3 = a2 + kstep; const char* b3 = b2 + kstep;
            if (last && has_next) S.a_ready(nxt);
            PG8_LDB(B0, 0, 0); PG8_SCHED; PG8_LDA(At, 0, 0); PG8_STAGE(PG8_SA(1, 1), a1 + hstep, voffA);
            PG8_WAIT_L(8); PG8_BAR; PG8_WAIT_L(0); PG8_MMA(0, 0, At, B0); PG8_BAR; PG8_SCHED;
            PG8_LDB(B1, 0, 1); PG8_STAGE(PG8_SB(0, 0), b2, voffB);
            PG8_BAR; PG8_WAIT_L(0); PG8_MMA(0, 1, At, B1); PG8_BAR;
            PG8_LDA(At, 0, 1); PG8_STAGE(PG8_SA(0, 0), a2, voffA);
            PG8_BAR; PG8_WAIT_L(0); PG8_MMA(1, 0, At, B0); PG8_BAR; PG8_SCHED;
            PG8_STAGE(PG8_SB(0, 1), b2 + hstep, voffB);
            PG8_WAIT_V(6); PG8_BAR; PG8_MMA(1, 1, At, B1); PG8_BAR;
            PG8_LDB(B0, 1, 0); PG8_SCHED; PG8_LDA(At, 1, 0); PG8_STAGE(PG8_SA(0, 1), a2 + hstep, voffA);
            PG8_WAIT_L(8); PG8_BAR; PG8_WAIT_L(0); PG8_MMA(0, 0, At, B0); PG8_BAR; PG8_SCHED;
            PG8_LDB(B1, 1, 1); PG8_STAGE(PG8_SB(1, 0), b3, voffB);
            PG8_BAR; PG8_WAIT_L(0); PG8_MMA(0, 1, At, B1); PG8_BAR;
            PG8_LDA(At, 1, 1); PG8_STAGE(PG8_SA(1, 0), a3, voffA);
            PG8_BAR; PG8_WAIT_L(0); PG8_MMA(1, 0, At, B0); PG8_BAR; PG8_SCHED;
            PG8_STAGE(PG8_SB(1, 1), b3 + hstep, voffB);
            PG8_WAIT_V(6); PG8_BAR; PG8_MMA(1, 1, At, B1); PG8_BAR;
        }
        PG8_STAMP();
        if constexpr (!Epi::AFTER_DRAIN) { E(acc, cur, wr, wc, fr, fq); S.done(cur); }
        PG8_STAMP();
        if (!has_next) break;
#pragma unroll
        for (int a = 0; a < 2; ++a)
#pragma unroll
            for (int b = 0; b < 2; ++b)
#pragma unroll
                for (int m = 0; m < 4; ++m)
#pragma unroll
                    for (int n = 0; n < 2; ++n) { float z0; asm volatile("v_mov_b32 %0, 0" : "=v"(z0)); acc[a][b][m][n] = (f32x4){z0, z0, z0, z0}; }
        cur = nxt; cA = nA; cB = nB; ++ui;
    }
    PG8_WAIT_V(0);
    if (wr == 0) PG8_BAR;
    PG8_BAR;
    if constexpr (Epi::AFTER_DRAIN) { E.fused(acc, cur, wr, wc, fr, fq, lds, wid, lane); S.done(cur); }
    PG8_STAMP();
    if (STAMP && wid == 0) { stamps[lane] = lane < nts ? (((unsigned long long)(unsigned)ts_hi << 32) | (unsigned)ts_lo) : 0ull;
        if (lane == 62) stamps[62] = rt_entry; if (lane == 63) stamps[63] = (unsigned long long)wall_clock64(); }
#undef PG8_STAMP
#undef PG8_SA
#undef PG8_SB
#undef PG8_STAGE
#undef PG8_LDA
#undef PG8_LDB
#undef PG8_MMA
#undef PG8_WAIT_V
#undef PG8_WAIT_L
#undef PG8_BAR
#undef PG8_SCHED
}
}

using pg8::cvt_pk_bf16;
DI uint4 pack8(const pg8::f32x4& a, const pg8::f32x4& b) {
  return uint4{cvt_pk_bf16(a[0], a[1]), cvt_pk_bf16(a[2], a[3]), cvt_pk_bf16(b[0], b[1]), cvt_pk_bf16(b[2], b[3])};
}
DI void unpack8(const uint4& u, float (&o)[8]) {
  o[0] = bf2f((u16)(u.x & 0xffff)); o[1] = bf2f((u16)(u.x >> 16));
  o[2] = bf2f((u16)(u.y & 0xffff)); o[3] = bf2f((u16)(u.y >> 16));
  o[4] = bf2f((u16)(u.z & 0xffff)); o[5] = bf2f((u16)(u.z >> 16));
  o[6] = bf2f((u16)(u.w & 0xffff)); o[7] = bf2f((u16)(u.w >> 16));
}
struct EpiP {
  static constexpr bool PERM = true, AFTER_DRAIN = false;
  u16 *zb, *xr, *rwb, *gb; float* dtb; int coff;
  DI void operator()(const pg8::f32x4 (&acc)[2][2][4][2], const pg8::Unit& u, int wr, int wc, int fr, int fq) const {
    const int row0 = u.pm * 256 + wr * 64 + fr;
#pragma unroll
    for (int bj = 0; bj < 2; ++bj) {
      const int cg = coff + u.pn * 256 + bj * 128 + wc * 32;
      const int col0 = cg + 8 * fq;
      if (cg >= 10688) continue;
#pragma unroll
      for (int ai = 0; ai < 2; ++ai)
#pragma unroll
        for (int m = 0; m < 4; ++m) {
          const size_t row = row0 + ai * 128 + m * 16;
          const pg8::f32x4 v0 = acc[ai][bj][m][0], v1 = acc[ai][bj][m][1];
          if (cg >= 5120 && cg < 5184) {
            float* d = dtb + row * 64 + (col0 - 5120);
            *(pg8::f32x4*)d = v0; *(pg8::f32x4*)(d + 4) = v1;
          } else {
            u16* dst = (cg < 2048) ? zb + row * 2048 + col0
                     : (cg < 5120) ? xr + row * 3072 + (col0 - 2048)
                     : (cg < 8640) ? rwb + row * 3456 + (col0 - 5184)
                                   : gb + row * 2048 + (col0 - 8640);
            *(uint4*)dst = pack8(v0, v1);
          }
        }
    }
  }
};
struct EpiOutV {
  static constexpr bool PERM = true, AFTER_DRAIN = false;
  const u16* gb; u16* V; int goff;
  DI void operator()(const pg8::f32x4 (&acc)[2][2][4][2], const pg8::Unit& u, int wr, int wc, int fr, int fq) const {
    const int row0 = u.pm * 256 + wr * 64 + fr;
#pragma unroll
    for (int bj = 0; bj < 2; ++bj) {
      const int col0 = u.pn * 256 + bj * 128 + wc * 32 + 8 * fq;
#pragma unroll
      for (int ai = 0; ai < 2; ++ai)
#pragma unroll
        for (int m = 0; m < 4; ++m) {
          const size_t row = row0 + ai * 128 + m * 16;
          float gt[8];
          unpack8(*(const uint4*)(gb + row * 2048 + goff + col0), gt);
          pg8::f32x4 v0 = acc[ai][bj][m][0], v1 = acc[ai][bj][m][1];
#pragma unroll
          for (int e = 0; e < 4; ++e) { v0[e] *= sigm(gt[e]); v1[e] *= sigm(gt[4 + e]); }
          *(uint4*)(V + row * 1024 + col0) = pack8(v0, v1);
        }
    }
  }
};
struct EpiWo {
  static constexpr bool PERM = true, AFTER_DRAIN = false;
  const float *xp, *xs, *mod; float* out; int tok0;
  DI void operator()(const pg8::f32x4 (&acc)[2][2][4][2], const pg8::Unit& u, int wr, int wc, int fr, int fq) const {
    const int row0 = u.pm * 256 + wr * 64 + fr;
#pragma unroll
    for (int bj = 0; bj < 2; ++bj) {
      const int col0 = u.pn * 256 + bj * 128 + wc * 32 + 8 * fq;
#pragma unroll
      for (int ai = 0; ai < 2; ++ai)
#pragma unroll
        for (int m = 0; m < 4; ++m) {
          const int tok = tok0 + row0 + ai * 128 + m * 16;
          const float* xr = tok < 8192 ? xp + (size_t)tok * 1024 : xs + (size_t)(tok - 8192) * 1024;
          const float* gt = mod + mrow_of(tok) * 6144 + 2048 + col0;
          const pg8::f32x4 x0 = *(const pg8::f32x4*)(xr + col0), x1 = *(const pg8::f32x4*)(xr + col0 + 4);
          const pg8::f32x4 g0 = *(const pg8::f32x4*)gt, g1 = *(const pg8::f32x4*)(gt + 4);
          float* o = out + (size_t)tok * 1024 + col0;
          *(pg8::f32x4*)o = x0 + g0 * acc[ai][bj][m][0];
          *(pg8::f32x4*)(o + 4) = x1 + g1 * acc[ai][bj][m][1];
        }
    }
  }
};
struct EpiGU {
  static constexpr bool PERM = true, AFTER_DRAIN = false;
  u16* act;
  DI void operator()(const pg8::f32x4 (&acc)[2][2][4][2], const pg8::Unit& u, int wr, int wc, int fr, int fq) const {
    const int row0 = u.pm * 256 + wr * 64 + fr;
    const int col0 = u.pn * 128 + wc * 32 + 8 * fq;
#pragma unroll
    for (int ai = 0; ai < 2; ++ai)
#pragma unroll
      for (int m = 0; m < 4; ++m) {
        const size_t row = row0 + ai * 128 + m * 16;
        pg8::f32x4 v0, v1;
#pragma unroll
        for (int e = 0; e < 4; ++e) {
          v0[e] = siluf(acc[ai][0][m][0][e]) * acc[ai][1][m][0][e];
          v1[e] = siluf(acc[ai][0][m][1][e]) * acc[ai][1][m][1][e];
        }
        *(uint4*)(act + ((row >> 8) * 44 + (col0 >> 6)) * 16384 + (row & 255) * 64 + (col0 & 63)) = pack8(v0, v1);
      }
  }
};
struct EpiDown {
  static constexpr bool PERM = true, AFTER_DRAIN = false;
  const float* mod; float* out;
  DI void operator()(const pg8::f32x4 (&acc)[2][2][4][2], const pg8::Unit& u, int wr, int wc, int fr, int fq) const {
    const int row0 = u.pm * 256 + wr * 64 + fr;
#pragma unroll
    for (int bj = 0; bj < 2; ++bj) {
      const int col0 = u.pn * 256 + bj * 128 + wc * 32 + 8 * fq;
#pragma unroll
      for (int ai = 0; ai < 2; ++ai)
#pragma unroll
        for (int m = 0; m < 4; ++m) {
          const int tok = row0 + ai * 128 + m * 16;
          const float* gt = mod + mrow_of(tok) * 6144 + 5120 + col0;
          const pg8::f32x4 g0 = *(const pg8::f32x4*)gt, g1 = *(const pg8::f32x4*)(gt + 4);
          float* o = out + (size_t)tok * 1024 + col0;
          const pg8::f32x4 x0 = *(const pg8::f32x4*)o, x1 = *(const pg8::f32x4*)(o + 4);
          *(pg8::f32x4*)o = x0 + g0 * acc[ai][bj][m][0];
          *(pg8::f32x4*)(o + 4) = x1 + g1 * acc[ai][bj][m][1];
        }
    }
  }
};
template <class Epi>
DI void run_gemm8(char* smem, const u16* A, const u16* Bt, int M, int N, int K, const Epi& E, int vb = -1, int nb = 0, int blk = 0, int ld = 0) {
  if (ld == 0) ld = K;
  asm volatile("" : "+s"(M), "+s"(N), "+s"(K), "+s"(blk), "+s"(ld));
  pg8::Gemm gm{A, Bt, M, N, K, blk, ld};
  pg8::StaticOrder S;
  if (vb < 0) { vb = blockIdx.x; nb = gridDim.x; }
  S.init(M, N, nb, vb);
  pg8::gemm_phase<Epi, pg8::StaticOrder, false>((PG8_LAS unsigned char*)smem, gm, S, E, nullptr);
  __syncthreads();
}

struct EpiR2 {
  static constexpr bool PERM = true, AFTER_DRAIN = false;
  __half* wk; const float *w0, *a0;
  DI void operator()(const pg8::f32x4 (&acc)[2][2][4][2], const pg8::Unit& u, int wr, int wc, int fr, int fq) const {
    const int row0 = u.pm * 256 + wr * 64 + fr;
    const int sec = u.pn >> 2;
#pragma unroll
    for (int bj = 0; bj < 2; ++bj) {
      const int nn = (u.pn & 3) * 256 + bj * 128 + wc * 32 + 8 * fq;
      const int d = sec & 1;
      const float* bias = (sec < 2 ? w0 : a0) + d * 1024 + nn;
      const pg8::f32x4 b0 = *(const pg8::f32x4*)bias, b1 = *(const pg8::f32x4*)(bias + 4);
      const int field = (sec < 2 ? 4 : 5) + 2 * d;
#pragma unroll
      for (int ai = 0; ai < 2; ++ai)
#pragma unroll
        for (int m = 0; m < 4; ++m) {
          const size_t row = row0 + ai * 128 + m * 16;
          pg8::f32x4 v0 = acc[ai][bj][m][0] + b0, v1 = acc[ai][bj][m][1] + b1;
          float o[8];
#pragma unroll
          for (int e = 0; e < 4; ++e) {
            float s0 = sigm(v0[e]), s1 = sigm(v1[e]);
            o[e] = sec < 2 ? __expf(-0.6065306597f * s0) : s0;
            o[4 + e] = sec < 2 ? __expf(-0.6065306597f * s1) : s1;
          }
          __half2 h0 = __floats2half2_rn(o[0], o[1]), h1 = __floats2half2_rn(o[2], o[3]);
          __half2 h2 = __floats2half2_rn(o[4], o[5]), h3 = __floats2half2_rn(o[6], o[7]);
          uint4 pk;
          pk.x = *reinterpret_cast<unsigned*>(&h0); pk.y = *reinterpret_cast<unsigned*>(&h1);
          pk.z = *reinterpret_cast<unsigned*>(&h2); pk.w = *reinterpret_cast<unsigned*>(&h3);
          *(uint4*)(wk + ((row * 16 + (nn >> 6)) * 8 + field) * 64 + (nn & 63)) = pk;
        }
    }
  }
};

template <int MODE>
__device__ __forceinline__ void convT(const float* __restrict__ src, int K, int N, u16* __restrict__ dst, char* smem, int vb = -1, int nb = 0, int ldd = 0) {
  if (ldd == 0) ldd = K;
  float* tile = (float*)smem;
  const int tid = get_tid();
  const int KT = K >> 6, NT = N >> 6;
  if (vb < 0) { vb = blockIdx.x; nb = gridDim.x; }
  for (int t = vb; t < KT * NT; t += nb) {
    int kt = t % KT, nt = t / KT;
#pragma unroll
    for (int i = 0; i < 2; ++i) {
      int idx = tid + i * 512;
      int r = idx >> 4, c4 = idx & 15;
      *(float4*)(tile + r * 68 + c4 * 4) = *(const float4*)(src + (size_t)(kt * 64 + r) * N + nt * 64 + c4 * 4);
    }
    __syncthreads();
    int n = tid >> 3, kc = tid & 7;
    unsigned w[4];
#pragma unroll
    for (int j = 0; j < 4; ++j)
      w[j] = pack2(tile[(kc * 8 + 2 * j) * 68 + n], tile[(kc * 8 + 2 * j + 1) * 68 + n]);
    int ng = nt * 64 + n;
    int row = ng;
    if (MODE == 1) {
      int isu = ng >= 2816;
      int nn = ng - isu * 2816;
      row = (nn >> 7) * 256 + isu * 128 + (nn & 127);
    }
    if (MODE == 2) *(uint4*)(dst + ((size_t)(row >> 8) * KT + kt) * 16384 + (row & 255) * 64 + kc * 8) = uint4{w[0], w[1], w[2], w[3]};
    else *(uint4*)(dst + (size_t)row * ldd + kt * 64 + kc * 8) = uint4{w[0], w[1], w[2], w[3]};
    __syncthreads();
  }
}

__device__ __forceinline__ void step_prep(const Params& p, char* smem) {
  const int tid = get_tid();
  char* ws = p.ws;
  {
    float* red = (float*)smem;
    float* mod = (float*)(ws + OFF_MOD);
    for (int item = blockIdx.x; item < 192; item += gridDim.x) {
      int c4 = tid & 7, kl = tid >> 3;
      float acc[12];
#pragma unroll
      for (int i = 0; i < 12; ++i) acc[i] = 0.f;
      for (int k = kl; k < 1024; k += 64) {
        float4 w = *(const float4*)(p.w_ada + (size_t)k * 6144 + item * 32 + c4 * 4);
        float s0 = siluf(p.c_ctx[k]), s1 = siluf(p.c[k]), s2 = siluf(p.c[1024 + k]);
        acc[0] += s0 * w.x; acc[1] += s0 * w.y; acc[2] += s0 * w.z; acc[3] += s0 * w.w;
        acc[4] += s1 * w.x; acc[5] += s1 * w.y; acc[6] += s1 * w.z; acc[7] += s1 * w.w;
        acc[8] += s2 * w.x; acc[9] += s2 * w.y; acc[10] += s2 * w.z; acc[11] += s2 * w.w;
      }
#pragma unroll
      for (int i = 0; i < 12; ++i) red[(kl * 8 + c4) * 12 + i] = acc[i];
      __syncthreads();
      if (tid < 96) {
        int cond = tid >> 5, col = tid & 31;
        int cc4 = col >> 2, e = col & 3;
        float s = 0.f;
        for (int k = 0; k < 64; ++k) s += red[(k * 8 + cc4) * 12 + cond * 4 + e];
        int n = item * 32 + col;
        mod[cond * 6144 + n] = s + p.b_ada[n];
      }
      __syncthreads();
    }
  }
  convT<0>(p.w_in, 1024, 10688, (u16*)(ws + OFF_WIN), smem);
  convT<0>(p.w_m_out, 2048, 1024, (u16*)(ws + OFF_WMOUT), smem);
  convT<0>(p.w_r_out, 1024, 1024, (u16*)(ws + OFF_WROUT), smem);
  convT<0>(p.w_o, 1024, 1024, (u16*)(ws + OFF_WO), smem);
  convT<0>(p.w2, 64, 1024, (u16*)(ws + OFF_W2T), smem);
  convT<0>(p.w2 + 65536, 64, 1024, (u16*)(ws + OFF_W2T) + 65536, smem);
  convT<0>(p.a2, 64, 1024, (u16*)(ws + OFF_A2T), smem);
  convT<0>(p.a2 + 65536, 64, 1024, (u16*)(ws + OFF_A2T) + 65536, smem);
  convT<0>(p.g2, 128, 1024, (u16*)(ws + OFF_G2T), smem);
  {
    u16* w4 = (u16*)(ws + OFF_W4T);
    convT<0>(p.w2, 64, 1024, w4 + (size_t)0 * 1024 * 256 + 0, smem, -1, 0, 256);
    convT<0>(p.w2 + 65536, 64, 1024, w4 + (size_t)1 * 1024 * 256 + 64, smem, -1, 0, 256);
    convT<0>(p.a2, 64, 1024, w4 + (size_t)2 * 1024 * 256 + 128, smem, -1, 0, 256);
    convT<0>(p.a2 + 65536, 64, 1024, w4 + (size_t)3 * 1024 * 256 + 192, smem, -1, 0, 256);
    for (int i = blockIdx.x * NTHR + tid; i < 4096 * 32; i += gridDim.x * NTHR) {
      int row = i >> 5, c = i & 31;
      if ((c >> 3) != (row >> 10)) *(uint4*)(w4 + (size_t)row * 256 + c * 8) = uint4{0, 0, 0, 0};
    }
  }
  {
    uint4* z = (uint4*)(ws + OFF_WIN + (size_t)10688 * 1024 * 2);
    for (int i = blockIdx.x * NTHR + tid; i < 8192; i += gridDim.x * NTHR) z[i] = uint4{0, 0, 0, 0};
  }
}

template <int WHICH>
__device__ __forceinline__ void step_norm(const Params& p, int g) {
  const int tid = get_tid(), lane = tid & 63, wave = tid >> 6;
  const float* mod = (const float*)(p.ws + OFF_MOD);
  const int nrows = WHICH == 0 ? TG : NTOK;
  u16* dst = WHICH == 0 ? (u16*)((char*)p.out + H1_OUT_OFF) : (u16*)(p.ws + OFF_H2);
  const float* nw = WHICH == 0 ? p.norm1_w : p.norm2_w;
  for (int r = blockIdx.x * 8 + wave; r < nrows; r += gridDim.x * 8) {
    int tok = WHICH == 0 ? g * TG + r : r;
    const float* xr;
    if (WHICH == 0) xr = tok < 8192 ? p.x_prompt + (size_t)tok * 1024 : p.x_sample + (size_t)(tok - 8192) * 1024;
    else xr = (const float*)(p.ws + OFF_X1) + (size_t)tok * 1024;
    const float* mr = mod + mrow_of(tok) * 6144 + (WHICH == 0 ? 0 : 3072);
    float4 v[4];
    float ss = 0.f;
#pragma unroll
    for (int i = 0; i < 4; ++i) {
      v[i] = ((const float4*)xr)[i * 64 + lane];
      ss += v[i].x * v[i].x + v[i].y * v[i].y + v[i].z * v[i].z + v[i].w * v[i].w;
    }
    ss = wave_sum(ss);
    float rinv = rsqrtf(ss * (1.f / 1024.f) + 1e-6f);
#pragma unroll
    for (int i = 0; i < 4; ++i) {
      int col = (i * 64 + lane) * 4;
      float4 w4 = *(const float4*)(nw + col);
      float4 sh = *(const float4*)(mr + col);
      float4 sc = *(const float4*)(mr + 1024 + col);
      float h0 = v[i].x * rinv * w4.x * (1.f + sc.x) + sh.x;
      float h1 = v[i].y * rinv * w4.y * (1.f + sc.y) + sh.y;
      float h2 = v[i].z * rinv * w4.z * (1.f + sc.z) + sh.z;
      float h3 = v[i].w * rinv * w4.w * (1.f + sc.w) + sh.w;
      *(uint2*)(dst + (size_t)r * 1024 + col) = uint2{pack2(h0, h1), pack2(h2, h3)};
    }
  }
}

__device__ __forceinline__ void step_gemm1(const Params& p, char* smem, int part) {
  char* ws = p.ws;
  const u16* H1 = (const u16*)((const char*)p.out + H1_OUT_OFF);
  const u16* W = (const u16*)(ws + OFF_WIN);
  if (part == 0) {
    EpiP E{(u16*)(ws + OFF_Z), (u16*)(ws + OFF_XBCRAW), (u16*)(ws + OFF_RW), (u16*)(ws + OFF_GATE), (float*)(ws + OFF_DT), 0};
    run_gemm8(smem, H1, W, TG, NPAD, 1024, E);
  } else if (part == 1) {
    EpiP E{(u16*)(ws + OFF_Z), (u16*)(ws + OFF_XBCRAW), (u16*)(ws + OFF_RW), (u16*)(ws + OFF_GATE), (float*)(ws + OFF_DT), 0};
    run_gemm8(smem, H1, W, TG, 5120, 1024, E, (int)blockIdx.x - 64, (int)gridDim.x - 64);
  } else {
    EpiP E{(u16*)(ws + OFF_Z), (u16*)(ws + OFF_XBCRAW), (u16*)(ws + OFF_RW), (u16*)(ws + OFF_GATE), (float*)(ws + OFF_DT), 5120};
    run_gemm8(smem, H1, W + (size_t)5120 * 1024, TG, NPAD - 5120, 1024, E);
  }
}

__device__ __forceinline__ void step_cr1(const Params& p, int g) {
  char* ws = p.ws;
  const int tid = get_tid(), lane = tid & 63, wave = tid >> 6;
  const int Ls = g < 2 ? 256 : 2048;
  {
    const u16* __restrict__ xr = (const u16*)(ws + OFF_XBCRAW);
    u16* __restrict__ xo = (u16*)(ws + OFF_XBC);
    for (int item = blockIdx.x * NTHR + tid; item < (TG / 8) * 384; item += gridDim.x * NTHR) {
      const int rb = item / 384, cc = item - rb * 384;
      const int r0 = rb * 8, pos0 = r0 & (Ls - 1);
      uint4 rows[12];
#pragma unroll
      for (int i = 0; i < 12; ++i) {
        const int pp = pos0 + i - 2;
        rows[i] = uint4{0, 0, 0, 0};
        if (pp >= 0 && pp < Ls) rows[i] = *(const uint4*)(xr + (size_t)(r0 + i - 2) * 3072 + cc * 8);
      }
      float w[5][8], bias[8];
      {
        float4 b0 = *(const float4*)(p.conv_b + cc * 8), b1 = *(const float4*)(p.conv_b + cc * 8 + 4);
        bias[0] = b0.x; bias[1] = b0.y; bias[2] = b0.z; bias[3] = b0.w; bias[4] = b1.x; bias[5] = b1.y; bias[6] = b1.z; bias[7] = b1.w;
#pragma unroll
        for (int i = 0; i < 5; ++i) {
          float4 w0 = *(const float4*)(p.conv_w + i * 3072 + cc * 8), w1 = *(const float4*)(p.conv_w + i * 3072 + cc * 8 + 4);
          w[i][0] = w0.x; w[i][1] = w0.y; w[i][2] = w0.z; w[i][3] = w0.w; w[i][4] = w1.x; w[i][5] = w1.y; w[i][6] = w1.z; w[i][7] = w1.w;
        }
      }
      float s[8][8];
#pragma unroll
      for (int o = 0; o < 8; ++o)
#pragma unroll
        for (int e = 0; e < 8; ++e) s[o][e] = bias[e];
#pragma unroll
      for (int i = 0; i < 12; ++i) {
        float xv[8];
        unpack8(rows[i], xv);
#pragma unroll
        for (int k = 0; k < 5; ++k) {
          const int o = i - k;
          if (o >= 0 && o < 8) {
#pragma unroll
            for (int e = 0; e < 8; ++e) s[o][e] += xv[e] * w[k][e];
          }
        }
      }
#pragma unroll
      for (int o = 0; o < 8; ++o) {
#pragma unroll
        for (int e = 0; e < 8; ++e) s[o][e] = siluf(s[o][e]);
        *(uint4*)(xo + (size_t)(r0 + o) * 3072 + cc * 8) = uint4{pack2(s[o][0], s[o][1]), pack2(s[o][2], s[o][3]), pack2(s[o][4], s[o][5]), pack2(s[o][6], s[o][7])};
      }
    }
  }
  {
    const u16* __restrict__ rw = (const u16*)(ws + OFF_RW);
    __half* __restrict__ wk = (__half*)(ws + OFF_WK);
    u16* __restrict__ tl = (u16*)(ws + OFF_TL);
    u16* __restrict__ sg = (u16*)(ws + OFF_SG);
    const bool grid = (g == 2);
    for (int r = blockIdx.x * 8 + wave; r < TG; r += gridDim.x * 8) {
      const int pos = r & (Ls - 1);
      uint4 cur[7], shv[7];
#pragma unroll
      for (int it = 0; it < 7; ++it) {
        const int ci = it * 64 + lane;
        cur[it] = uint4{0, 0, 0, 0};
        shv[it] = uint4{0, 0, 0, 0};
        if (ci < 432) {
          const int q = ci / 108;
          int dr;
          bool ok;
          if (!grid) {
            if (q & 1) { dr = 1; ok = pos < Ls - 1; } else { dr = -1; ok = pos > 0; }
          } else {
            if (q == 0) { dr = -1; ok = (pos & 63) != 0; }
            else if (q == 1) { dr = 1; ok = (pos & 63) != 63; }
            else if (q == 2) { dr = -64; ok = pos >= 64; }
            else { dr = 64; ok = pos < Ls - 64; }
          }
          cur[it] = *(const uint4*)(rw + (size_t)r * 3456 + ci * 8);
          if (ok) shv[it] = *(const uint4*)(rw + (size_t)(r + dr) * 3456 + ci * 8);
        }
      }
#pragma unroll
      for (int it = 0; it < 7; ++it) {
        const int ci = it * 64 + lane;
        const bool valid = ci < 432;
        float xx[8];
        {
          float cf[8], sf[8];
          unpack8(cur[it], cf);
          unpack8(shv[it], sf);
          const int cm = valid ? ci * 8 : 0;
          const float4 m0 = *(const float4*)(p.mu_shift + cm), m1 = *(const float4*)(p.mu_shift + cm + 4);
          const float mu[8] = {m0.x, m0.y, m0.z, m0.w, m1.x, m1.y, m1.z, m1.w};
#pragma unroll
          for (int e = 0; e < 8; ++e) xx[e] = cf[e] + mu[e] * (sf[e] - cf[e]);
        }
        const bool isk = valid && ci >= 144 && ci < 272;
        float kk[8];
        float ss = 0.f;
        {
          const int kc = isk ? ci - 144 : 0;
          const float4 k0 = *(const float4*)(p.k_k + kc * 8), k1 = *(const float4*)(p.k_k + kc * 8 + 4);
          const float kkw[8] = {k0.x, k0.y, k0.z, k0.w, k1.x, k1.y, k1.z, k1.w};
#pragma unroll
          for (int e = 0; e < 8; ++e) { kk[e] = xx[e] * kkw[e]; ss += kk[e] * kk[e]; }
        }
        ss += dpp_xor1(ss);
        ss += dpp_xor2(ss);
        ss += dpp_hmirror(ss);
        if (valid) {
          if (ci < 128) {
            __half2 h0 = __floats2half2_rn(xx[0], xx[1]), h1 = __floats2half2_rn(xx[2], xx[3]), h2 = __floats2half2_rn(xx[4], xx[5]), h3 = __floats2half2_rn(xx[6], xx[7]);
            uint4 pk{*reinterpret_cast<unsigned*>(&h0), *reinterpret_cast<unsigned*>(&h1), *reinterpret_cast<unsigned*>(&h2), *reinterpret_cast<unsigned*>(&h3)};
            *(uint4*)(wk + ((size_t)(r * 16 + (ci >> 3)) * 8 + 0) * 64 + (ci & 7) * 8) = pk;
          } else if (ci < 144) {
            float t[8];
#pragma unroll
            for (int e = 0; e < 8; ++e) t[e] = tanhf(xx[e]);
            *(uint4*)(tl + (size_t)r * 256 + (ci - 128) * 8) = uint4{pack2(t[0], t[1]), pack2(t[2], t[3]), pack2(t[4], t[5]), pack2(t[6], t[7])};
          } else if (ci < 272) {
            const int kc = ci - 144;
            const float rn = -rsqrtf(ss + 1e-12f);
            __half2 h0 = __floats2half2_rn(xx[0], xx[1]), h1 = __floats2half2_rn(xx[2], xx[3]), h2 = __floats2half2_rn(xx[4], xx[5]), h3 = __floats2half2_rn(xx[6], xx[7]);
            uint4 pk{*reinterpret_cast<unsigned*>(&h0), *reinterpret_cast<unsigned*>(&h1), *reinterpret_cast<unsigned*>(&h2), *reinterpret_cast<unsigned*>(&h3)};
            *(uint4*)(wk + ((size_t)(r * 16 + (kc >> 3)) * 8 + 2) * 64 + (kc & 7) * 8) = pk;
            __half2 n0 = __floats2half2_rn(kk[0] * rn, kk[1] * rn), n1 = __floats2half2_rn(kk[2] * rn, kk[3] * rn), n2 = __floats2half2_rn(kk[4] * rn, kk[5] * rn), n3 = __floats2half2_rn(kk[6] * rn, kk[7] * rn);
            uint4 pn{*reinterpret_cast<unsigned*>(&n0), *reinterpret_cast<unsigned*>(&n1), *reinterpret_cast<unsigned*>(&n2), *reinterpret_cast<unsigned*>(&n3)};
            *(uint4*)(wk + ((size_t)(r * 16 + (kc >> 3)) * 8 + 3) * 64 + (kc & 7) * 8) = pn;
          } else if (ci < 400) {
            const int vc = ci - 272;
            __half2 h0 = __floats2half2_rn(xx[0], xx[1]), h1 = __floats2half2_rn(xx[2], xx[3]), h2 = __floats2half2_rn(xx[4], xx[5]), h3 = __floats2half2_rn(xx[6], xx[7]);
            uint4 pk{*reinterpret_cast<unsigned*>(&h0), *reinterpret_cast<unsigned*>(&h1), *reinterpret_cast<unsigned*>(&h2), *reinterpret_cast<unsigned*>(&h3)};
            *(uint4*)(wk + ((size_t)(r * 16 + (vc >> 3)) * 8 + 1) * 64 + (vc & 7) * 8) = pk;
          } else if (ci < 416) {
            *(uint4*)(tl + (size_t)r * 256 + 128 + (ci - 400) * 8) = uint4{pack2(xx[0], xx[1]), pack2(xx[2], xx[3]), pack2(xx[4], xx[5]), pack2(xx[6], xx[7])};
          } else {
            float t[8];
#pragma unroll
            for (int e = 0; e < 8; ++e) t[e] = sigm(xx[e]);
            *(uint4*)(sg + (size_t)r * 128 + (ci - 416) * 8) = uint4{pack2(t[0], t[1]), pack2(t[2], t[3]), pack2(t[4], t[5]), pack2(t[6], t[7])};
          }
        }
      }
    }
  }
}

__device__ __forceinline__ void step_r2(const Params& p, char* smem) {
  char* ws = p.ws;
  const int tid = get_tid(), lane = tid & 63, wave = tid >> 6;
  const int wm = wave >> 1, wn = wave & 1;
  const u16* tl = (const u16*)(ws + OFF_TL);
  const u16* sg = (const u16*)(ws + OFF_SG);
  __half* wk = (__half*)(ws + OFF_WK);
  u16* gr = (u16*)(ws + OFF_GR);
  {
    EpiR2 E{wk, p.w0, p.a0};
    run_gemm8(smem, tl, (const u16*)(ws + OFF_W4T), TG, 4096, 256, E);
  }
  for (int t = (gridDim.x - 1 - blockIdx.x) + 4 * 128; t < 5 * 128; t += gridDim.x) {
    int sub = t >> 7, rem = t & 127;
    int mt = rem & 15, nt = rem >> 4;
    f32x4 acc[4][4];
    zero_acc(acc);
    if (sub < 2) {
      gemm_acc(tl + (size_t)mt * 256 * 256 + sub * 64, 256, (const u16*)(ws + OFF_W2T) + sub * 65536 + (size_t)nt * 128 * 64, 64, 64, acc, smem);
    } else if (sub < 4) {
      gemm_acc(tl + (size_t)mt * 256 * 256 + 128 + (sub - 2) * 64, 256, (const u16*)(ws + OFF_A2T) + (sub - 2) * 65536 + (size_t)nt * 128 * 64, 64, 64, acc, smem);
    } else {
      gemm_acc(sg + (size_t)mt * 256 * 128, 128, (const u16*)(ws + OFF_G2T) + (size_t)nt * 128 * 128, 128, 128, acc, smem);
    }
#pragma unroll
    for (int mf = 0; mf < 4; ++mf)
#pragma unroll
      for (int nf = 0; nf < 4; ++nf)
#pragma unroll
        for (int j = 0; j < 4; ++j) {
          if (nf == 0 && j == 0) asm volatile("" ::: "memory");
          int m = mt * 256 + wm * 64 + mf * 16 + (lane >> 4) * 4 + j;
          int n = nt * 128 + wn * 64 + nf * 16 + (lane & 15);
          float v = acc[mf][nf][j];
          if (sub < 2) {
            float wl = v + p.w0[sub * 1024 + n];
            float dec = __expf(-0.6065306597f * sigm(wl));
            wk[((size_t)(m * 16 + (n >> 6)) * 8 + 4 + 2 * sub) * 64 + (n & 63)] = __float2half(dec);
          } else if (sub < 4) {
            int d = sub - 2;
            float a = sigm(v + p.a0[d * 1024 + n]);
            wk[((size_t)(m * 16 + (n >> 6)) * 8 + 5 + 2 * d) * 64 + (n & 63)] = __float2half(a);
          } else {
            gr[(size_t)m * 1024 + n] = f2bf(v);
          }
        }
  }
}

DI int swz16(int row) { return (row ^ (row >> 3)) & 15; }
DI int sw256(int row, int e) { return row * 256 + ((((e >> 3) ^ swz16(row))) << 4) + (e & 7) * 2; }
DI const bf16x8 ldfrag256(const char* base, int row, int ch) {
  return *(const bf16x8*)(base + row * 256 + ((ch ^ swz16(row)) << 4));
}

typedef unsigned v4u __attribute__((ext_vector_type(4)));
struct SsdPre { v4u c0, c1, c2, c3, b0, b1, b2, b3, x0, x1; float d0, d1; };
DI void ssd_issue(const Params& p, int g, int chain, int ci, int tid, SsdPre& R) {
  const int Ls = g < 2 ? 256 : 2048;
  const int nch = Ls >> 7;
  const int d = chain & 1, h = (chain >> 1) & 31, b = chain >> 6;
  const int grp = h >> 3;
  const int c = d ? nch - 1 - ci : ci;
  const int tok0 = b * Ls + c * 128;
  const u16* xbc = (const u16*)(p.ws + OFF_XBC);
  const float* dtb = (const float*)(p.ws + OFF_DT);
  const int lane = tid & 63, wave = tid >> 6;
#define SSD_LDCB(i, CF, BF) { int idx = tid + i * 512; int row = idx >> 4, ch = idx & 15; \
    const u16* src = xbc + (size_t)(tok0 + row) * 3072 + grp * 128 + ch * 8; R.CF = *(const v4u*)(src + 2560); R.BF = *(const v4u*)(src + 2048); }
  SSD_LDCB(0, c0, b0) SSD_LDCB(1, c1, b1) SSD_LDCB(2, c2, b2) SSD_LDCB(3, c3, b3)
#undef SSD_LDCB
#define SSD_LDX(i, XF) { int idx = tid + i * 512; int l = idx >> 3, ch = idx & 7; R.XF = *(const v4u*)(xbc + (size_t)(tok0 + l) * 3072 + h * 64 + ch * 8); }
  SSD_LDX(0, x0) SSD_LDX(1, x1)
#undef SSD_LDX
  if (wave == 0) {
    int e0 = 2 * lane, e1 = 2 * lane + 1;
    int l0 = d ? 127 - e0 : e0, l1 = d ? 127 - e1 : e1;
    R.d0 = dtb[(size_t)(tok0 + l0) * 64 + d * 32 + h];
    R.d1 = dtb[(size_t)(tok0 + l1) * 64 + d * 32 + h];
  }
}

__device__ __forceinline__ void ssd_chain(const Params& p, char* smem, int g, int chain, int next_chain, SsdPre& R) {
  char* ws = p.ws;
  const int tid = get_tid(), lane = tid & 63, wave = tid >> 6;
  const int Ls = g < 2 ? 256 : 2048;
  const int nch = Ls >> 7;
  const int d = chain & 1, h = (chain >> 1) & 31, b = chain >> 6;
  const int grp = h >> 3;
  const u16* xbc = (const u16*)(ws + OFF_XBC);
  const float* dtb = (const float*)(ws + OFF_DT);
  u16* yout = (u16*)(ws + (d ? OFF_SYB : OFF_SYF));
  char* Cs = smem;
  char* Bs = smem + 32768;
  char* BdT = smem + 65536;
  char* XT = smem + 98304;
  char* Ss = smem + 114688;
  float* csum = (float*)(smem + 131072);
  float* dts = (float*)(smem + 131584);
  const float a_h = -__expf(p.a_log[d * 32 + h]);
  const float dtbias = p.dt_bias[d * 32 + h];
  f32x4 sacc[2][2];
  {
    const int wn4 = wave >> 1, wp2 = wave & 1;
#pragma unroll
    for (int nf = 0; nf < 2; ++nf)
#pragma unroll
      for (int pf = 0; pf < 2; ++pf) {
        if (g == 2) {
          const float* h0 = (d ? p.ssm_b : p.ssm_f) + (size_t)(b * 32 + h) * 8192;
          const int n0 = wn4 * 32 + nf * 16 + (lane >> 4) * 4, pp = wp2 * 32 + pf * 16 + (lane & 15);
          const float4 t = *(const float4*)(h0 + pp * 128 + n0);
          sacc[nf][pf] = f32x4{t.x, t.y, t.z, t.w};
        } else {
          sacc[nf][pf] = f32x4{0.f, 0.f, 0.f, 0.f};
        }
      }
  }
  const int tid_outer = tid;
  for (int ci = 0; ci < nch; ++ci) {
    int tidv = tid_outer;
    asm volatile("" : "+v"(tidv));
    const int tid = tidv, lane = tidv & 63, wave = tidv >> 6;
    const int wq4 = wave >> 1, wq2 = wave & 1;
    const int c = d ? nch - 1 - ci : ci;
    const int tok0 = b * Ls + c * 128;
#define SSD_STCB(i, CF, BF) { int idx = tid + i * 512; int row = idx >> 4, ch = idx & 15; \
      *(v4u*)(Cs + row * 256 + ((ch ^ swz16(row)) << 4)) = R.CF; *(v4u*)(Bs + row * 256 + ((ch ^ swz16(row)) << 4)) = R.BF; }
    SSD_STCB(0, c0, b0) SSD_STCB(1, c1, b1) SSD_STCB(2, c2, b2) SSD_STCB(3, c3, b3)
#undef SSD_STCB
#define SSD_STX(i, XF) { int idx = tid + i * 512; int l = idx >> 3, ch = idx & 7; \
      const unsigned w0 = R.XF[0], w1 = R.XF[1], w2 = R.XF[2], w3 = R.XF[3]; \
      *(u16*)(XT + sw256(ch * 8 + 0, l)) = (u16)(w0 & 0xffff); *(u16*)(XT + sw256(ch * 8 + 1, l)) = (u16)(w0 >> 16); \
      *(u16*)(XT + sw256(ch * 8 + 2, l)) = (u16)(w1 & 0xffff); *(u16*)(XT + sw256(ch * 8 + 3, l)) = (u16)(w1 >> 16); \
      *(u16*)(XT + sw256(ch * 8 + 4, l)) = (u16)(w2 & 0xffff); *(u16*)(XT + sw256(ch * 8 + 5, l)) = (u16)(w2 >> 16); \
      *(u16*)(XT + sw256(ch * 8 + 6, l)) = (u16)(w3 & 0xffff); *(u16*)(XT + sw256(ch * 8 + 7, l)) = (u16)(w3 >> 16); }
    SSD_STX(0, x0) SSD_STX(1, x1)
#undef SSD_STX
    if (wave == 0) {
      int e0 = 2 * lane, e1 = 2 * lane + 1;
      int l0 = d ? 127 - e0 : e0, l1 = d ? 127 - e1 : e1;
      float x0 = R.d0 + dtbias;
      float x1 = R.d1 + dtbias;
      float dt0 = x0 > 20.f ? x0 : log1pf(__expf(x0));
      float dt1 = x1 > 20.f ? x1 : log1pf(__expf(x1));
      float a0 = dt0 * a_h, a1 = dt1 * a_h;
      float s = a0 + a1;
#pragma unroll
      for (int o = 1; o < 64; o <<= 1) {
        float t = __shfl_up(s, o);
        if (lane >= o) s += t;
      }
      csum[l1] = s;
      csum[l0] = s - a1;
      dts[l0] = dt0;
      dts[l1] = dt1;
    }
    if (ci + 1 < nch) ssd_issue(p, g, chain, ci + 1, tid, R);
    else if (next_chain >= 0) ssd_issue(p, g, next_chain, 0, tid, R);
#pragma unroll
    for (int nf = 0; nf < 2; ++nf)
#pragma unroll
      for (int pf = 0; pf < 2; ++pf) {
        const int n0 = wq4 * 32 + nf * 16 + (lane >> 4) * 4, pp = wq2 * 32 + pf * 16 + (lane & 15);
        *(uint2*)(Ss + sw256(pp, n0)) = uint2{pack2(sacc[nf][pf][0], sacc[nf][pf][1]), pack2(sacc[nf][pf][2], sacc[nf][pf][3])};
      }
    __syncthreads();
    const float cstot = csum[d ? 0 : 127];
#pragma unroll
    for (int i = 0; i < 4; ++i) {
      int idx = tid + i * 512;
      int l = idx >> 4, ch = idx & 15;
      uint4 bv = *(const uint4*)(Bs + l * 256 + ((ch ^ swz16(l)) << 4));
      float f = dts[l] * __expf(cstot - csum[l]);
      unsigned w[4] = {bv.x, bv.y, bv.z, bv.w};
#pragma unroll
      for (int e = 0; e < 8; ++e) {
        int n = ch * 8 + e;
        float val = bf2f((u16)((w[e >> 1] >> ((e & 1) * 16)) & 0xffff)) * f;
        *(u16*)(BdT + sw256(n, l)) = f2bf(val);
      }
    }
    f32x4 gacc[2][4];
#pragma unroll
    for (int i = 0; i < 2; ++i)
#pragma unroll
      for (int j = 0; j < 4; ++j) gacc[i][j] = f32x4{0.f, 0.f, 0.f, 0.f};
#pragma unroll
    for (int ks = 0; ks < 4; ++ks) {
      int ch = ks * 4 + (lane >> 4);
      bf16x8 a[2], bb[4];
#pragma unroll
      for (int sf = 0; sf < 2; ++sf) a[sf] = ldfrag256(Bs, wq4 * 32 + sf * 16 + (lane & 15), ch);
#pragma unroll
      for (int lf = 0; lf < 4; ++lf) bb[lf] = ldfrag256(Cs, wq2 * 64 + lf * 16 + (lane & 15), ch);
#pragma unroll
      for (int sf = 0; sf < 2; ++sf)
#pragma unroll
        for (int lf = 0; lf < 4; ++lf)
          gacc[sf][lf] = __builtin_amdgcn_mfma_f32_16x16x32_bf16(a[sf], bb[lf], gacc[sf][lf], 0, 0, 0);
    }
    {
      float css[2][4], dss[2][4];
#pragma unroll
      for (int sf = 0; sf < 2; ++sf)
#pragma unroll
        for (int j = 0; j < 4; ++j) {
          const int sI = wq4 * 32 + sf * 16 + (lane >> 4) * 4 + j;
          css[sf][j] = csum[sI];
          dss[sf][j] = dts[sI];
        }
#pragma unroll
      for (int lf = 0; lf < 4; ++lf) {
        const int l = wq2 * 64 + lf * 16 + (lane & 15);
        const float csl = csum[l];
#pragma unroll
        for (int sf = 0; sf < 2; ++sf)
#pragma unroll
          for (int j = 0; j < 4; ++j) {
            const int sI = wq4 * 32 + sf * 16 + (lane >> 4) * 4 + j;
            const bool valid = d ? (sI >= l) : (sI <= l);
            const float e = valid ? __expf(csl - css[sf][j]) * dss[sf][j] : 0.f;
            gacc[sf][lf][j] *= e;
          }
      }
    }
    __syncthreads();
#pragma unroll
    for (int sf = 0; sf < 2; ++sf)
#pragma unroll
      for (int lf = 0; lf < 4; ++lf) {
        const int s0 = wq4 * 32 + sf * 16 + (lane >> 4) * 4, l = wq2 * 64 + lf * 16 + (lane & 15);
        *(uint2*)(Bs + sw256(l, s0)) = uint2{pack2(gacc[sf][lf][0], gacc[sf][lf][1]), pack2(gacc[sf][lf][2], gacc[sf][lf][3])};
      }
    __syncthreads();
    {
      f32x4 yacc[2][2];
#pragma unroll
      for (int i = 0; i < 2; ++i)
#pragma unroll
        for (int j = 0; j < 2; ++j) yacc[i][j] = f32x4{0.f, 0.f, 0.f, 0.f};
#pragma unroll
      for (int ks = 0; ks < 4; ++ks) {
        int ch = ks * 4 + (lane >> 4);
        bf16x8 a[2], bb[2];
#pragma unroll
        for (int pf = 0; pf < 2; ++pf) a[pf] = ldfrag256(Ss, wq2 * 32 + pf * 16 + (lane & 15), ch);
#pragma unroll
        for (int lf = 0; lf < 2; ++lf) bb[lf] = ldfrag256(Cs, wq4 * 32 + lf * 16 + (lane & 15), ch);
#pragma unroll
        for (int pf = 0; pf < 2; ++pf)
#pragma unroll
          for (int lf = 0; lf < 2; ++lf)
            yacc[pf][lf] = __builtin_amdgcn_mfma_f32_16x16x32_bf16(a[pf], bb[lf], yacc[pf][lf], 0, 0, 0);
      }
#pragma unroll
      for (int lf = 0; lf < 2; ++lf) {
        const float e = __expf(csum[wq4 * 32 + lf * 16 + (lane & 15)]);
#pragma unroll
        for (int pf = 0; pf < 2; ++pf) yacc[pf][lf] *= e;
      }
#pragma unroll
      for (int ks = 0; ks < 4; ++ks) {
        int ch = ks * 4 + (lane >> 4);
        bf16x8 a[2], bb[2];
#pragma unroll
        for (int pf = 0; pf < 2; ++pf) a[pf] = ldfrag256(XT, wq2 * 32 + pf * 16 + (lane & 15), ch);
#pragma unroll
        for (int lf = 0; lf < 2; ++lf) bb[lf] = ldfrag256(Bs, wq4 * 32 + lf * 16 + (lane & 15), ch);
#pragma unroll
        for (int pf = 0; pf < 2; ++pf)
#pragma unroll
          for (int lf = 0; lf < 2; ++lf)
            yacc[pf][lf] = __builtin_amdgcn_mfma_f32_16x16x32_bf16(a[pf], bb[lf], yacc[pf][lf], 0, 0, 0);
      }
#pragma unroll
      for (int pf = 0; pf < 2; ++pf)
#pragma unroll
        for (int lf = 0; lf < 2; ++lf) {
          const int p0 = wq2 * 32 + pf * 16 + (lane >> 4) * 4, l = wq4 * 32 + lf * 16 + (lane & 15);
          *(uint2*)(yout + (size_t)(tok0 + l) * 2048 + h * 64 + p0) = uint2{pack2(yacc[pf][lf][0], yacc[pf][lf][1]), pack2(yacc[pf][lf][2], yacc[pf][lf][3])};
        }
    }
    {
      float e = __expf(cstot);
#pragma unroll
      for (int nf = 0; nf < 2; ++nf)
#pragma unroll
        for (int pf = 0; pf < 2; ++pf) sacc[nf][pf] *= e;
#pragma unroll
      for (int ks = 0; ks < 4; ++ks) {
        int ch = ks * 4 + (lane >> 4);
        bf16x8 a[2], bb[2];
#pragma unroll
        for (int nf = 0; nf < 2; ++nf) a[nf] = ldfrag256(BdT, wq4 * 32 + nf * 16 + (lane & 15), ch);
#pragma unroll
        for (int pf = 0; pf < 2; ++pf) bb[pf] = ldfrag256(XT, wq2 * 32 + pf * 16 + (lane & 15), ch);
#pragma unroll
        for (int nf = 0; nf < 2; ++nf)
#pragma unroll
          for (int pf = 0; pf < 2; ++pf)
            sacc[nf][pf] = __builtin_amdgcn_mfma_f32_16x16x32_bf16(a[nf], bb[pf], sacc[nf][pf], 0, 0, 0);
      }
    }
    __syncthreads();
  }
  if (g < 2) {
    float* so = p.out + (d ? OUT_SSMB : OUT_SSMF) + (size_t)((g * 16 + b) * 32 + h) * 8192;
    const int wn4 = wave >> 1, wp2 = wave & 1;
#pragma unroll
    for (int nf = 0; nf < 2; ++nf)
#pragma unroll
      for (int pf = 0; pf < 2; ++pf) {
        const int n0 = wn4 * 32 + nf * 16 + (lane >> 4) * 4, pp = wp2 * 32 + pf * 16 + (lane & 15);
        *(float4*)(so + pp * 128 + n0) = float4{sacc[nf][pf][0], sacc[nf][pf][1], sacc[nf][pf][2], sacc[nf][pf][3]};
      }
  }
}


template <bool SEG>
__device__ __forceinline__ void wkv_pair(const Params& p, char* smem, int g, int item) {
  char* ws = p.ws;
  const int tid = get_tid(), lane = tid & 63, wave = tid >> 6;
  const int Ls = SEG ? 2048 : 256;
  const __half* wk = (const __half*)(ws + OFF_WK);
  float* stage = (float*)smem;
  float* ylds = (float*)(smem + 98304);
  const bool cw = true;
  const int slot = wave >> 2, wq = wave & 3;
  const int ig = lane >> 3, jg = lane & 7;
  const int row0 = wq * 16 + ig * 2;
  const int chain = SEG ? (item >> 3) : item * 2 + slot;
  const int seg = SEG ? (item & 7) : 0;
  const bool act = cw && (SEG ? !(slot == 1 && seg == 0) : true);
  const int d = chain & 1, h = (chain >> 1) & 15, b = chain >> 5;
  typedef float f2 __attribute__((ext_vector_type(2)));
  f2 S[2][4];
#pragma unroll
  for (int rr = 0; rr < 2; ++rr) {
    if (SEG) {
      if (slot == 0) {
        if (seg == 0) {
          const float* s0 = (d ? p.wkv_b : p.wkv_f) + ((size_t)(b * 16 + h) * 64 + row0 + rr) * 64 + jg * 8;
#pragma unroll
          for (int c = 0; c < 4; ++c) S[rr][c] = f2{s0[2 * c], s0[2 * c + 1]};
        } else {
#pragma unroll
          for (int c = 0; c < 4; ++c) S[rr][c] = f2{0.f, 0.f};
        }
      } else {
#pragma unroll
        for (int c = 0; c < 4; ++c) S[rr][c] = f2{(row0 + rr == jg * 8 + 2 * c) ? 1.f : 0.f, (row0 + rr == jg * 8 + 2 * c + 1) ? 1.f : 0.f};
      }
    } else {
#pragma unroll
      for (int c = 0; c < 4; ++c) S[rr][c] = f2{0.f, 0.f};
    }
  }
  const int pair = tid >> 4, lslot = pair >> 4, lstep = pair & 15, sub = tid & 15;
  const int lch = SEG ? (item >> 3) : item * 2 + lslot;
  const int ld = lch & 1, lh = (lch >> 1) & 15, lb = lch >> 5;
  const bool ldo = SEG ? (lslot == 0) : true;
  const int sbase = seg * 256;
  const int cslot = SEG ? 0 : slot;
  float ka[4];
#pragma unroll
  for (int e = 0; e < 4; ++e) ka[e] = p.k_a[lh * 64 + sub * 4 + e];
  u16* yout;
  if (SEG) yout = lslot == 0 ? (u16*)(ws + (ld ? OFF_WYB : OFF_WYF)) : (u16*)(ws + OFF_YM) + (ld ? (size_t)TG * 1024 : 0);
  else yout = (u16*)(ws + (ld ? OFF_WYB : OFF_WYF));
  const bool ywr = SEG ? (lslot == 0 || seg > 0) : true;
  uint2 rg[6];
  auto prefetch = [&](int tb) {
    int s = sbase + tb * 16 + lstep;
    int pos = ld ? Ls - 1 - s : s;
    int r = lb * Ls + pos;
    const __half* rec = wk + ((size_t)(r * 16 + lh) * 8) * 64 + sub * 4;
    rg[0] = *(const uint2*)(rec + 0 * 64);
    rg[1] = *(const uint2*)(rec + 1 * 64);
    rg[2] = *(const uint2*)(rec + 2 * 64);
    rg[3] = *(const uint2*)(rec + 3 * 64);
    rg[4] = *(const uint2*)(rec + (4 + 2 * ld) * 64);
    rg[5] = *(const uint2*)(rec + (5 + 2 * ld) * 64);
  };
  auto unpack4 = [&](uint2 u, float (&o)[4]) {
    __half2 h0 = *reinterpret_cast<__half2*>(&u.x);
    __half2 h1 = *reinterpret_cast<__half2*>(&u.y);
    float2 f0 = __half22float2(h0), f1 = __half22float2(h1);
    o[0] = f0.x; o[1] = f0.y; o[2] = f1.x; o[3] = f1.y;
  };
  auto stage_store = [&](int buf) {
    float r_[4], v_[4], k_[4], nkk_[4], w_[4], a_[4];
    unpack4(rg[0], r_); unpack4(rg[1], v_); unpack4(rg[2], k_); unpack4(rg[3], nkk_); unpack4(rg[4], w_); unpack4(rg[5], a_);
    float b_[4], kd_[4];
#pragma unroll
    for (int e = 0; e < 4; ++e) {
      b_[e] = -nkk_[e] * a_[e];
      kd_[e] = k_[e] * (1.f + (a_[e] - 1.f) * ka[e]);
    }
    float* dst = stage + ((size_t)((buf * 2 + lslot) * 16 + lstep) * 6) * 64 + sub * 4;
    *(float4*)(dst + 0 * 64) = float4{nkk_[0], nkk_[1], nkk_[2], nkk_[3]};
    *(float4*)(dst + 1 * 64) = float4{w_[0], w_[1], w_[2], w_[3]};
    *(float4*)(dst + 2 * 64) = float4{b_[0], b_[1], b_[2], b_[3]};
    *(float4*)(dst + 3 * 64) = float4{kd_[0], kd_[1], kd_[2], kd_[3]};
    *(float4*)(dst + 4 * 64) = float4{r_[0], r_[1], r_[2], r_[3]};
    *(float4*)(dst + 5 * 64) = float4{v_[0], v_[1], v_[2], v_[3]};
  };
  if (ldo) { prefetch(0); stage_store(0); }
  __syncthreads();
  for (int tb = 0; tb < 16; ++tb) {
    const bool more = tb + 1 < 16;
    if (more && ldo) prefetch(tb + 1);
    if (act) {
      const float* sb = stage + ((size_t)(((tb & 1) * 2 + cslot) * 16) * 6) * 64;
      for (int sg = 0; sg < 8; ++sg) {
        float ysv[2][2];
#pragma unroll
        for (int s4 = 0; s4 < 2; ++s4) {
          const int st = sg * 2 + s4;
          const float* v6 = sb + st * 384 + jg * 8;
          f2 nkk[4], w[4], bb[4], kd[4], rr[4];
#pragma unroll
          for (int q = 0; q < 2; ++q) {
            float4 t0 = *(const float4*)(v6 + 0 * 64 + q * 4);
            nkk[q * 2] = f2{t0.x, t0.y}; nkk[q * 2 + 1] = f2{t0.z, t0.w};
            float4 t1 = *(const float4*)(v6 + 1 * 64 + q * 4);
            w[q * 2] = f2{t1.x, t1.y}; w[q * 2 + 1] = f2{t1.z, t1.w};
            float4 t2 = *(const float4*)(v6 + 2 * 64 + q * 4);
            bb[q * 2] = f2{t2.x, t2.y}; bb[q * 2 + 1] = f2{t2.z, t2.w};
            float4 t3 = *(const float4*)(v6 + 3 * 64 + q * 4);
            kd[q * 2] = f2{t3.x, t3.y}; kd[q * 2 + 1] = f2{t3.z, t3.w};
            float4 t4 = *(const float4*)(v6 + 4 * 64 + q * 4);
            rr[q * 2] = f2{t4.x, t4.y}; rr[q * 2 + 1] = f2{t4.z, t4.w};
          }
          float2 vv2 = *(const float2*)(sb + st * 384 + 5 * 64 + row0);
          float vi[2] = {vv2.x, vv2.y};
          if (SEG && slot == 1) { vi[0] = 0.f; vi[1] = 0.f; }
#pragma unroll
          for (int r2 = 0; r2 < 2; ++r2) {
            f2 sa2a = S[r2][0] * nkk[0], sa2b = S[r2][1] * nkk[1];
            sa2a += S[r2][2] * nkk[2]; sa2b += S[r2][3] * nkk[3];
            f2 sat = sa2a + sa2b;
            float sa = sat.x + sat.y;
            sa += dpp_xor1(sa);
            sa += dpp_xor2(sa);
            sa += dpp_hmirror(sa);
            f2 y2a, y2b;
            {
              f2 t0 = S[r2][0] * w[0] + vi[r2] * kd[0]; S[r2][0] = t0 + sa * bb[0]; y2a = S[r2][0] * rr[0];
              f2 t1 = S[r2][1] * w[1] + vi[r2] * kd[1]; S[r2][1] = t1 + sa * bb[1]; y2b = S[r2][1] * rr[1];
              f2 t2 = S[r2][2] * w[2] + vi[r2] * kd[2]; S[r2][2] = t2 + sa * bb[2]; y2a += S[r2][2] * rr[2];
              f2 t3 = S[r2][3] * w[3] + vi[r2] * kd[3]; S[r2][3] = t3 + sa * bb[3]; y2b += S[r2][3] * rr[3];
            }
            f2 yt = y2a + y2b;
            float y = yt.x + yt.y;
            y += dpp_xor1(y);
            y += dpp_xor2(y);
            y += dpp_hmirror(y);
            ysv[s4][r2] = y;
          }
        }
        if (jg == 0) {
#pragma unroll
          for (int s4 = 0; s4 < 2; ++s4)
            *(float2*)(ylds + (slot * 16 + sg * 2 + s4) * 64 + row0) = float2{ysv[s4][0], ysv[s4][1]};
        }
      }
    }
    __syncthreads();
    if (more && ldo) stage_store((tb + 1) & 1);
    if (ywr) {
      int s = sbase + tb * 16 + lstep;
      int pos = ld ? Ls - 1 - s : s;
      int r = lb * Ls + pos;
      float4 yv = *(const float4*)(ylds + (lslot * 16 + lstep) * 64 + sub * 4);
      *(uint2*)(yout + (size_t)r * 1024 + lh * 64 + sub * 4) = uint2{pack2(yv.x, yv.y), pack2(yv.z, yv.w)};
    }
    __syncthreads();
  }
  if (act) {
#pragma unroll
    for (int r2 = 0; r2 < 2; ++r2) {
      float* so;
      if (SEG) so = p.out + 8388608 + ((size_t)((chain * 8 + seg) * 2 + slot)) * 4096 + (row0 + r2) * 64 + jg * 8;
      else so = p.out + (d ? OUT_WKVB : OUT_WKVF) + ((size_t)((g * 16 + b) * 16 + h) * 64 + row0 + r2) * 64 + jg * 8;
#pragma unroll
      for (int c = 0; c < 4; ++c) { so[2 * c] = S[r2][c].x; so[2 * c + 1] = S[r2][c].y; }
    }
  }
}

__device__ __forceinline__ void wkv_fix(const Params& p, char* smem, int item) {
  const int chain = item >> 2, qt = item & 3;
  char* ws = p.ws;
  const int tid = get_tid(), lane = tid & 63, wave = tid >> 6;
  const int d = chain & 1, h = (chain >> 1) & 15, b = chain >> 5;
  const float* SE = p.out + 8388608;
  u16* yout = (u16*)(ws + (d ? OFF_WYB : OFF_WYF));
  const u16* Q = (const u16*)(ws + OFF_YM) + (d ? (size_t)TG * 1024 : 0);
  float* Pl = (float*)smem;
  float* Sl = (float*)(smem + 16384);
  u16* Ql = (u16*)(smem + 36864);
  const int i = lane;
  float S0[64];
  {
    const float* src = SE + ((size_t)(chain * 8) * 2) * 4096 + i * 64;
#pragma unroll
    for (int j = 0; j < 16; ++j) {
      float4 t = *(const float4*)(src + j * 4);
      S0[j * 4] = t.x; S0[j * 4 + 1] = t.y; S0[j * 4 + 2] = t.z; S0[j * 4 + 3] = t.w;
    }
  }
  for (int k = 1; k < 8; ++k) {
    {
      int tt = qt * 64 + (tid >> 3), ch = tid & 7;
      int s = k * 256 + tt;
      int pos = d ? 2047 - s : s;
      int r = b * 2048 + pos;
      *(uint4*)(Ql + tt * 64 + ch * 8) = *(const uint4*)(Q + (size_t)r * 1024 + h * 64 + ch * 8);
    }
    if (k < 7) {
      const float* src = SE + ((size_t)((chain * 8 + k) * 2 + 1)) * 4096;
#pragma unroll
      for (int e = 0; e < 2; ++e) ((float4*)Pl)[tid + e * 512] = ((const float4*)src)[tid + e * 512];
    }
    __syncthreads();
    for (int n = 0; n < 8; ++n) {
      int tt = qt * 64 + wave + n * 8;
      float a0 = 0.f, a1 = 0.f;
#pragma unroll
      for (int jc = 0; jc < 8; ++jc) {
        float q[8];
        unpack8(*(const uint4*)(Ql + tt * 64 + jc * 8), q);
#pragma unroll
        for (int e = 0; e < 8; e += 2) { a0 += S0[jc * 8 + e] * q[e]; a1 += S0[jc * 8 + e + 1] * q[e + 1]; }
      }
      int s = k * 256 + tt;
      int pos = d ? 2047 - s : s;
      size_t off = (size_t)(b * 2048 + pos) * 1024 + h * 64 + i;
      yout[off] = f2bf(bf2f(yout[off]) + (a0 + a1));
    }
    if (k < 7) {
      float nv[8];
      const float* sl = SE + ((size_t)((chain * 8 + k) * 2)) * 4096 + i * 64 + wave * 8;
      {
        float4 t0 = *(const float4*)sl, t1 = *(const float4*)(sl + 4);
        nv[0] = t0.x; nv[1] = t0.y; nv[2] = t0.z; nv[3] = t0.w; nv[4] = t1.x; nv[5] = t1.y; nv[6] = t1.z; nv[7] = t1.w;
      }
#pragma unroll
      for (int m = 0; m < 64; ++m) {
        float4 p0 = *(const float4*)(Pl + m * 64 + wave * 8), p1 = *(const float4*)(Pl + m * 64 + wave * 8 + 4);
        nv[0] += S0[m] * p0.x; nv[1] += S0[m] * p0.y; nv[2] += S0[m] * p0.z; nv[3] += S0[m] * p0.w;
        nv[4] += S0[m] * p1.x; nv[5] += S0[m] * p1.y; nv[6] += S0[m] * p1.z; nv[7] += S0[m] * p1.w;
      }
      *(float4*)(Sl + i * 68 + wave * 8) = float4{nv[0], nv[1], nv[2], nv[3]};
      *(float4*)(Sl + i * 68 + wave * 8 + 4) = float4{nv[4], nv[5], nv[6], nv[7]};
      __syncthreads();
#pragma unroll
      for (int j = 0; j < 16; ++j) {
        float4 t = *(const float4*)(Sl + i * 68 + j * 4);
        S0[j * 4] = t.x; S0[j * 4 + 1] = t.y; S0[j * 4 + 2] = t.z; S0[j * 4 + 3] = t.w;
      }
    }
    __syncthreads();
  }
}

__device__ __forceinline__ void step_scan(const Params& p, char* smem, int g, int parts) {
  const int G = gridDim.x;
  const int r1 = (parts & 1) ? ((RM & (1 << 20)) ? 2 : 1) : 0, r2 = (parts & 2) ? ((RM & (1 << 21)) ? 2 : 1) : 0;
  if (g < 2) {
    for (int rr = 0; rr < r1; ++rr) {
      SsdPre R;
      if ((int)blockIdx.x < 1024) ssd_issue(p, g, blockIdx.x, 0, get_tid(), R);
      for (int ch = blockIdx.x; ch < 1024; ch += G) ssd_chain(p, smem, g, ch, ch + G < 1024 ? ch + G : -1, R);
    }
    for (int rr = 0; rr < r2; ++rr) for (int it = blockIdx.x; it < 256; it += G) wkv_pair<false>(p, smem, g, it);
  } else {
    for (int rr = 0; rr < r1; ++rr) {
      SsdPre R;
      if ((int)blockIdx.x < 128) ssd_issue(p, g, blockIdx.x, 0, get_tid(), R);
      for (int ch = blockIdx.x; ch < 128; ch += G) ssd_chain(p, smem, g, ch, ch + G < 128 ? ch + G : -1, R);
    }
    for (int rr = 0; rr < r2; ++rr) for (int it = (G - 1 - blockIdx.x); it < 512; it += G) wkv_pair<true>(p, smem, g, it);
  }
}
__device__ __forceinline__ void step_fix(const Params& p, char* smem) {
  for (int it = blockIdx.x; it < 256; it += gridDim.x) wkv_fix(p, smem, it);
}

__device__ __forceinline__ void step_fin(const Params& p, int g) {
  char* ws = p.ws;
  const int tid = get_tid(), lane = tid & 63, wave = tid >> 6;
  const int gw = blockIdx.x * 8 + wave, nw = gridDim.x * 8;
  {
    const u16* yf = (const u16*)(ws + OFF_SYF);
    const u16* yb = (const u16*)(ws + OFF_SYB);
    const u16* xbc = (const u16*)(ws + OFF_XBC);
    const u16* zb = (const u16*)(ws + OFF_Z);
    u16* ym = (u16*)(ws + OFF_YM);
    for (int it = gw; it < TG * 4; it += nw) {
      int r = it >> 2, gq = it & 3;
      int ch = gq * 512 + lane * 8;
      uint4 a = *(const uint4*)(yf + (size_t)r * 2048 + ch);
      uint4 b = *(const uint4*)(yb + (size_t)r * 2048 + ch);
      uint4 x = *(const uint4*)(xbc + (size_t)r * 3072 + ch);
      uint4 z = *(const uint4*)(zb + (size_t)r * 2048 + ch);
      float dsk = p.d_skip[ch >> 6];
      unsigned aw[4] = {a.x, a.y, a.z, a.w}, bw[4] = {b.x, b.y, b.z, b.w}, xw[4] = {x.x, x.y, x.z, x.w}, zw[4] = {z.x, z.y, z.z, z.w};
      float y[8];
      float ss = 0.f;
#pragma unroll
      for (int e = 0; e < 8; ++e) {
        int sh = (e & 1) * 16;
        float yy = bf2f((u16)(aw[e >> 1] >> sh)) + bf2f((u16)(bw[e >> 1] >> sh)) + dsk * bf2f((u16)(xw[e >> 1] >> sh));
        yy *= siluf(bf2f((u16)(zw[e >> 1] >> sh)));
        y[e] = yy;
        ss += yy * yy;
      }
      ss = wave_sum(ss);
      float rinv = rsqrtf(ss * (1.f / 512.f) + 1e-5f);
      float4 w0 = *(const float4*)(p.m_norm_w + ch), w1 = *(const float4*)(p.m_norm_w + ch + 4);
      *(uint4*)(ym + (size_t)r * 2048 + ch) =
          uint4{pack2(y[0] * rinv * w0.x, y[1] * rinv * w0.y), pack2(y[2] * rinv * w0.z, y[3] * rinv * w0.w),
                pack2(y[4] * rinv * w1.x, y[5] * rinv * w1.y), pack2(y[6] * rinv * w1.z, y[7] * rinv * w1.w)};
    }
  }
  {
    const u16* __restrict__ yf = (const u16*)(ws + OFF_WYF);
    const u16* __restrict__ yb = (const u16*)(ws + OFF_WYB);
    const __half* __restrict__ wk = (const __half*)(ws + OFF_WK);
    const u16* __restrict__ gr = (const u16*)(ws + OFF_GR);
    u16* __restrict__ yr = (u16*)(ws + OFF_YR);
    for (int it = gw; it < TG * 2; it += nw) {
      const int r = it >> 1, hh = it & 1;
      const int c0 = hh * 512 + lane * 8;
      const int head = c0 >> 6;
      const uint4 a = *(const uint4*)(yf + (size_t)r * 1024 + c0);
      const uint4 b = *(const uint4*)(yb + (size_t)r * 1024 + c0);
      const uint4 gq = *(const uint4*)(gr + (size_t)r * 1024 + c0);
      const __half* rec = wk + ((size_t)(r * 16 + head) * 8) * 64 + (lane & 7) * 8;
      const uint4 qr = *(const uint4*)(rec + 0 * 64), qv = *(const uint4*)(rec + 1 * 64), qk = *(const uint4*)(rec + 2 * 64);
      const uint4 qaf = *(const uint4*)(rec + 5 * 64), qab = *(const uint4*)(rec + 7 * 64);
      const float4 lw0 = *(const float4*)(p.lnx_w + c0), lw1 = *(const float4*)(p.lnx_w + c0 + 4);
      const float4 lb0 = *(const float4*)(p.lnx_b + c0), lb1 = *(const float4*)(p.lnx_b + c0 + 4);
      const float4 ka0 = *(const float4*)(p.k_a + c0), ka1 = *(const float4*)(p.k_a + c0 + 4);
      const float4 rk0 = *(const float4*)(p.r_k + c0), rk1 = *(const float4*)(p.r_k + c0 + 4);
      const float lw[8] = {lw0.x, lw0.y, lw0.z, lw0.w, lw1.x, lw1.y, lw1.z, lw1.w};
      const float lb[8] = {lb0.x, lb0.y, lb0.z, lb0.w, lb1.x, lb1.y, lb1.z, lb1.w};
      const float kav[8] = {ka0.x, ka0.y, ka0.z, ka0.w, ka1.x, ka1.y, ka1.z, ka1.w};
      const float rkv[8] = {rk0.x, rk0.y, rk0.z, rk0.w, rk1.x, rk1.y, rk1.z, rk1.w};
      float ya[8], yb8[8], gg[8];
      unpack8(a, ya); unpack8(b, yb8); unpack8(gq, gg);
      auto unph = [&](const uint4& u, float (&o)[8]) {
        const __half2* hp = reinterpret_cast<const __half2*>(&u);
#pragma unroll
        for (int e = 0; e < 4; ++e) { float2 f = __half22float2(hp[e]); o[2 * e] = f.x; o[2 * e + 1] = f.y; }
      };
      float rr[8], vv[8], kk[8], af[8], ab[8];
      unph(qr, rr); unph(qv, vv); unph(qk, kk); unph(qaf, af); unph(qab, ab);
      float y[8];
      float s1 = 0.f;
#pragma unroll
      for (int e = 0; e < 8; ++e) { y[e] = ya[e] + yb8[e]; s1 += y[e]; }
      s1 += dpp_xor1(s1); s1 += dpp_xor2(s1); s1 += dpp_hmirror(s1);
      const float mean = s1 * (1.f / 64.f);
      float s2 = 0.f, s3 = 0.f;
#pragma unroll
      for (int e = 0; e < 8; ++e) {
        const float dy = y[e] - mean;
        s2 += dy * dy;
        const float kmean = kk[e] * (1.f + (0.5f * (af[e] + ab[e]) - 1.f) * kav[e]);
        s3 += rr[e] * kmean * rkv[e];
      }
      s2 += dpp_xor1(s2); s2 += dpp_xor2(s2); s2 += dpp_hmirror(s2);
      s3 += dpp_xor1(s3); s3 += dpp_xor2(s3); s3 += dpp_hmirror(s3);
      const float rs = rsqrtf(s2 * (1.f / 64.f) + 64e-5f);
      float o[8];
#pragma unroll
      for (int e = 0; e < 8; ++e) o[e] = ((y[e] - mean) * rs * lw[e] + lb[e] + s3 * vv[e]) * gg[e];
      *(uint4*)(yr + (size_t)r * 1024 + c0) = uint4{pack2(o[0], o[1]), pack2(o[2], o[3]), pack2(o[4], o[5]), pack2(o[6], o[7])};
    }
  }
}

__device__ __forceinline__ void step_outproj(const Params& p, char* smem, int g) {
  char* ws = p.ws;
  const int sub = blockIdx.x >> 6, vb = blockIdx.x & 63;
  if (sub < 3) {
    const u16* A = sub == 2 ? (const u16*)(ws + OFF_YR) : (const u16*)(ws + OFF_YM) + sub * 1024;
    const u16* B = sub == 2 ? (const u16*)(ws + OFF_WROUT) : (const u16*)(ws + OFF_WMOUT) + sub * 1024;
    EpiOutV E{(const u16*)(ws + OFF_GATE), (u16*)(ws + OFF_XBC) + (size_t)sub * TG * 1024, sub == 2 ? 1024 : 0};
    run_gemm8(smem, A, B, TG, 1024, 1024, E, vb, 64, 0, sub == 2 ? 1024 : 2048);
  }
}
__device__ __forceinline__ void step_sum(const Params& p, int g) {
  const u16* __restrict__ V = (const u16*)(p.ws + OFF_XBC);
  u16* __restrict__ U = (u16*)p.out + (size_t)g * TG * 1024;
  const int tid = get_tid();
  for (int i = blockIdx.x * NTHR + tid; i < TG * 128; i += gridDim.x * NTHR) {
    float a[8], b[8], c[8];
    unpack8(*(const uint4*)(V + (size_t)i * 8), a);
    unpack8(*(const uint4*)(V + (size_t)TG * 1024 + (size_t)i * 8), b);
    unpack8(*(const uint4*)(V + (size_t)2 * TG * 1024 + (size_t)i * 8), c);
    *(uint4*)(U + (size_t)i * 8) = uint4{pack2(a[0] + b[0] + c[0], a[1] + b[1] + c[1]), pack2(a[2] + b[2] + c[2], a[3] + b[3] + c[3]),
                                         pack2(a[4] + b[4] + c[4], a[5] + b[5] + c[5]), pack2(a[6] + b[6] + c[6], a[7] + b[7] + c[7])};
  }
}

__device__ __forceinline__ void step_wo(const Params& p, char* smem, int g) {
  char* ws = p.ws;
  EpiWo E{p.x_prompt, p.x_sample, (const float*)(ws + OFF_MOD), (float*)(ws + OFF_X1), 0};
  run_gemm8(smem, (const u16*)p.out, (const u16*)(ws + OFF_WO), NTOK, 1024, 1024, E);
}

__device__ __forceinline__ void step_gu(const Params& p, char* smem) {
  char* ws = p.ws;
  EpiGU E{(u16*)(ws + OFF_ACT)};
  run_gemm8(smem, (const u16*)(ws + OFF_H2), (const u16*)(ws + OFF_WGU), NTOK, 5632, 1024, E);
}

__device__ __forceinline__ void step_down(const Params& p, char* smem) {
  char* ws = p.ws;
  EpiDown E{(const float*)(ws + OFF_MOD), (float*)(ws + OFF_X1)};
  run_gemm8(smem, (const u16*)(ws + OFF_ACT), (const u16*)(ws + OFF_WDOWN), NTOK, 1024, 2816, E, -1, 0, 1);
}

__device__ __forceinline__ void step_final(const Params& p) {
  const int tid = get_tid(), lane = tid & 63, wave = tid >> 6;
  for (int r = blockIdx.x * 8 + wave; r < NTOK; r += gridDim.x * 8) {
    const float* xr = (const float*)(p.ws + OFF_X1) + (size_t)r * 1024;
    float* xo = p.out + (size_t)r * 1024;
    float4 v[4];
    float ss = 0.f;
#pragma unroll
    for (int i = 0; i < 4; ++i) {
      v[i] = ((const float4*)xr)[i * 64 + lane];
      ss += v[i].x * v[i].x + v[i].y * v[i].y + v[i].z * v[i].z + v[i].w * v[i].w;
    }
    ss = wave_sum(ss);
    float rinv = rsqrtf(ss * (1.f / 1024.f) + 1e-6f);
#pragma unroll
    for (int i = 0; i < 4; ++i) {
      float4 w4 = ((const float4*)p.final_norm_w)[i * 64 + lane];
      ((float4*)xo)[i * 64 + lane] = float4{v[i].x * rinv * w4.x, v[i].y * rinv * w4.y, v[i].z * rinv * w4.z, v[i].w * rinv * w4.w};
    }
  }
}

constexpr int NSTEPS = 33;

__global__ void __launch_bounds__(NTHR) mega(Params p_arg) {
  const int step_lo = p_arg.step_lo, step_hi = p_arg.step_hi;
  __shared__ __attribute__((aligned(16))) char smem[SMEM_BYTES];
#if !MULTI_LAUNCH
  if (threadIdx.x == 0) *(uint4*)(smem + SMEM_BYTES - 16) = uint4{0u, 0u, 0u, 0u};
  __syncthreads();
  XcdBarrier xb = xcd_barrier_post((unsigned*)(p_arg.ws + OFF_BAR), (volatile LAS unsigned*)(smem + SMEM_BYTES - 16));
#endif
  for (int step = step_lo; step <= step_hi; ++step) {
#if defined(__HIP_DEVICE_COMPILE__)
    const __attribute__((address_space(4))) Params* pp = (const __attribute__((address_space(4))) Params*)__builtin_amdgcn_kernarg_segment_ptr();
    asm volatile("" : "+s"(pp));
    const Params p = *pp;
#else
    const Params p = p_arg;
#endif
    const int g = (step - 1) / 9, s = (step - 1) - g * 9;
    const int scode = step == 0 ? 0 : (step <= 27 ? 1 + s : step - 18);
    if (scode == 6 && g < 2) continue;
    if (scode == 1 && g > 0) continue;
    if (scode == 9 && g < 2) continue;
    const int reps = ((RM >> scode) & 1) ? 2 : 1;
    for (int rep = 0; rep < reps; ++rep) {
      if (!((SM >> scode) & 1)) continue;
      switch (scode) {
        case 0: step_prep(p, smem); break;
        case 1: step_norm<0>(p, g); break;
        case 2: step_gemm1(p, smem, 0); if (g > 0) step_sum(p, g - 1); break;
        case 3: step_cr1(p, g); break;
        case 4: step_r2(p, smem); if (g == 2) step_scan(p, smem, g, 1); break;
        case 5: step_scan(p, smem, g, g == 2 ? 2 : 3); break;
        case 6: step_fix(p, smem); break;
        case 7: step_fin(p, g); if (g < 2) step_norm<0>(p, g + 1); break;
        case 8:
          step_outproj(p, smem, g);
          if (g == 0 && blockIdx.x >= 192) {
            convT<1>(p.w_gu, 1024, 5632, (u16*)(p.ws + OFF_WGU), smem, blockIdx.x - 192, gridDim.x - 192);
            convT<2>(p.w_down, 2816, 1024, (u16*)(p.ws + OFF_WDOWN), smem, blockIdx.x - 192, gridDim.x - 192);
          }
          break;
        case 9: step_sum(p, g); break;
        case 10: step_wo(p, smem, 0); break;
        case 11: step_norm<1>(p, 0); break;
        case 12: step_gu(p, smem); break;
        case 13: if (reps == 2 && rep == 0) { Params q = p; q.out = (float*)(p.ws + (size_t)150000000); step_down(q, smem); } else step_down(p, smem); break;
        default: step_final(p); break;
      }
    }
    if (step < step_hi) {
#if !MULTI_LAUNCH
      if (step_hi > 100000) cg::this_grid().sync();
      for (int xs = 0; xs < 1 + XSYNC; ++xs) xcd_barrier(xb);
#endif
    }
  }
}

extern "C" void kernel_launch(void* const* d_in, const int* in_sizes, int n_in, void* d_out, int out_size,
                              void* d_ws, size_t ws_size, hipStream_t stream) {
  Params p{};
  const float** pp = (const float**)&p;
  for (int i = 0; i < 36; ++i) pp[i] = (const float*)d_in[i];
  p.out = (float*)d_out;
  p.ws = (char*)d_ws;
  if (ws_size < WS_NEED) fprintf(stderr, "workspace too small: %zu < %zu\n", ws_size, (size_t)WS_NEED);
#if MULTI_LAUNCH
  for (int s = 0; s < NSTEPS; ++s) {
    p.step_lo = s;
    p.step_hi = s;
    hipLaunchKernelGGL(mega, dim3(256), dim3(NTHR), 0, stream, p);
  }
#else
  static int grid_blocks = 0;
  if (!grid_blocks) {
    int dev = 0, cus = 0, per_cu = 0;
    hipGetDevice(&dev);
    hipDeviceGetAttribute(&cus, hipDeviceAttributeMultiprocessorCount, dev);
    hipOccupancyMaxActiveBlocksPerMultiprocessor(&per_cu, mega, NTHR, 0);
    if (per_cu < 1) per_cu = 1;
    if (per_cu > 1) per_cu = 1;
    grid_blocks = cus * per_cu;
  }
  p.step_lo = 0;
  p.step_hi = NSTEPS - 1;
  void* args[] = {&p};
  hipMemsetAsync((char*)d_ws + OFF_BAR, 0, XCD_BAR_WORDS_C * 4, stream);
  hipError_t e = hipLaunchCooperativeKernel((void*)mega, dim3(grid_blocks), dim3(NTHR), args, 0, stream);
  if (e != hipSuccess) fprintf(stderr, "cooperative launch failed: %s (grid %d)\n", hipGetErrorString(e), grid_blocks);
#endif
}
```

```cpp
#include <hip/hip_runtime.h>
#include <hip/hip_cooperative_groups.h>
#include <hip/hip_fp16.h>
#include <cstdio>
#include <cstdint>
namespace cg = cooperative_groups;

#ifndef MULTI_LAUNCH
#define MULTI_LAUNCH 0
#endif

#define DI __device__ __forceinline__
typedef __attribute__((ext_vector_type(8))) short bf16x8;
typedef __attribute__((ext_vector_type(4))) float f32x4;
typedef unsigned short u16;

#ifndef STEP_MASK
#define STEP_MASK 0xffffff
#endif
constexpr int SM = STEP_MASK;
#ifndef REPEAT_MASK
#define REPEAT_MASK 0
#endif
#ifndef XSYNC
#define XSYNC 0
#endif
constexpr int RM = REPEAT_MASK;
constexpr int TG = 4096;
constexpr int NTOK = 12288;
constexpr int NPAD = 10752;
constexpr int NTHR = 512;
constexpr int SMEM_BYTES = 133120;
constexpr int XCD_BAR_WORDS_C = 3456;

constexpr size_t OFF_WIN = 0;
constexpr size_t OFF_WGU = OFF_WIN + (size_t)NPAD * 1024 * 2;
constexpr size_t OFF_WDOWN = OFF_WGU + (size_t)5632 * 1024 * 2;
constexpr size_t OFF_WMOUT = OFF_WDOWN + (size_t)1024 * 2816 * 2;
constexpr size_t OFF_WROUT = OFF_WMOUT + (size_t)1024 * 2048 * 2;
constexpr size_t OFF_WO = OFF_WROUT + (size_t)1024 * 1024 * 2;
constexpr size_t OFF_W2T = OFF_WO + (size_t)1024 * 1024 * 2;
constexpr size_t OFF_A2T = OFF_W2T + 262144;
constexpr size_t OFF_G2T = OFF_A2T + 262144;
constexpr size_t OFF_MOD = OFF_G2T + 262144;
constexpr size_t OFF_GRP = OFF_MOD + 73728;
constexpr size_t OFF_Z = OFF_GRP;
constexpr size_t OFF_GATE = OFF_Z + (size_t)TG * 2048 * 2;
constexpr size_t OFF_XBC = OFF_GATE + (size_t)TG * 2048 * 2;
constexpr size_t OFF_WK = OFF_XBC + (size_t)TG * 3072 * 2;
constexpr size_t OFF_GR = OFF_WK + (size_t)TG * 16 * 1024;
constexpr size_t OFF_DT = OFF_GR + (size_t)TG * 1024 * 2;
constexpr size_t OFF_TL = OFF_DT + (size_t)TG * 64 * 4;
constexpr size_t OFF_SG = OFF_TL + (size_t)TG * 256 * 2;
constexpr size_t OFF_R = OFF_SG + (size_t)TG * 128 * 2;
constexpr size_t OFF_H1 = OFF_R;
constexpr size_t OFF_XBCRAW = OFF_H1 + (size_t)TG * 1024 * 2;
constexpr size_t OFF_RW = OFF_XBCRAW + (size_t)TG * 3072 * 2;
constexpr size_t OFF_SYF = OFF_R;
constexpr size_t OFF_SYB = OFF_SYF + (size_t)TG * 2048 * 2;
constexpr size_t OFF_WYF = OFF_SYB + (size_t)TG * 2048 * 2;
constexpr size_t OFF_WYB = OFF_WYF + (size_t)TG * 1024 * 2;
constexpr size_t OFF_YM = OFF_WYB + (size_t)TG * 1024 * 2;
constexpr size_t OFF_YR = OFF_YM + (size_t)TG * 2048 * 2;
constexpr size_t OFF_END = OFF_YR + (size_t)TG * 1024 * 2;
constexpr size_t OFF_BAR = OFF_END;
constexpr size_t OFF_W4T = OFF_BAR + 16384;
constexpr size_t WS_NEED = OFF_W4T + (size_t)4096 * 256 * 2;
constexpr size_t OFF_U = OFF_XBC;
constexpr size_t OFF_H2 = OFF_GRP;
constexpr size_t OFF_ACT = OFF_H2 + (size_t)NTOK * 1024 * 2;
constexpr size_t H1_OUT_OFF = 25165824;
constexpr size_t OFF_X1 = OFF_ACT + (size_t)NTOK * 2816 * 2;

constexpr size_t OUT_SSMF = 12582912;
constexpr size_t OUT_SSMB = OUT_SSMF + 8388608;
constexpr size_t OUT_WKVF = OUT_SSMB + 8388608;
constexpr size_t OUT_WKVB = OUT_WKVF + 2097152;

struct Params {
  const float *x_prompt, *x_sample, *ssm_f, *ssm_b, *wkv_f, *wkv_b, *c, *c_ctx, *norm1_w, *norm2_w,
      *w_ada, *b_ada, *w_in, *conv_w, *conv_b, *dt_bias, *a_log, *d_skip, *m_norm_w, *mu_shift, *w0,
      *w2, *a0, *a2, *g2, *k_k, *k_a, *r_k, *lnx_w, *lnx_b, *w_m_out, *w_r_out, *w_o, *w_gu, *w_down,
      *final_norm_w;
  float* out;
  char* ws;
  int step_lo, step_hi;
};

DI int get_tid() {
  int t = threadIdx.x;
  asm volatile("" : "+v"(t));
  return t;
}
DI u16 f2bf(float f) {
  unsigned u = __float_as_uint(f);
  u += 0x7fffu + ((u >> 16) & 1u);
  return (u16)(u >> 16);
}
DI float bf2f(u16 h) { return __uint_as_float(((unsigned)h) << 16); }
DI float siluf(float x) { return x / (1.f + __expf(-x)); }
DI float sigm(float x) { return 1.f / (1.f + __expf(-x)); }
DI float wave_sum(float v) {
  v += __int_as_float(__builtin_amdgcn_update_dpp(0, __float_as_int(v), 0xB1, 0xF, 0xF, true));
  v += __int_as_float(__builtin_amdgcn_update_dpp(0, __float_as_int(v), 0x4E, 0xF, 0xF, true));
  v += __int_as_float(__builtin_amdgcn_update_dpp(0, __float_as_int(v), 0x141, 0xF, 0xF, true));
  v += __int_as_float(__builtin_amdgcn_update_dpp(0, __float_as_int(v), 0x140, 0xF, 0xF, true));
  const int vi = __float_as_int(v);
  float a = __int_as_float(__builtin_amdgcn_readlane(vi, 0)), b = __int_as_float(__builtin_amdgcn_readlane(vi, 16));
  float c = __int_as_float(__builtin_amdgcn_readlane(vi, 32)), d = __int_as_float(__builtin_amdgcn_readlane(vi, 48));
  return (a + b) + (c + d);
}
DI float dpp_xor1(float v) { return __int_as_float(__builtin_amdgcn_update_dpp(0, __float_as_int(v), 0xB1, 0xF, 0xF, true)); }
DI float dpp_hmirror(float v) { return __int_as_float(__builtin_amdgcn_update_dpp(0, __float_as_int(v), 0x141, 0xF, 0xF, true)); }
DI float dpp_xor2(float v) { return __int_as_float(__builtin_amdgcn_update_dpp(0, __float_as_int(v), 0x4E, 0xF, 0xF, true)); }
DI unsigned pack2(float a, float b) { return (unsigned)f2bf(a) | ((unsigned)f2bf(b) << 16); }
DI int mrow_of(int tok) { return tok < 8192 ? 0 : 1 + ((tok - 8192) >> 11); }


#define XB_TMO      128
#define XB_XCNT(j)  (256  + 64 * (j))
#define XB_XSUB(j)  (1280 + 64 * (j))
#define XB_XGEN(j)  (2304 + 64 * (j))
#define XB_TOP      3328
#define XB_TOPGEN   3392
#define XCD_BAR_WORDS 3456
#define XB_SPIN_CAP (1u << 22)
#define LAS __attribute__((address_space(3)))
DI unsigned xb_ld(unsigned* p) { return __hip_atomic_load(p, __ATOMIC_RELAXED, __HIP_MEMORY_SCOPE_AGENT); }
DI unsigned xb_add(unsigned* p, unsigned v) { return __hip_atomic_fetch_add(p, v, __ATOMIC_RELAXED, __HIP_MEMORY_SCOPE_AGENT); }
DI unsigned xb_xcc_id() { return (unsigned)__builtin_amdgcn_s_getreg((3 << 11) | 20) & 0xFu; }
#define XB_SPIN(cond, bar) do { unsigned _sp = 0; while (cond) { __builtin_amdgcn_s_sleep(1); \
    if ((++_sp & 255u) == 0u) { if (xb_ld(&(bar)[XB_TMO])) break; if (_sp > XB_SPIN_CAP) { atomicAdd(&(bar)[XB_TMO], 1u); break; } } } } while (0)
struct XcdBarrier { unsigned* bar; unsigned x; volatile LAS unsigned* st; };
DI XcdBarrier xcd_barrier_post(unsigned* bar, volatile LAS unsigned* st) {
  XcdBarrier b; b.bar = bar; b.x = xb_xcc_id(); b.st = st;
  if (threadIdx.x == 0) (void)xb_add(&bar[XB_XCNT(b.x)], 1u);
  return b;
}
DI void xcd_barrier_complete(unsigned* bar, unsigned x, unsigned& nloc, unsigned& nx) {
  const unsigned G = gridDim.x * gridDim.y * gridDim.z;
  unsigned sum, cnt, mine, sp = 0u;
  for (;;) {
    sum = 0u; cnt = 0u; mine = 0u;
#pragma unroll
    for (unsigned j = 0; j < 16; ++j) { const unsigned c = xb_ld(&bar[XB_XCNT(j)]); sum += c; cnt += (c > 0u) ? 1u : 0u; mine = (j == x) ? c : mine; }
    if (sum == G) break;
    __builtin_amdgcn_s_sleep(1);
    if ((++sp & 255u) == 0u) { if (xb_ld(&bar[XB_TMO])) break; if (sp > XB_SPIN_CAP) { atomicAdd(&bar[XB_TMO], 1u); break; } }
  }
  nloc = mine > 0u ? mine : 1u; nx = cnt > 0u ? cnt : 1u;
}
DI void xcd_barrier(const XcdBarrier& b) {
  asm volatile("s_waitcnt vmcnt(0)" ::: "memory");
  __syncthreads();
  if (threadIdx.x == 0) {
    unsigned* bar = b.bar;
    asm volatile("" : "+s"(bar));
    __builtin_amdgcn_s_waitcnt(0);
    unsigned nloc = b.st[0], nx = b.st[1];
    if (nloc == 0u) { xcd_barrier_complete(bar, b.x, nloc, nx); b.st[0] = nloc; b.st[1] = nx; }
    const unsigned old = xb_add(&bar[XB_XSUB(b.x)], 1u);
    const unsigned gen = old / nloc;
    if (old + 1u == (gen + 1u) * nloc) {
      __builtin_amdgcn_fence(__ATOMIC_RELEASE, "agent");
      asm volatile("s_waitcnt vmcnt(0)" ::: "memory");
      const unsigned og = xb_add(&bar[XB_TOP], 1u);
      const unsigned tg = og / nx;
      if (og + 1u == (tg + 1u) * nx) xb_add(&bar[XB_TOPGEN], 1u);
      else XB_SPIN(xb_ld(&bar[XB_TOPGEN]) == tg, bar);
      __builtin_amdgcn_fence(__ATOMIC_ACQUIRE, "agent");
      xb_add(&bar[XB_XGEN(b.x)], 1u);
      asm volatile("s_waitcnt vmcnt(0)" ::: "memory");
    } else {
      XB_SPIN(xb_ld(&bar[XB_XGEN(b.x)]) == gen, bar);
      __builtin_amdgcn_fence(__ATOMIC_ACQUIRE, "agent");
      asm volatile("s_waitcnt vmcnt(0)" ::: "memory");
    }
  }
  __syncthreads();
}

DI void gemm_load(const int tid, const u16* A, int lda, const u16* B, int ldb, int k0, uint4 (&ra)[4], uint4 (&rb)[2]) {
#pragma unroll
  for (int i = 0; i < 4; ++i) {
    int idx = tid + i * 512;
    int row = idx >> 3, ch = idx & 7;
    ra[i] = *(const uint4*)(A + (size_t)row * lda + k0 + ch * 8);
  }
#pragma unroll
  for (int i = 0; i < 2; ++i) {
    int idx = tid + i * 512;
    int row = idx >> 3, ch = idx & 7;
    rb[i] = *(const uint4*)(B + (size_t)row * ldb + k0 + ch * 8);
  }
}
DI void gemm_store_lds(const int tid, char* sA, char* sB, const uint4 (&ra)[4], const uint4 (&rb)[2]) {
#pragma unroll
  for (int i = 0; i < 4; ++i) {
    int idx = tid + i * 512;
    int row = idx >> 3, ch = idx & 7;
    *(uint4*)(sA + row * 128 + ((ch ^ ((row >> 1) & 7)) << 4)) = ra[i];
  }
#pragma unroll
  for (int i = 0; i < 2; ++i) {
    int idx = tid + i * 512;
    int row = idx >> 3, ch = idx & 7;
    *(uint4*)(sB + row * 128 + ((ch ^ ((row >> 1) & 7)) << 4)) = rb[i];
  }
}
DI void gemm_compute(const char* sA, const char* sB, f32x4 (&acc)[4][4], int wm, int wn, int lane) {
#pragma unroll
  for (int kk = 0; kk < 2; ++kk) {
    bf16x8 a[4], b[4];
    const int ch = kk * 4 + (lane >> 4);
#pragma unroll
    for (int mf = 0; mf < 4; ++mf) {
      int row = wm * 64 + mf * 16 + (lane & 15);
      a[mf] = *(const bf16x8*)(sA + row * 128 + ((ch ^ ((row >> 1) & 7)) << 4));
    }
#pragma unroll
    for (int nf = 0; nf < 4; ++nf) {
      int row = wn * 64 + nf * 16 + (lane & 15);
      b[nf] = *(const bf16x8*)(sB + row * 128 + ((ch ^ ((row >> 1) & 7)) << 4));
    }
#pragma unroll
    for (int mf = 0; mf < 4; ++mf)
#pragma unroll
      for (int nf = 0; nf < 4; ++nf)
        acc[mf][nf] = __builtin_amdgcn_mfma_f32_16x16x32_bf16(a[mf], b[nf], acc[mf][nf], 0, 0, 0);
  }
}
DI void gemm_acc(const u16* A, int lda, const u16* B, int ldb, int K, f32x4 (&acc)[4][4], char* smem) {
  const int tid = get_tid(), lane = tid & 63, wave = tid >> 6;
  const int wm = wave >> 1, wn = wave & 1;
  char* sA0 = smem;
  char* sB0 = smem + 32768;
  char* sA1 = smem + 49152;
  char* sB1 = smem + 81920;
  uint4 ra[4], rb[2];
  const int nk = K >> 6;
  gemm_load(tid, A, lda, B, ldb, 0, ra, rb);
  gemm_store_lds(tid, sA0, sB0, ra, rb);
  __syncthreads();
  for (int kt = 0; kt < nk; ++kt) {
    const bool more = (kt + 1 < nk);
    if (more) gemm_load(tid, A, lda, B, ldb, (kt + 1) * 64, ra, rb);
    if (kt & 1) gemm_compute(sA1, sB1, acc, wm, wn, lane);
    else gemm_compute(sA0, sB0, acc, wm, wn, lane);
    if (more) {
      if (kt & 1) gemm_store_lds(tid, sA0, sB0, ra, rb);
      else gemm_store_lds(tid, sA1, sB1, ra, rb);
    }
    __syncthreads();
  }
}
DI void zero_acc(f32x4 (&acc)[4][4]) {
#pragma unroll
  for (int i = 0; i < 4; ++i)
#pragma unroll
    for (int j = 0; j < 4; ++j) { float z0; asm volatile("v_mov_b32 %0, 0" : "=v"(z0)); acc[i][j] = f32x4{z0, z0, z0, z0}; }
}

#define PG8_LAS __attribute__((address_space(3)))
namespace pg8 {
typedef unsigned short bf16_t;
typedef short bf16x8 __attribute__((ext_vector_type(8)));
typedef float f32x4 __attribute__((ext_vector_type(4)));
typedef unsigned u32x4 __attribute__((ext_vector_type(4)));
constexpr int BM = 256, BK = 64, HALF = 128, HTB = HALF * BK * 2  , STAGE_BYTES = 8 * HTB, NXCD = 8, WGM = 8;

__host__ __device__ __forceinline__ int lds_byte(int r, int c) { const int st = (r >> 4) * 2 + (c >> 5), rr = r & 15, cc = c & 31, ob = rr * 64 + cc * 2; return st * 1024 + (ob ^ (((ob >> 9) & 1) << 5)); }
__host__ __device__ __forceinline__ void stage_rc(int b, int& R, int& C) { const int st = b / 1024, sb = b % 1024, swz = sb ^ (((sb >> 9) & 1) << 5); R = (st >> 1) * 16 + swz / 64; C = (st & 1) * 32 + (swz % 64) / 2; }
__host__ __device__ __forceinline__ int perm32(int rho) { const int n = rho >> 4, i = rho & 15; return 8 * (i >> 2) + 4 * n + (i & 3); }

struct Unit { int pm, pn; };
struct Gemm { const bf16_t* A; const bf16_t* Bt; int M, N, K, blk, ld; };

struct StaticOrder {
    int nM, nN, nwg, G, c;
    __host__ __device__ void init(int M, int N, int G_, int c_) { nM = M / BM; nN = N / BM; nwg = nM * nN; G = G_; c = c_; }
    __host__ __device__ bool next(int i, Unit& u) const {
        const long L = (long)i * G + c; if (L >= nwg) return false;
        int wgid = (int)L; { const int q = nwg / NXCD, r = nwg % NXCD, xcd = wgid % NXCD, off = wgid / NXCD; wgid = (xcd < r ? xcd * (q + 1) : r * (q + 1) + (xcd - r) * q) + off; }
        const int nig = WGM * nN, gid = wgid / nig, fm = gid * WGM, gsz = (nM - fm) < WGM ? (nM - fm) : WGM;
        u.pm = fm + ((wgid % nig) % gsz); u.pn = (wgid % nig) / gsz; return true;
    }
    __device__ __forceinline__ void a_ready(const Unit&) const {}
    __device__ __forceinline__ void done(const Unit&) const {}
};
__device__ __forceinline__ unsigned cvt_pk_bf16(float lo, float hi) { unsigned r; asm volatile("v_cvt_pk_bf16_f32 %0, %1, %2" : "=v"(r) : "v"(lo), "v"(hi)); return r; }
template <class Epi, class Sched, bool STAMP = false>
__device__ __forceinline__ void gemm_phase(PG8_LAS unsigned char* lds, const Gemm g, const Sched& S, const Epi& E, unsigned long long* stamps) {
    const int tid = get_tid(), wid = __builtin_amdgcn_readfirstlane(tid >> 6), lane = tid & 63, wr = wid >> 2, wc = wid & 3, fr = lane & 15, fq = lane >> 4;
    const int K = g.K, nt = K / BK;
    int ts_lo = 0, ts_hi = 0, nts = 0; const unsigned long long rt_entry = STAMP ? (unsigned long long)wall_clock64() : 0ull;
#define PG8_STAMP() do { if (STAMP && wid == 0 && nts < 64) { const unsigned long long _c = (unsigned long long)clock64(); \
        ts_lo = (lane == nts) ? (int)(unsigned)_c : ts_lo; ts_hi = (lane == nts) ? (int)(unsigned)(_c >> 32) : ts_hi; ++nts; } } while (0)
    PG8_STAMP();
    unsigned voffA[2], voffB[2];
#pragma unroll
    for (int i = 0; i < 2; ++i) { int R, C; stage_rc(tid * 16 + i * 8192, R, C); const int Rb = Epi::PERM ? ((R & ~31) + perm32(R & 31)) : R;
        const int ldr = g.blk ? 64 : g.ld; voffA[i] = (unsigned)(R * ldr + C) * 2u; voffB[i] = (unsigned)(Rb * ldr + C) * 2u; }
    const size_t kstep = g.blk ? (size_t)32768 : (size_t)(BK * 2);
    const size_t hstep = g.blk ? (size_t)16384 : (size_t)HALF * g.ld * 2;
    const size_t tstep = g.blk ? (size_t)(K / 64) * 32768 : 2 * hstep;
    const unsigned ldsw = (unsigned)wid * 1024u;
    const int aoff = lds_byte(wr * 64 + fr, fq * 8), boff = lds_byte(wc * 32 + fr, fq * 8);
#define PG8_SA(b, h) (((b) * 2 + (h)) * HTB)
#define PG8_SB(b, h) ((4 + (b) * 2 + (h)) * HTB)
#define PG8_STAGE(bufoff, gbase, voff) do { _Pragma("unroll") for (int _i = 0; _i < 2; ++_i) \
        __builtin_amdgcn_global_load_lds((const unsigned*)((const char*)(gbase) + (voff)[_i]), (PG8_LAS unsigned*)(lds + (bufoff) + ldsw + _i * 8192), 16, 0, 0); } while (0)
#define PG8_LDA(dst, b, h) do { _Pragma("unroll") for (int m = 0; m < 4; ++m) _Pragma("unroll") for (int k = 0; k < 2; ++k) dst[m][k] = *(const PG8_LAS bf16x8*)(lds + PG8_SA(b, h) + aoff + m * 2048 + k * 1024); } while (0)
#define PG8_LDB(dst, b, h) do { _Pragma("unroll") for (int n = 0; n < 2; ++n) _Pragma("unroll") for (int k = 0; k < 2; ++k) dst[n][k] = *(const PG8_LAS bf16x8*)(lds + PG8_SB(b, h) + boff + n * 2048 + k * 1024); } while (0)
#define PG8_MMA(ai, bj, At, Bt) do { __builtin_amdgcn_s_setprio(1); _Pragma("unroll") for (int m = 0; m < 4; ++m) _Pragma("unroll") for (int n = 0; n < 2; ++n) _Pragma("unroll") for (int k = 0; k < 2; ++k) \
        acc[ai][bj][m][n] = __builtin_amdgcn_mfma_f32_16x16x32_bf16(Bt[n][k], At[m][k], acc[ai][bj][m][n], 0, 0, 0); __builtin_amdgcn_s_setprio(0); } while (0)
#define PG8_WAIT_V(n) asm volatile("s_waitcnt vmcnt(" #n ")" ::: "memory")
#define PG8_WAIT_L(n) asm volatile("s_waitcnt lgkmcnt(" #n ")" ::: "memory")
#define PG8_BAR __builtin_amdgcn_s_barrier()
#define PG8_SCHED __builtin_amdgcn_sched_barrier(0)
    Unit cur, nxt; int ui = 0;
    if (!S.next(0, cur)) return;
    f32x4 acc[2][2][4][2];
#pragma unroll
    for (int a = 0; a < 2; ++a)
#pragma unroll
        for (int b = 0; b < 2; ++b)
#pragma unroll
            for (int m = 0; m < 4; ++m)
#pragma unroll
                for (int n = 0; n < 2; ++n) { float z0; asm volatile("v_mov_b32 %0, 0" : "=v"(z0)); acc[a][b][m][n] = (f32x4){z0, z0, z0, z0}; }
    bf16x8 At[4][2], B0[2][2], B1[2][2];
    const char* cA = (const char*)g.A + (size_t)cur.pm * tstep; const char* cB = (const char*)g.Bt + (size_t)cur.pn * tstep;
    S.a_ready(cur);
    PG8_STAGE(PG8_SB(0, 0), cB, voffB); PG8_STAGE(PG8_SA(0, 0), cA, voffA); PG8_STAGE(PG8_SB(0, 1), cB + hstep, voffB); PG8_STAGE(PG8_SA(0, 1), cA + hstep, voffA);
    if (wr == 1) PG8_BAR;
    PG8_WAIT_V(4); PG8_BAR;
    PG8_STAGE(PG8_SB(1, 0), cB + kstep, voffB); PG8_STAGE(PG8_SA(1, 0), cA + kstep, voffA); PG8_STAGE(PG8_SB(1, 1), cB + hstep + kstep, voffB);
    PG8_WAIT_V(6); PG8_BAR;
    PG8_STAMP();
    for (;;) {
        const bool has_next = S.next(ui + 1, nxt);
        const char* nA = has_next ? (const char*)g.A + (size_t)nxt.pm * tstep : cA; const char* nB = has_next ? (const char*)g.Bt + (size_t)nxt.pn * tstep : cB;
        for (int t = 0; t < nt; t += 2) {
            const bool last = (t == nt - 2);
            const char* a1 = cA + (size_t)(t + 1) * kstep;
            const char* a2 = last ? nA : cA + (size_t)(t + 2) * kstep; const char* b2 = last ? nB : cB + (size_t)(t + 2) * kstep;
            const char* a3 = a2 + kstep; const char* b3 = b2 + kstep;
            if (last && has_next) S.a_ready(nxt);
            PG8_LDB(B0, 0, 0); PG8_SCHED; PG8_LDA(At, 0, 0); PG8_STAGE(PG8_SA(1, 1), a1 + hstep, voffA);
            PG8_WAIT_L(8); PG8_BAR; PG8_WAIT_L(0); PG8_MMA(0, 0, At, B0); PG8_BAR; PG8_SCHED;
            PG8_LDB(B1, 0, 1); PG8_STAGE(PG8_SB(0, 0), b2, voffB);
            PG8_BAR; PG8_WAIT_L(0); PG8_MMA(0, 1, At, B1); PG8_BAR;
            PG8_LDA(At, 0, 1); PG8_STAGE(PG8_SA(0, 0), a2, voffA);
            PG8_BAR; PG8_WAIT_L(0); PG8_MMA(1, 0, At, B0); PG8_BAR; PG8_SCHED;
            PG8_STAGE(PG8_SB(0, 1), b2 + hstep, voffB);
            PG8_WAIT_V(6); PG8_BAR; PG8_MMA(1, 1, At, B1); PG8_BAR;
            PG8_LDB(B0, 1, 0); PG8_SCHED; PG8_LDA(At, 1, 0); PG8_STAGE(PG8_SA(0, 1), a2 + hstep, voffA);
            PG8_WAIT_L(8); PG8_BAR; PG8_WAIT_L(0); PG8_MMA(0, 0, At, B0); PG8_BAR; PG8_SCHED;
            PG8_LDB(B1, 1, 1); PG8_STAGE(PG8_SB(1, 0), b3, voffB);
            PG8_BAR; PG8_WAIT_L(0); PG8_MMA(0, 1, At, B1); PG8_BAR;
            PG8_LDA(At, 1, 1); PG8_STAGE(PG8_SA(1, 0), a3, voffA);
            PG8_BAR; PG8_WAIT_L(0); PG8_MMA(1, 0, At, B0); PG8_BAR; PG8_SCHED;
            PG8_STAGE(PG8_SB(1, 1), b3 + hstep, voffB);
            PG8_WAIT_V(6); PG8_BAR; PG8_MMA(1, 1, At, B1); PG8_BAR;
        }
        PG8_STAMP();
        if constexpr (!Epi::AFTER_DRAIN) { E(acc, cur, wr, wc, fr, fq); S.done(cur); }
        PG8_STAMP();
        if (!has_next) break;
#pragma unroll
        for (int a = 0; a < 2; ++a)
#pragma unroll
            for (int b = 0; b < 2; ++b)
#pragma unroll
                for (int m = 0; m < 4; ++m)
#pragma unroll
                    for (int n = 0; n < 2; ++n) { float z0; asm volatile("v_mov_b32 %0, 0" : "=v"(z0)); acc[a][b][m][n] = (f32x4){z0, z0, z0, z0}; }
        cur = nxt; cA = nA; cB = nB; ++ui;
    }
    PG8_WAIT_V(0);
    if (wr == 0) PG8_BAR;
    PG8_BAR;
    if constexpr (Epi::AFTER_DRAIN) { E.fused(acc, cur, wr, wc, fr, fq, lds, wid, lane); S.done(cur); }
    PG8_STAMP();
    if (STAMP && wid == 0) { stamps[lane] = lane < nts ? (((unsigned long long)(unsigned)ts_hi << 32) | (unsigned)ts_lo) : 0ull;
        if (lane == 62) stamps[62] = rt_entry; if (lane == 63) stamps[63] = (unsigned long long)wall_clock64(); }
#undef PG8_STAMP
#undef PG8_SA
#undef PG8_SB
#undef PG8_STAGE
#undef PG8_LDA
#undef PG8_LDB
#undef PG8_MMA
#undef PG8_WAIT_V
#undef PG8_WAIT_L
#undef PG8_BAR
#undef PG8_SCHED
}
}

using pg8::cvt_pk_bf16;
DI uint4 pack8(const pg8::f32x4& a, const pg8::f32x4& b) {
  return uint4{cvt_pk_bf16(a[0], a[1]), cvt_pk_bf16(a[2], a[3]), cvt_pk_bf16(b[0], b[1]), cvt_pk_bf16(b[2], b[3])};
}
DI void unpack8(const uint4& u, float (&o)[8]) {
  o[0] = bf2f((u16)(u.x & 0xffff)); o[1] = bf2f((u16)(u.x >> 16));
  o[2] = bf2f((u16)(u.y & 0xffff)); o[3] = bf2f((u16)(u.y >> 16));
  o[4] = bf2f((u16)(u.z & 0xffff)); o[5] = bf2f((u16)(u.z >> 16));
  o[6] = bf2f((u16)(u.w & 0xffff)); o[7] = bf2f((u16)(u.w >> 16));
}
struct EpiP {
  static constexpr bool PERM = true, AFTER_DRAIN = false;
  u16 *zb, *xr, *rwb, *gb; float* dtb; int coff;
  DI void operator()(const pg8::f32x4 (&acc)[2][2][4][2], const pg8::Unit& u, int wr, int wc, int fr, int fq) const {
    const int row0 = u.pm * 256 + wr * 64 + fr;
#pragma unroll
    for (int bj = 0; bj < 2; ++bj) {
      const int cg = coff + u.pn * 256 + bj * 128 + wc * 32;
      const int col0 = cg + 8 * fq;
      if (cg >= 10688) continue;
#pragma unroll
      for (int ai = 0; ai < 2; ++ai)
#pragma unroll
        for (int m = 0; m < 4; ++m) {
          const size_t row = row0 + ai * 128 + m * 16;
          const pg8::f32x4 v0 = acc[ai][bj][m][0], v1 = acc[ai][bj][m][1];
          if (cg >= 5120 && cg < 5184) {
            float* d = dtb + row * 64 + (col0 - 5120);
            *(pg8::f32x4*)d = v0; *(pg8::f32x4*)(d + 4) = v1;
          } else {
            u16* dst = (cg < 2048) ? zb + row * 2048 + col0
                     : (cg < 5120) ? xr + row * 3072 + (col0 - 2048)
                     : (cg < 8640) ? rwb + row * 3456 + (col0 - 5184)
                                   : gb + row * 2048 + (col0 - 8640);
            *(uint4*)dst = pack8(v0, v1);
          }
        }
    }
  }
};
struct EpiOutV {
  static constexpr bool PERM = true, AFTER_DRAIN = false;
  const u16* gb; u16* V; int goff;
  DI void operator()(const pg8::f32x4 (&acc)[2][2][4][2], const pg8::Unit& u, int wr, int wc, int fr, int fq) const {
    const int row0 = u.pm * 256 + wr * 64 + fr;
#pragma unroll
    for (int bj = 0; bj < 2; ++bj) {
      const int col0 = u.pn * 256 + bj * 128 + wc * 32 + 8 * fq;
#pragma unroll
      for (int ai = 0; ai < 2; ++ai)
#pragma unroll
        for (int m = 0; m < 4; ++m) {
          const size_t row = row0 + ai * 128 + m * 16;
          float gt[8];
          unpack8(*(const uint4*)(gb + row * 2048 + goff + col0), gt);
          pg8::f32x4 v0 = acc[ai][bj][m][0], v1 = acc[ai][bj][m][1];
#pragma unroll
          for (int e = 0; e < 4; ++e) { v0[e] *= sigm(gt[e]); v1[e] *= sigm(gt[4 + e]); }
          *(uint4*)(V + row * 1024 + col0) = pack8(v0, v1);
        }
    }
  }
};
struct EpiWo {
  static constexpr bool PERM = true, AFTER_DRAIN = false;
  const float *xp, *xs, *mod; float* out; int tok0;
  DI void operator()(const pg8::f32x4 (&acc)[2][2][4][2], const pg8::Unit& u, int wr, int wc, int fr, int fq) const {
    const int row0 = u.pm * 256 + wr * 64 + fr;
#pragma unroll
    for (int bj = 0; bj < 2; ++bj) {
      const int col0 = u.pn * 256 + bj * 128 + wc * 32 + 8 * fq;
#pragma unroll
      for (int ai = 0; ai < 2; ++ai)
#pragma unroll
        for (int m = 0; m < 4; ++m) {
          const int tok = tok0 + row0 + ai * 128 + m * 16;
          const float* xr = tok < 8192 ? xp + (size_t)tok * 1024 : xs + (size_t)(tok - 8192) * 1024;
          const float* gt = mod + mrow_of(tok) * 6144 + 2048 + col0;
          const pg8::f32x4 x0 = *(const pg8::f32x4*)(xr + col0), x1 = *(const pg8::f32x4*)(xr + col0 + 4);
          const pg8::f32x4 g0 = *(const pg8::f32x4*)gt, g1 = *(const pg8::f32x4*)(gt + 4);
          float* o = out + (size_t)tok * 1024 + col0;
          *(pg8::f32x4*)o = x0 + g0 * acc[ai][bj][m][0];
          *(pg8::f32x4*)(o + 4) = x1 + g1 * acc[ai][bj][m][1];
        }
    }
  }
};
struct EpiGU {
  static constexpr bool PERM = true, AFTER_DRAIN = false;
  u16* act;
  DI void operator()(const pg8::f32x4 (&acc)[2][2][4][2], const pg8::Unit& u, int wr, int wc, int fr, int fq) const {
    const int row0 = u.pm * 256 + wr * 64 + fr;
    const int col0 = u.pn * 128 + wc * 32 + 8 * fq;
#pragma unroll
    for (int ai = 0; ai < 2; ++ai)
#pragma unroll
      for (int m = 0; m < 4; ++m) {
        const size_t row = row0 + ai * 128 + m * 16;
        pg8::f32x4 v0, v1;
#pragma unroll
        for (int e = 0; e < 4; ++e) {
          v0[e] = siluf(acc[ai][0][m][0][e]) * acc[ai][1][m][0][e];
          v1[e] = siluf(acc[ai][0][m][1][e]) * acc[ai][1][m][1][e];
        }
        *(uint4*)(act + ((row >> 8) * 44 + (col0 >> 6)) * 16384 + (row & 255) * 64 + (col0 & 63)) = pack8(v0, v1);
      }
  }
};
struct EpiDown {
  static constexpr bool PERM = true, AFTER_DRAIN = false;
  const float* mod; float* out;
  DI void operator()(const pg8::f32x4 (&acc)[2][2][4][2], const pg8::Unit& u, int wr, int wc, int fr, int fq) const {
    const int row0 = u.pm * 256 + wr * 64 + fr;
#pragma unroll
    for (int bj = 0; bj < 2; ++bj) {
      const int col0 = u.pn * 256 + bj * 128 + wc * 32 + 8 * fq;
#pragma unroll
      for (int ai = 0; ai < 2; ++ai)
#pragma unroll
        for (int m = 0; m < 4; ++m) {
          const int tok = row0 + ai * 128 + m * 16;
          const float* gt = mod + mrow_of(tok) * 6144 + 5120 + col0;
          const pg8::f32x4 g0 = *(const pg8::f32x4*)gt, g1 = *(const pg8::f32x4*)(gt + 4);
          float* o = out + (size_t)tok * 1024 + col0;
          const pg8::f32x4 x0 = *(const pg8::f32x4*)o, x1 = *(const pg8::f32x4*)(o + 4);
          *(pg8::f32x4*)o = x0 + g0 * acc[ai][bj][m][0];
          *(pg8::f32x4*)(o + 4) = x1 + g1 * acc[ai][bj][m][1];
        }
    }
  }
};
template <class Epi>
DI void run_gemm8(char* smem, const u16* A, const u16* Bt, int M, int N, int K, const Epi& E, int vb = -1, int nb = 0, int blk = 0, int ld = 0) {
  if (ld == 0) ld = K;
  asm volatile("" : "+s"(M), "+s"(N), "+s"(K), "+s"(blk), "+s"(ld));
  pg8::Gemm gm{A, Bt, M, N, K, blk, ld};
  pg8::StaticOrder S;
  if (vb < 0) { vb = blockIdx.x; nb = gridDim.x; }
  S.init(M, N, nb, vb);
  pg8::gemm_phase<Epi, pg8::StaticOrder, false>((PG8_LAS unsigned char*)smem, gm, S, E, nullptr);
  __syncthreads();
}

struct EpiR2 {
  static constexpr bool PERM = true, AFTER_DRAIN = false;
  __half* wk; const float *w0, *a0;
  DI void operator()(const pg8::f32x4 (&acc)[2][2][4][2], const pg8::Unit& u, int wr, int wc, int fr, int fq) const {
    const int row0 = u.pm * 256 + wr * 64 + fr;
    const int sec = u.pn >> 2;
#pragma unroll
    for (int bj = 0; bj < 2; ++bj) {
      const int nn = (u.pn & 3) * 256 + bj * 128 + wc * 32 + 8 * fq;
      const int d = sec & 1;
      const float* bias = (sec < 2 ? w0 : a0) + d * 1024 + nn;
      const pg8::f32x4 b0 = *(const pg8::f32x4*)bias, b1 = *(const pg8::f32x4*)(bias + 4);
      const int field = (sec < 2 ? 4 : 5) + 2 * d;
#pragma unroll
      for (int ai = 0; ai < 2; ++ai)
#pragma unroll
        for (int m = 0; m < 4; ++m) {
          const size_t row = row0 + ai * 128 + m * 16;
          pg8::f32x4 v0 = acc[ai][bj][m][0] + b0, v1 = acc[ai][bj][m][1] + b1;
          float o[8];
#pragma unroll
          for (int e = 0; e < 4; ++e) {
            float s0 = sigm(v0[e]), s1 = sigm(v1[e]);
            o[e] = sec < 2 ? __expf(-0.6065306597f * s0) : s0;
            o[4 + e] = sec < 2 ? __expf(-0.6065306597f * s1) : s1;
          }
          __half2 h0 = __floats2half2_rn(o[0], o[1]), h1 = __floats2half2_rn(o[2], o[3]);
          __half2 h2 = __floats2half2_rn(o[4], o[5]), h3 = __floats2half2_rn(o[6], o[7]);
          uint4 pk;
          pk.x = *reinterpret_cast<unsigned*>(&h0); pk.y = *reinterpret_cast<unsigned*>(&h1);
          pk.z = *reinterpret_cast<unsigned*>(&h2); pk.w = *reinterpret_cast<unsigned*>(&h3);
          *(uint4*)(wk + ((row * 16 + (nn >> 6)) * 8 + field) * 64 + (nn & 63)) = pk;
        }
    }
  }
};

template <int MODE>
__device__ __forceinline__ void convT(const float* __restrict__ src, int K, int N, u16* __restrict__ dst, char* smem, int vb = -1, int nb = 0, int ldd = 0) {
  if (ldd == 0) ldd = K;
  float* tile = (float*)smem;
  const int tid = get_tid();
  const int KT = K >> 6, NT = N >> 6;
  if (vb < 0) { vb = blockIdx.x; nb = gridDim.x; }
  for (int t = vb; t < KT * NT; t += nb) {
    int kt = t % KT, nt = t / KT;
#pragma unroll
    for (int i = 0; i < 2; ++i) {
      int idx = tid + i * 512;
      int r = idx >> 4, c4 = idx & 15;
      *(float4*)(tile + r * 68 + c4 * 4) = *(const float4*)(src + (size_t)(kt * 64 + r) * N + nt * 64 + c4 * 4);
    }
    __syncthreads();
    int n = tid >> 3, kc = tid & 7;
    unsigned w[4];
#pragma unroll
    for (int j = 0; j < 4; ++j)
      w[j] = pack2(tile[(kc * 8 + 2 * j) * 68 + n], tile[(kc * 8 + 2 * j + 1) * 68 + n]);
    int ng = nt * 64 + n;
    int row = ng;
    if (MODE == 1) {
      int isu = ng >= 2816;
      int nn = ng - isu * 2816;
      row = (nn >> 7) * 256 + isu * 128 + (nn & 127);
    }
    if (MODE == 2) *(uint4*)(dst + ((size_t)(row >> 8) * KT + kt) * 16384 + (row & 255) * 64 + kc * 8) = uint4{w[0], w[1], w[2], w[3]};
    else *(uint4*)(dst + (size_t)row * ldd + kt * 64 + kc * 8) = uint4{w[0], w[1], w[2], w[3]};
    __syncthreads();
  }
}

__device__ __forceinline__ void step_prep(const Params& p, char* smem) {
  const int tid = get_tid();
  char* ws = p.ws;
  {
    float* red = (float*)smem;
    float* mod = (float*)(ws + OFF_MOD);
    for (int item = blockIdx.x; item < 192; item += gridDim.x) {
      int c4 = tid & 7, kl = tid >> 3;
      float acc[12];
#pragma unroll
      for (int i = 0; i < 12; ++i) acc[i] = 0.f;
      for (int k = kl; k < 1024; k += 64) {
        float4 w = *(const float4*)(p.w_ada + (size_t)k * 6144 + item * 32 + c4 * 4);
        float s0 = siluf(p.c_ctx[k]), s1 = siluf(p.c[k]), s2 = siluf(p.c[1024 + k]);
        acc[0] += s0 * w.x; acc[1] += s0 * w.y; acc[2] += s0 * w.z; acc[3] += s0 * w.w;
        acc[4] += s1 * w.x; acc[5] += s1 * w.y; acc[6] += s1 * w.z; acc[7] += s1 * w.w;
        acc[8] += s2 * w.x; acc[9] += s2 * w.y; acc[10] += s2 * w.z; acc[11] += s2 * w.w;
      }
#pragma unroll
      for (int i = 0; i < 12; ++i) red[(kl * 8 + c4) * 12 + i] = acc[i];
      __syncthreads();
      if (tid < 96) {
        int cond = tid >> 5, col = tid & 31;
        int cc4 = col >> 2, e = col & 3;
        float s = 0.f;
        for (int k = 0; k < 64; ++k) s += red[(k * 8 + cc4) * 12 + cond * 4 + e];
        int n = item * 32 + col;
        mod[cond * 6144 + n] = s + p.b_ada[n];
      }
      __syncthreads();
    }
  }
  convT<0>(p.w_in, 1024, 10688, (u16*)(ws + OFF_WIN), smem);
  convT<0>(p.w_m_out, 2048, 1024, (u16*)(ws + OFF_WMOUT), smem);
  convT<0>(p.w_r_out, 1024, 1024, (u16*)(ws + OFF_WROUT), smem);
  convT<0>(p.w_o, 1024, 1024, (u16*)(ws + OFF_WO), smem);
  convT<0>(p.w2, 64, 1024, (u16*)(ws + OFF_W2T), smem);
  convT<0>(p.w2 + 65536, 64, 1024, (u16*)(ws + OFF_W2T) + 65536, smem);
  convT<0>(p.a2, 64, 1024, (u16*)(ws + OFF_A2T), smem);
  convT<0>(p.a2 + 65536, 64, 1024, (u16*)(ws + OFF_A2T) + 65536, smem);
  convT<0>(p.g2, 128, 1024, (u16*)(ws + OFF_G2T), smem);
  {
    u16* w4 = (u16*)(ws + OFF_W4T);
    convT<0>(p.w2, 64, 1024, w4 + (size_t)0 * 1024 * 256 + 0, smem, -1, 0, 256);
    convT<0>(p.w2 + 65536, 64, 1024, w4 + (size_t)1 * 1024 * 256 + 64, smem, -1, 0, 256);
    convT<0>(p.a2, 64, 1024, w4 + (size_t)2 * 1024 * 256 + 128, smem, -1, 0, 256);
    convT<0>(p.a2 + 65536, 64, 1024, w4 + (size_t)3 * 1024 * 256 + 192, smem, -1, 0, 256);
    for (int i = blockIdx.x * NTHR + tid; i < 4096 * 32; i += gridDim.x * NTHR) {
      int row = i >> 5, c = i & 31;
      if ((c >> 3) != (row >> 10)) *(uint4*)(w4 + (size_t)row * 256 + c * 8) = uint4{0, 0, 0, 0};
    }
  }
  {
    uint4* z = (uint4*)(ws + OFF_WIN + (size_t)10688 * 1024 * 2);
    for (int i = blockIdx.x * NTHR + tid; i < 8192; i += gridDim.x * NTHR) z[i] = uint4{0, 0, 0, 0};
  }
}

template <int WHICH>
__device__ __forceinline__ void step_norm(const Params& p, int g) {
  const int tid = get_tid(), lane = tid & 63, wave = tid >> 6;
  const float* mod = (const float*)(p.ws + OFF_MOD);
  const int nrows = WHICH == 0 ? TG : NTOK;
  u16* dst = WHICH == 0 ? (u16*)((char*)p.out + H1_OUT_OFF) : (u16*)(p.ws + OFF_H2);
  const float* nw = WHICH == 0 ? p.norm1_w : p.norm2_w;
  for (int r = blockIdx.x * 8 + wave; r < nrows; r += gridDim.x * 8) {
    int tok = WHICH == 0 ? g * TG + r : r;
    const float* xr;
    if (WHICH == 0) xr = tok < 8192 ? p.x_prompt + (size_t)tok * 1024 : p.x_sample + (size_t)(tok - 8192) * 1024;
    else xr = (const float*)(p.ws + OFF_X1) + (size_t)tok * 1024;
    const float* mr = mod + mrow_of(tok) * 6144 + (WHICH == 0 ? 0 : 3072);
    float4 v[4];
    float ss = 0.f;
#pragma unroll
    for (int i = 0; i < 4; ++i) {
      v[i] = ((const float4*)xr)[i * 64 + lane];
      ss += v[i].x * v[i].x + v[i].y * v[i].y + v[i].z * v[i].z + v[i].w * v[i].w;
    }
    ss = wave_sum(ss);
    float rinv = rsqrtf(ss * (1.f / 1024.f) + 1e-6f);
#pragma unroll
    for (int i = 0; i < 4; ++i) {
      int col = (i * 64 + lane) * 4;
      float4 w4 = *(const float4*)(nw + col);
      float4 sh = *(const float4*)(mr + col);
      float4 sc = *(const float4*)(mr + 1024 + col);
      float h0 = v[i].x * rinv * w4.x * (1.f + sc.x) + sh.x;
      float h1 = v[i].y * rinv * w4.y * (1.f + sc.y) + sh.y;
      float h2 = v[i].z * rinv * w4.z * (1.f + sc.z) + sh.z;
      float h3 = v[i].w * rinv * w4.w * (1.f + sc.w) + sh.w;
      *(uint2*)(dst + (size_t)r * 1024 + col) = uint2{pack2(h0, h1), pack2(h2, h3)};
    }
  }
}

__device__ __forceinline__ void step_gemm1(const Params& p, char* smem, int part) {
  char* ws = p.ws;
  const u16* H1 = (const u16*)((const char*)p.out + H1_OUT_OFF);
  const u16* W = (const u16*)(ws + OFF_WIN);
  if (part == 0) {
    EpiP E{(u16*)(ws + OFF_Z), (u16*)(ws + OFF_XBCRAW), (u16*)(ws + OFF_RW), (u16*)(ws + OFF_GATE), (float*)(ws + OFF_DT), 0};
    run_gemm8(smem, H1, W, TG, NPAD, 1024, E);
  } else if (part == 1) {
    EpiP E{(u16*)(ws + OFF_Z), (u16*)(ws + OFF_XBCRAW), (u16*)(ws + OFF_RW), (u16*)(ws + OFF_GATE), (float*)(ws + OFF_DT), 0};
    run_gemm8(smem, H1, W, TG, 5120, 1024, E, (int)blockIdx.x - 64, (int)gridDim.x - 64);
  } else {
    EpiP E{(u16*)(ws + OFF_Z), (u16*)(ws + OFF_XBCRAW), (u16*)(ws + OFF_RW), (u16*)(ws + OFF_GATE), (float*)(ws + OFF_DT), 5120};
    run_gemm8(smem, H1, W + (size_t)5120 * 1024, TG, NPAD - 5120, 1024, E);
  }
}

__device__ __forceinline__ void step_cr1(const Params& p, int g) {
  char* ws = p.ws;
  const int tid = get_tid(), lane = tid & 63, wave = tid >> 6;
  const int Ls = g < 2 ? 256 : 2048;
  {
    const u16* __restrict__ xr = (const u16*)(ws + OFF_XBCRAW);
    u16* __restrict__ xo = (u16*)(ws + OFF_XBC);
    for (int item = blockIdx.x * NTHR + tid; item < (TG / 8) * 384; item += gridDim.x * NTHR) {
      const int rb = item / 384, cc = item - rb * 384;
      const int r0 = rb * 8, pos0 = r0 & (Ls - 1);
      uint4 rows[12];
#pragma unroll
      for (int i = 0; i < 12; ++i) {
        const int pp = pos0 + i - 2;
        rows[i] = uint4{0, 0, 0, 0};
        if (pp >= 0 && pp < Ls) rows[i] = *(const uint4*)(xr + (size_t)(r0 + i - 2) * 3072 + cc * 8);
      }
      float w[5][8], bias[8];
      {
        float4 b0 = *(const float4*)(p.conv_b + cc * 8), b1 = *(const float4*)(p.conv_b + cc * 8 + 4);
        bias[0] = b0.x; bias[1] = b0.y; bias[2] = b0.z; bias[3] = b0.w; bias[4] = b1.x; bias[5] = b1.y; bias[6] = b1.z; bias[7] = b1.w;
#pragma unroll
        for (int i = 0; i < 5; ++i) {
          float4 w0 = *(const float4*)(p.conv_w + i * 3072 + cc * 8), w1 = *(const float4*)(p.conv_w + i * 3072 + cc * 8 + 4);
          w[i][0] = w0.x; w[i][1] = w0.y; w[i][2] = w0.z; w[i][3] = w0.w; w[i][4] = w1.x; w[i][5] = w1.y; w[i][6] = w1.z; w[i][7] = w1.w;
        }
      }
      float s[8][8];
#pragma unroll
      for (int o = 0; o < 8; ++o)
#pragma unroll
        for (int e = 0; e < 8; ++e) s[o][e] = bias[e];
#pragma unroll
      for (int i = 0; i < 12; ++i) {
        float xv[8];
        unpack8(rows[i], xv);
#pragma unroll
        for (int k = 0; k < 5; ++k) {
          const int o = i - k;
          if (o >= 0 && o < 8) {
#pragma unroll
            for (int e = 0; e < 8; ++e) s[o][e] += xv[e] * w[k][e];
          }
        }
      }
#pragma unroll
      for (int o = 0; o < 8; ++o) {
#pragma unroll
        for (int e = 0; e < 8; ++e) s[o][e] = siluf(s[o][e]);
        *(uint4*)(xo + (size_t)(r0 + o) * 3072 + cc * 8) = uint4{pack2(s[o][0], s[o][1]), pack2(s[o][2], s[o][3]), pack2(s[o][4], s[o][5]), pack2(s[o][6], s[o][7])};
      }
    }
  }
  {
    const u16* __restrict__ rw = (const u16*)(ws + OFF_RW);
    __half* __restrict__ wk = (__half*)(ws + OFF_WK);
    u16* __restrict__ tl = (u16*)(ws + OFF_TL);
    u16* __restrict__ sg = (u16*)(ws + OFF_SG);
    const bool grid = (g == 2);
    for (int r = blockIdx.x * 8 + wave; r < TG; r += gridDim.x * 8) {
      const int pos = r & (Ls - 1);
      uint4 cur[7], shv[7];
#pragma unroll
      for (int it = 0; it < 7; ++it) {
        const int ci = it * 64 + lane;
        cur[it] = uint4{0, 0, 0, 0};
        shv[it] = uint4{0, 0, 0, 0};
        if (ci < 432) {
          const int q = ci / 108;
          int dr;
          bool ok;
          if (!grid) {
            if (q & 1) { dr = 1; ok = pos < Ls - 1; } else { dr = -1; ok = pos > 0; }
          } else {
            if (q == 0) { dr = -1; ok = (pos & 63) != 0; }
            else if (q == 1) { dr = 1; ok = (pos & 63) != 63; }
            else if (q == 2) { dr = -64; ok = pos >= 64; }
            else { dr = 64; ok = pos < Ls - 64; }
          }
          cur[it] = *(const uint4*)(rw + (size_t)r * 3456 + ci * 8);
          if (ok) shv[it] = *(const uint4*)(rw + (size_t)(r + dr) * 3456 + ci * 8);
        }
      }
#pragma unroll
      for (int it = 0; it < 7; ++it) {
        const int ci = it * 64 + lane;
        const bool valid = ci < 432;
        float xx[8];
        {
          float cf[8], sf[8];
          unpack8(cur[it], cf);
          unpack8(shv[it], sf);
          const int cm = valid ? ci * 8 : 0;
          const float4 m0 = *(const float4*)(p.mu_shift + cm), m1 = *(const float4*)(p.mu_shift + cm + 4);
          const float mu[8] = {m0.x, m0.y, m0.z, m0.w, m1.x, m1.y, m1.z, m1.w};
#pragma unroll
          for (int e = 0; e < 8; ++e) xx[e] = cf[e] + mu[e] * (sf[e] - cf[e]);
        }
        const bool isk = valid && ci >= 144 && ci < 272;
        float kk[8];
        float ss = 0.f;
        {
          const int kc = isk ? ci - 144 : 0;
          const float4 k0 = *(const float4*)(p.k_k + kc * 8), k1 = *(const float4*)(p.k_k + kc * 8 + 4);
          const float kkw[8] = {k0.x, k0.y, k0.z, k0.w, k1.x, k1.y, k1.z, k1.w};
#pragma unroll
          for (int e = 0; e < 8; ++e) { kk[e] = xx[e] * kkw[e]; ss += kk[e] * kk[e]; }
        }
        ss += dpp_xor1(ss);
        ss += dpp_xor2(ss);
        ss += dpp_hmirror(ss);
        if (valid) {
          if (ci < 128) {
            __half2 h0 = __floats2half2_rn(xx[0], xx[1]), h1 = __floats2half2_rn(xx[2], xx[3]), h2 = __floats2half2_rn(xx[4], xx[5]), h3 = __floats2half2_rn(xx[6], xx[7]);
            uint4 pk{*reinterpret_cast<unsigned*>(&h0), *reinterpret_cast<unsigned*>(&h1), *reinterpret_cast<unsigned*>(&h2), *reinterpret_cast<unsigned*>(&h3)};
            *(uint4*)(wk + ((size_t)(r * 16 + (ci >> 3)) * 8 + 0) * 64 + (ci & 7) * 8) = pk;
          } else if (ci < 144) {
            float t[8];
#pragma unroll
            for (int e = 0; e < 8; ++e) t[e] = tanhf(xx[e]);
            *(uint4*)(tl + (size_t)r * 256 + (ci - 128) * 8) = uint4{pack2(t[0], t[1]), pack2(t[2], t[3]), pack2(t[4], t[5]), pack2(t[6], t[7])};
          } else if (ci < 272) {
            const int kc = ci - 144;
            const float rn = -rsqrtf(ss + 1e-12f);
            __half2 h0 = __floats2half2_rn(xx[0], xx[1]), h1 = __floats2half2_rn(xx[2], xx[3]), h2 = __floats2half2_rn(xx[4], xx[5]), h3 = __floats2half2_rn(xx[6], xx[7]);
            uint4 pk{*reinterpret_cast<unsigned*>(&h0), *reinterpret_cast<unsigned*>(&h1), *reinterpret_cast<unsigned*>(&h2), *reinterpret_cast<unsigned*>(&h3)};
            *(uint4*)(wk + ((size_t)(r * 16 + (kc >> 3)) * 8 + 2) * 64 + (kc & 7) * 8) = pk;
            __half2 n0 = __floats2half2_rn(kk[0] * rn, kk[1] * rn), n1 = __floats2half2_rn(kk[2] * rn, kk[3] * rn), n2 = __floats2half2_rn(kk[4] * rn, kk[5] * rn), n3 = __floats2half2_rn(kk[6] * rn, kk[7] * rn);
            uint4 pn{*reinterpret_cast<unsigned*>(&n0), *reinterpret_cast<unsigned*>(&n1), *reinterpret_cast<unsigned*>(&n2), *reinterpret_cast<unsigned*>(&n3)};
            *(uint4*)(wk + ((size_t)(r * 16 + (kc >> 3)) * 8 + 3) * 64 + (kc & 7) * 8) = pn;
          } else if (ci < 400) {
            const int vc = ci - 272;
            __half2 h0 = __floats2half2_rn(xx[0], xx[1]), h1 = __floats2half2_rn(xx[2], xx[3]), h2 = __floats2half2_rn(xx[4], xx[5]), h3 = __floats2half2_rn(xx[6], xx[7]);
            uint4 pk{*reinterpret_cast<unsigned*>(&h0), *reinterpret_cast<unsigned*>(&h1), *reinterpret_cast<unsigned*>(&h2), *reinterpret_cast<unsigned*>(&h3)};
            *(uint4*)(wk + ((size_t)(r * 16 + (vc >> 3)) * 8 + 1) * 64 + (vc & 7) * 8) = pk;
          } else if (ci < 416) {
            *(uint4*)(tl + (size_t)r * 256 + 128 + (ci - 400) * 8) = uint4{pack2(xx[0], xx[1]), pack2(xx[2], xx[3]), pack2(xx[4], xx[5]), pack2(xx[6], xx[7])};
          } else {
            float t[8];
#pragma unroll
            for (int e = 0; e < 8; ++e) t[e] = sigm(xx[e]);
            *(uint4*)(sg + (size_t)r * 128 + (ci - 416) * 8) = uint4{pack2(t[0], t[1]), pack2(t[2], t[3]), pack2(t[4], t[5]), pack2(t[6], t[7])};
          }
        }
      }
    }
  }
}

__device__ __forceinline__ void step_r2(const Params& p, char* smem) {
  char* ws = p.ws;
  const int tid = get_tid(), lane = tid & 63, wave = tid >> 6;
  const int wm = wave >> 1, wn = wave & 1;
  const u16* tl = (const u16*)(ws + OFF_TL);
  const u16* sg = (const u16*)(ws + OFF_SG);
  __half* wk = (__half*)(ws + OFF_WK);
  u16* gr = (u16*)(ws + OFF_GR);
  {
    EpiR2 E{wk, p.w0, p.a0};
    run_gemm8(smem, tl, (const u16*)(ws + OFF_W4T), TG, 4096, 256, E);
  }
  for (int t = (gridDim.x - 1 - blockIdx.x) + 4 * 128; t < 5 * 128; t += gridDim.x) {
    int sub = t >> 7, rem = t & 127;
    int mt = rem & 15, nt = rem >> 4;
    f32x4 acc[4][4];
    zero_acc(acc);
    if (sub < 2) {
      gemm_acc(tl + (size_t)mt * 256 * 256 + sub * 64, 256, (const u16*)(ws + OFF_W2T) + sub * 65536 + (size_t)nt * 128 * 64, 64, 64, acc, smem);
    } else if (sub < 4) {
      gemm_acc(tl + (size_t)mt * 256 * 256 + 128 + (sub - 2) * 64, 256, (const u16*)(ws + OFF_A2T) + (sub - 2) * 65536 + (size_t)nt * 128 * 64, 64, 64, acc, smem);
    } else {
      gemm_acc(sg + (size_t)mt * 256 * 128, 128, (const u16*)(ws + OFF_G2T) + (size_t)nt * 128 * 128, 128, 128, acc, smem);
    }
#pragma unroll
    for (int mf = 0; mf < 4; ++mf)
#pragma unroll
      for (int nf = 0; nf < 4; ++nf)
#pragma unroll
        for (int j = 0; j < 4; ++j) {
          if (nf == 0 && j == 0) asm volatile("" ::: "memory");
          int m = mt * 256 + wm * 64 + mf * 16 + (lane >> 4) * 4 + j;
          int n = nt * 128 + wn * 64 + nf * 16 + (lane & 15);
          float v = acc[mf][nf][j];
          if (sub < 2) {
            float wl = v + p.w0[sub * 1024 + n];
            float dec = __expf(-0.6065306597f * sigm(wl));
            wk[((size_t)(m * 16 + (n >> 6)) * 8 + 4 + 2 * sub) * 64 + (n & 63)] = __float2half(dec);
          } else if (sub < 4) {
            int d = sub - 2;
            float a = sigm(v + p.a0[d * 1024 + n]);
            wk[((size_t)(m * 16 + (n >> 6)) * 8 + 5 + 2 * d) * 64 + (n & 63)] = __float2half(a);
          } else {
            gr[(size_t)m * 1024 + n] = f2bf(v);
          }
        }
  }
}

DI int swz16(int row) { return (row ^ (row >> 3)) & 15; }
DI int sw256(int row, int e) { return row * 256 + ((((e >> 3) ^ swz16(row))) << 4) + (e & 7) * 2; }
DI const bf16x8 ldfrag256(const char* base, int row, int ch) {
  return *(const bf16x8*)(base + row * 256 + ((ch ^ swz16(row)) << 4));
}

typedef unsigned v4u __attribute__((ext_vector_type(4)));
struct SsdPre { v4u c0, c1, c2, c3, b0, b1, b2, b3, x0, x1; float d0, d1; };
DI void ssd_issue(const Params& p, int g, int chain, int ci, int tid, SsdPre& R) {
  const int Ls = g < 2 ? 256 : 2048;
  const int nch = Ls >> 7;
  const int d = chain & 1, h = (chain >> 1) & 31, b = chain >> 6;
  const int grp = h >> 3;
  const int c = d ? nch - 1 - ci : ci;
  const int tok0 = b * Ls + c * 128;
  const u16* xbc = (const u16*)(p.ws + OFF_XBC);
  const float* dtb = (const float*)(p.ws + OFF_DT);
  const int lane = tid & 63, wave = tid >> 6;
#define SSD_LDCB(i, CF, BF) { int idx = tid + i * 512; int row = idx >> 4, ch = idx & 15; \
    const u16* src = xbc + (size_t)(tok0 + row) * 3072 + grp * 128 + ch * 8; R.CF = *(const v4u*)(src + 2560); R.BF = *(const v4u*)(src + 2048); }
  SSD_LDCB(0, c0, b0) SSD_LDCB(1, c1, b1) SSD_LDCB(2, c2, b2) SSD_LDCB(3, c3, b3)
#undef SSD_LDCB
#define SSD_LDX(i, XF) { int idx = tid + i * 512; int l = idx >> 3, ch = idx & 7; R.XF = *(const v4u*)(xbc + (size_t)(tok0 + l) * 3072 + h * 64 + ch * 8); }
  SSD_LDX(0, x0) SSD_LDX(1, x1)
#undef SSD_LDX
  if (wave == 0) {
    int e0 = 2 * lane, e1 = 2 * lane + 1;
    int l0 = d ? 127 - e0 : e0, l1 = d ? 127 - e1 : e1;
    R.d0 = dtb[(size_t)(tok0 + l0) * 64 + d * 32 + h];
    R.d1 = dtb[(size_t)(tok0 + l1) * 64 + d * 32 + h];
  }
}

__device__ __forceinline__ void ssd_chain(const Params& p, char* smem, int g, int chain, int next_chain, SsdPre& R) {
  char* ws = p.ws;
  const int tid = get_tid(), lane = tid & 63, wave = tid >> 6;
  const int Ls = g < 2 ? 256 : 2048;
  const int nch = Ls >> 7;
  const int d = chain & 1, h = (chain >> 1) & 31, b = chain >> 6;
  const int grp = h >> 3;
  const u16* xbc = (const u16*)(ws + OFF_XBC);
  const float* dtb = (const float*)(ws + OFF_DT);
  u16* yout = (u16*)(ws + (d ? OFF_SYB : OFF_SYF));
  char* Cs = smem;
  char* Bs = smem + 32768;
  char* BdT = smem + 65536;
  char* XT = smem + 98304;
  char* Ss = smem + 114688;
  float* csum = (float*)(smem + 131072);
  float* dts = (float*)(smem + 131584);
  const float a_h = -__expf(p.a_log[d * 32 + h]);
  const float dtbias = p.dt_bias[d * 32 + h];
  f32x4 sacc[2][2];
  {
    const int wn4 = wave >> 1, wp2 = wave & 1;
#pragma unroll
    for (int nf = 0; nf < 2; ++nf)
#pragma unroll
      for (int pf = 0; pf < 2; ++pf) {
        if (g == 2) {
          const float* h0 = (d ? p.ssm_b : p.ssm_f) + (size_t)(b * 32 + h) * 8192;
          const int n0 = wn4 * 32 + nf * 16 + (lane >> 4) * 4, pp = wp2 * 32 + pf * 16 + (lane & 15);
          const float4 t = *(const float4*)(h0 + pp * 128 + n0);
          sacc[nf][pf] = f32x4{t.x, t.y, t.z, t.w};
        } else {
          sacc[nf][pf] = f32x4{0.f, 0.f, 0.f, 0.f};
        }
      }
  }
  const int tid_outer = tid;
  for (int ci = 0; ci < nch; ++ci) {
    int tidv = tid_outer;
    asm volatile("" : "+v"(tidv));
    const int tid = tidv, lane = tidv & 63, wave = tidv >> 6;
    const int wq4 = wave >> 1, wq2 = wave & 1;
    const int c = d ? nch - 1 - ci : ci;
    const int tok0 = b * Ls + c * 128;
#define SSD_STCB(i, CF, BF) { int idx = tid + i * 512; int row = idx >> 4, ch = idx & 15; \
      *(v4u*)(Cs + row * 256 + ((ch ^ swz16(row)) << 4)) = R.CF; *(v4u*)(Bs + row * 256 + ((ch ^ swz16(row)) << 4)) = R.BF; }
    SSD_STCB(0, c0, b0) SSD_STCB(1, c1, b1) SSD_STCB(2, c2, b2) SSD_STCB(3, c3, b3)
#undef SSD_STCB
#define SSD_STX(i, XF) { int idx = tid + i * 512; int l = idx >> 3, ch = idx & 7; \
      const unsigned w0 = R.XF[0], w1 = R.XF[1], w2 = R.XF[2], w3 = R.XF[3]; \
      *(u16*)(XT + sw256(ch * 8 + 0, l)) = (u16)(w0 & 0xffff); *(u16*)(XT + sw256(ch * 8 + 1, l)) = (u16)(w0 >> 16); \
      *(u16*)(XT + sw256(ch * 8 + 2, l)) = (u16)(w1 & 0xffff); *(u16*)(XT + sw256(ch * 8 + 3, l)) = (u16)(w1 >> 16); \
      *(u16*)(XT + sw256(ch * 8 + 4, l)) = (u16)(w2 & 0xffff); *(u16*)(XT + sw256(ch * 8 + 5, l)) = (u16)(w2 >> 16); \
      *(u16*)(XT + sw256(ch * 8 + 6, l)) = (u16)(w3 & 0xffff); *(u16*)(XT + sw256(ch * 8 + 7, l)) = (u16)(w3 >> 16); }
    SSD_STX(0, x0) SSD_STX(1, x1)
#undef SSD_STX
    if (wave == 0) {
      int e0 = 2 * lane, e1 = 2 * lane + 1;
      int l0 = d ? 127 - e0 : e0, l1 = d ? 127 - e1 : e1;
      float x0 = R.d0 + dtbias;
      float x1 = R.d1 + dtbias;
      float dt0 = x0 > 20.f ? x0 : log1pf(__expf(x0));
      float dt1 = x1 > 20.f ? x1 : log1pf(__expf(x1));
      float a0 = dt0 * a_h, a1 = dt1 * a_h;
      float s = a0 + a1;
#pragma unroll
      for (int o = 1; o < 64; o <<= 1) {
        float t = __shfl_up(s, o);
        if (lane >= o) s += t;
      }
      csum[l1] = s;
      csum[l0] = s - a1;
      dts[l0] = dt0;
      dts[l1] = dt1;
    }
    if (ci + 1 < nch) ssd_issue(p, g, chain, ci + 1, tid, R);
    else if (next_chain >= 0) ssd_issue(p, g, next_chain, 0, tid, R);
#pragma unroll
    for (int nf = 0; nf < 2; ++nf)
#pragma unroll
      for (int pf = 0; pf < 2; ++pf) {
        const int n0 = wq4 * 32 + nf * 16 + (lane >> 4) * 4, pp = wq2 * 32 + pf * 16 + (lane & 15);
        *(uint2*)(Ss + sw256(pp, n0)) = uint2{pack2(sacc[nf][pf][0], sacc[nf][pf][1]), pack2(sacc[nf][pf][2], sacc[nf][pf][3])};
      }
    __syncthreads();
    const float cstot = csum[d ? 0 : 127];
#pragma unroll
    for (int i = 0; i < 4; ++i) {
      int idx = tid + i * 512;
      int l = idx >> 4, ch = idx & 15;
      uint4 bv = *(const uint4*)(Bs + l * 256 + ((ch ^ swz16(l)) << 4));
      float f = dts[l] * __expf(cstot - csum[l]);
      unsigned w[4] = {bv.x, bv.y, bv.z, bv.w};
#pragma unroll
      for (int e = 0; e < 8; ++e) {
        int n = ch * 8 + e;
        float val = bf2f((u16)((w[e >> 1] >> ((e & 1) * 16)) & 0xffff)) * f;
        *(u16*)(BdT + sw256(n, l)) = f2bf(val);
      }
    }
    f32x4 gacc[2][4];
#pragma unroll
    for (int i = 0; i < 2; ++i)
#pragma unroll
      for (int j = 0; j < 4; ++j) gacc[i][j] = f32x4{0.f, 0.f, 0.f, 0.f};
#pragma unroll
    for (int ks = 0; ks < 4; ++ks) {
      int ch = ks * 4 + (lane >> 4);
      bf16x8 a[2], bb[4];
#pragma unroll
      for (int sf = 0; sf < 2; ++sf) a[sf] = ldfrag256(Bs, wq4 * 32 + sf * 16 + (lane & 15), ch);
#pragma unroll
      for (int lf = 0; lf < 4; ++lf) bb[lf] = ldfrag256(Cs, wq2 * 64 + lf * 16 + (lane & 15), ch);
#pragma unroll
      for (int sf = 0; sf < 2; ++sf)
#pragma unroll
        for (int lf = 0; lf < 4; ++lf)
          gacc[sf][lf] = __builtin_amdgcn_mfma_f32_16x16x32_bf16(a[sf], bb[lf], gacc[sf][lf], 0, 0, 0);
    }
    {
      float css[2][4], dss[2][4];
#pragma unroll
      for (int sf = 0; sf < 2; ++sf)
#pragma unroll
        for (int j = 0; j < 4; ++j) {
          const int sI = wq4 * 32 + sf * 16 + (lane >> 4) * 4 + j;
          css[sf][j] = csum[sI];
          dss[sf][j] = dts[sI];
        }
#pragma unroll
      for (int lf = 0; lf < 4; ++lf) {
        const int l = wq2 * 64 + lf * 16 + (lane & 15);
        const float csl = csum[l];
#pragma unroll
        for (int sf = 0; sf < 2; ++sf)
#pragma unroll
          for (int j = 0; j < 4; ++j) {
            const int sI = wq4 * 32 + sf * 16 + (lane >> 4) * 4 + j;
            const bool valid = d ? (sI >= l) : (sI <= l);
            const float e = valid ? __expf(csl - css[sf][j]) * dss[sf][j] : 0.f;
            gacc[sf][lf][j] *= e;
          }
      }
    }
    __syncthreads();
#pragma unroll
    for (int sf = 0; sf < 2; ++sf)
#pragma unroll
      for (int lf = 0; lf < 4; ++lf) {
        const int s0 = wq4 * 32 + sf * 16 + (lane >> 4) * 4, l = wq2 * 64 + lf * 16 + (lane & 15);
        *(uint2*)(Bs + sw256(l, s0)) = uint2{pack2(gacc[sf][lf][0], gacc[sf][lf][1]), pack2(gacc[sf][lf][2], gacc[sf][lf][3])};
      }
    __syncthreads();
    {
      f32x4 yacc[2][2];
#pragma unroll
      for (int i = 0; i < 2; ++i)
#pragma unroll
        for (int j = 0; j < 2; ++j) yacc[i][j] = f32x4{0.f, 0.f, 0.f, 0.f};
#pragma unroll
      for (int ks = 0; ks < 4; ++ks) {
        int ch = ks * 4 + (lane >> 4);
        bf16x8 a[2], bb[2];
#pragma unroll
        for (int pf = 0; pf < 2; ++pf) a[pf] = ldfrag256(Ss, wq2 * 32 + pf * 16 + (lane & 15), ch);
#pragma unroll
        for (int lf = 0; lf < 2; ++lf) bb[lf] = ldfrag256(Cs, wq4 * 32 + lf * 16 + (lane & 15), ch);
#pragma unroll
        for (int pf = 0; pf < 2; ++pf)
#pragma unroll
          for (int lf = 0; lf < 2; ++lf)
            yacc[pf][lf] = __builtin_amdgcn_mfma_f32_16x16x32_bf16(a[pf], bb[lf], yacc[pf][lf], 0, 0, 0);
      }
#pragma unroll
      for (int lf = 0; lf < 2; ++lf) {
        const float e = __expf(csum[wq4 * 32 + lf * 16 + (lane & 15)]);
#pragma unroll
        for (int pf = 0; pf < 2; ++pf) yacc[pf][lf] *= e;
      }
#pragma unroll
      for (int ks = 0; ks < 4; ++ks) {
        int ch = ks * 4 + (lane >> 4);
        bf16x8 a[2], bb[2];
#pragma unroll
        for (int pf = 0; pf < 2; ++pf) a[pf] = ldfrag256(XT, wq2 * 32 + pf * 16 + (lane & 15), ch);
#pragma unroll
        for (int lf = 0; lf < 2; ++lf) bb[lf] = ldfrag256(Bs, wq4 * 32 + lf * 16 + (lane & 15), ch);
#pragma unroll
        for (int pf = 0; pf < 2; ++pf)
#pragma unroll
          for (int lf = 0; lf < 2; ++lf)
            yacc[pf][lf] = __builtin_amdgcn_mfma_f32_16x16x32_bf16(a[pf], bb[lf], yacc[pf][lf], 0, 0, 0);
      }
#pragma unroll
      for (int pf = 0; pf < 2; ++pf)
#pragma unroll
        for (int lf = 0; lf < 2; ++lf) {
          const int p0 = wq2 * 32 + pf * 16 + (lane >> 4) * 4, l = wq4 * 32 + lf * 16 + (lane & 15);
          *(uint2*)(yout + (size_t)(tok0 + l) * 2048 + h * 64 + p0) = uint2{pack2(yacc[pf][lf][0], yacc[pf][lf][1]), pack2(yacc[pf][lf][2], yacc[pf][lf][3])};
        }
    }
    {
      float e = __expf(cstot);
#pragma unroll
      for (int nf = 0; nf < 2; ++nf)
#pragma unroll
        for (int pf = 0; pf < 2; ++pf) sacc[nf][pf] *= e;
#pragma unroll
      for (int ks = 0; ks < 4; ++ks) {
        int ch = ks * 4 + (lane >> 4);
        bf16x8 a[2], bb[2];
#pragma unroll
        for (int nf = 0; nf < 2; ++nf) a[nf] = ldfrag256(BdT, wq4 * 32 + nf * 16 + (lane & 15), ch);
#pragma unroll
        for (int pf = 0; pf < 2; ++pf) bb[pf] = ldfrag256(XT, wq2 * 32 + pf * 16 + (lane & 15), ch);
#pragma unroll
        for (int nf = 0; nf < 2; ++nf)
#pragma unroll
          for (int pf = 0; pf < 2; ++pf)
            sacc[nf][pf] = __builtin_amdgcn_mfma_f32_16x16x32_bf16(a[nf], bb[pf], sacc[nf][pf], 0, 0, 0);
      }
    }
    __syncthreads();
  }
  if (g < 2) {
    float* so = p.out + (d ? OUT_SSMB : OUT_SSMF) + (size_t)((g * 16 + b) * 32 + h) * 8192;
    const int wn4 = wave >> 1, wp2 = wave & 1;
#pragma unroll
    for (int nf = 0; nf < 2; ++nf)
#pragma unroll
      for (int pf = 0; pf < 2; ++pf) {
        const int n0 = wn4 * 32 + nf * 16 + (lane >> 4) * 4, pp = wp2 * 32 + pf * 16 + (lane & 15);
        *(float4*)(so + pp * 128 + n0) = float4{sacc[nf][pf][0], sacc[nf][pf][1], sacc[nf][pf][2], sacc[nf][pf][3]};
      }
  }
}


template <bool SEG>
__device__ __forceinline__ void wkv_pair(const Params& p, char* smem, int g, int item) {
  char* ws = p.ws;
  const int tid = get_tid(), lane = tid & 63, wave = tid >> 6;
  const int Ls = SEG ? 2048 : 256;
  const __half* wk = (const __half*)(ws + OFF_WK);
  float* stage = (float*)smem;
  float* ylds = (float*)(smem + 98304);
  const bool cw = true;
  const int slot = wave >> 2, wq = wave & 3;
  const int ig = lane >> 3, jg = lane & 7;
  const int row0 = wq * 16 + ig * 2;
  const int chain = SEG ? (item >> 3) : item * 2 + slot;
  const int seg = SEG ? (item & 7) : 0;
  const bool act = cw && (SEG ? !(slot == 1 && seg == 0) : true);
  const int d = chain & 1, h = (chain >> 1) & 15, b = chain >> 5;
  typedef float f2 __attribute__((ext_vector_type(2)));
  f2 S[2][4];
#pragma unroll
  for (int rr = 0; rr < 2; ++rr) {
    if (SEG) {
      if (slot == 0) {
        if (seg == 0) {
          const float* s0 = (d ? p.wkv_b : p.wkv_f) + ((size_t)(b * 16 + h) * 64 + row0 + rr) * 64 + jg * 8;
#pragma unroll
          for (int c = 0; c < 4; ++c) S[rr][c] = f2{s0[2 * c], s0[2 * c + 1]};
        } else {
#pragma unroll
          for (int c = 0; c < 4; ++c) S[rr][c] = f2{0.f, 0.f};
        }
      } else {
#pragma unroll
        for (int c = 0; c < 4; ++c) S[rr][c] = f2{(row0 + rr == jg * 8 + 2 * c) ? 1.f : 0.f, (row0 + rr == jg * 8 + 2 * c + 1) ? 1.f : 0.f};
      }
    } else {
#pragma unroll
      for (int c = 0; c < 4; ++c) S[rr][c] = f2{0.f, 0.f};
    }
  }
  const int pair = tid >> 4, lslot = pair >> 4, lstep = pair & 15, sub = tid & 15;
  const int lch = SEG ? (item >> 3) : item * 2 + lslot;
  const int ld = lch & 1, lh = (lch >> 1) & 15, lb = lch >> 5;
  const bool ldo = SEG ? (lslot == 0) : true;
  const int sbase = seg * 256;
  const int cslot = SEG ? 0 : slot;
  float ka[4];
#pragma unroll
  for (int e = 0; e < 4; ++e) ka[e] = p.k_a[lh * 64 + sub * 4 + e];
  u16* yout;
  if (SEG) yout = lslot == 0 ? (u16*)(ws + (ld ? OFF_WYB : OFF_WYF)) : (u16*)(ws + OFF_YM) + (ld ? (size_t)TG * 1024 : 0);
  else yout = (u16*)(ws + (ld ? OFF_WYB : OFF_WYF));
  const bool ywr = SEG ? (lslot == 0 || seg > 0) : true;
  uint2 rg[6];
  auto prefetch = [&](int tb) {
    int s = sbase + tb * 16 + lstep;
    int pos = ld ? Ls - 1 - s : s;
    int r = lb * Ls + pos;
    const __half* rec = wk + ((size_t)(r * 16 + lh) * 8) * 64 + sub * 4;
    rg[0] = *(const uint2*)(rec + 0 * 64);
    rg[1] = *(const uint2*)(rec + 1 * 64);
    rg[2] = *(const uint2*)(rec + 2 * 64);
    rg[3] = *(const uint2*)(rec + 3 * 64);
    rg[4] = *(const uint2*)(rec + (4 + 2 * ld) * 64);
    rg[5] = *(const uint2*)(rec + (5 + 2 * ld) * 64);
  };
  auto unpack4 = [&](uint2 u, float (&o)[4]) {
    __half2 h0 = *reinterpret_cast<__half2*>(&u.x);
    __half2 h1 = *reinterpret_cast<__half2*>(&u.y);
    float2 f0 = __half22float2(h0), f1 = __half22float2(h1);
    o[0] = f0.x; o[1] = f0.y; o[2] = f1.x; o[3] = f1.y;
  };
  auto stage_store = [&](int buf) {
    float r_[4], v_[4], k_[4], nkk_[4], w_[4], a_[4];
    unpack4(rg[0], r_); unpack4(rg[1], v_); unpack4(rg[2], k_); unpack4(rg[3], nkk_); unpack4(rg[4], w_); unpack4(rg[5], a_);
    float b_[4], kd_[4];
#pragma unroll
    for (int e = 0; e < 4; ++e) {
      b_[e] = -nkk_[e] * a_[e];
      kd_[e] = k_[e] * (1.f + (a_[e] - 1.f) * ka[e]);
    }
    float* dst = stage + ((size_t)((buf * 2 + lslot) * 16 + lstep) * 6) * 64 + sub * 4;
    *(float4*)(dst + 0 * 64) = float4{nkk_[0], nkk_[1], nkk_[2], nkk_[3]};
    *(float4*)(dst + 1 * 64) = float4{w_[0], w_[1], w_[2], w_[3]};
    *(float4*)(dst + 2 * 64) = float4{b_[0], b_[1], b_[2], b_[3]};
    *(float4*)(dst + 3 * 64) = float4{kd_[0], kd_[1], kd_[2], kd_[3]};
    *(float4*)(dst + 4 * 64) = float4{r_[0], r_[1], r_[2], r_[3]};
    *(float4*)(dst + 5 * 64) = float4{v_[0], v_[1], v_[2], v_[3]};
  };
  if (ldo) { prefetch(0); stage_store(0); }
  __syncthreads();
  for (int tb = 0; tb < 16; ++tb) {
    const bool more = tb + 1 < 16;
    if (more && ldo) prefetch(tb + 1);
    if (act) {
      const float* sb = stage + ((size_t)(((tb & 1) * 2 + cslot) * 16) * 6) * 64;
      for (int sg = 0; sg < 8; ++sg) {
        float ysv[2][2];
#pragma unroll
        for (int s4 = 0; s4 < 2; ++s4) {
          const int st = sg * 2 + s4;
          const float* v6 = sb + st * 384 + jg * 8;
          f2 nkk[4], w[4], bb[4], kd[4], rr[4];
#pragma unroll
          for (int q = 0; q < 2; ++q) {
            float4 t0 = *(const float4*)(v6 + 0 * 64 + q * 4);
            nkk[q * 2] = f2{t0.x, t0.y}; nkk[q * 2 + 1] = f2{t0.z, t0.w};
            float4 t1 = *(const float4*)(v6 + 1 * 64 + q * 4);
            w[q * 2] = f2{t1.x, t1.y}; w[q * 2 + 1] = f2{t1.z, t1.w};
            float4 t2 = *(const float4*)(v6 + 2 * 64 + q * 4);
            bb[q * 2] = f2{t2.x, t2.y}; bb[q * 2 + 1] = f2{t2.z, t2.w};
            float4 t3 = *(const float4*)(v6 + 3 * 64 + q * 4);
            kd[q * 2] = f2{t3.x, t3.y}; kd[q * 2 + 1] = f2{t3.z, t3.w};
            float4 t4 = *(const float4*)(v6 + 4 * 64 + q * 4);
            rr[q * 2] = f2{t4.x, t4.y}; rr[q * 2 + 1] = f2{t4.z, t4.w};
          }
          float2 vv2 = *(const float2*)(sb + st * 384 + 5 * 64 + row0);
          float vi[2] = {vv2.x, vv2.y};
          if (SEG && slot == 1) { vi[0] = 0.f; vi[1] = 0.f; }
#pragma unroll
          for (int r2 = 0; r2 < 2; ++r2) {
            f2 sa2a = S[r2][0] * nkk[0], sa2b = S[r2][1] * nkk[1];
            sa2a += S[r2][2] * nkk[2]; sa2b += S[r2][3] * nkk[3];
            f2 sat = sa2a + sa2b;
            float sa = sat.x + sat.y;
            sa += dpp_xor1(sa);
            sa += dpp_xor2(sa);
            sa += dpp_hmirror(sa);
            f2 y2a, y2b;
            {
              f2 t0 = S[r2][0] * w[0] + vi[r2] * kd[0]; S[r2][0] = t0 + sa * bb[0]; y2a = S[r2][0] * rr[0];
              f2 t1 = S[r2][1] * w[1] + vi[r2] * kd[1]; S[r2][1] = t1 + sa * bb[1]; y2b = S[r2][1] * rr[1];
              f2 t2 = S[r2][2] * w[2] + vi[r2] * kd[2]; S[r2][2] = t2 + sa * bb[2]; y2a += S[r2][2] * rr[2];
              f2 t3 = S[r2][3] * w[3] + vi[r2] * kd[3]; S[r2][3] = t3 + sa * bb[3]; y2b += S[r2][3] * rr[3];
            }
            f2 yt = y2a + y2b;
            float y = yt.x + yt.y;
            y += dpp_xor1(y);
            y += dpp_xor2(y);
            y += dpp_hmirror(y);
            ysv[s4][r2] = y;
          }
        }
        if (jg == 0) {
#pragma unroll
          for (int s4 = 0; s4 < 2; ++s4)
            *(float2*)(ylds + (slot * 16 + sg * 2 + s4) * 64 + row0) = float2{ysv[s4][0], ysv[s4][1]};
        }
      }
    }
    __syncthreads();
    if (more && ldo) stage_store((tb + 1) & 1);
    if (ywr) {
      int s = sbase + tb * 16 + lstep;
      int pos = ld ? Ls - 1 - s : s;
      int r = lb * Ls + pos;
      float4 yv = *(const float4*)(ylds + (lslot * 16 + lstep) * 64 + sub * 4);
      *(uint2*)(yout + (size_t)r * 1024 + lh * 64 + sub * 4) = uint2{pack2(yv.x, yv.y), pack2(yv.z, yv.w)};
    }
    __syncthreads();
  }
  if (act) {
#pragma unroll
    for (int r2 = 0; r2 < 2; ++r2) {
      float* so;
      if (SEG) so = p.out + 8388608 + ((size_t)((chain * 8 + seg) * 2 + slot)) * 4096 + (row0 + r2) * 64 + jg * 8;
      else so = p.out + (d ? OUT_WKVB : OUT_WKVF) + ((size_t)((g * 16 + b) * 16 + h) * 64 + row0 + r2) * 64 + jg * 8;
#pragma unroll
      for (int c = 0; c < 4; ++c) { so[2 * c] = S[r2][c].x; so[2 * c + 1] = S[r2][c].y; }
    }
  }
}

__device__ __forceinline__ void wkv_fix(const Params& p, char* smem, int item) {
  const int chain = item >> 2, qt = item & 3;
  char* ws = p.ws;
  const int tid = get_tid(), lane = tid & 63, wave = tid >> 6;
  const int d = chain & 1, h = (chain >> 1) & 15, b = chain >> 5;
  const float* SE = p.out + 8388608;
  u16* yout = (u16*)(ws + (d ? OFF_WYB : OFF_WYF));
  const u16* Q = (const u16*)(ws + OFF_YM) + (d ? (size_t)TG * 1024 : 0);
  float* Pl = (float*)smem;
  float* Sl = (float*)(smem + 16384);
  u16* Ql = (u16*)(smem + 36864);
  const int i = lane;
  float S0[64];
  {
    const float* src = SE + ((size_t)(chain * 8) * 2) * 4096 + i * 64;
#pragma unroll
    for (int j = 0; j < 16; ++j) {
      float4 t = *(const float4*)(src + j * 4);
      S0[j * 4] = t.x; S0[j * 4 + 1] = t.y; S0[j * 4 + 2] = t.z; S0[j * 4 + 3] = t.w;
    }
  }
  for (int k = 1; k < 8; ++k) {
    {
      int tt = qt * 64 + (tid >> 3), ch = tid & 7;
      int s = k * 256 + tt;
      int pos = d ? 2047 - s : s;
      int r = b * 2048 + pos;
      *(uint4*)(Ql + tt * 64 + ch * 8) = *(const uint4*)(Q + (size_t)r * 1024 + h * 64 + ch * 8);
    }
    if (k < 7) {
      const float* src = SE + ((size_t)((chain * 8 + k) * 2 + 1)) * 4096;
#pragma unroll
      for (int e = 0; e < 2; ++e) ((float4*)Pl)[tid + e * 512] = ((const float4*)src)[tid + e * 512];
    }
    __syncthreads();
    for (int n = 0; n < 8; ++n) {
      int tt = qt * 64 + wave + n * 8;
      float a0 = 0.f, a1 = 0.f;
#pragma unroll
      for (int jc = 0; jc < 8; ++jc) {
        float q[8];
        unpack8(*(const uint4*)(Ql + tt * 64 + jc * 8), q);
#pragma unroll
        for (int e = 0; e < 8; e += 2) { a0 += S0[jc * 8 + e] * q[e]; a1 += S0[jc * 8 + e + 1] * q[e + 1]; }
      }
      int s = k * 256 + tt;
      int pos = d ? 2047 - s : s;
      size_t off = (size_t)(b * 2048 + pos) * 1024 + h * 64 + i;
      yout[off] = f2bf(bf2f(yout[off]) + (a0 + a1));
    }
    if (k < 7) {
      float nv[8];
      const float* sl = SE + ((size_t)((chain * 8 + k) * 2)) * 4096 + i * 64 + wave * 8;
      {
        float4 t0 = *(const float4*)sl, t1 = *(const float4*)(sl + 4);
        nv[0] = t0.x; nv[1] = t0.y; nv[2] = t0.z; nv[3] = t0.w; nv[4] = t1.x; nv[5] = t1.y; nv[6] = t1.z; nv[7] = t1.w;
      }
#pragma unroll
      for (int m = 0; m < 64; ++m) {
        float4 p0 = *(const float4*)(Pl + m * 64 + wave * 8), p1 = *(const float4*)(Pl + m * 64 + wave * 8 + 4);
        nv[0] += S0[m] * p0.x; nv[1] += S0[m] * p0.y; nv[2] += S0[m] * p0.z; nv[3] += S0[m] * p0.w;
        nv[4] += S0[m] * p1.x; nv[5] += S0[m] * p1.y; nv[6] += S0[m] * p1.z; nv[7] += S0[m] * p1.w;
      }
      *(float4*)(Sl + i * 68 + wave * 8) = float4{nv[0], nv[1], nv[2], nv[3]};
      *(float4*)(Sl + i * 68 + wave * 8 + 4) = float4{nv[4], nv[5], nv[6], nv[7]};
      __syncthreads();
#pragma unroll
      for (int j = 0; j < 16; ++j) {
        float4 t = *(const float4*)(Sl + i * 68 + j * 4);
        S0[j * 4] = t.x; S0[j * 4 + 1] = t.y; S0[j * 4 + 2] = t.z; S0[j * 4 + 3] = t.w;
      }
    }
    __syncthreads();
  }
}

__device__ __forceinline__ void step_scan(const Params& p, char* smem, int g, int parts) {
  const int G = gridDim.x;
  const int r1 = (parts & 1) ? ((RM & (1 << 20)) ? 2 : 1) : 0, r2 = (parts & 2) ? ((RM & (1 << 21)) ? 2 : 1) : 0;
  if (g < 2) {
    for (int rr = 0; rr < r1; ++rr) {
      SsdPre R;
      if ((int)blockIdx.x < 1024) ssd_issue(p, g, blockIdx.x, 0, get_tid(), R);
      for (int ch = blockIdx.x; ch < 1024; ch += G) ssd_chain(p, smem, g, ch, ch + G < 1024 ? ch + G : -1, R);
    }
    for (int rr = 0; rr < r2; ++rr) for (int it = blockIdx.x; it < 256; it += G) wkv_pair<false>(p, smem, g, it);
  } else {
    for (int rr = 0; rr < r1; ++rr) {
      SsdPre R;
      if ((int)blockIdx.x < 128) ssd_issue(p, g, blockIdx.x, 0, get_tid(), R);
      for (int ch = blockIdx.x; ch < 128; ch += G) ssd_chain(p, smem, g, ch, ch + G < 128 ? ch + G : -1, R);
    }
    for (int rr = 0; rr < r2; ++rr) for (int it = (G - 1 - blockIdx.x); it < 512; it += G) wkv_pair<true>(p, smem, g, it);
  }
}
__device__ __forceinline__ void step_fix(const Params& p, char* smem) {
  for (int it = blockIdx.x; it < 256; it += gridDim.x) wkv_fix(p, smem, it);
}

__device__ __forceinline__ void step_fin(const Params& p, int g) {
  char* ws = p.ws;
  const int tid = get_tid(), lane = tid & 63, wave = tid >> 6;
  const int gw = blockIdx.x * 8 + wave, nw = gridDim.x * 8;
  {
    const u16* yf = (const u16*)(ws + OFF_SYF);
    const u16* yb = (const u16*)(ws + OFF_SYB);
    const u16* xbc = (const u16*)(ws + OFF_XBC);
    const u16* zb = (const u16*)(ws + OFF_Z);
    u16* ym = (u16*)(ws + OFF_YM);
    for (int it = gw; it < TG * 4; it += nw) {
      int r = it >> 2, gq = it & 3;
      int ch = gq * 512 + lane * 8;
      uint4 a = *(const uint4*)(yf + (size_t)r * 2048 + ch);
      uint4 b = *(const uint4*)(yb + (size_t)r * 2048 + ch);
      uint4 x = *(const uint4*)(xbc + (size_t)r * 3072 + ch);
      uint4 z = *(const uint4*)(zb + (size_t)r * 2048 + ch);
      float dsk = p.d_skip[ch >> 6];
      unsigned aw[4] = {a.x, a.y, a.z, a.w}, bw[4] = {b.x, b.y, b.z, b.w}, xw[4] = {x.x, x.y, x.z, x.w}, zw[4] = {z.x, z.y, z.z, z.w};
      float y[8];
      float ss = 0.f;
#pragma unroll
      for (int e = 0; e < 8; ++e) {
        int sh = (e & 1) * 16;
        float yy = bf2f((u16)(aw[e >> 1] >> sh)) + bf2f((u16)(bw[e >> 1] >> sh)) + dsk * bf2f((u16)(xw[e >> 1] >> sh));
        yy *= siluf(bf2f((u16)(zw[e >> 1] >> sh)));
        y[e] = yy;
        ss += yy * yy;
      }
      ss = wave_sum(ss);
      float rinv = rsqrtf(ss * (1.f / 512.f) + 1e-5f);
      float4 w0 = *(const float4*)(p.m_norm_w + ch), w1 = *(const float4*)(p.m_norm_w + ch + 4);
      *(uint4*)(ym + (size_t)r * 2048 + ch) =
          uint4{pack2(y[0] * rinv * w0.x, y[1] * rinv * w0.y), pack2(y[2] * rinv * w0.z, y[3] * rinv * w0.w),
                pack2(y[4] * rinv * w1.x, y[5] * rinv * w1.y), pack2(y[6] * rinv * w1.z, y[7] * rinv * w1.w)};
    }
  }
  {
    const u16* __restrict__ yf = (const u16*)(ws + OFF_WYF);
    const u16* __restrict__ yb = (const u16*)(ws + OFF_WYB);
    const __half* __restrict__ wk = (const __half*)(ws + OFF_WK);
    const u16* __restrict__ gr = (const u16*)(ws + OFF_GR);
    u16* __restrict__ yr = (u16*)(ws + OFF_YR);
    for (int it = gw; it < TG * 2; it += nw) {
      const int r = it >> 1, hh = it & 1;
      const int c0 = hh * 512 + lane * 8;
      const int head = c0 >> 6;
      const uint4 a = *(const uint4*)(yf + (size_t)r * 1024 + c0);
      const uint4 b = *(const uint4*)(yb + (size_t)r * 1024 + c0);
      const uint4 gq = *(const uint4*)(gr + (size_t)r * 1024 + c0);
      const __half* rec = wk + ((size_t)(r * 16 + head) * 8) * 64 + (lane & 7) * 8;
      const uint4 qr = *(const uint4*)(rec + 0 * 64), qv = *(const uint4*)(rec + 1 * 64), qk = *(const uint4*)(rec + 2 * 64);
      const uint4 qaf = *(const uint4*)(rec + 5 * 64), qab = *(const uint4*)(rec + 7 * 64);
      const float4 lw0 = *(const float4*)(p.lnx_w + c0), lw1 = *(const float4*)(p.lnx_w + c0 + 4);
      const float4 lb0 = *(const float4*)(p.lnx_b + c0), lb1 = *(const float4*)(p.lnx_b + c0 + 4);
      const float4 ka0 = *(const float4*)(p.k_a + c0), ka1 = *(const float4*)(p.k_a + c0 + 4);
      const float4 rk0 = *(const float4*)(p.r_k + c0), rk1 = *(const float4*)(p.r_k + c0 + 4);
      const float lw[8] = {lw0.x, lw0.y, lw0.z, lw0.w, lw1.x, lw1.y, lw1.z, lw1.w};
      const float lb[8] = {lb0.x, lb0.y, lb0.z, lb0.w, lb1.x, lb1.y, lb1.z, lb1.w};
      const float kav[8] = {ka0.x, ka0.y, ka0.z, ka0.w, ka1.x, ka1.y, ka1.z, ka1.w};
      const float rkv[8] = {rk0.x, rk0.y, rk0.z, rk0.w, rk1.x, rk1.y, rk1.z, rk1.w};
      float ya[8], yb8[8], gg[8];
      unpack8(a, ya); unpack8(b, yb8); unpack8(gq, gg);
      auto unph = [&](const uint4& u, float (&o)[8]) {
        const __half2* hp = reinterpret_cast<const __half2*>(&u);
#pragma unroll
        for (int e = 0; e < 4; ++e) { float2 f = __half22float2(hp[e]); o[2 * e] = f.x; o[2 * e + 1] = f.y; }
      };
      float rr[8], vv[8], kk[8], af[8], ab[8];
      unph(qr, rr); unph(qv, vv); unph(qk, kk); unph(qaf, af); unph(qab, ab);
      float y[8];
      float s1 = 0.f;
#pragma unroll
      for (int e = 0; e < 8; ++e) { y[e] = ya[e] + yb8[e]; s1 += y[e]; }
      s1 += dpp_xor1(s1); s1 += dpp_xor2(s1); s1 += dpp_hmirror(s1);
      const float mean = s1 * (1.f / 64.f);
      float s2 = 0.f, s3 = 0.f;
#pragma unroll
      for (int e = 0; e < 8; ++e) {
        const float dy = y[e] - mean;
        s2 += dy * dy;
        const float kmean = kk[e] * (1.f + (0.5f * (af[e] + ab[e]) - 1.f) * kav[e]);
        s3 += rr[e] * kmean * rkv[e];
      }
      s2 += dpp_xor1(s2); s2 += dpp_xor2(s2); s2 += dpp_hmirror(s2);
      s3 += dpp_xor1(s3); s3 += dpp_xor2(s3); s3 += dpp_hmirror(s3);
      const float rs = rsqrtf(s2 * (1.f / 64.f) + 64e-5f);
      float o[8];
#pragma unroll
      for (int e = 0; e < 8; ++e) o[e] = ((y[e] - mean) * rs * lw[e] + lb[e] + s3 * vv[e]) * gg[e];
      *(uint4*)(yr + (size_t)r * 1024 + c0) = uint4{pack2(o[0], o[1]), pack2(o[2], o[3]), pack2(o[4], o[5]), pack2(o[6], o[7])};
    }
  }
}

__device__ __forceinline__ void step_outproj(const Params& p, char* smem, int g) {
  char* ws = p.ws;
  const int sub = blockIdx.x >> 6, vb = blockIdx.x & 63;
  if (sub < 3) {
    const u16* A = sub == 2 ? (const u16*)(ws + OFF_YR) : (const u16*)(ws + OFF_YM) + sub * 1024;
    const u16* B = sub == 2 ? (const u16*)(ws + OFF_WROUT) : (const u16*)(ws + OFF_WMOUT) + sub * 1024;
    EpiOutV E{(const u16*)(ws + OFF_GATE), (u16*)(ws + OFF_XBC) + (size_t)sub * TG * 1024, sub == 2 ? 1024 : 0};
    run_gemm8(smem, A, B, TG, 1024, 1024, E, vb, 64, 0, sub == 2 ? 1024 : 2048);
  }
}
__device__ __forceinline__ void step_sum(const Params& p, int g, int vb = -1, int nb = 0) {
  const u16* __restrict__ V = (const u16*)(p.ws + OFF_XBC);
  u16* __restrict__ U = (u16*)p.out + (size_t)g * TG * 1024;
  const int tid = get_tid();
  if (vb < 0) { vb = blockIdx.x; nb = gridDim.x; }
  for (int i = vb * NTHR + tid; i < TG * 128; i += nb * NTHR) {
    float a[8], b[8], c[8];
    unpack8(*(const uint4*)(V + (size_t)i * 8), a);
    unpack8(*(const uint4*)(V + (size_t)TG * 1024 + (size_t)i * 8), b);
    unpack8(*(const uint4*)(V + (size_t)2 * TG * 1024 + (size_t)i * 8), c);
    *(uint4*)(U + (size_t)i * 8) = uint4{pack2(a[0] + b[0] + c[0], a[1] + b[1] + c[1]), pack2(a[2] + b[2] + c[2], a[3] + b[3] + c[3]),
                                         pack2(a[4] + b[4] + c[4], a[5] + b[5] + c[5]), pack2(a[6] + b[6] + c[6], a[7] + b[7] + c[7])};
  }
}

__device__ __forceinline__ void step_wo(const Params& p, char* smem, int g) {
  char* ws = p.ws;
  EpiWo E{p.x_prompt, p.x_sample, (const float*)(ws + OFF_MOD), (float*)(ws + OFF_X1), 0};
  run_gemm8(smem, (const u16*)p.out, (const u16*)(ws + OFF_WO), NTOK, 1024, 1024, E);
}

__device__ __forceinline__ void step_gu(const Params& p, char* smem) {
  char* ws = p.ws;
  EpiGU E{(u16*)(ws + OFF_ACT)};
  run_gemm8(smem, (const u16*)(ws + OFF_H2), (const u16*)(ws + OFF_WGU), NTOK, 5632, 1024, E);
}

__device__ __forceinline__ void step_down(const Params& p, char* smem) {
  char* ws = p.ws;
  EpiDown E{(const float*)(ws + OFF_MOD), (float*)(ws + OFF_X1)};
  run_gemm8(smem, (const u16*)(ws + OFF_ACT), (const u16*)(ws + OFF_WDOWN), NTOK, 1024, 2816, E, -1, 0, 1);
}

__device__ __forceinline__ void step_final(const Params& p) {
  const int tid = get_tid(), lane = tid & 63, wave = tid >> 6;
  for (int r = blockIdx.x * 8 + wave; r < NTOK; r += gridDim.x * 8) {
    const float* xr = (const float*)(p.ws + OFF_X1) + (size_t)r * 1024;
    float* xo = p.out + (size_t)r * 1024;
    float4 v[4];
    float ss = 0.f;
#pragma unroll
    for (int i = 0; i < 4; ++i) {
      v[i] = ((const float4*)xr)[i * 64 + lane];
      ss += v[i].x * v[i].x + v[i].y * v[i].y + v[i].z * v[i].z + v[i].w * v[i].w;
    }
    ss = wave_sum(ss);
    float rinv = rsqrtf(ss * (1.f / 1024.f) + 1e-6f);
#pragma unroll
    for (int i = 0; i < 4; ++i) {
      float4 w4 = ((const float4*)p.final_norm_w)[i * 64 + lane];
      ((float4*)xo)[i * 64 + lane] = float4{v[i].x * rinv * w4.x, v[i].y * rinv * w4.y, v[i].z * rinv * w4.z, v[i].w * rinv * w4.w};
    }
  }
}

constexpr int NSTEPS = 33;

__global__ void __launch_bounds__(NTHR) mega(Params p_arg) {
  const int step_lo = p_arg.step_lo, step_hi = p_arg.step_hi;
  __shared__ __attribute__((aligned(16))) char smem[SMEM_BYTES];
#if !MULTI_LAUNCH
  if (threadIdx.x == 0) *(uint4*)(smem + SMEM_BYTES - 16) = uint4{0u, 0u, 0u, 0u};
  __syncthreads();
  XcdBarrier xb = xcd_barrier_post((unsigned*)(p_arg.ws + OFF_BAR), (volatile LAS unsigned*)(smem + SMEM_BYTES - 16));
#endif
  for (int step = step_lo; step <= step_hi; ++step) {
#if defined(__HIP_DEVICE_COMPILE__)
    const __attribute__((address_space(4))) Params* pp = (const __attribute__((address_space(4))) Params*)__builtin_amdgcn_kernarg_segment_ptr();
    asm volatile("" : "+s"(pp));
    const Params p = *pp;
#else
    const Params p = p_arg;
#endif
    const int g = (step - 1) / 9, s = (step - 1) - g * 9;
    const int scode = step == 0 ? 0 : (step <= 27 ? 1 + s : step - 18);
    if (scode == 6 && g < 2) continue;
    if (scode == 1 && g > 0) continue;
    if (scode == 9 && g < 2) continue;
    const int reps = ((RM >> scode) & 1) ? 2 : 1;
    for (int rep = 0; rep < reps; ++rep) {
      if (!((SM >> scode) & 1)) continue;
      switch (scode) {
        case 0: step_prep(p, smem); break;
        case 1: step_norm<0>(p, g); break;
        case 2:
          if (g > 0 && (int)blockIdx.x >= 160 && gridDim.x > 160) step_sum(p, g - 1, (int)blockIdx.x - 160, (int)gridDim.x - 160);
          step_gemm1(p, smem, 0);
          break;
        case 3: step_cr1(p, g); break;
        case 4: step_r2(p, smem); if (g == 2) step_scan(p, smem, g, 1); break;
        case 5: step_scan(p, smem, g, g == 2 ? 2 : 3); break;
        case 6: step_fix(p, smem); break;
        case 7: step_fin(p, g); if (g < 2) step_norm<0>(p, g + 1); break;
        case 8:
          step_outproj(p, smem, g);
          if (g == 0 && blockIdx.x >= 192) {
            convT<1>(p.w_gu, 1024, 5632, (u16*)(p.ws + OFF_WGU), smem, blockIdx.x - 192, gridDim.x - 192);
            convT<2>(p.w_down, 2816, 1024, (u16*)(p.ws + OFF_WDOWN), smem, blockIdx.x - 192, gridDim.x - 192);
          }
          break;
        case 9: step_sum(p, g); break;
        case 10: step_wo(p, smem, 0); break;
        case 11: step_norm<1>(p, 0); break;
        case 12: step_gu(p, smem); break;
        case 13: if (reps == 2 && rep == 0) { Params q = p; q.out = (float*)(p.ws + (size_t)150000000); step_down(q, smem); } else step_down(p, smem); break;
        default: step_final(p); break;
      }
    }
    if (step < step_hi) {
#if !MULTI_LAUNCH
      if (step_hi > 100000) cg::this_grid().sync();
      for (int xs = 0; xs < 1 + XSYNC; ++xs) xcd_barrier(xb);
#endif
    }
  }
}

extern "C" void kernel_launch(void* const* d_in, const int* in_sizes, int n_in, void* d_out, int out_size,
                              void* d_ws, size_t ws_size, hipStream_t stream) {
  Params p{};
  const float** pp = (const float**)&p;
  for (int i = 0; i < 36; ++i) pp[i] = (const float*)d_in[i];
  p.out = (float*)d_out;
  p.ws = (char*)d_ws;
  if (ws_size < WS_NEED) fprintf(stderr, "workspace too small: %zu < %zu\n", ws_size, (size_t)WS_NEED);
#if MULTI_LAUNCH
  for (int s = 0; s < NSTEPS; ++s) {
    p.step_lo = s;
    p.step_hi = s;
    hipLaunchKernelGGL(mega, dim3(256), dim3(NTHR), 0, stream, p);
  }
#else
  static int grid_blocks = 0;
  if (!grid_blocks) {
    int dev = 0, cus = 0, per_cu = 0;
    hipGetDevice(&dev);
    hipDeviceGetAttribute(&cus, hipDeviceAttributeMultiprocessorCount, dev);
    hipOccupancyMaxActiveBlocksPerMultiprocessor(&per_cu, mega, NTHR, 0);
    if (per_cu < 1) per_cu = 1;
    if (per_cu > 1) per_cu = 1;
    grid_blocks = cus * per_cu;
  }
  p.step_lo = 0;
  p.step_hi = NSTEPS - 1;
  void* args[] = {&p};
  hipMemsetAsync((char*)d_ws + OFF_BAR, 0, XCD_BAR_WORDS_C * 4, stream);
  hipError_t e = hipLaunchCooperativeKernel((void*)mega, dim3(grid_blocks), dim3(NTHR), args, 0, stream);
  if (e != hipSuccess) fprintf(stderr, "cooperative launch failed: %s (grid %d)\n", hipGetErrorString(e), grid_blocks);
#endif
}
```

```cpp
#include <hip/hip_runtime.h>
#include <hip/hip_cooperative_groups.h>
#include <hip/hip_fp16.h>
#include <cstdio>
#include <cstdint>
namespace cg = cooperative_groups;

#ifndef MULTI_LAUNCH
#define MULTI_LAUNCH 0
#endif

#define DI __device__ __forceinline__
typedef __attribute__((ext_vector_type(8))) short bf16x8;
typedef __attribute__((ext_vector_type(4))) float f32x4;
typedef unsigned short u16;

#ifndef STEP_MASK
#define STEP_MASK 0xffffff
#endif
constexpr int SM = STEP_MASK;
#ifndef REPEAT_MASK
#define REPEAT_MASK 0
#endif
#ifndef XSYNC
#define XSYNC 0
#endif
constexpr int RM = REPEAT_MASK;
constexpr int TG = 4096;
constexpr int NTOK = 12288;
constexpr int NPAD = 10752;
constexpr int NTHR = 512;
constexpr int SMEM_BYTES = 133120;
constexpr int XCD_BAR_WORDS_C = 3456;

constexpr size_t OFF_WIN = 0;
constexpr size_t OFF_WGU = OFF_WIN + (size_t)NPAD * 1024 * 2;
constexpr size_t OFF_WDOWN = OFF_WGU + (size_t)5632 * 1024 * 2;
constexpr size_t OFF_WMOUT = OFF_WDOWN + (size_t)1024 * 2816 * 2;
constexpr size_t OFF_WROUT = OFF_WMOUT + (size_t)1024 * 2048 * 2;
constexpr size_t OFF_WO = OFF_WROUT + (size_t)1024 * 1024 * 2;
constexpr size_t OFF_W2T = OFF_WO + (size_t)1024 * 1024 * 2;
constexpr size_t OFF_A2T = OFF_W2T + 262144;
constexpr size_t OFF_G2T = OFF_A2T + 262144;
constexpr size_t OFF_MOD = OFF_G2T + 262144;
constexpr size_t OFF_GRP = OFF_MOD + 73728;
constexpr size_t OFF_Z = OFF_GRP;
constexpr size_t OFF_GATE = OFF_Z + (size_t)TG * 2048 * 2;
constexpr size_t OFF_XBC = OFF_GATE + (size_t)TG * 2048 * 2;
constexpr size_t OFF_WK = OFF_XBC + (size_t)TG * 3072 * 2;
constexpr size_t OFF_GR = OFF_WK + (size_t)TG * 16 * 1024;
constexpr size_t OFF_DT = OFF_GR + (size_t)TG * 1024 * 2;
constexpr size_t OFF_TL = OFF_DT + (size_t)TG * 64 * 4;
constexpr size_t OFF_SG = OFF_TL + (size_t)TG * 256 * 2;
constexpr size_t OFF_R = OFF_SG + (size_t)TG * 128 * 2;
constexpr size_t OFF_H1 = OFF_R;
constexpr size_t OFF_XBCRAW = OFF_H1 + (size_t)TG * 1024 * 2;
constexpr size_t OFF_RW = OFF_XBCRAW + (size_t)TG * 3072 * 2;
constexpr size_t OFF_SYF = OFF_R;
constexpr size_t OFF_SYB = OFF_SYF + (size_t)TG * 2048 * 2;
constexpr size_t OFF_WYF = OFF_SYB + (size_t)TG * 2048 * 2;
constexpr size_t OFF_WYB = OFF_WYF + (size_t)TG * 1024 * 2;
constexpr size_t OFF_YM = OFF_WYB + (size_t)TG * 1024 * 2;
constexpr size_t OFF_YR = OFF_YM + (size_t)TG * 2048 * 2;
constexpr size_t OFF_END = OFF_YR + (size_t)TG * 1024 * 2;
constexpr size_t OFF_BAR = OFF_END;
constexpr size_t OFF_W4T = OFF_BAR + 16384;
constexpr size_t WS_NEED = OFF_W4T + (size_t)4096 * 256 * 2;
constexpr size_t OFF_U = OFF_XBC;
constexpr size_t OFF_H2 = OFF_GRP;
constexpr size_t OFF_ACT = OFF_H2 + (size_t)NTOK * 1024 * 2;
constexpr size_t H1_OUT_OFF = 25165824;
constexpr size_t OFF_X1 = OFF_ACT + (size_t)NTOK * 2816 * 2;

constexpr size_t OUT_SSMF = 12582912;
constexpr size_t OUT_SSMB = OUT_SSMF + 8388608;
constexpr size_t OUT_WKVF = OUT_SSMB + 8388608;
constexpr size_t OUT_WKVB = OUT_WKVF + 2097152;

struct Params {
  const float *x_prompt, *x_sample, *ssm_f, *ssm_b, *wkv_f, *wkv_b, *c, *c_ctx, *norm1_w, *norm2_w,
      *w_ada, *b_ada, *w_in, *conv_w, *conv_b, *dt_bias, *a_log, *d_skip, *m_norm_w, *mu_shift, *w0,
      *w2, *a0, *a2, *g2, *k_k, *k_a, *r_k, *lnx_w, *lnx_b, *w_m_out, *w_r_out, *w_o, *w_gu, *w_down,
      *final_norm_w;
  float* out;
  char* ws;
  int step_lo, step_hi;
};

DI int get_tid() {
  int t = threadIdx.x;
  asm volatile("" : "+v"(t));
  return t;
}
DI u16 f2bf(float f) {
  unsigned u = __float_as_uint(f);
  u += 0x7fffu + ((u >> 16) & 1u);
  return (u16)(u >> 16);
}
DI float bf2f(u16 h) { return __uint_as_float(((unsigned)h) << 16); }
DI float siluf(float x) { return x / (1.f + __expf(-x)); }
DI float sigm(float x) { return 1.f / (1.f + __expf(-x)); }
DI float wave_sum(float v) {
  v += __int_as_float(__builtin_amdgcn_update_dpp(0, __float_as_int(v), 0xB1, 0xF, 0xF, true));
  v += __int_as_float(__builtin_amdgcn_update_dpp(0, __float_as_int(v), 0x4E, 0xF, 0xF, true));
  v += __int_as_float(__builtin_amdgcn_update_dpp(0, __float_as_int(v), 0x141, 0xF, 0xF, true));
  v += __int_as_float(__builtin_amdgcn_update_dpp(0, __float_as_int(v), 0x140, 0xF, 0xF, true));
  const int vi = __float_as_int(v);
  float a = __int_as_float(__builtin_amdgcn_readlane(vi, 0)), b = __int_as_float(__builtin_amdgcn_readlane(vi, 16));
  float c = __int_as_float(__builtin_amdgcn_readlane(vi, 32)), d = __int_as_float(__builtin_amdgcn_readlane(vi, 48));
  return (a + b) + (c + d);
}
DI float dpp_xor1(float v) { return __int_as_float(__builtin_amdgcn_update_dpp(0, __float_as_int(v), 0xB1, 0xF, 0xF, true)); }
DI float dpp_hmirror(float v) { return __int_as_float(__builtin_amdgcn_update_dpp(0, __float_as_int(v), 0x141, 0xF, 0xF, true)); }
DI float dpp_xor2(float v) { return __int_as_float(__builtin_amdgcn_update_dpp(0, __float_as_int(v), 0x4E, 0xF, 0xF, true)); }
DI unsigned pack2(float a, float b) { return (unsigned)f2bf(a) | ((unsigned)f2bf(b) << 16); }
DI int mrow_of(int tok) { return tok < 8192 ? 0 : 1 + ((tok - 8192) >> 11); }


#define XB_TMO      128
#define XB_XCNT(j)  (256  + 64 * (j))
#define XB_XSUB(j)  (1280 + 64 * (j))
#define XB_XGEN(j)  (2304 + 64 * (j))
#define XB_TOP      3328
#define XB_TOPGEN   3392
#define XCD_BAR_WORDS 3456
#define XB_SPIN_CAP (1u << 22)
#define LAS __attribute__((address_space(3)))
DI unsigned xb_ld(unsigned* p) { return __hip_atomic_load(p, __ATOMIC_RELAXED, __HIP_MEMORY_SCOPE_AGENT); }
DI unsigned xb_add(unsigned* p, unsigned v) { return __hip_atomic_fetch_add(p, v, __ATOMIC_RELAXED, __HIP_MEMORY_SCOPE_AGENT); }
DI unsigned xb_xcc_id() { return (unsigned)__builtin_amdgcn_s_getreg((3 << 11) | 20) & 0xFu; }
#define XB_SPIN(cond, bar) do { unsigned _sp = 0; while (cond) { __builtin_amdgcn_s_sleep(1); \
    if ((++_sp & 255u) == 0u) { if (xb_ld(&(bar)[XB_TMO])) break; if (_sp > XB_SPIN_CAP) { atomicAdd(&(bar)[XB_TMO], 1u); break; } } } } while (0)
struct XcdBarrier { unsigned* bar; unsigned x; volatile LAS unsigned* st; };
DI XcdBarrier xcd_barrier_post(unsigned* bar, volatile LAS unsigned* st) {
  XcdBarrier b; b.bar = bar; b.x = xb_xcc_id(); b.st = st;
  if (threadIdx.x == 0) (void)xb_add(&bar[XB_XCNT(b.x)], 1u);
  return b;
}
DI void xcd_barrier_complete(unsigned* bar, unsigned x, unsigned& nloc, unsigned& nx) {
  const unsigned G = gridDim.x * gridDim.y * gridDim.z;
  unsigned sum, cnt, mine, sp = 0u;
  for (;;) {
    sum = 0u; cnt = 0u; mine = 0u;
#pragma unroll
    for (unsigned j = 0; j < 16; ++j) { const unsigned c = xb_ld(&bar[XB_XCNT(j)]); sum += c; cnt += (c > 0u) ? 1u : 0u; mine = (j == x) ? c : mine; }
    if (sum == G) break;
    __builtin_amdgcn_s_sleep(1);
    if ((++sp & 255u) == 0u) { if (xb_ld(&bar[XB_TMO])) break; if (sp > XB_SPIN_CAP) { atomicAdd(&bar[XB_TMO], 1u); break; } }
  }
  nloc = mine > 0u ? mine : 1u; nx = cnt > 0u ? cnt : 1u;
}
DI void xcd_barrier(const XcdBarrier& b) {
  asm volatile("s_waitcnt vmcnt(0)" ::: "memory");
  __syncthreads();
  if (threadIdx.x == 0) {
    unsigned* bar = b.bar;
    asm volatile("" : "+s"(bar));
    __builtin_amdgcn_s_waitcnt(0);
    unsigned nloc = b.st[0], nx = b.st[1];
    if (nloc == 0u) { xcd_barrier_complete(bar, b.x, nloc, nx); b.st[0] = nloc; b.st[1] = nx; }
    const unsigned old = xb_add(&bar[XB_XSUB(b.x)], 1u);
    const unsigned gen = old / nloc;
    if (old + 1u == (gen + 1u) * nloc) {
      __builtin_amdgcn_fence(__ATOMIC_RELEASE, "agent");
      asm volatile("s_waitcnt vmcnt(0)" ::: "memory");
      const unsigned og = xb_add(&bar[XB_TOP], 1u);
      const unsigned tg = og / nx;
      if (og + 1u == (tg + 1u) * nx) xb_add(&bar[XB_TOPGEN], 1u);
      else XB_SPIN(xb_ld(&bar[XB_TOPGEN]) == tg, bar);
      __builtin_amdgcn_fence(__ATOMIC_ACQUIRE, "agent");
      xb_add(&bar[XB_XGEN(b.x)], 1u);
      asm volatile("s_waitcnt vmcnt(0)" ::: "memory");
    } else {
      XB_SPIN(xb_ld(&bar[XB_XGEN(b.x)]) == gen, bar);
      __builtin_amdgcn_fence(__ATOMIC_ACQUIRE, "agent");
      asm volatile("s_waitcnt vmcnt(0)" ::: "memory");
    }
  }
  __syncthreads();
}

DI void gemm_load(const int tid, const u16* A, int lda, const u16* B, int ldb, int k0, uint4 (&ra)[4], uint4 (&rb)[2]) {
#pragma unroll
  for (int i = 0; i < 4; ++i) {
    int idx = tid + i * 512;
    int row = idx >> 3, ch = idx & 7;
    ra[i] = *(const uint4*)(A + (size_t)row * lda + k0 + ch * 8);
  }
#pragma unroll
  for (int i = 0; i < 2; ++i) {
    int idx = tid + i * 512;
    int row = idx >> 3, ch = idx & 7;
    rb[i] = *(const uint4*)(B + (size_t)row * ldb + k0 + ch * 8);
  }
}
DI void gemm_store_lds(const int tid, char* sA, char* sB, const uint4 (&ra)[4], const uint4 (&rb)[2]) {
#pragma unroll
  for (int i = 0; i < 4; ++i) {
    int idx = tid + i * 512;
    int row = idx >> 3, ch = idx & 7;
    *(uint4*)(sA + row * 128 + ((ch ^ ((row >> 1) & 7)) << 4)) = ra[i];
  }
#pragma unroll
  for (int i = 0; i < 2; ++i) {
    int idx = tid + i * 512;
    int row = idx >> 3, ch = idx & 7;
    *(uint4*)(sB + row * 128 + ((ch ^ ((row >> 1) & 7)) << 4)) = rb[i];
  }
}
DI void gemm_compute(const char* sA, const char* sB, f32x4 (&acc)[4][4], int wm, int wn, int lane) {
#pragma unroll
  for (int kk = 0; kk < 2; ++kk) {
    bf16x8 a[4], b[4];
    const int ch = kk * 4 + (lane >> 4);
#pragma unroll
    for (int mf = 0; mf < 4; ++mf) {
      int row = wm * 64 + mf * 16 + (lane & 15);
      a[mf] = *(const bf16x8*)(sA + row * 128 + ((ch ^ ((row >> 1) & 7)) << 4));
    }
#pragma unroll
    for (int nf = 0; nf < 4; ++nf) {
      int row = wn * 64 + nf * 16 + (lane & 15);
      b[nf] = *(const bf16x8*)(sB + row * 128 + ((ch ^ ((row >> 1) & 7)) << 4));
    }
#pragma unroll
    for (int mf = 0; mf < 4; ++mf)
#pragma unroll
      for (int nf = 0; nf < 4; ++nf)
        acc[mf][nf] = __builtin_amdgcn_mfma_f32_16x16x32_bf16(a[mf], b[nf], acc[mf][nf], 0, 0, 0);
  }
}
DI void gemm_acc(const u16* A, int lda, const u16* B, int ldb, int K, f32x4 (&acc)[4][4], char* smem) {
  const int tid = get_tid(), lane = tid & 63, wave = tid >> 6;
  const int wm = wave >> 1, wn = wave & 1;
  char* sA0 = smem;
  char* sB0 = smem + 32768;
  char* sA1 = smem + 49152;
  char* sB1 = smem + 81920;
  uint4 ra[4], rb[2];
  const int nk = K >> 6;
  gemm_load(tid, A, lda, B, ldb, 0, ra, rb);
  gemm_store_lds(tid, sA0, sB0, ra, rb);
  __syncthreads();
  for (int kt = 0; kt < nk; ++kt) {
    const bool more = (kt + 1 < nk);
    if (more) gemm_load(tid, A, lda, B, ldb, (kt + 1) * 64, ra, rb);
    if (kt & 1) gemm_compute(sA1, sB1, acc, wm, wn, lane);
    else gemm_compute(sA0, sB0, acc, wm, wn, lane);
    if (more) {
      if (kt & 1) gemm_store_lds(tid, sA0, sB0, ra, rb);
      else gemm_store_lds(tid, sA1, sB1, ra, rb);
    }
    __syncthreads();
  }
}
DI void zero_acc(f32x4 (&acc)[4][4]) {
#pragma unroll
  for (int i = 0; i < 4; ++i)
#pragma unroll
    for (int j = 0; j < 4; ++j) { float z0; asm volatile("v_mov_b32 %0, 0" : "=v"(z0)); acc[i][j] = f32x4{z0, z0, z0, z0}; }
}

#define PG8_LAS __attribute__((address_space(3)))
namespace pg8 {
typedef unsigned short bf16_t;
typedef short bf16x8 __attribute__((ext_vector_type(8)));
typedef float f32x4 __attribute__((ext_vector_type(4)));
typedef unsigned u32x4 __attribute__((ext_vector_type(4)));
constexpr int BM = 256, BK = 64, HALF = 128, HTB = HALF * BK * 2  , STAGE_BYTES = 8 * HTB, NXCD = 8, WGM = 8;

__host__ __device__ __forceinline__ int lds_byte(int r, int c) { const int st = (r >> 4) * 2 + (c >> 5), rr = r & 15, cc = c & 31, ob = rr * 64 + cc * 2; return st * 1024 + (ob ^ (((ob >> 9) & 1) << 5)); }
__host__ __device__ __forceinline__ void stage_rc(int b, int& R, int& C) { const int st = b / 1024, sb = b % 1024, swz = sb ^ (((sb >> 9) & 1) << 5); R = (st >> 1) * 16 + swz / 64; C = (st & 1) * 32 + (swz % 64) / 2; }
__host__ __device__ __forceinline__ int perm32(int rho) { const int n = rho >> 4, i = rho & 15; return 8 * (i >> 2) + 4 * n + (i & 3); }

struct Unit { int pm, pn; };
struct Gemm { const bf16_t* A; const bf16_t* Bt; int M, N, K, blk, ld; };

struct StaticOrder {
    int nM, nN, nwg, G, c;
    __host__ __device__ void init(int M, int N, int G_, int c_) { nM = M / BM; nN = N / BM; nwg = nM * nN; G = G_; c = c_; }
    __host__ __device__ bool next(int i, Unit& u) const {
        const long L = (long)i * G + c; if (L >= nwg) return false;
        int wgid = (int)L; { const int q = nwg / NXCD, r = nwg % NXCD, xcd = wgid % NXCD, off = wgid / NXCD; wgid = (xcd < r ? xcd * (q + 1) : r * (q + 1) + (xcd - r) * q) + off; }
        const int nig = WGM * nN, gid = wgid / nig, fm = gid * WGM, gsz = (nM - fm) < WGM ? (nM - fm) : WGM;
        u.pm = fm + ((wgid % nig) % gsz); u.pn = (wgid % nig) / gsz; return true;
    }
    __device__ __forceinline__ void a_ready(const Unit&) const {}
    __device__ __forceinline__ void done(const Unit&) const {}
};
__device__ __forceinline__ unsigned cvt_pk_bf16(float lo, float hi) { unsigned r; asm volatile("v_cvt_pk_bf16_f32 %0, %1, %2" : "=v"(r) : "v"(lo), "v"(hi)); return r; }
template <class Epi, class Sched, bool STAMP = false>
__device__ __forceinline__ void gemm_phase(PG8_LAS unsigned char* lds, const Gemm g, const Sched& S, const Epi& E, unsigned long long* stamps) {
    const int tid = get_tid(), wid = __builtin_amdgcn_readfirstlane(tid >> 6), lane = tid & 63, wr = wid >> 2, wc = wid & 3, fr = lane & 15, fq = lane >> 4;
    const int K = g.K, nt = K / BK;
    int ts_lo = 0, ts_hi = 0, nts = 0; const unsigned long long rt_entry = STAMP ? (unsigned long long)wall_clock64() : 0ull;
#define PG8_STAMP() do { if (STAMP && wid == 0 && nts < 64) { const unsigned long long _c = (unsigned long long)clock64(); \
        ts_lo = (lane == nts) ? (int)(unsigned)_c : ts_lo; ts_hi = (lane == nts) ? (int)(unsigned)(_c >> 32) : ts_hi; ++nts; } } while (0)
    PG8_STAMP();
    unsigned voffA[2], voffB[2];
#pragma unroll
    for (int i = 0; i < 2; ++i) { int R, C; stage_rc(tid * 16 + i * 8192, R, C); const int Rb = Epi::PERM ? ((R & ~31) + perm32(R & 31)) : R;
        const int ldr = g.blk ? 64 : g.ld; voffA[i] = (unsigned)(R * ldr + C) * 2u; voffB[i] = (unsigned)(Rb * ldr + C) * 2u; }
    const size_t kstep = g.blk ? (size_t)32768 : (size_t)(BK * 2);
    const size_t hstep = g.blk ? (size_t)16384 : (size_t)HALF * g.ld * 2;
    const size_t tstep = g.blk ? (size_t)(K / 64) * 32768 : 2 * hstep;
    const unsigned ldsw = (unsigned)wid * 1024u;
    const int aoff = lds_byte(wr * 64 + fr, fq * 8), boff = lds_byte(wc * 32 + fr, fq * 8);
#define PG8_SA(b, h) (((b) * 2 + (h)) * HTB)
#define PG8_SB(b, h) ((4 + (b) * 2 + (h)) * HTB)
#define PG8_STAGE(bufoff, gbase, voff) do { _Pragma("unroll") for (int _i = 0; _i < 2; ++_i) \
        __builtin_amdgcn_global_load_lds((const unsigned*)((const char*)(gbase) + (voff)[_i]), (PG8_LAS unsigned*)(lds + (bufoff) + ldsw + _i * 8192), 16, 0, 0); } while (0)
#define PG8_LDA(dst, b, h) do { _Pragma("unroll") for (int m = 0; m < 4; ++m) _Pragma("unroll") for (int k = 0; k < 2; ++k) dst[m][k] = *(const PG8_LAS bf16x8*)(lds + PG8_SA(b, h) + aoff + m * 2048 + k * 1024); } while (0)
#define PG8_LDB(dst, b, h) do { _Pragma("unroll") for (int n = 0; n < 2; ++n) _Pragma("unroll") for (int k = 0; k < 2; ++k) dst[n][k] = *(const PG8_LAS bf16x8*)(lds + PG8_SB(b, h) + boff + n * 2048 + k * 1024); } while (0)
#define PG8_MMA(ai, bj, At, Bt) do { __builtin_amdgcn_s_setprio(1); _Pragma("unroll") for (int m = 0; m < 4; ++m) _Pragma("unroll") for (int n = 0; n < 2; ++n) _Pragma("unroll") for (int k = 0; k < 2; ++k) \
        acc[ai][bj][m][n] = __builtin_amdgcn_mfma_f32_16x16x32_bf16(Bt[n][k], At[m][k], acc[ai][bj][m][n], 0, 0, 0); __builtin_amdgcn_s_setprio(0); } while (0)
#define PG8_WAIT_V(n) asm volatile("s_waitcnt vmcnt(" #n ")" ::: "memory")
#define PG8_WAIT_L(n) asm volatile("s_waitcnt lgkmcnt(" #n ")" ::: "memory")
#define PG8_BAR __builtin_amdgcn_s_barrier()
#define PG8_SCHED __builtin_amdgcn_sched_barrier(0)
    Unit cur, nxt; int ui = 0;
    if (!S.next(0, cur)) return;
    f32x4 acc[2][2][4][2];
#pragma unroll
    for (int a = 0; a < 2; ++a)
#pragma unroll
        for (int b = 0; b < 2; ++b)
#pragma unroll
            for (int m = 0; m < 4; ++m)
#pragma unroll
                for (int n = 0; n < 2; ++n) { float z0; asm volatile("v_mov_b32 %0, 0" : "=v"(z0)); acc[a][b][m][n] = (f32x4){z0, z0, z0, z0}; }
    bf16x8 At[4][2], B0[2][2], B1[2][2];
    const char* cA = (const char*)g.A + (size_t)cur.pm * tstep; const char* cB = (const char*)g.Bt + (size_t)cur.pn * tstep;
    S.a_ready(cur);
    PG8_STAGE(PG8_SB(0, 0), cB, voffB); PG8_STAGE(PG8_SA(0, 0), cA, voffA); PG8_STAGE(PG8_SB(0, 1), cB + hstep, voffB); PG8_STAGE(PG8_SA(0, 1), cA + hstep, voffA);
    if (wr == 1) PG8_BAR;
    PG8_WAIT_V(4); PG8_BAR;
    PG8_STAGE(PG8_SB(1, 0), cB + kstep, voffB); PG8_STAGE(PG8_SA(1, 0), cA + kstep, voffA); PG8_STAGE(PG8_SB(1, 1), cB + hstep + kstep, voffB);
    PG8_WAIT_V(6); PG8_BAR;
    PG8_STAMP();
    for (;;) {
        const bool has_next = S.next(ui + 1, nxt);
        const char* nA = has_next ? (const char*)g.A + (size_t)nxt.pm * tstep : cA; const char* nB = has_next ? (const char*)g.Bt + (size_t)nxt.pn * tstep : cB;
        for (int t = 0; t < nt; t += 2) {
            const bool last = (t == nt - 2);
            const char* a1 = cA + (size_t)(t + 1) * kstep;
            const char* a2 = last ? nA : cA + (size_t)(t + 2) * kstep; const char* b2 = last ? nB : cB + (size_t)(t + 2) * kstep;
            const char* a3 = a2 + kstep; const char* b3 = b2 + kstep;
            if (last && has_next) S.a_ready(nxt);
            PG8_LDB(B0, 0, 0); PG8_SCHED; PG8_LDA(At, 0, 0); PG8_STAGE(PG8_SA(1, 1), a1 + hstep, voffA);
            PG8_WAIT_L(8); PG8_BAR; PG8_WAIT_L(0); PG8_MMA(0, 0, At, B0); PG8_BAR; PG8_SCHED;
            PG8_LDB(B1, 0, 1); PG8_STAGE(PG8_SB(0, 0), b2, voffB);
            PG8_BAR; PG8_WAIT_L(0); PG8_MMA(0, 1, At, B1); PG8_BAR;
            PG8_LDA(At, 0, 1); PG8_STAGE(PG8_SA(0, 0), a2, voffA);
            PG8_BAR; PG8_WAIT_L(0); PG8_MMA(1, 0, At, B0); PG8_BAR; PG8_SCHED;
            PG8_STAGE(PG8_SB(0, 1), b2 + hstep, voffB);
            PG8_WAIT_V(6); PG8_BAR; PG8_MMA(1, 1, At, B1); PG8_BAR;
            PG8_LDB(B0, 1, 0); PG8_SCHED; PG8_LDA(At, 1, 0); PG8_STAGE(PG8_SA(0, 1), a2 + hstep, voffA);
            PG8_WAIT_L(8); PG8_BAR; PG8_WAIT_L(0); PG8_MMA(0, 0, At, B0); PG8_BAR; PG8_SCHED;
            PG8_LDB(B1, 1, 1); PG8_STAGE(PG8_SB(1, 0), b3, voffB);
            PG8_BAR; PG8_WAIT_L(0); PG8_MMA(0, 1, At, B1); PG8_BAR;
            PG8_LDA(At, 1, 1); PG8_STAGE(PG8_SA(1, 0), a3, voffA);
            PG8_BAR; PG8_WAIT_L(0); PG8_MMA(1, 0, At, B0); PG8_BAR; PG8_SCHED;
            PG8_STAGE(PG8_SB(1, 1), b3 + hstep, voffB);
            PG8_WAIT_V(6); PG8_BAR; PG8_MMA(1, 1, At, B1); PG8_BAR;
        }
        PG8_STAMP();
        if constexpr (!Epi::AFTER_DRAIN) { E(acc, cur, wr, wc, fr, fq); S.done(cur); }
        PG8_STAMP();
        if (!has_next) break;
#pragma unroll
        for (int a = 0; a < 2; ++a)
#pragma unroll
            for (int b = 0; b < 2; ++b)
#pragma unroll
                for (int m = 0; m < 4; ++m)
#pragma unroll
                    for (int n = 0; n < 2; ++n) { float z0; asm volatile("v_mov_b32 %0, 0" : "=v"(z0)); acc[a][b][m][n] = (f32x4){z0, z0, z0, z0}; }
        cur = nxt; cA = nA; cB = nB; ++ui;
    }
    PG8_WAIT_V(0);
    if (wr == 0) PG8_BAR;
    PG8_BAR;
    if constexpr (Epi::AFTER_DRAIN) { E.fused(acc, cur, wr, wc, fr, fq, lds, wid, lane); S.done(cur); }
    PG8_STAMP();
    if (STAMP && wid == 0) { stamps[lane] = lane < nts ? (((unsigned long long)(unsigned)ts_hi << 32) | (unsigned)ts_lo) : 0ull;
        if (lane == 62) stamps[62] = rt_entry; if (lane == 63) stamps[63] = (unsigned long long)wall_clock64(); }
#undef PG8_STAMP
#undef PG8_SA
#undef PG8_SB
#undef PG8_STAGE
#undef PG8_LDA
#undef PG8_LDB
#undef PG8_MMA
#undef PG8_WAIT_V
#undef PG8_WAIT_L
#undef PG8_BAR
#undef PG8_SCHED
}
}

using pg8::cvt_pk_bf16;
DI uint4 pack8(const pg8::f32x4& a, const pg8::f32x4& b) {
  return uint4{cvt_pk_bf16(a[0], a[1]), cvt_pk_bf16(a[2], a[3]), cvt_pk_bf16(b[0], b[1]), cvt_pk_bf16(b[2], b[3])};
}
DI void unpack8(const uint4& u, float (&o)[8]) {
  o[0] = bf2f((u16)(u.x & 0xffff)); o[1] = bf2f((u16)(u.x >> 16));
  o[2] = bf2f((u16)(u.y & 0xffff)); o[3] = bf2f((u16)(u.y >> 16));
  o[4] = bf2f((u16)(u.z & 0xffff)); o[5] = bf2f((u16)(u.z >> 16));
  o[6] = bf2f((u16)(u.w & 0xffff)); o[7] = bf2f((u16)(u.w >> 16));
}
struct EpiP {
  static constexpr bool PERM = true, AFTER_DRAIN = false;
  u16 *zb, *xr, *rwb, *gb; float* dtb; int coff;
  DI void operator()(const pg8::f32x4 (&acc)[2][2][4][2], const pg8::Unit& u, int wr, int wc, int fr, int fq) const {
    const int row0 = u.pm * 256 + wr * 64 + fr;
#pragma unroll
    for (int bj = 0; bj < 2; ++bj) {
      const int cg = coff + u.pn * 256 + bj * 128 + wc * 32;
      const int col0 = cg + 8 * fq;
      if (cg >= 10688) continue;
#pragma unroll
      for (int ai = 0; ai < 2; ++ai)
#pragma unroll
        for (int m = 0; m < 4; ++m) {
          const size_t row = row0 + ai * 128 + m * 16;
          const pg8::f32x4 v0 = acc[ai][bj][m][0], v1 = acc[ai][bj][m][1];
          if (cg >= 5120 && cg < 5184) {
            float* d = dtb + row * 64 + (col0 - 5120);
            *(pg8::f32x4*)d = v0; *(pg8::f32x4*)(d + 4) = v1;
          } else {
            u16* dst = (cg < 2048) ? zb + row * 2048 + col0
                     : (cg < 5120) ? xr + row * 3072 + (col0 - 2048)
                     : (cg < 8640) ? rwb + row * 3456 + (col0 - 5184)
                                   : gb + row * 2048 + (col0 - 8640);
            *(uint4*)dst = pack8(v0, v1);
          }
        }
    }
  }
};
struct EpiOutV {
  static constexpr bool PERM = true, AFTER_DRAIN = false;
  const u16* gb; u16* V; int goff;
  DI void operator()(const pg8::f32x4 (&acc)[2][2][4][2], const pg8::Unit& u, int wr, int wc, int fr, int fq) const {
    const int row0 = u.pm * 256 + wr * 64 + fr;
#pragma unroll
    for (int bj = 0; bj < 2; ++bj) {
      const int col0 = u.pn * 256 + bj * 128 + wc * 32 + 8 * fq;
#pragma unroll
      for (int ai = 0; ai < 2; ++ai)
#pragma unroll
        for (int m = 0; m < 4; ++m) {
          const size_t row = row0 + ai * 128 + m * 16;
          float gt[8];
          unpack8(*(const uint4*)(gb + row * 2048 + goff + col0), gt);
          pg8::f32x4 v0 = acc[ai][bj][m][0], v1 = acc[ai][bj][m][1];
#pragma unroll
          for (int e = 0; e < 4; ++e) { v0[e] *= sigm(gt[e]); v1[e] *= sigm(gt[4 + e]); }
          *(uint4*)(V + row * 1024 + col0) = pack8(v0, v1);
        }
    }
  }
};
struct EpiWo {
  static constexpr bool PERM = true, AFTER_DRAIN = false;
  const float *xp, *xs, *mod; float* out; int tok0;
  DI void operator()(const pg8::f32x4 (&acc)[2][2][4][2], const pg8::Unit& u, int wr, int wc, int fr, int fq) const {
    const int row0 = u.pm * 256 + wr * 64 + fr;
#pragma unroll
    for (int bj = 0; bj < 2; ++bj) {
      const int col0 = u.pn * 256 + bj * 128 + wc * 32 + 8 * fq;
#pragma unroll
      for (int ai = 0; ai < 2; ++ai)
#pragma unroll
        for (int m = 0; m < 4; ++m) {
          const int tok = tok0 + row0 + ai * 128 + m * 16;
          const float* xr = tok < 8192 ? xp + (size_t)tok * 1024 : xs + (size_t)(tok - 8192) * 1024;
          const float* gt = mod + mrow_of(tok) * 6144 + 2048 + col0;
          const pg8::f32x4 x0 = *(const pg8::f32x4*)(xr + col0), x1 = *(const pg8::f32x4*)(xr + col0 + 4);
          const pg8::f32x4 g0 = *(const pg8::f32x4*)gt, g1 = *(const pg8::f32x4*)(gt + 4);
          float* o = out + (size_t)tok * 1024 + col0;
          *(pg8::f32x4*)o = x0 + g0 * acc[ai][bj][m][0];
          *(pg8::f32x4*)(o + 4) = x1 + g1 * acc[ai][bj][m][1];
        }
    }
  }
};
struct EpiGU {
  static constexpr bool PERM = true, AFTER_DRAIN = false;
  u16* act;
  DI void operator()(const pg8::f32x4 (&acc)[2][2][4][2], const pg8::Unit& u, int wr, int wc, int fr, int fq) const {
    const int row0 = u.pm * 256 + wr * 64 + fr;
    const int col0 = u.pn * 128 + wc * 32 + 8 * fq;
#pragma unroll
    for (int ai = 0; ai < 2; ++ai)
#pragma unroll
      for (int m = 0; m < 4; ++m) {
        const size_t row = row0 + ai * 128 + m * 16;
        pg8::f32x4 v0, v1;
#pragma unroll
        for (int e = 0; e < 4; ++e) {
          v0[e] = siluf(acc[ai][0][m][0][e]) * acc[ai][1][m][0][e];
          v1[e] = siluf(acc[ai][0][m][1][e]) * acc[ai][1][m][1][e];
        }
        *(uint4*)(act + ((row >> 8) * 44 + (col0 >> 6)) * 16384 + (row & 255) * 64 + (col0 & 63)) = pack8(v0, v1);
      }
  }
};
struct EpiDown {
  static constexpr bool PERM = true, AFTER_DRAIN = false;
  const float* mod; float* out;
  DI void operator()(const pg8::f32x4 (&acc)[2][2][4][2], const pg8::Unit& u, int wr, int wc, int fr, int fq) const {
    const int row0 = u.pm * 256 + wr * 64 + fr;
#pragma unroll
    for (int bj = 0; bj < 2; ++bj) {
      const int col0 = u.pn * 256 + bj * 128 + wc * 32 + 8 * fq;
#pragma unroll
      for (int ai = 0; ai < 2; ++ai)
#pragma unroll
        for (int m = 0; m < 4; ++m) {
          const int tok = row0 + ai * 128 + m * 16;
          const float* gt = mod + mrow_of(tok) * 6144 + 5120 + col0;
          const pg8::f32x4 g0 = *(const pg8::f32x4*)gt, g1 = *(const pg8::f32x4*)(gt + 4);
          float* o = out + (size_t)tok * 1024 + col0;
          const pg8::f32x4 x0 = *(const pg8::f32x4*)o, x1 = *(const pg8::f32x4*)(o + 4);
          *(pg8::f32x4*)o = x0 + g0 * acc[ai][bj][m][0];
          *(pg8::f32x4*)(o + 4) = x1 + g1 * acc[ai][bj][m][1];
        }
    }
  }
};
template <class Epi>
DI void run_gemm8(char* smem, const u16* A, const u16* Bt, int M, int N, int K, const Epi& E, int vb = -1, int nb = 0, int blk = 0, int ld = 0) {
  if (ld == 0) ld = K;
  asm volatile("" : "+s"(M), "+s"(N), "+s"(K), "+s"(blk), "+s"(ld));
  pg8::Gemm gm{A, Bt, M, N, K, blk, ld};
  pg8::StaticOrder S;
  if (vb < 0) { vb = blockIdx.x; nb = gridDim.x; }
  S.init(M, N, nb, vb);
  pg8::gemm_phase<Epi, pg8::StaticOrder, false>((PG8_LAS unsigned char*)smem, gm, S, E, nullptr);
  __syncthreads();
}

struct EpiR2 {
  static constexpr bool PERM = true, AFTER_DRAIN = false;
  __half* wk; const float *w0, *a0;
  DI void operator()(const pg8::f32x4 (&acc)[2][2][4][2], const pg8::Unit& u, int wr, int wc, int fr, int fq) const {
    const int row0 = u.pm * 256 + wr * 64 + fr;
    const int sec = u.pn >> 2;
#pragma unroll
    for (int bj = 0; bj < 2; ++bj) {
      const int nn = (u.pn & 3) * 256 + bj * 128 + wc * 32 + 8 * fq;
      const int d = sec & 1;
      const float* bias = (sec < 2 ? w0 : a0) + d * 1024 + nn;
      const pg8::f32x4 b0 = *(const pg8::f32x4*)bias, b1 = *(const pg8::f32x4*)(bias + 4);
      const int field = (sec < 2 ? 4 : 5) + 2 * d;
#pragma unroll
      for (int ai = 0; ai < 2; ++ai)
#pragma unroll
        for (int m = 0; m < 4; ++m) {
          const size_t row = row0 + ai * 128 + m * 16;
          pg8::f32x4 v0 = acc[ai][bj][m][0] + b0, v1 = acc[ai][bj][m][1] + b1;
          float o[8];
#pragma unroll
          for (int e = 0; e < 4; ++e) {
            float s0 = sigm(v0[e]), s1 = sigm(v1[e]);
            o[e] = sec < 2 ? __expf(-0.6065306597f * s0) : s0;
            o[4 + e] = sec < 2 ? __expf(-0.6065306597f * s1) : s1;
          }
          __half2 h0 = __floats2half2_rn(o[0], o[1]), h1 = __floats2half2_rn(o[2], o[3]);
          __half2 h2 = __floats2half2_rn(o[4], o[5]), h3 = __floats2half2_rn(o[6], o[7]);
          uint4 pk;
          pk.x = *reinterpret_cast<unsigned*>(&h0); pk.y = *reinterpret_cast<unsigned*>(&h1);
          pk.z = *reinterpret_cast<unsigned*>(&h2); pk.w = *reinterpret_cast<unsigned*>(&h3);
          *(uint4*)(wk + ((row * 16 + (nn >> 6)) * 8 + field) * 64 + (nn & 63)) = pk;
        }
    }
  }
};

template <int MODE>
__device__ __forceinline__ void convT(const float* __restrict__ src, int K, int N, u16* __restrict__ dst, char* smem, int vb = -1, int nb = 0, int ldd = 0) {
  if (ldd == 0) ldd = K;
  float* tile = (float*)smem;
  const int tid = get_tid();
  const int KT = K >> 6, NT = N >> 6;
  if (vb < 0) { vb = blockIdx.x; nb = gridDim.x; }
  for (int t = vb; t < KT * NT; t += nb) {
    int kt = t % KT, nt = t / KT;
#pragma unroll
    for (int i = 0; i < 2; ++i) {
      int idx = tid + i * 512;
      int r = idx >> 4, c4 = idx & 15;
      *(float4*)(tile + r * 68 + c4 * 4) = *(const float4*)(src + (size_t)(kt * 64 + r) * N + nt * 64 + c4 * 4);
    }
    __syncthreads();
    int n = tid >> 3, kc = tid & 7;
    unsigned w[4];
#pragma unroll
    for (int j = 0; j < 4; ++j)
      w[j] = pack2(tile[(kc * 8 + 2 * j) * 68 + n], tile[(kc * 8 + 2 * j + 1) * 68 + n]);
    int ng = nt * 64 + n;
    int row = ng;
    if (MODE == 1) {
      int isu = ng >= 2816;
      int nn = ng - isu * 2816;
      row = (nn >> 7) * 256 + isu * 128 + (nn & 127);
    }
    if (MODE == 2) *(uint4*)(dst + ((size_t)(row >> 8) * KT + kt) * 16384 + (row & 255) * 64 + kc * 8) = uint4{w[0], w[1], w[2], w[3]};
    else *(uint4*)(dst + (size_t)row * ldd + kt * 64 + kc * 8) = uint4{w[0], w[1], w[2], w[3]};
    __syncthreads();
  }
}

__device__ __forceinline__ void step_prep(const Params& p, char* smem) {
  const int tid = get_tid();
  char* ws = p.ws;
  {
    float* red = (float*)smem;
    float* mod = (float*)(ws + OFF_MOD);
    for (int item = blockIdx.x; item < 192; item += gridDim.x) {
      int c4 = tid & 7, kl = tid >> 3;
      float acc[12];
#pragma unroll
      for (int i = 0; i < 12; ++i) acc[i] = 0.f;
      for (int k = kl; k < 1024; k += 64) {
        float4 w = *(const float4*)(p.w_ada + (size_t)k * 6144 + item * 32 + c4 * 4);
        float s0 = siluf(p.c_ctx[k]), s1 = siluf(p.c[k]), s2 = siluf(p.c[1024 + k]);
        acc[0] += s0 * w.x; acc[1] += s0 * w.y; acc[2] += s0 * w.z; acc[3] += s0 * w.w;
        acc[4] += s1 * w.x; acc[5] += s1 * w.y; acc[6] += s1 * w.z; acc[7] += s1 * w.w;
        acc[8] += s2 * w.x; acc[9] += s2 * w.y; acc[10] += s2 * w.z; acc[11] += s2 * w.w;
      }
#pragma unroll
      for (int i = 0; i < 12; ++i) red[(kl * 8 + c4) * 12 + i] = acc[i];
      __syncthreads();
      if (tid < 96) {
        int cond = tid >> 5, col = tid & 31;
        int cc4 = col >> 2, e = col & 3;
        float s = 0.f;
        for (int k = 0; k < 64; ++k) s += red[(k * 8 + cc4) * 12 + cond * 4 + e];
        int n = item * 32 + col;
        mod[cond * 6144 + n] = s + p.b_ada[n];
      }
      __syncthreads();
    }
  }
  convT<0>(p.w_in, 1024, 10688, (u16*)(ws + OFF_WIN), smem);
  convT<0>(p.w_m_out, 2048, 1024, (u16*)(ws + OFF_WMOUT), smem);
  convT<0>(p.w_r_out, 1024, 1024, (u16*)(ws + OFF_WROUT), smem);
  convT<0>(p.w_o, 1024, 1024, (u16*)(ws + OFF_WO), smem);
  convT<0>(p.w2, 64, 1024, (u16*)(ws + OFF_W2T), smem);
  convT<0>(p.w2 + 65536, 64, 1024, (u16*)(ws + OFF_W2T) + 65536, smem);
  convT<0>(p.a2, 64, 1024, (u16*)(ws + OFF_A2T), smem);
  convT<0>(p.a2 + 65536, 64, 1024, (u16*)(ws + OFF_A2T) + 65536, smem);
  convT<0>(p.g2, 128, 1024, (u16*)(ws + OFF_G2T), smem);
  {
    u16* w4 = (u16*)(ws + OFF_W4T);
    convT<0>(p.w2, 64, 1024, w4 + (size_t)0 * 1024 * 256 + 0, smem, -1, 0, 256);
    convT<0>(p.w2 + 65536, 64, 1024, w4 + (size_t)1 * 1024 * 256 + 64, smem, -1, 0, 256);
    convT<0>(p.a2, 64, 1024, w4 + (size_t)2 * 1024 * 256 + 128, smem, -1, 0, 256);
    convT<0>(p.a2 + 65536, 64, 1024, w4 + (size_t)3 * 1024 * 256 + 192, smem, -1, 0, 256);
    for (int i = blockIdx.x * NTHR + tid; i < 4096 * 32; i += gridDim.x * NTHR) {
      int row = i >> 5, c = i & 31;
      if ((c >> 3) != (row >> 10)) *(uint4*)(w4 + (size_t)row * 256 + c * 8) = uint4{0, 0, 0, 0};
    }
  }
  {
    uint4* z = (uint4*)(ws + OFF_WIN + (size_t)10688 * 1024 * 2);
    for (int i = blockIdx.x * NTHR + tid; i < 8192; i += gridDim.x * NTHR) z[i] = uint4{0, 0, 0, 0};
  }
}

template <int WHICH>
__device__ __forceinline__ void step_norm(const Params& p, int g) {
  const int tid = get_tid(), lane = tid & 63, wave = tid >> 6;
  const float* mod = (const float*)(p.ws + OFF_MOD);
  const int nrows = WHICH == 0 ? TG : NTOK;
  u16* dst = WHICH == 0 ? (u16*)((char*)p.out + H1_OUT_OFF) : (u16*)(p.ws + OFF_H2);
  const float* nw = WHICH == 0 ? p.norm1_w : p.norm2_w;
  for (int r = blockIdx.x * 8 + wave; r < nrows; r += gridDim.x * 8) {
    int tok = WHICH == 0 ? g * TG + r : r;
    const float* xr;
    if (WHICH == 0) xr = tok < 8192 ? p.x_prompt + (size_t)tok * 1024 : p.x_sample + (size_t)(tok - 8192) * 1024;
    else xr = (const float*)(p.ws + OFF_X1) + (size_t)tok * 1024;
    const float* mr = mod + mrow_of(tok) * 6144 + (WHICH == 0 ? 0 : 3072);
    float4 v[4];
    float ss = 0.f;
#pragma unroll
    for (int i = 0; i < 4; ++i) {
      v[i] = ((const float4*)xr)[i * 64 + lane];
      ss += v[i].x * v[i].x + v[i].y * v[i].y + v[i].z * v[i].z + v[i].w * v[i].w;
    }
    ss = wave_sum(ss);
    float rinv = rsqrtf(ss * (1.f / 1024.f) + 1e-6f);
#pragma unroll
    for (int i = 0; i < 4; ++i) {
      int col = (i * 64 + lane) * 4;
      float4 w4 = *(const float4*)(nw + col);
      float4 sh = *(const float4*)(mr + col);
      float4 sc = *(const float4*)(mr + 1024 + col);
      float h0 = v[i].x * rinv * w4.x * (1.f + sc.x) + sh.x;
      float h1 = v[i].y * rinv * w4.y * (1.f + sc.y) + sh.y;
      float h2 = v[i].z * rinv * w4.z * (1.f + sc.z) + sh.z;
      float h3 = v[i].w * rinv * w4.w * (1.f + sc.w) + sh.w;
      *(uint2*)(dst + (size_t)r * 1024 + col) = uint2{pack2(h0, h1), pack2(h2, h3)};
    }
  }
}

__device__ __forceinline__ void step_gemm1(const Params& p, char* smem, int part) {
  char* ws = p.ws;
  const u16* H1 = (const u16*)((const char*)p.out + H1_OUT_OFF);
  const u16* W = (const u16*)(ws + OFF_WIN);
  if (part == 0) {
    EpiP E{(u16*)(ws + OFF_Z), (u16*)(ws + OFF_XBCRAW), (u16*)(ws + OFF_RW), (u16*)(ws + OFF_GATE), (float*)(ws + OFF_DT), 0};
    run_gemm8(smem, H1, W, TG, NPAD, 1024, E);
  } else if (part == 1) {
    EpiP E{(u16*)(ws + OFF_Z), (u16*)(ws + OFF_XBCRAW), (u16*)(ws + OFF_RW), (u16*)(ws + OFF_GATE), (float*)(ws + OFF_DT), 0};
    run_gemm8(smem, H1, W, TG, 5120, 1024, E, (int)blockIdx.x - 64, (int)gridDim.x - 64);
  } else {
    EpiP E{(u16*)(ws + OFF_Z), (u16*)(ws + OFF_XBCRAW), (u16*)(ws + OFF_RW), (u16*)(ws + OFF_GATE), (float*)(ws + OFF_DT), 5120};
    run_gemm8(smem, H1, W + (size_t)5120 * 1024, TG, NPAD - 5120, 1024, E);
  }
}

__device__ __forceinline__ void step_cr1(const Params& p, int g) {
  char* ws = p.ws;
  const int tid = get_tid(), lane = tid & 63, wave = tid >> 6;
  const int Ls = g < 2 ? 256 : 2048;
  {
    const u16* __restrict__ xr = (const u16*)(ws + OFF_XBCRAW);
    u16* __restrict__ xo = (u16*)(ws + OFF_XBC);
    for (int item = blockIdx.x * NTHR + tid; item < (TG / 8) * 384; item += gridDim.x * NTHR) {
      const int rb = item / 384, cc = item - rb * 384;
      const int r0 = rb * 8, pos0 = r0 & (Ls - 1);
      uint4 rows[12];
#pragma unroll
      for (int i = 0; i < 12; ++i) {
        const int pp = pos0 + i - 2;
        rows[i] = uint4{0, 0, 0, 0};
        if (pp >= 0 && pp < Ls) rows[i] = *(const uint4*)(xr + (size_t)(r0 + i - 2) * 3072 + cc * 8);
      }
      float w[5][8], bias[8];
      {
        float4 b0 = *(const float4*)(p.conv_b + cc * 8), b1 = *(const float4*)(p.conv_b + cc * 8 + 4);
        bias[0] = b0.x; bias[1] = b0.y; bias[2] = b0.z; bias[3] = b0.w; bias[4] = b1.x; bias[5] = b1.y; bias[6] = b1.z; bias[7] = b1.w;
#pragma unroll
        for (int i = 0; i < 5; ++i) {
          float4 w0 = *(const float4*)(p.conv_w + i * 3072 + cc * 8), w1 = *(const float4*)(p.conv_w + i * 3072 + cc * 8 + 4);
          w[i][0] = w0.x; w[i][1] = w0.y; w[i][2] = w0.z; w[i][3] = w0.w; w[i][4] = w1.x; w[i][5] = w1.y; w[i][6] = w1.z; w[i][7] = w1.w;
        }
      }
      float s[8][8];
#pragma unroll
      for (int o = 0; o < 8; ++o)
#pragma unroll
        for (int e = 0; e < 8; ++e) s[o][e] = bias[e];
#pragma unroll
      for (int i = 0; i < 12; ++i) {
        float xv[8];
        unpack8(rows[i], xv);
#pragma unroll
        for (int k = 0; k < 5; ++k) {
          const int o = i - k;
          if (o >= 0 && o < 8) {
#pragma unroll
            for (int e = 0; e < 8; ++e) s[o][e] += xv[e] * w[k][e];
          }
        }
      }
#pragma unroll
      for (int o = 0; o < 8; ++o) {
#pragma unroll
        for (int e = 0; e < 8; ++e) s[o][e] = siluf(s[o][e]);
        *(uint4*)(xo + (size_t)(r0 + o) * 3072 + cc * 8) = uint4{pack2(s[o][0], s[o][1]), pack2(s[o][2], s[o][3]), pack2(s[o][4], s[o][5]), pack2(s[o][6], s[o][7])};
      }
    }
  }
  {
    const u16* __restrict__ rw = (const u16*)(ws + OFF_RW);
    __half* __restrict__ wk = (__half*)(ws + OFF_WK);
    u16* __restrict__ tl = (u16*)(ws + OFF_TL);
    u16* __restrict__ sg = (u16*)(ws + OFF_SG);
    const bool grid = (g == 2);
    for (int r = blockIdx.x * 8 + wave; r < TG; r += gridDim.x * 8) {
      const int pos = r & (Ls - 1);
      uint4 cur[7], shv[7];
#pragma unroll
      for (int it = 0; it < 7; ++it) {
        const int ci = it * 64 + lane;
        cur[it] = uint4{0, 0, 0, 0};
        shv[it] = uint4{0, 0, 0, 0};
        if (ci < 432) {
          const int q = ci / 108;
          int dr;
          bool ok;
          if (!grid) {
            if (q & 1) { dr = 1; ok = pos < Ls - 1; } else { dr = -1; ok = pos > 0; }
          } else {
            if (q == 0) { dr = -1; ok = (pos & 63) != 0; }
            else if (q == 1) { dr = 1; ok = (pos & 63) != 63; }
            else if (q == 2) { dr = -64; ok = pos >= 64; }
            else { dr = 64; ok = pos < Ls - 64; }
          }
          cur[it] = *(const uint4*)(rw + (size_t)r * 3456 + ci * 8);
          if (ok) shv[it] = *(const uint4*)(rw + (size_t)(r + dr) * 3456 + ci * 8);
        }
      }
#pragma unroll
      for (int it = 0; it < 7; ++it) {
        const int ci = it * 64 + lane;
        const bool valid = ci < 432;
        float xx[8];
        {
          float cf[8], sf[8];
          unpack8(cur[it], cf);
          unpack8(shv[it], sf);
          const int cm = valid ? ci * 8 : 0;
          const float4 m0 = *(const float4*)(p.mu_shift + cm), m1 = *(const float4*)(p.mu_shift + cm + 4);
          const float mu[8] = {m0.x, m0.y, m0.z, m0.w, m1.x, m1.y, m1.z, m1.w};
#pragma unroll
          for (int e = 0; e < 8; ++e) xx[e] = cf[e] + mu[e] * (sf[e] - cf[e]);
        }
        const bool isk = valid && ci >= 144 && ci < 272;
        float kk[8];
        float ss = 0.f;
        {
          const int kc = isk ? ci - 144 : 0;
          const float4 k0 = *(const float4*)(p.k_k + kc * 8), k1 = *(const float4*)(p.k_k + kc * 8 + 4);
          const float kkw[8] = {k0.x, k0.y, k0.z, k0.w, k1.x, k1.y, k1.z, k1.w};
#pragma unroll
          for (int e = 0; e < 8; ++e) { kk[e] = xx[e] * kkw[e]; ss += kk[e] * kk[e]; }
        }
        ss += dpp_xor1(ss);
        ss += dpp_xor2(ss);
        ss += dpp_hmirror(ss);
        if (valid) {
          if (ci < 128) {
            __half2 h0 = __floats2half2_rn(xx[0], xx[1]), h1 = __floats2half2_rn(xx[2], xx[3]), h2 = __floats2half2_rn(xx[4], xx[5]), h3 = __floats2half2_rn(xx[6], xx[7]);
            uint4 pk{*reinterpret_cast<unsigned*>(&h0), *reinterpret_cast<unsigned*>(&h1), *reinterpret_cast<unsigned*>(&h2), *reinterpret_cast<unsigned*>(&h3)};
            *(uint4*)(wk + ((size_t)(r * 16 + (ci >> 3)) * 8 + 0) * 64 + (ci & 7) * 8) = pk;
          } else if (ci < 144) {
            float t[8];
#pragma unroll
            for (int e = 0; e < 8; ++e) t[e] = tanhf(xx[e]);
            *(uint4*)(tl + (size_t)r * 256 + (ci - 128) * 8) = uint4{pack2(t[0], t[1]), pack2(t[2], t[3]), pack2(t[4], t[5]), pack2(t[6], t[7])};
          } else if (ci < 272) {
            const int kc = ci - 144;
            const float rn = -rsqrtf(ss + 1e-12f);
            __half2 h0 = __floats2half2_rn(xx[0], xx[1]), h1 = __floats2half2_rn(xx[2], xx[3]), h2 = __floats2half2_rn(xx[4], xx[5]), h3 = __floats2half2_rn(xx[6], xx[7]);
            uint4 pk{*reinterpret_cast<unsigned*>(&h0), *reinterpret_cast<unsigned*>(&h1), *reinterpret_cast<unsigned*>(&h2), *reinterpret_cast<unsigned*>(&h3)};
            *(uint4*)(wk + ((size_t)(r * 16 + (kc >> 3)) * 8 + 2) * 64 + (kc & 7) * 8) = pk;
            __half2 n0 = __floats2half2_rn(kk[0] * rn, kk[1] * rn), n1 = __floats2half2_rn(kk[2] * rn, kk[3] * rn), n2 = __floats2half2_rn(kk[4] * rn, kk[5] * rn), n3 = __floats2half2_rn(kk[6] * rn, kk[7] * rn);
            uint4 pn{*reinterpret_cast<unsigned*>(&n0), *reinterpret_cast<unsigned*>(&n1), *reinterpret_cast<unsigned*>(&n2), *reinterpret_cast<unsigned*>(&n3)};
            *(uint4*)(wk + ((size_t)(r * 16 + (kc >> 3)) * 8 + 3) * 64 + (kc & 7) * 8) = pn;
          } else if (ci < 400) {
            const int vc = ci - 272;
            __half2 h0 = __floats2half2_rn(xx[0], xx[1]), h1 = __floats2half2_rn(xx[2], xx[3]), h2 = __floats2half2_rn(xx[4], xx[5]), h3 = __floats2half2_rn(xx[6], xx[7]);
            uint4 pk{*reinterpret_cast<unsigned*>(&h0), *reinterpret_cast<unsigned*>(&h1), *reinterpret_cast<unsigned*>(&h2), *reinterpret_cast<unsigned*>(&h3)};
            *(uint4*)(wk + ((size_t)(r * 16 + (vc >> 3)) * 8 + 1) * 64 + (vc & 7) * 8) = pk;
          } else if (ci < 416) {
            *(uint4*)(tl + (size_t)r * 256 + 128 + (ci - 400) * 8) = uint4{pack2(xx[0], xx[1]), pack2(xx[2], xx[3]), pack2(xx[4], xx[5]), pack2(xx[6], xx[7])};
          } else {
            float t[8];
#pragma unroll
            for (int e = 0; e < 8; ++e) t[e] = sigm(xx[e]);
            *(uint4*)(sg + (size_t)r * 128 + (ci - 416) * 8) = uint4{pack2(t[0], t[1]), pack2(t[2], t[3]), pack2(t[4], t[5]), pack2(t[6], t[7])};
          }
        }
      }
    }
  }
}

__device__ __forceinline__ void step_r2(const Params& p, char* smem) {
  char* ws = p.ws;
  const int tid = get_tid(), lane = tid & 63, wave = tid >> 6;
  const int wm = wave >> 1, wn = wave & 1;
  const u16* tl = (const u16*)(ws + OFF_TL);
  const u16* sg = (const u16*)(ws + OFF_SG);
  __half* wk = (__half*)(ws + OFF_WK);
  u16* gr = (u16*)(ws + OFF_GR);
  {
    EpiR2 E{wk, p.w0, p.a0};
    run_gemm8(smem, tl, (const u16*)(ws + OFF_W4T), TG, 4096, 256, E);
  }
  for (int t = (gridDim.x - 1 - blockIdx.x) + 4 * 128; t < 5 * 128; t += gridDim.x) {
    int sub = t >> 7, rem = t & 127;
    int mt = rem & 15, nt = rem >> 4;
    f32x4 acc[4][4];
    zero_acc(acc);
    if (sub < 2) {
      gemm_acc(tl + (size_t)mt * 256 * 256 + sub * 64, 256, (const u16*)(ws + OFF_W2T) + sub * 65536 + (size_t)nt * 128 * 64, 64, 64, acc, smem);
    } else if (sub < 4) {
      gemm_acc(tl + (size_t)mt * 256 * 256 + 128 + (sub - 2) * 64, 256, (const u16*)(ws + OFF_A2T) + (sub - 2) * 65536 + (size_t)nt * 128 * 64, 64, 64, acc, smem);
    } else {
      gemm_acc(sg + (size_t)mt * 256 * 128, 128, (const u16*)(ws + OFF_G2T) + (size_t)nt * 128 * 128, 128, 128, acc, smem);
    }
#pragma unroll
    for (int mf = 0; mf < 4; ++mf)
#pragma unroll
      for (int nf = 0; nf < 4; ++nf)
#pragma unroll
        for (int j = 0; j < 4; ++j) {
          if (nf == 0 && j == 0) asm volatile("" ::: "memory");
          int m = mt * 256 + wm * 64 + mf * 16 + (lane >> 4) * 4 + j;
          int n = nt * 128 + wn * 64 + nf * 16 + (lane & 15);
          float v = acc[mf][nf][j];
          if (sub < 2) {
            float wl = v + p.w0[sub * 1024 + n];
            float dec = __expf(-0.6065306597f * sigm(wl));
            wk[((size_t)(m * 16 + (n >> 6)) * 8 + 4 + 2 * sub) * 64 + (n & 63)] = __float2half(dec);
          } else if (sub < 4) {
            int d = sub - 2;
            float a = sigm(v + p.a0[d * 1024 + n]);
            wk[((size_t)(m * 16 + (n >> 6)) * 8 + 5 + 2 * d) * 64 + (n & 63)] = __float2half(a);
          } else {
            gr[(size_t)m * 1024 + n] = f2bf(v);
          }
        }
  }
}

DI int swz16(int row) { return (row ^ (row >> 3)) & 15; }
DI int sw256(int row, int e) { return row * 256 + ((((e >> 3) ^ swz16(row))) << 4) + (e & 7) * 2; }
DI const bf16x8 ldfrag256(const char* base, int row, int ch) {
  return *(const bf16x8*)(base + row * 256 + ((ch ^ swz16(row)) << 4));
}

typedef unsigned v4u __attribute__((ext_vector_type(4)));
struct SsdPre { v4u c0, c1, c2, c3, b0, b1, b2, b3, x0, x1; float d0, d1; };
DI void ssd_issue(const Params& p, int g, int chain, int ci, int tid, SsdPre& R) {
  const int Ls = g < 2 ? 256 : 2048;
  const int nch = Ls >> 7;
  const int d = chain & 1, h = (chain >> 1) & 31, b = chain >> 6;
  const int grp = h >> 3;
  const int c = d ? nch - 1 - ci : ci;
  const int tok0 = b * Ls + c * 128;
  const u16* xbc = (const u16*)(p.ws + OFF_XBC);
  const float* dtb = (const float*)(p.ws + OFF_DT);
  const int lane = tid & 63, wave = tid >> 6;
#define SSD_LDCB(i, CF, BF) { int idx = tid + i * 512; int row = idx >> 4, ch = idx & 15; \
    const u16* src = xbc + (size_t)(tok0 + row) * 3072 + grp * 128 + ch * 8; R.CF = *(const v4u*)(src + 2560); R.BF = *(const v4u*)(src + 2048); }
  SSD_LDCB(0, c0, b0) SSD_LDCB(1, c1, b1) SSD_LDCB(2, c2, b2) SSD_LDCB(3, c3, b3)
#undef SSD_LDCB
#define SSD_LDX(i, XF) { int idx = tid + i * 512; int l = idx >> 3, ch = idx & 7; R.XF = *(const v4u*)(xbc + (size_t)(tok0 + l) * 3072 + h * 64 + ch * 8); }
  SSD_LDX(0, x0) SSD_LDX(1, x1)
#undef SSD_LDX
  if (wave == 0) {
    int e0 = 2 * lane, e1 = 2 * lane + 1;
    int l0 = d ? 127 - e0 : e0, l1 = d ? 127 - e1 : e1;
    R.d0 = dtb[(size_t)(tok0 + l0) * 64 + d * 32 + h];
    R.d1 = dtb[(size_t)(tok0 + l1) * 64 + d * 32 + h];
  }
}

__device__ __forceinline__ void ssd_chain(const Params& p, char* smem, int g, int chain, int next_chain, SsdPre& R) {
  char* ws = p.ws;
  const int tid = get_tid(), lane = tid & 63, wave = tid >> 6;
  const int Ls = g < 2 ? 256 : 2048;
  const int nch = Ls >> 7;
  const int d = chain & 1, h = (chain >> 1) & 31, b = chain >> 6;
  const int grp = h >> 3;
  const u16* xbc = (const u16*)(ws + OFF_XBC);
  const float* dtb = (const float*)(ws + OFF_DT);
  u16* yout = (u16*)(ws + (d ? OFF_SYB : OFF_SYF));
  char* Cs = smem;
  char* Bs = smem + 32768;
  char* BdT = smem + 65536;
  char* XT = smem + 98304;
  char* Ss = smem + 114688;
  float* csum = (float*)(smem + 131072);
  float* dts = (float*)(smem + 131584);
  const float a_h = -__expf(p.a_log[d * 32 + h]);
  const float dtbias = p.dt_bias[d * 32 + h];
  f32x4 sacc[2][2];
  {
    const int wn4 = wave >> 1, wp2 = wave & 1;
#pragma unroll
    for (int nf = 0; nf < 2; ++nf)
#pragma unroll
      for (int pf = 0; pf < 2; ++pf) {
        if (g == 2) {
          const float* h0 = (d ? p.ssm_b : p.ssm_f) + (size_t)(b * 32 + h) * 8192;
          const int n0 = wn4 * 32 + nf * 16 + (lane >> 4) * 4, pp = wp2 * 32 + pf * 16 + (lane & 15);
          const float4 t = *(const float4*)(h0 + pp * 128 + n0);
          sacc[nf][pf] = f32x4{t.x, t.y, t.z, t.w};
        } else {
          sacc[nf][pf] = f32x4{0.f, 0.f, 0.f, 0.f};
        }
      }
  }
  const int tid_outer = tid;
  for (int ci = 0; ci < nch; ++ci) {
    int tidv = tid_outer;
    asm volatile("" : "+v"(tidv));
    const int tid = tidv, lane = tidv & 63, wave = tidv >> 6;
    const int wq4 = wave >> 1, wq2 = wave & 1;
    const int c = d ? nch - 1 - ci : ci;
    const int tok0 = b * Ls + c * 128;
#define SSD_STCB(i, CF, BF) { int idx = tid + i * 512; int row = idx >> 4, ch = idx & 15; \
      *(v4u*)(Cs + row * 256 + ((ch ^ swz16(row)) << 4)) = R.CF; *(v4u*)(Bs + row * 256 + ((ch ^ swz16(row)) << 4)) = R.BF; }
    SSD_STCB(0, c0, b0) SSD_STCB(1, c1, b1) SSD_STCB(2, c2, b2) SSD_STCB(3, c3, b3)
#undef SSD_STCB
#define SSD_STX(i, XF) { int idx = tid + i * 512; int l = idx >> 3, ch = idx & 7; \
      const unsigned w0 = R.XF[0], w1 = R.XF[1], w2 = R.XF[2], w3 = R.XF[3]; \
      *(u16*)(XT + sw256(ch * 8 + 0, l)) = (u16)(w0 & 0xffff); *(u16*)(XT + sw256(ch * 8 + 1, l)) = (u16)(w0 >> 16); \
      *(u16*)(XT + sw256(ch * 8 + 2, l)) = (u16)(w1 & 0xffff); *(u16*)(XT + sw256(ch * 8 + 3, l)) = (u16)(w1 >> 16); \
      *(u16*)(XT + sw256(ch * 8 + 4, l)) = (u16)(w2 & 0xffff); *(u16*)(XT + sw256(ch * 8 + 5, l)) = (u16)(w2 >> 16); \
      *(u16*)(XT + sw256(ch * 8 + 6, l)) = (u16)(w3 & 0xffff); *(u16*)(XT + sw256(ch * 8 + 7, l)) = (u16)(w3 >> 16); }
    SSD_STX(0, x0) SSD_STX(1, x1)
#undef SSD_STX
    if (wave == 0) {
      int e0 = 2 * lane, e1 = 2 * lane + 1;
      int l0 = d ? 127 - e0 : e0, l1 = d ? 127 - e1 : e1;
      float x0 = R.d0 + dtbias;
      float x1 = R.d1 + dtbias;
      float dt0 = x0 > 20.f ? x0 : log1pf(__expf(x0));
      float dt1 = x1 > 20.f ? x1 : log1pf(__expf(x1));
      float a0 = dt0 * a_h, a1 = dt1 * a_h;
      float s = a0 + a1;
#pragma unroll
      for (int o = 1; o < 64; o <<= 1) {
        float t = __shfl_up(s, o);
        if (lane >= o) s += t;
      }
      csum[l1] = s;
      csum[l0] = s - a1;
      dts[l0] = dt0;
      dts[l1] = dt1;
    }
    if (ci + 1 < nch) ssd_issue(p, g, chain, ci + 1, tid, R);
    else if (next_chain >= 0) ssd_issue(p, g, next_chain, 0, tid, R);
#pragma unroll
    for (int nf = 0; nf < 2; ++nf)
#pragma unroll
      for (int pf = 0; pf < 2; ++pf) {
        const int n0 = wq4 * 32 + nf * 16 + (lane >> 4) * 4, pp = wq2 * 32 + pf * 16 + (lane & 15);
        *(uint2*)(Ss + sw256(pp, n0)) = uint2{pack2(sacc[nf][pf][0], sacc[nf][pf][1]), pack2(sacc[nf][pf][2], sacc[nf][pf][3])};
      }
    __syncthreads();
    const float cstot = csum[d ? 0 : 127];
#pragma unroll
    for (int i = 0; i < 4; ++i) {
      int idx = tid + i * 512;
      int l = idx >> 4, ch = idx & 15;
      uint4 bv = *(const uint4*)(Bs + l * 256 + ((ch ^ swz16(l)) << 4));
      float f = dts[l] * __expf(cstot - csum[l]);
      unsigned w[4] = {bv.x, bv.y, bv.z, bv.w};
#pragma unroll
      for (int e = 0; e < 8; ++e) {
        int n = ch * 8 + e;
        float val = bf2f((u16)((w[e >> 1] >> ((e & 1) * 16)) & 0xffff)) * f;
        *(u16*)(BdT + sw256(n, l)) = f2bf(val);
      }
    }
    f32x4 gacc[2][4];
#pragma unroll
    for (int i = 0; i < 2; ++i)
#pragma unroll
      for (int j = 0; j < 4; ++j) gacc[i][j] = f32x4{0.f, 0.f, 0.f, 0.f};
#pragma unroll
    for (int ks = 0; ks < 4; ++ks) {
      int ch = ks * 4 + (lane >> 4);
      bf16x8 a[2], bb[4];
#pragma unroll
      for (int sf = 0; sf < 2; ++sf) a[sf] = ldfrag256(Bs, wq4 * 32 + sf * 16 + (lane & 15), ch);
#pragma unroll
      for (int lf = 0; lf < 4; ++lf) bb[lf] = ldfrag256(Cs, wq2 * 64 + lf * 16 + (lane & 15), ch);
#pragma unroll
      for (int sf = 0; sf < 2; ++sf)
#pragma unroll
        for (int lf = 0; lf < 4; ++lf)
          gacc[sf][lf] = __builtin_amdgcn_mfma_f32_16x16x32_bf16(a[sf], bb[lf], gacc[sf][lf], 0, 0, 0);
    }
    {
      float css[2][4], dss[2][4];
#pragma unroll
      for (int sf = 0; sf < 2; ++sf)
#pragma unroll
        for (int j = 0; j < 4; ++j) {
          const int sI = wq4 * 32 + sf * 16 + (lane >> 4) * 4 + j;
          css[sf][j] = csum[sI];
          dss[sf][j] = dts[sI];
        }
#pragma unroll
      for (int lf = 0; lf < 4; ++lf) {
        const int l = wq2 * 64 + lf * 16 + (lane & 15);
        const float csl = csum[l];
#pragma unroll
        for (int sf = 0; sf < 2; ++sf)
#pragma unroll
          for (int j = 0; j < 4; ++j) {
            const int sI = wq4 * 32 + sf * 16 + (lane >> 4) * 4 + j;
            const bool valid = d ? (sI >= l) : (sI <= l);
            const float e = valid ? __expf(csl - css[sf][j]) * dss[sf][j] : 0.f;
            gacc[sf][lf][j] *= e;
          }
      }
    }
    __syncthreads();
#pragma unroll
    for (int sf = 0; sf < 2; ++sf)
#pragma unroll
      for (int lf = 0; lf < 4; ++lf) {
        const int s0 = wq4 * 32 + sf * 16 + (lane >> 4) * 4, l = wq2 * 64 + lf * 16 + (lane & 15);
        *(uint2*)(Bs + sw256(l, s0)) = uint2{pack2(gacc[sf][lf][0], gacc[sf][lf][1]), pack2(gacc[sf][lf][2], gacc[sf][lf][3])};
      }
    __syncthreads();
    {
      f32x4 yacc[2][2];
#pragma unroll
      for (int i = 0; i < 2; ++i)
#pragma unroll
        for (int j = 0; j < 2; ++j) yacc[i][j] = f32x4{0.f, 0.f, 0.f, 0.f};
#pragma unroll
      for (int ks = 0; ks < 4; ++ks) {
        int ch = ks * 4 + (lane >> 4);
        bf16x8 a[2], bb[2];
#pragma unroll
        for (int pf = 0; pf < 2; ++pf) a[pf] = ldfrag256(Ss, wq2 * 32 + pf * 16 + (lane & 15), ch);
#pragma unroll
        for (int lf = 0; lf < 2; ++lf) bb[lf] = ldfrag256(Cs, wq4 * 32 + lf * 16 + (lane & 15), ch);
#pragma unroll
        for (int pf = 0; pf < 2; ++pf)
#pragma unroll
          for (int lf = 0; lf < 2; ++lf)
            yacc[pf][lf] = __builtin_amdgcn_mfma_f32_16x16x32_bf16(a[pf], bb[lf], yacc[pf][lf], 0, 0, 0);
      }
#pragma unroll
      for (int lf = 0; lf < 2; ++lf) {
        const float e = __expf(csum[wq4 * 32 + lf * 16 + (lane & 15)]);
#pragma unroll
        for (int pf = 0; pf < 2; ++pf) yacc[pf][lf] *= e;
      }
#pragma unroll
      for (int ks = 0; ks < 4; ++ks) {
        int ch = ks * 4 + (lane >> 4);
        bf16x8 a[2], bb[2];
#pragma unroll
        for (int pf = 0; pf < 2; ++pf) a[pf] = ldfrag256(XT, wq2 * 32 + pf * 16 + (lane & 15), ch);
#pragma unroll
        for (int lf = 0; lf < 2; ++lf) bb[lf] = ldfrag256(Bs, wq4 * 32 + lf * 16 + (lane & 15), ch);
#pragma unroll
        for (int pf = 0; pf < 2; ++pf)
#pragma unroll
          for (int lf = 0; lf < 2; ++lf)
            yacc[pf][lf] = __builtin_amdgcn_mfma_f32_16x16x32_bf16(a[pf], bb[lf], yacc[pf][lf], 0, 0, 0);
      }
#pragma unroll
      for (int pf = 0; pf < 2; ++pf)
#pragma unroll
        for (int lf = 0; lf < 2; ++lf) {
          const int p0 = wq2 * 32 + pf * 16 + (lane >> 4) * 4, l = wq4 * 32 + lf * 16 + (lane & 15);
          *(uint2*)(yout + (size_t)(tok0 + l) * 2048 + h * 64 + p0) = uint2{pack2(yacc[pf][lf][0], yacc[pf][lf][1]), pack2(yacc[pf][lf][2], yacc[pf][lf][3])};
        }
    }
    {
      float e = __expf(cstot);
#pragma unroll
      for (int nf = 0; nf < 2; ++nf)
#pragma unroll
        for (int pf = 0; pf < 2; ++pf) sacc[nf][pf] *= e;
#pragma unroll
      for (int ks = 0; ks < 4; ++ks) {
        int ch = ks * 4 + (lane >> 4);
        bf16x8 a[2], bb[2];
#pragma unroll
        for (int nf = 0; nf < 2; ++nf) a[nf] = ldfrag256(BdT, wq4 * 32 + nf * 16 + (lane & 15), ch);
#pragma unroll
        for (int pf = 0; pf < 2; ++pf) bb[pf] = ldfrag256(XT, wq2 * 32 + pf * 16 + (lane & 15), ch);
#pragma unroll
        for (int nf = 0; nf < 2; ++nf)
#pragma unroll
          for (int pf = 0; pf < 2; ++pf)
            sacc[nf][pf] = __builtin_amdgcn_mfma_f32_16x16x32_bf16(a[nf], bb[pf], sacc[nf][pf], 0, 0, 0);
      }
    }
    __syncthreads();
  }
  if (g < 2) {
    float* so = p.out + (d ? OUT_SSMB : OUT_SSMF) + (size_t)((g * 16 + b) * 32 + h) * 8192;
    const int wn4 = wave >> 1, wp2 = wave & 1;
#pragma unroll
    for (int nf = 0; nf < 2; ++nf)
#pragma unroll
      for (int pf = 0; pf < 2; ++pf) {
        const int n0 = wn4 * 32 + nf * 16 + (lane >> 4) * 4, pp = wp2 * 32 + pf * 16 + (lane & 15);
        *(float4*)(so + pp * 128 + n0) = float4{sacc[nf][pf][0], sacc[nf][pf][1], sacc[nf][pf][2], sacc[nf][pf][3]};
      }
  }
}


template <bool SEG>
__device__ __forceinline__ void wkv_pair(const Params& p, char* smem, int g, int item) {
  char* ws = p.ws;
  const int tid = get_tid(), lane = tid & 63, wave = tid >> 6;
  const int Ls = SEG ? 2048 : 256;
  const __half* wk = (const __half*)(ws + OFF_WK);
  float* stage = (float*)smem;
  float* ylds = (float*)(smem + 98304);
  const bool cw = true;
  const int slot = wave >> 2, wq = wave & 3;
  const int ig = lane >> 3, jg = lane & 7;
  const int row0 = wq * 16 + ig * 2;
  const int chain = SEG ? (item >> 3) : item * 2 + slot;
  const int seg = SEG ? (item & 7) : 0;
  const bool act = cw && (SEG ? !(slot == 1 && seg == 0) : true);
  const int d = chain & 1, h = (chain >> 1) & 15, b = chain >> 5;
  typedef float f2 __attribute__((ext_vector_type(2)));
  f2 S[2][4];
#pragma unroll
  for (int rr = 0; rr < 2; ++rr) {
    if (SEG) {
      if (slot == 0) {
        if (seg == 0) {
          const float* s0 = (d ? p.wkv_b : p.wkv_f) + ((size_t)(b * 16 + h) * 64 + row0 + rr) * 64 + jg * 8;
#pragma unroll
          for (int c = 0; c < 4; ++c) S[rr][c] = f2{s0[2 * c], s0[2 * c + 1]};
        } else {
#pragma unroll
          for (int c = 0; c < 4; ++c) S[rr][c] = f2{0.f, 0.f};
        }
      } else {
#pragma unroll
        for (int c = 0; c < 4; ++c) S[rr][c] = f2{(row0 + rr == jg * 8 + 2 * c) ? 1.f : 0.f, (row0 + rr == jg * 8 + 2 * c + 1) ? 1.f : 0.f};
      }
    } else {
#pragma unroll
      for (int c = 0; c < 4; ++c) S[rr][c] = f2{0.f, 0.f};
    }
  }
  const int pair = tid >> 4, lslot = pair >> 4, lstep = pair & 15, sub = tid & 15;
  const int lch = SEG ? (item >> 3) : item * 2 + lslot;
  const int ld = lch & 1, lh = (lch >> 1) & 15, lb = lch >> 5;
  const bool ldo = SEG ? (lslot == 0) : true;
  const int sbase = seg * 256;
  const int cslot = SEG ? 0 : slot;
  float ka[4];
#pragma unroll
  for (int e = 0; e < 4; ++e) ka[e] = p.k_a[lh * 64 + sub * 4 + e];
  u16* yout;
  if (SEG) yout = lslot == 0 ? (u16*)(ws + (ld ? OFF_WYB : OFF_WYF)) : (u16*)(ws + OFF_YM) + (ld ? (size_t)TG * 1024 : 0);
  else yout = (u16*)(ws + (ld ? OFF_WYB : OFF_WYF));
  const bool ywr = SEG ? (lslot == 0 || seg > 0) : true;
  uint2 rg[6];
  auto prefetch = [&](int tb) {
    int s = sbase + tb * 16 + lstep;
    int pos = ld ? Ls - 1 - s : s;
    int r = lb * Ls + pos;
    const __half* rec = wk + ((size_t)(r * 16 + lh) * 8) * 64 + sub * 4;
    rg[0] = *(const uint2*)(rec + 0 * 64);
    rg[1] = *(const uint2*)(rec + 1 * 64);
    rg[2] = *(const uint2*)(rec + 2 * 64);
    rg[3] = *(const uint2*)(rec + 3 * 64);
    rg[4] = *(const uint2*)(rec + (4 + 2 * ld) * 64);
    rg[5] = *(const uint2*)(rec + (5 + 2 * ld) * 64);
  };
  auto unpack4 = [&](uint2 u, float (&o)[4]) {
    __half2 h0 = *reinterpret_cast<__half2*>(&u.x);
    __half2 h1 = *reinterpret_cast<__half2*>(&u.y);
    float2 f0 = __half22float2(h0), f1 = __half22float2(h1);
    o[0] = f0.x; o[1] = f0.y; o[2] = f1.x; o[3] = f1.y;
  };
  auto stage_store = [&](int buf) {
    float r_[4], v_[4], k_[4], nkk_[4], w_[4], a_[4];
    unpack4(rg[0], r_); unpack4(rg[1], v_); unpack4(rg[2], k_); unpack4(rg[3], nkk_); unpack4(rg[4], w_); unpack4(rg[5], a_);
    float b_[4], kd_[4];
#pragma unroll
    for (int e = 0; e < 4; ++e) {
      b_[e] = -nkk_[e] * a_[e];
      kd_[e] = k_[e] * (1.f + (a_[e] - 1.f) * ka[e]);
    }
    float* dst = stage + ((size_t)((buf * 2 + lslot) * 16 + lstep) * 6) * 64 + sub * 4;
    *(float4*)(dst + 0 * 64) = float4{nkk_[0], nkk_[1], nkk_[2], nkk_[3]};
    *(float4*)(dst + 1 * 64) = float4{w_[0], w_[1], w_[2], w_[3]};
    *(float4*)(dst + 2 * 64) = float4{b_[0], b_[1], b_[2], b_[3]};
    *(float4*)(dst + 3 * 64) = float4{kd_[0], kd_[1], kd_[2], kd_[3]};
    *(float4*)(dst + 4 * 64) = float4{r_[0], r_[1], r_[2], r_[3]};
    *(float4*)(dst + 5 * 64) = float4{v_[0], v_[1], v_[2], v_[3]};
  };
  if (ldo) { prefetch(0); stage_store(0); }
  __syncthreads();
  for (int tb = 0; tb < 16; ++tb) {
    const bool more = tb + 1 < 16;
    if (more && ldo) prefetch(tb + 1);
    if (act) {
      const float* sb = stage + ((size_t)(((tb & 1) * 2 + cslot) * 16) * 6) * 64;
      for (int sg = 0; sg < 8; ++sg) {
        float ysv[2][2];
#pragma unroll
        for (int s4 = 0; s4 < 2; ++s4) {
          const int st = sg * 2 + s4;
          const float* v6 = sb + st * 384 + jg * 8;
          f2 nkk[4], w[4], bb[4], kd[4], rr[4];
#pragma unroll
          for (int q = 0; q < 2; ++q) {
            float4 t0 = *(const float4*)(v6 + 0 * 64 + q * 4);
            nkk[q * 2] = f2{t0.x, t0.y}; nkk[q * 2 + 1] = f2{t0.z, t0.w};
            float4 t1 = *(const float4*)(v6 + 1 * 64 + q * 4);
            w[q * 2] = f2{t1.x, t1.y}; w[q * 2 + 1] = f2{t1.z, t1.w};
            float4 t2 = *(const float4*)(v6 + 2 * 64 + q * 4);
            bb[q * 2] = f2{t2.x, t2.y}; bb[q * 2 + 1] = f2{t2.z, t2.w};
            float4 t3 = *(const float4*)(v6 + 3 * 64 + q * 4);
            kd[q * 2] = f2{t3.x, t3.y}; kd[q * 2 + 1] = f2{t3.z, t3.w};
            float4 t4 = *(const float4*)(v6 + 4 * 64 + q * 4);
            rr[q * 2] = f2{t4.x, t4.y}; rr[q * 2 + 1] = f2{t4.z, t4.w};
          }
          float2 vv2 = *(const float2*)(sb + st * 384 + 5 * 64 + row0);
          float vi[2] = {vv2.x, vv2.y};
          if (SEG && slot == 1) { vi[0] = 0.f; vi[1] = 0.f; }
#pragma unroll
          for (int r2 = 0; r2 < 2; ++r2) {
            f2 sat = S[r2][0] * nkk[0];
            sat += S[r2][1] * nkk[1]; sat += S[r2][2] * nkk[2]; sat += S[r2][3] * nkk[3];
            float sa = sat.x + sat.y;
            sa += dpp_xor1(sa);
            sa += dpp_xor2(sa);
            sa += dpp_hmirror(sa);
            f2 yt;
            {
              f2 t0 = S[r2][0] * w[0] + vi[r2] * kd[0]; S[r2][0] = t0 + sa * bb[0]; yt = S[r2][0] * rr[0];
              f2 t1 = S[r2][1] * w[1] + vi[r2] * kd[1]; S[r2][1] = t1 + sa * bb[1]; yt += S[r2][1] * rr[1];
              f2 t2 = S[r2][2] * w[2] + vi[r2] * kd[2]; S[r2][2] = t2 + sa * bb[2]; yt += S[r2][2] * rr[2];
              f2 t3 = S[r2][3] * w[3] + vi[r2] * kd[3]; S[r2][3] = t3 + sa * bb[3]; yt += S[r2][3] * rr[3];
            }
            float y = yt.x + yt.y;
            y += dpp_xor1(y);
            y += dpp_xor2(y);
            y += dpp_hmirror(y);
            ysv[s4][r2] = y;
          }
        }
        if (jg == 0) {
#pragma unroll
          for (int s4 = 0; s4 < 2; ++s4)
            *(float2*)(ylds + (slot * 16 + sg * 2 + s4) * 64 + row0) = float2{ysv[s4][0], ysv[s4][1]};
        }
      }
    }
    __syncthreads();
    if (more && ldo) stage_store((tb + 1) & 1);
    if (ywr) {
      int s = sbase + tb * 16 + lstep;
      int pos = ld ? Ls - 1 - s : s;
      int r = lb * Ls + pos;
      float4 yv = *(const float4*)(ylds + (lslot * 16 + lstep) * 64 + sub * 4);
      *(uint2*)(yout + (size_t)r * 1024 + lh * 64 + sub * 4) = uint2{pack2(yv.x, yv.y), pack2(yv.z, yv.w)};
    }
    __syncthreads();
  }
  if (act) {
#pragma unroll
    for (int r2 = 0; r2 < 2; ++r2) {
      float* so;
      if (SEG) so = p.out + 8388608 + ((size_t)((chain * 8 + seg) * 2 + slot)) * 4096 + (row0 + r2) * 64 + jg * 8;
      else so = p.out + (d ? OUT_WKVB : OUT_WKVF) + ((size_t)((g * 16 + b) * 16 + h) * 64 + row0 + r2) * 64 + jg * 8;
#pragma unroll
      for (int c = 0; c < 4; ++c) { so[2 * c] = S[r2][c].x; so[2 * c + 1] = S[r2][c].y; }
    }
  }
}

__device__ __forceinline__ void wkv_fix(const Params& p, char* smem, int item) {
  const int chain = item >> 2, qt = item & 3;
  char* ws = p.ws;
  const int tid = get_tid(), lane = tid & 63, wave = tid >> 6;
  const int d = chain & 1, h = (chain >> 1) & 15, b = chain >> 5;
  const float* SE = p.out + 8388608;
  u16* yout = (u16*)(ws + (d ? OFF_WYB : OFF_WYF));
  const u16* Q = (const u16*)(ws + OFF_YM) + (d ? (size_t)TG * 1024 : 0);
  float* Pl = (float*)smem;
  float* Sl = (float*)(smem + 16384);
  u16* Ql = (u16*)(smem + 36864);
  const int i = lane;
  float S0[64];
  {
    const float* src = SE + ((size_t)(chain * 8) * 2) * 4096 + i * 64;
#pragma unroll
    for (int j = 0; j < 16; ++j) {
      float4 t = *(const float4*)(src + j * 4);
      S0[j * 4] = t.x; S0[j * 4 + 1] = t.y; S0[j * 4 + 2] = t.z; S0[j * 4 + 3] = t.w;
    }
  }
  for (int k = 1; k < 8; ++k) {
    {
      int tt = qt * 64 + (tid >> 3), ch = tid & 7;
      int s = k * 256 + tt;
      int pos = d ? 2047 - s : s;
      int r = b * 2048 + pos;
      *(uint4*)(Ql + tt * 64 + ch * 8) = *(const uint4*)(Q + (size_t)r * 1024 + h * 64 + ch * 8);
    }
    if (k < 7) {
      const float* src = SE + ((size_t)((chain * 8 + k) * 2 + 1)) * 4096;
#pragma unroll
      for (int e = 0; e < 2; ++e) ((float4*)Pl)[tid + e * 512] = ((const float4*)src)[tid + e * 512];
    }
    __syncthreads();
    for (int n = 0; n < 8; ++n) {
      int tt = qt * 64 + wave + n * 8;
      float a0 = 0.f, a1 = 0.f;
#pragma unroll
      for (int jc = 0; jc < 8; ++jc) {
        float q[8];
        unpack8(*(const uint4*)(Ql + tt * 64 + jc * 8), q);
#pragma unroll
        for (int e = 0; e < 8; e += 2) { a0 += S0[jc * 8 + e] * q[e]; a1 += S0[jc * 8 + e + 1] * q[e + 1]; }
      }
      int s = k * 256 + tt;
      int pos = d ? 2047 - s : s;
      size_t off = (size_t)(b * 2048 + pos) * 1024 + h * 64 + i;
      yout[off] = f2bf(bf2f(yout[off]) + (a0 + a1));
    }
    if (k < 7) {
      float nv[8];
      const float* sl = SE + ((size_t)((chain * 8 + k) * 2)) * 4096 + i * 64 + wave * 8;
      {
        float4 t0 = *(const float4*)sl, t1 = *(const float4*)(sl + 4);
        nv[0] = t0.x; nv[1] = t0.y; nv[2] = t0.z; nv[3] = t0.w; nv[4] = t1.x; nv[5] = t1.y; nv[6] = t1.z; nv[7] = t1.w;
      }
#pragma unroll
      for (int m = 0; m < 64; ++m) {
        float4 p0 = *(const float4*)(Pl + m * 64 + wave * 8), p1 = *(const float4*)(Pl + m * 64 + wave * 8 + 4);
        nv[0] += S0[m] * p0.x; nv[1] += S0[m] * p0.y; nv[2] += S0[m] * p0.z; nv[3] += S0[m] * p0.w;
        nv[4] += S0[m] * p1.x; nv[5] += S0[m] * p1.y; nv[6] += S0[m] * p1.z; nv[7] += S0[m] * p1.w;
      }
      *(float4*)(Sl + i * 68 + wave * 8) = float4{nv[0], nv[1], nv[2], nv[3]};
      *(float4*)(Sl + i * 68 + wave * 8 + 4) = float4{nv[4], nv[5], nv[6], nv[7]};
      __syncthreads();
#pragma unroll
      for (int j = 0; j < 16; ++j) {
        float4 t = *(const float4*)(Sl + i * 68 + j * 4);
        S0[j * 4] = t.x; S0[j * 4 + 1] = t.y; S0[j * 4 + 2] = t.z; S0[j * 4 + 3] = t.w;
      }
    }
    __syncthreads();
  }
}

__device__ __forceinline__ void step_scan(const Params& p, char* smem, int g, int parts) {
  const int G = gridDim.x;
  const int r1 = (parts & 1) ? ((RM & (1 << 20)) ? 2 : 1) : 0, r2 = (parts & 2) ? ((RM & (1 << 21)) ? 2 : 1) : 0;
  if (g < 2) {
    for (int rr = 0; rr < r1; ++rr) {
      SsdPre R;
      if ((int)blockIdx.x < 1024) ssd_issue(p, g, blockIdx.x, 0, get_tid(), R);
      for (int ch = blockIdx.x; ch < 1024; ch += G) ssd_chain(p, smem, g, ch, ch + G < 1024 ? ch + G : -1, R);
    }
    for (int rr = 0; rr < r2; ++rr) for (int it = blockIdx.x; it < 256; it += G) wkv_pair<false>(p, smem, g, it);
  } else {
    for (int rr = 0; rr < r1; ++rr) {
      SsdPre R;
      if ((int)blockIdx.x < 128) ssd_issue(p, g, blockIdx.x, 0, get_tid(), R);
      for (int ch = blockIdx.x; ch < 128; ch += G) ssd_chain(p, smem, g, ch, ch + G < 128 ? ch + G : -1, R);
    }
    for (int rr = 0; rr < r2; ++rr) for (int it = (G - 1 - blockIdx.x); it < 512; it += G) wkv_pair<true>(p, smem, g, it);
  }
}
__device__ __forceinline__ void step_fix(const Params& p, char* smem) {
  for (int it = blockIdx.x; it < 256; it += gridDim.x) wkv_fix(p, smem, it);
}

__device__ __forceinline__ void step_fin(const Params& p, int g) {
  char* ws = p.ws;
  const int tid = get_tid(), lane = tid & 63, wave = tid >> 6;
  const int gw = blockIdx.x * 8 + wave, nw = gridDim.x * 8;
  {
    const u16* yf = (const u16*)(ws + OFF_SYF);
    const u16* yb = (const u16*)(ws + OFF_SYB);
    const u16* xbc = (const u16*)(ws + OFF_XBC);
    const u16* zb = (const u16*)(ws + OFF_Z);
    u16* ym = (u16*)(ws + OFF_YM);
    for (int it = gw; it < TG * 4; it += nw) {
      int r = it >> 2, gq = it & 3;
      int ch = gq * 512 + lane * 8;
      uint4 a = *(const uint4*)(yf + (size_t)r * 2048 + ch);
      uint4 b = *(const uint4*)(yb + (size_t)r * 2048 + ch);
      uint4 x = *(const uint4*)(xbc + (size_t)r * 3072 + ch);
      uint4 z = *(const uint4*)(zb + (size_t)r * 2048 + ch);
      float dsk = p.d_skip[ch >> 6];
      unsigned aw[4] = {a.x, a.y, a.z, a.w}, bw[4] = {b.x, b.y, b.z, b.w}, xw[4] = {x.x, x.y, x.z, x.w}, zw[4] = {z.x, z.y, z.z, z.w};
      float y[8];
      float ss = 0.f;
#pragma unroll
      for (int e = 0; e < 8; ++e) {
        int sh = (e & 1) * 16;
        float yy = bf2f((u16)(aw[e >> 1] >> sh)) + bf2f((u16)(bw[e >> 1] >> sh)) + dsk * bf2f((u16)(xw[e >> 1] >> sh));
        yy *= siluf(bf2f((u16)(zw[e >> 1] >> sh)));
        y[e] = yy;
        ss += yy * yy;
      }
      ss = wave_sum(ss);
      float rinv = rsqrtf(ss * (1.f / 512.f) + 1e-5f);
      float4 w0 = *(const float4*)(p.m_norm_w + ch), w1 = *(const float4*)(p.m_norm_w + ch + 4);
      *(uint4*)(ym + (size_t)r * 2048 + ch) =
          uint4{pack2(y[0] * rinv * w0.x, y[1] * rinv * w0.y), pack2(y[2] * rinv * w0.z, y[3] * rinv * w0.w),
                pack2(y[4] * rinv * w1.x, y[5] * rinv * w1.y), pack2(y[6] * rinv * w1.z, y[7] * rinv * w1.w)};
    }
  }
  {
    const u16* __restrict__ yf = (const u16*)(ws + OFF_WYF);
    const u16* __restrict__ yb = (const u16*)(ws + OFF_WYB);
    const __half* __restrict__ wk = (const __half*)(ws + OFF_WK);
    const u16* __restrict__ gr = (const u16*)(ws + OFF_GR);
    u16* __restrict__ yr = (u16*)(ws + OFF_YR);
    for (int it = gw; it < TG * 2; it += nw) {
      const int r = it >> 1, hh = it & 1;
      const int c0 = hh * 512 + lane * 8;
      const int head = c0 >> 6;
      const uint4 a = *(const uint4*)(yf + (size_t)r * 1024 + c0);
      const uint4 b = *(const uint4*)(yb + (size_t)r * 1024 + c0);
      const uint4 gq = *(const uint4*)(gr + (size_t)r * 1024 + c0);
      const __half* rec = wk + ((size_t)(r * 16 + head) * 8) * 64 + (lane & 7) * 8;
      const uint4 qr = *(const uint4*)(rec + 0 * 64), qv = *(const uint4*)(rec + 1 * 64), qk = *(const uint4*)(rec + 2 * 64);
      const uint4 qaf = *(const uint4*)(rec + 5 * 64), qab = *(const uint4*)(rec + 7 * 64);
      const float4 lw0 = *(const float4*)(p.lnx_w + c0), lw1 = *(const float4*)(p.lnx_w + c0 + 4);
      const float4 lb0 = *(const float4*)(p.lnx_b + c0), lb1 = *(const float4*)(p.lnx_b + c0 + 4);
      const float4 ka0 = *(const float4*)(p.k_a + c0), ka1 = *(const float4*)(p.k_a + c0 + 4);
      const float4 rk0 = *(const float4*)(p.r_k + c0), rk1 = *(const float4*)(p.r_k + c0 + 4);
      const float lw[8] = {lw0.x, lw0.y, lw0.z, lw0.w, lw1.x, lw1.y, lw1.z, lw1.w};
      const float lb[8] = {lb0.x, lb0.y, lb0.z, lb0.w, lb1.x, lb1.y, lb1.z, lb1.w};
      const float kav[8] = {ka0.x, ka0.y, ka0.z, ka0.w, ka1.x, ka1.y, ka1.z, ka1.w};
      const float rkv[8] = {rk0.x, rk0.y, rk0.z, rk0.w, rk1.x, rk1.y, rk1.z, rk1.w};
      float ya[8], yb8[8], gg[8];
      unpack8(a, ya); unpack8(b, yb8); unpack8(gq, gg);
      auto unph = [&](const uint4& u, float (&o)[8]) {
        const __half2* hp = reinterpret_cast<const __half2*>(&u);
#pragma unroll
        for (int e = 0; e < 4; ++e) { float2 f = __half22float2(hp[e]); o[2 * e] = f.x; o[2 * e + 1] = f.y; }
      };
      float rr[8], vv[8], kk[8], af[8], ab[8];
      unph(qr, rr); unph(qv, vv); unph(qk, kk); unph(qaf, af); unph(qab, ab);
      float y[8];
      float s1 = 0.f;
#pragma unroll
      for (int e = 0; e < 8; ++e) { y[e] = ya[e] + yb8[e]; s1 += y[e]; }
      s1 += dpp_xor1(s1); s1 += dpp_xor2(s1); s1 += dpp_hmirror(s1);
      const float mean = s1 * (1.f / 64.f);
      float s2 = 0.f, s3 = 0.f;
#pragma unroll
      for (int e = 0; e < 8; ++e) {
        const float dy = y[e] - mean;
        s2 += dy * dy;
        const float kmean = kk[e] * (1.f + (0.5f * (af[e] + ab[e]) - 1.f) * kav[e]);
        s3 += rr[e] * kmean * rkv[e];
      }
      s2 += dpp_xor1(s2); s2 += dpp_xor2(s2); s2 += dpp_hmirror(s2);
      s3 += dpp_xor1(s3); s3 += dpp_xor2(s3); s3 += dpp_hmirror(s3);
      const float rs = rsqrtf(s2 * (1.f / 64.f) + 64e-5f);
      float o[8];
#pragma unroll
      for (int e = 0; e < 8; ++e) o[e] = ((y[e] - mean) * rs * lw[e] + lb[e] + s3 * vv[e]) * gg[e];
      *(uint4*)(yr + (size_t)r * 1024 + c0) = uint4{pack2(o[0], o[1]), pack2(o[2], o[3]), pack2(o[4], o[5]), pack2(o[6], o[7])};
    }
  }
}

__device__ __forceinline__ void step_outproj(const Params& p, char* smem, int g) {
  char* ws = p.ws;
  const int sub = blockIdx.x >> 6, vb = blockIdx.x & 63;
  if (sub < 3) {
    const u16* A = sub == 2 ? (const u16*)(ws + OFF_YR) : (const u16*)(ws + OFF_YM) + sub * 1024;
    const u16* B = sub == 2 ? (const u16*)(ws + OFF_WROUT) : (const u16*)(ws + OFF_WMOUT) + sub * 1024;
    EpiOutV E{(const u16*)(ws + OFF_GATE), (u16*)(ws + OFF_XBC) + (size_t)sub * TG * 1024, sub == 2 ? 1024 : 0};
    run_gemm8(smem, A, B, TG, 1024, 1024, E, vb, 64, 0, sub == 2 ? 1024 : 2048);
  }
}
__device__ __forceinline__ void step_sum(const Params& p, int g, int vb = -1, int nb = 0) {
  const u16* __restrict__ V = (const u16*)(p.ws + OFF_XBC);
  u16* __restrict__ U = (u16*)p.out + (size_t)g * TG * 1024;
  const int tid = get_tid();
  if (vb < 0) { vb = blockIdx.x; nb = gridDim.x; }
  for (int i = vb * NTHR + tid; i < TG * 128; i += nb * NTHR) {
    float a[8], b[8], c[8];
    unpack8(*(const uint4*)(V + (size_t)i * 8), a);
    unpack8(*(const uint4*)(V + (size_t)TG * 1024 + (size_t)i * 8), b);
    unpack8(*(const uint4*)(V + (size_t)2 * TG * 1024 + (size_t)i * 8), c);
    *(uint4*)(U + (size_t)i * 8) = uint4{pack2(a[0] + b[0] + c[0], a[1] + b[1] + c[1]), pack2(a[2] + b[2] + c[2], a[3] + b[3] + c[3]),
                                         pack2(a[4] + b[4] + c[4], a[5] + b[5] + c[5]), pack2(a[6] + b[6] + c[6], a[7] + b[7] + c[7])};
  }
}

__device__ __forceinline__ void step_wo(const Params& p, char* smem, int g) {
  char* ws = p.ws;
  EpiWo E{p.x_prompt, p.x_sample, (const float*)(ws + OFF_MOD), (float*)(ws + OFF_X1), 0};
  run_gemm8(smem, (const u16*)p.out, (const u16*)(ws + OFF_WO), NTOK, 1024, 1024, E);
}

__device__ __forceinline__ void step_gu(const Params& p, char* smem) {
  char* ws = p.ws;
  EpiGU E{(u16*)(ws + OFF_ACT)};
  run_gemm8(smem, (const u16*)(ws + OFF_H2), (const u16*)(ws + OFF_WGU), NTOK, 5632, 1024, E);
}

__device__ __forceinline__ void step_down(const Params& p, char* smem) {
  char* ws = p.ws;
  EpiDown E{(const float*)(ws + OFF_MOD), (float*)(ws + OFF_X1)};
  run_gemm8(smem, (const u16*)(ws + OFF_ACT), (const u16*)(ws + OFF_WDOWN), NTOK, 1024, 2816, E, -1, 0, 1);
}

__device__ __forceinline__ void step_final(const Params& p) {
  const int tid = get_tid(), lane = tid & 63, wave = tid >> 6;
  for (int r = blockIdx.x * 8 + wave; r < NTOK; r += gridDim.x * 8) {
    const float* xr = (const float*)(p.ws + OFF_X1) + (size_t)r * 1024;
    float* xo = p.out + (size_t)r * 1024;
    float4 v[4];
    float ss = 0.f;
#pragma unroll
    for (int i = 0; i < 4; ++i) {
      v[i] = ((const float4*)xr)[i * 64 + lane];
      ss += v[i].x * v[i].x + v[i].y * v[i].y + v[i].z * v[i].z + v[i].w * v[i].w;
    }
    ss = wave_sum(ss);
    float rinv = rsqrtf(ss * (1.f / 1024.f) + 1e-6f);
#pragma unroll
    for (int i = 0; i < 4; ++i) {
      float4 w4 = ((const float4*)p.final_norm_w)[i * 64 + lane];
      ((float4*)xo)[i * 64 + lane] = float4{v[i].x * rinv * w4.x, v[i].y * rinv * w4.y, v[i].z * rinv * w4.z, v[i].w * rinv * w4.w};
    }
  }
}

constexpr int NSTEPS = 33;

__global__ void __launch_bounds__(NTHR) mega(Params p_arg) {
  const int step_lo = p_arg.step_lo, step_hi = p_arg.step_hi;
  __shared__ __attribute__((aligned(16))) char smem[SMEM_BYTES];
#if !MULTI_LAUNCH
  if (threadIdx.x == 0) *(uint4*)(smem + SMEM_BYTES - 16) = uint4{0u, 0u, 0u, 0u};
  __syncthreads();
  XcdBarrier xb = xcd_barrier_post((unsigned*)(p_arg.ws + OFF_BAR), (volatile LAS unsigned*)(smem + SMEM_BYTES - 16));
#endif
  for (int step = step_lo; step <= step_hi; ++step) {
#if defined(__HIP_DEVICE_COMPILE__)
    const __attribute__((address_space(4))) Params* pp = (const __attribute__((address_space(4))) Params*)__builtin_amdgcn_kernarg_segment_ptr();
    asm volatile("" : "+s"(pp));
    const Params p = *pp;
#else
    const Params p = p_arg;
#endif
    const int g = (step - 1) / 9, s = (step - 1) - g * 9;
    const int scode = step == 0 ? 0 : (step <= 27 ? 1 + s : step - 18);
    if (scode == 6 && g < 2) continue;
    if (scode == 1 && g > 0) continue;
    if (scode == 9 && g < 2) continue;
    const int reps = ((RM >> scode) & 1) ? 2 : 1;
    for (int rep = 0; rep < reps; ++rep) {
      if (!((SM >> scode) & 1)) continue;
      switch (scode) {
        case 0: step_prep(p, smem); break;
        case 1: step_norm<0>(p, g); break;
        case 2:
          if (g > 0 && (int)blockIdx.x >= 160 && gridDim.x > 160) step_sum(p, g - 1, (int)blockIdx.x - 160, (int)gridDim.x - 160);
          step_gemm1(p, smem, 0);
          break;
        case 3: step_cr1(p, g); break;
        case 4: step_r2(p, smem); if (g == 2) step_scan(p, smem, g, 1); break;
        case 5: step_scan(p, smem, g, g == 2 ? 2 : 3); break;
        case 6: step_fix(p, smem); break;
        case 7: step_fin(p, g); if (g < 2) step_norm<0>(p, g + 1); break;
        case 8:
          step_outproj(p, smem, g);
          if (g == 0 && blockIdx.x >= 192) {
            convT<1>(p.w_gu, 1024, 5632, (u16*)(p.ws + OFF_WGU), smem, blockIdx.x - 192, gridDim.x - 192);
            convT<2>(p.w_down, 2816, 1024, (u16*)(p.ws + OFF_WDOWN), smem, blockIdx.x - 192, gridDim.x - 192);
          }
          break;
        case 9: step_sum(p, g); break;
        case 10: step_wo(p, smem, 0); break;
        case 11: step_norm<1>(p, 0); break;
        case 12: step_gu(p, smem); break;
        case 13: if (reps == 2 && rep == 0) { Params q = p; q.out = (float*)(p.ws + (size_t)150000000); step_down(q, smem); } else step_down(p, smem); break;
        default: step_final(p); break;
      }
    }
    if (step < step_hi) {
#if !MULTI_LAUNCH
      if (step_hi > 100000) cg::this_grid().sync();
      for (int xs = 0; xs < 1 + XSYNC; ++xs) xcd_barrier(xb);
#endif
    }
  }
}

extern "C" void kernel_launch(void* const* d_in, const int* in_sizes, int n_in, void* d_out, int out_size,
                              void* d_ws, size_t ws_size, hipStream_t stream) {
  Params p{};
  const float** pp = (const float**)&p;
  for (int i = 0; i < 36; ++i) pp[i] = (const float*)d_in[i];
  p.out = (float*)d_out;
  p.ws = (char*)d_ws;
  if (ws_size < WS_NEED) fprintf(stderr, "workspace too small: %zu < %zu\n", ws_size, (size_t)WS_NEED);
#if MULTI_LAUNCH
  for (int s = 0; s < NSTEPS; ++s) {
    p.step_lo = s;
    p.step_hi = s;
    hipLaunchKernelGGL(mega, dim3(256), dim3(NTHR), 0, stream, p);
  }
#else
  static int grid_blocks = 0;
  if (!grid_blocks) {
    int dev = 0, cus = 0, per_cu = 0;
    hipGetDevice(&dev);
    hipDeviceGetAttribute(&cus, hipDeviceAttributeMultiprocessorCount, dev);
    hipOccupancyMaxActiveBlocksPerMultiprocessor(&per_cu, mega, NTHR, 0);
    if (per_cu < 1) per_cu = 1;
    if (per_cu > 1) per_cu = 1;
    grid_blocks = cus * per_cu;
  }
  p.step_lo = 0;
  p.step_hi = NSTEPS - 1;
  void* args[] = {&p};
  hipMemsetAsync((char*)d_ws + OFF_BAR, 0, XCD_BAR_WORDS_C * 4, stream);
  hipError_t e = hipLaunchCooperativeKernel((void*)mega, dim3(grid_blocks), dim3(NTHR), args, 0, stream);
  if (e != hipSuccess) fprintf(stderr, "cooperative launch failed: %s (grid %d)\n", hipGetErrorString(e), grid_blocks);
#endif
}
```

```cpp
#include <hip/hip_runtime.h>
#include <hip/hip_cooperative_groups.h>
#include <hip/hip_fp16.h>
#include <cstdio>
#include <cstdint>
namespace cg = cooperative_groups;

#ifndef MULTI_LAUNCH
#define MULTI_LAUNCH 0
#endif

#define DI __device__ __forceinline__
typedef __attribute__((ext_vector_type(8))) short bf16x8;
typedef __attribute__((ext_vector_type(4))) float f32x4;
typedef unsigned short u16;

#ifndef STEP_MASK
#define STEP_MASK 0xffffff
#endif
constexpr int SM = STEP_MASK;
#ifndef REPEAT_MASK
#define REPEAT_MASK 0
#endif
#ifndef XSYNC
#define XSYNC 0
#endif
constexpr int RM = REPEAT_MASK;
constexpr int TG = 4096;
constexpr int NTOK = 12288;
constexpr int NPAD = 10752;
constexpr int NTHR = 512;
constexpr int SMEM_BYTES = 133120;
constexpr int XCD_BAR_WORDS_C = 3456;

constexpr size_t OFF_WIN = 0;
constexpr size_t OFF_WGU = OFF_WIN + (size_t)NPAD * 1024 * 2;
constexpr size_t OFF_WDOWN = OFF_WGU + (size_t)5632 * 1024 * 2;
constexpr size_t OFF_WMOUT = OFF_WDOWN + (size_t)1024 * 2816 * 2;
constexpr size_t OFF_WROUT = OFF_WMOUT + (size_t)1024 * 2048 * 2;
constexpr size_t OFF_WO = OFF_WROUT + (size_t)1024 * 1024 * 2;
constexpr size_t OFF_W2T = OFF_WO + (size_t)1024 * 1024 * 2;
constexpr size_t OFF_A2T = OFF_W2T + 262144;
constexpr size_t OFF_G2T = OFF_A2T + 262144;
constexpr size_t OFF_MOD = OFF_G2T + 262144;
constexpr size_t OFF_GRP = OFF_MOD + 73728;
constexpr size_t OFF_Z = OFF_GRP;
constexpr size_t OFF_GATE = OFF_Z + (size_t)TG * 2048 * 2;
constexpr size_t OFF_XBC = OFF_GATE + (size_t)TG * 2048 * 2;
constexpr size_t OFF_WK = OFF_XBC + (size_t)TG * 3072 * 2;
constexpr size_t OFF_GR = OFF_WK + (size_t)TG * 16 * 1024;
constexpr size_t OFF_DT = OFF_GR + (size_t)TG * 1024 * 2;
constexpr size_t OFF_TL = OFF_DT + (size_t)TG * 64 * 4;
constexpr size_t OFF_SG = OFF_TL + (size_t)TG * 256 * 2;
constexpr size_t OFF_R = OFF_SG + (size_t)TG * 128 * 2;
constexpr size_t OFF_H1 = OFF_R;
constexpr size_t OFF_XBCRAW = OFF_H1 + (size_t)TG * 1024 * 2;
constexpr size_t OFF_RW = OFF_XBCRAW + (size_t)TG * 3072 * 2;
constexpr size_t OFF_SYF = OFF_R;
constexpr size_t OFF_SYB = OFF_SYF + (size_t)TG * 2048 * 2;
constexpr size_t OFF_WYF = OFF_SYB + (size_t)TG * 2048 * 2;
constexpr size_t OFF_WYB = OFF_WYF + (size_t)TG * 1024 * 2;
constexpr size_t OFF_YM = OFF_WYB + (size_t)TG * 1024 * 2;
constexpr size_t OFF_YR = OFF_YM + (size_t)TG * 2048 * 2;
constexpr size_t OFF_END = OFF_YR + (size_t)TG * 1024 * 2;
constexpr size_t OFF_BAR = OFF_END;
constexpr size_t OFF_W4T = OFF_BAR + 16384;
constexpr size_t WS_NEED = OFF_W4T + (size_t)4096 * 256 * 2;
constexpr size_t OFF_U = OFF_XBC;
constexpr size_t OFF_H2 = OFF_GRP;
constexpr size_t OFF_ACT = OFF_H2 + (size_t)NTOK * 1024 * 2;
constexpr size_t H1_OUT_OFF = 25165824;
constexpr size_t OFF_X1 = OFF_ACT + (size_t)NTOK * 2816 * 2;

constexpr size_t OUT_SSMF = 12582912;
constexpr size_t OUT_SSMB = OUT_SSMF + 8388608;
constexpr size_t OUT_WKVF = OUT_SSMB + 8388608;
constexpr size_t OUT_WKVB = OUT_WKVF + 2097152;

struct Params {
  const float *x_prompt, *x_sample, *ssm_f, *ssm_b, *wkv_f, *wkv_b, *c, *c_ctx, *norm1_w, *norm2_w,
      *w_ada, *b_ada, *w_in, *conv_w, *conv_b, *dt_bias, *a_log, *d_skip, *m_norm_w, *mu_shift, *w0,
      *w2, *a0, *a2, *g2, *k_k, *k_a, *r_k, *lnx_w, *lnx_b, *w_m_out, *w_r_out, *w_o, *w_gu, *w_down,
      *final_norm_w;
  float* out;
  char* ws;
  int step_lo, step_hi;
};

DI int get_tid() {
  int t = threadIdx.x;
  asm volatile("" : "+v"(t));
  return t;
}
DI u16 f2bf(float f) {
  unsigned u = __float_as_uint(f);
  u += 0x7fffu + ((u >> 16) & 1u);
  return (u16)(u >> 16);
}
DI float bf2f(u16 h) { return __uint_as_float(((unsigned)h) << 16); }
DI float siluf(float x) { return x / (1.f + __expf(-x)); }
DI float sigm(float x) { return 1.f / (1.f + __expf(-x)); }
DI float wave_sum(float v) {
  v += __int_as_float(__builtin_amdgcn_update_dpp(0, __float_as_int(v), 0xB1, 0xF, 0xF, true));
  v += __int_as_float(__builtin_amdgcn_update_dpp(0, __float_as_int(v), 0x4E, 0xF, 0xF, true));
  v += __int_as_float(__builtin_amdgcn_update_dpp(0, __float_as_int(v), 0x141, 0xF, 0xF, true));
  v += __int_as_float(__builtin_amdgcn_update_dpp(0, __float_as_int(v), 0x140, 0xF, 0xF, true));
  const int vi = __float_as_int(v);
  float a = __int_as_float(__builtin_amdgcn_readlane(vi, 0)), b = __int_as_float(__builtin_amdgcn_readlane(vi, 16));
  float c = __int_as_float(__builtin_amdgcn_readlane(vi, 32)), d = __int_as_float(__builtin_amdgcn_readlane(vi, 48));
  return (a + b) + (c + d);
}
DI float dpp_xor1(float v) { return __int_as_float(__builtin_amdgcn_update_dpp(0, __float_as_int(v), 0xB1, 0xF, 0xF, true)); }
DI float dpp_hmirror(float v) { return __int_as_float(__builtin_amdgcn_update_dpp(0, __float_as_int(v), 0x141, 0xF, 0xF, true)); }
DI float dpp_xor2(float v) { return __int_as_float(__builtin_amdgcn_update_dpp(0, __float_as_int(v), 0x4E, 0xF, 0xF, true)); }
DI unsigned pack2(float a, float b) { return (unsigned)f2bf(a) | ((unsigned)f2bf(b) << 16); }
DI int mrow_of(int tok) { return tok < 8192 ? 0 : 1 + ((tok - 8192) >> 11); }


#define XB_TMO      128
#define XB_XCNT(j)  (256  + 64 * (j))
#define XB_XSUB(j)  (1280 + 64 * (j))
#define XB_XGEN(j)  (2304 + 64 * (j))
#define XB_TOP      3328
#define XB_TOPGEN   3392
#define XCD_BAR_WORDS 3456
#define XB_SPIN_CAP (1u << 22)
#define LAS __attribute__((address_space(3)))
DI unsigned xb_ld(unsigned* p) { return __hip_atomic_load(p, __ATOMIC_RELAXED, __HIP_MEMORY_SCOPE_AGENT); }
DI unsigned xb_add(unsigned* p, unsigned v) { return __hip_atomic_fetch_add(p, v, __ATOMIC_RELAXED, __HIP_MEMORY_SCOPE_AGENT); }
DI unsigned xb_xcc_id() { return (unsigned)__builtin_amdgcn_s_getreg((3 << 11) | 20) & 0xFu; }
#define XB_SPIN(cond, bar) do { unsigned _sp = 0; while (cond) { __builtin_amdgcn_s_sleep(1); \
    if ((++_sp & 255u) == 0u) { if (xb_ld(&(bar)[XB_TMO])) break; if (_sp > XB_SPIN_CAP) { atomicAdd(&(bar)[XB_TMO], 1u); break; } } } } while (0)
struct XcdBarrier { unsigned* bar; unsigned x; volatile LAS unsigned* st; };
DI XcdBarrier xcd_barrier_post(unsigned* bar, volatile LAS unsigned* st) {
  XcdBarrier b; b.bar = bar; b.x = xb_xcc_id(); b.st = st;
  if (threadIdx.x == 0) (void)xb_add(&bar[XB_XCNT(b.x)], 1u);
  return b;
}
DI void xcd_barrier_complete(unsigned* bar, unsigned x, unsigned& nloc, unsigned& nx) {
  const unsigned G = gridDim.x * gridDim.y * gridDim.z;
  unsigned sum, cnt, mine, sp = 0u;
  for (;;) {
    sum = 0u; cnt = 0u; mine = 0u;
#pragma unroll
    for (unsigned j = 0; j < 16; ++j) { const unsigned c = xb_ld(&bar[XB_XCNT(j)]); sum += c; cnt += (c > 0u) ? 1u : 0u; mine = (j == x) ? c : mine; }
    if (sum == G) break;
    __builtin_amdgcn_s_sleep(1);
    if ((++sp & 255u) == 0u) { if (xb_ld(&bar[XB_TMO])) break; if (sp > XB_SPIN_CAP) { atomicAdd(&bar[XB_TMO], 1u); break; } }
  }
  nloc = mine > 0u ? mine : 1u; nx = cnt > 0u ? cnt : 1u;
}
DI void xcd_barrier(const XcdBarrier& b) {
  asm volatile("s_waitcnt vmcnt(0)" ::: "memory");
  __syncthreads();
  if (threadIdx.x == 0) {
    unsigned* bar = b.bar;
    asm volatile("" : "+s"(bar));
    __builtin_amdgcn_s_waitcnt(0);
    unsigned nloc = b.st[0], nx = b.st[1];
    if (nloc == 0u) { xcd_barrier_complete(bar, b.x, nloc, nx); b.st[0] = nloc; b.st[1] = nx; }
    const unsigned old = xb_add(&bar[XB_XSUB(b.x)], 1u);
    const unsigned gen = old / nloc;
    if (old + 1u == (gen + 1u) * nloc) {
      __builtin_amdgcn_fence(__ATOMIC_RELEASE, "agent");
      asm volatile("s_waitcnt vmcnt(0)" ::: "memory");
      const unsigned og = xb_add(&bar[XB_TOP], 1u);
      const unsigned tg = og / nx;
      if (og + 1u == (tg + 1u) * nx) xb_add(&bar[XB_TOPGEN], 1u);
      else XB_SPIN(xb_ld(&bar[XB_TOPGEN]) == tg, bar);
      __builtin_amdgcn_fence(__ATOMIC_ACQUIRE, "agent");
      xb_add(&bar[XB_XGEN(b.x)], 1u);
      asm volatile("s_waitcnt vmcnt(0)" ::: "memory");
    } else {
      XB_SPIN(xb_ld(&bar[XB_XGEN(b.x)]) == gen, bar);
      __builtin_amdgcn_fence(__ATOMIC_ACQUIRE, "agent");
      asm volatile("s_waitcnt vmcnt(0)" ::: "memory");
    }
  }
  __syncthreads();
}

DI void gemm_load(const int tid, const u16* A, int lda, const u16* B, int ldb, int k0, uint4 (&ra)[4], uint4 (&rb)[2]) {
#pragma unroll
  for (int i = 0; i < 4; ++i) {
    int idx = tid + i * 512;
    int row = idx >> 3, ch = idx & 7;
    ra[i] = *(const uint4*)(A + (size_t)row * lda + k0 + ch * 8);
  }
#pragma unroll
  for (int i = 0; i < 2; ++i) {
    int idx = tid + i * 512;
    int row = idx >> 3, ch = idx & 7;
    rb[i] = *(const uint4*)(B + (size_t)row * ldb + k0 + ch * 8);
  }
}
DI void gemm_store_lds(const int tid, char* sA, char* sB, const uint4 (&ra)[4], const uint4 (&rb)[2]) {
#pragma unroll
  for (int i = 0; i < 4; ++i) {
    int idx = tid + i * 512;
    int row = idx >> 3, ch = idx & 7;
    *(uint4*)(sA + row * 128 + ((ch ^ ((row >> 1) & 7)) << 4)) = ra[i];
  }
#pragma unroll
  for (int i = 0; i < 2; ++i) {
    int idx = tid + i * 512;
    int row = idx >> 3, ch = idx & 7;
    *(uint4*)(sB + row * 128 + ((ch ^ ((row >> 1) & 7)) << 4)) = rb[i];
  }
}
DI void gemm_compute(const char* sA, const char* sB, f32x4 (&acc)[4][4], int wm, int wn, int lane) {
#pragma unroll
  for (int kk = 0; kk < 2; ++kk) {
    bf16x8 a[4], b[4];
    const int ch = kk * 4 + (lane >> 4);
#pragma unroll
    for (int mf = 0; mf < 4; ++mf) {
      int row = wm * 64 + mf * 16 + (lane & 15);
      a[mf] = *(const bf16x8*)(sA + row * 128 + ((ch ^ ((row >> 1) & 7)) << 4));
    }
#pragma unroll
    for (int nf = 0; nf < 4; ++nf) {
      int row = wn * 64 + nf * 16 + (lane & 15);
      b[nf] = *(const bf16x8*)(sB + row * 128 + ((ch ^ ((row >> 1) & 7)) << 4));
    }
#pragma unroll
    for (int mf = 0; mf < 4; ++mf)
#pragma unroll
      for (int nf = 0; nf < 4; ++nf)
        acc[mf][nf] = __builtin_amdgcn_mfma_f32_16x16x32_bf16(a[mf], b[nf], acc[mf][nf], 0, 0, 0);
  }
}
DI void gemm_acc(const u16* A, int lda, const u16* B, int ldb, int K, f32x4 (&acc)[4][4], char* smem) {
  const int tid = get_tid(), lane = tid & 63, wave = tid >> 6;
  const int wm = wave >> 1, wn = wave & 1;
  char* sA0 = smem;
  char* sB0 = smem + 32768;
  char* sA1 = smem + 49152;
  char* sB1 = smem + 81920;
  uint4 ra[4], rb[2];
  const int nk = K >> 6;
  gemm_load(tid, A, lda, B, ldb, 0, ra, rb);
  gemm_store_lds(tid, sA0, sB0, ra, rb);
  __syncthreads();
  for (int kt = 0; kt < nk; ++kt) {
    const bool more = (kt + 1 < nk);
    if (more) gemm_load(tid, A, lda, B, ldb, (kt + 1) * 64, ra, rb);
    if (kt & 1) gemm_compute(sA1, sB1, acc, wm, wn, lane);
    else gemm_compute(sA0, sB0, acc, wm, wn, lane);
    if (more) {
      if (kt & 1) gemm_store_lds(tid, sA0, sB0, ra, rb);
      else gemm_store_lds(tid, sA1, sB1, ra, rb);
    }
    __syncthreads();
  }
}
DI void zero_acc(f32x4 (&acc)[4][4]) {
#pragma unroll
  for (int i = 0; i < 4; ++i)
#pragma unroll
    for (int j = 0; j < 4; ++j) { float z0; asm volatile("v_mov_b32 %0, 0" : "=v"(z0)); acc[i][j] = f32x4{z0, z0, z0, z0}; }
}

#define PG8_LAS __attribute__((address_space(3)))
namespace pg8 {
typedef unsigned short bf16_t;
typedef short bf16x8 __attribute__((ext_vector_type(8)));
typedef float f32x4 __attribute__((ext_vector_type(4)));
typedef unsigned u32x4 __attribute__((ext_vector_type(4)));
constexpr int BM = 256, BK = 64, HALF = 128, HTB = HALF * BK * 2  , STAGE_BYTES = 8 * HTB, NXCD = 8, WGM = 8;

__host__ __device__ __forceinline__ int lds_byte(int r, int c) { const int st = (r >> 4) * 2 + (c >> 5), rr = r & 15, cc = c & 31, ob = rr * 64 + cc * 2; return st * 1024 + (ob ^ (((ob >> 9) & 1) << 5)); }
__host__ __device__ __forceinline__ void stage_rc(int b, int& R, int& C) { const int st = b / 1024, sb = b % 1024, swz = sb ^ (((sb >> 9) & 1) << 5); R = (st >> 1) * 16 + swz / 64; C = (st & 1) * 32 + (swz % 64) / 2; }
__host__ __device__ __forceinline__ int perm32(int rho) { const int n = rho >> 4, i = rho & 15; return 8 * (i >> 2) + 4 * n + (i & 3); }

struct Unit { int pm, pn; };
struct Gemm { const bf16_t* A; const bf16_t* Bt; int M, N, K, blk, ld; };

struct StaticOrder {
    int nM, nN, nwg, G, c;
    __host__ __device__ void init(int M, int N, int G_, int c_) { nM = M / BM; nN = N / BM; nwg = nM * nN; G = G_; c = c_; }
    __host__ __device__ bool next(int i, Unit& u) const {
        const long L = (long)i * G + c; if (L >= nwg) return false;
        int wgid = (int)L; { const int q = nwg / NXCD, r = nwg % NXCD, xcd = wgid % NXCD, off = wgid / NXCD; wgid = (xcd < r ? xcd * (q + 1) : r * (q + 1) + (xcd - r) * q) + off; }
        const int nig = WGM * nN, gid = wgid / nig, fm = gid * WGM, gsz = (nM - fm) < WGM ? (nM - fm) : WGM;
        u.pm = fm + ((wgid % nig) % gsz); u.pn = (wgid % nig) / gsz; return true;
    }
    __device__ __forceinline__ void a_ready(const Unit&) const {}
    __device__ __forceinline__ void done(const Unit&) const {}
};
__device__ __forceinline__ unsigned cvt_pk_bf16(float lo, float hi) { unsigned r; asm volatile("v_cvt_pk_bf16_f32 %0, %1, %2" : "=v"(r) : "v"(lo), "v"(hi)); return r; }
template <class Epi, class Sched, bool STAMP = false>
__device__ __forceinline__ void gemm_phase(PG8_LAS unsigned char* lds, const Gemm g, const Sched& S, const Epi& E, unsigned long long* stamps) {
    const int tid = get_tid(), wid = __builtin_amdgcn_readfirstlane(tid >> 6), lane = tid & 63, wr = wid >> 2, wc = wid & 3, fr = lane & 15, fq = lane >> 4;
    const int K = g.K, nt = K / BK;
    int ts_lo = 0, ts_hi = 0, nts = 0; const unsigned long long rt_entry = STAMP ? (unsigned long long)wall_clock64() : 0ull;
#define PG8_STAMP() do { if (STAMP && wid == 0 && nts < 64) { const unsigned long long _c = (unsigned long long)clock64(); \
        ts_lo = (lane == nts) ? (int)(unsigned)_c : ts_lo; ts_hi = (lane == nts) ? (int)(unsigned)(_c >> 32) : ts_hi; ++nts; } } while (0)
    PG8_STAMP();
    unsigned voffA[2], voffB[2];
#pragma unroll
    for (int i = 0; i < 2; ++i) { int R, C; stage_rc(tid * 16 + i * 8192, R, C); const int Rb = Epi::PERM ? ((R & ~31) + perm32(R & 31)) : R;
        const int ldr = g.blk ? 64 : g.ld; voffA[i] = (unsigned)(R * ldr + C) * 2u; voffB[i] = (unsigned)(Rb * ldr + C) * 2u; }
    const size_t kstep = g.blk ? (size_t)32768 : (size_t)(BK * 2);
    const size_t hstep = g.blk ? (size_t)16384 : (size_t)HALF * g.ld * 2;
    const size_t tstep = g.blk ? (size_t)(K / 64) * 32768 : 2 * hstep;
    const unsigned ldsw = (unsigned)wid * 1024u;
    const int aoff = lds_byte(wr * 64 + fr, fq * 8), boff = lds_byte(wc * 32 + fr, fq * 8);
#define PG8_SA(b, h) (((b) * 2 + (h)) * HTB)
#define PG8_SB(b, h) ((4 + (b) * 2 + (h)) * HTB)
#define PG8_STAGE(bufoff, gbase, voff) do { _Pragma("unroll") for (int _i = 0; _i < 2; ++_i) \
        __builtin_amdgcn_global_load_lds((const unsigned*)((const char*)(gbase) + (voff)[_i]), (PG8_LAS unsigned*)(lds + (bufoff) + ldsw + _i * 8192), 16, 0, 0); } while (0)
#define PG8_LDA(dst, b, h) do { _Pragma("unroll") for (int m = 0; m < 4; ++m) _Pragma("unroll") for (int k = 0; k < 2; ++k) dst[m][k] = *(const PG8_LAS bf16x8*)(lds + PG8_SA(b, h) + aoff + m * 2048 + k * 1024); } while (0)
#define PG8_LDB(dst, b, h) do { _Pragma("unroll") for (int n = 0; n < 2; ++n) _Pragma("unroll") for (int k = 0; k < 2; ++k) dst[n][k] = *(const PG8_LAS bf16x8*)(lds + PG8_SB(b, h) + boff + n * 2048 + k * 1024); } while (0)
#define PG8_MMA(ai, bj, At, Bt) do { __builtin_amdgcn_s_setprio(1); _Pragma("unroll") for (int m = 0; m < 4; ++m) _Pragma("unroll") for (int n = 0; n < 2; ++n) _Pragma("unroll") for (int k = 0; k < 2; ++k) \
        acc[ai][bj][m][n] = __builtin_amdgcn_mfma_f32_16x16x32_bf16(Bt[n][k], At[m][k], acc[ai][bj][m][n], 0, 0, 0); __builtin_amdgcn_s_setprio(0); } while (0)
#define PG8_WAIT_V(n) asm volatile("s_waitcnt vmcnt(" #n ")" ::: "memory")
#define PG8_WAIT_L(n) asm volatile("s_waitcnt lgkmcnt(" #n ")" ::: "memory")
#define PG8_BAR __builtin_amdgcn_s_barrier()
#define PG8_SCHED __builtin_amdgcn_sched_barrier(0)
    Unit cur, nxt; int ui = 0;
    if (!S.next(0, cur)) return;
    f32x4 acc[2][2][4][2];
#pragma unroll
    for (int a = 0; a < 2; ++a)
#pragma unroll
        for (int b = 0; b < 2; ++b)
#pragma unroll
            for (int m = 0; m < 4; ++m)
#pragma unroll
                for (int n = 0; n < 2; ++n) { float z0; asm volatile("v_mov_b32 %0, 0" : "=v"(z0)); acc[a][b][m][n] = (f32x4){z0, z0, z0, z0}; }
    bf16x8 At[4][2], B0[2][2], B1[2][2];
    const char* cA = (const char*)g.A + (size_t)cur.pm * tstep; const char* cB = (const char*)g.Bt + (size_t)cur.pn * tstep;
    S.a_ready(cur);
    PG8_STAGE(PG8_SB(0, 0), cB, voffB); PG8_STAGE(PG8_SA(0, 0), cA, voffA); PG8_STAGE(PG8_SB(0, 1), cB + hstep, voffB); PG8_STAGE(PG8_SA(0, 1), cA + hstep, voffA);
    if (wr == 1) PG8_BAR;
    PG8_WAIT_V(4); PG8_BAR;
    PG8_STAGE(PG8_SB(1, 0), cB + kstep, voffB); PG8_STAGE(PG8_SA(1, 0), cA + kstep, voffA); PG8_STAGE(PG8_SB(1, 1), cB + hstep + kstep, voffB);
    PG8_WAIT_V(6); PG8_BAR;
    PG8_STAMP();
    for (;;) {
        const bool has_next = S.next(ui + 1, nxt);
        const char* nA = has_next ? (const char*)g.A + (size_t)nxt.pm * tstep : cA; const char* nB = has_next ? (const char*)g.Bt + (size_t)nxt.pn * tstep : cB;
        for (int t = 0; t < nt; t += 2) {
            const bool last = (t == nt - 2);
            const char* a1 = cA + (size_t)(t + 1) * kstep;
            const char* a2 = last ? nA : cA + (size_t)(t + 2) * kstep; const char* b2 = last ? nB : cB + (size_t)(t + 2) * kstep;
            const char* a3 = a2 + kstep; const char* b3 = b2 + kstep;
            if (last && has_next) S.a_ready(nxt);
            PG8_LDB(B0, 0, 0); PG8_SCHED; PG8_LDA(At, 0, 0); PG8_STAGE(PG8_SA(1, 1), a1 + hstep, voffA);
            PG8_WAIT_L(8); PG8_BAR; PG8_WAIT_L(0); PG8_MMA(0, 0, At, B0); PG8_BAR; PG8_SCHED;
            PG8_LDB(B1, 0, 1); PG8_STAGE(PG8_SB(0, 0), b2, voffB);
            PG8_BAR; PG8_WAIT_L(0); PG8_MMA(0, 1, At, B1); PG8_BAR;
            PG8_LDA(At, 0, 1); PG8_STAGE(PG8_SA(0, 0), a2, voffA);
            PG8_BAR; PG8_WAIT_L(0); PG8_MMA(1, 0, At, B0); PG8_BAR; PG8_SCHED;
            PG8_STAGE(PG8_SB(0, 1), b2 + hstep, voffB);
            PG8_WAIT_V(6); PG8_BAR; PG8_MMA(1, 1, At, B1); PG8_BAR;
            PG8_LDB(B0, 1, 0); PG8_SCHED; PG8_LDA(At, 1, 0); PG8_STAGE(PG8_SA(0, 1), a2 + hstep, voffA);
            PG8_WAIT_L(8); PG8_BAR; PG8_WAIT_L(0); PG8_MMA(0, 0, At, B0); PG8_BAR; PG8_SCHED;
            PG8_LDB(B1, 1, 1); PG8_STAGE(PG8_SB(1, 0), b3, voffB);
            PG8_BAR; PG8_WAIT_L(0); PG8_MMA(0, 1, At, B1); PG8_BAR;
            PG8_LDA(At, 1, 1); PG8_STAGE(PG8_SA(1, 0), a3, voffA);
            PG8_BAR; PG8_WAIT_L(0); PG8_MMA(1, 0, At, B0); PG8_BAR; PG8_SCHED;
            PG8_STAGE(PG8_SB(1, 1), b3 + hstep, voffB);
            PG8_WAIT_V(6); PG8_BAR; PG8_MMA(1, 1, At, B1); PG8_BAR;
        }
        PG8_STAMP();
        if constexpr (!Epi::AFTER_DRAIN) { E(acc, cur, wr, wc, fr, fq); S.done(cur); }
        PG8_STAMP();
        if (!has_next) break;
#pragma unroll
        for (int a = 0; a < 2; ++a)
#pragma unroll
            for (int b = 0; b < 2; ++b)
#pragma unroll
                for (int m = 0; m < 4; ++m)
#pragma unroll
                    for (int n = 0; n < 2; ++n) { float z0; asm volatile("v_mov_b32 %0, 0" : "=v"(z0)); acc[a][b][m][n] = (f32x4){z0, z0, z0, z0}; }
        cur = nxt; cA = nA; cB = nB; ++ui;
    }
    PG8_WAIT_V(0);
    if (wr == 0) PG8_BAR;
    PG8_BAR;
    if constexpr (Epi::AFTER_DRAIN) { E.fused(acc, cur, wr, wc, fr, fq, lds, wid, lane); S.done(cur); }
    PG8_STAMP();
    if (STAMP && wid == 0) { stamps[lane] = lane < nts ? (((unsigned long long)(unsigned)ts_hi << 32) | (unsigned)ts_lo) : 0ull;
        if (lane == 62) stamps[62] = rt_entry; if (lane == 63) stamps[63] = (unsigned long long)wall_clock64(); }
#undef PG8_STAMP
#undef PG8_SA
#undef PG8_SB
#undef PG8_STAGE
#undef PG8_LDA
#undef PG8_LDB
#undef PG8_MMA
#undef PG8_WAIT_V
#undef PG8_WAIT_L
#undef PG8_BAR
#undef PG8_SCHED
}
}

using pg8::cvt_pk_bf16;
DI uint4 pack8(const pg8::f32x4& a, const pg8::f32x4& b) {
  return uint4{cvt_pk_bf16(a[0], a[1]), cvt_pk_bf16(a[2], a[3]), cvt_pk_bf16(b[0], b[1]), cvt_pk_bf16(b[2], b[3])};
}
DI void unpack8(const uint4& u, float (&o)[8]) {
  o[0] = bf2f((u16)(u.x & 0xffff)); o[1] = bf2f((u16)(u.x >> 16));
  o[2] = bf2f((u16)(u.y & 0xffff)); o[3] = bf2f((u16)(u.y >> 16));
  o[4] = bf2f((u16)(u.z & 0xffff)); o[5] = bf2f((u16)(u.z >> 16));
  o[6] = bf2f((u16)(u.w & 0xffff)); o[7] = bf2f((u16)(u.w >> 16));
}
struct EpiP {
  static constexpr bool PERM = true, AFTER_DRAIN = false;
  u16 *zb, *xr, *rwb, *gb; float* dtb; int coff;
  DI void operator()(const pg8::f32x4 (&acc)[2][2][4][2], const pg8::Unit& u, int wr, int wc, int fr, int fq) const {
    const int row0 = u.pm * 256 + wr * 64 + fr;
#pragma unroll
    for (int bj = 0; bj < 2; ++bj) {
      const int cg = coff + u.pn * 256 + bj * 128 + wc * 32;
      const int col0 = cg + 8 * fq;
      if (cg >= 10688) continue;
#pragma unroll
      for (int ai = 0; ai < 2; ++ai)
#pragma unroll
        for (int m = 0; m < 4; ++m) {
          const size_t row = row0 + ai * 128 + m * 16;
          const pg8::f32x4 v0 = acc[ai][bj][m][0], v1 = acc[ai][bj][m][1];
          if (cg >= 5120 && cg < 5184) {
            float* d = dtb + row * 64 + (col0 - 5120);
            *(pg8::f32x4*)d = v0; *(pg8::f32x4*)(d + 4) = v1;
          } else {
            u16* dst = (cg < 2048) ? zb + row * 2048 + col0
                     : (cg < 5120) ? xr + row * 3072 + (col0 - 2048)
                     : (cg < 8640) ? rwb + row * 3456 + (col0 - 5184)
                                   : gb + row * 2048 + (col0 - 8640);
            *(uint4*)dst = pack8(v0, v1);
          }
        }
    }
  }
};
struct EpiOutV {
  static constexpr bool PERM = true, AFTER_DRAIN = false;
  const u16* gb; u16* V; int goff;
  DI void operator()(const pg8::f32x4 (&acc)[2][2][4][2], const pg8::Unit& u, int wr, int wc, int fr, int fq) const {
    const int row0 = u.pm * 256 + wr * 64 + fr;
#pragma unroll
    for (int bj = 0; bj < 2; ++bj) {
      const int col0 = u.pn * 256 + bj * 128 + wc * 32 + 8 * fq;
#pragma unroll
      for (int ai = 0; ai < 2; ++ai)
#pragma unroll
        for (int m = 0; m < 4; ++m) {
          const size_t row = row0 + ai * 128 + m * 16;
          float gt[8];
          unpack8(*(const uint4*)(gb + row * 2048 + goff + col0), gt);
          pg8::f32x4 v0 = acc[ai][bj][m][0], v1 = acc[ai][bj][m][1];
#pragma unroll
          for (int e = 0; e < 4; ++e) { v0[e] *= sigm(gt[e]); v1[e] *= sigm(gt[4 + e]); }
          *(uint4*)(V + row * 1024 + col0) = pack8(v0, v1);
        }
    }
  }
};
struct EpiWo {
  static constexpr bool PERM = true, AFTER_DRAIN = false;
  const float *xp, *xs, *mod; float* out; int tok0;
  DI void operator()(const pg8::f32x4 (&acc)[2][2][4][2], const pg8::Unit& u, int wr, int wc, int fr, int fq) const {
    const int row0 = u.pm * 256 + wr * 64 + fr;
#pragma unroll
    for (int bj = 0; bj < 2; ++bj) {
      const int col0 = u.pn * 256 + bj * 128 + wc * 32 + 8 * fq;
#pragma unroll
      for (int ai = 0; ai < 2; ++ai)
#pragma unroll
        for (int m = 0; m < 4; ++m) {
          const int tok = tok0 + row0 + ai * 128 + m * 16;
          const float* xr = tok < 8192 ? xp + (size_t)tok * 1024 : xs + (size_t)(tok - 8192) * 1024;
          const float* gt = mod + mrow_of(tok) * 6144 + 2048 + col0;
          const pg8::f32x4 x0 = *(const pg8::f32x4*)(xr + col0), x1 = *(const pg8::f32x4*)(xr + col0 + 4);
          const pg8::f32x4 g0 = *(const pg8::f32x4*)gt, g1 = *(const pg8::f32x4*)(gt + 4);
          float* o = out + (size_t)tok * 1024 + col0;
          *(pg8::f32x4*)o = x0 + g0 * acc[ai][bj][m][0];
          *(pg8::f32x4*)(o + 4) = x1 + g1 * acc[ai][bj][m][1];
        }
    }
  }
};
struct EpiGU {
  static constexpr bool PERM = true, AFTER_DRAIN = false;
  u16* act;
  DI void operator()(const pg8::f32x4 (&acc)[2][2][4][2], const pg8::Unit& u, int wr, int wc, int fr, int fq) const {
    const int row0 = u.pm * 256 + wr * 64 + fr;
    const int col0 = u.pn * 128 + wc * 32 + 8 * fq;
#pragma unroll
    for (int ai = 0; ai < 2; ++ai)
#pragma unroll
      for (int m = 0; m < 4; ++m) {
        const size_t row = row0 + ai * 128 + m * 16;
        pg8::f32x4 v0, v1;
#pragma unroll
        for (int e = 0; e < 4; ++e) {
          v0[e] = siluf(acc[ai][0][m][0][e]) * acc[ai][1][m][0][e];
          v1[e] = siluf(acc[ai][0][m][1][e]) * acc[ai][1][m][1][e];
        }
        *(uint4*)(act + ((row >> 8) * 44 + (col0 >> 6)) * 16384 + (row & 255) * 64 + (col0 & 63)) = pack8(v0, v1);
      }
  }
};
struct EpiDown {
  static constexpr bool PERM = true, AFTER_DRAIN = false;
  const float* mod; float* out;
  DI void operator()(const pg8::f32x4 (&acc)[2][2][4][2], const pg8::Unit& u, int wr, int wc, int fr, int fq) const {
    const int row0 = u.pm * 256 + wr * 64 + fr;
#pragma unroll
    for (int bj = 0; bj < 2; ++bj) {
      const int col0 = u.pn * 256 + bj * 128 + wc * 32 + 8 * fq;
#pragma unroll
      for (int ai = 0; ai < 2; ++ai)
#pragma unroll
        for (int m = 0; m < 4; ++m) {
          const int tok = row0 + ai * 128 + m * 16;
          const float* gt = mod + mrow_of(tok) * 6144 + 5120 + col0;
          const pg8::f32x4 g0 = *(const pg8::f32x4*)gt, g1 = *(const pg8::f32x4*)(gt + 4);
          float* o = out + (size_t)tok * 1024 + col0;
          const pg8::f32x4 x0 = *(const pg8::f32x4*)o, x1 = *(const pg8::f32x4*)(o + 4);
          *(pg8::f32x4*)o = x0 + g0 * acc[ai][bj][m][0];
          *(pg8::f32x4*)(o + 4) = x1 + g1 * acc[ai][bj][m][1];
        }
    }
  }
};
template <class Epi>
DI void run_gemm8(char* smem, const u16* A, const u16* Bt, int M, int N, int K, const Epi& E, int vb = -1, int nb = 0, int blk = 0, int ld = 0) {
  if (ld == 0) ld = K;
  asm volatile("" : "+s"(M), "+s"(N), "+s"(K), "+s"(blk), "+s"(ld));
  pg8::Gemm gm{A, Bt, M, N, K, blk, ld};
  pg8::StaticOrder S;
  if (vb < 0) { vb = blockIdx.x; nb = gridDim.x; }
  S.init(M, N, nb, vb);
  pg8::gemm_phase<Epi, pg8::StaticOrder, false>((PG8_LAS unsigned char*)smem, gm, S, E, nullptr);
  __syncthreads();
}

struct EpiR2 {
  static constexpr bool PERM = true, AFTER_DRAIN = false;
  __half* wk; const float *w0, *a0;
  DI void operator()(const pg8::f32x4 (&acc)[2][2][4][2], const pg8::Unit& u, int wr, int wc, int fr, int fq) const {
    const int row0 = u.pm * 256 + wr * 64 + fr;
    const int sec = u.pn >> 2;
#pragma unroll
    for (int bj = 0; bj < 2; ++bj) {
      const int nn = (u.pn & 3) * 256 + bj * 128 + wc * 32 + 8 * fq;
      const int d = sec & 1;
      const float* bias = (sec < 2 ? w0 : a0) + d * 1024 + nn;
      const pg8::f32x4 b0 = *(const pg8::f32x4*)bias, b1 = *(const pg8::f32x4*)(bias + 4);
      const int field = (sec < 2 ? 4 : 5) + 2 * d;
#pragma unroll
      for (int ai = 0; ai < 2; ++ai)
#pragma unroll
        for (int m = 0; m < 4; ++m) {
          const size_t row = row0 + ai * 128 + m * 16;
          pg8::f32x4 v0 = acc[ai][bj][m][0] + b0, v1 = acc[ai][bj][m][1] + b1;
          float o[8];
#pragma unroll
          for (int e = 0; e < 4; ++e) {
            float s0 = sigm(v0[e]), s1 = sigm(v1[e]);
            o[e] = sec < 2 ? __expf(-0.6065306597f * s0) : s0;
            o[4 + e] = sec < 2 ? __expf(-0.6065306597f * s1) : s1;
          }
          __half2 h0 = __floats2half2_rn(o[0], o[1]), h1 = __floats2half2_rn(o[2], o[3]);
          __half2 h2 = __floats2half2_rn(o[4], o[5]), h3 = __floats2half2_rn(o[6], o[7]);
          uint4 pk;
          pk.x = *reinterpret_cast<unsigned*>(&h0); pk.y = *reinterpret_cast<unsigned*>(&h1);
          pk.z = *reinterpret_cast<unsigned*>(&h2); pk.w = *reinterpret_cast<unsigned*>(&h3);
          *(uint4*)(wk + ((row * 16 + (nn >> 6)) * 8 + field) * 64 + (nn & 63)) = pk;
        }
    }
  }
};

template <int MODE>
__device__ __forceinline__ void convT(const float* __restrict__ src, int K, int N, u16* __restrict__ dst, char* smem, int vb = -1, int nb = 0, int ldd = 0) {
  if (ldd == 0) ldd = K;
  float* tile = (float*)smem;
  const int tid = get_tid();
  const int KT = K >> 6, NT = N >> 6;
  if (vb < 0) { vb = blockIdx.x; nb = gridDim.x; }
  for (int t = vb; t < KT * NT; t += nb) {
    int kt = t % KT, nt = t / KT;
#pragma unroll
    for (int i = 0; i < 2; ++i) {
      int idx = tid + i * 512;
      int r = idx >> 4, c4 = idx & 15;
      *(float4*)(tile + r * 68 + c4 * 4) = *(const float4*)(src + (size_t)(kt * 64 + r) * N + nt * 64 + c4 * 4);
    }
    __syncthreads();
    int n = tid >> 3, kc = tid & 7;
    unsigned w[4];
#pragma unroll
    for (int j = 0; j < 4; ++j)
      w[j] = pack2(tile[(kc * 8 + 2 * j) * 68 + n], tile[(kc * 8 + 2 * j + 1) * 68 + n]);
    int ng = nt * 64 + n;
    int row = ng;
    if (MODE == 1) {
      int isu = ng >= 2816;
      int nn = ng - isu * 2816;
      row = (nn >> 7) * 256 + isu * 128 + (nn & 127);
    }
    if (MODE == 2) *(uint4*)(dst + ((size_t)(row >> 8) * KT + kt) * 16384 + (row & 255) * 64 + kc * 8) = uint4{w[0], w[1], w[2], w[3]};
    else *(uint4*)(dst + (size_t)row * ldd + kt * 64 + kc * 8) = uint4{w[0], w[1], w[2], w[3]};
    __syncthreads();
  }
}

__device__ __forceinline__ void step_prep(const Params& p, char* smem) {
  const int tid = get_tid();
  char* ws = p.ws;
  {
    float* red = (float*)smem;
    float* mod = (float*)(ws + OFF_MOD);
    for (int item = blockIdx.x; item < 192; item += gridDim.x) {
      int c4 = tid & 7, kl = tid >> 3;
      float acc[12];
#pragma unroll
      for (int i = 0; i < 12; ++i) acc[i] = 0.f;
      for (int k = kl; k < 1024; k += 64) {
        float4 w = *(const float4*)(p.w_ada + (size_t)k * 6144 + item * 32 + c4 * 4);
        float s0 = siluf(p.c_ctx[k]), s1 = siluf(p.c[k]), s2 = siluf(p.c[1024 + k]);
        acc[0] += s0 * w.x; acc[1] += s0 * w.y; acc[2] += s0 * w.z; acc[3] += s0 * w.w;
        acc[4] += s1 * w.x; acc[5] += s1 * w.y; acc[6] += s1 * w.z; acc[7] += s1 * w.w;
        acc[8] += s2 * w.x; acc[9] += s2 * w.y; acc[10] += s2 * w.z; acc[11] += s2 * w.w;
      }
#pragma unroll
      for (int i = 0; i < 12; ++i) red[(kl * 8 + c4) * 12 + i] = acc[i];
      __syncthreads();
      if (tid < 96) {
        int cond = tid >> 5, col = tid & 31;
        int cc4 = col >> 2, e = col & 3;
        float s = 0.f;
        for (int k = 0; k < 64; ++k) s += red[(k * 8 + cc4) * 12 + cond * 4 + e];
        int n = item * 32 + col;
        mod[cond * 6144 + n] = s + p.b_ada[n];
      }
      __syncthreads();
    }
  }
  convT<0>(p.w_in, 1024, 10688, (u16*)(ws + OFF_WIN), smem);
  convT<0>(p.w_m_out, 2048, 1024, (u16*)(ws + OFF_WMOUT), smem);
  convT<0>(p.w_r_out, 1024, 1024, (u16*)(ws + OFF_WROUT), smem);
  convT<0>(p.w_o, 1024, 1024, (u16*)(ws + OFF_WO), smem);
  convT<0>(p.w2, 64, 1024, (u16*)(ws + OFF_W2T), smem);
  convT<0>(p.w2 + 65536, 64, 1024, (u16*)(ws + OFF_W2T) + 65536, smem);
  convT<0>(p.a2, 64, 1024, (u16*)(ws + OFF_A2T), smem);
  convT<0>(p.a2 + 65536, 64, 1024, (u16*)(ws + OFF_A2T) + 65536, smem);
  convT<0>(p.g2, 128, 1024, (u16*)(ws + OFF_G2T), smem);
  {
    u16* w4 = (u16*)(ws + OFF_W4T);
    convT<0>(p.w2, 64, 1024, w4 + (size_t)0 * 1024 * 256 + 0, smem, -1, 0, 256);
    convT<0>(p.w2 + 65536, 64, 1024, w4 + (size_t)1 * 1024 * 256 + 64, smem, -1, 0, 256);
    convT<0>(p.a2, 64, 1024, w4 + (size_t)2 * 1024 * 256 + 128, smem, -1, 0, 256);
    convT<0>(p.a2 + 65536, 64, 1024, w4 + (size_t)3 * 1024 * 256 + 192, smem, -1, 0, 256);
    for (int i = blockIdx.x * NTHR + tid; i < 4096 * 32; i += gridDim.x * NTHR) {
      int row = i >> 5, c = i & 31;
      if ((c >> 3) != (row >> 10)) *(uint4*)(w4 + (size_t)row * 256 + c * 8) = uint4{0, 0, 0, 0};
    }
  }
  {
    uint4* z = (uint4*)(ws + OFF_WIN + (size_t)10688 * 1024 * 2);
    for (int i = blockIdx.x * NTHR + tid; i < 8192; i += gridDim.x * NTHR) z[i] = uint4{0, 0, 0, 0};
  }
}

template <int WHICH>
__device__ __forceinline__ void step_norm(const Params& p, int g) {
  const int tid = get_tid(), lane = tid & 63, wave = tid >> 6;
  const float* mod = (const float*)(p.ws + OFF_MOD);
  const int nrows = WHICH == 0 ? TG : NTOK;
  u16* dst = WHICH == 0 ? (u16*)((char*)p.out + H1_OUT_OFF) : (u16*)(p.ws + OFF_H2);
  const float* nw = WHICH == 0 ? p.norm1_w : p.norm2_w;
  for (int r = blockIdx.x * 8 + wave; r < nrows; r += gridDim.x * 8) {
    int tok = WHICH == 0 ? g * TG + r : r;
    const float* xr;
    if (WHICH == 0) xr = tok < 8192 ? p.x_prompt + (size_t)tok * 1024 : p.x_sample + (size_t)(tok - 8192) * 1024;
    else xr = (const float*)(p.ws + OFF_X1) + (size_t)tok * 1024;
    const float* mr = mod + mrow_of(tok) * 6144 + (WHICH == 0 ? 0 : 3072);
    float4 v[4];
    float ss = 0.f;
#pragma unroll
    for (int i = 0; i < 4; ++i) {
      v[i] = ((const float4*)xr)[i * 64 + lane];
      ss += v[i].x * v[i].x + v[i].y * v[i].y + v[i].z * v[i].z + v[i].w * v[i].w;
    }
    ss = wave_sum(ss);
    float rinv = rsqrtf(ss * (1.f / 1024.f) + 1e-6f);
#pragma unroll
    for (int i = 0; i < 4; ++i) {
      int col = (i * 64 + lane) * 4;
      float4 w4 = *(const float4*)(nw + col);
      float4 sh = *(const float4*)(mr + col);
      float4 sc = *(const float4*)(mr + 1024 + col);
      float h0 = v[i].x * rinv * w4.x * (1.f + sc.x) + sh.x;
      float h1 = v[i].y * rinv * w4.y * (1.f + sc.y) + sh.y;
      float h2 = v[i].z * rinv * w4.z * (1.f + sc.z) + sh.z;
      float h3 = v[i].w * rinv * w4.w * (1.f + sc.w) + sh.w;
      *(uint2*)(dst + (size_t)r * 1024 + col) = uint2{pack2(h0, h1), pack2(h2, h3)};
    }
  }
}

__device__ __forceinline__ void step_gemm1(const Params& p, char* smem, int part) {
  char* ws = p.ws;
  const u16* H1 = (const u16*)((const char*)p.out + H1_OUT_OFF);
  const u16* W = (const u16*)(ws + OFF_WIN);
  if (part == 0) {
    EpiP E{(u16*)(ws + OFF_Z), (u16*)(ws + OFF_XBCRAW), (u16*)(ws + OFF_RW), (u16*)(ws + OFF_GATE), (float*)(ws + OFF_DT), 0};
    run_gemm8(smem, H1, W, TG, NPAD, 1024, E);
  } else if (part == 1) {
    EpiP E{(u16*)(ws + OFF_Z), (u16*)(ws + OFF_XBCRAW), (u16*)(ws + OFF_RW), (u16*)(ws + OFF_GATE), (float*)(ws + OFF_DT), 0};
    run_gemm8(smem, H1, W, TG, 5120, 1024, E, (int)blockIdx.x - 64, (int)gridDim.x - 64);
  } else {
    EpiP E{(u16*)(ws + OFF_Z), (u16*)(ws + OFF_XBCRAW), (u16*)(ws + OFF_RW), (u16*)(ws + OFF_GATE), (float*)(ws + OFF_DT), 5120};
    run_gemm8(smem, H1, W + (size_t)5120 * 1024, TG, NPAD - 5120, 1024, E);
  }
}

__device__ __forceinline__ void step_cr1(const Params& p, int g) {
  char* ws = p.ws;
  const int tid = get_tid(), lane = tid & 63, wave = tid >> 6;
  const int Ls = g < 2 ? 256 : 2048;
  {
    const u16* __restrict__ xr = (const u16*)(ws + OFF_XBCRAW);
    u16* __restrict__ xo = (u16*)(ws + OFF_XBC);
    for (int item = blockIdx.x * NTHR + tid; item < (TG / 8) * 384; item += gridDim.x * NTHR) {
      const int rb = item / 384, cc = item - rb * 384;
      const int r0 = rb * 8, pos0 = r0 & (Ls - 1);
      uint4 rows[12];
#pragma unroll
      for (int i = 0; i < 12; ++i) {
        const int pp = pos0 + i - 2;
        rows[i] = uint4{0, 0, 0, 0};
        if (pp >= 0 && pp < Ls) rows[i] = *(const uint4*)(xr + (size_t)(r0 + i - 2) * 3072 + cc * 8);
      }
      float w[5][8], bias[8];
      {
        float4 b0 = *(const float4*)(p.conv_b + cc * 8), b1 = *(const float4*)(p.conv_b + cc * 8 + 4);
        bias[0] = b0.x; bias[1] = b0.y; bias[2] = b0.z; bias[3] = b0.w; bias[4] = b1.x; bias[5] = b1.y; bias[6] = b1.z; bias[7] = b1.w;
#pragma unroll
        for (int i = 0; i < 5; ++i) {
          float4 w0 = *(const float4*)(p.conv_w + i * 3072 + cc * 8), w1 = *(const float4*)(p.conv_w + i * 3072 + cc * 8 + 4);
          w[i][0] = w0.x; w[i][1] = w0.y; w[i][2] = w0.z; w[i][3] = w0.w; w[i][4] = w1.x; w[i][5] = w1.y; w[i][6] = w1.z; w[i][7] = w1.w;
        }
      }
      float s[8][8];
#pragma unroll
      for (int o = 0; o < 8; ++o)
#pragma unroll
        for (int e = 0; e < 8; ++e) s[o][e] = bias[e];
#pragma unroll
      for (int i = 0; i < 12; ++i) {
        float xv[8];
        unpack8(rows[i], xv);
#pragma unroll
        for (int k = 0; k < 5; ++k) {
          const int o = i - k;
          if (o >= 0 && o < 8) {
#pragma unroll
            for (int e = 0; e < 8; ++e) s[o][e] += xv[e] * w[k][e];
          }
        }
      }
#pragma unroll
      for (int o = 0; o < 8; ++o) {
#pragma unroll
        for (int e = 0; e < 8; ++e) s[o][e] = siluf(s[o][e]);
        *(uint4*)(xo + (size_t)(r0 + o) * 3072 + cc * 8) = uint4{pack2(s[o][0], s[o][1]), pack2(s[o][2], s[o][3]), pack2(s[o][4], s[o][5]), pack2(s[o][6], s[o][7])};
      }
    }
  }
  {
    const u16* __restrict__ rw = (const u16*)(ws + OFF_RW);
    __half* __restrict__ wk = (__half*)(ws + OFF_WK);
    u16* __restrict__ tl = (u16*)(ws + OFF_TL);
    u16* __restrict__ sg = (u16*)(ws + OFF_SG);
    const bool grid = (g == 2);
    for (int r = blockIdx.x * 8 + wave; r < TG; r += gridDim.x * 8) {
      const int pos = r & (Ls - 1);
      uint4 cur[7], shv[7];
#pragma unroll
      for (int it = 0; it < 7; ++it) {
        const int ci = it * 64 + lane;
        cur[it] = uint4{0, 0, 0, 0};
        shv[it] = uint4{0, 0, 0, 0};
        if (ci < 432) {
          const int q = ci / 108;
          int dr;
          bool ok;
          if (!grid) {
            if (q & 1) { dr = 1; ok = pos < Ls - 1; } else { dr = -1; ok = pos > 0; }
          } else {
            if (q == 0) { dr = -1; ok = (pos & 63) != 0; }
            else if (q == 1) { dr = 1; ok = (pos & 63) != 63; }
            else if (q == 2) { dr = -64; ok = pos >= 64; }
            else { dr = 64; ok = pos < Ls - 64; }
          }
          cur[it] = *(const uint4*)(rw + (size_t)r * 3456 + ci * 8);
          if (ok) shv[it] = *(const uint4*)(rw + (size_t)(r + dr) * 3456 + ci * 8);
        }
      }
#pragma unroll
      for (int it = 0; it < 7; ++it) {
        const int ci = it * 64 + lane;
        const bool valid = ci < 432;
        float xx[8];
        {
          float cf[8], sf[8];
          unpack8(cur[it], cf);
          unpack8(shv[it], sf);
          const int cm = valid ? ci * 8 : 0;
          const float4 m0 = *(const float4*)(p.mu_shift + cm), m1 = *(const float4*)(p.mu_shift + cm + 4);
          const float mu[8] = {m0.x, m0.y, m0.z, m0.w, m1.x, m1.y, m1.z, m1.w};
#pragma unroll
          for (int e = 0; e < 8; ++e) xx[e] = cf[e] + mu[e] * (sf[e] - cf[e]);
        }
        const bool isk = valid && ci >= 144 && ci < 272;
        float kk[8];
        float ss = 0.f;
        {
          const int kc = isk ? ci - 144 : 0;
          const float4 k0 = *(const float4*)(p.k_k + kc * 8), k1 = *(const float4*)(p.k_k + kc * 8 + 4);
          const float kkw[8] = {k0.x, k0.y, k0.z, k0.w, k1.x, k1.y, k1.z, k1.w};
#pragma unroll
          for (int e = 0; e < 8; ++e) { kk[e] = xx[e] * kkw[e]; ss += kk[e] * kk[e]; }
        }
        ss += dpp_xor1(ss);
        ss += dpp_xor2(ss);
        ss += dpp_hmirror(ss);
        if (valid) {
          if (ci < 128) {
            __half2 h0 = __floats2half2_rn(xx[0], xx[1]), h1 = __floats2half2_rn(xx[2], xx[3]), h2 = __floats2half2_rn(xx[4], xx[5]), h3 = __floats2half2_rn(xx[6], xx[7]);
            uint4 pk{*reinterpret_cast<unsigned*>(&h0), *reinterpret_cast<unsigned*>(&h1), *reinterpret_cast<unsigned*>(&h2), *reinterpret_cast<unsigned*>(&h3)};
            *(uint4*)(wk + ((size_t)(r * 16 + (ci >> 3)) * 8 + 0) * 64 + (ci & 7) * 8) = pk;
          } else if (ci < 144) {
            float t[8];
#pragma unroll
            for (int e = 0; e < 8; ++e) t[e] = tanhf(xx[e]);
            *(uint4*)(tl + (size_t)r * 256 + (ci - 128) * 8) = uint4{pack2(t[0], t[1]), pack2(t[2], t[3]), pack2(t[4], t[5]), pack2(t[6], t[7])};
          } else if (ci < 272) {
            const int kc = ci - 144;
            const float rn = -rsqrtf(ss + 1e-12f);
            __half2 h0 = __floats2half2_rn(xx[0], xx[1]), h1 = __floats2half2_rn(xx[2], xx[3]), h2 = __floats2half2_rn(xx[4], xx[5]), h3 = __floats2half2_rn(xx[6], xx[7]);
            uint4 pk{*reinterpret_cast<unsigned*>(&h0), *reinterpret_cast<unsigned*>(&h1), *reinterpret_cast<unsigned*>(&h2), *reinterpret_cast<unsigned*>(&h3)};
            *(uint4*)(wk + ((size_t)(r * 16 + (kc >> 3)) * 8 + 2) * 64 + (kc & 7) * 8) = pk;
            __half2 n0 = __floats2half2_rn(kk[0] * rn, kk[1] * rn), n1 = __floats2half2_rn(kk[2] * rn, kk[3] * rn), n2 = __floats2half2_rn(kk[4] * rn, kk[5] * rn), n3 = __floats2half2_rn(kk[6] * rn, kk[7] * rn);
            uint4 pn{*reinterpret_cast<unsigned*>(&n0), *reinterpret_cast<unsigned*>(&n1), *reinterpret_cast<unsigned*>(&n2), *reinterpret_cast<unsigned*>(&n3)};
            *(uint4*)(wk + ((size_t)(r * 16 + (kc >> 3)) * 8 + 3) * 64 + (kc & 7) * 8) = pn;
          } else if (ci < 400) {
            const int vc = ci - 272;
            __half2 h0 = __floats2half2_rn(xx[0], xx[1]), h1 = __floats2half2_rn(xx[2], xx[3]), h2 = __floats2half2_rn(xx[4], xx[5]), h3 = __floats2half2_rn(xx[6], xx[7]);
            uint4 pk{*reinterpret_cast<unsigned*>(&h0), *reinterpret_cast<unsigned*>(&h1), *reinterpret_cast<unsigned*>(&h2), *reinterpret_cast<unsigned*>(&h3)};
            *(uint4*)(wk + ((size_t)(r * 16 + (vc >> 3)) * 8 + 1) * 64 + (vc & 7) * 8) = pk;
          } else if (ci < 416) {
            *(uint4*)(tl + (size_t)r * 256 + 128 + (ci - 400) * 8) = uint4{pack2(xx[0], xx[1]), pack2(xx[2], xx[3]), pack2(xx[4], xx[5]), pack2(xx[6], xx[7])};
          } else {
            float t[8];
#pragma unroll
            for (int e = 0; e < 8; ++e) t[e] = sigm(xx[e]);
            *(uint4*)(sg + (size_t)r * 128 + (ci - 416) * 8) = uint4{pack2(t[0], t[1]), pack2(t[2], t[3]), pack2(t[4], t[5]), pack2(t[6], t[7])};
          }
        }
      }
    }
  }
}

__device__ __forceinline__ void step_r2(const Params& p, char* smem) {
  char* ws = p.ws;
  const int tid = get_tid(), lane = tid & 63, wave = tid >> 6;
  const int wm = wave >> 1, wn = wave & 1;
  const u16* tl = (const u16*)(ws + OFF_TL);
  const u16* sg = (const u16*)(ws + OFF_SG);
  __half* wk = (__half*)(ws + OFF_WK);
  u16* gr = (u16*)(ws + OFF_GR);
  {
    EpiR2 E{wk, p.w0, p.a0};
    run_gemm8(smem, tl, (const u16*)(ws + OFF_W4T), TG, 4096, 256, E);
  }
  for (int t = (gridDim.x - 1 - blockIdx.x) + 4 * 128; t < 5 * 128; t += gridDim.x) {
    int sub = t >> 7, rem = t & 127;
    int mt = rem & 15, nt = rem >> 4;
    f32x4 acc[4][4];
    zero_acc(acc);
    if (sub < 2) {
      gemm_acc(tl + (size_t)mt * 256 * 256 + sub * 64, 256, (const u16*)(ws + OFF_W2T) + sub * 65536 + (size_t)nt * 128 * 64, 64, 64, acc, smem);
    } else if (sub < 4) {
      gemm_acc(tl + (size_t)mt * 256 * 256 + 128 + (sub - 2) * 64, 256, (const u16*)(ws + OFF_A2T) + (sub - 2) * 65536 + (size_t)nt * 128 * 64, 64, 64, acc, smem);
    } else {
      gemm_acc(sg + (size_t)mt * 256 * 128, 128, (const u16*)(ws + OFF_G2T) + (size_t)nt * 128 * 128, 128, 128, acc, smem);
    }
#pragma unroll
    for (int mf = 0; mf < 4; ++mf)
#pragma unroll
      for (int nf = 0; nf < 4; ++nf)
#pragma unroll
        for (int j = 0; j < 4; ++j) {
          if (nf == 0 && j == 0) asm volatile("" ::: "memory");
          int m = mt * 256 + wm * 64 + mf * 16 + (lane >> 4) * 4 + j;
          int n = nt * 128 + wn * 64 + nf * 16 + (lane & 15);
          float v = acc[mf][nf][j];
          if (sub < 2) {
            float wl = v + p.w0[sub * 1024 + n];
            float dec = __expf(-0.6065306597f * sigm(wl));
            wk[((size_t)(m * 16 + (n >> 6)) * 8 + 4 + 2 * sub) * 64 + (n & 63)] = __float2half(dec);
          } else if (sub < 4) {
            int d = sub - 2;
            float a = sigm(v + p.a0[d * 1024 + n]);
            wk[((size_t)(m * 16 + (n >> 6)) * 8 + 5 + 2 * d) * 64 + (n & 63)] = __float2half(a);
          } else {
            gr[(size_t)m * 1024 + n] = f2bf(v);
          }
        }
  }
}

DI int swz16(int row) { return (row ^ (row >> 3)) & 15; }
DI int sw256(int row, int e) { return row * 256 + ((((e >> 3) ^ swz16(row))) << 4) + (e & 7) * 2; }
DI const bf16x8 ldfrag256(const char* base, int row, int ch) {
  return *(const bf16x8*)(base + row * 256 + ((ch ^ swz16(row)) << 4));
}

typedef unsigned v4u __attribute__((ext_vector_type(4)));
struct SsdPre { v4u c0, c1, c2, c3, b0, b1, b2, b3, x0, x1; float d0, d1; };
DI void ssd_issue(const Params& p, int g, int chain, int ci, int tid, SsdPre& R) {
  const int Ls = g < 2 ? 256 : 2048;
  const int nch = Ls >> 7;
  const int d = chain & 1, h = (chain >> 1) & 31, b = chain >> 6;
  const int grp = h >> 3;
  const int c = d ? nch - 1 - ci : ci;
  const int tok0 = b * Ls + c * 128;
  const u16* xbc = (const u16*)(p.ws + OFF_XBC);
  const float* dtb = (const float*)(p.ws + OFF_DT);
  const int lane = tid & 63, wave = tid >> 6;
#define SSD_LDCB(i, CF, BF) { int idx = tid + i * 512; int row = idx >> 4, ch = idx & 15; \
    const u16* src = xbc + (size_t)(tok0 + row) * 3072 + grp * 128 + ch * 8; R.CF = *(const v4u*)(src + 2560); R.BF = *(const v4u*)(src + 2048); }
  SSD_LDCB(0, c0, b0) SSD_LDCB(1, c1, b1) SSD_LDCB(2, c2, b2) SSD_LDCB(3, c3, b3)
#undef SSD_LDCB
#define SSD_LDX(i, XF) { int idx = tid + i * 512; int l = idx >> 3, ch = idx & 7; R.XF = *(const v4u*)(xbc + (size_t)(tok0 + l) * 3072 + h * 64 + ch * 8); }
  SSD_LDX(0, x0) SSD_LDX(1, x1)
#undef SSD_LDX
  if (wave == 0) {
    int e0 = 2 * lane, e1 = 2 * lane + 1;
    int l0 = d ? 127 - e0 : e0, l1 = d ? 127 - e1 : e1;
    R.d0 = dtb[(size_t)(tok0 + l0) * 64 + d * 32 + h];
    R.d1 = dtb[(size_t)(tok0 + l1) * 64 + d * 32 + h];
  }
}

__device__ __forceinline__ void ssd_chain(const Params& p, char* smem, int g, int chain, int next_chain, SsdPre& R) {
  char* ws = p.ws;
  const int tid = get_tid(), lane = tid & 63, wave = tid >> 6;
  const int Ls = g < 2 ? 256 : 2048;
  const int nch = Ls >> 7;
  const int d = chain & 1, h = (chain >> 1) & 31, b = chain >> 6;
  const int grp = h >> 3;
  const u16* xbc = (const u16*)(ws + OFF_XBC);
  const float* dtb = (const float*)(ws + OFF_DT);
  u16* yout = (u16*)(ws + (d ? OFF_SYB : OFF_SYF));
  char* Cs = smem;
  char* Bs = smem + 32768;
  char* BdT = smem + 65536;
  char* XT = smem + 98304;
  char* Ss = smem + 114688;
  float* csum = (float*)(smem + 131072);
  float* dts = (float*)(smem + 131584);
  const float a_h = -__expf(p.a_log[d * 32 + h]);
  const float dtbias = p.dt_bias[d * 32 + h];
  f32x4 sacc[2][2];
  {
    const int wn4 = wave >> 1, wp2 = wave & 1;
#pragma unroll
    for (int nf = 0; nf < 2; ++nf)
#pragma unroll
      for (int pf = 0; pf < 2; ++pf) {
        if (g == 2) {
          const float* h0 = (d ? p.ssm_b : p.ssm_f) + (size_t)(b * 32 + h) * 8192;
          const int n0 = wn4 * 32 + nf * 16 + (lane >> 4) * 4, pp = wp2 * 32 + pf * 16 + (lane & 15);
          const float4 t = *(const float4*)(h0 + pp * 128 + n0);
          sacc[nf][pf] = f32x4{t.x, t.y, t.z, t.w};
        } else {
          sacc[nf][pf] = f32x4{0.f, 0.f, 0.f, 0.f};
        }
      }
  }
  const int tid_outer = tid;
  for (int ci = 0; ci < nch; ++ci) {
    int tidv = tid_outer;
    asm volatile("" : "+v"(tidv));
    const int tid = tidv, lane = tidv & 63, wave = tidv >> 6;
    const int wq4 = wave >> 1, wq2 = wave & 1;
    const int c = d ? nch - 1 - ci : ci;
    const int tok0 = b * Ls + c * 128;
#define SSD_STCB(i, CF, BF) { int idx = tid + i * 512; int row = idx >> 4, ch = idx & 15; \
      *(v4u*)(Cs + row * 256 + ((ch ^ swz16(row)) << 4)) = R.CF; *(v4u*)(Bs + row * 256 + ((ch ^ swz16(row)) << 4)) = R.BF; }
    SSD_STCB(0, c0, b0) SSD_STCB(1, c1, b1) SSD_STCB(2, c2, b2) SSD_STCB(3, c3, b3)
#undef SSD_STCB
#define SSD_STX(i, XF) { int idx = tid + i * 512; int l = idx >> 3, ch = idx & 7; \
      const unsigned w0 = R.XF[0], w1 = R.XF[1], w2 = R.XF[2], w3 = R.XF[3]; \
      *(u16*)(XT + sw256(ch * 8 + 0, l)) = (u16)(w0 & 0xffff); *(u16*)(XT + sw256(ch * 8 + 1, l)) = (u16)(w0 >> 16); \
      *(u16*)(XT + sw256(ch * 8 + 2, l)) = (u16)(w1 & 0xffff); *(u16*)(XT + sw256(ch * 8 + 3, l)) = (u16)(w1 >> 16); \
      *(u16*)(XT + sw256(ch * 8 + 4, l)) = (u16)(w2 & 0xffff); *(u16*)(XT + sw256(ch * 8 + 5, l)) = (u16)(w2 >> 16); \
      *(u16*)(XT + sw256(ch * 8 + 6, l)) = (u16)(w3 & 0xffff); *(u16*)(XT + sw256(ch * 8 + 7, l)) = (u16)(w3 >> 16); }
    SSD_STX(0, x0) SSD_STX(1, x1)
#undef SSD_STX
    if (wave == 0) {
      int e0 = 2 * lane, e1 = 2 * lane + 1;
      int l0 = d ? 127 - e0 : e0, l1 = d ? 127 - e1 : e1;
      float x0 = R.d0 + dtbias;
      float x1 = R.d1 + dtbias;
      float dt0 = x0 > 20.f ? x0 : log1pf(__expf(x0));
      float dt1 = x1 > 20.f ? x1 : log1pf(__expf(x1));
      float a0 = dt0 * a_h, a1 = dt1 * a_h;
      float s = a0 + a1;
#pragma unroll
      for (int o = 1; o < 64; o <<= 1) {
        float t = __shfl_up(s, o);
        if (lane >= o) s += t;
      }
      csum[l1] = s;
      csum[l0] = s - a1;
      dts[l0] = dt0;
      dts[l1] = dt1;
    }
    if (ci + 1 < nch) ssd_issue(p, g, chain, ci + 1, tid, R);
    else if (next_chain >= 0) ssd_issue(p, g, next_chain, 0, tid, R);
#pragma unroll
    for (int nf = 0; nf < 2; ++nf)
#pragma unroll
      for (int pf = 0; pf < 2; ++pf) {
        const int n0 = wq4 * 32 + nf * 16 + (lane >> 4) * 4, pp = wq2 * 32 + pf * 16 + (lane & 15);
        *(uint2*)(Ss + sw256(pp, n0)) = uint2{pack2(sacc[nf][pf][0], sacc[nf][pf][1]), pack2(sacc[nf][pf][2], sacc[nf][pf][3])};
      }
    __syncthreads();
    const float cstot = csum[d ? 0 : 127];
#pragma unroll
    for (int i = 0; i < 4; ++i) {
      int idx = tid + i * 512;
      int l = idx >> 4, ch = idx & 15;
      uint4 bv = *(const uint4*)(Bs + l * 256 + ((ch ^ swz16(l)) << 4));
      float f = dts[l] * __expf(cstot - csum[l]);
      unsigned w[4] = {bv.x, bv.y, bv.z, bv.w};
#pragma unroll
      for (int e = 0; e < 8; ++e) {
        int n = ch * 8 + e;
        float val = bf2f((u16)((w[e >> 1] >> ((e & 1) * 16)) & 0xffff)) * f;
        *(u16*)(BdT + sw256(n, l)) = f2bf(val);
      }
    }
    f32x4 gacc[2][4];
#pragma unroll
    for (int i = 0; i < 2; ++i)
#pragma unroll
      for (int j = 0; j < 4; ++j) gacc[i][j] = f32x4{0.f, 0.f, 0.f, 0.f};
#pragma unroll
    for (int ks = 0; ks < 4; ++ks) {
      int ch = ks * 4 + (lane >> 4);
      bf16x8 a[2], bb[4];
#pragma unroll
      for (int sf = 0; sf < 2; ++sf) a[sf] = ldfrag256(Bs, wq4 * 32 + sf * 16 + (lane & 15), ch);
#pragma unroll
      for (int lf = 0; lf < 4; ++lf) bb[lf] = ldfrag256(Cs, wq2 * 64 + lf * 16 + (lane & 15), ch);
#pragma unroll
      for (int sf = 0; sf < 2; ++sf)
#pragma unroll
        for (int lf = 0; lf < 4; ++lf)
          gacc[sf][lf] = __builtin_amdgcn_mfma_f32_16x16x32_bf16(a[sf], bb[lf], gacc[sf][lf], 0, 0, 0);
    }
    {
      float css[2][4], dss[2][4];
#pragma unroll
      for (int sf = 0; sf < 2; ++sf)
#pragma unroll
        for (int j = 0; j < 4; ++j) {
          const int sI = wq4 * 32 + sf * 16 + (lane >> 4) * 4 + j;
          css[sf][j] = csum[sI];
          dss[sf][j] = dts[sI];
        }
#pragma unroll
      for (int lf = 0; lf < 4; ++lf) {
        const int l = wq2 * 64 + lf * 16 + (lane & 15);
        const float csl = csum[l];
#pragma unroll
        for (int sf = 0; sf < 2; ++sf)
#pragma unroll
          for (int j = 0; j < 4; ++j) {
            const int sI = wq4 * 32 + sf * 16 + (lane >> 4) * 4 + j;
            const bool valid = d ? (sI >= l) : (sI <= l);
            const float e = valid ? __expf(csl - css[sf][j]) * dss[sf][j] : 0.f;
            gacc[sf][lf][j] *= e;
          }
      }
    }
    __syncthreads();
#pragma unroll
    for (int sf = 0; sf < 2; ++sf)
#pragma unroll
      for (int lf = 0; lf < 4; ++lf) {
        const int s0 = wq4 * 32 + sf * 16 + (lane >> 4) * 4, l = wq2 * 64 + lf * 16 + (lane & 15);
        *(uint2*)(Bs + sw256(l, s0)) = uint2{pack2(gacc[sf][lf][0], gacc[sf][lf][1]), pack2(gacc[sf][lf][2], gacc[sf][lf][3])};
      }
    __syncthreads();
    {
      f32x4 yacc[2][2];
#pragma unroll
      for (int i = 0; i < 2; ++i)
#pragma unroll
        for (int j = 0; j < 2; ++j) yacc[i][j] = f32x4{0.f, 0.f, 0.f, 0.f};
#pragma unroll
      for (int ks = 0; ks < 4; ++ks) {
        int ch = ks * 4 + (lane >> 4);
        bf16x8 a[2], bb[2];
#pragma unroll
        for (int pf = 0; pf < 2; ++pf) a[pf] = ldfrag256(Ss, wq2 * 32 + pf * 16 + (lane & 15), ch);
#pragma unroll
        for (int lf = 0; lf < 2; ++lf) bb[lf] = ldfrag256(Cs, wq4 * 32 + lf * 16 + (lane & 15), ch);
#pragma unroll
        for (int pf = 0; pf < 2; ++pf)
#pragma unroll
          for (int lf = 0; lf < 2; ++lf)
            yacc[pf][lf] = __builtin_amdgcn_mfma_f32_16x16x32_bf16(a[pf], bb[lf], yacc[pf][lf], 0, 0, 0);
      }
#pragma unroll
      for (int lf = 0; lf < 2; ++lf) {
        const float e = __expf(csum[wq4 * 32 + lf * 16 + (lane & 15)]);
#pragma unroll
        for (int pf = 0; pf < 2; ++pf) yacc[pf][lf] *= e;
      }
#pragma unroll
      for (int ks = 0; ks < 4; ++ks) {
        int ch = ks * 4 + (lane >> 4);
        bf16x8 a[2], bb[2];
#pragma unroll
        for (int pf = 0; pf < 2; ++pf) a[pf] = ldfrag256(XT, wq2 * 32 + pf * 16 + (lane & 15), ch);
#pragma unroll
        for (int lf = 0; lf < 2; ++lf) bb[lf] = ldfrag256(Bs, wq4 * 32 + lf * 16 + (lane & 15), ch);
#pragma unroll
        for (int pf = 0; pf < 2; ++pf)
#pragma unroll
          for (int lf = 0; lf < 2; ++lf)
            yacc[pf][lf] = __builtin_amdgcn_mfma_f32_16x16x32_bf16(a[pf], bb[lf], yacc[pf][lf], 0, 0, 0);
      }
#pragma unroll
      for (int pf = 0; pf < 2; ++pf)
#pragma unroll
        for (int lf = 0; lf < 2; ++lf) {
          const int p0 = wq2 * 32 + pf * 16 + (lane >> 4) * 4, l = wq4 * 32 + lf * 16 + (lane & 15);
          *(uint2*)(yout + (size_t)(tok0 + l) * 2048 + h * 64 + p0) = uint2{pack2(yacc[pf][lf][0], yacc[pf][lf][1]), pack2(yacc[pf][lf][2], yacc[pf][lf][3])};
        }
    }
    {
      float e = __expf(cstot);
#pragma unroll
      for (int nf = 0; nf < 2; ++nf)
#pragma unroll
        for (int pf = 0; pf < 2; ++pf) sacc[nf][pf] *= e;
#pragma unroll
      for (int ks = 0; ks < 4; ++ks) {
        int ch = ks * 4 + (lane >> 4);
        bf16x8 a[2], bb[2];
#pragma unroll
        for (int nf = 0; nf < 2; ++nf) a[nf] = ldfrag256(BdT, wq4 * 32 + nf * 16 + (lane & 15), ch);
#pragma unroll
        for (int pf = 0; pf < 2; ++pf) bb[pf] = ldfrag256(XT, wq2 * 32 + pf * 16 + (lane & 15), ch);
#pragma unroll
        for (int nf = 0; nf < 2; ++nf)
#pragma unroll
          for (int pf = 0; pf < 2; ++pf)
            sacc[nf][pf] = __builtin_amdgcn_mfma_f32_16x16x32_bf16(a[nf], bb[pf], sacc[nf][pf], 0, 0, 0);
      }
    }
    __syncthreads();
  }
  if (g < 2) {
    float* so = p.out + (d ? OUT_SSMB : OUT_SSMF) + (size_t)((g * 16 + b) * 32 + h) * 8192;
    const int wn4 = wave >> 1, wp2 = wave & 1;
#pragma unroll
    for (int nf = 0; nf < 2; ++nf)
#pragma unroll
      for (int pf = 0; pf < 2; ++pf) {
        const int n0 = wn4 * 32 + nf * 16 + (lane >> 4) * 4, pp = wp2 * 32 + pf * 16 + (lane & 15);
        *(float4*)(so + pp * 128 + n0) = float4{sacc[nf][pf][0], sacc[nf][pf][1], sacc[nf][pf][2], sacc[nf][pf][3]};
      }
  }
}


template <bool SEG>
__device__ __forceinline__ void wkv_pair(const Params& p, char* smem, int g, int item) {
  char* ws = p.ws;
  const int tid = get_tid(), lane = tid & 63, wave = tid >> 6;
  const int Ls = SEG ? 2048 : 256;
  const __half* wk = (const __half*)(ws + OFF_WK);
  float* stage = (float*)smem;
  float* ylds = (float*)(smem + 98304);
  const bool cw = true;
  const int slot = wave >> 2, wq = wave & 3;
  const int ig = lane >> 3, jg = lane & 7;
  const int row0 = wq * 16 + ig * 2;
  const int chain = SEG ? (item >> 3) : item * 2 + slot;
  const int seg = SEG ? (item & 7) : 0;
  const bool act = cw && (SEG ? !(slot == 1 && seg == 0) : true);
  const int d = chain & 1, h = (chain >> 1) & 15, b = chain >> 5;
  typedef float f2 __attribute__((ext_vector_type(2)));
  f2 S[2][4];
#pragma unroll
  for (int rr = 0; rr < 2; ++rr) {
    if (SEG) {
      if (slot == 0) {
        if (seg == 0) {
          const float* s0 = (d ? p.wkv_b : p.wkv_f) + ((size_t)(b * 16 + h) * 64 + row0 + rr) * 64 + jg * 8;
#pragma unroll
          for (int c = 0; c < 4; ++c) S[rr][c] = f2{s0[2 * c], s0[2 * c + 1]};
        } else {
#pragma unroll
          for (int c = 0; c < 4; ++c) S[rr][c] = f2{0.f, 0.f};
        }
      } else {
#pragma unroll
        for (int c = 0; c < 4; ++c) S[rr][c] = f2{(row0 + rr == jg * 8 + 2 * c) ? 1.f : 0.f, (row0 + rr == jg * 8 + 2 * c + 1) ? 1.f : 0.f};
      }
    } else {
#pragma unroll
      for (int c = 0; c < 4; ++c) S[rr][c] = f2{0.f, 0.f};
    }
  }
  const int pair = tid >> 4, lslot = pair >> 4, lstep = pair & 15, sub = tid & 15;
  const int lch = SEG ? (item >> 3) : item * 2 + lslot;
  const int ld = lch & 1, lh = (lch >> 1) & 15, lb = lch >> 5;
  const bool ldo = SEG ? (lslot == 0) : true;
  const int sbase = seg * 256;
  const int cslot = SEG ? 0 : slot;
  float ka[4];
#pragma unroll
  for (int e = 0; e < 4; ++e) ka[e] = p.k_a[lh * 64 + sub * 4 + e];
  u16* yout;
  if (SEG) yout = lslot == 0 ? (u16*)(ws + (ld ? OFF_WYB : OFF_WYF)) : (u16*)(ws + OFF_YM) + (ld ? (size_t)TG * 1024 : 0);
  else yout = (u16*)(ws + (ld ? OFF_WYB : OFF_WYF));
  const bool ywr = SEG ? (lslot == 0 || seg > 0) : true;
  uint2 rg[6];
  auto prefetch = [&](int tb) {
    int s = sbase + tb * 16 + lstep;
    int pos = ld ? Ls - 1 - s : s;
    int r = lb * Ls + pos;
    const __half* rec = wk + ((size_t)(r * 16 + lh) * 8) * 64 + sub * 4;
    rg[0] = *(const uint2*)(rec + 0 * 64);
    rg[1] = *(const uint2*)(rec + 1 * 64);
    rg[2] = *(const uint2*)(rec + 2 * 64);
    rg[3] = *(const uint2*)(rec + 3 * 64);
    rg[4] = *(const uint2*)(rec + (4 + 2 * ld) * 64);
    rg[5] = *(const uint2*)(rec + (5 + 2 * ld) * 64);
  };
  auto unpack4 = [&](uint2 u, float (&o)[4]) {
    __half2 h0 = *reinterpret_cast<__half2*>(&u.x);
    __half2 h1 = *reinterpret_cast<__half2*>(&u.y);
    float2 f0 = __half22float2(h0), f1 = __half22float2(h1);
    o[0] = f0.x; o[1] = f0.y; o[2] = f1.x; o[3] = f1.y;
  };
  auto stage_store = [&](int buf) {
    float r_[4], v_[4], k_[4], nkk_[4], w_[4], a_[4];
    unpack4(rg[0], r_); unpack4(rg[1], v_); unpack4(rg[2], k_); unpack4(rg[3], nkk_); unpack4(rg[4], w_); unpack4(rg[5], a_);
    float b_[4], kd_[4];
#pragma unroll
    for (int e = 0; e < 4; ++e) {
      b_[e] = -nkk_[e] * a_[e];
      kd_[e] = k_[e] * (1.f + (a_[e] - 1.f) * ka[e]);
    }
    float* dst = stage + ((size_t)((buf * 2 + lslot) * 16 + lstep) * 6) * 64 + sub * 4;
    *(float4*)(dst + 0 * 64) = float4{nkk_[0], nkk_[1], nkk_[2], nkk_[3]};
    *(float4*)(dst + 1 * 64) = float4{w_[0], w_[1], w_[2], w_[3]};
    *(float4*)(dst + 2 * 64) = float4{b_[0], b_[1], b_[2], b_[3]};
    *(float4*)(dst + 3 * 64) = float4{kd_[0], kd_[1], kd_[2], kd_[3]};
    *(float4*)(dst + 4 * 64) = float4{r_[0], r_[1], r_[2], r_[3]};
    *(float4*)(dst + 5 * 64) = float4{v_[0], v_[1], v_[2], v_[3]};
  };
  if (ldo) { prefetch(0); stage_store(0); prefetch(1); stage_store(1); }
  __syncthreads();
  for (int tb = 0; tb < 16; ++tb) {
    const bool more = tb + 2 < 16;
    if (more && ldo) prefetch(tb + 2);
    float* yl = ylds + (tb & 1) * 2048;
    if (act) {
      const float* sb = stage + ((size_t)(((tb & 1) * 2 + cslot) * 16) * 6) * 64;
      for (int sg = 0; sg < 8; ++sg) {
        float ysv[2][2];
#pragma unroll
        for (int s4 = 0; s4 < 2; ++s4) {
          const int st = sg * 2 + s4;
          const float* v6 = sb + st * 384 + jg * 8;
          f2 nkk[4], w[4], bb[4], kd[4], rr[4];
#pragma unroll
          for (int q = 0; q < 2; ++q) {
            float4 t0 = *(const float4*)(v6 + 0 * 64 + q * 4);
            nkk[q * 2] = f2{t0.x, t0.y}; nkk[q * 2 + 1] = f2{t0.z, t0.w};
            float4 t1 = *(const float4*)(v6 + 1 * 64 + q * 4);
            w[q * 2] = f2{t1.x, t1.y}; w[q * 2 + 1] = f2{t1.z, t1.w};
            float4 t2 = *(const float4*)(v6 + 2 * 64 + q * 4);
            bb[q * 2] = f2{t2.x, t2.y}; bb[q * 2 + 1] = f2{t2.z, t2.w};
            float4 t3 = *(const float4*)(v6 + 3 * 64 + q * 4);
            kd[q * 2] = f2{t3.x, t3.y}; kd[q * 2 + 1] = f2{t3.z, t3.w};
            float4 t4 = *(const float4*)(v6 + 4 * 64 + q * 4);
            rr[q * 2] = f2{t4.x, t4.y}; rr[q * 2 + 1] = f2{t4.z, t4.w};
          }
          float2 vv2 = *(const float2*)(sb + st * 384 + 5 * 64 + row0);
          float vi[2] = {vv2.x, vv2.y};
          if (SEG && slot == 1) { vi[0] = 0.f; vi[1] = 0.f; }
#pragma unroll
          for (int r2 = 0; r2 < 2; ++r2) {
            f2 sat = S[r2][0] * nkk[0];
            sat += S[r2][1] * nkk[1]; sat += S[r2][2] * nkk[2]; sat += S[r2][3] * nkk[3];
            float sa = sat.x + sat.y;
            sa += dpp_xor1(sa);
            sa += dpp_xor2(sa);
            sa += dpp_hmirror(sa);
            f2 yt;
            {
              f2 t0 = S[r2][0] * w[0] + vi[r2] * kd[0]; S[r2][0] = t0 + sa * bb[0]; yt = S[r2][0] * rr[0];
              f2 t1 = S[r2][1] * w[1] + vi[r2] * kd[1]; S[r2][1] = t1 + sa * bb[1]; yt += S[r2][1] * rr[1];
              f2 t2 = S[r2][2] * w[2] + vi[r2] * kd[2]; S[r2][2] = t2 + sa * bb[2]; yt += S[r2][2] * rr[2];
              f2 t3 = S[r2][3] * w[3] + vi[r2] * kd[3]; S[r2][3] = t3 + sa * bb[3]; yt += S[r2][3] * rr[3];
            }
            float y = yt.x + yt.y;
            y += dpp_xor1(y);
            y += dpp_xor2(y);
            y += dpp_hmirror(y);
            ysv[s4][r2] = y;
          }
        }
        if (jg == 0) {
#pragma unroll
          for (int s4 = 0; s4 < 2; ++s4)
            *(float2*)(yl + (slot * 16 + sg * 2 + s4) * 64 + row0) = float2{ysv[s4][0], ysv[s4][1]};
        }
      }
    }
    __syncthreads();
    if (more && ldo) stage_store(tb & 1);
    if (ywr) {
      int s = sbase + tb * 16 + lstep;
      int pos = ld ? Ls - 1 - s : s;
      int r = lb * Ls + pos;
      float4 yv = *(const float4*)(yl + (lslot * 16 + lstep) * 64 + sub * 4);
      *(uint2*)(yout + (size_t)r * 1024 + lh * 64 + sub * 4) = uint2{pack2(yv.x, yv.y), pack2(yv.z, yv.w)};
    }
  }
  __syncthreads();
  if (act) {
#pragma unroll
    for (int r2 = 0; r2 < 2; ++r2) {
      float* so;
      if (SEG) so = p.out + 8388608 + ((size_t)((chain * 8 + seg) * 2 + slot)) * 4096 + (row0 + r2) * 64 + jg * 8;
      else so = p.out + (d ? OUT_WKVB : OUT_WKVF) + ((size_t)((g * 16 + b) * 16 + h) * 64 + row0 + r2) * 64 + jg * 8;
#pragma unroll
      for (int c = 0; c < 4; ++c) { so[2 * c] = S[r2][c].x; so[2 * c + 1] = S[r2][c].y; }
    }
  }
}

__device__ __forceinline__ void wkv_fix(const Params& p, char* smem, int item) {
  const int chain = item >> 2, qt = item & 3;
  char* ws = p.ws;
  const int tid = get_tid(), lane = tid & 63, wave = tid >> 6;
  const int d = chain & 1, h = (chain >> 1) & 15, b = chain >> 5;
  const float* SE = p.out + 8388608;
  u16* yout = (u16*)(ws + (d ? OFF_WYB : OFF_WYF));
  const u16* Q = (const u16*)(ws + OFF_YM) + (d ? (size_t)TG * 1024 : 0);
  float* Pl = (float*)smem;
  float* Sl = (float*)(smem + 16384);
  u16* Ql = (u16*)(smem + 36864);
  const int i = lane;
  float S0[64];
  {
    const float* src = SE + ((size_t)(chain * 8) * 2) * 4096 + i * 64;
#pragma unroll
    for (int j = 0; j < 16; ++j) {
      float4 t = *(const float4*)(src + j * 4);
      S0[j * 4] = t.x; S0[j * 4 + 1] = t.y; S0[j * 4 + 2] = t.z; S0[j * 4 + 3] = t.w;
    }
  }
  for (int k = 1; k < 8; ++k) {
    {
      int tt = qt * 64 + (tid >> 3), ch = tid & 7;
      int s = k * 256 + tt;
      int pos = d ? 2047 - s : s;
      int r = b * 2048 + pos;
      *(uint4*)(Ql + tt * 64 + ch * 8) = *(const uint4*)(Q + (size_t)r * 1024 + h * 64 + ch * 8);
    }
    if (k < 7) {
      const float* src = SE + ((size_t)((chain * 8 + k) * 2 + 1)) * 4096;
#pragma unroll
      for (int e = 0; e < 2; ++e) ((float4*)Pl)[tid + e * 512] = ((const float4*)src)[tid + e * 512];
    }
    __syncthreads();
    for (int n = 0; n < 8; ++n) {
      int tt = qt * 64 + wave + n * 8;
      float a0 = 0.f, a1 = 0.f;
#pragma unroll
      for (int jc = 0; jc < 8; ++jc) {
        float q[8];
        unpack8(*(const uint4*)(Ql + tt * 64 + jc * 8), q);
#pragma unroll
        for (int e = 0; e < 8; e += 2) { a0 += S0[jc * 8 + e] * q[e]; a1 += S0[jc * 8 + e + 1] * q[e + 1]; }
      }
      int s = k * 256 + tt;
      int pos = d ? 2047 - s : s;
      size_t off = (size_t)(b * 2048 + pos) * 1024 + h * 64 + i;
      yout[off] = f2bf(bf2f(yout[off]) + (a0 + a1));
    }
    if (k < 7) {
      float nv[8];
      const float* sl = SE + ((size_t)((chain * 8 + k) * 2)) * 4096 + i * 64 + wave * 8;
      {
        float4 t0 = *(const float4*)sl, t1 = *(const float4*)(sl + 4);
        nv[0] = t0.x; nv[1] = t0.y; nv[2] = t0.z; nv[3] = t0.w; nv[4] = t1.x; nv[5] = t1.y; nv[6] = t1.z; nv[7] = t1.w;
      }
#pragma unroll
      for (int m = 0; m < 64; ++m) {
        float4 p0 = *(const float4*)(Pl + m * 64 + wave * 8), p1 = *(const float4*)(Pl + m * 64 + wave * 8 + 4);
        nv[0] += S0[m] * p0.x; nv[1] += S0[m] * p0.y; nv[2] += S0[m] * p0.z; nv[3] += S0[m] * p0.w;
        nv[4] += S0[m] * p1.x; nv[5] += S0[m] * p1.y; nv[6] += S0[m] * p1.z; nv[7] += S0[m] * p1.w;
      }
      *(float4*)(Sl + i * 68 + wave * 8) = float4{nv[0], nv[1], nv[2], nv[3]};
      *(float4*)(Sl + i * 68 + wave * 8 + 4) = float4{nv[4], nv[5], nv[6], nv[7]};
      __syncthreads();
#pragma unroll
      for (int j = 0; j < 16; ++j) {
        float4 t = *(const float4*)(Sl + i * 68 + j * 4);
        S0[j * 4] = t.x; S0[j * 4 + 1] = t.y; S0[j * 4 + 2] = t.z; S0[j * 4 + 3] = t.w;
      }
    }
    __syncthreads();
  }
}

__device__ __forceinline__ void step_scan(const Params& p, char* smem, int g, int parts) {
  const int G = gridDim.x;
  const int r1 = (parts & 1) ? ((RM & (1 << 20)) ? 2 : 1) : 0, r2 = (parts & 2) ? ((RM & (1 << 21)) ? 2 : 1) : 0;
  if (g < 2) {
    for (int rr = 0; rr < r1; ++rr) {
      SsdPre R;
      if ((int)blockIdx.x < 1024) ssd_issue(p, g, blockIdx.x, 0, get_tid(), R);
      for (int ch = blockIdx.x; ch < 1024; ch += G) ssd_chain(p, smem, g, ch, ch + G < 1024 ? ch + G : -1, R);
    }
    for (int rr = 0; rr < r2; ++rr) for (int it = blockIdx.x; it < 256; it += G) wkv_pair<false>(p, smem, g, it);
  } else {
    for (int rr = 0; rr < r1; ++rr) {
      SsdPre R;
      if ((int)blockIdx.x < 128) ssd_issue(p, g, blockIdx.x, 0, get_tid(), R);
      for (int ch = blockIdx.x; ch < 128; ch += G) ssd_chain(p, smem, g, ch, ch + G < 128 ? ch + G : -1, R);
    }
    for (int rr = 0; rr < r2; ++rr) for (int it = (G - 1 - blockIdx.x); it < 512; it += G) wkv_pair<true>(p, smem, g, it);
  }
}
__device__ __forceinline__ void step_fix(const Params& p, char* smem) {
  for (int it = blockIdx.x; it < 256; it += gridDim.x) wkv_fix(p, smem, it);
}

__device__ __forceinline__ void step_fin(const Params& p, int g) {
  char* ws = p.ws;
  const int tid = get_tid(), lane = tid & 63, wave = tid >> 6;
  const int gw = blockIdx.x * 8 + wave, nw = gridDim.x * 8;
  {
    const u16* yf = (const u16*)(ws + OFF_SYF);
    const u16* yb = (const u16*)(ws + OFF_SYB);
    const u16* xbc = (const u16*)(ws + OFF_XBC);
    const u16* zb = (const u16*)(ws + OFF_Z);
    u16* ym = (u16*)(ws + OFF_YM);
    for (int it = gw; it < TG * 4; it += nw) {
      int r = it >> 2, gq = it & 3;
      int ch = gq * 512 + lane * 8;
      uint4 a = *(const uint4*)(yf + (size_t)r * 2048 + ch);
      uint4 b = *(const uint4*)(yb + (size_t)r * 2048 + ch);
      uint4 x = *(const uint4*)(xbc + (size_t)r * 3072 + ch);
      uint4 z = *(const uint4*)(zb + (size_t)r * 2048 + ch);
      float dsk = p.d_skip[ch >> 6];
      unsigned aw[4] = {a.x, a.y, a.z, a.w}, bw[4] = {b.x, b.y, b.z, b.w}, xw[4] = {x.x, x.y, x.z, x.w}, zw[4] = {z.x, z.y, z.z, z.w};
      float y[8];
      float ss = 0.f;
#pragma unroll
      for (int e = 0; e < 8; ++e) {
        int sh = (e & 1) * 16;
        float yy = bf2f((u16)(aw[e >> 1] >> sh)) + bf2f((u16)(bw[e >> 1] >> sh)) + dsk * bf2f((u16)(xw[e >> 1] >> sh));
        yy *= siluf(bf2f((u16)(zw[e >> 1] >> sh)));
        y[e] = yy;
        ss += yy * yy;
      }
      ss = wave_sum(ss);
      float rinv = rsqrtf(ss * (1.f / 512.f) + 1e-5f);
      float4 w0 = *(const float4*)(p.m_norm_w + ch), w1 = *(const float4*)(p.m_norm_w + ch + 4);
      *(uint4*)(ym + (size_t)r * 2048 + ch) =
          uint4{pack2(y[0] * rinv * w0.x, y[1] * rinv * w0.y), pack2(y[2] * rinv * w0.z, y[3] * rinv * w0.w),
                pack2(y[4] * rinv * w1.x, y[5] * rinv * w1.y), pack2(y[6] * rinv * w1.z, y[7] * rinv * w1.w)};
    }
  }
  {
    const u16* __restrict__ yf = (const u16*)(ws + OFF_WYF);
    const u16* __restrict__ yb = (const u16*)(ws + OFF_WYB);
    const __half* __restrict__ wk = (const __half*)(ws + OFF_WK);
    const u16* __restrict__ gr = (const u16*)(ws + OFF_GR);
    u16* __restrict__ yr = (u16*)(ws + OFF_YR);
    for (int it = gw; it < TG * 2; it += nw) {
      const int r = it >> 1, hh = it & 1;
      const int c0 = hh * 512 + lane * 8;
      const int head = c0 >> 6;
      const uint4 a = *(const uint4*)(yf + (size_t)r * 1024 + c0);
      const uint4 b = *(const uint4*)(yb + (size_t)r * 1024 + c0);
      const uint4 gq = *(const uint4*)(gr + (size_t)r * 1024 + c0);
      const __half* rec = wk + ((size_t)(r * 16 + head) * 8) * 64 + (lane & 7) * 8;
      const uint4 qr = *(const uint4*)(rec + 0 * 64), qv = *(const uint4*)(rec + 1 * 64), qk = *(const uint4*)(rec + 2 * 64);
      const uint4 qaf = *(const uint4*)(rec + 5 * 64), qab = *(const uint4*)(rec + 7 * 64);
      const float4 lw0 = *(const float4*)(p.lnx_w + c0), lw1 = *(const float4*)(p.lnx_w + c0 + 4);
      const float4 lb0 = *(const float4*)(p.lnx_b + c0), lb1 = *(const float4*)(p.lnx_b + c0 + 4);
      const float4 ka0 = *(const float4*)(p.k_a + c0), ka1 = *(const float4*)(p.k_a + c0 + 4);
      const float4 rk0 = *(const float4*)(p.r_k + c0), rk1 = *(const float4*)(p.r_k + c0 + 4);
      const float lw[8] = {lw0.x, lw0.y, lw0.z, lw0.w, lw1.x, lw1.y, lw1.z, lw1.w};
      const float lb[8] = {lb0.x, lb0.y, lb0.z, lb0.w, lb1.x, lb1.y, lb1.z, lb1.w};
      const float kav[8] = {ka0.x, ka0.y, ka0.z, ka0.w, ka1.x, ka1.y, ka1.z, ka1.w};
      const float rkv[8] = {rk0.x, rk0.y, rk0.z, rk0.w, rk1.x, rk1.y, rk1.z, rk1.w};
      float ya[8], yb8[8], gg[8];
      unpack8(a, ya); unpack8(b, yb8); unpack8(gq, gg);
      auto unph = [&](const uint4& u, float (&o)[8]) {
        const __half2* hp = reinterpret_cast<const __half2*>(&u);
#pragma unroll
        for (int e = 0; e < 4; ++e) { float2 f = __half22float2(hp[e]); o[2 * e] = f.x; o[2 * e + 1] = f.y; }
      };
      float rr[8], vv[8], kk[8], af[8], ab[8];
      unph(qr, rr); unph(qv, vv); unph(qk, kk); unph(qaf, af); unph(qab, ab);
      float y[8];
      float s1 = 0.f;
#pragma unroll
      for (int e = 0; e < 8; ++e) { y[e] = ya[e] + yb8[e]; s1 += y[e]; }
      s1 += dpp_xor1(s1); s1 += dpp_xor2(s1); s1 += dpp_hmirror(s1);
      const float mean = s1 * (1.f / 64.f);
      float s2 = 0.f, s3 = 0.f;
#pragma unroll
      for (int e = 0; e < 8; ++e) {
        const float dy = y[e] - mean;
        s2 += dy * dy;
        const float kmean = kk[e] * (1.f + (0.5f * (af[e] + ab[e]) - 1.f) * kav[e]);
        s3 += rr[e] * kmean * rkv[e];
      }
      s2 += dpp_xor1(s2); s2 += dpp_xor2(s2); s2 += dpp_hmirror(s2);
      s3 += dpp_xor1(s3); s3 += dpp_xor2(s3); s3 += dpp_hmirror(s3);
      const float rs = rsqrtf(s2 * (1.f / 64.f) + 64e-5f);
      float o[8];
#pragma unroll
      for (int e = 0; e < 8; ++e) o[e] = ((y[e] - mean) * rs * lw[e] + lb[e] + s3 * vv[e]) * gg[e];
      *(uint4*)(yr + (size_t)r * 1024 + c0) = uint4{pack2(o[0], o[1]), pack2(o[2], o[3]), pack2(o[4], o[5]), pack2(o[6], o[7])};
    }
  }
}

__device__ __forceinline__ void step_outproj(const Params& p, char* smem, int g) {
  char* ws = p.ws;
  const int sub = blockIdx.x >> 6, vb = blockIdx.x & 63;
  if (sub < 3) {
    const u16* A = sub == 2 ? (const u16*)(ws + OFF_YR) : (const u16*)(ws + OFF_YM) + sub * 1024;
    const u16* B = sub == 2 ? (const u16*)(ws + OFF_WROUT) : (const u16*)(ws + OFF_WMOUT) + sub * 1024;
    EpiOutV E{(const u16*)(ws + OFF_GATE), (u16*)(ws + OFF_XBC) + (size_t)sub * TG * 1024, sub == 2 ? 1024 : 0};
    run_gemm8(smem, A, B, TG, 1024, 1024, E, vb, 64, 0, sub == 2 ? 1024 : 2048);
  }
}
__device__ __forceinline__ void step_sum(const Params& p, int g, int vb = -1, int nb = 0) {
  const u16* __restrict__ V = (const u16*)(p.ws + OFF_XBC);
  u16* __restrict__ U = (u16*)p.out + (size_t)g * TG * 1024;
  const int tid = get_tid();
  if (vb < 0) { vb = blockIdx.x; nb = gridDim.x; }
  for (int i = vb * NTHR + tid; i < TG * 128; i += nb * NTHR) {
    float a[8], b[8], c[8];
    unpack8(*(const uint4*)(V + (size_t)i * 8), a);
    unpack8(*(const uint4*)(V + (size_t)TG * 1024 + (size_t)i * 8), b);
    unpack8(*(const uint4*)(V + (size_t)2 * TG * 1024 + (size_t)i * 8), c);
    *(uint4*)(U + (size_t)i * 8) = uint4{pack2(a[0] + b[0] + c[0], a[1] + b[1] + c[1]), pack2(a[2] + b[2] + c[2], a[3] + b[3] + c[3]),
                                         pack2(a[4] + b[4] + c[4], a[5] + b[5] + c[5]), pack2(a[6] + b[6] + c[6], a[7] + b[7] + c[7])};
  }
}

__device__ __forceinline__ void step_wo(const Params& p, char* smem, int g) {
  char* ws = p.ws;
  EpiWo E{p.x_prompt, p.x_sample, (const float*)(ws + OFF_MOD), (float*)(ws + OFF_X1), 0};
  run_gemm8(smem, (const u16*)p.out, (const u16*)(ws + OFF_WO), NTOK, 1024, 1024, E);
}

__device__ __forceinline__ void step_gu(const Params& p, char* smem) {
  char* ws = p.ws;
  EpiGU E{(u16*)(ws + OFF_ACT)};
  run_gemm8(smem, (const u16*)(ws + OFF_H2), (const u16*)(ws + OFF_WGU), NTOK, 5632, 1024, E);
}

__device__ __forceinline__ void step_down(const Params& p, char* smem) {
  char* ws = p.ws;
  EpiDown E{(const float*)(ws + OFF_MOD), (float*)(ws + OFF_X1)};
  run_gemm8(smem, (const u16*)(ws + OFF_ACT), (const u16*)(ws + OFF_WDOWN), NTOK, 1024, 2816, E, -1, 0, 1);
}

__device__ __forceinline__ void step_final(const Params& p) {
  const int tid = get_tid(), lane = tid & 63, wave = tid >> 6;
  for (int r = blockIdx.x * 8 + wave; r < NTOK; r += gridDim.x * 8) {
    const float* xr = (const float*)(p.ws + OFF_X1) + (size_t)r * 1024;
    float* xo = p.out + (size_t)r * 1024;
    float4 v[4];
    float ss = 0.f;
#pragma unroll
    for (int i = 0; i < 4; ++i) {
      v[i] = ((const float4*)xr)[i * 64 + lane];
      ss += v[i].x * v[i].x + v[i].y * v[i].y + v[i].z * v[i].z + v[i].w * v[i].w;
    }
    ss = wave_sum(ss);
    float rinv = rsqrtf(ss * (1.f / 1024.f) + 1e-6f);
#pragma unroll
    for (int i = 0; i < 4; ++i) {
      float4 w4 = ((const float4*)p.final_norm_w)[i * 64 + lane];
      ((float4*)xo)[i * 64 + lane] = float4{v[i].x * rinv * w4.x, v[i].y * rinv * w4.y, v[i].z * rinv * w4.z, v[i].w * rinv * w4.w};
    }
  }
}

constexpr int NSTEPS = 33;

__global__ void __launch_bounds__(NTHR) mega(Params p_arg) {
  const int step_lo = p_arg.step_lo, step_hi = p_arg.step_hi;
  __shared__ __attribute__((aligned(16))) char smem[SMEM_BYTES];
#if !MULTI_LAUNCH
  if (threadIdx.x == 0) *(uint4*)(smem + SMEM_BYTES - 16) = uint4{0u, 0u, 0u, 0u};
  __syncthreads();
  XcdBarrier xb = xcd_barrier_post((unsigned*)(p_arg.ws + OFF_BAR), (volatile LAS unsigned*)(smem + SMEM_BYTES - 16));
#endif
  for (int step = step_lo; step <= step_hi; ++step) {
#if defined(__HIP_DEVICE_COMPILE__)
    const __attribute__((address_space(4))) Params* pp = (const __attribute__((address_space(4))) Params*)__builtin_amdgcn_kernarg_segment_ptr();
    asm volatile("" : "+s"(pp));
    const Params p = *pp;
#else
    const Params p = p_arg;
#endif
    const int g = (step - 1) / 9, s = (step - 1) - g * 9;
    const int scode = step == 0 ? 0 : (step <= 27 ? 1 + s : step - 18);
    if (scode == 6 && g < 2) continue;
    if (scode == 1 && g > 0) continue;
    if (scode == 9 && g < 2) continue;
    const int reps = ((RM >> scode) & 1) ? 2 : 1;
    for (int rep = 0; rep < reps; ++rep) {
      if (!((SM >> scode) & 1)) continue;
      switch (scode) {
        case 0: step_prep(p, smem); break;
        case 1: step_norm<0>(p, g); break;
        case 2:
          if (g > 0 && (int)blockIdx.x >= 160 && gridDim.x > 160) step_sum(p, g - 1, (int)blockIdx.x - 160, (int)gridDim.x - 160);
          step_gemm1(p, smem, 0);
          break;
        case 3: step_cr1(p, g); break;
        case 4: step_r2(p, smem); if (g == 2) step_scan(p, smem, g, 1); break;
        case 5: step_scan(p, smem, g, g == 2 ? 2 : 3); break;
        case 6: step_fix(p, smem); break;
        case 7: step_fin(p, g); if (g < 2) step_norm<0>(p, g + 1); break;
        case 8:
          step_outproj(p, smem, g);
          if (g == 0 && blockIdx.x >= 192) {
            convT<1>(p.w_gu, 1024, 5632, (u16*)(p.ws + OFF_WGU), smem, blockIdx.x - 192, gridDim.x - 192);
            convT<2>(p.w_down, 2816, 1024, (u16*)(p.ws + OFF_WDOWN), smem, blockIdx.x - 192, gridDim.x - 192);
          }
          break;
        case 9: step_sum(p, g); break;
        case 10: step_wo(p, smem, 0); break;
        case 11: step_norm<1>(p, 0); break;
        case 12: step_gu(p, smem); break;
        case 13: if (reps == 2 && rep == 0) { Params q = p; q.out = (float*)(p.ws + (size_t)150000000); step_down(q, smem); } else step_down(p, smem); break;
        default: step_final(p); break;
      }
    }
    if (step < step_hi) {
#if !MULTI_LAUNCH
      if (step_hi > 100000) cg::this_grid().sync();
      for (int xs = 0; xs < 1 + XSYNC; ++xs) xcd_barrier(xb);
#endif
    }
  }
}

extern "C" void kernel_launch(void* const* d_in, const int* in_sizes, int n_in, void* d_out, int out_size,
                              void* d_ws, size_t ws_size, hipStream_t stream) {
  Params p{};
  const float** pp = (const float**)&p;
  for (int i = 0; i < 36; ++i) pp[i] = (const float*)d_in[i];
  p.out = (float*)d_out;
  p.ws = (char*)d_ws;
  if (ws_size < WS_NEED) fprintf(stderr, "workspace too small: %zu < %zu\n", ws_size, (size_t)WS_NEED);
#if MULTI_LAUNCH
  for (int s = 0; s < NSTEPS; ++s) {
    p.step_lo = s;
    p.step_hi = s;
    hipLaunchKernelGGL(mega, dim3(256), dim3(NTHR), 0, stream, p);
  }
#else
  static int grid_blocks = 0;
  if (!grid_blocks) {
    int dev = 0, cus = 0, per_cu = 0;
    hipGetDevice(&dev);
    hipDeviceGetAttribute(&cus, hipDeviceAttributeMultiprocessorCount, dev);
    hipOccupancyMaxActiveBlocksPerMultiprocessor(&per_cu, mega, NTHR, 0);
    if (per_cu < 1) per_cu = 1;
    if (per_cu > 1) per_cu = 1;
    grid_blocks = cus * per_cu;
  }
  p.step_lo = 0;
  p.step_hi = NSTEPS - 1;
  void* args[] = {&p};
  hipMemsetAsync((char*)d_ws + OFF_BAR, 0, XCD_BAR_WORDS_C * 4, stream);
  hipError_t e = hipLaunchCooperativeKernel((void*)mega, dim3(grid_blocks), dim3(NTHR), args, 0, stream);
  if (e != hipSuccess) fprintf(stderr, "cooperative launch failed: %s (grid %d)\n", hipGetErrorString(e), grid_blocks);
#endif
}
```
